# Optimizing an MI355X kernel written in HIP

```python
import math
import jax
import jax.numpy as jnp
from jax import lax
import numpy as np

D_MODEL = 1024
BATCH = 16
SEQ = 4096
DEPTH = 4

GRID_W = 64
CTX_LEN = 256
N_MIXERS = 3
N_MOD = 9
EPS = 1e-6
ROPE_BASE = 10000.0
D_FF = 128 * ((8 * D_MODEL + 3 * 128 - 1) // (3 * 128))

MLA_HEADS = D_MODEL // 128
MLA_NOPE = 128
MLA_ROPE = 64
MLA_V = 128
MLA_Q_RANK = 3 * D_MODEL // 8
MLA_KV_RANK = D_MODEL // 4
Q_BLOCK = 128

RET_HEADS = D_MODEL // 256
RET_DK = 256
RET_DV = 512
RET_CHUNK = 128

S5_GROUP = 16
S5_GROUPS = D_MODEL // S5_GROUP
S5_STATE = 64
S5_CHUNK = 128
DT_MIN = 1e-3
DT_MAX = 1e-1

N_MLA = (DEPTH + N_MIXERS - 1) // N_MIXERS
N_RET = (DEPTH + N_MIXERS - 2) // N_MIXERS
N_S5 = (DEPTH + N_MIXERS - 3) // N_MIXERS

kernel_name = 'hybrid_mla_retention_s5_dit'


def rms_norm(x, gain):
    xf = x.astype(jnp.float32)
    y = xf * lax.rsqrt(jnp.mean(xf * xf, axis=-1, keepdims=True) + EPS)
    return (y * gain.astype(jnp.float32)).astype(x.dtype)


def pre_norm(z, gain, mod, k):
    return rms_norm(z, gain) * (1 + mod[:, 3 * k + 1]) + mod[:, 3 * k]


def swiglu(x, w_in, w_out):
    a, b = jnp.split(x @ w_in, 2, axis=-1)
    return (jax.nn.silu(a) * b) @ w_out


def flip(a):
    return jnp.flip(a, axis=1)


def rope_angles(pos, dim):
    inv_freq = ROPE_BASE ** (-jnp.arange(0, dim, 2, dtype=jnp.float32) / dim)
    return pos.astype(jnp.float32)[:, None] * inv_freq[None, :]


def apply_rotary(x, ang):
    cos = jnp.cos(ang)[:, None, :]
    sin = jnp.sin(ang)[:, None, :]
    x1, x2 = jnp.split(x.astype(jnp.float32), 2, axis=-1)
    return jnp.concatenate([x1 * cos - x2 * sin, x2 * cos + x1 * sin], axis=-1).astype(x.dtype)


def grid_angles(n_tok, dim):
    rows = n_tok // GRID_W
    row = jnp.repeat(jnp.arange(rows), GRID_W)
    col = jnp.tile(jnp.arange(GRID_W), rows)
    return rope_angles(row, dim // 2), rope_angles(col, dim // 2)


def axial_rotary(x, angs):
    ang_row, ang_col = angs
    half = x.shape[-1] // 2
    return jnp.concatenate([apply_rotary(x[..., :half], ang_row), apply_rotary(x[..., half:], ang_col)], axis=-1)


def mla_qk_norm(x, gain):
    return jnp.concatenate([rms_norm(x[..., :MLA_NOPE], gain[:MLA_NOPE]),
                            rms_norm(x[..., MLA_NOPE:], gain[MLA_NOPE:])], axis=-1)


def mla_queries(cq, q_norm, w_uq, q_gain, angs):
    b, t, _ = cq.shape
    q = (rms_norm(cq, q_norm) @ w_uq).reshape(b, t, MLA_HEADS, MLA_NOPE + MLA_ROPE)
    q = mla_qk_norm(q, q_gain)
    if angs is None:
        return q
    return jnp.concatenate([q[..., :MLA_NOPE], axial_rotary(q[..., MLA_NOPE:], angs)], axis=-1)


def mla_keys_values(ckv, k_rope, kv_norm, w_ukv, k_gain, angs):
    b, t, _ = ckv.shape
    kv = (rms_norm(ckv, kv_norm) @ w_ukv).reshape(b, t, MLA_HEADS, MLA_NOPE + MLA_V)
    k_nope = rms_norm(kv[..., :MLA_NOPE], k_gain[:MLA_NOPE])
    k_rope = rms_norm(k_rope, k_gain[MLA_NOPE:])[:, :, None, :]
    if angs is not None:
        k_rope = axial_rotary(k_rope, angs)
    k = jnp.concatenate([k_nope, jnp.broadcast_to(k_rope, (b, t, MLA_HEADS, MLA_ROPE))], axis=-1)
    return k, kv[..., MLA_NOPE:]


def attend(q, k, v):
    s = jnp.einsum('bqhd,bkhd->bhqk', q, k, preferred_element_type=jnp.float32) * (q.shape[-1] ** -0.5)
    p = jax.nn.softmax(s, axis=-1).astype(v.dtype)
    return jnp.einsum('bhqk,bkhd->bqhd', p, v)


def blocked_attend(q, k, v):
    b, t, h, dk = q.shape
    nb = t // Q_BLOCK
    qb = q.reshape(b, nb, Q_BLOCK, h, dk).swapaxes(0, 1)
    o = lax.map(lambda qi: attend(qi, k, v), qb)
    return o.swapaxes(0, 1).reshape(b, t, h, v.shape[-1])


def mla_mixer(hn, gn, need_ctx, w_in, q_norm, kv_norm, w_uq, w_ukv, q_gain, k_gain, w_o):
    b, s, _ = hn.shape
    l = gn.shape[1]
    cuts = [MLA_Q_RANK, MLA_Q_RANK + MLA_KV_RANK]
    angs = grid_angles(s, MLA_ROPE)
    cq_l, ckv_l, kr_l = jnp.split(hn @ w_in, cuts, axis=-1)
    q_l = mla_queries(cq_l, q_norm, w_uq, q_gain, angs)
    k_l, v_l = mla_keys_values(ckv_l, kr_l, kv_norm, w_ukv, k_gain, angs)
    if need_ctx:
        cq_c, ckv_c, kr_c = jnp.split(gn @ w_in, cuts, axis=-1)
    else:
        ckv_c, kr_c = jnp.split(gn @ w_in[:, MLA_Q_RANK:], [MLA_KV_RANK], axis=-1)
    k_c, v_c = mla_keys_values(ckv_c, kr_c, kv_norm, w_ukv, k_gain, None)
    k_all = jnp.concatenate([k_c, k_l], axis=1)
    v_all = jnp.concatenate([v_c, v_l], axis=1)
    y_l = blocked_attend(q_l, k_all, v_all).reshape(b, s, MLA_HEADS * MLA_V) @ w_o
    y_c = None
    if need_ctx:
        q_c = mla_queries(cq_c, q_norm, w_uq, q_gain, None)
        y_c = attend(q_c, k_c, v_c).reshape(b, l, MLA_HEADS * MLA_V) @ w_o
    return y_l, y_c


def ret_heads(a, dim):
    return a.reshape(a.shape[0], a.shape[1], RET_HEADS, dim)


def retention_scan(q, k, v, log_g, state0, strict):
    b, t, h, _ = q.shape
    dv = v.shape[-1]
    c = RET_CHUNK
    n = t // c
    idx = jnp.arange(c, dtype=jnp.float32)
    diff = idx[:, None] - idx[None, :]
    lower = diff > 0 if strict else diff >= 0
    intra = jnp.where(lower[None], jnp.exp(log_g[:, None, None] * jnp.maximum(diff, 0.0)[None]), 0.0)
    q_dec = jnp.exp(log_g[None, :] * (idx[:, None] + 1.0))[None, :, :, None]
    k_dec = jnp.exp(log_g[None, :] * (c - 1.0 - idx[:, None]))[None, :, :, None]
    chunk_dec = jnp.exp(log_g * c)[None, :, None, None]

    def chunks(a):
        return a.astype(jnp.float32).reshape(b, n, c, h, a.shape[-1]).swapaxes(0, 1)

    def step(state, inp):
        qc, kc, vc = inp
        scores = jnp.einsum('bihd,bjhd->bhij', qc, kc) * intra[None]
        o = jnp.einsum('bhij,bjhe->bihe', scores, vc) + jnp.einsum('bihd,bhde->bihe', qc * q_dec, state)
        state = state * chunk_dec + jnp.einsum('bjhd,bjhe->bhde', kc * k_dec, vc)
        return state, o

    _, o = lax.scan(step, state0, (chunks(q), chunks(k), chunks(v)))
    return o.swapaxes(0, 1).reshape(b, t, h, dv)


def retention_state(k, v, log_g, expo):
    w = jnp.exp(expo[:, None] * log_g[None, :])
    return jnp.einsum('lh,blhd,blhe->bhde', w, k.astype(jnp.float32), v.astype(jnp.float32))


def retention_out(o, gate, gn_gain, w_o):
    b, t = o.shape[:2]
    mu = jnp.mean(o, axis=-1, keepdims=True)
    var = jnp.mean(jnp.square(o - mu), axis=-1, keepdims=True)
    on = ((o - mu) * lax.rsqrt(var + EPS)).reshape(b, t, RET_HEADS * RET_DV)
    y = on * gn_gain.astype(jnp.float32) * jax.nn.silu(gate.astype(jnp.float32))
    return y.astype(w_o.dtype) @ w_o


def retention_mixer(hn, gn, need_ctx, w_in, log1m_gamma, gn_gain, w_o):
    b, s, _ = hn.shape
    l = gn.shape[1]
    hdk, hdv = RET_HEADS * RET_DK, RET_HEADS * RET_DV
    cuts = [hdk, 2 * hdk, 2 * hdk + hdv]
    log_g = jnp.log1p(-jnp.exp(log1m_gamma.astype(jnp.float32)))
    scale = RET_DK ** -0.5
    q_l, k_l, v_l, gate_l = jnp.split(hn @ w_in, cuts, axis=-1)
    ang = rope_angles(jnp.arange(s), RET_DK)
    q_l = apply_rotary(ret_heads(q_l, RET_DK), ang)
    k_l = apply_rotary(ret_heads(k_l, RET_DK), ang) * scale
    v_l = ret_heads(v_l, RET_DV)
    if need_ctx:
        q_c, k_c, v_c, gate_c = jnp.split(gn @ w_in, cuts, axis=-1)
    else:
        k_c, v_c = jnp.split(gn @ w_in[:, hdk:2 * hdk + hdv], [hdk], axis=-1)
    k_c = ret_heads(k_c, RET_DK) * scale
    v_c = ret_heads(v_c, RET_DV)
    pos_c = jnp.arange(l, dtype=jnp.float32)
    s_fwd = retention_state(k_c, v_c, log_g[0], (l - 1) - pos_c)
    s_bwd = retention_state(k_c, v_c, log_g[1], pos_c)
    o_l = (retention_scan(q_l, k_l, v_l, log_g[0], s_fwd, False)
           + flip(retention_scan(flip(q_l), flip(k_l), flip(v_l), log_g[1], s_bwd, True)))
    y_l = retention_out(o_l, gate_l, gn_gain, w_o)
    y_c = None
    if need_ctx:
        q_c = ret_heads(q_c, RET_DK)
        zero = jnp.zeros_like(s_fwd)
        o_c = (retention_scan(q_c, k_c, v_c, log_g[0], zero, False)
               + flip(retention_scan(flip(q_c), flip(k_c), flip(v_c), log_g[1], zero, True)))
        y_c = retention_out(o_c, gate_c, gn_gain, w_o)
    return y_l, y_c


def s5_discretise(lam_re, lam_im, log_dt, b_re, b_im, c_re, c_im):
    f32 = jnp.float32
    lam = lax.complex(lam_re.astype(f32), lam_im.astype(f32))
    a_log = lam * jnp.exp(log_dt.astype(f32))[:, None]
    b_bar = ((jnp.exp(a_log) - 1.0) / lam)[..., None] * lax.complex(b_re.astype(f32), b_im.astype(f32))
    c_mat = lax.complex(c_re.astype(f32), c_im.astype(f32))
    return a_log, b_bar, c_mat


def ssm_combine(e1, e2):
    a1, b1 = e1
    a2, b2 = e2
    return a1 * a2, a2 * b1 + b2


def s5_state(u, a_log, b_bar, expo):
    pw = jnp.exp(a_log[None] * expo[:, None, None])
    return jnp.einsum('lgp,gpm,blgm->bgp', pw, b_bar, u.astype(jnp.complex64))


def s5_scan(u, a_log, b_bar, c_mat, h0):
    b, t, g, m = u.shape
    n = t // S5_CHUNK
    a_bar = jnp.exp(a_log)

    def step(h_prev, uc):
        bu = jnp.einsum('gpm,bcgm->bcgp', b_bar, uc.astype(jnp.complex64))
        a_cum, h_loc = lax.associative_scan(ssm_combine, (jnp.broadcast_to(a_bar, bu.shape), bu), axis=1)
        hs = h_loc + a_cum * h_prev[:, None]
        y = jnp.einsum('gmp,bcgp->bcgm', c_mat, hs).real
        return hs[:, -1], y

    _, y = lax.scan(step, h0, u.reshape(b, n, S5_CHUNK, g, m).swapaxes(0, 1))
    return y.swapaxes(0, 1).reshape(b, t, g, m)


def s5_out(y, glu_w, glu_b):
    z = jax.nn.gelu(y).astype(glu_w.dtype)
    a, gate = jnp.split(z @ glu_w + glu_b, 2, axis=-1)
    return a * jax.nn.sigmoid(gate)


def s5_mixer(hn, gn, need_ctx, lam_re, lam_im, log_dt, b_re, b_im, c_re, c_im, d_skip, glu_w, glu_b):
    b, s, d = hn.shape
    l = gn.shape[1]
    fwd = s5_discretise(lam_re[0], lam_im[0], log_dt[0], b_re[0], b_im[0], c_re[0], c_im[0])
    bwd = s5_discretise(lam_re[1], lam_im[1], log_dt[1], b_re[1], b_im[1], c_re[1], c_im[1])
    u_l = hn.astype(jnp.float32).reshape(b, s, S5_GROUPS, S5_GROUP)
    u_c = gn.astype(jnp.float32).reshape(b, l, S5_GROUPS, S5_GROUP)
    d_g = d_skip.astype(jnp.float32).reshape(S5_GROUPS, S5_GROUP)
    pos_c = jnp.arange(l, dtype=jnp.float32)
    h_fwd = s5_state(u_c, fwd[0], fwd[1], (l - 1) - pos_c)
    h_bwd = s5_state(u_c, bwd[0], bwd[1], pos_c)
    y_l = s5_scan(u_l, *fwd, h_fwd) + flip(s5_scan(flip(u_l), *bwd, h_bwd)) + d_g * u_l
    out_l = s5_out(y_l.reshape(b, s, d), glu_w, glu_b)
    out_c = None
    if need_ctx:
        zero = jnp.zeros_like(h_fwd)
        y_c = s5_scan(u_c, *fwd, zero) + flip(s5_scan(flip(u_c), *bwd, zero)) + d_g * u_c
        out_c = s5_out(y_c.reshape(b, l, d), glu_w, glu_b)
    return out_l, out_c


def setup_inputs(seed: int = 0) -> dict:
    key = jax.random.key(seed)
    keys = iter(jax.random.split(key, 40))
    f32 = jnp.float32

    def nrm(shape, std):
        return jax.random.normal(next(keys), shape, f32) * std

    def gain(shape):
        return 1.0 + nrm(shape, 0.01)

    d = D_MODEL
    hq = MLA_HEADS * (MLA_NOPE + MLA_ROPE)
    hkv = MLA_HEADS * (MLA_NOPE + MLA_V)
    hdk, hdv = RET_HEADS * RET_DK, RET_HEADS * RET_DV
    gp = (N_S5, 2, S5_GROUPS, S5_STATE)
    decay0 = -(5.0 + jnp.arange(RET_HEADS, dtype=f32)) * math.log(2.0)
    return {
        'x': nrm((BATCH, SEQ, d), 1.0),
        'c': nrm((BATCH, d), 1.0),
        'ctx': nrm((BATCH, CTX_LEN, d), 1.0),
        'c_ctx': nrm((d,), 1.0),
        'ada_w': nrm((DEPTH, d, N_MOD * d), 0.5 * d ** -0.5),
        'ada_b': nrm((DEPTH, N_MOD * d), 0.01),
        'norm_g': gain((DEPTH, 3, d)),
        'ffn_w_in': nrm((DEPTH, 2, d, 2 * D_FF), d ** -0.5),
        'ffn_w_out': nrm((DEPTH, 2, D_FF, d), D_FF ** -0.5),
        'mla_w_in': nrm((N_MLA, d, MLA_Q_RANK + MLA_KV_RANK + MLA_ROPE), d ** -0.5),
        'mla_q_norm': gain((N_MLA, MLA_Q_RANK)),
        'mla_kv_norm': gain((N_MLA, MLA_KV_RANK)),
        'mla_w_uq': nrm((N_MLA, MLA_Q_RANK, hq), MLA_Q_RANK ** -0.5),
        'mla_w_ukv': nrm((N_MLA, MLA_KV_RANK, hkv), MLA_KV_RANK ** -0.5),
        'mla_q_gain': gain((N_MLA, MLA_NOPE + MLA_ROPE)),
        'mla_k_gain': gain((N_MLA, MLA_NOPE + MLA_ROPE)),
        'mla_w_o': nrm((N_MLA, MLA_HEADS * MLA_V, d), (MLA_HEADS * MLA_V) ** -0.5),
        'ret_w_in': nrm((N_RET, d, 2 * hdk + 2 * hdv), d ** -0.5),
        'ret_log1m_gamma': jnp.broadcast_to(decay0, (N_RET, 2, RET_HEADS)) + nrm((N_RET, 2, RET_HEADS), 0.05),
        'ret_gn_gain': gain((N_RET, hdv)),
        'ret_w_o': nrm((N_RET, hdv, d), hdv ** -0.5),
        's5_lam_re': -0.5 + nrm(gp, 0.01),
        's5_lam_im': jnp.pi * jnp.arange(S5_STATE, dtype=f32) + nrm(gp, 0.01),
        's5_log_dt': jax.random.uniform(next(keys), (N_S5, 2, S5_GROUPS), f32, math.log(DT_MIN), math.log(DT_MAX)),
        's5_b_re': nrm(gp + (S5_GROUP,), (2 * S5_GROUP) ** -0.5),
        's5_b_im': nrm(gp + (S5_GROUP,), (2 * S5_GROUP) ** -0.5),
        's5_c_re': nrm((N_S5, 2, S5_GROUPS, S5_GROUP, S5_STATE), S5_STATE ** -0.5),
        's5_c_im': nrm((N_S5, 2, S5_GROUPS, S5_GROUP, S5_STATE), S5_STATE ** -0.5),
        's5_d': nrm((N_S5, d), 1.0),
        's5_glu_w': nrm((N_S5, d, 2 * d), d ** -0.5),
        's5_glu_b': nrm((N_S5, 2 * d), 0.01),
    }


def reference(x, c, ctx, c_ctx, ada_w, ada_b, norm_g, ffn_w_in, ffn_w_out,
              mla_w_in, mla_q_norm, mla_kv_norm, mla_w_uq, mla_w_ukv, mla_q_gain, mla_k_gain, mla_w_o,
              ret_w_in, ret_log1m_gamma, ret_gn_gain, ret_w_o,
              s5_lam_re, s5_lam_im, s5_log_dt, s5_b_re, s5_b_im, s5_c_re, s5_c_im, s5_d, s5_glu_w, s5_glu_b):
    b, s, d = x.shape
    silu_c = jax.nn.silu(c)
    silu_cc = jax.nn.silu(c_ctx)[None, :]
    h, g = x, ctx
    for i in range(DEPTH):
        last = i == DEPTH - 1
        kind, j = i % N_MIXERS, i // N_MIXERS
        mod_l = (silu_c @ ada_w[i] + ada_b[i]).reshape(b, N_MOD, 1, d)
        mod_c = (silu_cc @ ada_w[i] + ada_b[i]).reshape(1, N_MOD, 1, d)
        h = h + 0.5 * mod_l[:, 2] * swiglu(pre_norm(h, norm_g[i, 0], mod_l, 0), ffn_w_in[i, 0], ffn_w_out[i, 0])
        g = g + 0.5 * mod_c[:, 2] * swiglu(pre_norm(g, norm_g[i, 0], mod_c, 0), ffn_w_in[i, 0], ffn_w_out[i, 0])
        hn = pre_norm(h, norm_g[i, 1], mod_l, 1)
        gn = pre_norm(g, norm_g[i, 1], mod_c, 1)
        if kind == 0:
            y_l, y_c = mla_mixer(hn, gn, not last, mla_w_in[j], mla_q_norm[j], mla_kv_norm[j], mla_w_uq[j],
                                 mla_w_ukv[j], mla_q_gain[j], mla_k_gain[j], mla_w_o[j])
        elif kind == 1:
            y_l, y_c = retention_mixer(hn, gn, not last, ret_w_in[j], ret_log1m_gamma[j], ret_gn_gain[j], ret_w_o[j])
        else:
            y_l, y_c = s5_mixer(hn, gn, not last, s5_lam_re[j], s5_lam_im[j], s5_log_dt[j], s5_b_re[j], s5_b_im[j],
                                s5_c_re[j], s5_c_im[j], s5_d[j], s5_glu_w[j], s5_glu_b[j])
        h = h + mod_l[:, 5] * y_l
        h = h + 0.5 * mod_l[:, 8] * swiglu(pre_norm(h, norm_g[i, 2], mod_l, 2), ffn_w_in[i, 1], ffn_w_out[i, 1])
        if not last:
            g = g + mod_c[:, 5] * y_c
            g = g + 0.5 * mod_c[:, 8] * swiglu(pre_norm(g, norm_g[i, 2], mod_c, 2), ffn_w_in[i, 1], ffn_w_out[i, 1])
    return h
```

```cpp
#ifdef HOST_EMU
#include <cmath>
#include <cstdio>
#include <cstdlib>
#include <cstring>
#include <vector>
#define HD inline
#else
#include <hip/hip_runtime.h>
#include <hip/hip_cooperative_groups.h>
#include <cstdio>
#define HD __device__ __forceinline__
#endif

#ifndef CFG_BATCH
#define CFG_BATCH 16
#endif
#ifndef CFG_SEQ
#define CFG_SEQ 4096
#endif

typedef unsigned short u16;
typedef float f32x4 __attribute__((ext_vector_type(4)));
typedef unsigned u32x2 __attribute__((ext_vector_type(2)));

constexpr int DM = 1024, NB = CFG_BATCH, SEQ = CFG_SEQ, CTX = 256, DFF = 2816, DEPTH = 4;
constexpr int NL = NB * SEQ, NC = NB * CTX, MT = NL + NC;
constexpr int NMR = NB + 1;
constexpr int RGB = (NB >= 4) ? 4 : 1;
constexpr int NCH = 1 + SEQ / 256;
constexpr int NCQ = RGB * NCH;
constexpr int S5L = SEQ / 32, S5C = CTX / 32;
constexpr int NROW5 = NB * S5L + NB * S5C;
constexpr int NROW5P = (NROW5 + 255) / 256 * 256;
constexpr float EPS = 1e-6f;

constexpr size_t al(size_t x) { return (x + 255) & ~(size_t)255; }
constexpr size_t O_MOD = 0;
constexpr size_t O_G = O_MOD + al((size_t)DEPTH * NMR * 9216 * 4);
constexpr size_t O_FFI = O_G + al((size_t)NC * 1024 * 4);
constexpr size_t SZ_FFI1 = (size_t)5632 * 1024 * 2, SZ_FFO1 = (size_t)1024 * 2816 * 2;
constexpr size_t O_FFO = O_FFI + 8 * SZ_FFI1;
constexpr size_t O_MWIN = O_FFO + 8 * SZ_FFO1;
constexpr size_t SZ_MWIN = (size_t)768 * 1024 * 2, SZ_MWUQ = (size_t)1536 * 384 * 2, SZ_MWUKV = (size_t)2048 * 256 * 2, SZ_MWO = (size_t)1024 * 1024 * 2;
constexpr size_t O_MWUQ = O_MWIN + 2 * SZ_MWIN;
constexpr size_t O_MWUKV = O_MWUQ + 2 * SZ_MWUQ;
constexpr size_t O_MWO = O_MWUKV + 2 * SZ_MWUKV;
constexpr size_t O_RWIN = O_MWO + 2 * SZ_MWO;
constexpr size_t O_RWO = O_RWIN + (size_t)6144 * 1024 * 2;
constexpr size_t O_GLU = O_RWO + (size_t)1024 * 2048 * 2;
constexpr size_t O_HN = O_GLU + (size_t)2048 * 1024 * 2;
constexpr size_t O_SCR = O_HN + al((size_t)MT * 1024 * 2);
constexpr size_t O_ACT = O_SCR;
constexpr size_t O_CALL = O_SCR;
constexpr size_t O_CQN = O_CALL + al((size_t)MT * 768 * 4);
constexpr size_t O_CKVN = O_CQN + al((size_t)MT * 384 * 2);
constexpr size_t O_KF = O_CKVN + al((size_t)MT * 256 * 2);
constexpr size_t O_VB = O_KF + al((size_t)MT * 1536 * 2);
constexpr size_t END_MLA = O_VB + al((size_t)MT * 1024 * 2);
constexpr size_t O_QN = O_SCR;
constexpr size_t O_KN = O_QN + al((size_t)NCQ * 256 * 1024 * 2);
constexpr size_t O_GATE = O_KN + al((size_t)NCQ * 256 * 1024 * 2);
constexpr size_t O_OB = O_GATE + al((size_t)NCQ * 256 * 2048 * 2);
constexpr size_t O_AEXT = O_OB + al((size_t)NCQ * 256 * 2048 * 2);
constexpr size_t O_KTX = O_AEXT + al((size_t)4 * NCQ * 256 * 768 * 2);
constexpr size_t O_BEXT = O_KTX + al((size_t)4 * NCQ * 2 * 256 * 256 * 2);
constexpr size_t END_RET = O_BEXT + al((size_t)4 * NCQ * 512 * 768 * 2);
constexpr size_t O_UEXT = O_SCR;
constexpr size_t O_KTAB = O_UEXT + al((size_t)64 * NROW5P * 768 * 2);
constexpr size_t O_TEXT = O_KTAB + al((size_t)64 * 2 * 32 * 256 * 4);
constexpr size_t O_FEXT = O_TEXT + al((size_t)64 * 512 * 768 * 2);
constexpr size_t END_S5 = O_FEXT + al((size_t)64 * 256 * 512 * 2);
constexpr size_t END_FFN = O_ACT + al((size_t)MT * 2816 * 2);
constexpr size_t cmax(size_t a, size_t b) { return a > b ? a : b; }
constexpr size_t WS_NEED = cmax(cmax(END_MLA, END_RET), cmax(END_S5, END_FFN));

struct P { const float* in[32]; float* out; char* ws; };
#ifndef PHASE_MASK
#define PHASE_MASK 0xFFFFFFFFu
#endif
#define PM(b) ((PHASE_MASK >> (b)) & 1u)

HD float bf2f(u16 b) { union { unsigned u; float f; } x; x.u = ((unsigned)b) << 16; return x.f; }
HD u16 f2bf(float f) { union { unsigned u; float f; } x; x.f = f; unsigned u = x.u; u += 0x7fffu + ((u >> 16) & 1u); return (u16)(u >> 16); }
HD void st4bf(u16* p, f32x4 v) { u32x2 w; w.x = (unsigned)f2bf(v[0]) | ((unsigned)f2bf(v[1]) << 16); w.y = (unsigned)f2bf(v[2]) | ((unsigned)f2bf(v[3]) << 16); *(u32x2*)p = w; }
HD float silu_f(float a) { return a / (1.0f + expf(-a)); }
HD float sigm_f(float a) { return 1.0f / (1.0f + expf(-a)); }
HD float gelu_f(float x) { return 0.5f * x * (1.0f + tanhf(0.7978845608028654f * (x + 0.044715f * x * x * x))); }
HD float rsq_f(float x) { return 1.0f / sqrtf(x); }
HD float ex2(float x) {
#ifdef HOST_EMU
    return exp2f(x);
#else
    return __builtin_amdgcn_exp2f(x);
#endif
}
HD float* hrow(const P& p, int r) { return r < NL ? p.out + (size_t)r * 1024 : (float*)(p.ws + O_G) + (size_t)(r - NL) * 1024; }
HD const float* modp(const P& p, int layer, int r, int idx) { const int mr = r < NL ? r / SEQ : NB; return (const float*)(p.ws + O_MOD) + ((size_t)(layer * NMR + mr) * 9 + idx) * 1024; }
HD u16* wsb(const P& p, size_t off) { return (u16*)(p.ws + off); }
HD float ropef(int d, int half) { return expf(-(float)d * (9.210340371976184f / (float)half)) * 0.15915494309189535f; }
HD void sincos_t(float turns, float& sn, float& cs) {
    const float f = turns - floorf(turns);
#ifdef HOST_EMU
    sn = sinf(6.283185307179586f * f); cs = cosf(6.283185307179586f * f);
#else
    sn = __builtin_amdgcn_sinf(f); cs = __builtin_amdgcn_cosf(f);
#endif
}

HD bool rect_unit(int L, int nM, int nN, int& pm, int& pn) {
    const int nwg = nM * nN; if (L >= nwg) return false;
    int wgid = L; { const int q = nwg / 8, r = nwg % 8, xcd = wgid % 8, off = wgid / 8; wgid = (xcd < r ? xcd * (q + 1) : r * (q + 1) + (xcd - r) * q) + off; }
    const int nig = 8 * nN, gid = wgid / nig, fm = gid * 8, gsz = (nM - fm) < 8 ? (nM - fm) : 8;
    pm = fm + ((wgid % nig) % gsz); pn = (wgid % nig) / gsz; return true;
}

struct Unit { const u16* A; const u16* B; int a, b, c, d; float f0, f1; };

struct DFfnUp { P p; int layer, f; static constexpr int K = 1024, lda = 1024, ldb = 1024;
    HD bool unit(int L, Unit& u) const { int pm, pn; if (!rect_unit(L, MT / 256, 22, pm, pn)) return false;
        u.A = wsb(p, O_HN) + (size_t)pm * 256 * 1024; u.B = wsb(p, O_FFI + (size_t)(layer * 2 + f) * SZ_FFI1) + (size_t)pn * 256 * 1024; u.a = pm; u.b = pn; u.c = 0; u.d = 0; return true; }
    HD void emit(const Unit& u, int r, int c, f32x4 v00, f32x4 v01, f32x4 v10, f32x4 v11) const {
        u16* act = wsb(p, O_ACT); const size_t R = (size_t)u.a * 256 + r; const int col = u.b * 128 + c; f32x4 o0, o1;
        for (int j = 0; j < 4; ++j) { o0[j] = silu_f(v00[j]) * v01[j]; o1[j] = silu_f(v10[j]) * v11[j]; }
        st4bf(act + R * 2816 + col, o0); st4bf(act + (R + 128) * 2816 + col, o1); } };

HD void resid4(const P& p, int layer, int midx, float sc, int R, int col, f32x4 v) {
    float* h = hrow(p, R) + col; const float* m = modp(p, layer, R, midx) + col; f32x4 x = *(f32x4*)h;
    for (int j = 0; j < 4; ++j) x[j] += sc * m[j] * v[j];
    *(f32x4*)h = x; }

struct DFfnDown { P p; int layer, f, nM; static constexpr int K = 2816, lda = 2816, ldb = 2816;
    HD bool unit(int L, Unit& u) const { int pm, pn; if (!rect_unit(L, nM, 4, pm, pn)) return false;
        u.A = wsb(p, O_ACT) + (size_t)pm * 256 * 2816; u.B = wsb(p, O_FFO + (size_t)(layer * 2 + f) * SZ_FFO1) + (size_t)pn * 256 * 2816; u.a = pm; u.b = pn; u.c = 0; u.d = 0; return true; }
    HD void emit(const Unit& u, int r, int c, f32x4 v00, f32x4 v01, f32x4 v10, f32x4 v11) const {
        const int R = u.a * 256 + r, col = u.b * 256 + c, mi = f ? 8 : 2;
        resid4(p, layer, mi, 0.5f, R, col, v00); resid4(p, layer, mi, 0.5f, R, col + 128, v01); resid4(p, layer, mi, 0.5f, R + 128, col, v10); resid4(p, layer, mi, 0.5f, R + 128, col + 128, v11); } };

struct DMlaIn { P p; int j; static constexpr int K = 1024, lda = 1024, ldb = 1024;
    HD bool unit(int L, Unit& u) const { int pm, pn; if (!rect_unit(L, MT / 256, 3, pm, pn)) return false;
        u.A = wsb(p, O_HN) + (size_t)pm * 256 * 1024; u.B = wsb(p, O_MWIN + j * SZ_MWIN) + (size_t)pn * 256 * 1024; u.a = pm; u.b = pn; u.c = 0; u.d = 0; return true; }
    HD void emit(const Unit& u, int r, int c, f32x4 v00, f32x4 v01, f32x4 v10, f32x4 v11) const {
        float* o = (float*)(p.ws + O_CALL) + ((size_t)u.a * 256 + r) * 768 + u.b * 256 + c;
        *(f32x4*)o = v00; *(f32x4*)(o + 128) = v01; *(f32x4*)(o + (size_t)128 * 768) = v10; *(f32x4*)(o + (size_t)128 * 768 + 128) = v11; } };
struct DMlaUq { P p; int j; static constexpr int K = 384, lda = 384, ldb = 384;
    HD bool unit(int L, Unit& u) const { int pm, pn; if (!rect_unit(L, MT / 256, 6, pm, pn)) return false;
        u.A = wsb(p, O_CQN) + (size_t)pm * 256 * 384; u.B = wsb(p, O_MWUQ + j * SZ_MWUQ) + (size_t)pn * 256 * 384; u.a = pm; u.b = pn; u.c = 0; u.d = 0; return true; }
    HD void emit(const Unit& u, int r, int c, f32x4 v00, f32x4 v01, f32x4 v10, f32x4 v11) const {
        u16* o = wsb(p, O_CALL) + ((size_t)u.a * 256 + r) * 1536 + u.b * 256 + c;
        st4bf(o, v00); st4bf(o + 128, v01); st4bf(o + (size_t)128 * 1536, v10); st4bf(o + (size_t)128 * 1536 + 128, v11); } };
struct DMlaUkv { P p; int j; static constexpr int K = 256, lda = 256, ldb = 256;
    HD bool unit(int L, Unit& u) const { int pm, pn; if (!rect_unit(L, MT / 256, 8, pm, pn)) return false;
        u.A = wsb(p, O_CKVN) + (size_t)pm * 256 * 256; u.B = wsb(p, O_MWUKV + j * SZ_MWUKV) + (size_t)pn * 256 * 256; u.a = pm; u.b = pn; u.c = 0; u.d = 0; return true; }
    HD void one(size_t R, int col, f32x4 v) const {
        if (col < 1024) st4bf(wsb(p, O_KF) + R * 1536 + (col >> 7) * 192 + (col & 127), v);
        else st4bf(wsb(p, O_VB) + R * 1024 + (col - 1024), v); }
    HD void emit(const Unit& u, int r, int c, f32x4 v00, f32x4 v01, f32x4 v10, f32x4 v11) const {
        const size_t R = (size_t)u.a * 256 + r; const int col = u.b * 256 + c;
        one(R, col, v00); one(R, col + 128, v01); one(R + 128, col, v10); one(R + 128, col + 128, v11); } };
struct DMlaO { P p; int layer, j, nM; static constexpr int K = 1024, lda = 1024, ldb = 1024;
    HD bool unit(int L, Unit& u) const { int pm, pn; if (!rect_unit(L, nM, 4, pm, pn)) return false;
        u.A = wsb(p, O_HN) + (size_t)pm * 256 * 1024; u.B = wsb(p, O_MWO + j * SZ_MWO) + (size_t)pn * 256 * 1024; u.a = pm; u.b = pn; u.c = 0; u.d = 0; return true; }
    HD void emit(const Unit& u, int r, int c, f32x4 v00, f32x4 v01, f32x4 v10, f32x4 v11) const {
        const int R = u.a * 256 + r, col = u.b * 256 + c;
        resid4(p, layer, 5, 1.0f, R, col, v00); resid4(p, layer, 5, 1.0f, R, col + 128, v01); resid4(p, layer, 5, 1.0f, R + 128, col, v10); resid4(p, layer, 5, 1.0f, R + 128, col + 128, v11); } };

HD int ret_tokrow(int q, int cidx) { const int b = q * RGB + cidx / NCH, n = cidx % NCH; return n == 0 ? NL + b * 256 : b * SEQ + (n - 1) * 256; }
HD float ret_logg(const P& p, int dir, int h) { return log1pf(-expf(p.in[18][dir * 4 + h])); }
struct DRetProj { P p; int q; static constexpr int K = 1024, lda = 1024, ldb = 1024;
    HD bool unit(int L, Unit& u) const { int pm, pn; if (!rect_unit(L, NCQ, 16, pm, pn)) return false;
        const int wrow = pn < 8 ? pn * 256 : 4096 + (pn - 8) * 256;
        u.A = wsb(p, O_HN) + (size_t)ret_tokrow(q, pm) * 1024; u.B = wsb(p, O_RWIN) + (size_t)wrow * 1024; u.a = pm; u.b = pn; u.c = 0; u.d = 0;
        u.f0 = ret_logg(p, 0, pn & 3) * 1.4426950408889634f; u.f1 = ret_logg(p, 1, pn & 3) * 1.4426950408889634f; return true; }
    HD void emit(const Unit& u, int r, int c, f32x4 v00, f32x4 v01, f32x4 v10, f32x4 v11) const {
        const int cidx = u.a, pn = u.b, n = cidx % NCH;
        if (pn >= 8) { u16* g = wsb(p, O_GATE) + ((size_t)cidx * 256 + r) * 2048 + (pn - 8) * 256 + c;
            st4bf(g, v00); st4bf(g + 128, v01); st4bf(g + (size_t)128 * 2048, v10); st4bf(g + (size_t)128 * 2048 + 128, v11); return; }
        const int h = pn & 3; const bool isq = pn < 4;
        const float lgf = u.f0, lgb = u.f1;
        for (int X = 0; X < 2; ++X) { const int i = r + 128 * X; const f32x4 x1 = X ? v10 : v00, x2 = X ? v11 : v01; f32x4 r1, r2;
            for (int jx = 0; jx < 4; ++jx) { float cs = 1.f, sn = 0.f;
                if (n > 0) sincos_t((float)((n - 1) * 256 + i) * ropef(c + jx, 128), sn, cs);
                r1[jx] = x1[jx] * cs - x2[jx] * sn; r2[jx] = x2[jx] * cs + x1[jx] * sn; }
            if (isq) { u16* qn = wsb(p, O_QN) + ((size_t)cidx * 256 + i) * 1024 + h * 256 + c; st4bf(qn, r1); st4bf(qn + 128, r2);
                const float df = ex2(lgf * (float)(i + 1)), db = ex2(lgb * (float)(256 - i));
                u16* ae = wsb(p, O_AEXT) + (((size_t)h * NCQ + cidx) * 256 + i) * 768;
                st4bf(ae + 256 + c, r1 * df); st4bf(ae + 384 + c, r2 * df); st4bf(ae + 512 + c, r1 * db); st4bf(ae + 640 + c, r2 * db); }
            else { u16* kn = wsb(p, O_KN) + ((size_t)cidx * 256 + i) * 1024 + h * 256 + c; st4bf(kn, r1 * 0.0625f); st4bf(kn + 128, r2 * 0.0625f); } } } };
struct DRetProjT { P p; int q; static constexpr int K = 1024, lda = 1024, ldb = 1024;
    HD bool unit(int L, Unit& u) const { int pm, pn; if (!rect_unit(L, 12, NCQ, pm, pn)) return false;
        u.A = wsb(p, O_RWIN) + (size_t)(1024 + pm * 256) * 1024; u.B = wsb(p, O_HN) + (size_t)ret_tokrow(q, pn) * 1024; u.a = pm; u.b = pn; u.c = 0; u.d = 0;
        u.f0 = ret_logg(p, 0, pm & 3) * 1.4426950408889634f; u.f1 = ret_logg(p, 1, pm & 3) * 1.4426950408889634f; return true; }
    HD void emit(const Unit& u, int r, int c, f32x4 v00, f32x4 v01, f32x4 v10, f32x4 v11) const {
        const int pm = u.a, cidx = u.b, n = cidx % NCH;
        if (pm >= 4) { const int h = (pm - 4) >> 1, e0 = ((pm - 4) & 1) * 256 + r; u16* be = wsb(p, O_BEXT) + (((size_t)h * NCQ + cidx) * 512 + e0) * 768 + c;
            st4bf(be, v00); st4bf(be + 128, v01); st4bf(be + (size_t)128 * 768, v10); st4bf(be + (size_t)128 * 768 + 128, v11); return; }
        const int h = pm; const float lgf = u.f0, lgb = u.f1, fr = ropef(r, 128);
        u16* kf = wsb(p, O_KTX) + (((size_t)h * NCQ + cidx) * 2 + 0) * 65536; u16* kb = kf + 65536;
        for (int Y = 0; Y < 2; ++Y) { const f32x4 x1 = Y ? v01 : v00, x2 = Y ? v11 : v10; f32x4 f1, f2, b1, b2;
            for (int jx = 0; jx < 4; ++jx) { const int jj = c + 128 * Y + jx; float cs = 1.f, sn = 0.f;
                if (n > 0) sincos_t((float)((n - 1) * 256 + jj) * fr, sn, cs);
                const float r1 = (x1[jx] * cs - x2[jx] * sn) * 0.0625f, r2 = (x2[jx] * cs + x1[jx] * sn) * 0.0625f;
                const float df = ex2(lgf * (float)(255 - jj)), db = ex2(lgb * (float)jj);
                f1[jx] = r1 * df; f2[jx] = r2 * df; b1[jx] = r1 * db; b2[jx] = r2 * db; }
            const int jc = c + 128 * Y;
            st4bf(kf + (size_t)r * 256 + jc, f1); st4bf(kf + (size_t)(r + 128) * 256 + jc, f2); st4bf(kb + (size_t)r * 256 + jc, b1); st4bf(kb + (size_t)(r + 128) * 256 + jc, b2); } } };
struct DRetP { P p; static constexpr int K = 256, lda = 1024, ldb = 1024;
    HD bool unit(int L, Unit& u) const { int pm, pn; if (!rect_unit(L, NCQ, 4, pm, pn)) return false;
        u.A = wsb(p, O_QN) + (size_t)pm * 256 * 1024 + pn * 256; u.B = wsb(p, O_KN) + (size_t)pm * 256 * 1024 + pn * 256; u.a = pm; u.b = pn; u.c = 0; u.d = 0;
        u.f0 = ret_logg(p, 0, pn) * 1.4426950408889634f; u.f1 = ret_logg(p, 1, pn) * 1.4426950408889634f; return true; }
    HD void one(u16* ae, float lgf, float lgb, int i, int j0, f32x4 v) const { f32x4 o;
        for (int jx = 0; jx < 4; ++jx) { const int jj = j0 + jx; o[jx] = v[jx] * ex2(jj <= i ? lgf * (float)(i - jj) : lgb * (float)(jj - i)); }
        st4bf(ae + (size_t)i * 768 + j0, o); }
    HD void emit(const Unit& u, int r, int c, f32x4 v00, f32x4 v01, f32x4 v10, f32x4 v11) const {
        const int cidx = u.a, h = u.b; const float lgf = u.f0, lgb = u.f1;
        u16* ae = wsb(p, O_AEXT) + ((size_t)h * NCQ + cidx) * 256 * 768;
        one(ae, lgf, lgb, r, c, v00); one(ae, lgf, lgb, r, c + 128, v01); one(ae, lgf, lgb, r + 128, c, v10); one(ae, lgf, lgb, r + 128, c + 128, v11); } };
struct DRetL { P p; static constexpr int K = 256, lda = 768, ldb = 256;
    HD bool unit(int L, Unit& u) const { int pm, pn; if (!rect_unit(L, 4 * NCQ, 4, pm, pn)) return false;
        const int dir = pn >> 1, eh = pn & 1;
        u.A = wsb(p, O_BEXT) + ((size_t)pm * 512 + eh * 256) * 768; u.B = wsb(p, O_KTX) + ((size_t)pm * 2 + dir) * 65536; u.a = pm; u.b = dir; u.c = eh; u.d = 0; return true; }
    HD void emit(const Unit& u, int r, int c, f32x4 v00, f32x4 v01, f32x4 v10, f32x4 v11) const {
        u16* o = wsb(p, O_BEXT) + ((size_t)u.a * 512 + u.c * 256 + r) * 768 + 256 + u.b * 256 + c;
        st4bf(o, v00); st4bf(o + 128, v01); st4bf(o + (size_t)128 * 768, v10); st4bf(o + (size_t)128 * 768 + 128, v11); } };
struct DRetO { P p; static constexpr int K = 768, lda = 768, ldb = 768;
    HD bool unit(int L, Unit& u) const { int pm, pn; if (!rect_unit(L, 4 * NCQ, 2, pm, pn)) return false;
        u.A = wsb(p, O_AEXT) + (size_t)pm * 256 * 768; u.B = wsb(p, O_BEXT) + ((size_t)pm * 512 + pn * 256) * 768; u.a = pm; u.b = pn; u.c = 0; u.d = 0; return true; }
    HD void emit(const Unit& u, int r, int c, f32x4 v00, f32x4 v01, f32x4 v10, f32x4 v11) const {
        const int h = u.a / NCQ, cidx = u.a % NCQ;
        u16* o = wsb(p, O_OB) + ((size_t)cidx * 256 + r) * 2048 + h * 512 + u.b * 256 + c;
        st4bf(o, v00); st4bf(o + 128, v01); st4bf(o + (size_t)128 * 2048, v10); st4bf(o + (size_t)128 * 2048 + 128, v11); } };
struct DRetWo { P p; int layer, q; static constexpr int K = 2048, lda = 2048, ldb = 2048;
    HD bool unit(int L, Unit& u) const { int pm, pn; if (!rect_unit(L, NCQ, 4, pm, pn)) return false;
        u.A = wsb(p, O_OB) + (size_t)pm * 256 * 2048; u.B = wsb(p, O_RWO) + (size_t)pn * 256 * 2048; u.a = ret_tokrow(q, pm); u.b = pn; u.c = 0; u.d = 0; return true; }
    HD void emit(const Unit& u, int r, int c, f32x4 v00, f32x4 v01, f32x4 v10, f32x4 v11) const {
        const int R = u.a + r, col = u.b * 256 + c;
        resid4(p, layer, 5, 1.0f, R, col, v00); resid4(p, layer, 5, 1.0f, R, col + 128, v01); resid4(p, layer, 5, 1.0f, R + 128, col, v10); resid4(p, layer, 5, 1.0f, R + 128, col + 128, v11); } };

struct DS5L { P p; static constexpr int K = 512, lda = 768, ldb = 512;
    HD bool unit(int L, Unit& u) const { int pm, pn; if (!rect_unit(L, NROW5P / 256, 64, pm, pn)) return false;
        u.A = wsb(p, O_UEXT) + ((size_t)pn * NROW5P + pm * 256) * 768; u.B = wsb(p, O_FEXT) + (size_t)pn * 256 * 512; u.a = pm; u.b = pn; u.c = 0; u.d = 0; return true; }
    HD void emit(const Unit& u, int r, int c, f32x4 v00, f32x4 v01, f32x4 v10, f32x4 v11) const {
        u16* o = wsb(p, O_UEXT) + ((size_t)u.b * NROW5P + u.a * 256 + r) * 768 + 512 + c;
        st4bf(o, v00); st4bf(o + 128, v01); st4bf(o + (size_t)128 * 768, v10); st4bf(o + (size_t)128 * 768 + 128, v11); } };
struct DS5Y { P p; static constexpr int K = 768, lda = 768, ldb = 768;
    HD bool unit(int L, Unit& u) const { int pm, pn; if (!rect_unit(L, NROW5P / 256, 128, pm, pn)) return false;
        const int g = pn >> 1, ch = pn & 1;
        u.A = wsb(p, O_UEXT) + ((size_t)g * NROW5P + pm * 256) * 768; u.B = wsb(p, O_TEXT) + ((size_t)g * 512 + ch * 256) * 768; u.a = pm; u.b = g; u.c = ch; u.d = 0; return true; }
    HD void one(int g, int row, int col, f32x4 v) const {
        int tok; if (row < NB * S5L) tok = (row / S5L) * SEQ + (row % S5L) * 32; else if (row < NROW5) { const int rr = row - NB * S5L; tok = NL + (rr / S5C) * 256 + (rr % S5C) * 32; } else return;
        f32x4 o; for (int jx = 0; jx < 4; ++jx) o[jx] = gelu_f(v[jx]);
        st4bf(wsb(p, O_HN) + (size_t)(tok + (col >> 4)) * 1024 + g * 16 + (col & 15), o); }
    HD void emit(const Unit& u, int r, int c, f32x4 v00, f32x4 v01, f32x4 v10, f32x4 v11) const {
        const int row = u.a * 256 + r, col = u.c * 256 + c;
        one(u.b, row, col, v00); one(u.b, row, col + 128, v01); one(u.b, row + 128, col, v10); one(u.b, row + 128, col + 128, v11); } };
struct DS5Glu { P p; int layer; static constexpr int K = 1024, lda = 1024, ldb = 1024;
    HD bool unit(int L, Unit& u) const { int pm, pn; if (!rect_unit(L, MT / 256, 8, pm, pn)) return false;
        u.A = wsb(p, O_HN) + (size_t)pm * 256 * 1024; u.B = wsb(p, O_GLU) + (size_t)pn * 256 * 1024; u.a = pm; u.b = pn; u.c = 0; u.d = 0; return true; }
    HD void emit(const Unit& u, int r, int c, f32x4 v00, f32x4 v01, f32x4 v10, f32x4 v11) const {
        const int col = u.b * 128 + c; const float* gb = p.in[30]; f32x4 y0, y1;
        for (int jx = 0; jx < 4; ++jx) { const float ba = gb[col + jx], bg = gb[1024 + col + jx];
            y0[jx] = (v00[jx] + ba) * sigm_f(v01[jx] + bg); y1[jx] = (v10[jx] + ba) * sigm_f(v11[jx] + bg); }
        resid4(p, layer, 5, 1.0f, u.a * 256 + r, col, y0); resid4(p, layer, 5, 1.0f, u.a * 256 + r + 128, col, y1); } };

HD void cvt8(const float* src, int N, int srccol, u16* dst, int Kd, int nrow, int k0) {
    f32x4 a, b;
    for (int j = 0; j < 4; ++j) { a[j] = srccol >= 0 ? src[(size_t)(k0 + j) * N + srccol] : 0.f; b[j] = srccol >= 0 ? src[(size_t)(k0 + 4 + j) * N + srccol] : 0.f; }
    st4bf(dst + (size_t)nrow * Kd + k0, a); st4bf(dst + (size_t)nrow * Kd + k0 + 4, b); }
constexpr long CV_FFI = (long)8 * 5632 * 128, CV_FFO = (long)8 * 1024 * 352, CV_MWIN = (long)2 * 768 * 128, CV_MWUQ = (long)2 * 1536 * 48, CV_MWUKV = (long)2 * 2048 * 32,
               CV_MWO = (long)2 * 1024 * 128, CV_RWIN = (long)6144 * 128, CV_RWO = (long)1024 * 256, CV_GLU = (long)2048 * 128;
constexpr long CV_TOTAL = CV_FFI + CV_FFO + CV_MWIN + CV_MWUQ + CV_MWUKV + CV_MWO + CV_RWIN + CV_RWO + CV_GLU;
HD void cvt_item(const P& p, long idx) {
    if (idx < CV_FFI) { const int n = (int)(idx % 5632); const long t = idx / 5632; const int kb = (int)(t % 128), m = (int)(t / 128);
        const int tile = n >> 8, rr = n & 255; const int sc = rr < 128 ? tile * 128 + rr : 2816 + tile * 128 + (rr - 128);
        cvt8(p.in[7] + (size_t)m * 1024 * 5632, 5632, sc, wsb(p, O_FFI + (size_t)m * SZ_FFI1), 1024, n, kb * 8); return; }
    idx -= CV_FFI;
    if (idx < CV_FFO) { const int n = (int)(idx % 1024); const long t = idx / 1024; const int kb = (int)(t % 352), m = (int)(t / 352);
        cvt8(p.in[8] + (size_t)m * 2816 * 1024, 1024, n, wsb(p, O_FFO + (size_t)m * SZ_FFO1), 2816, n, kb * 8); return; }
    idx -= CV_FFO;
    if (idx < CV_MWIN) { const int n = (int)(idx % 768); const long t = idx / 768; const int kb = (int)(t % 128), m = (int)(t / 128);
        cvt8(p.in[9] + (size_t)m * 1024 * 704, 704, n < 704 ? n : -1, wsb(p, O_MWIN + (size_t)m * SZ_MWIN), 1024, n, kb * 8); return; }
    idx -= CV_MWIN;
    if (idx < CV_MWUQ) { const int n = (int)(idx % 1536); const long t = idx / 1536; const int kb = (int)(t % 48), m = (int)(t / 48);
        cvt8(p.in[12] + (size_t)m * 384 * 1536, 1536, n, wsb(p, O_MWUQ + (size_t)m * SZ_MWUQ), 384, n, kb * 8); return; }
    idx -= CV_MWUQ;
    if (idx < CV_MWUKV) { const int n = (int)(idx % 2048); const long t = idx / 2048; const int kb = (int)(t % 32), m = (int)(t / 32);
        const int sc = n < 1024 ? (n >> 7) * 256 + (n & 127) : ((n - 1024) >> 7) * 256 + 128 + (n & 127);
        cvt8(p.in[13] + (size_t)m * 256 * 2048, 2048, sc, wsb(p, O_MWUKV + (size_t)m * SZ_MWUKV), 256, n, kb * 8); return; }
    idx -= CV_MWUKV;
    if (idx < CV_MWO) { const int n = (int)(idx % 1024); const long t = idx / 1024; const int kb = (int)(t % 128), m = (int)(t / 128);
        cvt8(p.in[16] + (size_t)m * 1024 * 1024, 1024, n, wsb(p, O_MWO + (size_t)m * SZ_MWO), 1024, n, kb * 8); return; }
    idx -= CV_MWO;
    if (idx < CV_RWIN) { const int n = (int)(idx % 6144), kb = (int)(idx / 6144); cvt8(p.in[17], 6144, n, wsb(p, O_RWIN), 1024, n, kb * 8); return; }
    idx -= CV_RWIN;
    if (idx < CV_RWO) { const int n = (int)(idx % 1024), kb = (int)(idx / 1024); cvt8(p.in[20], 1024, n, wsb(p, O_RWO), 2048, n, kb * 8); return; }
    idx -= CV_RWO;
    { const int n = (int)(idx % 2048), kb = (int)(idx / 2048); const int tile = n >> 8, rr = n & 255; const int sc = rr < 128 ? tile * 128 + rr : 1024 + tile * 128 + (rr - 128);
      cvt8(p.in[29], 2048, sc, wsb(p, O_GLU), 1024, n, kb * 8); }
}
HD void mod_item(const P& p, int idx) {
    const int layer = idx / 9216, col = idx % 9216; const float* w = p.in[4] + (size_t)layer * 1024 * 9216 + col; float acc[NMR];
    for (int b = 0; b < NMR; ++b) acc[b] = 0.f;
    for (int k = 0; k < 1024; ++k) { const float wv = w[(size_t)k * 9216];
#pragma unroll
        for (int b = 0; b < NMR; ++b) { const float cv = b < NB ? p.in[1][b * 1024 + k] : p.in[3][k]; acc[b] += silu_f(cv) * wv; } }
    const float bias = p.in[5][layer * 9216 + col];
#pragma unroll
    for (int b = 0; b < NMR; ++b) ((float*)(p.ws + O_MOD))[(size_t)(layer * NMR + b) * 9216 + col] = acc[b] + bias; }
HD void copy_item(const P& p, long idx) {
    const long nl4 = (long)NL * 256;
    if (idx < nl4) ((f32x4*)p.out)[idx] = ((const f32x4*)p.in[0])[idx]; else ((f32x4*)(p.ws + O_G))[idx - nl4] = ((const f32x4*)p.in[2])[idx - nl4]; }
HD void norm_item(const P& p, int layer, int k, int r, int s5) {
    const float* x = hrow(p, r); float ss = 0.f;
    for (int d = 0; d < 1024; d += 4) { const f32x4 v = *(const f32x4*)(x + d); ss += v[0] * v[0] + v[1] * v[1] + v[2] * v[2] + v[3] * v[3]; }
    const float rinv = rsq_f(ss * (1.0f / 1024.0f) + EPS);
    const float* g = p.in[6] + (size_t)(layer * 3 + k) * 1024; const float* sh = modp(p, layer, r, 3 * k); const float* sc = modp(p, layer, r, 3 * k + 1);
    int row5 = 0, i5 = 0;
    if (s5) { if (r < NL) { const int b = r / SEQ, t = r % SEQ; row5 = b * S5L + t / 32; i5 = t % 32; } else { const int rr = r - NL; const int b = rr / 256, l = rr % 256; row5 = NB * S5L + b * S5C + l / 32; i5 = l % 32; } }
    for (int d = 0; d < 1024; d += 4) { const f32x4 v = *(const f32x4*)(x + d); f32x4 o;
        for (int j = 0; j < 4; ++j) o[j] = v[j] * rinv * g[d + j] * (1.0f + sc[d + j]) + sh[d + j];
        if (!s5) st4bf(wsb(p, O_HN) + (size_t)r * 1024 + d, o);
        else st4bf(wsb(p, O_UEXT) + ((size_t)(d >> 4) * NROW5P + row5) * 768 + i5 * 16 + (d & 15), o); } }
HD void axial_rot64(float* v, int t) {
    const int prow = t / 64, pcol = t % 64;
    for (int f = 0; f < 16; ++f) { const float fq = ropef(f, 16);
        { float cs, sn; sincos_t((float)prow * fq, sn, cs); const float x1 = v[f], x2 = v[16 + f]; v[f] = x1 * cs - x2 * sn; v[16 + f] = x2 * cs + x1 * sn; }
        { float cs, sn; sincos_t((float)pcol * fq, sn, cs); const float x1 = v[32 + f], x2 = v[48 + f]; v[32 + f] = x1 * cs - x2 * sn; v[48 + f] = x2 * cs + x1 * sn; } } }
HD void mla_row_item(const P& p, int j, int r) {
    const float* x = (const float*)(p.ws + O_CALL) + (size_t)r * 768; float ss = 0.f;
    for (int d = 0; d < 384; ++d) ss += x[d] * x[d];
    float rinv = rsq_f(ss * (1.0f / 384.0f) + EPS); const float* qn = p.in[10] + j * 384;
    for (int d = 0; d < 384; d += 4) { f32x4 o; for (int jx = 0; jx < 4; ++jx) o[jx] = x[d + jx] * rinv * qn[d + jx]; st4bf(wsb(p, O_CQN) + (size_t)r * 384 + d, o); }
    ss = 0.f; for (int d = 0; d < 256; ++d) ss += x[384 + d] * x[384 + d];
    rinv = rsq_f(ss * (1.0f / 256.0f) + EPS); const float* kvn = p.in[11] + j * 256;
    for (int d = 0; d < 256; d += 4) { f32x4 o; for (int jx = 0; jx < 4; ++jx) o[jx] = x[384 + d + jx] * rinv * kvn[d + jx]; st4bf(wsb(p, O_CKVN) + (size_t)r * 256 + d, o); }
    ss = 0.f; for (int d = 0; d < 64; ++d) ss += x[640 + d] * x[640 + d];
    rinv = rsq_f(ss * (1.0f / 64.0f) + EPS); const float* kg = p.in[15] + j * 192 + 128;
#ifdef HOST_EMU
    float kr[64];
    for (int d = 0; d < 64; ++d) kr[d] = x[640 + d] * rinv * kg[d];
    if (r < NL) axial_rot64(kr, r % SEQ);
    for (int h = 0; h < 8; ++h) for (int d = 0; d < 64; ++d) wsb(p, O_KF)[(size_t)r * 1536 + h * 192 + 128 + d] = f2bf(kr[d]);
#else
    const int t = r % SEQ, prow = t / 64, pcol = t % 64;
    for (int f = 0; f < 16; ++f) { const float fq = ropef(f, 16);
#pragma unroll
        for (int part = 0; part < 2; ++part) { float cs = 1.f, sn = 0.f; if (r < NL) sincos_t((float)(part ? pcol : prow) * fq, sn, cs);
            const int d1 = part * 32 + f, d2 = d1 + 16; const float x1 = x[640 + d1] * rinv * kg[d1], x2 = x[640 + d2] * rinv * kg[d2];
            const u16 o1 = f2bf(x1 * cs - x2 * sn), o2 = f2bf(x2 * cs + x1 * sn);
            for (int h = 0; h < 8; ++h) { wsb(p, O_KF)[(size_t)r * 1536 + h * 192 + 128 + d1] = o1; wsb(p, O_KF)[(size_t)r * 1536 + h * 192 + 128 + d2] = o2; } } }
#endif
}
HD void mla_head_item(const P& p, int j, int idx) {
    const int r = idx >> 3, h = idx & 7;
    u16* q = wsb(p, O_CALL) + (size_t)r * 1536 + h * 192; const float* qg = p.in[14] + j * 192; float ss = 0.f;
    for (int d = 0; d < 128; ++d) { const float v = bf2f(q[d]); ss += v * v; }
    float rinv = rsq_f(ss * (1.0f / 128.0f) + EPS);
    for (int d = 0; d < 128; ++d) q[d] = f2bf(bf2f(q[d]) * rinv * qg[d]);
    ss = 0.f; for (int d = 0; d < 64; ++d) { const float v = bf2f(q[128 + d]); ss += v * v; }
    rinv = rsq_f(ss * (1.0f / 64.0f) + EPS);
    { const int t = r % SEQ, prow = t / 64, pcol = t % 64;
      for (int f = 0; f < 16; ++f) { const float fq = ropef(f, 16);
#pragma unroll
        for (int part = 0; part < 2; ++part) { float cs = 1.f, sn = 0.f; if (r < NL) sincos_t((float)(part ? pcol : prow) * fq, sn, cs);
            const int d1 = 128 + part * 32 + f, d2 = d1 + 16; const float x1 = bf2f(q[d1]) * rinv * qg[d1], x2 = bf2f(q[d2]) * rinv * qg[d2];
            q[d1] = f2bf(x1 * cs - x2 * sn); q[d2] = f2bf(x2 * cs + x1 * sn); } } }
    u16* k = wsb(p, O_KF) + (size_t)r * 1536 + h * 192; const float* kg = p.in[15] + j * 192;
    ss = 0.f; for (int d = 0; d < 128; ++d) { const float v = bf2f(k[d]); ss += v * v; }
    rinv = rsq_f(ss * (1.0f / 128.0f) + EPS);
    for (int d = 0; d < 128; ++d) k[d] = f2bf(bf2f(k[d]) * rinv * kg[d]);
}
HD void ret_prefix_item(const P& p, int idx) {
    const int d4 = idx & 63, e = (idx >> 6) & 511, bq = (idx >> 15) % RGB, h = (idx >> 15) / RGB;
    const float gf = expf(256.f * ret_logg(p, 0, h)), gb = expf(256.f * ret_logg(p, 1, h));
    f32x4 cf = {0.f, 0.f, 0.f, 0.f}, cb = {0.f, 0.f, 0.f, 0.f};
    for (int n = 0; n < NCH; ++n) { u16* s = wsb(p, O_BEXT) + (((size_t)h * NCQ + bq * NCH + n) * 512 + e) * 768 + 256 + d4 * 4;
        f32x4 t; for (int j = 0; j < 4; ++j) t[j] = bf2f(s[j]);
        st4bf(s, cf); cf = cf * gf + t; }
    for (int s_ = 0; s_ < NCH; ++s_) { const int n = s_ == 0 ? 0 : NCH - s_; u16* s = wsb(p, O_BEXT) + (((size_t)h * NCQ + bq * NCH + n) * 512 + e) * 768 + 512 + d4 * 4;
        f32x4 t; for (int j = 0; j < 4; ++j) t[j] = bf2f(s[j]);
        st4bf(s, cb); cb = cb * gb + t; } }
HD void ret_norm_item(const P& p, int idx) {
    const int lr = idx >> 2, h = idx & 3; u16* o = wsb(p, O_OB) + (size_t)lr * 2048 + h * 512; const u16* g = wsb(p, O_GATE) + (size_t)lr * 2048 + h * 512; const float* gg = p.in[19] + h * 512;
    float s = 0.f; for (int e = 0; e < 512; ++e) s += bf2f(o[e]);
    const float mu = s * (1.0f / 512.0f); float q = 0.f; for (int e = 0; e < 512; ++e) { const float d = bf2f(o[e]) - mu; q += d * d; }
    const float rstd = rsq_f(q * (1.0f / 512.0f) + EPS);
    for (int e = 0; e < 512; ++e) o[e] = f2bf((bf2f(o[e]) - mu) * rstd * gg[e] * silu_f(bf2f(g[e]))); }
struct Cx { float re, im; };
HD Cx cmul(Cx a, Cx b) { Cx r; r.re = a.re * b.re - a.im * b.im; r.im = a.re * b.im + a.im * b.re; return r; }
HD Cx s5_alog(const P& p, int dir, int g, int pp) { const float dt = expf(p.in[23][dir * 64 + g]); Cx r; r.re = p.in[21][(dir * 64 + g) * 64 + pp] * dt; r.im = p.in[22][(dir * 64 + g) * 64 + pp] * dt; return r; }
HD Cx cpowa(Cx al, float n) { const float m = expf(al.re * n); float sn, cs; sincos_t(al.im * n * 0.15915494309189535f, sn, cs); Cx r; r.re = m * cs; r.im = m * sn; return r; }
HD Cx s5_coef(const P& p, int dir, int g, int pp) {
    const Cx al = s5_alog(p, dir, g, pp); Cx a = cpowa(al, 1.f); a.re -= 1.f; const float lr = p.in[21][(dir * 64 + g) * 64 + pp], li = p.in[22][(dir * 64 + g) * 64 + pp], den = 1.0f / (lr * lr + li * li);
    Cx r; r.re = (a.re * lr + a.im * li) * den; r.im = (a.im * lr - a.re * li) * den; return r; }
HD Cx s5_bbar(const P& p, int dir, int g, int pp, int m) { Cx b; const size_t o = (((size_t)dir * 64 + g) * 64 + pp) * 16 + m; b.re = p.in[24][o]; b.im = p.in[25][o]; return cmul(s5_coef(p, dir, g, pp), b); }
HD Cx s5_c(const P& p, int dir, int g, int m, int pp) { Cx c; const size_t o = (((size_t)dir * 64 + g) * 16 + m) * 64 + pp; c.re = p.in[26][o]; c.im = p.in[27][o]; return c; }
HD void s5_ktab_item(const P& p, int idx) {
    const int m2 = idx & 15, m = (idx >> 4) & 15, tau = (idx >> 8) & 31, dir = (idx >> 13) & 1, g = idx >> 14; float acc = 0.f;
    for (int pp = 0; pp < 64; ++pp) { const Cx w = cmul(cmul(s5_c(p, dir, g, m, pp), cpowa(s5_alog(p, dir, g, pp), (float)tau)), s5_bbar(p, dir, g, pp, m2)); acc += w.re; }
    ((float*)(p.ws + O_KTAB))[idx] = acc; }
HD void s5_text_item(const P& p, long idx) {
    const int col = (int)(idx % 768); const long t = idx / 768; const int row = (int)(t % 512), g = (int)(t / 512), i = row >> 4, m = row & 15; float v;
    const float* kt = (const float*)(p.ws + O_KTAB);
    if (col < 512) { const int jj = col >> 4, m2 = col & 15; v = 0.f;
        if (jj <= i) v += kt[((((size_t)g * 2 + 0) * 32 + (i - jj)) * 16 + m) * 16 + m2];
        if (jj >= i) v += kt[((((size_t)g * 2 + 1) * 32 + (jj - i)) * 16 + m) * 16 + m2];
        if (jj == i && m == m2) v += p.in[28][g * 16 + m]; }
    else { const int dir = col >= 640, pp = ((col - 512) & 127) >> 1, part = col & 1;
        const Cx w = cmul(s5_c(p, dir, g, m, pp), cpowa(s5_alog(p, dir, g, pp), dir ? (float)(32 - i) : (float)(i + 1))); v = part ? -w.im : w.re; }
    wsb(p, O_TEXT)[idx] = f2bf(v); }
HD void s5_fext_item(const P& p, int idx) {
    const int col = idx & 511, row = (idx >> 9) & 255, g = idx >> 17, jj = col >> 4, m2 = col & 15, dir = row >> 7, pp = (row & 127) >> 1, part = row & 1;
    const Cx w = cmul(cpowa(s5_alog(p, dir, g, pp), dir ? (float)jj : (float)(31 - jj)), s5_bbar(p, dir, g, pp, m2));
    wsb(p, O_FEXT)[idx] = f2bf(part ? w.im : w.re); }
HD int s5_row(int b, int s) { return s < S5C ? NB * S5L + b * S5C + s : b * S5L + (s - S5C); }
HD void s5_prefix_item(const P& p, int idx) {
    const int pp = idx & 63, b = (idx >> 6) % NB, g = (idx >> 6) / NB;
    const Cx af = cpowa(s5_alog(p, 0, g, pp), 32.f), ab = cpowa(s5_alog(p, 1, g, pp), 32.f);
    u16* base = wsb(p, O_UEXT) + (size_t)g * NROW5P * 768; Cx c; c.re = 0.f; c.im = 0.f;
    for (int s = 0; s < S5C + S5L; ++s) { u16* q = base + (size_t)s5_row(b, s) * 768 + 512 + 2 * pp; Cx t; t.re = bf2f(q[0]); t.im = bf2f(q[1]);
        q[0] = f2bf(c.re); q[1] = f2bf(c.im); c = cmul(af, c); c.re += t.re; c.im += t.im; }
    c.re = 0.f; c.im = 0.f;
    for (int s_ = 0; s_ < S5C + S5L; ++s_) { const int s = s_ < S5C ? S5C - 1 - s_ : S5C + S5L - 1 - (s_ - S5C); u16* q = base + (size_t)s5_row(b, s) * 768 + 640 + 2 * pp; Cx t; t.re = bf2f(q[0]); t.im = bf2f(q[1]);
        q[0] = f2bf(c.re); q[1] = f2bf(c.im); c = cmul(ab, c); c.re += t.re; c.im += t.im; } }

struct AttItem { const u16* q; const u16* k0; const u16* k1; const u16* v0; const u16* v1; u16* o; int n0, ntot; };
HD void att_item(const P& p, int it, AttItem& a) {
    const u16* Q = wsb(p, O_CALL); const u16* KF = wsb(p, O_KF); const u16* VB = wsb(p, O_VB); u16* O = wsb(p, O_HN);
    const int nlat = NB * 8 * (SEQ / 256);
    if (it < nlat) { const int qb = it % (SEQ / 256), h = (it / (SEQ / 256)) & 7, b = it / (SEQ / 256) / 8; const size_t r0 = (size_t)b * SEQ + qb * 256, c0 = (size_t)NL + b * 256, l0 = (size_t)b * SEQ;
        a.q = Q + r0 * 1536 + h * 192; a.o = O + r0 * 1024 + h * 128; a.k0 = KF + c0 * 1536 + h * 192; a.v0 = VB + c0 * 1024 + h * 128; a.k1 = KF + l0 * 1536 + h * 192; a.v1 = VB + l0 * 1024 + h * 128; a.n0 = 256; a.ntot = 256 + SEQ; }
    else { const int x = it - nlat, h = x & 7, b = x >> 3; const size_t c0 = (size_t)NL + b * 256;
        a.q = Q + c0 * 1536 + h * 192; a.o = O + c0 * 1024 + h * 128; a.k0 = KF + c0 * 1536 + h * 192; a.v0 = VB + c0 * 1024 + h * 128; a.k1 = a.k0; a.v1 = a.v0; a.n0 = 256; a.ntot = 256; } }
constexpr float ATT_SCALE = 0.07216878364870322f;

#ifndef HOST_EMU
#define LAS __attribute__((address_space(3)))
typedef short bf16x8 __attribute__((ext_vector_type(8)));
typedef short s16x4 __attribute__((ext_vector_type(4)));
typedef float f32x16 __attribute__((ext_vector_type(16)));
typedef unsigned u32x4 __attribute__((ext_vector_type(4)));
constexpr int HTB = 128 * 64 * 2, STAGE_BYTES = 8 * HTB;
__device__ __forceinline__ int lds_byte(int r, int c) { const int st = (r >> 4) * 2 + (c >> 5), rr = r & 15, cc = c & 31, ob = rr * 64 + cc * 2; return st * 1024 + (ob ^ (((ob >> 9) & 1) << 5)); }
__device__ __forceinline__ void stage_rc(int b, int& R, int& C) { const int st = b / 1024, sb = b % 1024, swz = sb ^ (((sb >> 9) & 1) << 5); R = (st >> 1) * 16 + swz / 64; C = (st & 1) * 32 + (swz % 64) / 2; }

template <class Dsc>
__device__ __forceinline__ void gemm_run(LAS unsigned char* lds, const Dsc& D) {
    int tid_ = threadIdx.x; asm volatile("" : "+v"(tid_));
    const int tid = tid_, wid = __builtin_amdgcn_readfirstlane(tid >> 6), lane = tid & 63, wr = wid >> 2, wc = wid & 3, fr = lane & 15, fq = lane >> 4;
    constexpr int K = Dsc::K, nt = K / 64, lda = Dsc::lda, ldb = Dsc::ldb;
    static_assert(K % 128 == 0 && K >= 256, "K");
    unsigned voffA[2], voffB[2];
#pragma unroll
    for (int i = 0; i < 2; ++i) { int R, C; stage_rc(tid * 16 + i * 8192, R, C); voffA[i] = (unsigned)(R * lda + C) * 2u; voffB[i] = (unsigned)(R * ldb + C) * 2u; }
    constexpr size_t kstep = 128, hstepA = (size_t)128 * lda * 2, hstepB = (size_t)128 * ldb * 2;
    const unsigned ldsw = (unsigned)wid * 1024u;
    const int aoff = lds_byte(wr * 64 + fr, fq * 8), boff = lds_byte(wc * 32 + fr, fq * 8);
#define G_SA(b, h) (((b) * 2 + (h)) * HTB)
#define G_SB(b, h) ((4 + (b) * 2 + (h)) * HTB)
#define G_STAGE(bufoff, gbase, voff) do { _Pragma("unroll") for (int _i = 0; _i < 2; ++_i) \
        __builtin_amdgcn_global_load_lds((const unsigned*)((const char*)(gbase) + (voff)[_i]), (LAS unsigned*)(lds + (bufoff) + ldsw + _i * 8192), 16, 0, 0); } while (0)
#define G_LDA(dst, b, h) do { _Pragma("unroll") for (int m = 0; m < 4; ++m) _Pragma("unroll") for (int k = 0; k < 2; ++k) dst[m][k] = *(const LAS bf16x8*)(lds + G_SA(b, h) + aoff + m * 2048 + k * 1024); } while (0)
#define G_LDB(dst, b, h) do { _Pragma("unroll") for (int n = 0; n < 2; ++n) _Pragma("unroll") for (int k = 0; k < 2; ++k) dst[n][k] = *(const LAS bf16x8*)(lds + G_SB(b, h) + boff + n * 2048 + k * 1024); } while (0)
#define G_MMA(ai, bj, At, Bt) do { __builtin_amdgcn_s_setprio(1); _Pragma("unroll") for (int m = 0; m < 4; ++m) _Pragma("unroll") for (int n = 0; n < 2; ++n) _Pragma("unroll") for (int k = 0; k < 2; ++k) \
        acc[ai][bj][m][n] = __builtin_amdgcn_mfma_f32_16x16x32_bf16(Bt[n][k], At[m][k], acc[ai][bj][m][n], 0, 0, 0); __builtin_amdgcn_s_setprio(0); } while (0)
#define G_WAIT_V(n) asm volatile("s_waitcnt vmcnt(" #n ")" ::: "memory")
#define G_WAIT_L(n) asm volatile("s_waitcnt lgkmcnt(" #n ")" ::: "memory")
#define G_BAR __builtin_amdgcn_s_barrier()
#define G_SCHED __builtin_amdgcn_sched_barrier(0)
    Unit cur{}, nxt{}; int ui = 0; const int G = gridDim.x, cb = blockIdx.x;
    if (!D.unit(cb, cur)) return;
    f32x4 acc[2][2][4][2];
#pragma unroll
    for (int a = 0; a < 2; ++a)
#pragma unroll
        for (int b = 0; b < 2; ++b)
#pragma unroll
            for (int m = 0; m < 4; ++m)
#pragma unroll
                for (int n = 0; n < 2; ++n) acc[a][b][m][n] = (f32x4){0.f, 0.f, 0.f, 0.f};
    bf16x8 At[4][2], B0[2][2], B1[2][2];
    const char* cA = (const char*)cur.A; const char* cB = (const char*)cur.B;
    G_STAGE(G_SB(0, 0), cB, voffB); G_STAGE(G_SA(0, 0), cA, voffA); G_STAGE(G_SB(0, 1), cB + hstepB, voffB); G_STAGE(G_SA(0, 1), cA + hstepA, voffA);
    if (wr == 1) G_BAR;
    G_WAIT_V(4); G_BAR;
    G_STAGE(G_SB(1, 0), cB + kstep, voffB); G_STAGE(G_SA(1, 0), cA + kstep, voffA); G_STAGE(G_SB(1, 1), cB + hstepB + kstep, voffB);
    G_WAIT_V(6); G_BAR;
    for (;;) {
        const bool has_next = D.unit((ui + 1) * G + cb, nxt);
        const char* nA = has_next ? (const char*)nxt.A : cA; const char* nB = has_next ? (const char*)nxt.B : cB;
        _Pragma("nounroll") for (int t = 0; t < nt; t += 2) {
            const bool last = (t == nt - 2);
            const char* a1 = cA + (size_t)(t + 1) * kstep;
            const char* a2 = last ? nA : cA + (size_t)(t + 2) * kstep; const char* b2 = last ? nB : cB + (size_t)(t + 2) * kstep;
            const char* a3 = a2 + kstep; const char* b3 = b2 + kstep;
            G_LDB(B0, 0, 0); G_SCHED; G_LDA(At, 0, 0); G_STAGE(G_SA(1, 1), a1 + hstepA, voffA);
            G_WAIT_L(8); G_BAR; G_WAIT_L(0); G_MMA(0, 0, At, B0); G_BAR; G_SCHED;
            G_LDB(B1, 0, 1); G_STAGE(G_SB(0, 0), b2, voffB);
            G_BAR; G_WAIT_L(0); G_MMA(0, 1, At, B1); G_BAR;
            G_LDA(At, 0, 1); G_STAGE(G_SA(0, 0), a2, voffA);
            G_BAR; G_WAIT_L(0); G_MMA(1, 0, At, B0); G_BAR; G_SCHED;
            G_STAGE(G_SB(0, 1), b2 + hstepB, voffB);
            G_WAIT_V(6); G_BAR; G_MMA(1, 1, At, B1); G_BAR;
            G_LDB(B0, 1, 0); G_SCHED; G_LDA(At, 1, 0); G_STAGE(G_SA(0, 1), a2 + hstepA, voffA);
            G_WAIT_L(8); G_BAR; G_WAIT_L(0); G_MMA(0, 0, At, B0); G_BAR; G_SCHED;
            G_LDB(B1, 1, 1); G_STAGE(G_SB(1, 0), b3, voffB);
            G_BAR; G_WAIT_L(0); G_MMA(0, 1, At, B1); G_BAR;
            G_LDA(At, 1, 1); G_STAGE(G_SA(1, 0), a3, voffA);
            G_BAR; G_WAIT_L(0); G_MMA(1, 0, At, B0); G_BAR; G_SCHED;
            G_STAGE(G_SB(1, 1), b3 + hstepB, voffB);
            G_WAIT_V(6); G_BAR; G_MMA(1, 1, At, B1); G_BAR;
        }
        int er_ = wr * 64 + fr, ec_ = wc * 32 + fq * 4; asm volatile("" : "+v"(er_), "+v"(ec_));
#pragma unroll
        for (int m = 0; m < 4; ++m)
#pragma unroll
            for (int n = 0; n < 2; ++n) { D.emit(cur, er_ + m * 16, ec_ + n * 16, acc[0][0][m][n], acc[0][1][m][n], acc[1][0][m][n], acc[1][1][m][n]); asm volatile("" ::: "memory"); }
        if (!has_next) break;
#pragma unroll
        for (int a = 0; a < 2; ++a)
#pragma unroll
            for (int b = 0; b < 2; ++b)
#pragma unroll
                for (int m = 0; m < 4; ++m)
#pragma unroll
                    for (int n = 0; n < 2; ++n) acc[a][b][m][n] = (f32x4){0.f, 0.f, 0.f, 0.f};
        cur = nxt; cA = nA; cB = nB; ++ui;
    }
    G_WAIT_V(0);
    if (wr == 0) G_BAR;
    G_BAR;
#undef G_SA
#undef G_SB
#undef G_STAGE
#undef G_LDA
#undef G_LDB
#undef G_MMA
#undef G_WAIT_V
#undef G_WAIT_L
#undef G_BAR
#undef G_SCHED
}

constexpr int A_SHM_V = 64 * 128 * 2, A_SHM_K = 64 * 192 * 2;
#define KSWZ(row, colB) ((row) * 384 + ((colB) ^ (((row) & 7) << 4)))
__device__ __forceinline__ int crow(int r, int hi) { return (r & 3) + 8 * (r >> 2) + 4 * hi; }
__device__ __forceinline__ unsigned cvtpk(float lo, float hi) { unsigned r; asm volatile("v_cvt_pk_bf16_f32 %0, %1, %2" : "=v"(r) : "v"(lo), "v"(hi)); return r; }
__device__ __forceinline__ int v_st(int k, int c) { const int kk = (k & ~0xC) | ((k & 4) << 1) | ((k & 8) >> 1); return ((kk >> 3) * 4 + (c >> 5)) * 512 + ((kk & 7) * 32 + (c & 31)) * 2; }
__device__ __forceinline__ int v_rd_base(int lane) { return ((lane & 3) << 3) | (((lane >> 2) & 3) << 6) | (((lane >> 4) & 1) << 5) | (((lane >> 5) & 1) << 8); }
constexpr int v_rd_off(int d0, int ks, int half) { return d0 * 512 + ks * 4096 + half * 2048; }
template <int OFF> __device__ __forceinline__ s16x4 tr_read(int vb) { s16x4 r; asm volatile("ds_read_b64_tr_b16 %0, %1 offset:%2" : "=&v"(r) : "v"(vb), "i"(OFF) : "memory"); return r; }
template <int D0> __device__ __forceinline__ void pv_one(f32x16& od, int vb, bf16x8 pa0, bf16x8 pa1, bf16x8 pa2, bf16x8 pa3) {
    const s16x4 l0 = tr_read<v_rd_off(D0, 0, 0)>(vb), h0 = tr_read<v_rd_off(D0, 0, 1)>(vb), l1 = tr_read<v_rd_off(D0, 1, 0)>(vb), h1 = tr_read<v_rd_off(D0, 1, 1)>(vb);
    const s16x4 l2 = tr_read<v_rd_off(D0, 2, 0)>(vb), h2 = tr_read<v_rd_off(D0, 2, 1)>(vb), l3 = tr_read<v_rd_off(D0, 3, 0)>(vb), h3 = tr_read<v_rd_off(D0, 3, 1)>(vb);
    asm volatile("s_waitcnt lgkmcnt(0)" ::: "memory"); __builtin_amdgcn_sched_barrier(0);
#define PK(L, H) (bf16x8){L[0], L[1], L[2], L[3], H[0], H[1], H[2], H[3]}
    od = __builtin_amdgcn_mfma_f32_32x32x16_bf16(pa0, PK(l0, h0), od, 0, 0, 0);
    od = __builtin_amdgcn_mfma_f32_32x32x16_bf16(pa1, PK(l1, h1), od, 0, 0, 0);
    od = __builtin_amdgcn_mfma_f32_32x32x16_bf16(pa2, PK(l2, h2), od, 0, 0, 0);
    od = __builtin_amdgcn_mfma_f32_32x32x16_bf16(pa3, PK(l3, h3), od, 0, 0, 0);
#undef PK
}
__device__ __forceinline__ void att_body(const AttItem& a, char* lds) {
    int tid_ = threadIdx.x; asm volatile("" : "+v"(tid_));
    const int tid = tid_, wid = tid >> 6, lane = tid & 63, r32 = lane & 31, hi = lane >> 5;
    char* V_lds = lds; char* K_lds = lds + 2 * A_SHM_V; float* li_l = (float*)(lds + 2 * A_SHM_V + 2 * A_SHM_K) + wid * 64;
    float l_reg = 0.f; f32x16 o[4] = {}; bf16x8 qr[12];
    const u16* Qw = a.q + (size_t)(wid * 32 + r32) * 1536 + hi * 8;
#pragma unroll
    for (int d0 = 0; d0 < 12; ++d0) qr[d0] = *(const bf16x8*)(Qw + d0 * 16);
    const int sr = tid >> 4, sc = (tid & 15) * 8, vst0 = v_st(sr, sc), vst1 = v_st(32 + sr, sc);
    const int voff0 = sr * 1024 + sc, voff1 = (32 + sr) * 1024 + sc;
    int koff[3], kwr[3];
#pragma unroll
    for (int i = 0; i < 3; ++i) { const int id = tid + i * 512, kr_ = id / 24, kc_ = (id % 24) * 8; koff[i] = kr_ * 1536 + kc_; kwr[i] = KSWZ(kr_, kc_ * 2); }
    const int vb0 = (int)(uintptr_t)V_lds + v_rd_base(lane);
    bf16x8 vs0, vs1, ks[3];
    const int NT = a.ntot / 64;
#define A_SLOAD(k0_) do { const int key0_ = (k0_); const u16* kb_ = key0_ < a.n0 ? a.k0 + (size_t)key0_ * 1536 : a.k1 + (size_t)(key0_ - a.n0) * 1536; \
        const u16* vbp_ = key0_ < a.n0 ? a.v0 + (size_t)key0_ * 1024 : a.v1 + (size_t)(key0_ - a.n0) * 1024; \
        vs0 = *(const bf16x8*)(vbp_ + voff0); vs1 = *(const bf16x8*)(vbp_ + voff1); \
        _Pragma("unroll") for (int i = 0; i < 3; ++i) ks[i] = *(const bf16x8*)(kb_ + koff[i]); } while (0)
#define A_SWRITE(b) do { *(bf16x8*)(V_lds + (b) * A_SHM_V + vst0) = vs0; *(bf16x8*)(V_lds + (b) * A_SHM_V + vst1) = vs1; \
        _Pragma("unroll") for (int i = 0; i < 3; ++i) *(bf16x8*)(K_lds + (b) * A_SHM_K + kwr[i]) = ks[i]; } while (0)
    A_SLOAD(0); A_SWRITE(0); __syncthreads();
    constexpr float C = ATT_SCALE * 1.4426950408889634f;
    _Pragma("nounroll") for (int j = 0; j < NT; ++j) {
        const int buf = j & 1;
        if (j + 1 < NT) A_SLOAD((j + 1) * 64);
        f32x16 p0 = {}, p1 = {};
        const char* Ks = K_lds + buf * A_SHM_K;
#pragma unroll
        for (int d0 = 0; d0 < 12; ++d0) { const int cbb = (d0 * 16 + hi * 8) * 2;
            const bf16x8 b0 = *(const bf16x8*)(Ks + KSWZ(r32, cbb)); const bf16x8 b1 = *(const bf16x8*)(Ks + KSWZ(32 + r32, cbb));
            p0 = __builtin_amdgcn_mfma_f32_32x32x16_bf16(b0, qr[d0], p0, 0, 0, 0);
            p1 = __builtin_amdgcn_mfma_f32_32x32x16_bf16(b1, qr[d0], p1, 0, 0, 0); }
        float ps = 0.f;
#pragma unroll
        for (int r = 0; r < 16; ++r) { p0[r] = __builtin_amdgcn_exp2f(p0[r] * C); p1[r] = __builtin_amdgcn_exp2f(p1[r] * C); ps += p0[r] + p1[r]; }
        { auto rr = __builtin_amdgcn_permlane32_swap(__float_as_uint(ps), __float_as_uint(ps), false, false); ps = __uint_as_float(rr[0]) + __uint_as_float(rr[1]); }
        l_reg += ps;
        bf16x8 pa0, pa1, pa2, pa3;
#define PK4(Pv, BASE, OUT) do { unsigned a0 = cvtpk(Pv[BASE + 0], Pv[BASE + 1]), a1 = cvtpk(Pv[BASE + 2], Pv[BASE + 3]); \
        unsigned b0 = cvtpk(Pv[BASE + 4], Pv[BASE + 5]), b1 = cvtpk(Pv[BASE + 6], Pv[BASE + 7]); \
        auto r0 = __builtin_amdgcn_permlane32_swap(a0, b0, false, false); auto r1 = __builtin_amdgcn_permlane32_swap(a1, b1, false, false); \
        u32x4 w = {r0[0], r1[0], r0[1], r1[1]}; OUT = *reinterpret_cast<bf16x8*>(&w); } while (0)
        PK4(p0, 0, pa0); PK4(p0, 8, pa1); PK4(p1, 0, pa2); PK4(p1, 8, pa3);
#undef PK4
        const int vb = vb0 + buf * A_SHM_V;
        pv_one<0>(o[0], vb, pa0, pa1, pa2, pa3); pv_one<1>(o[1], vb, pa0, pa1, pa2, pa3); pv_one<2>(o[2], vb, pa0, pa1, pa2, pa3); pv_one<3>(o[3], vb, pa0, pa1, pa2, pa3);
        if (j + 1 < NT) A_SWRITE(buf ^ 1);
        __syncthreads();
    }
    if (hi == 0) li_l[r32] = l_reg;
    asm volatile("s_waitcnt lgkmcnt(0)" ::: "memory");
    __builtin_amdgcn_wave_barrier();
    u16* Ow = a.o + (size_t)(wid * 32) * 1024;
#pragma unroll
    for (int r = 0; r < 16; ++r) { const int orow = crow(r, hi); const float rl = 1.0f / li_l[orow];
#pragma unroll
        for (int d0 = 0; d0 < 4; ++d0) Ow[(size_t)orow * 1024 + d0 * 32 + r32] = f2bf(o[d0][r] * rl); }
    __syncthreads();
#undef A_SLOAD
#undef A_SWRITE
}

namespace cg = cooperative_groups;
#define PASS(N, CALL) do { const long _n = (long)(N); int t0_ = threadIdx.x; asm volatile("" : "+v"(t0_)); for (long it = (long)blockIdx.x * 512 + t0_; it < _n; it += (long)gridDim.x * 512) { CALL; } } while (0)
#define GEMM(D) gemm_run(lds, D)
#define SYNC() grid.sync()
#define HOOK(L, S) do { } while (0)
#define ATTN(NITEMS) do { for (int it = blockIdx.x; it < (NITEMS); it += gridDim.x) { AttItem ai_; att_item(p, it, ai_); att_body(ai_, (char*)shm); } } while (0)
#else
template <class Dsc> static void gemm_emu(const Dsc& D) {
    int n = 0; { Unit u; while (D.unit(n, u)) ++n; }
#pragma omp parallel for schedule(dynamic)
    for (int L = 0; L < n; ++L) { Unit u{}; D.unit(L, u); const int K = Dsc::K;
        std::vector<float> A((size_t)256 * K), B((size_t)256 * K), C((size_t)256 * 256);
        for (int r = 0; r < 256; ++r) for (int k = 0; k < K; ++k) { A[(size_t)r * K + k] = bf2f(u.A[(size_t)r * Dsc::lda + k]); B[(size_t)r * K + k] = bf2f(u.B[(size_t)r * Dsc::ldb + k]); }
        for (int r = 0; r < 256; ++r) for (int c = 0; c < 256; ++c) { float s = 0.f; const float* a = &A[(size_t)r * K]; const float* b = &B[(size_t)c * K]; for (int k = 0; k < K; ++k) s += a[k] * b[k]; C[r * 256 + c] = s; }
        for (int r = 0; r < 128; ++r) for (int c = 0; c < 128; c += 4) { f32x4 v[2][2];
            for (int X = 0; X < 2; ++X) for (int Y = 0; Y < 2; ++Y) for (int j = 0; j < 4; ++j) v[X][Y][j] = C[(r + 128 * X) * 256 + c + 128 * Y + j];
            D.emit(u, r, c, v[0][0], v[0][1], v[1][0], v[1][1]); } } }
static void att_emu(const P& p, int nitems) {
#pragma omp parallel for schedule(dynamic)
    for (int it = 0; it < nitems; ++it) { AttItem a; att_item(p, it, a); std::vector<float> s(a.ntot);
        for (int i = 0; i < 256; ++i) { const u16* q = a.q + (size_t)i * 1536; float l = 0.f; float o[128]; for (int e = 0; e < 128; ++e) o[e] = 0.f;
            for (int k = 0; k < a.ntot; ++k) { const u16* kr = k < a.n0 ? a.k0 + (size_t)k * 1536 : a.k1 + (size_t)(k - a.n0) * 1536; float d = 0.f; for (int x = 0; x < 192; ++x) d += bf2f(q[x]) * bf2f(kr[x]);
                const float pv = bf2f(f2bf(expf(d * ATT_SCALE))); l += expf(d * ATT_SCALE); const u16* vr = k < a.n0 ? a.v0 + (size_t)k * 1024 : a.v1 + (size_t)(k - a.n0) * 1024; for (int e = 0; e < 128; ++e) o[e] += pv * bf2f(vr[e]); }
            for (int e = 0; e < 128; ++e) a.o[(size_t)i * 1024 + e] = f2bf(o[e] / l); } } }
#define PASS(N, CALL) do { const long _n = (long)(N); _Pragma("omp parallel for schedule(static)") for (long it = 0; it < _n; ++it) { CALL; } } while (0)
#define GEMM(D) gemm_emu(D)
#define SYNC() do { } while (0)
#define ATTN(NITEMS) att_emu(p, NITEMS)
static void emu_hook(const P& p, int layer, int stage);
#define HOOK(L, S) emu_hook(p, L, S)
#endif

#ifndef HOST_EMU
__global__ void __launch_bounds__(512) fwd_megakernel(P p) {
    extern __shared__ __attribute__((aligned(16))) unsigned char shm[];
    LAS unsigned char* lds = (LAS unsigned char*)shm;
    cg::grid_group grid = cg::this_grid();
#else
static void fwd_emu(P p) {
#endif
    if (PM(0)) { PASS(DEPTH * 9216, mod_item(p, (int)it));
    PASS((long)MT * 256, copy_item(p, it));
    PASS(CV_TOTAL, cvt_item(p, it)); }
    SYNC();
    for (int layer = 0; layer < DEPTH; ++layer) {
        const int kind = layer % 3, j = layer / 3; const bool last = layer == DEPTH - 1;
        if (PM(1)) { PASS(MT, norm_item(p, layer, 0, (int)it, 0)); } SYNC();
        if (PM(2)) { DFfnUp d{p, layer, 0}; GEMM(d); } SYNC();
        if (PM(3)) { DFfnDown d{p, layer, 0, MT / 256}; GEMM(d); } SYNC();
        if (kind == 0) {
            if (PM(1)) { PASS(MT, norm_item(p, layer, 1, (int)it, 0)); } SYNC();
            if (PM(4)) { DMlaIn d{p, j}; GEMM(d); } SYNC();
            if (PM(5)) { PASS(MT, mla_row_item(p, j, (int)it)); } SYNC();
            if (PM(6)) { DMlaUq d{p, j}; GEMM(d); } if (PM(7)) { DMlaUkv d{p, j}; GEMM(d); } SYNC();
            if (PM(8)) { PASS((long)MT * 8, mla_head_item(p, j, (int)it)); } SYNC();
            if (PM(9)) { ATTN(NB * 8 * (SEQ / 256) + (last ? 0 : NB * 8)); } SYNC();
            if (PM(10)) { DMlaO d{p, layer, j, last ? NL / 256 : MT / 256}; GEMM(d); } SYNC();
        } else if (kind == 1) {
            if (PM(1)) { PASS(MT, norm_item(p, layer, 1, (int)it, 0)); } SYNC();
            for (int q = 0; q < NB / RGB; ++q) {
                if (PM(11)) { DRetProj d{p, q}; GEMM(d); } if (PM(12)) { DRetProjT d{p, q}; GEMM(d); } SYNC();
                if (PM(13)) { DRetP d{p}; GEMM(d); } if (PM(14)) { DRetL d{p}; GEMM(d); } SYNC();
                if (PM(15)) { PASS(4 * RGB * 512 * 64, ret_prefix_item(p, (int)it)); } SYNC();
                if (PM(16)) { DRetO d{p}; GEMM(d); } SYNC();
                if (PM(17)) { PASS(NCQ * 256 * 4, ret_norm_item(p, (int)it)); } SYNC();
                if (PM(18)) { DRetWo d{p, layer, q}; GEMM(d); } SYNC();
            }
        } else {
            if (PM(19)) { PASS(MT, norm_item(p, layer, 1, (int)it, 1));
            PASS(64 * 2 * 32 * 256, s5_ktab_item(p, (int)it));
            PASS(64 * 256 * 512, s5_fext_item(p, (int)it)); } SYNC();
            if (PM(19)) { PASS((long)64 * 512 * 768, s5_text_item(p, it)); }
            if (PM(20)) { DS5L d{p}; GEMM(d); } SYNC();
            if (PM(21)) { PASS(64 * NB * 64, s5_prefix_item(p, (int)it)); } SYNC();
            if (PM(22)) { DS5Y d{p}; GEMM(d); } SYNC();
            if (PM(23)) { DS5Glu d{p, layer}; GEMM(d); } SYNC();
        }
        HOOK(layer, 0);
        if (PM(1)) { PASS(last ? NL : MT, norm_item(p, layer, 2, (int)it, 0)); } SYNC();
        if (PM(2)) { DFfnUp d{p, layer, 1}; GEMM(d); } SYNC();
        if (PM(3)) { DFfnDown d{p, layer, 1, last ? NL / 256 : MT / 256}; GEMM(d); } SYNC();
        HOOK(layer, 1);
    }
}

#ifndef HOST_EMU
extern "C" void kernel_launch(void* const* d_in, const int* in_sizes, int n_in, void* d_out, int out_size, void* d_ws, size_t ws_size, hipStream_t stream) {
    constexpr size_t kDynLds = STAGE_BYTES + 4096;
    static int grid_blocks = 0;
    if (!grid_blocks) {
        int dev = 0, cus = 0, per_cu = 0;
        hipGetDevice(&dev);
        hipDeviceGetAttribute(&cus, hipDeviceAttributeMultiprocessorCount, dev);
        hipFuncSetAttribute((const void*)fwd_megakernel, hipFuncAttributeMaxDynamicSharedMemorySize, (int)kDynLds);
        hipOccupancyMaxActiveBlocksPerMultiprocessor(&per_cu, fwd_megakernel, 512, kDynLds);
        if (per_cu < 1) per_cu = 1;
        if (per_cu > 1) per_cu = 1;
        grid_blocks = cus * per_cu;
        if (ws_size < WS_NEED) fprintf(stderr, "workspace too small: %zu < %zu\n", ws_size, (size_t)WS_NEED);
    }
    P p{};
    for (int i = 0; i < 31 && i < n_in; ++i) p.in[i] = (const float*)d_in[i];
    p.out = (float*)d_out; p.ws = (char*)d_ws;
    void* args[] = {&p};
    hipError_t e = hipLaunchCooperativeKernel((void*)fwd_megakernel, dim3(grid_blocks), dim3(512), args, kDynLds, stream);
    if (e != hipSuccess) fprintf(stderr, "cooperative launch failed: %s (grid %d)\n", hipGetErrorString(e), grid_blocks);
}
#endif
```

```cpp
#ifdef HOST_EMU
#include <cmath>
#include <cstdio>
#include <cstdlib>
#include <cstring>
#include <vector>
#define HD inline
#else
#include <hip/hip_runtime.h>
#include <hip/hip_cooperative_groups.h>
#include <cstdio>
#define HD __device__ __forceinline__
#endif

#ifndef CFG_BATCH
#define CFG_BATCH 16
#endif
#ifndef CFG_SEQ
#define CFG_SEQ 4096
#endif

typedef unsigned short u16;
typedef float f32x4 __attribute__((ext_vector_type(4)));
typedef unsigned u32x2 __attribute__((ext_vector_type(2)));

constexpr int DM = 1024, NB = CFG_BATCH, SEQ = CFG_SEQ, CTX = 256, DFF = 2816, DEPTH = 4;
constexpr int NL = NB * SEQ, NC = NB * CTX, MT = NL + NC;
constexpr int NMR = NB + 1;
constexpr int RGB = (NB >= 4) ? 4 : 1;
constexpr int NCH = 1 + SEQ / 256;
constexpr int NCQ = RGB * NCH;
constexpr int S5L = SEQ / 32, S5C = CTX / 32;
constexpr int NROW5 = NB * S5L + NB * S5C;
constexpr int NROW5P = (NROW5 + 255) / 256 * 256;
constexpr float EPS = 1e-6f;

constexpr size_t al(size_t x) { return (x + 255) & ~(size_t)255; }
constexpr size_t O_MOD = 0;
constexpr size_t O_G = O_MOD + al((size_t)DEPTH * NMR * 9216 * 4);
constexpr size_t O_FFI = O_G + al((size_t)NC * 1024 * 4);
constexpr size_t SZ_FFI1 = (size_t)5632 * 1024 * 2, SZ_FFO1 = (size_t)1024 * 2816 * 2;
constexpr size_t O_FFO = O_FFI + 8 * SZ_FFI1;
constexpr size_t O_MWIN = O_FFO + 8 * SZ_FFO1;
constexpr size_t SZ_MWIN = (size_t)768 * 1024 * 2, SZ_MWUQ = (size_t)1536 * 384 * 2, SZ_MWUKV = (size_t)2048 * 256 * 2, SZ_MWO = (size_t)1024 * 1024 * 2;
constexpr size_t O_MWUQ = O_MWIN + 2 * SZ_MWIN;
constexpr size_t O_MWUKV = O_MWUQ + 2 * SZ_MWUQ;
constexpr size_t O_MWO = O_MWUKV + 2 * SZ_MWUKV;
constexpr size_t O_RWIN = O_MWO + 2 * SZ_MWO;
constexpr size_t O_RWO = O_RWIN + (size_t)6144 * 1024 * 2;
constexpr size_t O_GLU = O_RWO + (size_t)1024 * 2048 * 2;
constexpr size_t O_HN = O_GLU + (size_t)2048 * 1024 * 2;
constexpr size_t O_SCR = O_HN + al((size_t)MT * 1024 * 2);
constexpr size_t O_ACT = O_SCR;
constexpr size_t O_CALL = O_SCR;
constexpr size_t O_CQN = O_CALL + al((size_t)MT * 768 * 4);
constexpr size_t O_CKVN = O_CQN + al((size_t)MT * 384 * 2);
constexpr size_t O_KF = O_CKVN + al((size_t)MT * 256 * 2);
constexpr size_t O_VB = O_KF + al((size_t)MT * 1536 * 2);
constexpr size_t END_MLA = O_VB + al((size_t)MT * 1024 * 2);
constexpr size_t O_QN = O_SCR;
constexpr size_t O_KN = O_QN + al((size_t)NCQ * 256 * 1024 * 2);
constexpr size_t O_GATE = O_KN + al((size_t)NCQ * 256 * 1024 * 2);
constexpr size_t O_OB = O_GATE + al((size_t)NCQ * 256 * 2048 * 2);
constexpr size_t O_AEXT = O_OB + al((size_t)NCQ * 256 * 2048 * 2);
constexpr size_t O_KTX = O_AEXT + al((size_t)4 * NCQ * 256 * 768 * 2);
constexpr size_t O_BEXT = O_KTX + al((size_t)4 * NCQ * 2 * 256 * 256 * 2);
constexpr size_t END_RET = O_BEXT + al((size_t)4 * NCQ * 512 * 768 * 2);
constexpr size_t O_UEXT = O_SCR;
constexpr size_t O_KTAB = O_UEXT + al((size_t)64 * NROW5P * 768 * 2);
constexpr size_t O_TEXT = O_KTAB + al((size_t)64 * 2 * 32 * 256 * 4);
constexpr size_t O_FEXT = O_TEXT + al((size_t)64 * 512 * 768 * 2);
constexpr size_t END_S5 = O_FEXT + al((size_t)64 * 256 * 512 * 2);
constexpr size_t END_FFN = O_ACT + al((size_t)MT * 2816 * 2);
constexpr size_t cmax(size_t a, size_t b) { return a > b ? a : b; }
constexpr size_t WS_NEED = cmax(cmax(END_MLA, END_RET), cmax(END_S5, END_FFN));

struct P { const float* in[32]; float* out; char* ws; };
#ifndef PHASE_MASK
#define PHASE_MASK 0xFFFFFFFFu
#endif
#define PM(b) ((PHASE_MASK >> (b)) & 1u)

HD float bf2f(u16 b) { union { unsigned u; float f; } x; x.u = ((unsigned)b) << 16; return x.f; }
HD u16 f2bf(float f) { union { unsigned u; float f; } x; x.f = f; unsigned u = x.u; u += 0x7fffu + ((u >> 16) & 1u); return (u16)(u >> 16); }
HD void st4bf(u16* p, f32x4 v) { u32x2 w; w.x = (unsigned)f2bf(v[0]) | ((unsigned)f2bf(v[1]) << 16); w.y = (unsigned)f2bf(v[2]) | ((unsigned)f2bf(v[3]) << 16); *(u32x2*)p = w; }
HD float silu_f(float a) { return a / (1.0f + expf(-a)); }
HD float sigm_f(float a) { return 1.0f / (1.0f + expf(-a)); }
HD float gelu_f(float x) { return 0.5f * x * (1.0f + tanhf(0.7978845608028654f * (x + 0.044715f * x * x * x))); }
HD float rsq_f(float x) { return 1.0f / sqrtf(x); }
HD float ex2(float x) {
#ifdef HOST_EMU
    return exp2f(x);
#else
    return __builtin_amdgcn_exp2f(x);
#endif
}
HD float* hrow(const P& p, int r) { return r < NL ? p.out + (size_t)r * 1024 : (float*)(p.ws + O_G) + (size_t)(r - NL) * 1024; }
HD const float* modp(const P& p, int layer, int r, int idx) { const int mr = r < NL ? r / SEQ : NB; return (const float*)(p.ws + O_MOD) + ((size_t)(layer * NMR + mr) * 9 + idx) * 1024; }
HD u16* wsb(const P& p, size_t off) { return (u16*)(p.ws + off); }
HD float ropef(int d, int half) { return expf(-(float)d * (9.210340371976184f / (float)half)) * 0.15915494309189535f; }
HD void sincos_t(float turns, float& sn, float& cs) {
    const float f = turns - floorf(turns);
#ifdef HOST_EMU
    sn = sinf(6.283185307179586f * f); cs = cosf(6.283185307179586f * f);
#else
    sn = __builtin_amdgcn_sinf(f); cs = __builtin_amdgcn_cosf(f);
#endif
}

HD bool rect_unit(int L, int nM, int nN, int& pm, int& pn) {
    const int nwg = nM * nN; if (L >= nwg) return false;
    int wgid = L; { const int q = nwg / 8, r = nwg % 8, xcd = wgid % 8, off = wgid / 8; wgid = (xcd < r ? xcd * (q + 1) : r * (q + 1) + (xcd - r) * q) + off; }
    const int nig = 8 * nN, gid = wgid / nig, fm = gid * 8, gsz = (nM - fm) < 8 ? (nM - fm) : 8;
    pm = fm + ((wgid % nig) % gsz); pn = (wgid % nig) / gsz; return true;
}

struct Unit { const u16* A; const u16* B; int a, b, c, d; float f0, f1; };

struct DFfnUp { P p; int layer, f; static constexpr int K = 1024, lda = 1024, ldb = 1024;
    HD bool unit(int L, Unit& u) const { int pm, pn; if (!rect_unit(L, MT / 256, 22, pm, pn)) return false;
        u.A = wsb(p, O_HN) + (size_t)pm * 256 * 1024; u.B = wsb(p, O_FFI + (size_t)(layer * 2 + f) * SZ_FFI1) + (size_t)pn * 256 * 1024; u.a = pm; u.b = pn; u.c = 0; u.d = 0; return true; }
    HD void emit(const Unit& u, int r, int c, f32x4 v00, f32x4 v01, f32x4 v10, f32x4 v11) const {
        u16* act = wsb(p, O_ACT); const size_t R = (size_t)u.a * 256 + r; const int col = u.b * 128 + c; f32x4 o0, o1;
        for (int j = 0; j < 4; ++j) { o0[j] = silu_f(v00[j]) * v01[j]; o1[j] = silu_f(v10[j]) * v11[j]; }
        st4bf(act + R * 2816 + col, o0); st4bf(act + (R + 128) * 2816 + col, o1); } };

HD void resid4(const P& p, int layer, int midx, float sc, int R, int col, f32x4 v) {
    float* h = hrow(p, R) + col; const float* m = modp(p, layer, R, midx) + col; f32x4 x = *(f32x4*)h;
    for (int j = 0; j < 4; ++j) x[j] += sc * m[j] * v[j];
    *(f32x4*)h = x; }

struct DFfnDown { P p; int layer, f, nM; static constexpr int K = 2816, lda = 2816, ldb = 2816;
    HD bool unit(int L, Unit& u) const { int pm, pn; if (!rect_unit(L, nM, 4, pm, pn)) return false;
        u.A = wsb(p, O_ACT) + (size_t)pm * 256 * 2816; u.B = wsb(p, O_FFO + (size_t)(layer * 2 + f) * SZ_FFO1) + (size_t)pn * 256 * 2816; u.a = pm; u.b = pn; u.c = 0; u.d = 0; return true; }
    HD void emit(const Unit& u, int r, int c, f32x4 v00, f32x4 v01, f32x4 v10, f32x4 v11) const {
        const int R = u.a * 256 + r, col = u.b * 256 + c, mi = f ? 8 : 2;
        resid4(p, layer, mi, 0.5f, R, col, v00); resid4(p, layer, mi, 0.5f, R, col + 128, v01); resid4(p, layer, mi, 0.5f, R + 128, col, v10); resid4(p, layer, mi, 0.5f, R + 128, col + 128, v11); } };

struct DMlaIn { P p; int j; static constexpr int K = 1024, lda = 1024, ldb = 1024;
    HD bool unit(int L, Unit& u) const { int pm, pn; if (!rect_unit(L, MT / 256, 3, pm, pn)) return false;
        u.A = wsb(p, O_HN) + (size_t)pm * 256 * 1024; u.B = wsb(p, O_MWIN + j * SZ_MWIN) + (size_t)pn * 256 * 1024; u.a = pm; u.b = pn; u.c = 0; u.d = 0; return true; }
    HD void emit(const Unit& u, int r, int c, f32x4 v00, f32x4 v01, f32x4 v10, f32x4 v11) const {
        float* o = (float*)(p.ws + O_CALL) + ((size_t)u.a * 256 + r) * 768 + u.b * 256 + c;
        *(f32x4*)o = v00; *(f32x4*)(o + 128) = v01; *(f32x4*)(o + (size_t)128 * 768) = v10; *(f32x4*)(o + (size_t)128 * 768 + 128) = v11; } };
struct DMlaUq { P p; int j; static constexpr int K = 384, lda = 384, ldb = 384;
    HD bool unit(int L, Unit& u) const { int pm, pn; if (!rect_unit(L, MT / 256, 6, pm, pn)) return false;
        u.A = wsb(p, O_CQN) + (size_t)pm * 256 * 384; u.B = wsb(p, O_MWUQ + j * SZ_MWUQ) + (size_t)pn * 256 * 384; u.a = pm; u.b = pn; u.c = 0; u.d = 0; return true; }
    HD void emit(const Unit& u, int r, int c, f32x4 v00, f32x4 v01, f32x4 v10, f32x4 v11) const {
        u16* o = wsb(p, O_CALL) + ((size_t)u.a * 256 + r) * 1536 + u.b * 256 + c;
        st4bf(o, v00); st4bf(o + 128, v01); st4bf(o + (size_t)128 * 1536, v10); st4bf(o + (size_t)128 * 1536 + 128, v11); } };
struct DMlaUkv { P p; int j; static constexpr int K = 256, lda = 256, ldb = 256;
    HD bool unit(int L, Unit& u) const { int pm, pn; if (!rect_unit(L, MT / 256, 8, pm, pn)) return false;
        u.A = wsb(p, O_CKVN) + (size_t)pm * 256 * 256; u.B = wsb(p, O_MWUKV + j * SZ_MWUKV) + (size_t)pn * 256 * 256; u.a = pm; u.b = pn; u.c = 0; u.d = 0; return true; }
    HD void one(size_t R, int col, f32x4 v) const {
        if (col < 1024) st4bf(wsb(p, O_KF) + R * 1536 + (col >> 7) * 192 + (col & 127), v);
        else st4bf(wsb(p, O_VB) + R * 1024 + (col - 1024), v); }
    HD void emit(const Unit& u, int r, int c, f32x4 v00, f32x4 v01, f32x4 v10, f32x4 v11) const {
        const size_t R = (size_t)u.a * 256 + r; const int col = u.b * 256 + c;
        one(R, col, v00); one(R, col + 128, v01); one(R + 128, col, v10); one(R + 128, col + 128, v11); } };
struct DMlaO { P p; int layer, j, nM; static constexpr int K = 1024, lda = 1024, ldb = 1024;
    HD bool unit(int L, Unit& u) const { int pm, pn; if (!rect_unit(L, nM, 4, pm, pn)) return false;
        u.A = wsb(p, O_HN) + (size_t)pm * 256 * 1024; u.B = wsb(p, O_MWO + j * SZ_MWO) + (size_t)pn * 256 * 1024; u.a = pm; u.b = pn; u.c = 0; u.d = 0; return true; }
    HD void emit(const Unit& u, int r, int c, f32x4 v00, f32x4 v01, f32x4 v10, f32x4 v11) const {
        const int R = u.a * 256 + r, col = u.b * 256 + c;
        resid4(p, layer, 5, 1.0f, R, col, v00); resid4(p, layer, 5, 1.0f, R, col + 128, v01); resid4(p, layer, 5, 1.0f, R + 128, col, v10); resid4(p, layer, 5, 1.0f, R + 128, col + 128, v11); } };

HD int ret_tokrow(int q, int cidx) { const int b = q * RGB + cidx / NCH, n = cidx % NCH; return n == 0 ? NL + b * 256 : b * SEQ + (n - 1) * 256; }
HD float ret_logg(const P& p, int dir, int h) { return log1pf(-expf(p.in[18][dir * 4 + h])); }
struct DRetProj { P p; int q; static constexpr int K = 1024, lda = 1024, ldb = 1024;
    HD bool unit(int L, Unit& u) const { int pm, pn; if (!rect_unit(L, NCQ, 16, pm, pn)) return false;
        const int wrow = pn < 8 ? pn * 256 : 4096 + (pn - 8) * 256;
        u.A = wsb(p, O_HN) + (size_t)ret_tokrow(q, pm) * 1024; u.B = wsb(p, O_RWIN) + (size_t)wrow * 1024; u.a = pm; u.b = pn; u.c = 0; u.d = 0;
        u.f0 = ret_logg(p, 0, pn & 3) * 1.4426950408889634f; u.f1 = ret_logg(p, 1, pn & 3) * 1.4426950408889634f; return true; }
    HD void emit(const Unit& u, int r, int c, f32x4 v00, f32x4 v01, f32x4 v10, f32x4 v11) const {
        const int cidx = u.a, pn = u.b, n = cidx % NCH;
        if (pn >= 8) { u16* g = wsb(p, O_GATE) + ((size_t)cidx * 256 + r) * 2048 + (pn - 8) * 256 + c;
            st4bf(g, v00); st4bf(g + 128, v01); st4bf(g + (size_t)128 * 2048, v10); st4bf(g + (size_t)128 * 2048 + 128, v11); return; }
        const int h = pn & 3; const bool isq = pn < 4;
        const float lgf = u.f0, lgb = u.f1;
        for (int X = 0; X < 2; ++X) { const int i = r + 128 * X; const f32x4 x1 = X ? v10 : v00, x2 = X ? v11 : v01; f32x4 r1, r2;
            for (int jx = 0; jx < 4; ++jx) { float cs = 1.f, sn = 0.f;
                if (n > 0) sincos_t((float)((n - 1) * 256 + i) * ropef(c + jx, 128), sn, cs);
                r1[jx] = x1[jx] * cs - x2[jx] * sn; r2[jx] = x2[jx] * cs + x1[jx] * sn; }
            if (isq) { u16* qn = wsb(p, O_QN) + ((size_t)cidx * 256 + i) * 1024 + h * 256 + c; st4bf(qn, r1); st4bf(qn + 128, r2);
                const float df = ex2(lgf * (float)(i + 1)), db = ex2(lgb * (float)(256 - i));
                u16* ae = wsb(p, O_AEXT) + (((size_t)h * NCQ + cidx) * 256 + i) * 768;
                st4bf(ae + 256 + c, r1 * df); st4bf(ae + 384 + c, r2 * df); st4bf(ae + 512 + c, r1 * db); st4bf(ae + 640 + c, r2 * db); }
            else { u16* kn = wsb(p, O_KN) + ((size_t)cidx * 256 + i) * 1024 + h * 256 + c; st4bf(kn, r1 * 0.0625f); st4bf(kn + 128, r2 * 0.0625f); } } } };
struct DRetProjT { P p; int q; static constexpr int K = 1024, lda = 1024, ldb = 1024;
    HD bool unit(int L, Unit& u) const { int pm, pn; if (!rect_unit(L, 12, NCQ, pm, pn)) return false;
        u.A = wsb(p, O_RWIN) + (size_t)(1024 + pm * 256) * 1024; u.B = wsb(p, O_HN) + (size_t)ret_tokrow(q, pn) * 1024; u.a = pm; u.b = pn; u.c = 0; u.d = 0;
        u.f0 = ret_logg(p, 0, pm & 3) * 1.4426950408889634f; u.f1 = ret_logg(p, 1, pm & 3) * 1.4426950408889634f; return true; }
    HD void emit(const Unit& u, int r, int c, f32x4 v00, f32x4 v01, f32x4 v10, f32x4 v11) const {
        const int pm = u.a, cidx = u.b, n = cidx % NCH;
        if (pm >= 4) { const int h = (pm - 4) >> 1, e0 = ((pm - 4) & 1) * 256 + r; u16* be = wsb(p, O_BEXT) + (((size_t)h * NCQ + cidx) * 512 + e0) * 768 + c;
            st4bf(be, v00); st4bf(be + 128, v01); st4bf(be + (size_t)128 * 768, v10); st4bf(be + (size_t)128 * 768 + 128, v11); return; }
        const int h = pm; const float lgf = u.f0, lgb = u.f1, fr = ropef(r, 128);
        u16* kf = wsb(p, O_KTX) + (((size_t)h * NCQ + cidx) * 2 + 0) * 65536; u16* kb = kf + 65536;
        for (int Y = 0; Y < 2; ++Y) { const f32x4 x1 = Y ? v01 : v00, x2 = Y ? v11 : v10; f32x4 f1, f2, b1, b2;
            for (int jx = 0; jx < 4; ++jx) { const int jj = c + 128 * Y + jx; float cs = 1.f, sn = 0.f;
                if (n > 0) sincos_t((float)((n - 1) * 256 + jj) * fr, sn, cs);
                const float r1 = (x1[jx] * cs - x2[jx] * sn) * 0.0625f, r2 = (x2[jx] * cs + x1[jx] * sn) * 0.0625f;
                const float df = ex2(lgf * (float)(255 - jj)), db = ex2(lgb * (float)jj);
                f1[jx] = r1 * df; f2[jx] = r2 * df; b1[jx] = r1 * db; b2[jx] = r2 * db; }
            const int jc = c + 128 * Y;
            st4bf(kf + (size_t)r * 256 + jc, f1); st4bf(kf + (size_t)(r + 128) * 256 + jc, f2); st4bf(kb + (size_t)r * 256 + jc, b1); st4bf(kb + (size_t)(r + 128) * 256 + jc, b2); } } };
struct DRetP { P p; static constexpr int K = 256, lda = 1024, ldb = 1024;
    HD bool unit(int L, Unit& u) const { int pm, pn; if (!rect_unit(L, NCQ, 4, pm, pn)) return false;
        u.A = wsb(p, O_QN) + (size_t)pm * 256 * 1024 + pn * 256; u.B = wsb(p, O_KN) + (size_t)pm * 256 * 1024 + pn * 256; u.a = pm; u.b = pn; u.c = 0; u.d = 0;
        u.f0 = ret_logg(p, 0, pn) * 1.4426950408889634f; u.f1 = ret_logg(p, 1, pn) * 1.4426950408889634f; return true; }
    HD void one(u16* ae, float lgf, float lgb, int i, int j0, f32x4 v) const { f32x4 o;
        for (int jx = 0; jx < 4; ++jx) { const int jj = j0 + jx; o[jx] = v[jx] * ex2(jj <= i ? lgf * (float)(i - jj) : lgb * (float)(jj - i)); }
        st4bf(ae + (size_t)i * 768 + j0, o); }
    HD void emit(const Unit& u, int r, int c, f32x4 v00, f32x4 v01, f32x4 v10, f32x4 v11) const {
        const int cidx = u.a, h = u.b; const float lgf = u.f0, lgb = u.f1;
        u16* ae = wsb(p, O_AEXT) + ((size_t)h * NCQ + cidx) * 256 * 768;
        one(ae, lgf, lgb, r, c, v00); one(ae, lgf, lgb, r, c + 128, v01); one(ae, lgf, lgb, r + 128, c, v10); one(ae, lgf, lgb, r + 128, c + 128, v11); } };
struct DRetL { P p; static constexpr int K = 256, lda = 768, ldb = 256;
    HD bool unit(int L, Unit& u) const { int pm, pn; if (!rect_unit(L, 4 * NCQ, 4, pm, pn)) return false;
        const int dir = pn >> 1, eh = pn & 1;
        u.A = wsb(p, O_BEXT) + ((size_t)pm * 512 + eh * 256) * 768; u.B = wsb(p, O_KTX) + ((size_t)pm * 2 + dir) * 65536; u.a = pm; u.b = dir; u.c = eh; u.d = 0; return true; }
    HD void emit(const Unit& u, int r, int c, f32x4 v00, f32x4 v01, f32x4 v10, f32x4 v11) const {
        u16* o = wsb(p, O_BEXT) + ((size_t)u.a * 512 + u.c * 256 + r) * 768 + 256 + u.b * 256 + c;
        st4bf(o, v00); st4bf(o + 128, v01); st4bf(o + (size_t)128 * 768, v10); st4bf(o + (size_t)128 * 768 + 128, v11); } };
struct DRetO { P p; static constexpr int K = 768, lda = 768, ldb = 768;
    HD bool unit(int L, Unit& u) const { int pm, pn; if (!rect_unit(L, 4 * NCQ, 2, pm, pn)) return false;
        u.A = wsb(p, O_AEXT) + (size_t)pm * 256 * 768; u.B = wsb(p, O_BEXT) + ((size_t)pm * 512 + pn * 256) * 768; u.a = pm; u.b = pn; u.c = 0; u.d = 0; return true; }
    HD void emit(const Unit& u, int r, int c, f32x4 v00, f32x4 v01, f32x4 v10, f32x4 v11) const {
        const int h = u.a / NCQ, cidx = u.a % NCQ;
        u16* o = wsb(p, O_OB) + ((size_t)cidx * 256 + r) * 2048 + h * 512 + u.b * 256 + c;
        st4bf(o, v00); st4bf(o + 128, v01); st4bf(o + (size_t)128 * 2048, v10); st4bf(o + (size_t)128 * 2048 + 128, v11); } };
struct DRetWo { P p; int layer, q; static constexpr int K = 2048, lda = 2048, ldb = 2048;
    HD bool unit(int L, Unit& u) const { int pm, pn; if (!rect_unit(L, NCQ, 4, pm, pn)) return false;
        u.A = wsb(p, O_OB) + (size_t)pm * 256 * 2048; u.B = wsb(p, O_RWO) + (size_t)pn * 256 * 2048; u.a = ret_tokrow(q, pm); u.b = pn; u.c = 0; u.d = 0; return true; }
    HD void emit(const Unit& u, int r, int c, f32x4 v00, f32x4 v01, f32x4 v10, f32x4 v11) const {
        const int R = u.a + r, col = u.b * 256 + c;
        resid4(p, layer, 5, 1.0f, R, col, v00); resid4(p, layer, 5, 1.0f, R, col + 128, v01); resid4(p, layer, 5, 1.0f, R + 128, col, v10); resid4(p, layer, 5, 1.0f, R + 128, col + 128, v11); } };

struct DS5L { P p; static constexpr int K = 512, lda = 768, ldb = 512;
    HD bool unit(int L, Unit& u) const { int pm, pn; if (!rect_unit(L, NROW5P / 256, 64, pm, pn)) return false;
        u.A = wsb(p, O_UEXT) + ((size_t)pn * NROW5P + pm * 256) * 768; u.B = wsb(p, O_FEXT) + (size_t)pn * 256 * 512; u.a = pm; u.b = pn; u.c = 0; u.d = 0; return true; }
    HD void emit(const Unit& u, int r, int c, f32x4 v00, f32x4 v01, f32x4 v10, f32x4 v11) const {
        u16* o = wsb(p, O_UEXT) + ((size_t)u.b * NROW5P + u.a * 256 + r) * 768 + 512 + c;
        st4bf(o, v00); st4bf(o + 128, v01); st4bf(o + (size_t)128 * 768, v10); st4bf(o + (size_t)128 * 768 + 128, v11); } };
struct DS5Y { P p; static constexpr int K = 768, lda = 768, ldb = 768;
    HD bool unit(int L, Unit& u) const { int pm, pn; if (!rect_unit(L, NROW5P / 256, 128, pm, pn)) return false;
        const int g = pn >> 1, ch = pn & 1;
        u.A = wsb(p, O_UEXT) + ((size_t)g * NROW5P + pm * 256) * 768; u.B = wsb(p, O_TEXT) + ((size_t)g * 512 + ch * 256) * 768; u.a = pm; u.b = g; u.c = ch; u.d = 0; return true; }
    HD void one(int g, int row, int col, f32x4 v) const {
        int tok; if (row < NB * S5L) tok = (row / S5L) * SEQ + (row % S5L) * 32; else if (row < NROW5) { const int rr = row - NB * S5L; tok = NL + (rr / S5C) * 256 + (rr % S5C) * 32; } else return;
        f32x4 o; for (int jx = 0; jx < 4; ++jx) o[jx] = gelu_f(v[jx]);
        st4bf(wsb(p, O_HN) + (size_t)(tok + (col >> 4)) * 1024 + g * 16 + (col & 15), o); }
    HD void emit(const Unit& u, int r, int c, f32x4 v00, f32x4 v01, f32x4 v10, f32x4 v11) const {
        const int row = u.a * 256 + r, col = u.c * 256 + c;
        one(u.b, row, col, v00); one(u.b, row, col + 128, v01); one(u.b, row + 128, col, v10); one(u.b, row + 128, col + 128, v11); } };
struct DS5Glu { P p; int layer; static constexpr int K = 1024, lda = 1024, ldb = 1024;
    HD bool unit(int L, Unit& u) const { int pm, pn; if (!rect_unit(L, MT / 256, 8, pm, pn)) return false;
        u.A = wsb(p, O_HN) + (size_t)pm * 256 * 1024; u.B = wsb(p, O_GLU) + (size_t)pn * 256 * 1024; u.a = pm; u.b = pn; u.c = 0; u.d = 0; return true; }
    HD void emit(const Unit& u, int r, int c, f32x4 v00, f32x4 v01, f32x4 v10, f32x4 v11) const {
        const int col = u.b * 128 + c; const float* gb = p.in[30]; f32x4 y0, y1;
        for (int jx = 0; jx < 4; ++jx) { const float ba = gb[col + jx], bg = gb[1024 + col + jx];
            y0[jx] = (v00[jx] + ba) * sigm_f(v01[jx] + bg); y1[jx] = (v10[jx] + ba) * sigm_f(v11[jx] + bg); }
        resid4(p, layer, 5, 1.0f, u.a * 256 + r, col, y0); resid4(p, layer, 5, 1.0f, u.a * 256 + r + 128, col, y1); } };

HD void cvt8(const float* src, int N, int srccol, u16* dst, int Kd, int nrow, int k0) {
    f32x4 a, b;
    for (int j = 0; j < 4; ++j) { a[j] = srccol >= 0 ? src[(size_t)(k0 + j) * N + srccol] : 0.f; b[j] = srccol >= 0 ? src[(size_t)(k0 + 4 + j) * N + srccol] : 0.f; }
    st4bf(dst + (size_t)nrow * Kd + k0, a); st4bf(dst + (size_t)nrow * Kd + k0 + 4, b); }
constexpr long CV_FFI = (long)8 * 5632 * 128, CV_FFO = (long)8 * 1024 * 352, CV_MWIN = (long)2 * 768 * 128, CV_MWUQ = (long)2 * 1536 * 48, CV_MWUKV = (long)2 * 2048 * 32,
               CV_MWO = (long)2 * 1024 * 128, CV_RWIN = (long)6144 * 128, CV_RWO = (long)1024 * 256, CV_GLU = (long)2048 * 128;
constexpr long CV_TOTAL = CV_FFI + CV_FFO + CV_MWIN + CV_MWUQ + CV_MWUKV + CV_MWO + CV_RWIN + CV_RWO + CV_GLU;
HD void cvt_item(const P& p, long idx) {
    if (idx < CV_FFI) { const int n = (int)(idx % 5632); const long t = idx / 5632; const int kb = (int)(t % 128), m = (int)(t / 128);
        const int tile = n >> 8, rr = n & 255; const int sc = rr < 128 ? tile * 128 + rr : 2816 + tile * 128 + (rr - 128);
        cvt8(p.in[7] + (size_t)m * 1024 * 5632, 5632, sc, wsb(p, O_FFI + (size_t)m * SZ_FFI1), 1024, n, kb * 8); return; }
    idx -= CV_FFI;
    if (idx < CV_FFO) { const int n = (int)(idx % 1024); const long t = idx / 1024; const int kb = (int)(t % 352), m = (int)(t / 352);
        cvt8(p.in[8] + (size_t)m * 2816 * 1024, 1024, n, wsb(p, O_FFO + (size_t)m * SZ_FFO1), 2816, n, kb * 8); return; }
    idx -= CV_FFO;
    if (idx < CV_MWIN) { const int n = (int)(idx % 768); const long t = idx / 768; const int kb = (int)(t % 128), m = (int)(t / 128);
        cvt8(p.in[9] + (size_t)m * 1024 * 704, 704, n < 704 ? n : -1, wsb(p, O_MWIN + (size_t)m * SZ_MWIN), 1024, n, kb * 8); return; }
    idx -= CV_MWIN;
    if (idx < CV_MWUQ) { const int n = (int)(idx % 1536); const long t = idx / 1536; const int kb = (int)(t % 48), m = (int)(t / 48);
        cvt8(p.in[12] + (size_t)m * 384 * 1536, 1536, n, wsb(p, O_MWUQ + (size_t)m * SZ_MWUQ), 384, n, kb * 8); return; }
    idx -= CV_MWUQ;
    if (idx < CV_MWUKV) { const int n = (int)(idx % 2048); const long t = idx / 2048; const int kb = (int)(t % 32), m = (int)(t / 32);
        const int sc = n < 1024 ? (n >> 7) * 256 + (n & 127) : ((n - 1024) >> 7) * 256 + 128 + (n & 127);
        cvt8(p.in[13] + (size_t)m * 256 * 2048, 2048, sc, wsb(p, O_MWUKV + (size_t)m * SZ_MWUKV), 256, n, kb * 8); return; }
    idx -= CV_MWUKV;
    if (idx < CV_MWO) { const int n = (int)(idx % 1024); const long t = idx / 1024; const int kb = (int)(t % 128), m = (int)(t / 128);
        cvt8(p.in[16] + (size_t)m * 1024 * 1024, 1024, n, wsb(p, O_MWO + (size_t)m * SZ_MWO), 1024, n, kb * 8); return; }
    idx -= CV_MWO;
    if (idx < CV_RWIN) { const int n = (int)(idx % 6144), kb = (int)(idx / 6144); cvt8(p.in[17], 6144, n, wsb(p, O_RWIN), 1024, n, kb * 8); return; }
    idx -= CV_RWIN;
    if (idx < CV_RWO) { const int n = (int)(idx % 1024), kb = (int)(idx / 1024); cvt8(p.in[20], 1024, n, wsb(p, O_RWO), 2048, n, kb * 8); return; }
    idx -= CV_RWO;
    { const int n = (int)(idx % 2048), kb = (int)(idx / 2048); const int tile = n >> 8, rr = n & 255; const int sc = rr < 128 ? tile * 128 + rr : 1024 + tile * 128 + (rr - 128);
      cvt8(p.in[29], 2048, sc, wsb(p, O_GLU), 1024, n, kb * 8); }
}
HD void mod_item(const P& p, int idx) {
    const int layer = idx / 9216, col = idx % 9216; const float* w = p.in[4] + (size_t)layer * 1024 * 9216 + col; float acc[NMR];
    for (int b = 0; b < NMR; ++b) acc[b] = 0.f;
    for (int k = 0; k < 1024; ++k) { const float wv = w[(size_t)k * 9216];
#pragma unroll
        for (int b = 0; b < NMR; ++b) { const float cv = b < NB ? p.in[1][b * 1024 + k] : p.in[3][k]; acc[b] += silu_f(cv) * wv; } }
    const float bias = p.in[5][layer * 9216 + col];
#pragma unroll
    for (int b = 0; b < NMR; ++b) ((float*)(p.ws + O_MOD))[(size_t)(layer * NMR + b) * 9216 + col] = acc[b] + bias; }
HD void copy_item(const P& p, long idx) {
    const long nl4 = (long)NL * 256;
    if (idx < nl4) ((f32x4*)p.out)[idx] = ((const f32x4*)p.in[0])[idx]; else ((f32x4*)(p.ws + O_G))[idx - nl4] = ((const f32x4*)p.in[2])[idx - nl4]; }
HD void norm_item(const P& p, int layer, int k, int r, int s5) {
    const float* x = hrow(p, r); float ss = 0.f;
    for (int d = 0; d < 1024; d += 4) { const f32x4 v = *(const f32x4*)(x + d); ss += v[0] * v[0] + v[1] * v[1] + v[2] * v[2] + v[3] * v[3]; }
    const float rinv = rsq_f(ss * (1.0f / 1024.0f) + EPS);
    const float* g = p.in[6] + (size_t)(layer * 3 + k) * 1024; const float* sh = modp(p, layer, r, 3 * k); const float* sc = modp(p, layer, r, 3 * k + 1);
    int row5 = 0, i5 = 0;
    if (s5) { if (r < NL) { const int b = r / SEQ, t = r % SEQ; row5 = b * S5L + t / 32; i5 = t % 32; } else { const int rr = r - NL; const int b = rr / 256, l = rr % 256; row5 = NB * S5L + b * S5C + l / 32; i5 = l % 32; } }
    for (int d = 0; d < 1024; d += 4) { const f32x4 v = *(const f32x4*)(x + d); f32x4 o;
        for (int j = 0; j < 4; ++j) o[j] = v[j] * rinv * g[d + j] * (1.0f + sc[d + j]) + sh[d + j];
        if (!s5) st4bf(wsb(p, O_HN) + (size_t)r * 1024 + d, o);
        else st4bf(wsb(p, O_UEXT) + ((size_t)(d >> 4) * NROW5P + row5) * 768 + i5 * 16 + (d & 15), o); } }
HD void axial_rot64(float* v, int t) {
    const int prow = t / 64, pcol = t % 64;
    for (int f = 0; f < 16; ++f) { const float fq = ropef(f, 16);
        { float cs, sn; sincos_t((float)prow * fq, sn, cs); const float x1 = v[f], x2 = v[16 + f]; v[f] = x1 * cs - x2 * sn; v[16 + f] = x2 * cs + x1 * sn; }
        { float cs, sn; sincos_t((float)pcol * fq, sn, cs); const float x1 = v[32 + f], x2 = v[48 + f]; v[32 + f] = x1 * cs - x2 * sn; v[48 + f] = x2 * cs + x1 * sn; } } }
HD void mla_row_item(const P& p, int j, int r) {
    const float* x = (const float*)(p.ws + O_CALL) + (size_t)r * 768; float ss = 0.f;
    for (int d = 0; d < 384; ++d) ss += x[d] * x[d];
    float rinv = rsq_f(ss * (1.0f / 384.0f) + EPS); const float* qn = p.in[10] + j * 384;
    for (int d = 0; d < 384; d += 4) { f32x4 o; for (int jx = 0; jx < 4; ++jx) o[jx] = x[d + jx] * rinv * qn[d + jx]; st4bf(wsb(p, O_CQN) + (size_t)r * 384 + d, o); }
    ss = 0.f; for (int d = 0; d < 256; ++d) ss += x[384 + d] * x[384 + d];
    rinv = rsq_f(ss * (1.0f / 256.0f) + EPS); const float* kvn = p.in[11] + j * 256;
    for (int d = 0; d < 256; d += 4) { f32x4 o; for (int jx = 0; jx < 4; ++jx) o[jx] = x[384 + d + jx] * rinv * kvn[d + jx]; st4bf(wsb(p, O_CKVN) + (size_t)r * 256 + d, o); }
    ss = 0.f; for (int d = 0; d < 64; ++d) ss += x[640 + d] * x[640 + d];
    rinv = rsq_f(ss * (1.0f / 64.0f) + EPS); const float* kg = p.in[15] + j * 192 + 128;
#ifdef HOST_EMU
    float kr[64];
    for (int d = 0; d < 64; ++d) kr[d] = x[640 + d] * rinv * kg[d];
    if (r < NL) axial_rot64(kr, r % SEQ);
    for (int h = 0; h < 8; ++h) for (int d = 0; d < 64; ++d) wsb(p, O_KF)[(size_t)r * 1536 + h * 192 + 128 + d] = f2bf(kr[d]);
#else
    const int t = r % SEQ, prow = t / 64, pcol = t % 64;
    for (int f = 0; f < 16; ++f) { const float fq = ropef(f, 16);
#pragma unroll
        for (int part = 0; part < 2; ++part) { float cs = 1.f, sn = 0.f; if (r < NL) sincos_t((float)(part ? pcol : prow) * fq, sn, cs);
            const int d1 = part * 32 + f, d2 = d1 + 16; const float x1 = x[640 + d1] * rinv * kg[d1], x2 = x[640 + d2] * rinv * kg[d2];
            const u16 o1 = f2bf(x1 * cs - x2 * sn), o2 = f2bf(x2 * cs + x1 * sn);
            for (int h = 0; h < 8; ++h) { wsb(p, O_KF)[(size_t)r * 1536 + h * 192 + 128 + d1] = o1; wsb(p, O_KF)[(size_t)r * 1536 + h * 192 + 128 + d2] = o2; } } }
#endif
}
HD void mla_head_item(const P& p, int j, int idx) {
    const int r = idx >> 3, h = idx & 7;
    u16* q = wsb(p, O_CALL) + (size_t)r * 1536 + h * 192; const float* qg = p.in[14] + j * 192; float ss = 0.f;
    for (int d = 0; d < 128; ++d) { const float v = bf2f(q[d]); ss += v * v; }
    float rinv = rsq_f(ss * (1.0f / 128.0f) + EPS);
    for (int d = 0; d < 128; ++d) q[d] = f2bf(bf2f(q[d]) * rinv * qg[d]);
    ss = 0.f; for (int d = 0; d < 64; ++d) { const float v = bf2f(q[128 + d]); ss += v * v; }
    rinv = rsq_f(ss * (1.0f / 64.0f) + EPS);
    { const int t = r % SEQ, prow = t / 64, pcol = t % 64;
      for (int f = 0; f < 16; ++f) { const float fq = ropef(f, 16);
#pragma unroll
        for (int part = 0; part < 2; ++part) { float cs = 1.f, sn = 0.f; if (r < NL) sincos_t((float)(part ? pcol : prow) * fq, sn, cs);
            const int d1 = 128 + part * 32 + f, d2 = d1 + 16; const float x1 = bf2f(q[d1]) * rinv * qg[d1], x2 = bf2f(q[d2]) * rinv * qg[d2];
            q[d1] = f2bf(x1 * cs - x2 * sn); q[d2] = f2bf(x2 * cs + x1 * sn); } } }
    u16* k = wsb(p, O_KF) + (size_t)r * 1536 + h * 192; const float* kg = p.in[15] + j * 192;
    ss = 0.f; for (int d = 0; d < 128; ++d) { const float v = bf2f(k[d]); ss += v * v; }
    rinv = rsq_f(ss * (1.0f / 128.0f) + EPS);
    for (int d = 0; d < 128; ++d) k[d] = f2bf(bf2f(k[d]) * rinv * kg[d]);
}
HD void ret_prefix_item(const P& p, int idx) {
    const int d4 = idx & 63, e = (idx >> 6) & 511, bq = (idx >> 15) % RGB, h = (idx >> 15) / RGB;
    const float gf = expf(256.f * ret_logg(p, 0, h)), gb = expf(256.f * ret_logg(p, 1, h));
    f32x4 cf = {0.f, 0.f, 0.f, 0.f}, cb = {0.f, 0.f, 0.f, 0.f};
    for (int n = 0; n < NCH; ++n) { u16* s = wsb(p, O_BEXT) + (((size_t)h * NCQ + bq * NCH + n) * 512 + e) * 768 + 256 + d4 * 4;
        f32x4 t; for (int j = 0; j < 4; ++j) t[j] = bf2f(s[j]);
        st4bf(s, cf); cf = cf * gf + t; }
    for (int s_ = 0; s_ < NCH; ++s_) { const int n = s_ == 0 ? 0 : NCH - s_; u16* s = wsb(p, O_BEXT) + (((size_t)h * NCQ + bq * NCH + n) * 512 + e) * 768 + 512 + d4 * 4;
        f32x4 t; for (int j = 0; j < 4; ++j) t[j] = bf2f(s[j]);
        st4bf(s, cb); cb = cb * gb + t; } }
HD void ret_norm_item(const P& p, int idx) {
    const int lr = idx >> 2, h = idx & 3; u16* o = wsb(p, O_OB) + (size_t)lr * 2048 + h * 512; const u16* g = wsb(p, O_GATE) + (size_t)lr * 2048 + h * 512; const float* gg = p.in[19] + h * 512;
    float s = 0.f; for (int e = 0; e < 512; ++e) s += bf2f(o[e]);
    const float mu = s * (1.0f / 512.0f); float q = 0.f; for (int e = 0; e < 512; ++e) { const float d = bf2f(o[e]) - mu; q += d * d; }
    const float rstd = rsq_f(q * (1.0f / 512.0f) + EPS);
    for (int e = 0; e < 512; ++e) o[e] = f2bf((bf2f(o[e]) - mu) * rstd * gg[e] * silu_f(bf2f(g[e]))); }
struct Cx { float re, im; };
HD Cx cmul(Cx a, Cx b) { Cx r; r.re = a.re * b.re - a.im * b.im; r.im = a.re * b.im + a.im * b.re; return r; }
HD Cx s5_alog(const P& p, int dir, int g, int pp) { const float dt = expf(p.in[23][dir * 64 + g]); Cx r; r.re = p.in[21][(dir * 64 + g) * 64 + pp] * dt; r.im = p.in[22][(dir * 64 + g) * 64 + pp] * dt; return r; }
HD Cx cpowa(Cx al, float n) { const float m = expf(al.re * n); float sn, cs; sincos_t(al.im * n * 0.15915494309189535f, sn, cs); Cx r; r.re = m * cs; r.im = m * sn; return r; }
HD Cx s5_coef(const P& p, int dir, int g, int pp) {
    const Cx al = s5_alog(p, dir, g, pp); Cx a = cpowa(al, 1.f); a.re -= 1.f; const float lr = p.in[21][(dir * 64 + g) * 64 + pp], li = p.in[22][(dir * 64 + g) * 64 + pp], den = 1.0f / (lr * lr + li * li);
    Cx r; r.re = (a.re * lr + a.im * li) * den; r.im = (a.im * lr - a.re * li) * den; return r; }
HD Cx s5_bbar(const P& p, int dir, int g, int pp, int m) { Cx b; const size_t o = (((size_t)dir * 64 + g) * 64 + pp) * 16 + m; b.re = p.in[24][o]; b.im = p.in[25][o]; return cmul(s5_coef(p, dir, g, pp), b); }
HD Cx s5_c(const P& p, int dir, int g, int m, int pp) { Cx c; const size_t o = (((size_t)dir * 64 + g) * 16 + m) * 64 + pp; c.re = p.in[26][o]; c.im = p.in[27][o]; return c; }
HD void s5_ktab_item(const P& p, int idx) {
    const int m2 = idx & 15, m = (idx >> 4) & 15, tau = (idx >> 8) & 31, dir = (idx >> 13) & 1, g = idx >> 14; float acc = 0.f;
    for (int pp = 0; pp < 64; ++pp) { const Cx w = cmul(cmul(s5_c(p, dir, g, m, pp), cpowa(s5_alog(p, dir, g, pp), (float)tau)), s5_bbar(p, dir, g, pp, m2)); acc += w.re; }
    ((float*)(p.ws + O_KTAB))[idx] = acc; }
HD void s5_text_item(const P& p, long idx) {
    const int col = (int)(idx % 768); const long t = idx / 768; const int row = (int)(t % 512), g = (int)(t / 512), i = row >> 4, m = row & 15; float v;
    const float* kt = (const float*)(p.ws + O_KTAB);
    if (col < 512) { const int jj = col >> 4, m2 = col & 15; v = 0.f;
        if (jj <= i) v += kt[((((size_t)g * 2 + 0) * 32 + (i - jj)) * 16 + m) * 16 + m2];
        if (jj >= i) v += kt[((((size_t)g * 2 + 1) * 32 + (jj - i)) * 16 + m) * 16 + m2];
        if (jj == i && m == m2) v += p.in[28][g * 16 + m]; }
    else { const int dir = col >= 640, pp = ((col - 512) & 127) >> 1, part = col & 1;
        const Cx w = cmul(s5_c(p, dir, g, m, pp), cpowa(s5_alog(p, dir, g, pp), dir ? (float)(32 - i) : (float)(i + 1))); v = part ? -w.im : w.re; }
    wsb(p, O_TEXT)[idx] = f2bf(v); }
HD void s5_fext_item(const P& p, int idx) {
    const int col = idx & 511, row = (idx >> 9) & 255, g = idx >> 17, jj = col >> 4, m2 = col & 15, dir = row >> 7, pp = (row & 127) >> 1, part = row & 1;
    const Cx w = cmul(cpowa(s5_alog(p, dir, g, pp), dir ? (float)jj : (float)(31 - jj)), s5_bbar(p, dir, g, pp, m2));
    wsb(p, O_FEXT)[idx] = f2bf(part ? w.im : w.re); }
HD int s5_row(int b, int s) { return s < S5C ? NB * S5L + b * S5C + s : b * S5L + (s - S5C); }
HD void s5_prefix_item(const P& p, int idx) {
    const int pp = idx & 63, b = (idx >> 6) % NB, g = (idx >> 6) / NB;
    const Cx af = cpowa(s5_alog(p, 0, g, pp), 32.f), ab = cpowa(s5_alog(p, 1, g, pp), 32.f);
    u16* base = wsb(p, O_UEXT) + (size_t)g * NROW5P * 768; Cx c; c.re = 0.f; c.im = 0.f;
    for (int s = 0; s < S5C + S5L; ++s) { u16* q = base + (size_t)s5_row(b, s) * 768 + 512 + 2 * pp; Cx t; t.re = bf2f(q[0]); t.im = bf2f(q[1]);
        q[0] = f2bf(c.re); q[1] = f2bf(c.im); c = cmul(af, c); c.re += t.re; c.im += t.im; }
    c.re = 0.f; c.im = 0.f;
    for (int s_ = 0; s_ < S5C + S5L; ++s_) { const int s = s_ < S5C ? S5C - 1 - s_ : S5C + S5L - 1 - (s_ - S5C); u16* q = base + (size_t)s5_row(b, s) * 768 + 640 + 2 * pp; Cx t; t.re = bf2f(q[0]); t.im = bf2f(q[1]);
        q[0] = f2bf(c.re); q[1] = f2bf(c.im); c = cmul(ab, c); c.re += t.re; c.im += t.im; } }

struct AttItem { const u16* q; const u16* k0; const u16* k1; const u16* v0; const u16* v1; u16* o; int n0, ntot; };
HD void att_item(const P& p, int it, AttItem& a) {
    const u16* Q = wsb(p, O_CALL); const u16* KF = wsb(p, O_KF); const u16* VB = wsb(p, O_VB); u16* O = wsb(p, O_HN);
    const int nlat = NB * 8 * (SEQ / 256);
    if (it < nlat) { const int qb = it % (SEQ / 256), h = (it / (SEQ / 256)) & 7, b = it / (SEQ / 256) / 8; const size_t r0 = (size_t)b * SEQ + qb * 256, c0 = (size_t)NL + b * 256, l0 = (size_t)b * SEQ;
        a.q = Q + r0 * 1536 + h * 192; a.o = O + r0 * 1024 + h * 128; a.k0 = KF + c0 * 1536 + h * 192; a.v0 = VB + c0 * 1024 + h * 128; a.k1 = KF + l0 * 1536 + h * 192; a.v1 = VB + l0 * 1024 + h * 128; a.n0 = 256; a.ntot = 256 + SEQ; }
    else { const int x = it - nlat, h = x & 7, b = x >> 3; const size_t c0 = (size_t)NL + b * 256;
        a.q = Q + c0 * 1536 + h * 192; a.o = O + c0 * 1024 + h * 128; a.k0 = KF + c0 * 1536 + h * 192; a.v0 = VB + c0 * 1024 + h * 128; a.k1 = a.k0; a.v1 = a.v0; a.n0 = 256; a.ntot = 256; } }
constexpr float ATT_SCALE = 0.07216878364870322f;

#ifndef HOST_EMU
#define LAS __attribute__((address_space(3)))
typedef short bf16x8 __attribute__((ext_vector_type(8)));
typedef short s16x4 __attribute__((ext_vector_type(4)));
typedef float f32x16 __attribute__((ext_vector_type(16)));
typedef unsigned u32x4 __attribute__((ext_vector_type(4)));
constexpr int HTB = 128 * 64 * 2, STAGE_BYTES = 8 * HTB;
__device__ __forceinline__ int lds_byte(int r, int c) { const int st = (r >> 4) * 2 + (c >> 5), rr = r & 15, cc = c & 31, ob = rr * 64 + cc * 2; return st * 1024 + (ob ^ (((ob >> 9) & 1) << 5)); }
__device__ __forceinline__ void stage_rc(int b, int& R, int& C) { const int st = b / 1024, sb = b % 1024, swz = sb ^ (((sb >> 9) & 1) << 5); R = (st >> 1) * 16 + swz / 64; C = (st & 1) * 32 + (swz % 64) / 2; }

template <class Dsc>
__device__ __forceinline__ void gemm_run(LAS unsigned char* lds, const Dsc& D) {
    int tid_ = threadIdx.x; asm volatile("" : "+v"(tid_));
    const int tid = tid_, wid = __builtin_amdgcn_readfirstlane(tid >> 6), lane = tid & 63, wr = wid >> 2, wc = wid & 3, fr = lane & 15, fq = lane >> 4;
    constexpr int K = Dsc::K, nt = K / 64, lda = Dsc::lda, ldb = Dsc::ldb;
    static_assert(K % 128 == 0 && K >= 256, "K");
    unsigned voffA[2], voffB[2];
#pragma unroll
    for (int i = 0; i < 2; ++i) { int R, C; stage_rc(tid * 16 + i * 8192, R, C); voffA[i] = (unsigned)(R * lda + C) * 2u; voffB[i] = (unsigned)(R * ldb + C) * 2u; }
    constexpr size_t kstep = 128, hstepA = (size_t)128 * lda * 2, hstepB = (size_t)128 * ldb * 2;
    const unsigned ldsw = (unsigned)wid * 1024u;
    const int aoff = lds_byte(wr * 64 + fr, fq * 8), boff = lds_byte(wc * 32 + fr, fq * 8);
#define G_SA(b, h) (((b) * 2 + (h)) * HTB)
#define G_SB(b, h) ((4 + (b) * 2 + (h)) * HTB)
#define G_STAGE(bufoff, gbase, voff) do { _Pragma("unroll") for (int _i = 0; _i < 2; ++_i) \
        __builtin_amdgcn_global_load_lds((const unsigned*)((const char*)(gbase) + (voff)[_i]), (LAS unsigned*)(lds + (bufoff) + ldsw + _i * 8192), 16, 0, 0); } while (0)
#define G_LDA(dst, b, h) do { _Pragma("unroll") for (int m = 0; m < 4; ++m) _Pragma("unroll") for (int k = 0; k < 2; ++k) dst[m][k] = *(const LAS bf16x8*)(lds + G_SA(b, h) + aoff + m * 2048 + k * 1024); } while (0)
#define G_LDB(dst, b, h) do { _Pragma("unroll") for (int n = 0; n < 2; ++n) _Pragma("unroll") for (int k = 0; k < 2; ++k) dst[n][k] = *(const LAS bf16x8*)(lds + G_SB(b, h) + boff + n * 2048 + k * 1024); } while (0)
#define G_MMA(ai, bj, At, Bt) do { __builtin_amdgcn_s_setprio(1); _Pragma("unroll") for (int m = 0; m < 4; ++m) _Pragma("unroll") for (int n = 0; n < 2; ++n) _Pragma("unroll") for (int k = 0; k < 2; ++k) \
        acc[ai][bj][m][n] = __builtin_amdgcn_mfma_f32_16x16x32_bf16(Bt[n][k], At[m][k], acc[ai][bj][m][n], 0, 0, 0); __builtin_amdgcn_s_setprio(0); } while (0)
#define G_WAIT_V(n) asm volatile("s_waitcnt vmcnt(" #n ")" ::: "memory")
#define G_WAIT_L(n) asm volatile("s_waitcnt lgkmcnt(" #n ")" ::: "memory")
#define G_BAR __builtin_amdgcn_s_barrier()
#define G_SCHED __builtin_amdgcn_sched_barrier(0)
    Unit cur{}, nxt{}; int ui = 0; const int G = gridDim.x, cb = blockIdx.x;
    if (!D.unit(cb, cur)) return;
    f32x4 acc[2][2][4][2];
#pragma unroll
    for (int a = 0; a < 2; ++a)
#pragma unroll
        for (int b = 0; b < 2; ++b)
#pragma unroll
            for (int m = 0; m < 4; ++m)
#pragma unroll
                for (int n = 0; n < 2; ++n) acc[a][b][m][n] = (f32x4){0.f, 0.f, 0.f, 0.f};
    bf16x8 At[4][2], B0[2][2], B1[2][2];
    const char* cA = (const char*)cur.A; const char* cB = (const char*)cur.B;
    G_STAGE(G_SB(0, 0), cB, voffB); G_STAGE(G_SA(0, 0), cA, voffA); G_STAGE(G_SB(0, 1), cB + hstepB, voffB); G_STAGE(G_SA(0, 1), cA + hstepA, voffA);
    if (wr == 1) G_BAR;
    G_WAIT_V(4); G_BAR;
    G_STAGE(G_SB(1, 0), cB + kstep, voffB); G_STAGE(G_SA(1, 0), cA + kstep, voffA); G_STAGE(G_SB(1, 1), cB + hstepB + kstep, voffB);
    G_WAIT_V(6); G_BAR;
    for (;;) {
        const bool has_next = D.unit((ui + 1) * G + cb, nxt);
        const char* nA = has_next ? (const char*)nxt.A : cA; const char* nB = has_next ? (const char*)nxt.B : cB;
        _Pragma("nounroll") for (int t = 0; t < nt; t += 2) {
            const bool last = (t == nt - 2);
            const char* a1 = cA + (size_t)(t + 1) * kstep;
            const char* a2 = last ? nA : cA + (size_t)(t + 2) * kstep; const char* b2 = last ? nB : cB + (size_t)(t + 2) * kstep;
            const char* a3 = a2 + kstep; const char* b3 = b2 + kstep;
            G_LDB(B0, 0, 0); G_SCHED; G_LDA(At, 0, 0); G_STAGE(G_SA(1, 1), a1 + hstepA, voffA);
            G_WAIT_L(8); G_BAR; G_WAIT_L(0); G_MMA(0, 0, At, B0); G_BAR; G_SCHED;
            G_LDB(B1, 0, 1); G_STAGE(G_SB(0, 0), b2, voffB);
            G_BAR; G_WAIT_L(0); G_MMA(0, 1, At, B1); G_BAR;
            G_LDA(At, 0, 1); G_STAGE(G_SA(0, 0), a2, voffA);
            G_BAR; G_WAIT_L(0); G_MMA(1, 0, At, B0); G_BAR; G_SCHED;
            G_STAGE(G_SB(0, 1), b2 + hstepB, voffB);
            G_WAIT_V(6); G_BAR; G_MMA(1, 1, At, B1); G_BAR;
            G_LDB(B0, 1, 0); G_SCHED; G_LDA(At, 1, 0); G_STAGE(G_SA(0, 1), a2 + hstepA, voffA);
            G_WAIT_L(8); G_BAR; G_WAIT_L(0); G_MMA(0, 0, At, B0); G_BAR; G_SCHED;
            G_LDB(B1, 1, 1); G_STAGE(G_SB(1, 0), b3, voffB);
            G_BAR; G_WAIT_L(0); G_MMA(0, 1, At, B1); G_BAR;
            G_LDA(At, 1, 1); G_STAGE(G_SA(1, 0), a3, voffA);
            G_BAR; G_WAIT_L(0); G_MMA(1, 0, At, B0); G_BAR; G_SCHED;
            G_STAGE(G_SB(1, 1), b3 + hstepB, voffB);
            G_WAIT_V(6); G_BAR; G_MMA(1, 1, At, B1); G_BAR;
        }
        int er_ = wr * 64 + fr, ec_ = wc * 32 + fq * 4; asm volatile("" : "+v"(er_), "+v"(ec_));
#pragma unroll
        for (int m = 0; m < 4; ++m)
#pragma unroll
            for (int n = 0; n < 2; ++n) { D.emit(cur, er_ + m * 16, ec_ + n * 16, acc[0][0][m][n], acc[0][1][m][n], acc[1][0][m][n], acc[1][1][m][n]); asm volatile("" ::: "memory"); }
        if (!has_next) break;
#pragma unroll
        for (int a = 0; a < 2; ++a)
#pragma unroll
            for (int b = 0; b < 2; ++b)
#pragma unroll
                for (int m = 0; m < 4; ++m)
#pragma unroll
                    for (int n = 0; n < 2; ++n) acc[a][b][m][n] = (f32x4){0.f, 0.f, 0.f, 0.f};
        cur = nxt; cA = nA; cB = nB; ++ui;
    }
    G_WAIT_V(0);
    if (wr == 0) G_BAR;
    G_BAR;
#undef G_SA
#undef G_SB
#undef G_STAGE
#undef G_LDA
#undef G_LDB
#undef G_MMA
#undef G_WAIT_V
#undef G_WAIT_L
#undef G_BAR
#undef G_SCHED
}

constexpr int A_SHM_V = 64 * 128 * 2, A_SHM_K = 64 * 192 * 2;
#define KSWZ(row, colB) ((row) * 384 + ((colB) ^ (((row) & 7) << 4)))
__device__ __forceinline__ int crow(int r, int hi) { return (r & 3) + 8 * (r >> 2) + 4 * hi; }
__device__ __forceinline__ unsigned cvtpk(float lo, float hi) { unsigned r; asm volatile("v_cvt_pk_bf16_f32 %0, %1, %2" : "=v"(r) : "v"(lo), "v"(hi)); return r; }
__device__ __forceinline__ int v_st(int k, int c) { const int kk = (k & ~0xC) | ((k & 4) << 1) | ((k & 8) >> 1); return ((kk >> 3) * 4 + (c >> 5)) * 512 + ((kk & 7) * 32 + (c & 31)) * 2; }
__device__ __forceinline__ int v_rd_base(int lane) { return ((lane & 3) << 3) | (((lane >> 2) & 3) << 6) | (((lane >> 4) & 1) << 5) | (((lane >> 5) & 1) << 8); }
constexpr int v_rd_off(int d0, int ks, int half) { return d0 * 512 + ks * 4096 + half * 2048; }
template <int OFF> __device__ __forceinline__ s16x4 tr_read(int vb) { s16x4 r; asm volatile("ds_read_b64_tr_b16 %0, %1 offset:%2" : "=&v"(r) : "v"(vb), "i"(OFF) : "memory"); return r; }
template <int D0> __device__ __forceinline__ void pv_one(f32x16& od, int vb, bf16x8 pa0, bf16x8 pa1, bf16x8 pa2, bf16x8 pa3) {
    const s16x4 l0 = tr_read<v_rd_off(D0, 0, 0)>(vb), h0 = tr_read<v_rd_off(D0, 0, 1)>(vb), l1 = tr_read<v_rd_off(D0, 1, 0)>(vb), h1 = tr_read<v_rd_off(D0, 1, 1)>(vb);
    const s16x4 l2 = tr_read<v_rd_off(D0, 2, 0)>(vb), h2 = tr_read<v_rd_off(D0, 2, 1)>(vb), l3 = tr_read<v_rd_off(D0, 3, 0)>(vb), h3 = tr_read<v_rd_off(D0, 3, 1)>(vb);
    asm volatile("s_waitcnt lgkmcnt(0)" ::: "memory"); __builtin_amdgcn_sched_barrier(0);
#define PK(L, H) (bf16x8){L[0], L[1], L[2], L[3], H[0], H[1], H[2], H[3]}
    od = __builtin_amdgcn_mfma_f32_32x32x16_bf16(pa0, PK(l0, h0), od, 0, 0, 0);
    od = __builtin_amdgcn_mfma_f32_32x32x16_bf16(pa1, PK(l1, h1), od, 0, 0, 0);
    od = __builtin_amdgcn_mfma_f32_32x32x16_bf16(pa2, PK(l2, h2), od, 0, 0, 0);
    od = __builtin_amdgcn_mfma_f32_32x32x16_bf16(pa3, PK(l3, h3), od, 0, 0, 0);
#undef PK
}
__device__ __forceinline__ void att_body(const AttItem& a, char* lds) {
    int tid_ = threadIdx.x; asm volatile("" : "+v"(tid_));
    const int tid = tid_, wid = tid >> 6, lane = tid & 63, r32 = lane & 31, hi = lane >> 5;
    char* V_lds = lds; char* K_lds = lds + 2 * A_SHM_V; float* li_l = (float*)(lds + 2 * A_SHM_V + 2 * A_SHM_K) + wid * 64;
    float l_reg = 0.f; f32x16 o[4] = {}; bf16x8 qr[12];
    const u16* Qw = a.q + (size_t)(wid * 32 + r32) * 1536 + hi * 8;
#pragma unroll
    for (int d0 = 0; d0 < 12; ++d0) qr[d0] = *(const bf16x8*)(Qw + d0 * 16);
    const int sr = tid >> 4, sc = (tid & 15) * 8, vst0 = v_st(sr, sc), vst1 = v_st(32 + sr, sc);
    const int voff0 = sr * 1024 + sc, voff1 = (32 + sr) * 1024 + sc;
    int koff[3], kwr[3];
#pragma unroll
    for (int i = 0; i < 3; ++i) { const int id = tid + i * 512, kr_ = id / 24, kc_ = (id % 24) * 8; koff[i] = kr_ * 1536 + kc_; kwr[i] = KSWZ(kr_, kc_ * 2); }
    const int vb0 = (int)(uintptr_t)V_lds + v_rd_base(lane);
    bf16x8 vs0, vs1, ks[3];
    const int NT = a.ntot / 64;
#define A_SLOAD(k0_) do { const int key0_ = (k0_); const u16* kb_ = key0_ < a.n0 ? a.k0 + (size_t)key0_ * 1536 : a.k1 + (size_t)(key0_ - a.n0) * 1536; \
        const u16* vbp_ = key0_ < a.n0 ? a.v0 + (size_t)key0_ * 1024 : a.v1 + (size_t)(key0_ - a.n0) * 1024; \
        vs0 = *(const bf16x8*)(vbp_ + voff0); vs1 = *(const bf16x8*)(vbp_ + voff1); \
        _Pragma("unroll") for (int i = 0; i < 3; ++i) ks[i] = *(const bf16x8*)(kb_ + koff[i]); } while (0)
#define A_SWRITE(b) do { *(bf16x8*)(V_lds + (b) * A_SHM_V + vst0) = vs0; *(bf16x8*)(V_lds + (b) * A_SHM_V + vst1) = vs1; \
        _Pragma("unroll") for (int i = 0; i < 3; ++i) *(bf16x8*)(K_lds + (b) * A_SHM_K + kwr[i]) = ks[i]; } while (0)
    A_SLOAD(0); A_SWRITE(0); __syncthreads();
    constexpr float C = ATT_SCALE * 1.4426950408889634f;
    _Pragma("nounroll") for (int j = 0; j < NT; ++j) {
        const int buf = j & 1;
        if (j + 1 < NT) A_SLOAD((j + 1) * 64);
        f32x16 p0 = {}, p1 = {};
        const char* Ks = K_lds + buf * A_SHM_K;
#pragma unroll
        for (int d0 = 0; d0 < 12; ++d0) { const int cbb = (d0 * 16 + hi * 8) * 2;
            const bf16x8 b0 = *(const bf16x8*)(Ks + KSWZ(r32, cbb)); const bf16x8 b1 = *(const bf16x8*)(Ks + KSWZ(32 + r32, cbb));
            p0 = __builtin_amdgcn_mfma_f32_32x32x16_bf16(b0, qr[d0], p0, 0, 0, 0);
            p1 = __builtin_amdgcn_mfma_f32_32x32x16_bf16(b1, qr[d0], p1, 0, 0, 0); }
        float ps = 0.f;
#pragma unroll
        for (int r = 0; r < 16; ++r) { p0[r] = __builtin_amdgcn_exp2f(p0[r] * C); p1[r] = __builtin_amdgcn_exp2f(p1[r] * C); ps += p0[r] + p1[r]; }
        { auto rr = __builtin_amdgcn_permlane32_swap(__float_as_uint(ps), __float_as_uint(ps), false, false); ps = __uint_as_float(rr[0]) + __uint_as_float(rr[1]); }
        l_reg += ps;
        bf16x8 pa0, pa1, pa2, pa3;
#define PK4(Pv, BASE, OUT) do { unsigned a0 = cvtpk(Pv[BASE + 0], Pv[BASE + 1]), a1 = cvtpk(Pv[BASE + 2], Pv[BASE + 3]); \
        unsigned b0 = cvtpk(Pv[BASE + 4], Pv[BASE + 5]), b1 = cvtpk(Pv[BASE + 6], Pv[BASE + 7]); \
        auto r0 = __builtin_amdgcn_permlane32_swap(a0, b0, false, false); auto r1 = __builtin_amdgcn_permlane32_swap(a1, b1, false, false); \
        u32x4 w = {r0[0], r1[0], r0[1], r1[1]}; OUT = *reinterpret_cast<bf16x8*>(&w); } while (0)
        PK4(p0, 0, pa0); PK4(p0, 8, pa1); PK4(p1, 0, pa2); PK4(p1, 8, pa3);
#undef PK4
        const int vb = vb0 + buf * A_SHM_V;
        pv_one<0>(o[0], vb, pa0, pa1, pa2, pa3); pv_one<1>(o[1], vb, pa0, pa1, pa2, pa3); pv_one<2>(o[2], vb, pa0, pa1, pa2, pa3); pv_one<3>(o[3], vb, pa0, pa1, pa2, pa3);
        if (j + 1 < NT) A_SWRITE(buf ^ 1);
        __syncthreads();
    }
    if (hi == 0) li_l[r32] = l_reg;
    asm volatile("s_waitcnt lgkmcnt(0)" ::: "memory");
    __builtin_amdgcn_wave_barrier();
    u16* Ow = a.o + (size_t)(wid * 32) * 1024;
#pragma unroll
    for (int r = 0; r < 16; ++r) { const int orow = crow(r, hi); const float rl = 1.0f / li_l[orow];
#pragma unroll
        for (int d0 = 0; d0 < 4; ++d0) Ow[(size_t)orow * 1024 + d0 * 32 + r32] = f2bf(o[d0][r] * rl); }
    __syncthreads();
#undef A_SLOAD
#undef A_SWRITE
}

__device__ __forceinline__ float wsum(float v) { for (int o = 32; o >= 1; o >>= 1) v += __shfl_xor(v, o); return v; }
__device__ __forceinline__ void norm_wave(const P& p, int layer, int k, int r, int s5, int lane) {
    const float* x = hrow(p, r); f32x4 v[4]; float ss = 0.f;
#pragma unroll
    for (int i = 0; i < 4; ++i) { v[i] = *(const f32x4*)(x + i * 256 + lane * 4); ss += v[i][0] * v[i][0] + v[i][1] * v[i][1] + v[i][2] * v[i][2] + v[i][3] * v[i][3]; }
    ss = wsum(ss); const float rinv = rsq_f(ss * (1.0f / 1024.0f) + EPS);
    const float* g = p.in[6] + (size_t)(layer * 3 + k) * 1024; const float* sh = modp(p, layer, r, 3 * k); const float* sc = modp(p, layer, r, 3 * k + 1);
    int row5 = 0, i5 = 0;
    if (s5) { if (r < NL) { const int b = r / SEQ, t = r % SEQ; row5 = b * S5L + t / 32; i5 = t % 32; } else { const int rr = r - NL; const int b = rr / 256, l = rr % 256; row5 = NB * S5L + b * S5C + l / 32; i5 = l % 32; } }
#pragma unroll
    for (int i = 0; i < 4; ++i) { const int d = i * 256 + lane * 4; const f32x4 gv = *(const f32x4*)(g + d), sv = *(const f32x4*)(sc + d), hv = *(const f32x4*)(sh + d); f32x4 o;
        for (int j = 0; j < 4; ++j) o[j] = v[i][j] * rinv * gv[j] * (1.0f + sv[j]) + hv[j];
        if (!s5) st4bf(wsb(p, O_HN) + (size_t)r * 1024 + d, o);
        else st4bf(wsb(p, O_UEXT) + ((size_t)(d >> 4) * NROW5P + row5) * 768 + i5 * 16 + (d & 15), o); } }
__device__ __forceinline__ void mla_row_wave(const P& p, int j, int r, int lane) {
    const float* x = (const float*)(p.ws + O_CALL) + (size_t)r * 768; f32x4 c[3]; float q[3];
#pragma unroll
    for (int i = 0; i < 3; ++i) { c[i] = *(const f32x4*)(x + i * 256 + lane * 4); q[i] = c[i][0] * c[i][0] + c[i][1] * c[i][1] + c[i][2] * c[i][2] + c[i][3] * c[i][3]; }
    const bool lo = lane < 32;
    const float ssq = wsum(q[0] + (lo ? q[1] : 0.f)), sskv = wsum((lo ? 0.f : q[1]) + (lo ? q[2] : 0.f)), ssr = wsum((lane >= 32 && lane < 48) ? q[2] : 0.f);
    const float rq = rsq_f(ssq * (1.0f / 384.0f) + EPS), rkv = rsq_f(sskv * (1.0f / 256.0f) + EPS), rr_ = rsq_f(ssr * (1.0f / 64.0f) + EPS);
    const float* qn = p.in[10] + j * 384; const float* kvn = p.in[11] + j * 256; const float* kg = p.in[15] + j * 192 + 128;
    { const f32x4 gq = *(const f32x4*)(qn + lane * 4); f32x4 o; for (int jx = 0; jx < 4; ++jx) o[jx] = c[0][jx] * rq * gq[jx]; st4bf(wsb(p, O_CQN) + (size_t)r * 384 + lane * 4, o); }
    if (lo) { const f32x4 gq = *(const f32x4*)(qn + 256 + lane * 4); f32x4 o; for (int jx = 0; jx < 4; ++jx) o[jx] = c[1][jx] * rq * gq[jx]; st4bf(wsb(p, O_CQN) + (size_t)r * 384 + 256 + lane * 4, o);
        const f32x4 gk = *(const f32x4*)(kvn + 128 + lane * 4); f32x4 o2; for (int jx = 0; jx < 4; ++jx) o2[jx] = c[2][jx] * rkv * gk[jx]; st4bf(wsb(p, O_CKVN) + (size_t)r * 256 + 128 + lane * 4, o2); }
    else { const f32x4 gk = *(const f32x4*)(kvn + lane * 4 - 128); f32x4 o; for (int jx = 0; jx < 4; ++jx) o[jx] = c[1][jx] * rkv * gk[jx]; st4bf(wsb(p, O_CKVN) + (size_t)r * 256 + lane * 4 - 128, o); }
    const int dd = (4 * (lane - 32)) & 63; const f32x4 gr = *(const f32x4*)(kg + dd); f32x4 own, oth, o;
    for (int jx = 0; jx < 4; ++jx) own[jx] = c[2][jx] * rr_ * gr[jx];
    for (int jx = 0; jx < 4; ++jx) oth[jx] = __shfl_xor(own[jx], 4);
    const int t = r % SEQ, pos = (dd & 32) ? (t % 64) : (t / 64); const bool first = (dd & 16) == 0;
    for (int jx = 0; jx < 4; ++jx) { float cs = 1.f, sn = 0.f; if (r < NL) sincos_t((float)pos * ropef((dd & 15) + jx, 16), sn, cs);
        o[jx] = first ? own[jx] * cs - oth[jx] * sn : own[jx] * cs + oth[jx] * sn; }
    if (lane >= 32 && lane < 48) { u16* kf = wsb(p, O_KF) + (size_t)r * 1536 + 128 + dd;
#pragma unroll
        for (int h = 0; h < 8; ++h) st4bf(kf + h * 192, o); } }
__device__ __forceinline__ float bflo(unsigned w) { return __uint_as_float(w << 16); }
__device__ __forceinline__ float bfhi(unsigned w) { return __uint_as_float(w & 0xffff0000u); }
__device__ __forceinline__ unsigned pk2(float a, float b) { return (unsigned)f2bf(a) | ((unsigned)f2bf(b) << 16); }
__device__ __forceinline__ void mla_head_wave(const P& p, int j, int r, int lane) {
    const int h = lane >> 3, sub = lane & 7;
    u16* q = wsb(p, O_CALL) + (size_t)r * 1536 + h * 192; u16* k = wsb(p, O_KF) + (size_t)r * 1536 + h * 192;
    const float* qg = p.in[14] + j * 192; const float* kg = p.in[15] + j * 192;
    u32x4 qa = *(const u32x4*)(q + sub * 16), qb = *(const u32x4*)(q + sub * 16 + 8), qr = *(const u32x4*)(q + 128 + sub * 8), ka = *(const u32x4*)(k + sub * 16), kb = *(const u32x4*)(k + sub * 16 + 8);
    float sq = 0.f, sk = 0.f, sr = 0.f;
#pragma unroll
    for (int i = 0; i < 4; ++i) { sq += bflo(qa[i]) * bflo(qa[i]) + bfhi(qa[i]) * bfhi(qa[i]) + bflo(qb[i]) * bflo(qb[i]) + bfhi(qb[i]) * bfhi(qb[i]);
        sk += bflo(ka[i]) * bflo(ka[i]) + bfhi(ka[i]) * bfhi(ka[i]) + bflo(kb[i]) * bflo(kb[i]) + bfhi(kb[i]) * bfhi(kb[i]); sr += bflo(qr[i]) * bflo(qr[i]) + bfhi(qr[i]) * bfhi(qr[i]); }
    for (int o = 4; o >= 1; o >>= 1) { sq += __shfl_xor(sq, o); sk += __shfl_xor(sk, o); sr += __shfl_xor(sr, o); }
    const float rq = rsq_f(sq * (1.0f / 128.0f) + EPS), rk = rsq_f(sk * (1.0f / 128.0f) + EPS), rr_ = rsq_f(sr * (1.0f / 64.0f) + EPS);
    u32x4 oa, ob, oka, okb;
#pragma unroll
    for (int i = 0; i < 4; ++i) { const int d = sub * 16 + 2 * i;
        oa[i] = pk2(bflo(qa[i]) * rq * qg[d], bfhi(qa[i]) * rq * qg[d + 1]); ob[i] = pk2(bflo(qb[i]) * rq * qg[d + 8], bfhi(qb[i]) * rq * qg[d + 9]);
        oka[i] = pk2(bflo(ka[i]) * rk * kg[d], bfhi(ka[i]) * rk * kg[d + 1]); okb[i] = pk2(bflo(kb[i]) * rk * kg[d + 8], bfhi(kb[i]) * rk * kg[d + 9]); }
    *(u32x4*)(q + sub * 16) = oa; *(u32x4*)(q + sub * 16 + 8) = ob; *(u32x4*)(k + sub * 16) = oka; *(u32x4*)(k + sub * 16 + 8) = okb;
    const int dd = sub * 8; float own[8], oth[8];
#pragma unroll
    for (int i = 0; i < 4; ++i) { own[2 * i] = bflo(qr[i]) * rr_ * qg[128 + dd + 2 * i]; own[2 * i + 1] = bfhi(qr[i]) * rr_ * qg[128 + dd + 2 * i + 1]; }
#pragma unroll
    for (int i = 0; i < 8; ++i) oth[i] = __shfl_xor(own[i], 2);
    const int t = r % SEQ, pos = (dd & 32) ? (t % 64) : (t / 64); const bool first = (dd & 16) == 0; u32x4 orr; float res[8];
#pragma unroll
    for (int i = 0; i < 8; ++i) { float cs = 1.f, sn = 0.f; if (r < NL) sincos_t((float)pos * ropef((dd & 15) + i, 16), sn, cs); res[i] = first ? own[i] * cs - oth[i] * sn : own[i] * cs + oth[i] * sn; }
#pragma unroll
    for (int i = 0; i < 4; ++i) orr[i] = pk2(res[2 * i], res[2 * i + 1]);
    *(u32x4*)(q + 128 + dd) = orr; }
__device__ __forceinline__ void ret_norm_wave(const P& p, int lr, int lane) {
    const int h = lane >> 4, sub = lane & 15; u16* o = wsb(p, O_OB) + (size_t)lr * 2048 + h * 512 + sub * 32; const u16* g = wsb(p, O_GATE) + (size_t)lr * 2048 + h * 512 + sub * 32; const float* gg = p.in[19] + h * 512 + sub * 32;
    u32x4 ov[4]; float s = 0.f;
#pragma unroll
    for (int i = 0; i < 4; ++i) { ov[i] = *(const u32x4*)(o + i * 8); for (int jx = 0; jx < 4; ++jx) s += bflo(ov[i][jx]) + bfhi(ov[i][jx]); }
    for (int m = 8; m >= 1; m >>= 1) s += __shfl_xor(s, m);
    const float mu = s * (1.0f / 512.0f); float qv = 0.f;
#pragma unroll
    for (int i = 0; i < 4; ++i) for (int jx = 0; jx < 4; ++jx) { const float a = bflo(ov[i][jx]) - mu, b = bfhi(ov[i][jx]) - mu; qv += a * a + b * b; }
    for (int m = 8; m >= 1; m >>= 1) qv += __shfl_xor(qv, m);
    const float rstd = rsq_f(qv * (1.0f / 512.0f) + EPS);
#pragma unroll
    for (int i = 0; i < 4; ++i) { const u32x4 gv = *(const u32x4*)(g + i * 8); u32x4 w;
        for (int jx = 0; jx < 4; ++jx) { const int e = i * 8 + 2 * jx;
            w[jx] = pk2((bflo(ov[i][jx]) - mu) * rstd * gg[e] * silu_f(bflo(gv[jx])), (bfhi(ov[i][jx]) - mu) * rstd * gg[e + 1] * silu_f(bfhi(gv[jx]))); }
        *(u32x4*)(o + i * 8) = w; } }
__device__ __forceinline__ void mod_phase(const P& p, float* tab) {
    for (int i = threadIdx.x; i < NMR * 1024; i += 512) { const int b = i >> 10, k = i & 1023; tab[i] = silu_f(b < NB ? p.in[1][b * 1024 + k] : p.in[3][k]); }
    __syncthreads();
    for (int idx = blockIdx.x * 512 + threadIdx.x; idx < DEPTH * 9216; idx += gridDim.x * 512) {
        const int layer = idx / 9216, col = idx % 9216; const float* w = p.in[4] + (size_t)layer * 1024 * 9216 + col; float acc[NMR];
#pragma unroll
        for (int b = 0; b < NMR; ++b) acc[b] = 0.f;
        for (int k = 0; k < 1024; ++k) { const float wv = w[(size_t)k * 9216];
#pragma unroll
            for (int b = 0; b < NMR; ++b) acc[b] += tab[b * 1024 + k] * wv; }
        const float bias = p.in[5][layer * 9216 + col];
#pragma unroll
        for (int b = 0; b < NMR; ++b) ((float*)(p.ws + O_MOD))[(size_t)(layer * NMR + b) * 9216 + col] = acc[b] + bias; }
    __syncthreads(); }
#define WPASS(N, HOSTCALL, DEVCALL) do { const int _n = (int)(N); int t0_ = threadIdx.x; asm volatile("" : "+v"(t0_)); const int lane = t0_ & 63; for (int it = blockIdx.x * 8 + (t0_ >> 6); it < _n; it += gridDim.x * 8) { DEVCALL; } } while (0)
#define MODPHASE() mod_phase(p, (float*)shm)

namespace cg = cooperative_groups;
#define PASS(N, CALL) do { const long _n = (long)(N); int t0_ = threadIdx.x; asm volatile("" : "+v"(t0_)); for (long it = (long)blockIdx.x * 512 + t0_; it < _n; it += (long)gridDim.x * 512) { CALL; } } while (0)
#define GEMM(D) gemm_run(lds, D)
#define SYNC() grid.sync()
#define HOOK(L, S) do { } while (0)
#define ATTN(NITEMS) do { for (int it = blockIdx.x; it < (NITEMS); it += gridDim.x) { AttItem ai_; att_item(p, it, ai_); att_body(ai_, (char*)shm); } } while (0)
#else
template <class Dsc> static void gemm_emu(const Dsc& D) {
    int n = 0; { Unit u; while (D.unit(n, u)) ++n; }
#pragma omp parallel for schedule(dynamic)
    for (int L = 0; L < n; ++L) { Unit u{}; D.unit(L, u); const int K = Dsc::K;
        std::vector<float> A((size_t)256 * K), B((size_t)256 * K), C((size_t)256 * 256);
        for (int r = 0; r < 256; ++r) for (int k = 0; k < K; ++k) { A[(size_t)r * K + k] = bf2f(u.A[(size_t)r * Dsc::lda + k]); B[(size_t)r * K + k] = bf2f(u.B[(size_t)r * Dsc::ldb + k]); }
        for (int r = 0; r < 256; ++r) for (int c = 0; c < 256; ++c) { float s = 0.f; const float* a = &A[(size_t)r * K]; const float* b = &B[(size_t)c * K]; for (int k = 0; k < K; ++k) s += a[k] * b[k]; C[r * 256 + c] = s; }
        for (int r = 0; r < 128; ++r) for (int c = 0; c < 128; c += 4) { f32x4 v[2][2];
            for (int X = 0; X < 2; ++X) for (int Y = 0; Y < 2; ++Y) for (int j = 0; j < 4; ++j) v[X][Y][j] = C[(r + 128 * X) * 256 + c + 128 * Y + j];
            D.emit(u, r, c, v[0][0], v[0][1], v[1][0], v[1][1]); } } }
static void att_emu(const P& p, int nitems) {
#pragma omp parallel for schedule(dynamic)
    for (int it = 0; it < nitems; ++it) { AttItem a; att_item(p, it, a); std::vector<float> s(a.ntot);
        for (int i = 0; i < 256; ++i) { const u16* q = a.q + (size_t)i * 1536; float l = 0.f; float o[128]; for (int e = 0; e < 128; ++e) o[e] = 0.f;
            for (int k = 0; k < a.ntot; ++k) { const u16* kr = k < a.n0 ? a.k0 + (size_t)k * 1536 : a.k1 + (size_t)(k - a.n0) * 1536; float d = 0.f; for (int x = 0; x < 192; ++x) d += bf2f(q[x]) * bf2f(kr[x]);
                const float pv = bf2f(f2bf(expf(d * ATT_SCALE))); l += expf(d * ATT_SCALE); const u16* vr = k < a.n0 ? a.v0 + (size_t)k * 1024 : a.v1 + (size_t)(k - a.n0) * 1024; for (int e = 0; e < 128; ++e) o[e] += pv * bf2f(vr[e]); }
            for (int e = 0; e < 128; ++e) a.o[(size_t)i * 1024 + e] = f2bf(o[e] / l); } } }
#define PASS(N, CALL) do { const long _n = (long)(N); _Pragma("omp parallel for schedule(static)") for (long it = 0; it < _n; ++it) { CALL; } } while (0)
#define WPASS(N, HOSTCALL, DEVCALL) PASS(N, HOSTCALL)
#define MODPHASE() PASS(DEPTH * 9216, mod_item(p, (int)it))
#define GEMM(D) gemm_emu(D)
#define SYNC() do { } while (0)
#define ATTN(NITEMS) att_emu(p, NITEMS)
static void emu_hook(const P& p, int layer, int stage);
#define HOOK(L, S) emu_hook(p, L, S)
#endif

#ifndef HOST_EMU
__global__ void __launch_bounds__(512) fwd_megakernel(P p) {
    extern __shared__ __attribute__((aligned(16))) unsigned char shm[];
    LAS unsigned char* lds = (LAS unsigned char*)shm;
    cg::grid_group grid = cg::this_grid();
#else
static void fwd_emu(P p) {
#endif
    if (PM(0)) { MODPHASE();
    PASS((long)MT * 256, copy_item(p, it));
    PASS(CV_TOTAL, cvt_item(p, it)); }
    SYNC();
    for (int layer = 0; layer < DEPTH; ++layer) {
        const int kind = layer % 3, j = layer / 3; const bool last = layer == DEPTH - 1;
        if (PM(1)) { WPASS(MT, norm_item(p, layer, 0, (int)it, 0), norm_wave(p, layer, 0, it, 0, lane)); } SYNC();
        if (PM(2)) { DFfnUp d{p, layer, 0}; GEMM(d); } SYNC();
        if (PM(3)) { DFfnDown d{p, layer, 0, MT / 256}; GEMM(d); } SYNC();
        if (kind == 0) {
            if (PM(1)) { WPASS(MT, norm_item(p, layer, 1, (int)it, 0), norm_wave(p, layer, 1, it, 0, lane)); } SYNC();
            if (PM(4)) { DMlaIn d{p, j}; GEMM(d); } SYNC();
            if (PM(5)) { WPASS(MT, mla_row_item(p, j, (int)it), mla_row_wave(p, j, it, lane)); } SYNC();
            if (PM(6)) { DMlaUq d{p, j}; GEMM(d); } if (PM(7)) { DMlaUkv d{p, j}; GEMM(d); } SYNC();
            if (PM(8)) { WPASS(MT, { for (int h_ = 0; h_ < 8; ++h_) mla_head_item(p, j, (int)it * 8 + h_); }, mla_head_wave(p, j, it, lane)); } SYNC();
            if (PM(9)) { ATTN(NB * 8 * (SEQ / 256) + (last ? 0 : NB * 8)); } SYNC();
            if (PM(10)) { DMlaO d{p, layer, j, last ? NL / 256 : MT / 256}; GEMM(d); } SYNC();
        } else if (kind == 1) {
            if (PM(1)) { WPASS(MT, norm_item(p, layer, 1, (int)it, 0), norm_wave(p, layer, 1, it, 0, lane)); } SYNC();
            for (int q = 0; q < NB / RGB; ++q) {
                if (PM(11)) { DRetProj d{p, q}; GEMM(d); } if (PM(12)) { DRetProjT d{p, q}; GEMM(d); } SYNC();
                if (PM(13)) { DRetP d{p}; GEMM(d); } if (PM(14)) { DRetL d{p}; GEMM(d); } SYNC();
                if (PM(15)) { PASS(4 * RGB * 512 * 64, ret_prefix_item(p, (int)it)); } SYNC();
                if (PM(16)) { DRetO d{p}; GEMM(d); } SYNC();
                if (PM(17)) { WPASS(NCQ * 256, { for (int h_ = 0; h_ < 4; ++h_) ret_norm_item(p, (int)it * 4 + h_); }, ret_norm_wave(p, it, lane)); } SYNC();
                if (PM(18)) { DRetWo d{p, layer, q}; GEMM(d); } SYNC();
            }
        } else {
            if (PM(19)) { WPASS(MT, norm_item(p, layer, 1, (int)it, 1), norm_wave(p, layer, 1, it, 1, lane));
            PASS(64 * 2 * 32 * 256, s5_ktab_item(p, (int)it));
            PASS(64 * 256 * 512, s5_fext_item(p, (int)it)); } SYNC();
            if (PM(19)) { PASS((long)64 * 512 * 768, s5_text_item(p, it)); }
            if (PM(20)) { DS5L d{p}; GEMM(d); } SYNC();
            if (PM(21)) { PASS(64 * NB * 64, s5_prefix_item(p, (int)it)); } SYNC();
            if (PM(22)) { DS5Y d{p}; GEMM(d); } SYNC();
            if (PM(23)) { DS5Glu d{p, layer}; GEMM(d); } SYNC();
        }
        HOOK(layer, 0);
        if (PM(1)) { WPASS(last ? NL : MT, norm_item(p, layer, 2, (int)it, 0), norm_wave(p, layer, 2, it, 0, lane)); } SYNC();
        if (PM(2)) { DFfnUp d{p, layer, 1}; GEMM(d); } SYNC();
        if (PM(3)) { DFfnDown d{p, layer, 1, last ? NL / 256 : MT / 256}; GEMM(d); } SYNC();
        HOOK(layer, 1);
    }
}

#ifndef HOST_EMU
extern "C" void kernel_launch(void* const* d_in, const int* in_sizes, int n_in, void* d_out, int out_size, void* d_ws, size_t ws_size, hipStream_t stream) {
    constexpr size_t kDynLds = STAGE_BYTES + 4096;
    static int grid_blocks = 0;
    if (!grid_blocks) {
        int dev = 0, cus = 0, per_cu = 0;
        hipGetDevice(&dev);
        hipDeviceGetAttribute(&cus, hipDeviceAttributeMultiprocessorCount, dev);
        hipFuncSetAttribute((const void*)fwd_megakernel, hipFuncAttributeMaxDynamicSharedMemorySize, (int)kDynLds);
        hipOccupancyMaxActiveBlocksPerMultiprocessor(&per_cu, fwd_megakernel, 512, kDynLds);
        if (per_cu < 1) per_cu = 1;
        if (per_cu > 1) per_cu = 1;
        grid_blocks = cus * per_cu;
        if (ws_size < WS_NEED) fprintf(stderr, "workspace too small: %zu < %zu\n", ws_size, (size_t)WS_NEED);
    }
    P p{};
    for (int i = 0; i < 31 && i < n_in; ++i) p.in[i] = (const float*)d_in[i];
    p.out = (float*)d_out; p.ws = (char*)d_ws;
    void* args[] = {&p};
    hipError_t e = hipLaunchCooperativeKernel((void*)fwd_megakernel, dim3(grid_blocks), dim3(512), args, kDynLds, stream);
    if (e != hipSuccess) fprintf(stderr, "cooperative launch failed: %s (grid %d)\n", hipGetErrorString(e), grid_blocks);
}
#endif
```

```cpp
#ifdef HOST_EMU
#include <cmath>
#include <cstdio>
#include <cstdlib>
#include <cstring>
#include <vector>
#define HD inline
#else
#include <hip/hip_runtime.h>
#include <hip/hip_cooperative_groups.h>
#include <cstdio>
#define HD __device__ __forceinline__
#endif

#ifndef CFG_BATCH
#define CFG_BATCH 16
#endif
#ifndef CFG_SEQ
#define CFG_SEQ 4096
#endif

typedef unsigned short u16;
typedef float f32x4 __attribute__((ext_vector_type(4)));
typedef unsigned u32x2 __attribute__((ext_vector_type(2)));

constexpr int DM = 1024, NB = CFG_BATCH, SEQ = CFG_SEQ, CTX = 256, DFF = 2816, DEPTH = 4;
constexpr int NL = NB * SEQ, NC = NB * CTX, MT = NL + NC;
constexpr int NMR = NB + 1;
constexpr int RGB = (NB >= 4) ? 4 : 1;
constexpr int NCH = 1 + SEQ / 256;
constexpr int NCQ = RGB * NCH;
constexpr int S5L = SEQ / 32, S5C = CTX / 32;
constexpr int NROW5 = NB * S5L + NB * S5C;
constexpr int NROW5P = (NROW5 + 255) / 256 * 256;
constexpr float EPS = 1e-6f;

constexpr size_t al(size_t x) { return (x + 255) & ~(size_t)255; }
constexpr size_t O_MOD = 0;
constexpr size_t O_G = O_MOD + al((size_t)DEPTH * NMR * 9216 * 4);
constexpr size_t O_FFI = O_G + al((size_t)NC * 1024 * 4);
constexpr size_t SZ_FFI1 = (size_t)5632 * 1024 * 2, SZ_FFO1 = (size_t)1024 * 2816 * 2;
constexpr size_t O_FFO = O_FFI + 8 * SZ_FFI1;
constexpr size_t O_MWIN = O_FFO + 8 * SZ_FFO1;
constexpr size_t SZ_MWIN = (size_t)768 * 1024 * 2, SZ_MWUQ = (size_t)1536 * 384 * 2, SZ_MWUKV = (size_t)2048 * 256 * 2, SZ_MWO = (size_t)1024 * 1024 * 2;
constexpr size_t O_MWUQ = O_MWIN + 2 * SZ_MWIN;
constexpr size_t O_MWUKV = O_MWUQ + 2 * SZ_MWUQ;
constexpr size_t O_MWO = O_MWUKV + 2 * SZ_MWUKV;
constexpr size_t O_RWIN = O_MWO + 2 * SZ_MWO;
constexpr size_t O_RWO = O_RWIN + (size_t)6144 * 1024 * 2;
constexpr size_t O_GLU = O_RWO + (size_t)1024 * 2048 * 2;
constexpr size_t O_HN = O_GLU + (size_t)2048 * 1024 * 2;
constexpr size_t O_SCR = O_HN + al((size_t)MT * 1024 * 2);
constexpr size_t O_ACT = O_SCR;
constexpr size_t O_CALL = O_SCR;
constexpr size_t O_CQN = O_CALL + al((size_t)MT * 768 * 4);
constexpr size_t O_CKVN = O_CQN + al((size_t)MT * 384 * 2);
constexpr size_t O_KF = O_CKVN + al((size_t)MT * 256 * 2);
constexpr size_t O_VB = O_KF + al((size_t)MT * 1536 * 2);
constexpr size_t END_MLA = O_VB + al((size_t)MT * 1024 * 2);
constexpr size_t O_QN = O_SCR;
constexpr size_t O_KN = O_QN + al((size_t)NCQ * 256 * 1024 * 2);
constexpr size_t O_GATE = O_KN + al((size_t)NCQ * 256 * 1024 * 2);
constexpr size_t O_OB = O_GATE + al((size_t)NCQ * 256 * 2048 * 2);
constexpr size_t O_AEXT = O_OB + al((size_t)NCQ * 256 * 2048 * 2);
constexpr size_t O_KTX = O_AEXT + al((size_t)4 * NCQ * 256 * 768 * 2);
constexpr size_t O_BEXT = O_KTX + al((size_t)4 * NCQ * 2 * 256 * 256 * 2);
constexpr size_t END_RET = O_BEXT + al((size_t)4 * NCQ * 512 * 768 * 2);
constexpr size_t O_UEXT = O_SCR;
constexpr size_t O_KTAB = O_UEXT + al((size_t)64 * NROW5P * 768 * 2);
constexpr size_t O_TEXT = O_KTAB + al((size_t)64 * 2 * 32 * 256 * 4);
constexpr size_t O_FEXT = O_TEXT + al((size_t)64 * 512 * 768 * 2);
constexpr size_t END_S5 = O_FEXT + al((size_t)64 * 256 * 512 * 2);
constexpr size_t END_FFN = O_ACT + al((size_t)MT * 2816 * 2);
constexpr size_t cmax(size_t a, size_t b) { return a > b ? a : b; }
constexpr size_t WS_NEED = cmax(cmax(END_MLA, END_RET), cmax(END_S5, END_FFN));

struct P { const float* in[32]; float* out; char* ws; };
#ifndef PHASE_MASK
#define PHASE_MASK 0xFFFFFFFFu
#endif
#define PM(b) ((PHASE_MASK >> (b)) & 1u)
#ifndef REP_UP
#define REP_UP 1
#endif
#ifndef REP_ATT
#define REP_ATT 1
#endif
#ifndef REP_NORM
#define REP_NORM 1
#endif

HD float bf2f(u16 b) { union { unsigned u; float f; } x; x.u = ((unsigned)b) << 16; return x.f; }
HD u16 f2bf(float f) { union { unsigned u; float f; } x; x.f = f; unsigned u = x.u; u += 0x7fffu + ((u >> 16) & 1u); return (u16)(u >> 16); }
#ifdef HOST_EMU
HD void st4bf(u16* p, f32x4 v) { u32x2 w; w.x = (unsigned)f2bf(v[0]) | ((unsigned)f2bf(v[1]) << 16); w.y = (unsigned)f2bf(v[2]) | ((unsigned)f2bf(v[3]) << 16); *(u32x2*)p = w; }
#else
HD unsigned cvtpk_bf(float lo, float hi) { unsigned r; asm("v_cvt_pk_bf16_f32 %0, %1, %2" : "=v"(r) : "v"(lo), "v"(hi)); return r; }
HD void st4bf(u16* p, f32x4 v) { u32x2 w; w.x = cvtpk_bf(v[0], v[1]); w.y = cvtpk_bf(v[2], v[3]); *(u32x2*)p = w; }
#endif
#ifdef HOST_EMU
HD float silu_f(float a) { return a / (1.0f + expf(-a)); }
HD float sigm_f(float a) { return 1.0f / (1.0f + expf(-a)); }
HD float gelu_f(float x) { return 0.5f * x * (1.0f + tanhf(0.7978845608028654f * (x + 0.044715f * x * x * x))); }
#else
HD float sigm_f(float a) { return __builtin_amdgcn_rcpf(1.0f + __builtin_amdgcn_exp2f(-1.4426950408889634f * a)); }
HD float silu_f(float a) { return a * sigm_f(a); }
HD float gelu_f(float x) { return x * sigm_f(1.5957691216057308f * (x + 0.044715f * x * x * x)); }
#endif
HD float rsq_f(float x) { return 1.0f / sqrtf(x); }
HD float ex2(float x) {
#ifdef HOST_EMU
    return exp2f(x);
#else
    return __builtin_amdgcn_exp2f(x);
#endif
}
HD float* hrow(const P& p, int r) { return r < NL ? p.out + (size_t)r * 1024 : (float*)(p.ws + O_G) + (size_t)(r - NL) * 1024; }
HD const float* modp(const P& p, int layer, int r, int idx) { const int mr = r < NL ? r / SEQ : NB; return (const float*)(p.ws + O_MOD) + ((size_t)(layer * NMR + mr) * 9 + idx) * 1024; }
HD u16* wsb(const P& p, size_t off) { return (u16*)(p.ws + off); }
#ifdef HOST_EMU
HD float ropef(int d, int half) { return expf(-(float)d * (9.210340371976184f / (float)half)) * 0.15915494309189535f; }
#else
HD float ropef(int d, int half) { return __builtin_amdgcn_exp2f(-(float)d * (13.287712379549449f / (float)half)) * 0.15915494309189535f; }
#endif
HD void sincos_t(float turns, float& sn, float& cs) {
    const float f = turns - floorf(turns);
#ifdef HOST_EMU
    sn = sinf(6.283185307179586f * f); cs = cosf(6.283185307179586f * f);
#else
    sn = __builtin_amdgcn_sinf(f); cs = __builtin_amdgcn_cosf(f);
#endif
}

HD bool rect_unit(int L, int nM, int nN, int& pm, int& pn) {
    const int nwg = nM * nN; if (L >= nwg) return false;
    int wgid = L; { const int q = nwg / 8, r = nwg % 8, xcd = wgid % 8, off = wgid / 8; wgid = (xcd < r ? xcd * (q + 1) : r * (q + 1) + (xcd - r) * q) + off; }
    const int nig = 8 * nN, gid = wgid / nig, fm = gid * 8, gsz = (nM - fm) < 8 ? (nM - fm) : 8;
    pm = fm + ((wgid % nig) % gsz); pn = (wgid % nig) / gsz; return true;
}

struct Unit { const u16* A; const u16* B; int a, b, c, d; float f0, f1; };

struct DFfnUp { P p; int layer, f; static constexpr int K = 1024, lda = 1024, ldb = 1024;
    HD bool unit(int L, Unit& u) const { int pm, pn; if (!rect_unit(L, MT / 256, 22, pm, pn)) return false;
        u.A = wsb(p, O_HN) + (size_t)pm * 256 * 1024; u.B = wsb(p, O_FFI + (size_t)(layer * 2 + f) * SZ_FFI1) + (size_t)pn * 256 * 1024; u.a = pm; u.b = pn; u.c = 0; u.d = 0; return true; }
    HD void emit(const Unit& u, int r, int c, f32x4 v00, f32x4 v01, f32x4 v10, f32x4 v11) const {
        u16* act = wsb(p, O_ACT); const size_t R = (size_t)u.a * 256 + r; const int col = u.b * 128 + c; f32x4 o0, o1;
        for (int j = 0; j < 4; ++j) { o0[j] = silu_f(v00[j]) * v01[j]; o1[j] = silu_f(v10[j]) * v11[j]; }
        st4bf(act + R * 2816 + col, o0); st4bf(act + (R + 128) * 2816 + col, o1); } };

HD void resid4(const P& p, int layer, int midx, float sc, int R, int col, f32x4 v) {
    float* h = hrow(p, R) + col; const float* m = modp(p, layer, R, midx) + col; f32x4 x = *(f32x4*)h;
    for (int j = 0; j < 4; ++j) x[j] += sc * m[j] * v[j];
    *(f32x4*)h = x; }

struct DFfnDown { P p; int layer, f, nM; static constexpr int K = 2816, lda = 2816, ldb = 2816;
    HD bool unit(int L, Unit& u) const { int pm, pn; if (!rect_unit(L, nM, 4, pm, pn)) return false;
        u.A = wsb(p, O_ACT) + (size_t)pm * 256 * 2816; u.B = wsb(p, O_FFO + (size_t)(layer * 2 + f) * SZ_FFO1) + (size_t)pn * 256 * 2816; u.a = pm; u.b = pn; u.c = 0; u.d = 0; return true; }
    HD void emit(const Unit& u, int r, int c, f32x4 v00, f32x4 v01, f32x4 v10, f32x4 v11) const {
        const int R = u.a * 256 + r, col = u.b * 256 + c, mi = f ? 8 : 2;
        resid4(p, layer, mi, 0.5f, R, col, v00); resid4(p, layer, mi, 0.5f, R, col + 128, v01); resid4(p, layer, mi, 0.5f, R + 128, col, v10); resid4(p, layer, mi, 0.5f, R + 128, col + 128, v11); } };

struct DMlaIn { P p; int j; static constexpr int K = 1024, lda = 1024, ldb = 1024;
    HD bool unit(int L, Unit& u) const { int pm, pn; if (!rect_unit(L, MT / 256, 3, pm, pn)) return false;
        u.A = wsb(p, O_HN) + (size_t)pm * 256 * 1024; u.B = wsb(p, O_MWIN + j * SZ_MWIN) + (size_t)pn * 256 * 1024; u.a = pm; u.b = pn; u.c = 0; u.d = 0; return true; }
    HD void emit(const Unit& u, int r, int c, f32x4 v00, f32x4 v01, f32x4 v10, f32x4 v11) const {
        float* o = (float*)(p.ws + O_CALL) + ((size_t)u.a * 256 + r) * 768 + u.b * 256 + c;
        *(f32x4*)o = v00; *(f32x4*)(o + 128) = v01; *(f32x4*)(o + (size_t)128 * 768) = v10; *(f32x4*)(o + (size_t)128 * 768 + 128) = v11; } };
struct DMlaUq { P p; int j; static constexpr int K = 384, lda = 384, ldb = 384;
    HD bool unit(int L, Unit& u) const { int pm, pn; if (!rect_unit(L, MT / 256, 6, pm, pn)) return false;
        u.A = wsb(p, O_CQN) + (size_t)pm * 256 * 384; u.B = wsb(p, O_MWUQ + j * SZ_MWUQ) + (size_t)pn * 256 * 384; u.a = pm; u.b = pn; u.c = 0; u.d = 0; return true; }
    HD void emit(const Unit& u, int r, int c, f32x4 v00, f32x4 v01, f32x4 v10, f32x4 v11) const {
        u16* o = wsb(p, O_CALL) + ((size_t)u.a * 256 + r) * 1536 + u.b * 256 + c;
        st4bf(o, v00); st4bf(o + 128, v01); st4bf(o + (size_t)128 * 1536, v10); st4bf(o + (size_t)128 * 1536 + 128, v11); } };
struct DMlaUkv { P p; int j; static constexpr int K = 256, lda = 256, ldb = 256;
    HD bool unit(int L, Unit& u) const { int pm, pn; if (!rect_unit(L, MT / 256, 8, pm, pn)) return false;
        u.A = wsb(p, O_CKVN) + (size_t)pm * 256 * 256; u.B = wsb(p, O_MWUKV + j * SZ_MWUKV) + (size_t)pn * 256 * 256; u.a = pm; u.b = pn; u.c = 0; u.d = 0; return true; }
    HD void one(size_t R, int col, f32x4 v) const {
        if (col < 1024) st4bf(wsb(p, O_KF) + R * 1536 + (col >> 7) * 192 + (col & 127), v);
        else st4bf(wsb(p, O_VB) + R * 1024 + (col - 1024), v); }
    HD void emit(const Unit& u, int r, int c, f32x4 v00, f32x4 v01, f32x4 v10, f32x4 v11) const {
        const size_t R = (size_t)u.a * 256 + r; const int col = u.b * 256 + c;
        one(R, col, v00); one(R, col + 128, v01); one(R + 128, col, v10); one(R + 128, col + 128, v11); } };
struct DMlaO { P p; int layer, j, nM; static constexpr int K = 1024, lda = 1024, ldb = 1024;
    HD bool unit(int L, Unit& u) const { int pm, pn; if (!rect_unit(L, nM, 4, pm, pn)) return false;
        u.A = wsb(p, O_HN) + (size_t)pm * 256 * 1024; u.B = wsb(p, O_MWO + j * SZ_MWO) + (size_t)pn * 256 * 1024; u.a = pm; u.b = pn; u.c = 0; u.d = 0; return true; }
    HD void emit(const Unit& u, int r, int c, f32x4 v00, f32x4 v01, f32x4 v10, f32x4 v11) const {
        const int R = u.a * 256 + r, col = u.b * 256 + c;
        resid4(p, layer, 5, 1.0f, R, col, v00); resid4(p, layer, 5, 1.0f, R, col + 128, v01); resid4(p, layer, 5, 1.0f, R + 128, col, v10); resid4(p, layer, 5, 1.0f, R + 128, col + 128, v11); } };

HD int ret_tokrow(int q, int cidx) { const int b = q * RGB + cidx / NCH, n = cidx % NCH; return n == 0 ? NL + b * 256 : b * SEQ + (n - 1) * 256; }
HD float ret_logg(const P& p, int dir, int h) { return log1pf(-expf(p.in[18][dir * 4 + h])); }
struct DRetProj { P p; int q; static constexpr int K = 1024, lda = 1024, ldb = 1024;
    HD bool unit(int L, Unit& u) const { int pm, pn; if (!rect_unit(L, NCQ, 16, pm, pn)) return false;
        const int wrow = pn < 8 ? pn * 256 : 4096 + (pn - 8) * 256;
        u.A = wsb(p, O_HN) + (size_t)ret_tokrow(q, pm) * 1024; u.B = wsb(p, O_RWIN) + (size_t)wrow * 1024; u.a = pm; u.b = pn; u.c = 0; u.d = 0;
        u.f0 = ret_logg(p, 0, pn & 3) * 1.4426950408889634f; u.f1 = ret_logg(p, 1, pn & 3) * 1.4426950408889634f; return true; }
    HD void emit(const Unit& u, int r, int c, f32x4 v00, f32x4 v01, f32x4 v10, f32x4 v11) const {
        const int cidx = u.a, pn = u.b, n = cidx % NCH;
        if (pn >= 8) { u16* g = wsb(p, O_GATE) + ((size_t)cidx * 256 + r) * 2048 + (pn - 8) * 256 + c;
            st4bf(g, v00); st4bf(g + 128, v01); st4bf(g + (size_t)128 * 2048, v10); st4bf(g + (size_t)128 * 2048 + 128, v11); return; }
        const int h = pn & 3; const bool isq = pn < 4;
        const float lgf = u.f0, lgb = u.f1;
        for (int X = 0; X < 2; ++X) { const int i = r + 128 * X; const f32x4 x1 = X ? v10 : v00, x2 = X ? v11 : v01; f32x4 r1, r2;
            for (int jx = 0; jx < 4; ++jx) { float cs = 1.f, sn = 0.f;
                if (n > 0) sincos_t((float)((n - 1) * 256 + i) * ropef(c + jx, 128), sn, cs);
                r1[jx] = x1[jx] * cs - x2[jx] * sn; r2[jx] = x2[jx] * cs + x1[jx] * sn; }
            if (isq) { u16* qn = wsb(p, O_QN) + ((size_t)cidx * 256 + i) * 1024 + h * 256 + c; st4bf(qn, r1); st4bf(qn + 128, r2);
                const float df = ex2(lgf * (float)(i + 1)), db = ex2(lgb * (float)(256 - i));
                u16* ae = wsb(p, O_AEXT) + (((size_t)h * NCQ + cidx) * 256 + i) * 768;
                st4bf(ae + 256 + c, r1 * df); st4bf(ae + 384 + c, r2 * df); st4bf(ae + 512 + c, r1 * db); st4bf(ae + 640 + c, r2 * db); }
            else { u16* kn = wsb(p, O_KN) + ((size_t)cidx * 256 + i) * 1024 + h * 256 + c; st4bf(kn, r1 * 0.0625f); st4bf(kn + 128, r2 * 0.0625f); } } } };
struct DRetProjT { P p; int q; static constexpr int K = 1024, lda = 1024, ldb = 1024;
    HD bool unit(int L, Unit& u) const { int pm, pn; if (!rect_unit(L, 12, NCQ, pm, pn)) return false;
        u.A = wsb(p, O_RWIN) + (size_t)(1024 + pm * 256) * 1024; u.B = wsb(p, O_HN) + (size_t)ret_tokrow(q, pn) * 1024; u.a = pm; u.b = pn; u.c = 0; u.d = 0;
        u.f0 = ret_logg(p, 0, pm & 3) * 1.4426950408889634f; u.f1 = ret_logg(p, 1, pm & 3) * 1.4426950408889634f; return true; }
    HD void emit(const Unit& u, int r, int c, f32x4 v00, f32x4 v01, f32x4 v10, f32x4 v11) const {
        const int pm = u.a, cidx = u.b, n = cidx % NCH;
        if (pm >= 4) { const int h = (pm - 4) >> 1, e0 = ((pm - 4) & 1) * 256 + r; u16* be = wsb(p, O_BEXT) + (((size_t)h * NCQ + cidx) * 512 + e0) * 768 + c;
            st4bf(be, v00); st4bf(be + 128, v01); st4bf(be + (size_t)128 * 768, v10); st4bf(be + (size_t)128 * 768 + 128, v11); return; }
        const int h = pm; const float lgf = u.f0, lgb = u.f1, fr = ropef(r, 128);
        u16* kf = wsb(p, O_KTX) + (((size_t)h * NCQ + cidx) * 2 + 0) * 65536; u16* kb = kf + 65536;
        for (int Y = 0; Y < 2; ++Y) { const f32x4 x1 = Y ? v01 : v00, x2 = Y ? v11 : v10; f32x4 f1, f2, b1, b2;
            for (int jx = 0; jx < 4; ++jx) { const int jj = c + 128 * Y + jx; float cs = 1.f, sn = 0.f;
                if (n > 0) sincos_t((float)((n - 1) * 256 + jj) * fr, sn, cs);
                const float r1 = (x1[jx] * cs - x2[jx] * sn) * 0.0625f, r2 = (x2[jx] * cs + x1[jx] * sn) * 0.0625f;
                const float df = ex2(lgf * (float)(255 - jj)), db = ex2(lgb * (float)jj);
                f1[jx] = r1 * df; f2[jx] = r2 * df; b1[jx] = r1 * db; b2[jx] = r2 * db; }
            const int jc = c + 128 * Y;
            st4bf(kf + (size_t)r * 256 + jc, f1); st4bf(kf + (size_t)(r + 128) * 256 + jc, f2); st4bf(kb + (size_t)r * 256 + jc, b1); st4bf(kb + (size_t)(r + 128) * 256 + jc, b2); } } };
struct DRetP { P p; static constexpr int K = 256, lda = 1024, ldb = 1024;
    HD bool unit(int L, Unit& u) const { int pm, pn; if (!rect_unit(L, NCQ, 4, pm, pn)) return false;
        u.A = wsb(p, O_QN) + (size_t)pm * 256 * 1024 + pn * 256; u.B = wsb(p, O_KN) + (size_t)pm * 256 * 1024 + pn * 256; u.a = pm; u.b = pn; u.c = 0; u.d = 0;
        u.f0 = ret_logg(p, 0, pn) * 1.4426950408889634f; u.f1 = ret_logg(p, 1, pn) * 1.4426950408889634f; return true; }
    HD void one(u16* ae, float lgf, float lgb, int i, int j0, f32x4 v) const { f32x4 o;
        for (int jx = 0; jx < 4; ++jx) { const int jj = j0 + jx; o[jx] = v[jx] * ex2(jj <= i ? lgf * (float)(i - jj) : lgb * (float)(jj - i)); }
        st4bf(ae + (size_t)i * 768 + j0, o); }
    HD void emit(const Unit& u, int r, int c, f32x4 v00, f32x4 v01, f32x4 v10, f32x4 v11) const {
        const int cidx = u.a, h = u.b; const float lgf = u.f0, lgb = u.f1;
        u16* ae = wsb(p, O_AEXT) + ((size_t)h * NCQ + cidx) * 256 * 768;
        one(ae, lgf, lgb, r, c, v00); one(ae, lgf, lgb, r, c + 128, v01); one(ae, lgf, lgb, r + 128, c, v10); one(ae, lgf, lgb, r + 128, c + 128, v11); } };
struct DRetL { P p; static constexpr int K = 256, lda = 768, ldb = 256;
    HD bool unit(int L, Unit& u) const { int pm, pn; if (!rect_unit(L, 4 * NCQ, 4, pm, pn)) return false;
        const int dir = pn >> 1, eh = pn & 1;
        u.A = wsb(p, O_BEXT) + ((size_t)pm * 512 + eh * 256) * 768; u.B = wsb(p, O_KTX) + ((size_t)pm * 2 + dir) * 65536; u.a = pm; u.b = dir; u.c = eh; u.d = 0; return true; }
    HD void emit(const Unit& u, int r, int c, f32x4 v00, f32x4 v01, f32x4 v10, f32x4 v11) const {
        u16* o = wsb(p, O_BEXT) + ((size_t)u.a * 512 + u.c * 256 + r) * 768 + 256 + u.b * 256 + c;
        st4bf(o, v00); st4bf(o + 128, v01); st4bf(o + (size_t)128 * 768, v10); st4bf(o + (size_t)128 * 768 + 128, v11); } };
struct DRetO { P p; static constexpr int K = 768, lda = 768, ldb = 768;
    HD bool unit(int L, Unit& u) const { int pm, pn; if (!rect_unit(L, 4 * NCQ, 2, pm, pn)) return false;
        u.A = wsb(p, O_AEXT) + (size_t)pm * 256 * 768; u.B = wsb(p, O_BEXT) + ((size_t)pm * 512 + pn * 256) * 768; u.a = pm; u.b = pn; u.c = 0; u.d = 0; return true; }
    HD void emit(const Unit& u, int r, int c, f32x4 v00, f32x4 v01, f32x4 v10, f32x4 v11) const {
        const int h = u.a / NCQ, cidx = u.a % NCQ;
        u16* o = wsb(p, O_OB) + ((size_t)cidx * 256 + r) * 2048 + h * 512 + u.b * 256 + c;
        st4bf(o, v00); st4bf(o + 128, v01); st4bf(o + (size_t)128 * 2048, v10); st4bf(o + (size_t)128 * 2048 + 128, v11); } };
struct DRetWo { P p; int layer, q; static constexpr int K = 2048, lda = 2048, ldb = 2048;
    HD bool unit(int L, Unit& u) const { int pm, pn; if (!rect_unit(L, NCQ, 4, pm, pn)) return false;
        u.A = wsb(p, O_OB) + (size_t)pm * 256 * 2048; u.B = wsb(p, O_RWO) + (size_t)pn * 256 * 2048; u.a = ret_tokrow(q, pm); u.b = pn; u.c = 0; u.d = 0; return true; }
    HD void emit(const Unit& u, int r, int c, f32x4 v00, f32x4 v01, f32x4 v10, f32x4 v11) const {
        const int R = u.a + r, col = u.b * 256 + c;
        resid4(p, layer, 5, 1.0f, R, col, v00); resid4(p, layer, 5, 1.0f, R, col + 128, v01); resid4(p, layer, 5, 1.0f, R + 128, col, v10); resid4(p, layer, 5, 1.0f, R + 128, col + 128, v11); } };

struct DS5L { P p; static constexpr int K = 512, lda = 768, ldb = 512;
    HD bool unit(int L, Unit& u) const { int pm, pn; if (!rect_unit(L, NROW5P / 256, 64, pm, pn)) return false;
        u.A = wsb(p, O_UEXT) + ((size_t)pn * NROW5P + pm * 256) * 768; u.B = wsb(p, O_FEXT) + (size_t)pn * 256 * 512; u.a = pm; u.b = pn; u.c = 0; u.d = 0; return true; }
    HD void emit(const Unit& u, int r, int c, f32x4 v00, f32x4 v01, f32x4 v10, f32x4 v11) const {
        u16* o = wsb(p, O_UEXT) + ((size_t)u.b * NROW5P + u.a * 256 + r) * 768 + 512 + c;
        st4bf(o, v00); st4bf(o + 128, v01); st4bf(o + (size_t)128 * 768, v10); st4bf(o + (size_t)128 * 768 + 128, v11); } };
struct DS5Y { P p; static constexpr int K = 768, lda = 768, ldb = 768;
    HD bool unit(int L, Unit& u) const { int pm, pn; if (!rect_unit(L, NROW5P / 256, 128, pm, pn)) return false;
        const int g = pn >> 1, ch = pn & 1;
        u.A = wsb(p, O_UEXT) + ((size_t)g * NROW5P + pm * 256) * 768; u.B = wsb(p, O_TEXT) + ((size_t)g * 512 + ch * 256) * 768; u.a = pm; u.b = g; u.c = ch; u.d = 0; return true; }
    HD void one(int g, int row, int col, f32x4 v) const {
        int tok; if (row < NB * S5L) tok = (row / S5L) * SEQ + (row % S5L) * 32; else if (row < NROW5) { const int rr = row - NB * S5L; tok = NL + (rr / S5C) * 256 + (rr % S5C) * 32; } else return;
        f32x4 o; for (int jx = 0; jx < 4; ++jx) o[jx] = gelu_f(v[jx]);
        st4bf(wsb(p, O_HN) + (size_t)(tok + (col >> 4)) * 1024 + g * 16 + (col & 15), o); }
    HD void emit(const Unit& u, int r, int c, f32x4 v00, f32x4 v01, f32x4 v10, f32x4 v11) const {
        const int row = u.a * 256 + r, col = u.c * 256 + c;
        one(u.b, row, col, v00); one(u.b, row, col + 128, v01); one(u.b, row + 128, col, v10); one(u.b, row + 128, col + 128, v11); } };
struct DS5Glu { P p; int layer; static constexpr int K = 1024, lda = 1024, ldb = 1024;
    HD bool unit(int L, Unit& u) const { int pm, pn; if (!rect_unit(L, MT / 256, 8, pm, pn)) return false;
        u.A = wsb(p, O_HN) + (size_t)pm * 256 * 1024; u.B = wsb(p, O_GLU) + (size_t)pn * 256 * 1024; u.a = pm; u.b = pn; u.c = 0; u.d = 0; return true; }
    HD void emit(const Unit& u, int r, int c, f32x4 v00, f32x4 v01, f32x4 v10, f32x4 v11) const {
        const int col = u.b * 128 + c; const float* gb = p.in[30]; f32x4 y0, y1;
        for (int jx = 0; jx < 4; ++jx) { const float ba = gb[col + jx], bg = gb[1024 + col + jx];
            y0[jx] = (v00[jx] + ba) * sigm_f(v01[jx] + bg); y1[jx] = (v10[jx] + ba) * sigm_f(v11[jx] + bg); }
        resid4(p, layer, 5, 1.0f, u.a * 256 + r, col, y0); resid4(p, layer, 5, 1.0f, u.a * 256 + r + 128, col, y1); } };

HD void cvt8(const float* src, int N, int srccol, u16* dst, int Kd, int nrow, int k0) {
    f32x4 a, b;
    for (int j = 0; j < 4; ++j) { a[j] = srccol >= 0 ? src[(size_t)(k0 + j) * N + srccol] : 0.f; b[j] = srccol >= 0 ? src[(size_t)(k0 + 4 + j) * N + srccol] : 0.f; }
    st4bf(dst + (size_t)nrow * Kd + k0, a); st4bf(dst + (size_t)nrow * Kd + k0 + 4, b); }
constexpr long CV_FFI = (long)8 * 5632 * 128, CV_FFO = (long)8 * 1024 * 352, CV_MWIN = (long)2 * 768 * 128, CV_MWUQ = (long)2 * 1536 * 48, CV_MWUKV = (long)2 * 2048 * 32,
               CV_MWO = (long)2 * 1024 * 128, CV_RWIN = (long)6144 * 128, CV_RWO = (long)1024 * 256, CV_GLU = (long)2048 * 128;
constexpr long CV_TOTAL = CV_FFI + CV_FFO + CV_MWIN + CV_MWUQ + CV_MWUKV + CV_MWO + CV_RWIN + CV_RWO + CV_GLU;
HD void cvt_item(const P& p, long idx) {
    if (idx < CV_FFI) { const int n = (int)(idx % 5632); const long t = idx / 5632; const int kb = (int)(t % 128), m = (int)(t / 128);
        const int tile = n >> 8, rr = n & 255; const int sc = rr < 128 ? tile * 128 + rr : 2816 + tile * 128 + (rr - 128);
        cvt8(p.in[7] + (size_t)m * 1024 * 5632, 5632, sc, wsb(p, O_FFI + (size_t)m * SZ_FFI1), 1024, n, kb * 8); return; }
    idx -= CV_FFI;
    if (idx < CV_FFO) { const int n = (int)(idx % 1024); const long t = idx / 1024; const int kb = (int)(t % 352), m = (int)(t / 352);
        cvt8(p.in[8] + (size_t)m * 2816 * 1024, 1024, n, wsb(p, O_FFO + (size_t)m * SZ_FFO1), 2816, n, kb * 8); return; }
    idx -= CV_FFO;
    if (idx < CV_MWIN) { const int n = (int)(idx % 768); const long t = idx / 768; const int kb = (int)(t % 128), m = (int)(t / 128);
        cvt8(p.in[9] + (size_t)m * 1024 * 704, 704, n < 704 ? n : -1, wsb(p, O_MWIN + (size_t)m * SZ_MWIN), 1024, n, kb * 8); return; }
    idx -= CV_MWIN;
    if (idx < CV_MWUQ) { const int n = (int)(idx % 1536); const long t = idx / 1536; const int kb = (int)(t % 48), m = (int)(t / 48);
        cvt8(p.in[12] + (size_t)m * 384 * 1536, 1536, n, wsb(p, O_MWUQ + (size_t)m * SZ_MWUQ), 384, n, kb * 8); return; }
    idx -= CV_MWUQ;
    if (idx < CV_MWUKV) { const int n = (int)(idx % 2048); const long t = idx / 2048; const int kb = (int)(t % 32), m = (int)(t / 32);
        const int sc = n < 1024 ? (n >> 7) * 256 + (n & 127) : ((n - 1024) >> 7) * 256 + 128 + (n & 127);
        cvt8(p.in[13] + (size_t)m * 256 * 2048, 2048, sc, wsb(p, O_MWUKV + (size_t)m * SZ_MWUKV), 256, n, kb * 8); return; }
    idx -= CV_MWUKV;
    if (idx < CV_MWO) { const int n = (int)(idx % 1024); const long t = idx / 1024; const int kb = (int)(t % 128), m = (int)(t / 128);
        cvt8(p.in[16] + (size_t)m * 1024 * 1024, 1024, n, wsb(p, O_MWO + (size_t)m * SZ_MWO), 1024, n, kb * 8); return; }
    idx -= CV_MWO;
    if (idx < CV_RWIN) { const int n = (int)(idx % 6144), kb = (int)(idx / 6144); cvt8(p.in[17], 6144, n, wsb(p, O_RWIN), 1024, n, kb * 8); return; }
    idx -= CV_RWIN;
    if (idx < CV_RWO) { const int n = (int)(idx % 1024), kb = (int)(idx / 1024); cvt8(p.in[20], 1024, n, wsb(p, O_RWO), 2048, n, kb * 8); return; }
    idx -= CV_RWO;
    { const int n = (int)(idx % 2048), kb = (int)(idx / 2048); const int tile = n >> 8, rr = n & 255; const int sc = rr < 128 ? tile * 128 + rr : 1024 + tile * 128 + (rr - 128);
      cvt8(p.in[29], 2048, sc, wsb(p, O_GLU), 1024, n, kb * 8); }
}
HD void mod_item(const P& p, int idx) {
    const int layer = idx / 9216, col = idx % 9216; const float* w = p.in[4] + (size_t)layer * 1024 * 9216 + col; float acc[NMR];
    for (int b = 0; b < NMR; ++b) acc[b] = 0.f;
    for (int k = 0; k < 1024; ++k) { const float wv = w[(size_t)k * 9216];
#pragma unroll
        for (int b = 0; b < NMR; ++b) { const float cv = b < NB ? p.in[1][b * 1024 + k] : p.in[3][k]; acc[b] += silu_f(cv) * wv; } }
    const float bias = p.in[5][layer * 9216 + col];
#pragma unroll
    for (int b = 0; b < NMR; ++b) ((float*)(p.ws + O_MOD))[(size_t)(layer * NMR + b) * 9216 + col] = acc[b] + bias; }
HD void copy_item(const P& p, long idx) {
    const long nl4 = (long)NL * 256;
    if (idx < nl4) ((f32x4*)p.out)[idx] = ((const f32x4*)p.in[0])[idx]; else ((f32x4*)(p.ws + O_G))[idx - nl4] = ((const f32x4*)p.in[2])[idx - nl4]; }
HD void norm_item(const P& p, int layer, int k, int r, int s5) {
    const float* x = hrow(p, r); float ss = 0.f;
    for (int d = 0; d < 1024; d += 4) { const f32x4 v = *(const f32x4*)(x + d); ss += v[0] * v[0] + v[1] * v[1] + v[2] * v[2] + v[3] * v[3]; }
    const float rinv = rsq_f(ss * (1.0f / 1024.0f) + EPS);
    const float* g = p.in[6] + (size_t)(layer * 3 + k) * 1024; const float* sh = modp(p, layer, r, 3 * k); const float* sc = modp(p, layer, r, 3 * k + 1);
    int row5 = 0, i5 = 0;
    if (s5) { if (r < NL) { const int b = r / SEQ, t = r % SEQ; row5 = b * S5L + t / 32; i5 = t % 32; } else { const int rr = r - NL; const int b = rr / 256, l = rr % 256; row5 = NB * S5L + b * S5C + l / 32; i5 = l % 32; } }
    for (int d = 0; d < 1024; d += 4) { const f32x4 v = *(const f32x4*)(x + d); f32x4 o;
        for (int j = 0; j < 4; ++j) o[j] = v[j] * rinv * g[d + j] * (1.0f + sc[d + j]) + sh[d + j];
        if (!s5) st4bf(wsb(p, O_HN) + (size_t)r * 1024 + d, o);
        else st4bf(wsb(p, O_UEXT) + ((size_t)(d >> 4) * NROW5P + row5) * 768 + i5 * 16 + (d & 15), o); } }
HD void axial_rot64(float* v, int t) {
    const int prow = t / 64, pcol = t % 64;
    for (int f = 0; f < 16; ++f) { const float fq = ropef(f, 16);
        { float cs, sn; sincos_t((float)prow * fq, sn, cs); const float x1 = v[f], x2 = v[16 + f]; v[f] = x1 * cs - x2 * sn; v[16 + f] = x2 * cs + x1 * sn; }
        { float cs, sn; sincos_t((float)pcol * fq, sn, cs); const float x1 = v[32 + f], x2 = v[48 + f]; v[32 + f] = x1 * cs - x2 * sn; v[48 + f] = x2 * cs + x1 * sn; } } }
HD void mla_row_item(const P& p, int j, int r) {
    const float* x = (const float*)(p.ws + O_CALL) + (size_t)r * 768; float ss = 0.f;
    for (int d = 0; d < 384; ++d) ss += x[d] * x[d];
    float rinv = rsq_f(ss * (1.0f / 384.0f) + EPS); const float* qn = p.in[10] + j * 384;
    for (int d = 0; d < 384; d += 4) { f32x4 o; for (int jx = 0; jx < 4; ++jx) o[jx] = x[d + jx] * rinv * qn[d + jx]; st4bf(wsb(p, O_CQN) + (size_t)r * 384 + d, o); }
    ss = 0.f; for (int d = 0; d < 256; ++d) ss += x[384 + d] * x[384 + d];
    rinv = rsq_f(ss * (1.0f / 256.0f) + EPS); const float* kvn = p.in[11] + j * 256;
    for (int d = 0; d < 256; d += 4) { f32x4 o; for (int jx = 0; jx < 4; ++jx) o[jx] = x[384 + d + jx] * rinv * kvn[d + jx]; st4bf(wsb(p, O_CKVN) + (size_t)r * 256 + d, o); }
    ss = 0.f; for (int d = 0; d < 64; ++d) ss += x[640 + d] * x[640 + d];
    rinv = rsq_f(ss * (1.0f / 64.0f) + EPS); const float* kg = p.in[15] + j * 192 + 128;
#ifdef HOST_EMU
    float kr[64];
    for (int d = 0; d < 64; ++d) kr[d] = x[640 + d] * rinv * kg[d];
    if (r < NL) axial_rot64(kr, r % SEQ);
    for (int h = 0; h < 8; ++h) for (int d = 0; d < 64; ++d) wsb(p, O_KF)[(size_t)r * 1536 + h * 192 + 128 + d] = f2bf(kr[d]);
#else
    const int t = r % SEQ, prow = t / 64, pcol = t % 64;
    for (int f = 0; f < 16; ++f) { const float fq = ropef(f, 16);
#pragma unroll
        for (int part = 0; part < 2; ++part) { float cs = 1.f, sn = 0.f; if (r < NL) sincos_t((float)(part ? pcol : prow) * fq, sn, cs);
            const int d1 = part * 32 + f, d2 = d1 + 16; const float x1 = x[640 + d1] * rinv * kg[d1], x2 = x[640 + d2] * rinv * kg[d2];
            const u16 o1 = f2bf(x1 * cs - x2 * sn), o2 = f2bf(x2 * cs + x1 * sn);
            for (int h = 0; h < 8; ++h) { wsb(p, O_KF)[(size_t)r * 1536 + h * 192 + 128 + d1] = o1; wsb(p, O_KF)[(size_t)r * 1536 + h * 192 + 128 + d2] = o2; } } }
#endif
}
HD void mla_head_item(const P& p, int j, int idx) {
    const int r = idx >> 3, h = idx & 7;
    u16* q = wsb(p, O_CALL) + (size_t)r * 1536 + h * 192; const float* qg = p.in[14] + j * 192; float ss = 0.f;
    for (int d = 0; d < 128; ++d) { const float v = bf2f(q[d]); ss += v * v; }
    float rinv = rsq_f(ss * (1.0f / 128.0f) + EPS);
    for (int d = 0; d < 128; ++d) q[d] = f2bf(bf2f(q[d]) * rinv * qg[d]);
    ss = 0.f; for (int d = 0; d < 64; ++d) { const float v = bf2f(q[128 + d]); ss += v * v; }
    rinv = rsq_f(ss * (1.0f / 64.0f) + EPS);
    { const int t = r % SEQ, prow = t / 64, pcol = t % 64;
      for (int f = 0; f < 16; ++f) { const float fq = ropef(f, 16);
#pragma unroll
        for (int part = 0; part < 2; ++part) { float cs = 1.f, sn = 0.f; if (r < NL) sincos_t((float)(part ? pcol : prow) * fq, sn, cs);
            const int d1 = 128 + part * 32 + f, d2 = d1 + 16; const float x1 = bf2f(q[d1]) * rinv * qg[d1], x2 = bf2f(q[d2]) * rinv * qg[d2];
            q[d1] = f2bf(x1 * cs - x2 * sn); q[d2] = f2bf(x2 * cs + x1 * sn); } } }
    u16* k = wsb(p, O_KF) + (size_t)r * 1536 + h * 192; const float* kg = p.in[15] + j * 192;
    ss = 0.f; for (int d = 0; d < 128; ++d) { const float v = bf2f(k[d]); ss += v * v; }
    rinv = rsq_f(ss * (1.0f / 128.0f) + EPS);
    for (int d = 0; d < 128; ++d) k[d] = f2bf(bf2f(k[d]) * rinv * kg[d]);
}
HD void ret_prefix_item(const P& p, int idx) {
    const int d4 = idx & 63, e = (idx >> 6) & 511, bq = (idx >> 15) % RGB, h = (idx >> 15) / RGB;
    const float gf = expf(256.f * ret_logg(p, 0, h)), gb = expf(256.f * ret_logg(p, 1, h));
    f32x4 cf = {0.f, 0.f, 0.f, 0.f}, cb = {0.f, 0.f, 0.f, 0.f};
    for (int n = 0; n < NCH; ++n) { u16* s = wsb(p, O_BEXT) + (((size_t)h * NCQ + bq * NCH + n) * 512 + e) * 768 + 256 + d4 * 4;
        f32x4 t; for (int j = 0; j < 4; ++j) t[j] = bf2f(s[j]);
        st4bf(s, cf); cf = cf * gf + t; }
    for (int s_ = 0; s_ < NCH; ++s_) { const int n = s_ == 0 ? 0 : NCH - s_; u16* s = wsb(p, O_BEXT) + (((size_t)h * NCQ + bq * NCH + n) * 512 + e) * 768 + 512 + d4 * 4;
        f32x4 t; for (int j = 0; j < 4; ++j) t[j] = bf2f(s[j]);
        st4bf(s, cb); cb = cb * gb + t; } }
HD void ret_norm_item(const P& p, int idx) {
    const int lr = idx >> 2, h = idx & 3; u16* o = wsb(p, O_OB) + (size_t)lr * 2048 + h * 512; const u16* g = wsb(p, O_GATE) + (size_t)lr * 2048 + h * 512; const float* gg = p.in[19] + h * 512;
    float s = 0.f; for (int e = 0; e < 512; ++e) s += bf2f(o[e]);
    const float mu = s * (1.0f / 512.0f); float q = 0.f; for (int e = 0; e < 512; ++e) { const float d = bf2f(o[e]) - mu; q += d * d; }
    const float rstd = rsq_f(q * (1.0f / 512.0f) + EPS);
    for (int e = 0; e < 512; ++e) o[e] = f2bf((bf2f(o[e]) - mu) * rstd * gg[e] * silu_f(bf2f(g[e]))); }
struct Cx { float re, im; };
HD Cx cmul(Cx a, Cx b) { Cx r; r.re = a.re * b.re - a.im * b.im; r.im = a.re * b.im + a.im * b.re; return r; }
HD Cx s5_alog(const P& p, int dir, int g, int pp) { const float dt = expf(p.in[23][dir * 64 + g]); Cx r; r.re = p.in[21][(dir * 64 + g) * 64 + pp] * dt; r.im = p.in[22][(dir * 64 + g) * 64 + pp] * dt; return r; }
HD Cx cpowa(Cx al, float n) { const float m = expf(al.re * n); float sn, cs; sincos_t(al.im * n * 0.15915494309189535f, sn, cs); Cx r; r.re = m * cs; r.im = m * sn; return r; }
HD Cx s5_coef(const P& p, int dir, int g, int pp) {
    const Cx al = s5_alog(p, dir, g, pp); Cx a = cpowa(al, 1.f); a.re -= 1.f; const float lr = p.in[21][(dir * 64 + g) * 64 + pp], li = p.in[22][(dir * 64 + g) * 64 + pp], den = 1.0f / (lr * lr + li * li);
    Cx r; r.re = (a.re * lr + a.im * li) * den; r.im = (a.im * lr - a.re * li) * den; return r; }
HD Cx s5_bbar(const P& p, int dir, int g, int pp, int m) { Cx b; const size_t o = (((size_t)dir * 64 + g) * 64 + pp) * 16 + m; b.re = p.in[24][o]; b.im = p.in[25][o]; return cmul(s5_coef(p, dir, g, pp), b); }
HD Cx s5_c(const P& p, int dir, int g, int m, int pp) { Cx c; const size_t o = (((size_t)dir * 64 + g) * 16 + m) * 64 + pp; c.re = p.in[26][o]; c.im = p.in[27][o]; return c; }
HD void s5_ktab_item(const P& p, int idx) {
    const int m2 = idx & 15, m = (idx >> 4) & 15, tau = (idx >> 8) & 31, dir = (idx >> 13) & 1, g = idx >> 14; float acc = 0.f;
    for (int pp = 0; pp < 64; ++pp) { const Cx w = cmul(cmul(s5_c(p, dir, g, m, pp), cpowa(s5_alog(p, dir, g, pp), (float)tau)), s5_bbar(p, dir, g, pp, m2)); acc += w.re; }
    ((float*)(p.ws + O_KTAB))[idx] = acc; }
HD void s5_text_item(const P& p, long idx) {
    const int col = (int)(idx % 768); const long t = idx / 768; const int row = (int)(t % 512), g = (int)(t / 512), i = row >> 4, m = row & 15; float v;
    const float* kt = (const float*)(p.ws + O_KTAB);
    if (col < 512) { const int jj = col >> 4, m2 = col & 15; v = 0.f;
        if (jj <= i) v += kt[((((size_t)g * 2 + 0) * 32 + (i - jj)) * 16 + m) * 16 + m2];
        if (jj >= i) v += kt[((((size_t)g * 2 + 1) * 32 + (jj - i)) * 16 + m) * 16 + m2];
        if (jj == i && m == m2) v += p.in[28][g * 16 + m]; }
    else { const int dir = col >= 640, pp = ((col - 512) & 127) >> 1, part = col & 1;
        const Cx w = cmul(s5_c(p, dir, g, m, pp), cpowa(s5_alog(p, dir, g, pp), dir ? (float)(32 - i) : (float)(i + 1))); v = part ? -w.im : w.re; }
    wsb(p, O_TEXT)[idx] = f2bf(v); }
HD void s5_fext_item(const P& p, int idx) {
    const int col = idx & 511, row = (idx >> 9) & 255, g = idx >> 17, jj = col >> 4, m2 = col & 15, dir = row >> 7, pp = (row & 127) >> 1, part = row & 1;
    const Cx w = cmul(cpowa(s5_alog(p, dir, g, pp), dir ? (float)jj : (float)(31 - jj)), s5_bbar(p, dir, g, pp, m2));
    wsb(p, O_FEXT)[idx] = f2bf(part ? w.im : w.re); }
HD int s5_row(int b, int s) { return s < S5C ? NB * S5L + b * S5C + s : b * S5L + (s - S5C); }
HD void s5_prefix_item(const P& p, int idx) {
    const int pp = idx & 63, b = (idx >> 6) % NB, g = (idx >> 6) / NB;
    const Cx af = cpowa(s5_alog(p, 0, g, pp), 32.f), ab = cpowa(s5_alog(p, 1, g, pp), 32.f);
    u16* base = wsb(p, O_UEXT) + (size_t)g * NROW5P * 768; Cx c; c.re = 0.f; c.im = 0.f;
    for (int s = 0; s < S5C + S5L; ++s) { u16* q = base + (size_t)s5_row(b, s) * 768 + 512 + 2 * pp; Cx t; t.re = bf2f(q[0]); t.im = bf2f(q[1]);
        q[0] = f2bf(c.re); q[1] = f2bf(c.im); c = cmul(af, c); c.re += t.re; c.im += t.im; }
    c.re = 0.f; c.im = 0.f;
    for (int s_ = 0; s_ < S5C + S5L; ++s_) { const int s = s_ < S5C ? S5C - 1 - s_ : S5C + S5L - 1 - (s_ - S5C); u16* q = base + (size_t)s5_row(b, s) * 768 + 640 + 2 * pp; Cx t; t.re = bf2f(q[0]); t.im = bf2f(q[1]);
        q[0] = f2bf(c.re); q[1] = f2bf(c.im); c = cmul(ab, c); c.re += t.re; c.im += t.im; } }

struct AttItem { const u16* q; const u16* k0; const u16* k1; const u16* v0; const u16* v1; u16* o; int n0, ntot; };
HD void att_item(const P& p, int it, AttItem& a) {
    const u16* Q = wsb(p, O_CALL); const u16* KF = wsb(p, O_KF); const u16* VB = wsb(p, O_VB); u16* O = wsb(p, O_HN);
    const int nlat = NB * 8 * (SEQ / 256);
    if (it < nlat) { const int qb = it % (SEQ / 256), h = (it / (SEQ / 256)) & 7, b = it / (SEQ / 256) / 8; const size_t r0 = (size_t)b * SEQ + qb * 256, c0 = (size_t)NL + b * 256, l0 = (size_t)b * SEQ;
        a.q = Q + r0 * 1536 + h * 192; a.o = O + r0 * 1024 + h * 128; a.k0 = KF + c0 * 1536 + h * 192; a.v0 = VB + c0 * 1024 + h * 128; a.k1 = KF + l0 * 1536 + h * 192; a.v1 = VB + l0 * 1024 + h * 128; a.n0 = 256; a.ntot = 256 + SEQ; }
    else { const int x = it - nlat, h = x & 7, b = x >> 3; const size_t c0 = (size_t)NL + b * 256;
        a.q = Q + c0 * 1536 + h * 192; a.o = O + c0 * 1024 + h * 128; a.k0 = KF + c0 * 1536 + h * 192; a.v0 = VB + c0 * 1024 + h * 128; a.k1 = a.k0; a.v1 = a.v0; a.n0 = 256; a.ntot = 256; } }
constexpr float ATT_SCALE = 0.07216878364870322f;

#ifndef HOST_EMU
#define LAS __attribute__((address_space(3)))
typedef short bf16x8 __attribute__((ext_vector_type(8)));
typedef short s16x4 __attribute__((ext_vector_type(4)));
typedef float f32x16 __attribute__((ext_vector_type(16)));
typedef unsigned u32x4 __attribute__((ext_vector_type(4)));
constexpr int HTB = 128 * 64 * 2, STAGE_BYTES = 8 * HTB;
__device__ __forceinline__ int lds_byte(int r, int c) { const int st = (r >> 4) * 2 + (c >> 5), rr = r & 15, cc = c & 31, ob = rr * 64 + cc * 2; return st * 1024 + (ob ^ (((ob >> 9) & 1) << 5)); }
__device__ __forceinline__ void stage_rc(int b, int& R, int& C) { const int st = b / 1024, sb = b % 1024, swz = sb ^ (((sb >> 9) & 1) << 5); R = (st >> 1) * 16 + swz / 64; C = (st & 1) * 32 + (swz % 64) / 2; }

template <class Dsc>
__device__ __forceinline__ void gemm_run(LAS unsigned char* lds, const Dsc& D) {
    int tid_ = threadIdx.x; asm volatile("" : "+v"(tid_));
    const int tid = tid_, wid = __builtin_amdgcn_readfirstlane(tid >> 6), lane = tid & 63, wr = wid >> 2, wc = wid & 3, fr = lane & 15, fq = lane >> 4;
    constexpr int K = Dsc::K, nt = K / 64, lda = Dsc::lda, ldb = Dsc::ldb;
    static_assert(K % 128 == 0 && K >= 256, "K");
    unsigned voffA[2], voffB[2];
#pragma unroll
    for (int i = 0; i < 2; ++i) { int R, C; stage_rc(tid * 16 + i * 8192, R, C); voffA[i] = (unsigned)(R * lda + C) * 2u; voffB[i] = (unsigned)(R * ldb + C) * 2u; }
    constexpr size_t kstep = 128, hstepA = (size_t)128 * lda * 2, hstepB = (size_t)128 * ldb * 2;
    const unsigned ldsw = (unsigned)wid * 1024u;
    const int aoff = lds_byte(wr * 64 + fr, fq * 8), boff = lds_byte(wc * 32 + fr, fq * 8);
#define G_SA(b, h) (((b) * 2 + (h)) * HTB)
#define G_SB(b, h) ((4 + (b) * 2 + (h)) * HTB)
#define G_STAGE(bufoff, gbase, voff) do { _Pragma("unroll") for (int _i = 0; _i < 2; ++_i) \
        __builtin_amdgcn_global_load_lds((const unsigned*)((const char*)(gbase) + (voff)[_i]), (LAS unsigned*)(lds + (bufoff) + ldsw + _i * 8192), 16, 0, 0); } while (0)
#define G_LDA(dst, b, h) do { _Pragma("unroll") for (int m = 0; m < 4; ++m) _Pragma("unroll") for (int k = 0; k < 2; ++k) dst[m][k] = *(const LAS bf16x8*)(lds + G_SA(b, h) + aoff + m * 2048 + k * 1024); } while (0)
#define G_LDB(dst, b, h) do { _Pragma("unroll") for (int n = 0; n < 2; ++n) _Pragma("unroll") for (int k = 0; k < 2; ++k) dst[n][k] = *(const LAS bf16x8*)(lds + G_SB(b, h) + boff + n * 2048 + k * 1024); } while (0)
#define G_MMA(ai, bj, At, Bt) do { __builtin_amdgcn_s_setprio(1); _Pragma("unroll") for (int m = 0; m < 4; ++m) _Pragma("unroll") for (int n = 0; n < 2; ++n) _Pragma("unroll") for (int k = 0; k < 2; ++k) \
        acc[ai][bj][m][n] = __builtin_amdgcn_mfma_f32_16x16x32_bf16(Bt[n][k], At[m][k], acc[ai][bj][m][n], 0, 0, 0); __builtin_amdgcn_s_setprio(0); } while (0)
#define G_WAIT_V(n) asm volatile("s_waitcnt vmcnt(" #n ")" ::: "memory")
#define G_WAIT_L(n) asm volatile("s_waitcnt lgkmcnt(" #n ")" ::: "memory")
#define G_BAR __builtin_amdgcn_s_barrier()
#define G_SCHED __builtin_amdgcn_sched_barrier(0)
    Unit cur{}, nxt{}; int ui = 0; const int G = gridDim.x, cb = blockIdx.x;
    if (!D.unit(cb, cur)) return;
    f32x4 acc[2][2][4][2];
#pragma unroll
    for (int a = 0; a < 2; ++a)
#pragma unroll
        for (int b = 0; b < 2; ++b)
#pragma unroll
            for (int m = 0; m < 4; ++m)
#pragma unroll
                for (int n = 0; n < 2; ++n) acc[a][b][m][n] = (f32x4){0.f, 0.f, 0.f, 0.f};
    bf16x8 At[4][2], B0[2][2], B1[2][2];
    const char* cA = (const char*)cur.A; const char* cB = (const char*)cur.B;
    G_STAGE(G_SB(0, 0), cB, voffB); G_STAGE(G_SA(0, 0), cA, voffA); G_STAGE(G_SB(0, 1), cB + hstepB, voffB); G_STAGE(G_SA(0, 1), cA + hstepA, voffA);
    if (wr == 1) G_BAR;
    G_WAIT_V(4); G_BAR;
    G_STAGE(G_SB(1, 0), cB + kstep, voffB); G_STAGE(G_SA(1, 0), cA + kstep, voffA); G_STAGE(G_SB(1, 1), cB + hstepB + kstep, voffB);
    G_WAIT_V(6); G_BAR;
    for (;;) {
        const bool has_next = D.unit((ui + 1) * G + cb, nxt);
        const char* nA = has_next ? (const char*)nxt.A : cA; const char* nB = has_next ? (const char*)nxt.B : cB;
        _Pragma("nounroll") for (int t = 0; t < nt; t += 2) {
            const bool last = (t == nt - 2);
            const char* a1 = cA + (size_t)(t + 1) * kstep;
            const char* a2 = last ? nA : cA + (size_t)(t + 2) * kstep; const char* b2 = last ? nB : cB + (size_t)(t + 2) * kstep;
            const char* a3 = a2 + kstep; const char* b3 = b2 + kstep;
            G_LDB(B0, 0, 0); G_SCHED; G_LDA(At, 0, 0); G_STAGE(G_SA(1, 1), a1 + hstepA, voffA);
            G_WAIT_L(8); G_BAR; G_WAIT_L(0); G_MMA(0, 0, At, B0); G_BAR; G_SCHED;
            G_LDB(B1, 0, 1); G_STAGE(G_SB(0, 0), b2, voffB);
            G_BAR; G_WAIT_L(0); G_MMA(0, 1, At, B1); G_BAR;
            G_LDA(At, 0, 1); G_STAGE(G_SA(0, 0), a2, voffA);
            G_BAR; G_WAIT_L(0); G_MMA(1, 0, At, B0); G_BAR; G_SCHED;
            G_STAGE(G_SB(0, 1), b2 + hstepB, voffB);
            G_WAIT_V(6); G_BAR; G_MMA(1, 1, At, B1); G_BAR;
            G_LDB(B0, 1, 0); G_SCHED; G_LDA(At, 1, 0); G_STAGE(G_SA(0, 1), a2 + hstepA, voffA);
            G_WAIT_L(8); G_BAR; G_WAIT_L(0); G_MMA(0, 0, At, B0); G_BAR; G_SCHED;
            G_LDB(B1, 1, 1); G_STAGE(G_SB(1, 0), b3, voffB);
            G_BAR; G_WAIT_L(0); G_MMA(0, 1, At, B1); G_BAR;
            G_LDA(At, 1, 1); G_STAGE(G_SA(1, 0), a3, voffA);
            G_BAR; G_WAIT_L(0); G_MMA(1, 0, At, B0); G_BAR; G_SCHED;
            G_STAGE(G_SB(1, 1), b3 + hstepB, voffB);
            G_WAIT_V(6); G_BAR; G_MMA(1, 1, At, B1); G_BAR;
        }
        int er_ = wr * 64 + fr, ec_ = wc * 32 + fq * 4; asm volatile("" : "+v"(er_), "+v"(ec_));
#pragma unroll
        for (int m = 0; m < 4; ++m)
#pragma unroll
            for (int n = 0; n < 2; ++n) { D.emit(cur, er_ + m * 16, ec_ + n * 16, acc[0][0][m][n], acc[0][1][m][n], acc[1][0][m][n], acc[1][1][m][n]); asm volatile("" ::: "memory"); }
        if (!has_next) break;
#pragma unroll
        for (int a = 0; a < 2; ++a)
#pragma unroll
            for (int b = 0; b < 2; ++b)
#pragma unroll
                for (int m = 0; m < 4; ++m)
#pragma unroll
                    for (int n = 0; n < 2; ++n) acc[a][b][m][n] = (f32x4){0.f, 0.f, 0.f, 0.f};
        cur = nxt; cA = nA; cB = nB; ++ui;
    }
    G_WAIT_V(0);
    if (wr == 0) G_BAR;
    G_BAR;
#undef G_SA
#undef G_SB
#undef G_STAGE
#undef G_LDA
#undef G_LDB
#undef G_MMA
#undef G_WAIT_V
#undef G_WAIT_L
#undef G_BAR
#undef G_SCHED
}

constexpr int A_SHM_V = 64 * 128 * 2, A_SHM_K = 64 * 192 * 2;
#define KSWZ(row, colB) ((row) * 384 + ((colB) ^ (((row) & 7) << 4)))
__device__ __forceinline__ int crow(int r, int hi) { return (r & 3) + 8 * (r >> 2) + 4 * hi; }
__device__ __forceinline__ unsigned cvtpk(float lo, float hi) { unsigned r; asm volatile("v_cvt_pk_bf16_f32 %0, %1, %2" : "=v"(r) : "v"(lo), "v"(hi)); return r; }
__device__ __forceinline__ int v_st(int k, int c) { const int kk = (k & ~0xC) | ((k & 4) << 1) | ((k & 8) >> 1); return ((kk >> 3) * 4 + (c >> 5)) * 512 + ((kk & 7) * 32 + (c & 31)) * 2; }
__device__ __forceinline__ int v_rd_base(int lane) { return ((lane & 3) << 3) | (((lane >> 2) & 3) << 6) | (((lane >> 4) & 1) << 5) | (((lane >> 5) & 1) << 8); }
constexpr int v_rd_off(int d0, int ks, int half) { return d0 * 512 + ks * 4096 + half * 2048; }
template <int OFF> __device__ __forceinline__ s16x4 tr_read(int vb) { s16x4 r; asm volatile("ds_read_b64_tr_b16 %0, %1 offset:%2" : "=&v"(r) : "v"(vb), "i"(OFF) : "memory"); return r; }
template <int D0> __device__ __forceinline__ void pv_one(f32x16& od, int vb, bf16x8 pa0, bf16x8 pa1, bf16x8 pa2, bf16x8 pa3) {
    const s16x4 l0 = tr_read<v_rd_off(D0, 0, 0)>(vb), h0 = tr_read<v_rd_off(D0, 0, 1)>(vb), l1 = tr_read<v_rd_off(D0, 1, 0)>(vb), h1 = tr_read<v_rd_off(D0, 1, 1)>(vb);
    const s16x4 l2 = tr_read<v_rd_off(D0, 2, 0)>(vb), h2 = tr_read<v_rd_off(D0, 2, 1)>(vb), l3 = tr_read<v_rd_off(D0, 3, 0)>(vb), h3 = tr_read<v_rd_off(D0, 3, 1)>(vb);
    asm volatile("s_waitcnt lgkmcnt(0)" ::: "memory"); __builtin_amdgcn_sched_barrier(0);
#define PK(L, H) (bf16x8){L[0], L[1], L[2], L[3], H[0], H[1], H[2], H[3]}
    od = __builtin_amdgcn_mfma_f32_32x32x16_bf16(pa0, PK(l0, h0), od, 0, 0, 0);
    od = __builtin_amdgcn_mfma_f32_32x32x16_bf16(pa1, PK(l1, h1), od, 0, 0, 0);
    od = __builtin_amdgcn_mfma_f32_32x32x16_bf16(pa2, PK(l2, h2), od, 0, 0, 0);
    od = __builtin_amdgcn_mfma_f32_32x32x16_bf16(pa3, PK(l3, h3), od, 0, 0, 0);
#undef PK
}
__device__ __forceinline__ void att_body(const AttItem& a, char* lds) {
    int tid_ = threadIdx.x; asm volatile("" : "+v"(tid_));
    const int tid = tid_, wid = tid >> 6, lane = tid & 63, r32 = lane & 31, hi = lane >> 5;
    char* V_lds = lds; char* K_lds = lds + 2 * A_SHM_V; float* li_l = (float*)(lds + 2 * A_SHM_V + 2 * A_SHM_K) + wid * 64;
    float l_reg = 0.f; f32x16 o[4] = {}; bf16x8 qr[12];
    const u16* Qw = a.q + (size_t)(wid * 32 + r32) * 1536 + hi * 8;
#pragma unroll
    for (int d0 = 0; d0 < 12; ++d0) qr[d0] = *(const bf16x8*)(Qw + d0 * 16);
    const int sr = tid >> 4, sc = (tid & 15) * 8, vst0 = v_st(sr, sc), vst1 = v_st(32 + sr, sc);
    const int voff0 = sr * 1024 + sc, voff1 = (32 + sr) * 1024 + sc;
    int koff[3], kwr[3];
#pragma unroll
    for (int i = 0; i < 3; ++i) { const int id = tid + i * 512, kr_ = id / 24, kc_ = (id % 24) * 8; koff[i] = kr_ * 1536 + kc_; kwr[i] = KSWZ(kr_, kc_ * 2); }
    const int vb0 = (int)(uintptr_t)V_lds + v_rd_base(lane);
    bf16x8 vs0, vs1, ks[3];
    const int NT = a.ntot / 64;
#define A_SLOAD(k0_) do { const int key0_ = (k0_); const u16* kb_ = key0_ < a.n0 ? a.k0 + (size_t)key0_ * 1536 : a.k1 + (size_t)(key0_ - a.n0) * 1536; \
        const u16* vbp_ = key0_ < a.n0 ? a.v0 + (size_t)key0_ * 1024 : a.v1 + (size_t)(key0_ - a.n0) * 1024; \
        vs0 = *(const bf16x8*)(vbp_ + voff0); vs1 = *(const bf16x8*)(vbp_ + voff1); \
        _Pragma("unroll") for (int i = 0; i < 3; ++i) ks[i] = *(const bf16x8*)(kb_ + koff[i]); } while (0)
#define A_SWRITE(b) do { *(bf16x8*)(V_lds + (b) * A_SHM_V + vst0) = vs0; *(bf16x8*)(V_lds + (b) * A_SHM_V + vst1) = vs1; \
        _Pragma("unroll") for (int i = 0; i < 3; ++i) *(bf16x8*)(K_lds + (b) * A_SHM_K + kwr[i]) = ks[i]; } while (0)
    A_SLOAD(0); A_SWRITE(0); __syncthreads();
    constexpr float C = ATT_SCALE * 1.4426950408889634f;
    _Pragma("nounroll") for (int j = 0; j < NT; ++j) {
        const int buf = j & 1;
        if (j + 1 < NT) A_SLOAD((j + 1) * 64);
        f32x16 p0 = {}, p1 = {};
        const char* Ks = K_lds + buf * A_SHM_K;
#pragma unroll
        for (int d0 = 0; d0 < 12; ++d0) { const int cbb = (d0 * 16 + hi * 8) * 2;
            const bf16x8 b0 = *(const bf16x8*)(Ks + KSWZ(r32, cbb)); const bf16x8 b1 = *(const bf16x8*)(Ks + KSWZ(32 + r32, cbb));
            p0 = __builtin_amdgcn_mfma_f32_32x32x16_bf16(b0, qr[d0], p0, 0, 0, 0);
            p1 = __builtin_amdgcn_mfma_f32_32x32x16_bf16(b1, qr[d0], p1, 0, 0, 0); }
        float ps = 0.f;
#pragma unroll
        for (int r = 0; r < 16; ++r) { p0[r] = __builtin_amdgcn_exp2f(p0[r] * C); p1[r] = __builtin_amdgcn_exp2f(p1[r] * C); ps += p0[r] + p1[r]; }
        { auto rr = __builtin_amdgcn_permlane32_swap(__float_as_uint(ps), __float_as_uint(ps), false, false); ps = __uint_as_float(rr[0]) + __uint_as_float(rr[1]); }
        l_reg += ps;
        bf16x8 pa0, pa1, pa2, pa3;
#define PK4(Pv, BASE, OUT) do { unsigned a0 = cvtpk(Pv[BASE + 0], Pv[BASE + 1]), a1 = cvtpk(Pv[BASE + 2], Pv[BASE + 3]); \
        unsigned b0 = cvtpk(Pv[BASE + 4], Pv[BASE + 5]), b1 = cvtpk(Pv[BASE + 6], Pv[BASE + 7]); \
        auto r0 = __builtin_amdgcn_permlane32_swap(a0, b0, false, false); auto r1 = __builtin_amdgcn_permlane32_swap(a1, b1, false, false); \
        u32x4 w = {r0[0], r1[0], r0[1], r1[1]}; OUT = *reinterpret_cast<bf16x8*>(&w); } while (0)
        PK4(p0, 0, pa0); PK4(p0, 8, pa1); PK4(p1, 0, pa2); PK4(p1, 8, pa3);
#undef PK4
        const int vb = vb0 + buf * A_SHM_V;
        pv_one<0>(o[0], vb, pa0, pa1, pa2, pa3); pv_one<1>(o[1], vb, pa0, pa1, pa2, pa3); pv_one<2>(o[2], vb, pa0, pa1, pa2, pa3); pv_one<3>(o[3], vb, pa0, pa1, pa2, pa3);
        if (j + 1 < NT) A_SWRITE(buf ^ 1);
        __syncthreads();
    }
    if (hi == 0) li_l[r32] = l_reg;
    asm volatile("s_waitcnt lgkmcnt(0)" ::: "memory");
    __builtin_amdgcn_wave_barrier();
    u16* Ow = a.o + (size_t)(wid * 32) * 1024;
#pragma unroll
    for (int r = 0; r < 16; ++r) { const int orow = crow(r, hi); const float rl = 1.0f / li_l[orow];
#pragma unroll
        for (int d0 = 0; d0 < 4; ++d0) Ow[(size_t)orow * 1024 + d0 * 32 + r32] = f2bf(o[d0][r] * rl); }
    __syncthreads();
#undef A_SLOAD
#undef A_SWRITE
}

__device__ __forceinline__ float wsum(float v) { for (int o = 32; o >= 1; o >>= 1) v += __shfl_xor(v, o); return v; }
__device__ __forceinline__ void norm_wave(const P& p, int layer, int k, int r, int s5, int lane) {
    const float* x = hrow(p, r); f32x4 v[4]; float ss = 0.f;
#pragma unroll
    for (int i = 0; i < 4; ++i) { v[i] = *(const f32x4*)(x + i * 256 + lane * 4); ss += v[i][0] * v[i][0] + v[i][1] * v[i][1] + v[i][2] * v[i][2] + v[i][3] * v[i][3]; }
    ss = wsum(ss); const float rinv = rsq_f(ss * (1.0f / 1024.0f) + EPS);
    const float* g = p.in[6] + (size_t)(layer * 3 + k) * 1024; const float* sh = modp(p, layer, r, 3 * k); const float* sc = modp(p, layer, r, 3 * k + 1);
    int row5 = 0, i5 = 0;
    if (s5) { if (r < NL) { const int b = r / SEQ, t = r % SEQ; row5 = b * S5L + t / 32; i5 = t % 32; } else { const int rr = r - NL; const int b = rr / 256, l = rr % 256; row5 = NB * S5L + b * S5C + l / 32; i5 = l % 32; } }
#pragma unroll
    for (int i = 0; i < 4; ++i) { const int d = i * 256 + lane * 4; const f32x4 gv = *(const f32x4*)(g + d), sv = *(const f32x4*)(sc + d), hv = *(const f32x4*)(sh + d); f32x4 o;
        for (int j = 0; j < 4; ++j) o[j] = v[i][j] * rinv * gv[j] * (1.0f + sv[j]) + hv[j];
        if (!s5) st4bf(wsb(p, O_HN) + (size_t)r * 1024 + d, o);
        else st4bf(wsb(p, O_UEXT) + ((size_t)(d >> 4) * NROW5P + row5) * 768 + i5 * 16 + (d & 15), o); } }
__device__ __forceinline__ void mla_row_wave(const P& p, int j, int r, int lane) {
    const float* x = (const float*)(p.ws + O_CALL) + (size_t)r * 768; f32x4 c[3]; float q[3];
#pragma unroll
    for (int i = 0; i < 3; ++i) { c[i] = *(const f32x4*)(x + i * 256 + lane * 4); q[i] = c[i][0] * c[i][0] + c[i][1] * c[i][1] + c[i][2] * c[i][2] + c[i][3] * c[i][3]; }
    const bool lo = lane < 32;
    const float ssq = wsum(q[0] + (lo ? q[1] : 0.f)), sskv = wsum((lo ? 0.f : q[1]) + (lo ? q[2] : 0.f)), ssr = wsum((lane >= 32 && lane < 48) ? q[2] : 0.f);
    const float rq = rsq_f(ssq * (1.0f / 384.0f) + EPS), rkv = rsq_f(sskv * (1.0f / 256.0f) + EPS), rr_ = rsq_f(ssr * (1.0f / 64.0f) + EPS);
    const float* qn = p.in[10] + j * 384; const float* kvn = p.in[11] + j * 256; const float* kg = p.in[15] + j * 192 + 128;
    { const f32x4 gq = *(const f32x4*)(qn + lane * 4); f32x4 o; for (int jx = 0; jx < 4; ++jx) o[jx] = c[0][jx] * rq * gq[jx]; st4bf(wsb(p, O_CQN) + (size_t)r * 384 + lane * 4, o); }
    if (lo) { const f32x4 gq = *(const f32x4*)(qn + 256 + lane * 4); f32x4 o; for (int jx = 0; jx < 4; ++jx) o[jx] = c[1][jx] * rq * gq[jx]; st4bf(wsb(p, O_CQN) + (size_t)r * 384 + 256 + lane * 4, o);
        const f32x4 gk = *(const f32x4*)(kvn + 128 + lane * 4); f32x4 o2; for (int jx = 0; jx < 4; ++jx) o2[jx] = c[2][jx] * rkv * gk[jx]; st4bf(wsb(p, O_CKVN) + (size_t)r * 256 + 128 + lane * 4, o2); }
    else { const f32x4 gk = *(const f32x4*)(kvn + lane * 4 - 128); f32x4 o; for (int jx = 0; jx < 4; ++jx) o[jx] = c[1][jx] * rkv * gk[jx]; st4bf(wsb(p, O_CKVN) + (size_t)r * 256 + lane * 4 - 128, o); }
    const int dd = (4 * (lane - 32)) & 63; const f32x4 gr = *(const f32x4*)(kg + dd); f32x4 own, oth, o;
    for (int jx = 0; jx < 4; ++jx) own[jx] = c[2][jx] * rr_ * gr[jx];
    for (int jx = 0; jx < 4; ++jx) oth[jx] = __shfl_xor(own[jx], 4);
    const int t = r % SEQ, pos = (dd & 32) ? (t % 64) : (t / 64); const bool first = (dd & 16) == 0;
    for (int jx = 0; jx < 4; ++jx) { float cs = 1.f, sn = 0.f; if (r < NL) sincos_t((float)pos * ropef((dd & 15) + jx, 16), sn, cs);
        o[jx] = first ? own[jx] * cs - oth[jx] * sn : own[jx] * cs + oth[jx] * sn; }
    if (lane >= 32 && lane < 48) { u16* kf = wsb(p, O_KF) + (size_t)r * 1536 + 128 + dd;
#pragma unroll
        for (int h = 0; h < 8; ++h) st4bf(kf + h * 192, o); } }
__device__ __forceinline__ float bflo(unsigned w) { return __uint_as_float(w << 16); }
__device__ __forceinline__ float bfhi(unsigned w) { return __uint_as_float(w & 0xffff0000u); }
__device__ __forceinline__ unsigned pk2(float a, float b) { return (unsigned)f2bf(a) | ((unsigned)f2bf(b) << 16); }
__device__ __forceinline__ void mla_head_wave(const P& p, int j, int r, int lane) {
    const int h = lane >> 3, sub = lane & 7;
    u16* q = wsb(p, O_CALL) + (size_t)r * 1536 + h * 192; u16* k = wsb(p, O_KF) + (size_t)r * 1536 + h * 192;
    const float* qg = p.in[14] + j * 192; const float* kg = p.in[15] + j * 192;
    u32x4 qa = *(const u32x4*)(q + sub * 16), qb = *(const u32x4*)(q + sub * 16 + 8), qr = *(const u32x4*)(q + 128 + sub * 8), ka = *(const u32x4*)(k + sub * 16), kb = *(const u32x4*)(k + sub * 16 + 8);
    float sq = 0.f, sk = 0.f, sr = 0.f;
#pragma unroll
    for (int i = 0; i < 4; ++i) { sq += bflo(qa[i]) * bflo(qa[i]) + bfhi(qa[i]) * bfhi(qa[i]) + bflo(qb[i]) * bflo(qb[i]) + bfhi(qb[i]) * bfhi(qb[i]);
        sk += bflo(ka[i]) * bflo(ka[i]) + bfhi(ka[i]) * bfhi(ka[i]) + bflo(kb[i]) * bflo(kb[i]) + bfhi(kb[i]) * bfhi(kb[i]); sr += bflo(qr[i]) * bflo(qr[i]) + bfhi(qr[i]) * bfhi(qr[i]); }
    for (int o = 4; o >= 1; o >>= 1) { sq += __shfl_xor(sq, o); sk += __shfl_xor(sk, o); sr += __shfl_xor(sr, o); }
    const float rq = rsq_f(sq * (1.0f / 128.0f) + EPS), rk = rsq_f(sk * (1.0f / 128.0f) + EPS), rr_ = rsq_f(sr * (1.0f / 64.0f) + EPS);
    u32x4 oa, ob, oka, okb;
#pragma unroll
    for (int i = 0; i < 4; ++i) { const int d = sub * 16 + 2 * i;
        oa[i] = pk2(bflo(qa[i]) * rq * qg[d], bfhi(qa[i]) * rq * qg[d + 1]); ob[i] = pk2(bflo(qb[i]) * rq * qg[d + 8], bfhi(qb[i]) * rq * qg[d + 9]);
        oka[i] = pk2(bflo(ka[i]) * rk * kg[d], bfhi(ka[i]) * rk * kg[d + 1]); okb[i] = pk2(bflo(kb[i]) * rk * kg[d + 8], bfhi(kb[i]) * rk * kg[d + 9]); }
    *(u32x4*)(q + sub * 16) = oa; *(u32x4*)(q + sub * 16 + 8) = ob; *(u32x4*)(k + sub * 16) = oka; *(u32x4*)(k + sub * 16 + 8) = okb;
    const int dd = sub * 8; float own[8], oth[8];
#pragma unroll
    for (int i = 0; i < 4; ++i) { own[2 * i] = bflo(qr[i]) * rr_ * qg[128 + dd + 2 * i]; own[2 * i + 1] = bfhi(qr[i]) * rr_ * qg[128 + dd + 2 * i + 1]; }
#pragma unroll
    for (int i = 0; i < 8; ++i) oth[i] = __shfl_xor(own[i], 2);
    const int t = r % SEQ, pos = (dd & 32) ? (t % 64) : (t / 64); const bool first = (dd & 16) == 0; u32x4 orr; float res[8];
#pragma unroll
    for (int i = 0; i < 8; ++i) { float cs = 1.f, sn = 0.f; if (r < NL) sincos_t((float)pos * ropef((dd & 15) + i, 16), sn, cs); res[i] = first ? own[i] * cs - oth[i] * sn : own[i] * cs + oth[i] * sn; }
#pragma unroll
    for (int i = 0; i < 4; ++i) orr[i] = pk2(res[2 * i], res[2 * i + 1]);
    *(u32x4*)(q + 128 + dd) = orr; }
__device__ __forceinline__ void ret_norm_wave(const P& p, int lr, int lane) {
    const int h = lane >> 4, sub = lane & 15; u16* o = wsb(p, O_OB) + (size_t)lr * 2048 + h * 512 + sub * 32; const u16* g = wsb(p, O_GATE) + (size_t)lr * 2048 + h * 512 + sub * 32; const float* gg = p.in[19] + h * 512 + sub * 32;
    u32x4 ov[4]; float s = 0.f;
#pragma unroll
    for (int i = 0; i < 4; ++i) { ov[i] = *(const u32x4*)(o + i * 8); for (int jx = 0; jx < 4; ++jx) s += bflo(ov[i][jx]) + bfhi(ov[i][jx]); }
    for (int m = 8; m >= 1; m >>= 1) s += __shfl_xor(s, m);
    const float mu = s * (1.0f / 512.0f); float qv = 0.f;
#pragma unroll
    for (int i = 0; i < 4; ++i) for (int jx = 0; jx < 4; ++jx) { const float a = bflo(ov[i][jx]) - mu, b = bfhi(ov[i][jx]) - mu; qv += a * a + b * b; }
    for (int m = 8; m >= 1; m >>= 1) qv += __shfl_xor(qv, m);
    const float rstd = rsq_f(qv * (1.0f / 512.0f) + EPS);
#pragma unroll
    for (int i = 0; i < 4; ++i) { const u32x4 gv = *(const u32x4*)(g + i * 8); u32x4 w;
        for (int jx = 0; jx < 4; ++jx) { const int e = i * 8 + 2 * jx;
            w[jx] = pk2((bflo(ov[i][jx]) - mu) * rstd * gg[e] * silu_f(bflo(gv[jx])), (bfhi(ov[i][jx]) - mu) * rstd * gg[e + 1] * silu_f(bfhi(gv[jx]))); }
        *(u32x4*)(o + i * 8) = w; } }
__device__ __forceinline__ void mod_phase(const P& p, float* tab) {
    for (int i = threadIdx.x; i < NMR * 1024; i += 512) { const int b = i >> 10, k = i & 1023; tab[i] = silu_f(b < NB ? p.in[1][b * 1024 + k] : p.in[3][k]); }
    __syncthreads();
    for (int idx = blockIdx.x * 512 + threadIdx.x; idx < DEPTH * 9216; idx += gridDim.x * 512) {
        const int layer = idx / 9216, col = idx % 9216; const float* w = p.in[4] + (size_t)layer * 1024 * 9216 + col; float acc[NMR];
#pragma unroll
        for (int b = 0; b < NMR; ++b) acc[b] = 0.f;
        for (int k = 0; k < 1024; ++k) { const float wv = w[(size_t)k * 9216];
#pragma unroll
            for (int b = 0; b < NMR; ++b) acc[b] += tab[b * 1024 + k] * wv; }
        const float bias = p.in[5][layer * 9216 + col];
#pragma unroll
        for (int b = 0; b < NMR; ++b) ((float*)(p.ws + O_MOD))[(size_t)(layer * NMR + b) * 9216 + col] = acc[b] + bias; }
    __syncthreads(); }
#define WPASS(N, HOSTCALL, DEVCALL) do { const int _n = (int)(N); int t0_ = threadIdx.x; asm volatile("" : "+v"(t0_)); const int lane = t0_ & 63; for (int it = blockIdx.x * 8 + (t0_ >> 6); it < _n; it += gridDim.x * 8) { DEVCALL; } } while (0)
#define MODPHASE() mod_phase(p, (float*)shm)

namespace cg = cooperative_groups;
#define PASS(N, CALL) do { const long _n = (long)(N); int t0_ = threadIdx.x; asm volatile("" : "+v"(t0_)); for (long it = (long)blockIdx.x * 512 + t0_; it < _n; it += (long)gridDim.x * 512) { CALL; } } while (0)
#define GEMM(D) gemm_run(lds, D)
#define SYNC() grid.sync()
#define HOOK(L, S) do { } while (0)
#define ATTN(NITEMS) do { for (int it = blockIdx.x; it < (NITEMS); it += gridDim.x) { AttItem ai_; att_item(p, it, ai_); att_body(ai_, (char*)shm); } } while (0)
#else
template <class Dsc> static void gemm_emu(const Dsc& D) {
    int n = 0; { Unit u; while (D.unit(n, u)) ++n; }
#pragma omp parallel for schedule(dynamic)
    for (int L = 0; L < n; ++L) { Unit u{}; D.unit(L, u); const int K = Dsc::K;
        std::vector<float> A((size_t)256 * K), B((size_t)256 * K), C((size_t)256 * 256);
        for (int r = 0; r < 256; ++r) for (int k = 0; k < K; ++k) { A[(size_t)r * K + k] = bf2f(u.A[(size_t)r * Dsc::lda + k]); B[(size_t)r * K + k] = bf2f(u.B[(size_t)r * Dsc::ldb + k]); }
        for (int r = 0; r < 256; ++r) for (int c = 0; c < 256; ++c) { float s = 0.f; const float* a = &A[(size_t)r * K]; const float* b = &B[(size_t)c * K]; for (int k = 0; k < K; ++k) s += a[k] * b[k]; C[r * 256 + c] = s; }
        for (int r = 0; r < 128; ++r) for (int c = 0; c < 128; c += 4) { f32x4 v[2][2];
            for (int X = 0; X < 2; ++X) for (int Y = 0; Y < 2; ++Y) for (int j = 0; j < 4; ++j) v[X][Y][j] = C[(r + 128 * X) * 256 + c + 128 * Y + j];
            D.emit(u, r, c, v[0][0], v[0][1], v[1][0], v[1][1]); } } }
static void att_emu(const P& p, int nitems) {
#pragma omp parallel for schedule(dynamic)
    for (int it = 0; it < nitems; ++it) { AttItem a; att_item(p, it, a); std::vector<float> s(a.ntot);
        for (int i = 0; i < 256; ++i) { const u16* q = a.q + (size_t)i * 1536; float l = 0.f; float o[128]; for (int e = 0; e < 128; ++e) o[e] = 0.f;
            for (int k = 0; k < a.ntot; ++k) { const u16* kr = k < a.n0 ? a.k0 + (size_t)k * 1536 : a.k1 + (size_t)(k - a.n0) * 1536; float d = 0.f; for (int x = 0; x < 192; ++x) d += bf2f(q[x]) * bf2f(kr[x]);
                const float pv = bf2f(f2bf(expf(d * ATT_SCALE))); l += expf(d * ATT_SCALE); const u16* vr = k < a.n0 ? a.v0 + (size_t)k * 1024 : a.v1 + (size_t)(k - a.n0) * 1024; for (int e = 0; e < 128; ++e) o[e] += pv * bf2f(vr[e]); }
            for (int e = 0; e < 128; ++e) a.o[(size_t)i * 1024 + e] = f2bf(o[e] / l); } } }
#define PASS(N, CALL) do { const long _n = (long)(N); _Pragma("omp parallel for schedule(static)") for (long it = 0; it < _n; ++it) { CALL; } } while (0)
#define WPASS(N, HOSTCALL, DEVCALL) PASS(N, HOSTCALL)
#define MODPHASE() PASS(DEPTH * 9216, mod_item(p, (int)it))
#define GEMM(D) gemm_emu(D)
#define SYNC() do { } while (0)
#define ATTN(NITEMS) att_emu(p, NITEMS)
static void emu_hook(const P& p, int layer, int stage);
#define HOOK(L, S) emu_hook(p, L, S)
#endif

#ifndef HOST_EMU
__global__ void __launch_bounds__(512) fwd_megakernel(P p) {
    extern __shared__ __attribute__((aligned(16))) unsigned char shm[];
    LAS unsigned char* lds = (LAS unsigned char*)shm;
    cg::grid_group grid = cg::this_grid();
#else
static void fwd_emu(P p) {
#endif
    if (PM(0)) { MODPHASE();
    PASS((long)MT * 256, copy_item(p, it));
    PASS(CV_TOTAL, cvt_item(p, it)); }
    SYNC();
    for (int layer = 0; layer < DEPTH; ++layer) {
        const int kind = layer % 3, j = layer / 3; const bool last = layer == DEPTH - 1;
        if (PM(1)) { WPASS(MT, norm_item(p, layer, 0, (int)it, 0), norm_wave(p, layer, 0, it, 0, lane)); } SYNC();
        for (int rep_ = 0; rep_ < REP_UP; ++rep_) { if (PM(2)) { DFfnUp d{p, layer, 0}; GEMM(d); } SYNC(); }
        if (PM(3)) { DFfnDown d{p, layer, 0, MT / 256}; GEMM(d); } SYNC();
        if (kind == 0) {
            if (PM(1)) { WPASS(MT, norm_item(p, layer, 1, (int)it, 0), norm_wave(p, layer, 1, it, 0, lane)); } SYNC();
            if (PM(4)) { DMlaIn d{p, j}; GEMM(d); } SYNC();
            if (PM(5)) { WPASS(MT, mla_row_item(p, j, (int)it), mla_row_wave(p, j, it, lane)); } SYNC();
            if (PM(6)) { DMlaUq d{p, j}; GEMM(d); } if (PM(7)) { DMlaUkv d{p, j}; GEMM(d); } SYNC();
            if (PM(8)) { WPASS(MT, { for (int h_ = 0; h_ < 8; ++h_) mla_head_item(p, j, (int)it * 8 + h_); }, mla_head_wave(p, j, it, lane)); } SYNC();
            for (int rep_ = 0; rep_ < REP_ATT; ++rep_) { if (PM(9)) { ATTN(NB * 8 * (SEQ / 256) + (last ? 0 : NB * 8)); } SYNC(); }
            if (PM(10)) { DMlaO d{p, layer, j, last ? NL / 256 : MT / 256}; GEMM(d); } SYNC();
        } else if (kind == 1) {
            if (PM(1)) { WPASS(MT, norm_item(p, layer, 1, (int)it, 0), norm_wave(p, layer, 1, it, 0, lane)); } SYNC();
            for (int q = 0; q < NB / RGB; ++q) {
                if (PM(11)) { DRetProj d{p, q}; GEMM(d); } if (PM(12)) { DRetProjT d{p, q}; GEMM(d); } SYNC();
                if (PM(13)) { DRetP d{p}; GEMM(d); } if (PM(14)) { DRetL d{p}; GEMM(d); } SYNC();
                if (PM(15)) { PASS(4 * RGB * 512 * 64, ret_prefix_item(p, (int)it)); } SYNC();
                if (PM(16)) { DRetO d{p}; GEMM(d); } SYNC();
                if (PM(17)) { WPASS(NCQ * 256, { for (int h_ = 0; h_ < 4; ++h_) ret_norm_item(p, (int)it * 4 + h_); }, ret_norm_wave(p, it, lane)); } SYNC();
                if (PM(18)) { DRetWo d{p, layer, q}; GEMM(d); } SYNC();
            }
        } else {
            if (PM(19)) { WPASS(MT, norm_item(p, layer, 1, (int)it, 1), norm_wave(p, layer, 1, it, 1, lane));
            PASS(64 * 2 * 32 * 256, s5_ktab_item(p, (int)it));
            PASS(64 * 256 * 512, s5_fext_item(p, (int)it)); } SYNC();
            if (PM(19)) { PASS((long)64 * 512 * 768, s5_text_item(p, it)); }
            if (PM(20)) { DS5L d{p}; GEMM(d); } SYNC();
            if (PM(21)) { PASS(64 * NB * 64, s5_prefix_item(p, (int)it)); } SYNC();
            if (PM(22)) { DS5Y d{p}; GEMM(d); } SYNC();
            if (PM(23)) { DS5Glu d{p, layer}; GEMM(d); } SYNC();
        }
        HOOK(layer, 0);
        if (PM(1)) { WPASS(last ? NL : MT, norm_item(p, layer, 2, (int)it, 0), norm_wave(p, layer, 2, it, 0, lane)); } SYNC();
        for (int rep_ = 0; rep_ < REP_UP; ++rep_) { if (PM(2)) { DFfnUp d{p, layer, 1}; GEMM(d); } SYNC(); }
        if (PM(3)) { DFfnDown d{p, layer, 1, last ? NL / 256 : MT / 256}; GEMM(d); } SYNC();
        HOOK(layer, 1);
    }
}

#ifndef HOST_EMU
extern "C" void kernel_launch(void* const* d_in, const int* in_sizes, int n_in, void* d_out, int out_size, void* d_ws, size_t ws_size, hipStream_t stream) {
    constexpr size_t kDynLds = STAGE_BYTES + 4096;
    static int grid_blocks = 0;
    if (!grid_blocks) {
        int dev = 0, cus = 0, per_cu = 0;
        hipGetDevice(&dev);
        hipDeviceGetAttribute(&cus, hipDeviceAttributeMultiprocessorCount, dev);
        hipFuncSetAttribute((const void*)fwd_megakernel, hipFuncAttributeMaxDynamicSharedMemorySize, (int)kDynLds);
        hipOccupancyMaxActiveBlocksPerMultiprocessor(&per_cu, fwd_megakernel, 512, kDynLds);
        if (per_cu < 1) per_cu = 1;
        if (per_cu > 1) per_cu = 1;
        grid_blocks = cus * per_cu;
        if (ws_size < WS_NEED) fprintf(stderr, "workspace too small: %zu < %zu\n", ws_size, (size_t)WS_NEED);
    }
    P p{};
    for (int i = 0; i < 31 && i < n_in; ++i) p.in[i] = (const float*)d_in[i];
    p.out = (float*)d_out; p.ws = (char*)d_ws;
    void* args[] = {&p};
    hipError_t e = hipLaunchCooperativeKernel((void*)fwd_megakernel, dim3(grid_blocks), dim3(512), args, kDynLds, stream);
    if (e != hipSuccess) fprintf(stderr, "cooperative launch failed: %s (grid %d)\n", hipGetErrorString(e), grid_blocks);
}
#endif
```

```cpp
#ifdef HOST_EMU
#include <cmath>
#include <cstdio>
#include <cstdlib>
#include <cstring>
#include <vector>
#define HD inline
#else
#include <hip/hip_runtime.h>
#include <hip/hip_cooperative_groups.h>
#include <cstdio>
#define HD __device__ __forceinline__
#endif

#ifndef CFG_BATCH
#define CFG_BATCH 16
#endif
#ifndef CFG_SEQ
#define CFG_SEQ 4096
#endif

typedef unsigned short u16;
typedef float f32x4 __attribute__((ext_vector_type(4)));
typedef unsigned u32x2 __attribute__((ext_vector_type(2)));

constexpr int DM = 1024, NB = CFG_BATCH, SEQ = CFG_SEQ, CTX = 256, DFF = 2816, DEPTH = 4;
constexpr int NL = NB * SEQ, NC = NB * CTX, MT = NL + NC;
constexpr int NMR = NB + 1;
constexpr int RGB = (NB >= 4) ? 4 : 1;
constexpr int NCH = 1 + SEQ / 256;
constexpr int NCQ = RGB * NCH;
constexpr int S5L = SEQ / 32, S5C = CTX / 32;
constexpr int NROW5 = NB * S5L + NB * S5C;
constexpr int NROW5P = (NROW5 + 255) / 256 * 256;
constexpr float EPS = 1e-6f;

constexpr size_t al(size_t x) { return (x + 255) & ~(size_t)255; }
constexpr size_t O_BAR = 0;
constexpr size_t O_MOD = 16384;
constexpr size_t O_G = O_MOD + al((size_t)DEPTH * NMR * 9216 * 4);
constexpr size_t O_FFI = O_G + al((size_t)NC * 1024 * 4);
constexpr size_t SZ_FFI1 = (size_t)5632 * 1024 * 2, SZ_FFO1 = (size_t)1024 * 2816 * 2;
constexpr size_t O_FFO = O_FFI + 8 * SZ_FFI1;
constexpr size_t O_MWIN = O_FFO + 8 * SZ_FFO1;
constexpr size_t SZ_MWIN = (size_t)768 * 1024 * 2, SZ_MWUQ = (size_t)1536 * 384 * 2, SZ_MWUKV = (size_t)2048 * 256 * 2, SZ_MWO = (size_t)1024 * 1024 * 2;
constexpr size_t O_MWUQ = O_MWIN + 2 * SZ_MWIN;
constexpr size_t O_MWUKV = O_MWUQ + 2 * SZ_MWUQ;
constexpr size_t O_MWO = O_MWUKV + 2 * SZ_MWUKV;
constexpr size_t O_RWIN = O_MWO + 2 * SZ_MWO;
constexpr size_t O_RWO = O_RWIN + (size_t)6144 * 1024 * 2;
constexpr size_t O_GLU = O_RWO + (size_t)1024 * 2048 * 2;
constexpr size_t O_HN = O_GLU + (size_t)2048 * 1024 * 2;
constexpr size_t O_SCR = O_HN + al((size_t)MT * 1024 * 2);
constexpr size_t O_ACT = O_SCR;
constexpr size_t O_CALL = O_SCR;
constexpr size_t O_CQN = O_CALL + al((size_t)MT * 768 * 4);
constexpr size_t O_CKVN = O_CQN + al((size_t)MT * 384 * 2);
constexpr size_t O_KF = O_CKVN + al((size_t)MT * 256 * 2);
constexpr size_t O_VB = O_KF + al((size_t)MT * 1536 * 2);
constexpr size_t END_MLA = O_VB + al((size_t)MT * 1024 * 2);
constexpr size_t O_QN = O_SCR;
constexpr size_t O_KN = O_QN + al((size_t)NCQ * 256 * 1024 * 2);
constexpr size_t O_GATE = O_KN + al((size_t)NCQ * 256 * 1024 * 2);
constexpr size_t O_OB = O_GATE + al((size_t)NCQ * 256 * 2048 * 2);
constexpr size_t O_AEXT = O_OB + al((size_t)NCQ * 256 * 2048 * 2);
constexpr size_t O_KTX = O_AEXT + al((size_t)4 * NCQ * 256 * 768 * 2);
constexpr size_t O_BEXT = O_KTX + al((size_t)4 * NCQ * 2 * 256 * 256 * 2);
constexpr size_t END_RET = O_BEXT + al((size_t)4 * NCQ * 512 * 768 * 2);
constexpr size_t O_UEXT = O_SCR;
constexpr size_t O_KTAB = O_UEXT + al((size_t)64 * NROW5P * 768 * 2);
constexpr size_t O_TEXT = O_KTAB + al((size_t)64 * 2 * 32 * 256 * 4);
constexpr size_t O_FEXT = O_TEXT + al((size_t)64 * 512 * 768 * 2);
constexpr size_t END_S5 = O_FEXT + al((size_t)64 * 256 * 512 * 2);
constexpr size_t END_FFN = O_ACT + al((size_t)MT * 2816 * 2);
constexpr size_t cmax(size_t a, size_t b) { return a > b ? a : b; }
constexpr size_t WS_NEED = cmax(cmax(END_MLA, END_RET), cmax(END_S5, END_FFN));

struct P { const float* in[32]; float* out; char* ws; };
#ifndef PHASE_MASK
#define PHASE_MASK 0xFFFFFFFFu
#endif
#define PM(b) ((PHASE_MASK >> (b)) & 1u)
#ifndef REP_UP
#define REP_UP 1
#endif
#ifndef REP_ATT
#define REP_ATT 1
#endif
#ifndef REP_NORM
#define REP_NORM 1
#endif
#ifndef REP_RET
#define REP_RET 1
#endif
#ifndef REP_MLA
#define REP_MLA 1
#endif
#ifndef REP_S5
#define REP_S5 1
#endif
#ifndef REP_SYNC
#define REP_SYNC 0
#endif

HD float bf2f(u16 b) { union { unsigned u; float f; } x; x.u = ((unsigned)b) << 16; return x.f; }
HD u16 f2bf(float f) { union { unsigned u; float f; } x; x.f = f; unsigned u = x.u; u += 0x7fffu + ((u >> 16) & 1u); return (u16)(u >> 16); }
#ifdef HOST_EMU
HD void st4bf(u16* p, f32x4 v) { u32x2 w; w.x = (unsigned)f2bf(v[0]) | ((unsigned)f2bf(v[1]) << 16); w.y = (unsigned)f2bf(v[2]) | ((unsigned)f2bf(v[3]) << 16); *(u32x2*)p = w; }
#else
HD unsigned cvtpk_bf(float lo, float hi) { unsigned r; asm("v_cvt_pk_bf16_f32 %0, %1, %2" : "=v"(r) : "v"(lo), "v"(hi)); return r; }
HD void st4bf(u16* p, f32x4 v) { u32x2 w; w.x = cvtpk_bf(v[0], v[1]); w.y = cvtpk_bf(v[2], v[3]); *(u32x2*)p = w; }
#endif
#ifdef HOST_EMU
HD float silu_f(float a) { return a / (1.0f + expf(-a)); }
HD float sigm_f(float a) { return 1.0f / (1.0f + expf(-a)); }
HD float gelu_f(float x) { return 0.5f * x * (1.0f + tanhf(0.7978845608028654f * (x + 0.044715f * x * x * x))); }
#else
HD float sigm_f(float a) { return __builtin_amdgcn_rcpf(1.0f + __builtin_amdgcn_exp2f(-1.4426950408889634f * a)); }
HD float silu_f(float a) { return a * sigm_f(a); }
HD float gelu_f(float x) { return x * sigm_f(1.5957691216057308f * (x + 0.044715f * x * x * x)); }
#endif
HD float rsq_f(float x) { return 1.0f / sqrtf(x); }
HD float ex2(float x) {
#ifdef HOST_EMU
    return exp2f(x);
#else
    return __builtin_amdgcn_exp2f(x);
#endif
}
HD float* hrow(const P& p, int r) { return r < NL ? p.out + (size_t)r * 1024 : (float*)(p.ws + O_G) + (size_t)(r - NL) * 1024; }
HD const float* modp(const P& p, int layer, int r, int idx) { const int mr = r < NL ? r / SEQ : NB; return (const float*)(p.ws + O_MOD) + ((size_t)(layer * NMR + mr) * 9 + idx) * 1024; }
HD u16* wsb(const P& p, size_t off) { return (u16*)(p.ws + off); }
#ifdef HOST_EMU
HD float ropef(int d, int half) { return expf(-(float)d * (9.210340371976184f / (float)half)) * 0.15915494309189535f; }
#else
HD float ropef(int d, int half) { return __builtin_amdgcn_exp2f(-(float)d * (13.287712379549449f / (float)half)) * 0.15915494309189535f; }
#endif
HD void sincos_t(float turns, float& sn, float& cs) {
    const float f = turns - floorf(turns);
#ifdef HOST_EMU
    sn = sinf(6.283185307179586f * f); cs = cosf(6.283185307179586f * f);
#else
    sn = __builtin_amdgcn_sinf(f); cs = __builtin_amdgcn_cosf(f);
#endif
}

HD bool rect_unit(int L, int nM, int nN, int& pm, int& pn) {
    const int nwg = nM * nN; if (L >= nwg) return false;
    int wgid = L; { const int q = nwg / 8, r = nwg % 8, xcd = wgid % 8, off = wgid / 8; wgid = (xcd < r ? xcd * (q + 1) : r * (q + 1) + (xcd - r) * q) + off; }
    const int nig = 8 * nN, gid = wgid / nig, fm = gid * 8, gsz = (nM - fm) < 8 ? (nM - fm) : 8;
    pm = fm + ((wgid % nig) % gsz); pn = (wgid % nig) / gsz; return true;
}

struct Unit { const u16* A; const u16* B; int a, b, c, d; float f0, f1; };

struct DFfnUp { P p; int layer, f; static constexpr int K = 1024, lda = 1024, ldb = 1024;
    HD bool unit(int L, Unit& u) const { int pm, pn; if (!rect_unit(L, MT / 256, 22, pm, pn)) return false;
        u.A = wsb(p, O_HN) + (size_t)pm * 256 * 1024; u.B = wsb(p, O_FFI + (size_t)(layer * 2 + f) * SZ_FFI1) + (size_t)pn * 256 * 1024; u.a = pm; u.b = pn; u.c = 0; u.d = 0; return true; }
    HD void emit(const Unit& u, int r, int c, f32x4 v00, f32x4 v01, f32x4 v10, f32x4 v11) const {
        u16* act = wsb(p, O_ACT); const size_t R = (size_t)u.a * 256 + r; const int col = u.b * 128 + c; f32x4 o0, o1;
        for (int j = 0; j < 4; ++j) { o0[j] = silu_f(v00[j]) * v01[j]; o1[j] = silu_f(v10[j]) * v11[j]; }
        st4bf(act + R * 2816 + col, o0); st4bf(act + (R + 128) * 2816 + col, o1); } };

HD void resid4(const P& p, int layer, int midx, float sc, int R, int col, f32x4 v) {
    float* h = hrow(p, R) + col; const float* m = modp(p, layer, R, midx) + col; f32x4 x = *(f32x4*)h;
    for (int j = 0; j < 4; ++j) x[j] += sc * m[j] * v[j];
    *(f32x4*)h = x; }

struct DFfnDown { P p; int layer, f, nM; static constexpr int K = 2816, lda = 2816, ldb = 2816;
    HD bool unit(int L, Unit& u) const { int pm, pn; if (!rect_unit(L, nM, 4, pm, pn)) return false;
        u.A = wsb(p, O_ACT) + (size_t)pm * 256 * 2816; u.B = wsb(p, O_FFO + (size_t)(layer * 2 + f) * SZ_FFO1) + (size_t)pn * 256 * 2816; u.a = pm; u.b = pn; u.c = 0; u.d = 0; return true; }
    HD void emit(const Unit& u, int r, int c, f32x4 v00, f32x4 v01, f32x4 v10, f32x4 v11) const {
        const int R = u.a * 256 + r, col = u.b * 256 + c, mi = f ? 8 : 2;
        resid4(p, layer, mi, 0.5f, R, col, v00); resid4(p, layer, mi, 0.5f, R, col + 128, v01); resid4(p, layer, mi, 0.5f, R + 128, col, v10); resid4(p, layer, mi, 0.5f, R + 128, col + 128, v11); } };

struct DMlaIn { P p; int j; static constexpr int K = 1024, lda = 1024, ldb = 1024;
    HD bool unit(int L, Unit& u) const { int pm, pn; if (!rect_unit(L, MT / 256, 3, pm, pn)) return false;
        u.A = wsb(p, O_HN) + (size_t)pm * 256 * 1024; u.B = wsb(p, O_MWIN + j * SZ_MWIN) + (size_t)pn * 256 * 1024; u.a = pm; u.b = pn; u.c = 0; u.d = 0; return true; }
    HD void emit(const Unit& u, int r, int c, f32x4 v00, f32x4 v01, f32x4 v10, f32x4 v11) const {
        float* o = (float*)(p.ws + O_CALL) + ((size_t)u.a * 256 + r) * 768 + u.b * 256 + c;
        *(f32x4*)o = v00; *(f32x4*)(o + 128) = v01; *(f32x4*)(o + (size_t)128 * 768) = v10; *(f32x4*)(o + (size_t)128 * 768 + 128) = v11; } };
struct DMlaUq { P p; int j; static constexpr int K = 384, lda = 384, ldb = 384;
    HD bool unit(int L, Unit& u) const { int pm, pn; if (!rect_unit(L, MT / 256, 6, pm, pn)) return false;
        u.A = wsb(p, O_CQN) + (size_t)pm * 256 * 384; u.B = wsb(p, O_MWUQ + j * SZ_MWUQ) + (size_t)pn * 256 * 384; u.a = pm; u.b = pn; u.c = 0; u.d = 0; return true; }
    HD void emit(const Unit& u, int r, int c, f32x4 v00, f32x4 v01, f32x4 v10, f32x4 v11) const {
        u16* o = wsb(p, O_CALL) + ((size_t)u.a * 256 + r) * 1536 + u.b * 256 + c;
        st4bf(o, v00); st4bf(o + 128, v01); st4bf(o + (size_t)128 * 1536, v10); st4bf(o + (size_t)128 * 1536 + 128, v11); } };
struct DMlaUkv { P p; int j; static constexpr int K = 256, lda = 256, ldb = 256;
    HD bool unit(int L, Unit& u) const { int pm, pn; if (!rect_unit(L, MT / 256, 8, pm, pn)) return false;
        u.A = wsb(p, O_CKVN) + (size_t)pm * 256 * 256; u.B = wsb(p, O_MWUKV + j * SZ_MWUKV) + (size_t)pn * 256 * 256; u.a = pm; u.b = pn; u.c = 0; u.d = 0; return true; }
    HD void one(size_t R, int col, f32x4 v) const {
        if (col < 1024) st4bf(wsb(p, O_KF) + R * 1536 + (col >> 7) * 192 + (col & 127), v);
        else st4bf(wsb(p, O_VB) + R * 1024 + (col - 1024), v); }
    HD void emit(const Unit& u, int r, int c, f32x4 v00, f32x4 v01, f32x4 v10, f32x4 v11) const {
        const size_t R = (size_t)u.a * 256 + r; const int col = u.b * 256 + c;
        one(R, col, v00); one(R, col + 128, v01); one(R + 128, col, v10); one(R + 128, col + 128, v11); } };
struct DMlaO { P p; int layer, j, nM; static constexpr int K = 1024, lda = 1024, ldb = 1024;
    HD bool unit(int L, Unit& u) const { int pm, pn; if (!rect_unit(L, nM, 4, pm, pn)) return false;
        u.A = wsb(p, O_HN) + (size_t)pm * 256 * 1024; u.B = wsb(p, O_MWO + j * SZ_MWO) + (size_t)pn * 256 * 1024; u.a = pm; u.b = pn; u.c = 0; u.d = 0; return true; }
    HD void emit(const Unit& u, int r, int c, f32x4 v00, f32x4 v01, f32x4 v10, f32x4 v11) const {
        const int R = u.a * 256 + r, col = u.b * 256 + c;
        resid4(p, layer, 5, 1.0f, R, col, v00); resid4(p, layer, 5, 1.0f, R, col + 128, v01); resid4(p, layer, 5, 1.0f, R + 128, col, v10); resid4(p, layer, 5, 1.0f, R + 128, col + 128, v11); } };

HD int ret_tokrow(int q, int cidx) { const int b = q * RGB + cidx / NCH, n = cidx % NCH; return n == 0 ? NL + b * 256 : b * SEQ + (n - 1) * 256; }
HD float ret_logg(const P& p, int dir, int h) { return log1pf(-expf(p.in[18][dir * 4 + h])); }
struct DRetProj { P p; int q; static constexpr int K = 1024, lda = 1024, ldb = 1024;
    HD bool unit(int L, Unit& u) const { int pm, pn; if (!rect_unit(L, NCQ, 16, pm, pn)) return false;
        const int wrow = pn < 8 ? pn * 256 : 4096 + (pn - 8) * 256;
        u.A = wsb(p, O_HN) + (size_t)ret_tokrow(q, pm) * 1024; u.B = wsb(p, O_RWIN) + (size_t)wrow * 1024; u.a = pm; u.b = pn; u.c = 0; u.d = 0;
        u.f0 = ret_logg(p, 0, pn & 3) * 1.4426950408889634f; u.f1 = ret_logg(p, 1, pn & 3) * 1.4426950408889634f; return true; }
    HD void emit(const Unit& u, int r, int c, f32x4 v00, f32x4 v01, f32x4 v10, f32x4 v11) const {
        const int cidx = u.a, pn = u.b, n = cidx % NCH;
        if (pn >= 8) { u16* g = wsb(p, O_GATE) + ((size_t)cidx * 256 + r) * 2048 + (pn - 8) * 256 + c;
            st4bf(g, v00); st4bf(g + 128, v01); st4bf(g + (size_t)128 * 2048, v10); st4bf(g + (size_t)128 * 2048 + 128, v11); return; }
        const int h = pn & 3; const bool isq = pn < 4;
        const float lgf = u.f0, lgb = u.f1;
        for (int X = 0; X < 2; ++X) { const int i = r + 128 * X; const f32x4 x1 = X ? v10 : v00, x2 = X ? v11 : v01; f32x4 r1, r2;
            for (int jx = 0; jx < 4; ++jx) { float cs = 1.f, sn = 0.f;
                if (n > 0) sincos_t((float)((n - 1) * 256 + i) * ropef(c + jx, 128), sn, cs);
                r1[jx] = x1[jx] * cs - x2[jx] * sn; r2[jx] = x2[jx] * cs + x1[jx] * sn; }
            if (isq) { u16* qn = wsb(p, O_QN) + ((size_t)cidx * 256 + i) * 1024 + h * 256 + c; st4bf(qn, r1); st4bf(qn + 128, r2);
                const float df = ex2(lgf * (float)(i + 1)), db = ex2(lgb * (float)(256 - i));
                u16* ae = wsb(p, O_AEXT) + (((size_t)h * NCQ + cidx) * 256 + i) * 768;
                st4bf(ae + 256 + c, r1 * df); st4bf(ae + 384 + c, r2 * df); st4bf(ae + 512 + c, r1 * db); st4bf(ae + 640 + c, r2 * db); }
            else { u16* kn = wsb(p, O_KN) + ((size_t)cidx * 256 + i) * 1024 + h * 256 + c; st4bf(kn, r1 * 0.0625f); st4bf(kn + 128, r2 * 0.0625f); } } } };
struct DRetProjT { P p; int q; static constexpr int K = 1024, lda = 1024, ldb = 1024;
    HD bool unit(int L, Unit& u) const { int pm, pn; if (!rect_unit(L, 12, NCQ, pm, pn)) return false;
        u.A = wsb(p, O_RWIN) + (size_t)(1024 + pm * 256) * 1024; u.B = wsb(p, O_HN) + (size_t)ret_tokrow(q, pn) * 1024; u.a = pm; u.b = pn; u.c = 0; u.d = 0;
        u.f0 = ret_logg(p, 0, pm & 3) * 1.4426950408889634f; u.f1 = ret_logg(p, 1, pm & 3) * 1.4426950408889634f; return true; }
    HD void emit(const Unit& u, int r, int c, f32x4 v00, f32x4 v01, f32x4 v10, f32x4 v11) const {
        const int pm = u.a, cidx = u.b, n = cidx % NCH;
        if (pm >= 4) { const int h = (pm - 4) >> 1, e0 = ((pm - 4) & 1) * 256 + r; u16* be = wsb(p, O_BEXT) + (((size_t)h * NCQ + cidx) * 512 + e0) * 768 + c;
            st4bf(be, v00); st4bf(be + 128, v01); st4bf(be + (size_t)128 * 768, v10); st4bf(be + (size_t)128 * 768 + 128, v11); return; }
        const int h = pm; const float lgf = u.f0, lgb = u.f1, fr = ropef(r, 128);
        u16* kf = wsb(p, O_KTX) + (((size_t)h * NCQ + cidx) * 2 + 0) * 65536; u16* kb = kf + 65536;
        for (int Y = 0; Y < 2; ++Y) { const f32x4 x1 = Y ? v01 : v00, x2 = Y ? v11 : v10; f32x4 f1, f2, b1, b2;
            for (int jx = 0; jx < 4; ++jx) { const int jj = c + 128 * Y + jx; float cs = 1.f, sn = 0.f;
                if (n > 0) sincos_t((float)((n - 1) * 256 + jj) * fr, sn, cs);
                const float r1 = (x1[jx] * cs - x2[jx] * sn) * 0.0625f, r2 = (x2[jx] * cs + x1[jx] * sn) * 0.0625f;
                const float df = ex2(lgf * (float)(255 - jj)), db = ex2(lgb * (float)jj);
                f1[jx] = r1 * df; f2[jx] = r2 * df; b1[jx] = r1 * db; b2[jx] = r2 * db; }
            const int jc = c + 128 * Y;
            st4bf(kf + (size_t)r * 256 + jc, f1); st4bf(kf + (size_t)(r + 128) * 256 + jc, f2); st4bf(kb + (size_t)r * 256 + jc, b1); st4bf(kb + (size_t)(r + 128) * 256 + jc, b2); } } };
struct DRetP { P p; static constexpr int K = 256, lda = 1024, ldb = 1024;
    HD bool unit(int L, Unit& u) const { int pm, pn; if (!rect_unit(L, NCQ, 4, pm, pn)) return false;
        u.A = wsb(p, O_QN) + (size_t)pm * 256 * 1024 + pn * 256; u.B = wsb(p, O_KN) + (size_t)pm * 256 * 1024 + pn * 256; u.a = pm; u.b = pn; u.c = 0; u.d = 0;
        u.f0 = ret_logg(p, 0, pn) * 1.4426950408889634f; u.f1 = ret_logg(p, 1, pn) * 1.4426950408889634f; return true; }
    HD void one(u16* ae, float lgf, float lgb, int i, int j0, f32x4 v) const { f32x4 o;
        for (int jx = 0; jx < 4; ++jx) { const int jj = j0 + jx; o[jx] = v[jx] * ex2(jj <= i ? lgf * (float)(i - jj) : lgb * (float)(jj - i)); }
        st4bf(ae + (size_t)i * 768 + j0, o); }
    HD void emit(const Unit& u, int r, int c, f32x4 v00, f32x4 v01, f32x4 v10, f32x4 v11) const {
        const int cidx = u.a, h = u.b; const float lgf = u.f0, lgb = u.f1;
        u16* ae = wsb(p, O_AEXT) + ((size_t)h * NCQ + cidx) * 256 * 768;
        one(ae, lgf, lgb, r, c, v00); one(ae, lgf, lgb, r, c + 128, v01); one(ae, lgf, lgb, r + 128, c, v10); one(ae, lgf, lgb, r + 128, c + 128, v11); } };
struct DRetL { P p; static constexpr int K = 256, lda = 768, ldb = 256;
    HD bool unit(int L, Unit& u) const { int pm, pn; if (!rect_unit(L, 4 * NCQ, 4, pm, pn)) return false;
        const int dir = pn >> 1, eh = pn & 1;
        u.A = wsb(p, O_BEXT) + ((size_t)pm * 512 + eh * 256) * 768; u.B = wsb(p, O_KTX) + ((size_t)pm * 2 + dir) * 65536; u.a = pm; u.b = dir; u.c = eh; u.d = 0; return true; }
    HD void emit(const Unit& u, int r, int c, f32x4 v00, f32x4 v01, f32x4 v10, f32x4 v11) const {
        u16* o = wsb(p, O_BEXT) + ((size_t)u.a * 512 + u.c * 256 + r) * 768 + 256 + u.b * 256 + c;
        st4bf(o, v00); st4bf(o + 128, v01); st4bf(o + (size_t)128 * 768, v10); st4bf(o + (size_t)128 * 768 + 128, v11); } };
struct DRetO { P p; static constexpr int K = 768, lda = 768, ldb = 768;
    HD bool unit(int L, Unit& u) const { int pm, pn; if (!rect_unit(L, 4 * NCQ, 2, pm, pn)) return false;
        u.A = wsb(p, O_AEXT) + (size_t)pm * 256 * 768; u.B = wsb(p, O_BEXT) + ((size_t)pm * 512 + pn * 256) * 768; u.a = pm; u.b = pn; u.c = 0; u.d = 0; return true; }
    HD void emit(const Unit& u, int r, int c, f32x4 v00, f32x4 v01, f32x4 v10, f32x4 v11) const {
        const int h = u.a / NCQ, cidx = u.a % NCQ;
        u16* o = wsb(p, O_OB) + ((size_t)cidx * 256 + r) * 2048 + h * 512 + u.b * 256 + c;
        st4bf(o, v00); st4bf(o + 128, v01); st4bf(o + (size_t)128 * 2048, v10); st4bf(o + (size_t)128 * 2048 + 128, v11); } };
struct DRetWo { P p; int layer, q; static constexpr int K = 2048, lda = 2048, ldb = 2048;
    HD bool unit(int L, Unit& u) const { int pm, pn; if (!rect_unit(L, NCQ, 4, pm, pn)) return false;
        u.A = wsb(p, O_OB) + (size_t)pm * 256 * 2048; u.B = wsb(p, O_RWO) + (size_t)pn * 256 * 2048; u.a = ret_tokrow(q, pm); u.b = pn; u.c = 0; u.d = 0; return true; }
    HD void emit(const Unit& u, int r, int c, f32x4 v00, f32x4 v01, f32x4 v10, f32x4 v11) const {
        const int R = u.a + r, col = u.b * 256 + c;
        resid4(p, layer, 5, 1.0f, R, col, v00); resid4(p, layer, 5, 1.0f, R, col + 128, v01); resid4(p, layer, 5, 1.0f, R + 128, col, v10); resid4(p, layer, 5, 1.0f, R + 128, col + 128, v11); } };

struct DS5L { P p; static constexpr int K = 512, lda = 768, ldb = 512;
    HD bool unit(int L, Unit& u) const { int pm, pn; if (!rect_unit(L, NROW5P / 256, 64, pm, pn)) return false;
        u.A = wsb(p, O_UEXT) + ((size_t)pn * NROW5P + pm * 256) * 768; u.B = wsb(p, O_FEXT) + (size_t)pn * 256 * 512; u.a = pm; u.b = pn; u.c = 0; u.d = 0; return true; }
    HD void emit(const Unit& u, int r, int c, f32x4 v00, f32x4 v01, f32x4 v10, f32x4 v11) const {
        u16* o = wsb(p, O_UEXT) + ((size_t)u.b * NROW5P + u.a * 256 + r) * 768 + 512 + c;
        st4bf(o, v00); st4bf(o + 128, v01); st4bf(o + (size_t)128 * 768, v10); st4bf(o + (size_t)128 * 768 + 128, v11); } };
struct DS5Y { P p; static constexpr int K = 768, lda = 768, ldb = 768;
    HD bool unit(int L, Unit& u) const { int pm, pn; if (!rect_unit(L, NROW5P / 256, 128, pm, pn)) return false;
        const int g = pn >> 1, ch = pn & 1;
        u.A = wsb(p, O_UEXT) + ((size_t)g * NROW5P + pm * 256) * 768; u.B = wsb(p, O_TEXT) + ((size_t)g * 512 + ch * 256) * 768; u.a = pm; u.b = g; u.c = ch; u.d = 0; return true; }
    HD void one(int g, int row, int col, f32x4 v) const {
        int tok; if (row < NB * S5L) tok = (row / S5L) * SEQ + (row % S5L) * 32; else if (row < NROW5) { const int rr = row - NB * S5L; tok = NL + (rr / S5C) * 256 + (rr % S5C) * 32; } else return;
        f32x4 o; for (int jx = 0; jx < 4; ++jx) o[jx] = gelu_f(v[jx]);
        st4bf(wsb(p, O_HN) + (size_t)(tok + (col >> 4)) * 1024 + g * 16 + (col & 15), o); }
    HD void emit(const Unit& u, int r, int c, f32x4 v00, f32x4 v01, f32x4 v10, f32x4 v11) const {
        const int row = u.a * 256 + r, col = u.c * 256 + c;
        one(u.b, row, col, v00); one(u.b, row, col + 128, v01); one(u.b, row + 128, col, v10); one(u.b, row + 128, col + 128, v11); } };
struct DS5Glu { P p; int layer; static constexpr int K = 1024, lda = 1024, ldb = 1024;
    HD bool unit(int L, Unit& u) const { int pm, pn; if (!rect_unit(L, MT / 256, 8, pm, pn)) return false;
        u.A = wsb(p, O_HN) + (size_t)pm * 256 * 1024; u.B = wsb(p, O_GLU) + (size_t)pn * 256 * 1024; u.a = pm; u.b = pn; u.c = 0; u.d = 0; return true; }
    HD void emit(const Unit& u, int r, int c, f32x4 v00, f32x4 v01, f32x4 v10, f32x4 v11) const {
        const int col = u.b * 128 + c; const float* gb = p.in[30]; f32x4 y0, y1;
        for (int jx = 0; jx < 4; ++jx) { const float ba = gb[col + jx], bg = gb[1024 + col + jx];
            y0[jx] = (v00[jx] + ba) * sigm_f(v01[jx] + bg); y1[jx] = (v10[jx] + ba) * sigm_f(v11[jx] + bg); }
        resid4(p, layer, 5, 1.0f, u.a * 256 + r, col, y0); resid4(p, layer, 5, 1.0f, u.a * 256 + r + 128, col, y1); } };

HD void cvt8(const float* src, int N, int srccol, u16* dst, int Kd, int nrow, int k0) {
    f32x4 a, b;
    for (int j = 0; j < 4; ++j) { a[j] = srccol >= 0 ? src[(size_t)(k0 + j) * N + srccol] : 0.f; b[j] = srccol >= 0 ? src[(size_t)(k0 + 4 + j) * N + srccol] : 0.f; }
    st4bf(dst + (size_t)nrow * Kd + k0, a); st4bf(dst + (size_t)nrow * Kd + k0 + 4, b); }
constexpr long CV_FFI = (long)8 * 5632 * 128, CV_FFO = (long)8 * 1024 * 352, CV_MWIN = (long)2 * 768 * 128, CV_MWUQ = (long)2 * 1536 * 48, CV_MWUKV = (long)2 * 2048 * 32,
               CV_MWO = (long)2 * 1024 * 128, CV_RWIN = (long)6144 * 128, CV_RWO = (long)1024 * 256, CV_GLU = (long)2048 * 128;
constexpr long CV_TOTAL = CV_FFI + CV_FFO + CV_MWIN + CV_MWUQ + CV_MWUKV + CV_MWO + CV_RWIN + CV_RWO + CV_GLU;
HD void cvt_item(const P& p, long idx) {
    if (idx < CV_FFI) { const int n = (int)(idx % 5632); const long t = idx / 5632; const int kb = (int)(t % 128), m = (int)(t / 128);
        const int tile = n >> 8, rr = n & 255; const int sc = rr < 128 ? tile * 128 + rr : 2816 + tile * 128 + (rr - 128);
        cvt8(p.in[7] + (size_t)m * 1024 * 5632, 5632, sc, wsb(p, O_FFI + (size_t)m * SZ_FFI1), 1024, n, kb * 8); return; }
    idx -= CV_FFI;
    if (idx < CV_FFO) { const int n = (int)(idx % 1024); const long t = idx / 1024; const int kb = (int)(t % 352), m = (int)(t / 352);
        cvt8(p.in[8] + (size_t)m * 2816 * 1024, 1024, n, wsb(p, O_FFO + (size_t)m * SZ_FFO1), 2816, n, kb * 8); return; }
    idx -= CV_FFO;
    if (idx < CV_MWIN) { const int n = (int)(idx % 768); const long t = idx / 768; const int kb = (int)(t % 128), m = (int)(t / 128);
        cvt8(p.in[9] + (size_t)m * 1024 * 704, 704, n < 704 ? n : -1, wsb(p, O_MWIN + (size_t)m * SZ_MWIN), 1024, n, kb * 8); return; }
    idx -= CV_MWIN;
    if (idx < CV_MWUQ) { const int n = (int)(idx % 1536); const long t = idx / 1536; const int kb = (int)(t % 48), m = (int)(t / 48);
        cvt8(p.in[12] + (size_t)m * 384 * 1536, 1536, n, wsb(p, O_MWUQ + (size_t)m * SZ_MWUQ), 384, n, kb * 8); return; }
    idx -= CV_MWUQ;
    if (idx < CV_MWUKV) { const int n = (int)(idx % 2048); const long t = idx / 2048; const int kb = (int)(t % 32), m = (int)(t / 32);
        const int sc = n < 1024 ? (n >> 7) * 256 + (n & 127) : ((n - 1024) >> 7) * 256 + 128 + (n & 127);
        cvt8(p.in[13] + (size_t)m * 256 * 2048, 2048, sc, wsb(p, O_MWUKV + (size_t)m * SZ_MWUKV), 256, n, kb * 8); return; }
    idx -= CV_MWUKV;
    if (idx < CV_MWO) { const int n = (int)(idx % 1024); const long t = idx / 1024; const int kb = (int)(t % 128), m = (int)(t / 128);
        cvt8(p.in[16] + (size_t)m * 1024 * 1024, 1024, n, wsb(p, O_MWO + (size_t)m * SZ_MWO), 1024, n, kb * 8); return; }
    idx -= CV_MWO;
    if (idx < CV_RWIN) { const int n = (int)(idx % 6144), kb = (int)(idx / 6144); cvt8(p.in[17], 6144, n, wsb(p, O_RWIN), 1024, n, kb * 8); return; }
    idx -= CV_RWIN;
    if (idx < CV_RWO) { const int n = (int)(idx % 1024), kb = (int)(idx / 1024); cvt8(p.in[20], 1024, n, wsb(p, O_RWO), 2048, n, kb * 8); return; }
    idx -= CV_RWO;
    { const int n = (int)(idx % 2048), kb = (int)(idx / 2048); const int tile = n >> 8, rr = n & 255; const int sc = rr < 128 ? tile * 128 + rr : 1024 + tile * 128 + (rr - 128);
      cvt8(p.in[29], 2048, sc, wsb(p, O_GLU), 1024, n, kb * 8); }
}
HD void mod_item(const P& p, int idx) {
    const int layer = idx / 9216, col = idx % 9216; const float* w = p.in[4] + (size_t)layer * 1024 * 9216 + col; float acc[NMR];
    for (int b = 0; b < NMR; ++b) acc[b] = 0.f;
    for (int k = 0; k < 1024; ++k) { const float wv = w[(size_t)k * 9216];
#pragma unroll
        for (int b = 0; b < NMR; ++b) { const float cv = b < NB ? p.in[1][b * 1024 + k] : p.in[3][k]; acc[b] += silu_f(cv) * wv; } }
    const float bias = p.in[5][layer * 9216 + col];
#pragma unroll
    for (int b = 0; b < NMR; ++b) ((float*)(p.ws + O_MOD))[(size_t)(layer * NMR + b) * 9216 + col] = acc[b] + bias; }
HD void copy_item(const P& p, long idx) {
    const long nl4 = (long)NL * 256;
    if (idx < nl4) ((f32x4*)p.out)[idx] = ((const f32x4*)p.in[0])[idx]; else ((f32x4*)(p.ws + O_G))[idx - nl4] = ((const f32x4*)p.in[2])[idx - nl4]; }
HD void norm_item(const P& p, int layer, int k, int r, int s5) {
    const float* x = hrow(p, r); float ss = 0.f;
    for (int d = 0; d < 1024; d += 4) { const f32x4 v = *(const f32x4*)(x + d); ss += v[0] * v[0] + v[1] * v[1] + v[2] * v[2] + v[3] * v[3]; }
    const float rinv = rsq_f(ss * (1.0f / 1024.0f) + EPS);
    const float* g = p.in[6] + (size_t)(layer * 3 + k) * 1024; const float* sh = modp(p, layer, r, 3 * k); const float* sc = modp(p, layer, r, 3 * k + 1);
    int row5 = 0, i5 = 0;
    if (s5) { if (r < NL) { const int b = r / SEQ, t = r % SEQ; row5 = b * S5L + t / 32; i5 = t % 32; } else { const int rr = r - NL; const int b = rr / 256, l = rr % 256; row5 = NB * S5L + b * S5C + l / 32; i5 = l % 32; } }
    for (int d = 0; d < 1024; d += 4) { const f32x4 v = *(const f32x4*)(x + d); f32x4 o;
        for (int j = 0; j < 4; ++j) o[j] = v[j] * rinv * g[d + j] * (1.0f + sc[d + j]) + sh[d + j];
        if (!s5) st4bf(wsb(p, O_HN) + (size_t)r * 1024 + d, o);
        else st4bf(wsb(p, O_UEXT) + ((size_t)(d >> 4) * NROW5P + row5) * 768 + i5 * 16 + (d & 15), o); } }
HD void axial_rot64(float* v, int t) {
    const int prow = t / 64, pcol = t % 64;
    for (int f = 0; f < 16; ++f) { const float fq = ropef(f, 16);
        { float cs, sn; sincos_t((float)prow * fq, sn, cs); const float x1 = v[f], x2 = v[16 + f]; v[f] = x1 * cs - x2 * sn; v[16 + f] = x2 * cs + x1 * sn; }
        { float cs, sn; sincos_t((float)pcol * fq, sn, cs); const float x1 = v[32 + f], x2 = v[48 + f]; v[32 + f] = x1 * cs - x2 * sn; v[48 + f] = x2 * cs + x1 * sn; } } }
HD void mla_row_item(const P& p, int j, int r) {
    const float* x = (const float*)(p.ws + O_CALL) + (size_t)r * 768; float ss = 0.f;
    for (int d = 0; d < 384; ++d) ss += x[d] * x[d];
    float rinv = rsq_f(ss * (1.0f / 384.0f) + EPS); const float* qn = p.in[10] + j * 384;
    for (int d = 0; d < 384; d += 4) { f32x4 o; for (int jx = 0; jx < 4; ++jx) o[jx] = x[d + jx] * rinv * qn[d + jx]; st4bf(wsb(p, O_CQN) + (size_t)r * 384 + d, o); }
    ss = 0.f; for (int d = 0; d < 256; ++d) ss += x[384 + d] * x[384 + d];
    rinv = rsq_f(ss * (1.0f / 256.0f) + EPS); const float* kvn = p.in[11] + j * 256;
    for (int d = 0; d < 256; d += 4) { f32x4 o; for (int jx = 0; jx < 4; ++jx) o[jx] = x[384 + d + jx] * rinv * kvn[d + jx]; st4bf(wsb(p, O_CKVN) + (size_t)r * 256 + d, o); }
    ss = 0.f; for (int d = 0; d < 64; ++d) ss += x[640 + d] * x[640 + d];
    rinv = rsq_f(ss * (1.0f / 64.0f) + EPS); const float* kg = p.in[15] + j * 192 + 128;
#ifdef HOST_EMU
    float kr[64];
    for (int d = 0; d < 64; ++d) kr[d] = x[640 + d] * rinv * kg[d];
    if (r < NL) axial_rot64(kr, r % SEQ);
    for (int h = 0; h < 8; ++h) for (int d = 0; d < 64; ++d) wsb(p, O_KF)[(size_t)r * 1536 + h * 192 + 128 + d] = f2bf(kr[d]);
#else
    const int t = r % SEQ, prow = t / 64, pcol = t % 64;
    for (int f = 0; f < 16; ++f) { const float fq = ropef(f, 16);
#pragma unroll
        for (int part = 0; part < 2; ++part) { float cs = 1.f, sn = 0.f; if (r < NL) sincos_t((float)(part ? pcol : prow) * fq, sn, cs);
            const int d1 = part * 32 + f, d2 = d1 + 16; const float x1 = x[640 + d1] * rinv * kg[d1], x2 = x[640 + d2] * rinv * kg[d2];
            const u16 o1 = f2bf(x1 * cs - x2 * sn), o2 = f2bf(x2 * cs + x1 * sn);
            for (int h = 0; h < 8; ++h) { wsb(p, O_KF)[(size_t)r * 1536 + h * 192 + 128 + d1] = o1; wsb(p, O_KF)[(size_t)r * 1536 + h * 192 + 128 + d2] = o2; } } }
#endif
}
HD void mla_head_item(const P& p, int j, int idx) {
    const int r = idx >> 3, h = idx & 7;
    u16* q = wsb(p, O_CALL) + (size_t)r * 1536 + h * 192; const float* qg = p.in[14] + j * 192; float ss = 0.f;
    for (int d = 0; d < 128; ++d) { const float v = bf2f(q[d]); ss += v * v; }
    float rinv = rsq_f(ss * (1.0f / 128.0f) + EPS);
    for (int d = 0; d < 128; ++d) q[d] = f2bf(bf2f(q[d]) * rinv * qg[d]);
    ss = 0.f; for (int d = 0; d < 64; ++d) { const float v = bf2f(q[128 + d]); ss += v * v; }
    rinv = rsq_f(ss * (1.0f / 64.0f) + EPS);
    { const int t = r % SEQ, prow = t / 64, pcol = t % 64;
      for (int f = 0; f < 16; ++f) { const float fq = ropef(f, 16);
#pragma unroll
        for (int part = 0; part < 2; ++part) { float cs = 1.f, sn = 0.f; if (r < NL) sincos_t((float)(part ? pcol : prow) * fq, sn, cs);
            const int d1 = 128 + part * 32 + f, d2 = d1 + 16; const float x1 = bf2f(q[d1]) * rinv * qg[d1], x2 = bf2f(q[d2]) * rinv * qg[d2];
            q[d1] = f2bf(x1 * cs - x2 * sn); q[d2] = f2bf(x2 * cs + x1 * sn); } } }
    u16* k = wsb(p, O_KF) + (size_t)r * 1536 + h * 192; const float* kg = p.in[15] + j * 192;
    ss = 0.f; for (int d = 0; d < 128; ++d) { const float v = bf2f(k[d]); ss += v * v; }
    rinv = rsq_f(ss * (1.0f / 128.0f) + EPS);
    for (int d = 0; d < 128; ++d) k[d] = f2bf(bf2f(k[d]) * rinv * kg[d]);
}
HD void ret_prefix_item(const P& p, int idx) {
    const int d4 = idx & 63, e = (idx >> 6) & 511, bq = (idx >> 15) % RGB, h = (idx >> 15) / RGB;
    const float gf = expf(256.f * ret_logg(p, 0, h)), gb = expf(256.f * ret_logg(p, 1, h));
    f32x4 cf = {0.f, 0.f, 0.f, 0.f}, cb = {0.f, 0.f, 0.f, 0.f};
    for (int n = 0; n < NCH; ++n) { u16* s = wsb(p, O_BEXT) + (((size_t)h * NCQ + bq * NCH + n) * 512 + e) * 768 + 256 + d4 * 4;
        f32x4 t; for (int j = 0; j < 4; ++j) t[j] = bf2f(s[j]);
        st4bf(s, cf); cf = cf * gf + t; }
    for (int s_ = 0; s_ < NCH; ++s_) { const int n = s_ == 0 ? 0 : NCH - s_; u16* s = wsb(p, O_BEXT) + (((size_t)h * NCQ + bq * NCH + n) * 512 + e) * 768 + 512 + d4 * 4;
        f32x4 t; for (int j = 0; j < 4; ++j) t[j] = bf2f(s[j]);
        st4bf(s, cb); cb = cb * gb + t; } }
HD void ret_norm_item(const P& p, int idx) {
    const int lr = idx >> 2, h = idx & 3; u16* o = wsb(p, O_OB) + (size_t)lr * 2048 + h * 512; const u16* g = wsb(p, O_GATE) + (size_t)lr * 2048 + h * 512; const float* gg = p.in[19] + h * 512;
    float s = 0.f; for (int e = 0; e < 512; ++e) s += bf2f(o[e]);
    const float mu = s * (1.0f / 512.0f); float q = 0.f; for (int e = 0; e < 512; ++e) { const float d = bf2f(o[e]) - mu; q += d * d; }
    const float rstd = rsq_f(q * (1.0f / 512.0f) + EPS);
    for (int e = 0; e < 512; ++e) o[e] = f2bf((bf2f(o[e]) - mu) * rstd * gg[e] * silu_f(bf2f(g[e]))); }
struct Cx { float re, im; };
HD Cx cmul(Cx a, Cx b) { Cx r; r.re = a.re * b.re - a.im * b.im; r.im = a.re * b.im + a.im * b.re; return r; }
HD Cx s5_alog(const P& p, int dir, int g, int pp) { const float dt = expf(p.in[23][dir * 64 + g]); Cx r; r.re = p.in[21][(dir * 64 + g) * 64 + pp] * dt; r.im = p.in[22][(dir * 64 + g) * 64 + pp] * dt; return r; }
HD Cx cpowa(Cx al, float n) { const float m = expf(al.re * n); float sn, cs; sincos_t(al.im * n * 0.15915494309189535f, sn, cs); Cx r; r.re = m * cs; r.im = m * sn; return r; }
HD Cx s5_coef(const P& p, int dir, int g, int pp) {
    const Cx al = s5_alog(p, dir, g, pp); Cx a = cpowa(al, 1.f); a.re -= 1.f; const float lr = p.in[21][(dir * 64 + g) * 64 + pp], li = p.in[22][(dir * 64 + g) * 64 + pp], den = 1.0f / (lr * lr + li * li);
    Cx r; r.re = (a.re * lr + a.im * li) * den; r.im = (a.im * lr - a.re * li) * den; return r; }
HD Cx s5_bbar(const P& p, int dir, int g, int pp, int m) { Cx b; const size_t o = (((size_t)dir * 64 + g) * 64 + pp) * 16 + m; b.re = p.in[24][o]; b.im = p.in[25][o]; return cmul(s5_coef(p, dir, g, pp), b); }
HD Cx s5_c(const P& p, int dir, int g, int m, int pp) { Cx c; const size_t o = (((size_t)dir * 64 + g) * 16 + m) * 64 + pp; c.re = p.in[26][o]; c.im = p.in[27][o]; return c; }
HD void s5_ktab_item(const P& p, int idx) {
    const int m2 = idx & 15, m = (idx >> 4) & 15, tau = (idx >> 8) & 31, dir = (idx >> 13) & 1, g = idx >> 14; float acc = 0.f;
    for (int pp = 0; pp < 64; ++pp) { const Cx w = cmul(cmul(s5_c(p, dir, g, m, pp), cpowa(s5_alog(p, dir, g, pp), (float)tau)), s5_bbar(p, dir, g, pp, m2)); acc += w.re; }
    ((float*)(p.ws + O_KTAB))[idx] = acc; }
HD void s5_text_item(const P& p, long idx) {
    const int col = (int)(idx % 768); const long t = idx / 768; const int row = (int)(t % 512), g = (int)(t / 512), i = row >> 4, m = row & 15; float v;
    const float* kt = (const float*)(p.ws + O_KTAB);
    if (col < 512) { const int jj = col >> 4, m2 = col & 15; v = 0.f;
        if (jj <= i) v += kt[((((size_t)g * 2 + 0) * 32 + (i - jj)) * 16 + m) * 16 + m2];
        if (jj >= i) v += kt[((((size_t)g * 2 + 1) * 32 + (jj - i)) * 16 + m) * 16 + m2];
        if (jj == i && m == m2) v += p.in[28][g * 16 + m]; }
    else { const int dir = col >= 640, pp = ((col - 512) & 127) >> 1, part = col & 1;
        const Cx w = cmul(s5_c(p, dir, g, m, pp), cpowa(s5_alog(p, dir, g, pp), dir ? (float)(32 - i) : (float)(i + 1))); v = part ? -w.im : w.re; }
    wsb(p, O_TEXT)[idx] = f2bf(v); }
HD void s5_fext_item(const P& p, int idx) {
    const int col = idx & 511, row = (idx >> 9) & 255, g = idx >> 17, jj = col >> 4, m2 = col & 15, dir = row >> 7, pp = (row & 127) >> 1, part = row & 1;
    const Cx w = cmul(cpowa(s5_alog(p, dir, g, pp), dir ? (float)jj : (float)(31 - jj)), s5_bbar(p, dir, g, pp, m2));
    wsb(p, O_FEXT)[idx] = f2bf(part ? w.im : w.re); }
HD int s5_row(int b, int s) { return s < S5C ? NB * S5L + b * S5C + s : b * S5L + (s - S5C); }
HD void s5_prefix_item(const P& p, int idx) {
    const int pp = idx & 63, b = (idx >> 6) % NB, g = (idx >> 6) / NB;
    const Cx af = cpowa(s5_alog(p, 0, g, pp), 32.f), ab = cpowa(s5_alog(p, 1, g, pp), 32.f);
    u16* base = wsb(p, O_UEXT) + (size_t)g * NROW5P * 768; Cx c; c.re = 0.f; c.im = 0.f;
    for (int s = 0; s < S5C + S5L; ++s) { u16* q = base + (size_t)s5_row(b, s) * 768 + 512 + 2 * pp; Cx t; t.re = bf2f(q[0]); t.im = bf2f(q[1]);
        q[0] = f2bf(c.re); q[1] = f2bf(c.im); c = cmul(af, c); c.re += t.re; c.im += t.im; }
    c.re = 0.f; c.im = 0.f;
    for (int s_ = 0; s_ < S5C + S5L; ++s_) { const int s = s_ < S5C ? S5C - 1 - s_ : S5C + S5L - 1 - (s_ - S5C); u16* q = base + (size_t)s5_row(b, s) * 768 + 640 + 2 * pp; Cx t; t.re = bf2f(q[0]); t.im = bf2f(q[1]);
        q[0] = f2bf(c.re); q[1] = f2bf(c.im); c = cmul(ab, c); c.re += t.re; c.im += t.im; } }

struct AttItem { const u16* q; const u16* k0; const u16* k1; const u16* v0; const u16* v1; u16* o; int n0, ntot; };
HD void att_item(const P& p, int it, AttItem& a) {
    const u16* Q = wsb(p, O_CALL); const u16* KF = wsb(p, O_KF); const u16* VB = wsb(p, O_VB); u16* O = wsb(p, O_HN);
    const int nlat = NB * 8 * (SEQ / 256);
    if (it < nlat) { const int qb = it % (SEQ / 256), h = (it / (SEQ / 256)) & 7, b = it / (SEQ / 256) / 8; const size_t r0 = (size_t)b * SEQ + qb * 256, c0 = (size_t)NL + b * 256, l0 = (size_t)b * SEQ;
        a.q = Q + r0 * 1536 + h * 192; a.o = O + r0 * 1024 + h * 128; a.k0 = KF + c0 * 1536 + h * 192; a.v0 = VB + c0 * 1024 + h * 128; a.k1 = KF + l0 * 1536 + h * 192; a.v1 = VB + l0 * 1024 + h * 128; a.n0 = 256; a.ntot = 256 + SEQ; }
    else { const int x = it - nlat, h = x & 7, b = x >> 3; const size_t c0 = (size_t)NL + b * 256;
        a.q = Q + c0 * 1536 + h * 192; a.o = O + c0 * 1024 + h * 128; a.k0 = KF + c0 * 1536 + h * 192; a.v0 = VB + c0 * 1024 + h * 128; a.k1 = a.k0; a.v1 = a.v0; a.n0 = 256; a.ntot = 256; } }
constexpr float ATT_SCALE = 0.07216878364870322f;

#ifndef HOST_EMU
#define LAS __attribute__((address_space(3)))
typedef short bf16x8 __attribute__((ext_vector_type(8)));
typedef short s16x4 __attribute__((ext_vector_type(4)));
typedef float f32x16 __attribute__((ext_vector_type(16)));
typedef unsigned u32x4 __attribute__((ext_vector_type(4)));
constexpr int HTB = 128 * 64 * 2, STAGE_BYTES = 8 * HTB;
__device__ __forceinline__ int lds_byte(int r, int c) { const int st = (r >> 4) * 2 + (c >> 5), rr = r & 15, cc = c & 31, ob = rr * 64 + cc * 2; return st * 1024 + (ob ^ (((ob >> 9) & 1) << 5)); }
__device__ __forceinline__ void stage_rc(int b, int& R, int& C) { const int st = b / 1024, sb = b % 1024, swz = sb ^ (((sb >> 9) & 1) << 5); R = (st >> 1) * 16 + swz / 64; C = (st & 1) * 32 + (swz % 64) / 2; }

template <class Dsc>
__device__ __forceinline__ void gemm_run(LAS unsigned char* lds, const Dsc& D) {
    int tid_ = threadIdx.x; asm volatile("" : "+v"(tid_));
    const int tid = tid_, wid = __builtin_amdgcn_readfirstlane(tid >> 6), lane = tid & 63, wr = wid >> 2, wc = wid & 3, fr = lane & 15, fq = lane >> 4;
    constexpr int K = Dsc::K, nt = K / 64, lda = Dsc::lda, ldb = Dsc::ldb;
    static_assert(K % 128 == 0 && K >= 256, "K");
    unsigned voffA[2], voffB[2];
#pragma unroll
    for (int i = 0; i < 2; ++i) { int R, C; stage_rc(tid * 16 + i * 8192, R, C); voffA[i] = (unsigned)(R * lda + C) * 2u; voffB[i] = (unsigned)(R * ldb + C) * 2u; }
    constexpr size_t kstep = 128, hstepA = (size_t)128 * lda * 2, hstepB = (size_t)128 * ldb * 2;
    const unsigned ldsw = (unsigned)wid * 1024u;
    const int aoff = lds_byte(wr * 64 + fr, fq * 8), boff = lds_byte(wc * 32 + fr, fq * 8);
#define G_SA(b, h) (((b) * 2 + (h)) * HTB)
#define G_SB(b, h) ((4 + (b) * 2 + (h)) * HTB)
#define G_STAGE(bufoff, gbase, voff) do { _Pragma("unroll") for (int _i = 0; _i < 2; ++_i) \
        __builtin_amdgcn_global_load_lds((const unsigned*)((const char*)(gbase) + (voff)[_i]), (LAS unsigned*)(lds + (bufoff) + ldsw + _i * 8192), 16, 0, 0); } while (0)
#define G_LDA(dst, b, h) do { _Pragma("unroll") for (int m = 0; m < 4; ++m) _Pragma("unroll") for (int k = 0; k < 2; ++k) dst[m][k] = *(const LAS bf16x8*)(lds + G_SA(b, h) + aoff + m * 2048 + k * 1024); } while (0)
#define G_LDB(dst, b, h) do { _Pragma("unroll") for (int n = 0; n < 2; ++n) _Pragma("unroll") for (int k = 0; k < 2; ++k) dst[n][k] = *(const LAS bf16x8*)(lds + G_SB(b, h) + boff + n * 2048 + k * 1024); } while (0)
#define G_MMA(ai, bj, At, Bt) do { __builtin_amdgcn_s_setprio(1); _Pragma("unroll") for (int m = 0; m < 4; ++m) _Pragma("unroll") for (int n = 0; n < 2; ++n) _Pragma("unroll") for (int k = 0; k < 2; ++k) \
        acc[ai][bj][m][n] = __builtin_amdgcn_mfma_f32_16x16x32_bf16(Bt[n][k], At[m][k], acc[ai][bj][m][n], 0, 0, 0); __builtin_amdgcn_s_setprio(0); } while (0)
#define G_WAIT_V(n) asm volatile("s_waitcnt vmcnt(" #n ")" ::: "memory")
#define G_WAIT_L(n) asm volatile("s_waitcnt lgkmcnt(" #n ")" ::: "memory")
#define G_BAR __builtin_amdgcn_s_barrier()
#define G_SCHED __builtin_amdgcn_sched_barrier(0)
    Unit cur{}, nxt{}; int ui = 0; const int G = gridDim.x, cb = blockIdx.x;
    if (!D.unit(cb, cur)) return;
    f32x4 acc[2][2][4][2];
#pragma unroll
    for (int a = 0; a < 2; ++a)
#pragma unroll
        for (int b = 0; b < 2; ++b)
#pragma unroll
            for (int m = 0; m < 4; ++m)
#pragma unroll
                for (int n = 0; n < 2; ++n) acc[a][b][m][n] = (f32x4){0.f, 0.f, 0.f, 0.f};
    bf16x8 At[4][2], B0[2][2], B1[2][2];
    const char* cA = (const char*)cur.A; const char* cB = (const char*)cur.B;
    G_STAGE(G_SB(0, 0), cB, voffB); G_STAGE(G_SA(0, 0), cA, voffA); G_STAGE(G_SB(0, 1), cB + hstepB, voffB); G_STAGE(G_SA(0, 1), cA + hstepA, voffA);
    if (wr == 1) G_BAR;
    G_WAIT_V(4); G_BAR;
    G_STAGE(G_SB(1, 0), cB + kstep, voffB); G_STAGE(G_SA(1, 0), cA + kstep, voffA); G_STAGE(G_SB(1, 1), cB + hstepB + kstep, voffB);
    G_WAIT_V(6); G_BAR;
    for (;;) {
        const bool has_next = D.unit((ui + 1) * G + cb, nxt);
        const char* nA = has_next ? (const char*)nxt.A : cA; const char* nB = has_next ? (const char*)nxt.B : cB;
        _Pragma("nounroll") for (int t = 0; t < nt; t += 2) {
            const bool last = (t == nt - 2);
            const char* a1 = cA + (size_t)(t + 1) * kstep;
            const char* a2 = last ? nA : cA + (size_t)(t + 2) * kstep; const char* b2 = last ? nB : cB + (size_t)(t + 2) * kstep;
            const char* a3 = a2 + kstep; const char* b3 = b2 + kstep;
            G_LDB(B0, 0, 0); G_SCHED; G_LDA(At, 0, 0); G_STAGE(G_SA(1, 1), a1 + hstepA, voffA);
            G_WAIT_L(8); G_BAR; G_WAIT_L(0); G_MMA(0, 0, At, B0); G_BAR; G_SCHED;
            G_LDB(B1, 0, 1); G_STAGE(G_SB(0, 0), b2, voffB);
            G_BAR; G_WAIT_L(0); G_MMA(0, 1, At, B1); G_BAR;
            G_LDA(At, 0, 1); G_STAGE(G_SA(0, 0), a2, voffA);
            G_BAR; G_WAIT_L(0); G_MMA(1, 0, At, B0); G_BAR; G_SCHED;
            G_STAGE(G_SB(0, 1), b2 + hstepB, voffB);
            G_WAIT_V(6); G_BAR; G_MMA(1, 1, At, B1); G_BAR;
            G_LDB(B0, 1, 0); G_SCHED; G_LDA(At, 1, 0); G_STAGE(G_SA(0, 1), a2 + hstepA, voffA);
            G_WAIT_L(8); G_BAR; G_WAIT_L(0); G_MMA(0, 0, At, B0); G_BAR; G_SCHED;
            G_LDB(B1, 1, 1); G_STAGE(G_SB(1, 0), b3, voffB);
            G_BAR; G_WAIT_L(0); G_MMA(0, 1, At, B1); G_BAR;
            G_LDA(At, 1, 1); G_STAGE(G_SA(1, 0), a3, voffA);
            G_BAR; G_WAIT_L(0); G_MMA(1, 0, At, B0); G_BAR; G_SCHED;
            G_STAGE(G_SB(1, 1), b3 + hstepB, voffB);
            G_WAIT_V(6); G_BAR; G_MMA(1, 1, At, B1); G_BAR;
        }
        int er_ = wr * 64 + fr, ec_ = wc * 32 + fq * 4; asm volatile("" : "+v"(er_), "+v"(ec_));
#pragma unroll
        for (int m = 0; m < 4; ++m)
#pragma unroll
            for (int n = 0; n < 2; ++n) { D.emit(cur, er_ + m * 16, ec_ + n * 16, acc[0][0][m][n], acc[0][1][m][n], acc[1][0][m][n], acc[1][1][m][n]); asm volatile("" ::: "memory"); }
        if (!has_next) break;
#pragma unroll
        for (int a = 0; a < 2; ++a)
#pragma unroll
            for (int b = 0; b < 2; ++b)
#pragma unroll
                for (int m = 0; m < 4; ++m)
#pragma unroll
                    for (int n = 0; n < 2; ++n) acc[a][b][m][n] = (f32x4){0.f, 0.f, 0.f, 0.f};
        cur = nxt; cA = nA; cB = nB; ++ui;
    }
    G_WAIT_V(0);
    if (wr == 0) G_BAR;
    G_BAR;
#undef G_SA
#undef G_SB
#undef G_STAGE
#undef G_LDA
#undef G_LDB
#undef G_MMA
#undef G_WAIT_V
#undef G_WAIT_L
#undef G_BAR
#undef G_SCHED
}

constexpr int A_SHM_V = 64 * 128 * 2, A_SHM_K = 64 * 192 * 2;
#define KSWZ(row, colB) ((row) * 384 + ((colB) ^ (((row) & 7) << 4)))
__device__ __forceinline__ int crow(int r, int hi) { return (r & 3) + 8 * (r >> 2) + 4 * hi; }
__device__ __forceinline__ unsigned cvtpk(float lo, float hi) { unsigned r; asm volatile("v_cvt_pk_bf16_f32 %0, %1, %2" : "=v"(r) : "v"(lo), "v"(hi)); return r; }
__device__ __forceinline__ int v_st(int k, int c) { const int kk = (k & ~0xC) | ((k & 4) << 1) | ((k & 8) >> 1); return ((kk >> 3) * 4 + (c >> 5)) * 512 + ((kk & 7) * 32 + (c & 31)) * 2; }
__device__ __forceinline__ int v_rd_base(int lane) { return ((lane & 3) << 3) | (((lane >> 2) & 3) << 6) | (((lane >> 4) & 1) << 5) | (((lane >> 5) & 1) << 8); }
constexpr int v_rd_off(int d0, int ks, int half) { return d0 * 512 + ks * 4096 + half * 2048; }
template <int OFF> __device__ __forceinline__ s16x4 tr_read(int vb) { s16x4 r; asm volatile("ds_read_b64_tr_b16 %0, %1 offset:%2" : "=&v"(r) : "v"(vb), "i"(OFF) : "memory"); return r; }
template <int D0> __device__ __forceinline__ void pv_one(f32x16& od, int vb, bf16x8 pa0, bf16x8 pa1, bf16x8 pa2, bf16x8 pa3) {
    const s16x4 l0 = tr_read<v_rd_off(D0, 0, 0)>(vb), h0 = tr_read<v_rd_off(D0, 0, 1)>(vb), l1 = tr_read<v_rd_off(D0, 1, 0)>(vb), h1 = tr_read<v_rd_off(D0, 1, 1)>(vb);
    const s16x4 l2 = tr_read<v_rd_off(D0, 2, 0)>(vb), h2 = tr_read<v_rd_off(D0, 2, 1)>(vb), l3 = tr_read<v_rd_off(D0, 3, 0)>(vb), h3 = tr_read<v_rd_off(D0, 3, 1)>(vb);
    asm volatile("s_waitcnt lgkmcnt(0)" ::: "memory"); __builtin_amdgcn_sched_barrier(0);
#define PK(L, H) (bf16x8){L[0], L[1], L[2], L[3], H[0], H[1], H[2], H[3]}
    od = __builtin_amdgcn_mfma_f32_32x32x16_bf16(pa0, PK(l0, h0), od, 0, 0, 0);
    od = __builtin_amdgcn_mfma_f32_32x32x16_bf16(pa1, PK(l1, h1), od, 0, 0, 0);
    od = __builtin_amdgcn_mfma_f32_32x32x16_bf16(pa2, PK(l2, h2), od, 0, 0, 0);
    od = __builtin_amdgcn_mfma_f32_32x32x16_bf16(pa3, PK(l3, h3), od, 0, 0, 0);
#undef PK
}
__device__ __forceinline__ void att_body(const AttItem& a, char* lds) {
    int tid_ = threadIdx.x; asm volatile("" : "+v"(tid_));
    const int tid = tid_, wid = tid >> 6, lane = tid & 63, r32 = lane & 31, hi = lane >> 5;
    char* V_lds = lds; char* K_lds = lds + 2 * A_SHM_V; float* li_l = (float*)(lds + 2 * A_SHM_V + 2 * A_SHM_K) + wid * 64;
    float l_reg = 0.f; f32x16 o[4] = {}; bf16x8 qr[12];
    const u16* Qw = a.q + (size_t)(wid * 32 + r32) * 1536 + hi * 8;
#pragma unroll
    for (int d0 = 0; d0 < 12; ++d0) qr[d0] = *(const bf16x8*)(Qw + d0 * 16);
    const int sr = tid >> 4, sc = (tid & 15) * 8, vst0 = v_st(sr, sc), vst1 = v_st(32 + sr, sc);
    const int voff0 = sr * 1024 + sc, voff1 = (32 + sr) * 1024 + sc;
    int koff[3], kwr[3];
#pragma unroll
    for (int i = 0; i < 3; ++i) { const int id = tid + i * 512, kr_ = id / 24, kc_ = (id % 24) * 8; koff[i] = kr_ * 1536 + kc_; kwr[i] = KSWZ(kr_, kc_ * 2); }
    const int vb0 = (int)(uintptr_t)V_lds + v_rd_base(lane);
    bf16x8 vs0, vs1, ks[3];
    const int NT = a.ntot / 64;
#define A_SLOAD(k0_) do { const int key0_ = (k0_); const u16* kb_ = key0_ < a.n0 ? a.k0 + (size_t)key0_ * 1536 : a.k1 + (size_t)(key0_ - a.n0) * 1536; \
        const u16* vbp_ = key0_ < a.n0 ? a.v0 + (size_t)key0_ * 1024 : a.v1 + (size_t)(key0_ - a.n0) * 1024; \
        vs0 = *(const bf16x8*)(vbp_ + voff0); vs1 = *(const bf16x8*)(vbp_ + voff1); \
        _Pragma("unroll") for (int i = 0; i < 3; ++i) ks[i] = *(const bf16x8*)(kb_ + koff[i]); } while (0)
#define A_SWRITE(b) do { *(bf16x8*)(V_lds + (b) * A_SHM_V + vst0) = vs0; *(bf16x8*)(V_lds + (b) * A_SHM_V + vst1) = vs1; \
        _Pragma("unroll") for (int i = 0; i < 3; ++i) *(bf16x8*)(K_lds + (b) * A_SHM_K + kwr[i]) = ks[i]; } while (0)
    A_SLOAD(0); A_SWRITE(0); __syncthreads();
    constexpr float C = ATT_SCALE * 1.4426950408889634f;
    _Pragma("nounroll") for (int j = 0; j < NT; ++j) {
        const int buf = j & 1;
        if (j + 1 < NT) A_SLOAD((j + 1) * 64);
        f32x16 p0 = {}, p1 = {};
        const char* Ks = K_lds + buf * A_SHM_K;
#pragma unroll
        for (int d0 = 0; d0 < 12; ++d0) { const int cbb = (d0 * 16 + hi * 8) * 2;
            const bf16x8 b0 = *(const bf16x8*)(Ks + KSWZ(r32, cbb)); const bf16x8 b1 = *(const bf16x8*)(Ks + KSWZ(32 + r32, cbb));
            p0 = __builtin_amdgcn_mfma_f32_32x32x16_bf16(b0, qr[d0], p0, 0, 0, 0);
            p1 = __builtin_amdgcn_mfma_f32_32x32x16_bf16(b1, qr[d0], p1, 0, 0, 0); }
        float ps = 0.f;
#pragma unroll
        for (int r = 0; r < 16; ++r) { p0[r] = __builtin_amdgcn_exp2f(p0[r] * C); p1[r] = __builtin_amdgcn_exp2f(p1[r] * C); ps += p0[r] + p1[r]; }
        { auto rr = __builtin_amdgcn_permlane32_swap(__float_as_uint(ps), __float_as_uint(ps), false, false); ps = __uint_as_float(rr[0]) + __uint_as_float(rr[1]); }
        l_reg += ps;
        bf16x8 pa0, pa1, pa2, pa3;
#define PK4(Pv, BASE, OUT) do { unsigned a0 = cvtpk(Pv[BASE + 0], Pv[BASE + 1]), a1 = cvtpk(Pv[BASE + 2], Pv[BASE + 3]); \
        unsigned b0 = cvtpk(Pv[BASE + 4], Pv[BASE + 5]), b1 = cvtpk(Pv[BASE + 6], Pv[BASE + 7]); \
        auto r0 = __builtin_amdgcn_permlane32_swap(a0, b0, false, false); auto r1 = __builtin_amdgcn_permlane32_swap(a1, b1, false, false); \
        u32x4 w = {r0[0], r1[0], r0[1], r1[1]}; OUT = *reinterpret_cast<bf16x8*>(&w); } while (0)
        PK4(p0, 0, pa0); PK4(p0, 8, pa1); PK4(p1, 0, pa2); PK4(p1, 8, pa3);
#undef PK4
        const int vb = vb0 + buf * A_SHM_V;
        pv_one<0>(o[0], vb, pa0, pa1, pa2, pa3); pv_one<1>(o[1], vb, pa0, pa1, pa2, pa3); pv_one<2>(o[2], vb, pa0, pa1, pa2, pa3); pv_one<3>(o[3], vb, pa0, pa1, pa2, pa3);
        if (j + 1 < NT) A_SWRITE(buf ^ 1);
        __syncthreads();
    }
    if (hi == 0) li_l[r32] = l_reg;
    asm volatile("s_waitcnt lgkmcnt(0)" ::: "memory");
    __builtin_amdgcn_wave_barrier();
    u16* Ow = a.o + (size_t)(wid * 32) * 1024;
#pragma unroll
    for (int r = 0; r < 16; ++r) { const int orow = crow(r, hi); const float rl = 1.0f / li_l[orow];
#pragma unroll
        for (int d0 = 0; d0 < 4; ++d0) Ow[(size_t)orow * 1024 + d0 * 32 + r32] = f2bf(o[d0][r] * rl); }
    __syncthreads();
#undef A_SLOAD
#undef A_SWRITE
}

__device__ __forceinline__ float wsum(float v) { for (int o = 32; o >= 1; o >>= 1) v += __shfl_xor(v, o); return v; }
__device__ __forceinline__ void norm_wave(const P& p, int layer, int k, int r, int s5, int lane) {
    const float* x = hrow(p, r); f32x4 v[4]; float ss = 0.f;
#pragma unroll
    for (int i = 0; i < 4; ++i) { v[i] = *(const f32x4*)(x + i * 256 + lane * 4); ss += v[i][0] * v[i][0] + v[i][1] * v[i][1] + v[i][2] * v[i][2] + v[i][3] * v[i][3]; }
    ss = wsum(ss); const float rinv = rsq_f(ss * (1.0f / 1024.0f) + EPS);
    const float* g = p.in[6] + (size_t)(layer * 3 + k) * 1024; const float* sh = modp(p, layer, r, 3 * k); const float* sc = modp(p, layer, r, 3 * k + 1);
    int row5 = 0, i5 = 0;
    if (s5) { if (r < NL) { const int b = r / SEQ, t = r % SEQ; row5 = b * S5L + t / 32; i5 = t % 32; } else { const int rr = r - NL; const int b = rr / 256, l = rr % 256; row5 = NB * S5L + b * S5C + l / 32; i5 = l % 32; } }
#pragma unroll
    for (int i = 0; i < 4; ++i) { const int d = i * 256 + lane * 4; const f32x4 gv = *(const f32x4*)(g + d), sv = *(const f32x4*)(sc + d), hv = *(const f32x4*)(sh + d); f32x4 o;
        for (int j = 0; j < 4; ++j) o[j] = v[i][j] * rinv * gv[j] * (1.0f + sv[j]) + hv[j];
        if (!s5) st4bf(wsb(p, O_HN) + (size_t)r * 1024 + d, o);
        else st4bf(wsb(p, O_UEXT) + ((size_t)(d >> 4) * NROW5P + row5) * 768 + i5 * 16 + (d & 15), o); } }
__device__ __forceinline__ void mla_row_wave(const P& p, int j, int r, int lane) {
    const float* x = (const float*)(p.ws + O_CALL) + (size_t)r * 768; f32x4 c[3]; float q[3];
#pragma unroll
    for (int i = 0; i < 3; ++i) { c[i] = *(const f32x4*)(x + i * 256 + lane * 4); q[i] = c[i][0] * c[i][0] + c[i][1] * c[i][1] + c[i][2] * c[i][2] + c[i][3] * c[i][3]; }
    const bool lo = lane < 32;
    const float ssq = wsum(q[0] + (lo ? q[1] : 0.f)), sskv = wsum((lo ? 0.f : q[1]) + (lo ? q[2] : 0.f)), ssr = wsum((lane >= 32 && lane < 48) ? q[2] : 0.f);
    const float rq = rsq_f(ssq * (1.0f / 384.0f) + EPS), rkv = rsq_f(sskv * (1.0f / 256.0f) + EPS), rr_ = rsq_f(ssr * (1.0f / 64.0f) + EPS);
    const float* qn = p.in[10] + j * 384; const float* kvn = p.in[11] + j * 256; const float* kg = p.in[15] + j * 192 + 128;
    { const f32x4 gq = *(const f32x4*)(qn + lane * 4); f32x4 o; for (int jx = 0; jx < 4; ++jx) o[jx] = c[0][jx] * rq * gq[jx]; st4bf(wsb(p, O_CQN) + (size_t)r * 384 + lane * 4, o); }
    if (lo) { const f32x4 gq = *(const f32x4*)(qn + 256 + lane * 4); f32x4 o; for (int jx = 0; jx < 4; ++jx) o[jx] = c[1][jx] * rq * gq[jx]; st4bf(wsb(p, O_CQN) + (size_t)r * 384 + 256 + lane * 4, o);
        const f32x4 gk = *(const f32x4*)(kvn + 128 + lane * 4); f32x4 o2; for (int jx = 0; jx < 4; ++jx) o2[jx] = c[2][jx] * rkv * gk[jx]; st4bf(wsb(p, O_CKVN) + (size_t)r * 256 + 128 + lane * 4, o2); }
    else { const f32x4 gk = *(const f32x4*)(kvn + lane * 4 - 128); f32x4 o; for (int jx = 0; jx < 4; ++jx) o[jx] = c[1][jx] * rkv * gk[jx]; st4bf(wsb(p, O_CKVN) + (size_t)r * 256 + lane * 4 - 128, o); }
    const int dd = (4 * (lane - 32)) & 63; const f32x4 gr = *(const f32x4*)(kg + dd); f32x4 own, oth, o;
    for (int jx = 0; jx < 4; ++jx) own[jx] = c[2][jx] * rr_ * gr[jx];
    for (int jx = 0; jx < 4; ++jx) oth[jx] = __shfl_xor(own[jx], 4);
    const int t = r % SEQ, pos = (dd & 32) ? (t % 64) : (t / 64); const bool first = (dd & 16) == 0;
    for (int jx = 0; jx < 4; ++jx) { float cs = 1.f, sn = 0.f; if (r < NL) sincos_t((float)pos * ropef((dd & 15) + jx, 16), sn, cs);
        o[jx] = first ? own[jx] * cs - oth[jx] * sn : own[jx] * cs + oth[jx] * sn; }
    if (lane >= 32 && lane < 48) { u16* kf = wsb(p, O_KF) + (size_t)r * 1536 + 128 + dd;
#pragma unroll
        for (int h = 0; h < 8; ++h) st4bf(kf + h * 192, o); } }
__device__ __forceinline__ float bflo(unsigned w) { return __uint_as_float(w << 16); }
__device__ __forceinline__ float bfhi(unsigned w) { return __uint_as_float(w & 0xffff0000u); }
__device__ __forceinline__ unsigned pk2(float a, float b) { return (unsigned)f2bf(a) | ((unsigned)f2bf(b) << 16); }
__device__ __forceinline__ void mla_head_wave(const P& p, int j, int r, int lane) {
    const int h = lane >> 3, sub = lane & 7;
    u16* q = wsb(p, O_CALL) + (size_t)r * 1536 + h * 192; u16* k = wsb(p, O_KF) + (size_t)r * 1536 + h * 192;
    const float* qg = p.in[14] + j * 192; const float* kg = p.in[15] + j * 192;
    u32x4 qa = *(const u32x4*)(q + sub * 16), qb = *(const u32x4*)(q + sub * 16 + 8), qr = *(const u32x4*)(q + 128 + sub * 8), ka = *(const u32x4*)(k + sub * 16), kb = *(const u32x4*)(k + sub * 16 + 8);
    float sq = 0.f, sk = 0.f, sr = 0.f;
#pragma unroll
    for (int i = 0; i < 4; ++i) { sq += bflo(qa[i]) * bflo(qa[i]) + bfhi(qa[i]) * bfhi(qa[i]) + bflo(qb[i]) * bflo(qb[i]) + bfhi(qb[i]) * bfhi(qb[i]);
        sk += bflo(ka[i]) * bflo(ka[i]) + bfhi(ka[i]) * bfhi(ka[i]) + bflo(kb[i]) * bflo(kb[i]) + bfhi(kb[i]) * bfhi(kb[i]); sr += bflo(qr[i]) * bflo(qr[i]) + bfhi(qr[i]) * bfhi(qr[i]); }
    for (int o = 4; o >= 1; o >>= 1) { sq += __shfl_xor(sq, o); sk += __shfl_xor(sk, o); sr += __shfl_xor(sr, o); }
    const float rq = rsq_f(sq * (1.0f / 128.0f) + EPS), rk = rsq_f(sk * (1.0f / 128.0f) + EPS), rr_ = rsq_f(sr * (1.0f / 64.0f) + EPS);
    u32x4 oa, ob, oka, okb;
#pragma unroll
    for (int i = 0; i < 4; ++i) { const int d = sub * 16 + 2 * i;
        oa[i] = pk2(bflo(qa[i]) * rq * qg[d], bfhi(qa[i]) * rq * qg[d + 1]); ob[i] = pk2(bflo(qb[i]) * rq * qg[d + 8], bfhi(qb[i]) * rq * qg[d + 9]);
        oka[i] = pk2(bflo(ka[i]) * rk * kg[d], bfhi(ka[i]) * rk * kg[d + 1]); okb[i] = pk2(bflo(kb[i]) * rk * kg[d + 8], bfhi(kb[i]) * rk * kg[d + 9]); }
    *(u32x4*)(q + sub * 16) = oa; *(u32x4*)(q + sub * 16 + 8) = ob; *(u32x4*)(k + sub * 16) = oka; *(u32x4*)(k + sub * 16 + 8) = okb;
    const int dd = sub * 8; float own[8], oth[8];
#pragma unroll
    for (int i = 0; i < 4; ++i) { own[2 * i] = bflo(qr[i]) * rr_ * qg[128 + dd + 2 * i]; own[2 * i + 1] = bfhi(qr[i]) * rr_ * qg[128 + dd + 2 * i + 1]; }
#pragma unroll
    for (int i = 0; i < 8; ++i) oth[i] = __shfl_xor(own[i], 2);
    const int t = r % SEQ, pos = (dd & 32) ? (t % 64) : (t / 64); const bool first = (dd & 16) == 0; u32x4 orr; float res[8];
#pragma unroll
    for (int i = 0; i < 8; ++i) { float cs = 1.f, sn = 0.f; if (r < NL) sincos_t((float)pos * ropef((dd & 15) + i, 16), sn, cs); res[i] = first ? own[i] * cs - oth[i] * sn : own[i] * cs + oth[i] * sn; }
#pragma unroll
    for (int i = 0; i < 4; ++i) orr[i] = pk2(res[2 * i], res[2 * i + 1]);
    *(u32x4*)(q + 128 + dd) = orr; }
__device__ __forceinline__ void ret_norm_wave(const P& p, int lr, int lane) {
    const int h = lane >> 4, sub = lane & 15; u16* o = wsb(p, O_OB) + (size_t)lr * 2048 + h * 512 + sub * 32; const u16* g = wsb(p, O_GATE) + (size_t)lr * 2048 + h * 512 + sub * 32; const float* gg = p.in[19] + h * 512 + sub * 32;
    u32x4 ov[4]; float s = 0.f;
#pragma unroll
    for (int i = 0; i < 4; ++i) { ov[i] = *(const u32x4*)(o + i * 8); for (int jx = 0; jx < 4; ++jx) s += bflo(ov[i][jx]) + bfhi(ov[i][jx]); }
    for (int m = 8; m >= 1; m >>= 1) s += __shfl_xor(s, m);
    const float mu = s * (1.0f / 512.0f); float qv = 0.f;
#pragma unroll
    for (int i = 0; i < 4; ++i) for (int jx = 0; jx < 4; ++jx) { const float a = bflo(ov[i][jx]) - mu, b = bfhi(ov[i][jx]) - mu; qv += a * a + b * b; }
    for (int m = 8; m >= 1; m >>= 1) qv += __shfl_xor(qv, m);
    const float rstd = rsq_f(qv * (1.0f / 512.0f) + EPS);
#pragma unroll
    for (int i = 0; i < 4; ++i) { const u32x4 gv = *(const u32x4*)(g + i * 8); u32x4 w;
        for (int jx = 0; jx < 4; ++jx) { const int e = i * 8 + 2 * jx;
            w[jx] = pk2((bflo(ov[i][jx]) - mu) * rstd * gg[e] * silu_f(bflo(gv[jx])), (bfhi(ov[i][jx]) - mu) * rstd * gg[e + 1] * silu_f(bfhi(gv[jx]))); }
        *(u32x4*)(o + i * 8) = w; } }
__device__ __forceinline__ void mod_phase(const P& p, float* tab) {
    for (int i = threadIdx.x; i < NMR * 1024; i += 512) { const int b = i >> 10, k = i & 1023; tab[i] = silu_f(b < NB ? p.in[1][b * 1024 + k] : p.in[3][k]); }
    __syncthreads();
    for (int idx = blockIdx.x * 512 + threadIdx.x; idx < DEPTH * 9216; idx += gridDim.x * 512) {
        const int layer = idx / 9216, col = idx % 9216; const float* w = p.in[4] + (size_t)layer * 1024 * 9216 + col; float acc[NMR];
#pragma unroll
        for (int b = 0; b < NMR; ++b) acc[b] = 0.f;
        for (int k = 0; k < 1024; ++k) { const float wv = w[(size_t)k * 9216];
#pragma unroll
            for (int b = 0; b < NMR; ++b) acc[b] += tab[b * 1024 + k] * wv; }
        const float bias = p.in[5][layer * 9216 + col];
#pragma unroll
        for (int b = 0; b < NMR; ++b) ((float*)(p.ws + O_MOD))[(size_t)(layer * NMR + b) * 9216 + col] = acc[b] + bias; }
    __syncthreads(); }
#define WPASS(N, HOSTCALL, DEVCALL) do { const int _n = (int)(N); int t0_ = threadIdx.x; asm volatile("" : "+v"(t0_)); const int lane = t0_ & 63; for (int it = blockIdx.x * 8 + (t0_ >> 6); it < _n; it += gridDim.x * 8) { DEVCALL; } } while (0)
#define MODPHASE() mod_phase(p, (float*)shm)

#define XB_TMO      128
#define XB_XCNT(j)  (256  + 64 * (j))
#define XB_XSUB(j)  (1280 + 64 * (j))
#define XB_XGEN(j)  (2304 + 64 * (j))
#define XB_TOP      3328
#define XB_TOPGEN   3392
#define XCD_BAR_WORDS 3456
#define XB_SPIN_CAP (1u << 18)
__device__ __forceinline__ unsigned xb_ld(unsigned* p)              { return __hip_atomic_load(p, __ATOMIC_RELAXED, __HIP_MEMORY_SCOPE_AGENT); }
__device__ __forceinline__ unsigned xb_add(unsigned* p, unsigned v) { return __hip_atomic_fetch_add(p, v, __ATOMIC_RELAXED, __HIP_MEMORY_SCOPE_AGENT); }
__device__ __forceinline__ unsigned xb_xcc_id() { return (unsigned)__builtin_amdgcn_s_getreg((3 << 11) | 20) & 0xFu; }
#define XB_SPIN(cond, bar) do { unsigned _sp = 0; while (cond) { __builtin_amdgcn_s_sleep(1); \
    if ((++_sp & 255u) == 0u) { if (xb_ld(&(bar)[XB_TMO])) break; if (_sp > XB_SPIN_CAP) { atomicAdd(&(bar)[XB_TMO], 1u); break; } } } } while (0)
struct XcdBarrier { unsigned* bar; unsigned x; volatile LAS unsigned* st; };
__device__ __forceinline__ XcdBarrier xcd_barrier_post(unsigned* bar, volatile LAS unsigned* st) {
    XcdBarrier b; b.bar = bar; b.x = xb_xcc_id(); b.st = st;
    if (threadIdx.x == 0) (void)xb_add(&bar[XB_XCNT(b.x)], 1u);
    return b; }
__device__ __forceinline__ void xcd_barrier_complete(unsigned* bar, unsigned x, unsigned& nloc, unsigned& nx) {
    const unsigned G = gridDim.x * gridDim.y * gridDim.z; unsigned sum, cnt, mine, sp = 0u;
    for (;;) { sum = 0u; cnt = 0u; mine = 0u;
#pragma unroll
        for (unsigned j = 0; j < 16; ++j) { const unsigned c = xb_ld(&bar[XB_XCNT(j)]); sum += c; cnt += (c > 0u) ? 1u : 0u; mine = (j == x) ? c : mine; }
        if (sum == G) break;
        __builtin_amdgcn_s_sleep(1);
        if ((++sp & 255u) == 0u) { if (xb_ld(&bar[XB_TMO])) break; if (sp > XB_SPIN_CAP) { atomicAdd(&bar[XB_TMO], 1u); break; } } }
    nloc = mine > 0u ? mine : 1u; nx = cnt > 0u ? cnt : 1u; }
__device__ __forceinline__ void xcd_barrier(const XcdBarrier& b) {
    asm volatile("s_waitcnt vmcnt(0)" ::: "memory");
    __syncthreads();
    if (threadIdx.x == 0) {
        unsigned* bar = b.bar;
        __builtin_amdgcn_s_waitcnt(0);
        unsigned nloc = b.st[0], nx = b.st[1];
        if (nloc == 0u) { xcd_barrier_complete(bar, b.x, nloc, nx); b.st[0] = nloc; b.st[1] = nx; }
        const unsigned old = xb_add(&bar[XB_XSUB(b.x)], 1u);
        const unsigned gen = old / nloc;
        if (old + 1u == (gen + 1u) * nloc) {
            __builtin_amdgcn_fence(__ATOMIC_RELEASE, "agent");
            asm volatile("s_waitcnt vmcnt(0)" ::: "memory");
            const unsigned og = xb_add(&bar[XB_TOP], 1u);
            const unsigned tg = og / nx;
            if (og + 1u == (tg + 1u) * nx) xb_add(&bar[XB_TOPGEN], 1u);
            else XB_SPIN(xb_ld(&bar[XB_TOPGEN]) == tg, bar);
            __builtin_amdgcn_fence(__ATOMIC_ACQUIRE, "agent");
            xb_add(&bar[XB_XGEN(b.x)], 1u);
            asm volatile("s_waitcnt vmcnt(0)" ::: "memory");
        } else {
            XB_SPIN(xb_ld(&bar[XB_XGEN(b.x)]) == gen, bar);
            __builtin_amdgcn_fence(__ATOMIC_ACQUIRE, "agent");
            asm volatile("s_waitcnt vmcnt(0)" ::: "memory");
        }
    }
    __syncthreads();
}

namespace cg = cooperative_groups;
#define PASS(N, CALL) do { const long _n = (long)(N); int t0_ = threadIdx.x; asm volatile("" : "+v"(t0_)); for (long it = (long)blockIdx.x * 512 + t0_; it < _n; it += (long)gridDim.x * 512) { CALL; } } while (0)
#define GEMM(D) gemm_run(lds, D)
#define SYNC() xcd_barrier(xb)
#define GRIDSYNC() grid.sync()
#define HOOK(L, S) do { } while (0)
#define ATTN(NITEMS) do { for (int it = blockIdx.x; it < (NITEMS); it += gridDim.x) { AttItem ai_; att_item(p, it, ai_); att_body(ai_, (char*)shm); } } while (0)
#else
template <class Dsc> static void gemm_emu(const Dsc& D) {
    int n = 0; { Unit u; while (D.unit(n, u)) ++n; }
#pragma omp parallel for schedule(dynamic)
    for (int L = 0; L < n; ++L) { Unit u{}; D.unit(L, u); const int K = Dsc::K;
        std::vector<float> A((size_t)256 * K), B((size_t)256 * K), C((size_t)256 * 256);
        for (int r = 0; r < 256; ++r) for (int k = 0; k < K; ++k) { A[(size_t)r * K + k] = bf2f(u.A[(size_t)r * Dsc::lda + k]); B[(size_t)r * K + k] = bf2f(u.B[(size_t)r * Dsc::ldb + k]); }
        for (int r = 0; r < 256; ++r) for (int c = 0; c < 256; ++c) { float s = 0.f; const float* a = &A[(size_t)r * K]; const float* b = &B[(size_t)c * K]; for (int k = 0; k < K; ++k) s += a[k] * b[k]; C[r * 256 + c] = s; }
        for (int r = 0; r < 128; ++r) for (int c = 0; c < 128; c += 4) { f32x4 v[2][2];
            for (int X = 0; X < 2; ++X) for (int Y = 0; Y < 2; ++Y) for (int j = 0; j < 4; ++j) v[X][Y][j] = C[(r + 128 * X) * 256 + c + 128 * Y + j];
            D.emit(u, r, c, v[0][0], v[0][1], v[1][0], v[1][1]); } } }
static void att_emu(const P& p, int nitems) {
#pragma omp parallel for schedule(dynamic)
    for (int it = 0; it < nitems; ++it) { AttItem a; att_item(p, it, a); std::vector<float> s(a.ntot);
        for (int i = 0; i < 256; ++i) { const u16* q = a.q + (size_t)i * 1536; float l = 0.f; float o[128]; for (int e = 0; e < 128; ++e) o[e] = 0.f;
            for (int k = 0; k < a.ntot; ++k) { const u16* kr = k < a.n0 ? a.k0 + (size_t)k * 1536 : a.k1 + (size_t)(k - a.n0) * 1536; float d = 0.f; for (int x = 0; x < 192; ++x) d += bf2f(q[x]) * bf2f(kr[x]);
                const float pv = bf2f(f2bf(expf(d * ATT_SCALE))); l += expf(d * ATT_SCALE); const u16* vr = k < a.n0 ? a.v0 + (size_t)k * 1024 : a.v1 + (size_t)(k - a.n0) * 1024; for (int e = 0; e < 128; ++e) o[e] += pv * bf2f(vr[e]); }
            for (int e = 0; e < 128; ++e) a.o[(size_t)i * 1024 + e] = f2bf(o[e] / l); } } }
#define PASS(N, CALL) do { const long _n = (long)(N); _Pragma("omp parallel for schedule(static)") for (long it = 0; it < _n; ++it) { CALL; } } while (0)
#define WPASS(N, HOSTCALL, DEVCALL) PASS(N, HOSTCALL)
#define MODPHASE() PASS(DEPTH * 9216, mod_item(p, (int)it))
#define GEMM(D) gemm_emu(D)
#define SYNC() do { } while (0)
#define GRIDSYNC() do { } while (0)
#define ATTN(NITEMS) att_emu(p, NITEMS)
static void emu_hook(const P& p, int layer, int stage);
#define HOOK(L, S) emu_hook(p, L, S)
#endif

#ifndef HOST_EMU
__global__ void __launch_bounds__(512) fwd_megakernel(P p) {
    extern __shared__ __attribute__((aligned(16))) unsigned char shm[];
    LAS unsigned char* lds = (LAS unsigned char*)shm;
    cg::grid_group grid = cg::this_grid();
    volatile LAS unsigned* xst = (volatile LAS unsigned*)(lds + STAGE_BYTES + 1024);
    if (threadIdx.x == 0) { xst[0] = 0u; xst[1] = 0u; xst[2] = 0u; xst[3] = 0u; }
    __syncthreads();
    const XcdBarrier xb = xcd_barrier_post((unsigned*)(p.ws + O_BAR), xst);
#else
static void fwd_emu(P p) {
#endif
    if (PM(0)) { MODPHASE();
    PASS((long)MT * 256, copy_item(p, it));
    PASS(CV_TOTAL, cvt_item(p, it)); }
    GRIDSYNC();
    for (int rep_ = 0; rep_ < REP_SYNC; ++rep_) SYNC();
    for (int layer = 0; layer < DEPTH; ++layer) {
        const int kind = layer % 3, j = layer / 3; const bool last = layer == DEPTH - 1;
        if (PM(1)) { WPASS(MT, norm_item(p, layer, 0, (int)it, 0), norm_wave(p, layer, 0, it, 0, lane)); } SYNC();
        for (int rep_ = 0; rep_ < REP_UP; ++rep_) { if (PM(2)) { DFfnUp d{p, layer, 0}; GEMM(d); } SYNC(); }
        if (PM(3)) { DFfnDown d{p, layer, 0, MT / 256}; GEMM(d); } SYNC();
        if (kind == 0) {
            if (PM(1)) { WPASS(MT, norm_item(p, layer, 1, (int)it, 0), norm_wave(p, layer, 1, it, 0, lane)); } SYNC();
            for (int rep_ = 0; rep_ < REP_MLA; ++rep_) { if (PM(4)) { DMlaIn d{p, j}; GEMM(d); } SYNC(); }
            if (PM(5)) { WPASS(MT, mla_row_item(p, j, (int)it), mla_row_wave(p, j, it, lane)); } SYNC();
            for (int rep_ = 0; rep_ < REP_MLA; ++rep_) { if (PM(6)) { DMlaUq d{p, j}; GEMM(d); } if (PM(7)) { DMlaUkv d{p, j}; GEMM(d); } SYNC(); }
            if (PM(8)) { WPASS(MT, { for (int h_ = 0; h_ < 8; ++h_) mla_head_item(p, j, (int)it * 8 + h_); }, mla_head_wave(p, j, it, lane)); } SYNC();
            for (int rep_ = 0; rep_ < REP_ATT; ++rep_) { if (PM(9)) { ATTN(NB * 8 * (SEQ / 256) + (last ? 0 : NB * 8)); } SYNC(); }
            if (PM(10)) { DMlaO d{p, layer, j, last ? NL / 256 : MT / 256}; GEMM(d); } SYNC();
        } else if (kind == 1) {
            if (PM(1)) { WPASS(MT, norm_item(p, layer, 1, (int)it, 0), norm_wave(p, layer, 1, it, 0, lane)); } SYNC();
            for (int q = 0; q < NB / RGB; ++q) {
                for (int rep_ = 0; rep_ < REP_RET; ++rep_) { if (PM(11)) { DRetProj d{p, q}; GEMM(d); } if (PM(12)) { DRetProjT d{p, q}; GEMM(d); } SYNC(); }
                for (int rep_ = 0; rep_ < REP_RET; ++rep_) { if (PM(13)) { DRetP d{p}; GEMM(d); } if (PM(14)) { DRetL d{p}; GEMM(d); } SYNC(); }
                if (PM(15)) { PASS(4 * RGB * 512 * 64, ret_prefix_item(p, (int)it)); } SYNC();
                for (int rep_ = 0; rep_ < REP_RET; ++rep_) { if (PM(16)) { DRetO d{p}; GEMM(d); } SYNC(); }
                if (PM(17)) { WPASS(NCQ * 256, { for (int h_ = 0; h_ < 4; ++h_) ret_norm_item(p, (int)it * 4 + h_); }, ret_norm_wave(p, it, lane)); } SYNC();
                if (PM(18)) { DRetWo d{p, layer, q}; GEMM(d); } SYNC();
            }
        } else {
            if (PM(19)) { WPASS(MT, norm_item(p, layer, 1, (int)it, 1), norm_wave(p, layer, 1, it, 1, lane));
            PASS(64 * 2 * 32 * 256, s5_ktab_item(p, (int)it));
            PASS(64 * 256 * 512, s5_fext_item(p, (int)it)); } SYNC();
            if (PM(19)) { PASS((long)64 * 512 * 768, s5_text_item(p, it)); }
            for (int rep_ = 0; rep_ < REP_S5; ++rep_) { if (PM(20)) { DS5L d{p}; GEMM(d); } SYNC(); }
            if (PM(21)) { PASS(64 * NB * 64, s5_prefix_item(p, (int)it)); } SYNC();
            for (int rep_ = 0; rep_ < REP_S5; ++rep_) { if (PM(22)) { DS5Y d{p}; GEMM(d); } SYNC(); }
            if (PM(23)) { DS5Glu d{p, layer}; GEMM(d); } SYNC();
        }
        HOOK(layer, 0);
        if (PM(1)) { WPASS(last ? NL : MT, norm_item(p, layer, 2, (int)it, 0), norm_wave(p, layer, 2, it, 0, lane)); } SYNC();
        for (int rep_ = 0; rep_ < REP_UP; ++rep_) { if (PM(2)) { DFfnUp d{p, layer, 1}; GEMM(d); } SYNC(); }
        if (PM(3)) { DFfnDown d{p, layer, 1, last ? NL / 256 : MT / 256}; GEMM(d); } SYNC();
        HOOK(layer, 1);
    }
}

#ifndef HOST_EMU
extern "C" void kernel_launch(void* const* d_in, const int* in_sizes, int n_in, void* d_out, int out_size, void* d_ws, size_t ws_size, hipStream_t stream) {
    constexpr size_t kDynLds = STAGE_BYTES + 4096;
    static int grid_blocks = 0;
    if (!grid_blocks) {
        int dev = 0, cus = 0, per_cu = 0;
        hipGetDevice(&dev);
        hipDeviceGetAttribute(&cus, hipDeviceAttributeMultiprocessorCount, dev);
        hipFuncSetAttribute((const void*)fwd_megakernel, hipFuncAttributeMaxDynamicSharedMemorySize, (int)kDynLds);
        hipOccupancyMaxActiveBlocksPerMultiprocessor(&per_cu, fwd_megakernel, 512, kDynLds);
        if (per_cu < 1) per_cu = 1;
        if (per_cu > 1) per_cu = 1;
        grid_blocks = cus * per_cu;
        if (ws_size < WS_NEED) fprintf(stderr, "workspace too small: %zu < %zu\n", ws_size, (size_t)WS_NEED);
    }
    P p{};
    for (int i = 0; i < 31 && i < n_in; ++i) p.in[i] = (const float*)d_in[i];
    p.out = (float*)d_out; p.ws = (char*)d_ws;
    hipMemsetAsync((char*)d_ws + O_BAR, 0, XCD_BAR_WORDS * 4, stream);
    void* args[] = {&p};
    hipError_t e = hipLaunchCooperativeKernel((void*)fwd_megakernel, dim3(grid_blocks), dim3(512), args, kDynLds, stream);
    if (e != hipSuccess) fprintf(stderr, "cooperative launch failed: %s (grid %d)\n", hipGetErrorString(e), grid_blocks);
}
#endif
```

```cpp
#ifdef HOST_EMU
#include <cmath>
#include <cstdio>
#include <cstdlib>
#include <cstring>
#include <vector>
#define HD inline
#else
#include <hip/hip_runtime.h>
#include <hip/hip_cooperative_groups.h>
#include <cstdio>
#define HD __device__ __forceinline__
#endif

#ifndef CFG_BATCH
#define CFG_BATCH 16
#endif
#ifndef CFG_SEQ
#define CFG_SEQ 4096
#endif

typedef unsigned short u16;
typedef float f32x4 __attribute__((ext_vector_type(4)));
typedef unsigned u32x2 __attribute__((ext_vector_type(2)));

constexpr int DM = 1024, NB = CFG_BATCH, SEQ = CFG_SEQ, CTX = 256, DFF = 2816, DEPTH = 4;
constexpr int NL = NB * SEQ, NC = NB * CTX, MT = NL + NC;
constexpr int NMR = NB + 1;
constexpr int RGB = (NB >= 4) ? 4 : 1;
constexpr int NCH = 1 + SEQ / 256;
constexpr int NCQ = RGB * NCH;
constexpr int S5L = SEQ / 32, S5C = CTX / 32;
constexpr int NROW5 = NB * S5L + NB * S5C;
constexpr int NROW5P = (NROW5 + 255) / 256 * 256;
constexpr float EPS = 1e-6f;

constexpr size_t al(size_t x) { return (x + 255) & ~(size_t)255; }
constexpr size_t O_BAR = 0;
constexpr size_t O_MOD = 16384;
constexpr size_t O_G = O_MOD + al((size_t)DEPTH * NMR * 9216 * 4);
constexpr size_t O_FFI = O_G + al((size_t)NC * 1024 * 4);
constexpr size_t SZ_FFI1 = (size_t)5632 * 1024 * 2, SZ_FFO1 = (size_t)1024 * 2816 * 2;
constexpr size_t O_FFO = O_FFI + 8 * SZ_FFI1;
constexpr size_t O_MWIN = O_FFO + 8 * SZ_FFO1;
constexpr size_t SZ_MWIN = (size_t)768 * 1024 * 2, SZ_MWUQ = (size_t)1536 * 384 * 2, SZ_MWUKV = (size_t)2048 * 256 * 2, SZ_MWO = (size_t)1024 * 1024 * 2;
constexpr size_t O_MWUQ = O_MWIN + 2 * SZ_MWIN;
constexpr size_t O_MWUKV = O_MWUQ + 2 * SZ_MWUQ;
constexpr size_t O_MWO = O_MWUKV + 2 * SZ_MWUKV;
constexpr size_t O_RWIN = O_MWO + 2 * SZ_MWO;
constexpr size_t O_RWO = O_RWIN + (size_t)6144 * 1024 * 2;
constexpr size_t O_GLU = O_RWO + (size_t)1024 * 2048 * 2;
constexpr size_t O_HN = O_GLU + (size_t)2048 * 1024 * 2;
constexpr size_t O_KTAB = O_HN + al((size_t)MT * 1024 * 2);
constexpr size_t O_TEXT = O_KTAB + al((size_t)64 * 2 * 32 * 256 * 4);
constexpr size_t O_FEXT = O_TEXT + al((size_t)64 * 512 * 768 * 2);
constexpr size_t O_SCR = O_FEXT + al((size_t)64 * 256 * 512 * 2);
constexpr size_t O_ACT = O_SCR;
constexpr size_t O_CALL = O_SCR;
constexpr size_t O_CQN = O_CALL + al((size_t)MT * 768 * 4);
constexpr size_t O_CKVN = O_CQN + al((size_t)MT * 384 * 2);
constexpr size_t O_KF = O_CKVN + al((size_t)MT * 256 * 2);
constexpr size_t O_VB = O_KF + al((size_t)MT * 1536 * 2);
constexpr size_t END_MLA = O_VB + al((size_t)MT * 1024 * 2);
constexpr size_t O_QN = O_SCR;
constexpr size_t O_KN = O_QN + al((size_t)NCQ * 256 * 1024 * 2);
constexpr size_t O_GATE = O_KN + al((size_t)NCQ * 256 * 1024 * 2);
constexpr size_t O_OB = O_GATE + al((size_t)NCQ * 256 * 2048 * 2);
constexpr size_t O_AEXT = O_OB + al((size_t)NCQ * 256 * 2048 * 2);
constexpr size_t O_KTX = O_AEXT + al((size_t)4 * NCQ * 256 * 768 * 2);
constexpr size_t O_BEXT = O_KTX + al((size_t)4 * NCQ * 2 * 256 * 256 * 2);
constexpr size_t O_YCTX = O_BEXT + al((size_t)4 * NCQ * 512 * 768 * 2);
constexpr size_t END_RET = O_YCTX + al((size_t)NC * 2048 * 2);
constexpr size_t O_UEXT = O_SCR;
constexpr size_t END_S5 = O_UEXT + al((size_t)64 * NROW5P * 768 * 2);
constexpr size_t END_FFN = O_ACT + al((size_t)MT * 2816 * 2);
constexpr size_t cmax(size_t a, size_t b) { return a > b ? a : b; }
constexpr size_t WS_NEED = cmax(cmax(END_MLA, END_RET), cmax(END_S5, END_FFN));

struct P { const float* in[32]; float* out; char* ws; };
#ifndef PHASE_MASK
#define PHASE_MASK 0xFFFFFFFFu
#endif
#define PM(b) ((PHASE_MASK >> (b)) & 1u)
#ifndef REP_UP
#define REP_UP 1
#endif
#ifndef REP_ATT
#define REP_ATT 1
#endif
#ifndef REP_NORM
#define REP_NORM 1
#endif
#ifndef REP_RET
#define REP_RET 1
#endif
#ifndef REP_DOWN
#define REP_DOWN 1
#endif
#ifndef REP_MLA
#define REP_MLA 1
#endif
#ifndef REP_S5
#define REP_S5 1
#endif
#ifndef REP_SYNC
#define REP_SYNC 0
#endif

HD float bf2f(u16 b) { union { unsigned u; float f; } x; x.u = ((unsigned)b) << 16; return x.f; }
HD u16 f2bf(float f) { union { unsigned u; float f; } x; x.f = f; unsigned u = x.u; u += 0x7fffu + ((u >> 16) & 1u); return (u16)(u >> 16); }
#ifdef HOST_EMU
HD void st4bf(u16* p, f32x4 v) { u32x2 w; w.x = (unsigned)f2bf(v[0]) | ((unsigned)f2bf(v[1]) << 16); w.y = (unsigned)f2bf(v[2]) | ((unsigned)f2bf(v[3]) << 16); *(u32x2*)p = w; }
#else
HD unsigned cvtpk_bf(float lo, float hi) { unsigned r; asm("v_cvt_pk_bf16_f32 %0, %1, %2" : "=v"(r) : "v"(lo), "v"(hi)); return r; }
HD void st4bf(u16* p, f32x4 v) { u32x2 w; w.x = cvtpk_bf(v[0], v[1]); w.y = cvtpk_bf(v[2], v[3]); *(u32x2*)p = w; }
#endif
#ifdef HOST_EMU
HD float silu_f(float a) { return a / (1.0f + expf(-a)); }
HD float sigm_f(float a) { return 1.0f / (1.0f + expf(-a)); }
HD float gelu_f(float x) { return 0.5f * x * (1.0f + tanhf(0.7978845608028654f * (x + 0.044715f * x * x * x))); }
#else
HD float sigm_f(float a) { return __builtin_amdgcn_rcpf(1.0f + __builtin_amdgcn_exp2f(-1.4426950408889634f * a)); }
HD float silu_f(float a) { return a * sigm_f(a); }
HD float gelu_f(float x) { return x * sigm_f(1.5957691216057308f * (x + 0.044715f * x * x * x)); }
#endif
HD float rsq_f(float x) { return 1.0f / sqrtf(x); }
HD float ex2(float x) {
#ifdef HOST_EMU
    return exp2f(x);
#else
    return __builtin_amdgcn_exp2f(x);
#endif
}
HD const float* hsrc(const P& p, int r, int first) { if (first && r < NL) return p.in[0] + (size_t)r * 1024; return r < NL ? p.out + (size_t)r * 1024 : (const float*)(p.ws + O_G) + (size_t)(r - NL) * 1024; }
HD float* hrow(const P& p, int r) { return r < NL ? p.out + (size_t)r * 1024 : (float*)(p.ws + O_G) + (size_t)(r - NL) * 1024; }
HD const float* modp(const P& p, int layer, int r, int idx) { const int mr = r < NL ? r / SEQ : NB; return (const float*)(p.ws + O_MOD) + ((size_t)(layer * NMR + mr) * 9 + idx) * 1024; }
HD u16* wsb(const P& p, size_t off) { return (u16*)(p.ws + off); }
#ifdef HOST_EMU
HD float ropef(int d, int half) { return expf(-(float)d * (9.210340371976184f / (float)half)) * 0.15915494309189535f; }
#else
HD float ropef(int d, int half) { return __builtin_amdgcn_exp2f(-(float)d * (13.287712379549449f / (float)half)) * 0.15915494309189535f; }
#endif
HD void sincos_t(float turns, float& sn, float& cs) {
    const float f = turns - floorf(turns);
#ifdef HOST_EMU
    sn = sinf(6.283185307179586f * f); cs = cosf(6.283185307179586f * f);
#else
    sn = __builtin_amdgcn_sinf(f); cs = __builtin_amdgcn_cosf(f);
#endif
}

HD bool rect_unit(int L, int nM, int nN, int& pm, int& pn) {
    const int nwg = nM * nN; if (L >= nwg) return false;
    int wgid = L; { const int q = nwg / 8, r = nwg % 8, xcd = wgid % 8, off = wgid / 8; wgid = (xcd < r ? xcd * (q + 1) : r * (q + 1) + (xcd - r) * q) + off; }
    const int nig = 8 * nN, gid = wgid / nig, fm = gid * 8, gsz = (nM - fm) < 8 ? (nM - fm) : 8;
    pm = fm + ((wgid % nig) % gsz); pn = (wgid % nig) / gsz; return true;
}

struct Unit { const u16* A; const u16* B; int a, b, c, d; float f0, f1; };

struct DFfnUp { P p; int layer, f, nM; static constexpr int FENCE = 1; static constexpr int K = 1024, lda = 1024, ldb = 1024;
    HD bool unit(int L, Unit& u) const { int pm, pn; if (!rect_unit(L, nM, 22, pm, pn)) return false;
        u.A = wsb(p, O_HN) + (size_t)pm * 256 * 1024; u.B = wsb(p, O_FFI + (size_t)(layer * 2 + f) * SZ_FFI1) + (size_t)pn * 256 * 1024; u.a = pm; u.b = pn; u.c = 0; u.d = 0; return true; }
    HD void emit(const Unit& u, int r, int c, f32x4 v00, f32x4 v01, f32x4 v10, f32x4 v11) const {
        u16* act = wsb(p, O_ACT); const size_t R = (size_t)u.a * 256 + r; const int col = u.b * 128 + c; f32x4 o0, o1;
        for (int j = 0; j < 4; ++j) { o0[j] = silu_f(v00[j]) * v01[j]; o1[j] = silu_f(v10[j]) * v11[j]; }
        st4bf(act + R * 2816 + col, o0); st4bf(act + (R + 128) * 2816 + col, o1); } };

HD void resid4(const P& p, int layer, int midx, float sc, int R, int col, f32x4 v, int first = 0) {
    float* h = hrow(p, R) + col; const float* m = modp(p, layer, R, midx) + col; f32x4 x = *(const f32x4*)(hsrc(p, R, first) + col);
    for (int j = 0; j < 4; ++j) x[j] += sc * m[j] * v[j];
    *(f32x4*)h = x; }

struct DFfnDown { P p; int layer, f, nM; float sc; static constexpr int FENCE = 4; static constexpr int K = 2816, lda = 2816, ldb = 2816;
    HD bool unit(int L, Unit& u) const { int pm, pn; if (!rect_unit(L, nM, 4, pm, pn)) return false;
        u.A = wsb(p, O_ACT) + (size_t)pm * 256 * 2816; u.B = wsb(p, O_FFO + (size_t)(layer * 2 + f) * SZ_FFO1) + (size_t)pn * 256 * 2816; u.a = pm; u.b = pn; u.c = 0; u.d = 0; return true; }
    HD void emit(const Unit& u, int r, int c, f32x4 v00, f32x4 v01, f32x4 v10, f32x4 v11) const {
        const int R = u.a * 256 + r, col = u.b * 256 + c, mi = f ? 8 : 2;
        const int first = (layer == 0 && f == 0 && sc != 0.f);
        resid4(p, layer, mi, sc, R, col, v00, first); resid4(p, layer, mi, sc, R, col + 128, v01, first); resid4(p, layer, mi, sc, R + 128, col, v10, first); resid4(p, layer, mi, sc, R + 128, col + 128, v11, first); } };
HD void atom4(float* g, const float* m, float sc, f32x4 v) {
#ifdef HOST_EMU
    for (int j = 0; j < 4; ++j) {
#pragma omp atomic
        g[j] += sc * m[j] * v[j]; }
#else
    for (int j = 0; j < 4; ++j) unsafeAtomicAdd(g + j, sc * m[j] * v[j]);
#endif
}
template <int KS, int SL0> struct DFfnDownCtx { P p; int layer, f; float sc; static constexpr int FENCE = 4; static constexpr int K = KS, lda = 2816, ldb = 2816;
    HD bool unit(int L, Unit& u) const { if (L >= 256) return false; const int x = SL0 ? (L + 128) % 256 : L; if (x >= 128 || x >= (NC / 256) * 8) return false;
        const int sl = x & 1, pn = (x >> 1) & 3, pm = NL / 256 + (x >> 3); const int k0 = SL0 ? 1536 + sl * 640 : sl * 768;
        u.A = wsb(p, O_ACT) + (size_t)pm * 256 * 2816 + k0; u.B = wsb(p, O_FFO + (size_t)(layer * 2 + f) * SZ_FFO1) + (size_t)pn * 256 * 2816 + k0; u.a = pm; u.b = pn; u.c = 0; u.d = 0; return true; }
    HD void one(int R, int col, f32x4 v) const { atom4(hrow(p, R) + col, modp(p, layer, R, f ? 8 : 2) + col, sc, v); }
    HD void emit(const Unit& u, int r, int c, f32x4 v00, f32x4 v01, f32x4 v10, f32x4 v11) const {
        const int R = u.a * 256 + r, col = u.b * 256 + c; one(R, col, v00); one(R, col + 128, v01); one(R + 128, col, v10); one(R + 128, col + 128, v11); } };

struct DMlaIn { P p; int j; static constexpr int FENCE = 1; static constexpr int K = 1024, lda = 1024, ldb = 1024;
    HD bool unit(int L, Unit& u) const { int pm, pn; if (!rect_unit(L, MT / 256, 3, pm, pn)) return false;
        u.A = wsb(p, O_HN) + (size_t)pm * 256 * 1024; u.B = wsb(p, O_MWIN + j * SZ_MWIN) + (size_t)pn * 256 * 1024; u.a = pm; u.b = pn; u.c = 0; u.d = 0; return true; }
    HD void emit(const Unit& u, int r, int c, f32x4 v00, f32x4 v01, f32x4 v10, f32x4 v11) const {
        float* o = (float*)(p.ws + O_CALL) + ((size_t)u.a * 256 + r) * 768 + u.b * 256 + c;
        *(f32x4*)o = v00; *(f32x4*)(o + 128) = v01; *(f32x4*)(o + (size_t)128 * 768) = v10; *(f32x4*)(o + (size_t)128 * 768 + 128) = v11; } };
struct DMlaUq { P p; int j; static constexpr int FENCE = 1; static constexpr int K = 384, lda = 384, ldb = 384;
    HD bool unit(int L, Unit& u) const { int pm, pn; if (!rect_unit(L, MT / 256, 6, pm, pn)) return false;
        u.A = wsb(p, O_CQN) + (size_t)pm * 256 * 384; u.B = wsb(p, O_MWUQ + j * SZ_MWUQ) + (size_t)pn * 256 * 384; u.a = pm; u.b = pn; u.c = 0; u.d = 0; return true; }
    HD void emit(const Unit& u, int r, int c, f32x4 v00, f32x4 v01, f32x4 v10, f32x4 v11) const {
        u16* o = wsb(p, O_CALL) + ((size_t)u.a * 256 + r) * 1536 + u.b * 256 + c;
        st4bf(o, v00); st4bf(o + 128, v01); st4bf(o + (size_t)128 * 1536, v10); st4bf(o + (size_t)128 * 1536 + 128, v11); } };
struct DMlaUkv { P p; int j; static constexpr int FENCE = 1; static constexpr int K = 256, lda = 256, ldb = 256;
    HD bool unit(int L, Unit& u) const { int pm, pn; if (!rect_unit(L, MT / 256, 8, pm, pn)) return false;
        u.A = wsb(p, O_CKVN) + (size_t)pm * 256 * 256; u.B = wsb(p, O_MWUKV + j * SZ_MWUKV) + (size_t)pn * 256 * 256; u.a = pm; u.b = pn; u.c = 0; u.d = 0; return true; }
    HD void one(size_t R, int col, f32x4 v) const {
        if (col < 1024) st4bf(wsb(p, O_KF) + R * 1536 + (col >> 7) * 192 + (col & 127), v);
        else st4bf(wsb(p, O_VB) + R * 1024 + (col - 1024), v); }
    HD void emit(const Unit& u, int r, int c, f32x4 v00, f32x4 v01, f32x4 v10, f32x4 v11) const {
        const size_t R = (size_t)u.a * 256 + r; const int col = u.b * 256 + c;
        one(R, col, v00); one(R, col + 128, v01); one(R + 128, col, v10); one(R + 128, col + 128, v11); } };
struct DMlaO { P p; int layer, j, nM; static constexpr int FENCE = 4; static constexpr int K = 1024, lda = 1024, ldb = 1024;
    HD bool unit(int L, Unit& u) const { int pm, pn; if (!rect_unit(L, nM, 4, pm, pn)) return false;
        u.A = wsb(p, O_HN) + (size_t)pm * 256 * 1024; u.B = wsb(p, O_MWO + j * SZ_MWO) + (size_t)pn * 256 * 1024; u.a = pm; u.b = pn; u.c = 0; u.d = 0; return true; }
    HD void emit(const Unit& u, int r, int c, f32x4 v00, f32x4 v01, f32x4 v10, f32x4 v11) const {
        const int R = u.a * 256 + r, col = u.b * 256 + c;
        resid4(p, layer, 5, 1.0f, R, col, v00); resid4(p, layer, 5, 1.0f, R, col + 128, v01); resid4(p, layer, 5, 1.0f, R + 128, col, v10); resid4(p, layer, 5, 1.0f, R + 128, col + 128, v11); } };

HD int ret_tokrow(int q, int cidx) { const int b = q * RGB + cidx / NCH, n = cidx % NCH; return n == 0 ? NL + b * 256 : b * SEQ + (n - 1) * 256; }
HD float ret_logg(const P& p, int dir, int h) { return log1pf(-expf(p.in[18][dir * 4 + h])); }
struct DRetProj { P p; int q; static constexpr int FENCE = 1; static constexpr int K = 1024, lda = 1024, ldb = 1024;
    HD bool unit(int L, Unit& u) const { int pm, pn; if (!rect_unit(L, NCQ, 16, pm, pn)) return false;
        const int wrow = pn < 8 ? pn * 256 : 4096 + (pn - 8) * 256;
        u.A = wsb(p, O_HN) + (size_t)ret_tokrow(q, pm) * 1024; u.B = wsb(p, O_RWIN) + (size_t)wrow * 1024; u.a = pm; u.b = pn; u.c = 0; u.d = 0;
        u.f0 = ret_logg(p, 0, pn & 3) * 1.4426950408889634f; u.f1 = ret_logg(p, 1, pn & 3) * 1.4426950408889634f; return true; }
    HD void emit(const Unit& u, int r, int c, f32x4 v00, f32x4 v01, f32x4 v10, f32x4 v11) const {
        const int cidx = u.a, pn = u.b, n = cidx % NCH;
        if (pn >= 8) { u16* g = wsb(p, O_GATE) + ((size_t)cidx * 256 + r) * 2048 + (pn - 8) * 256 + c;
            st4bf(g, v00); st4bf(g + 128, v01); st4bf(g + (size_t)128 * 2048, v10); st4bf(g + (size_t)128 * 2048 + 128, v11); return; }
        const int h = pn & 3; const bool isq = pn < 4;
        const float lgf = u.f0, lgb = u.f1;
        for (int X = 0; X < 2; ++X) { const int i = r + 128 * X; const f32x4 x1 = X ? v10 : v00, x2 = X ? v11 : v01; f32x4 r1, r2;
            for (int jx = 0; jx < 4; ++jx) { float cs = 1.f, sn = 0.f;
                if (n > 0) sincos_t((float)((n - 1) * 256 + i) * ropef(c + jx, 128), sn, cs);
                r1[jx] = x1[jx] * cs - x2[jx] * sn; r2[jx] = x2[jx] * cs + x1[jx] * sn; }
            if (isq) { u16* qn = wsb(p, O_QN) + ((size_t)cidx * 256 + i) * 1024 + h * 256 + c; st4bf(qn, r1); st4bf(qn + 128, r2);
                const float df = ex2(lgf * (float)(i + 1)), db = ex2(lgb * (float)(256 - i));
                u16* ae = wsb(p, O_AEXT) + (((size_t)h * NCQ + cidx) * 256 + i) * 768;
                st4bf(ae + 256 + c, r1 * df); st4bf(ae + 384 + c, r2 * df); st4bf(ae + 512 + c, r1 * db); st4bf(ae + 640 + c, r2 * db); }
            else { u16* kn = wsb(p, O_KN) + ((size_t)cidx * 256 + i) * 1024 + h * 256 + c; st4bf(kn, r1 * 0.0625f); st4bf(kn + 128, r2 * 0.0625f); } } } };
struct DRetProjT { P p; int q; static constexpr int FENCE = 1; static constexpr int K = 1024, lda = 1024, ldb = 1024;
    HD bool unit(int L, Unit& u) const { int pm, pn; if (!rect_unit(L, 12, NCQ, pm, pn)) return false;
        u.A = wsb(p, O_RWIN) + (size_t)(1024 + pm * 256) * 1024; u.B = wsb(p, O_HN) + (size_t)ret_tokrow(q, pn) * 1024; u.a = pm; u.b = pn; u.c = 0; u.d = 0;
        u.f0 = ret_logg(p, 0, pm & 3) * 1.4426950408889634f; u.f1 = ret_logg(p, 1, pm & 3) * 1.4426950408889634f; return true; }
    HD void emit(const Unit& u, int r, int c, f32x4 v00, f32x4 v01, f32x4 v10, f32x4 v11) const {
        const int pm = u.a, cidx = u.b, n = cidx % NCH;
        if (pm >= 4) { const int h = (pm - 4) >> 1, e0 = ((pm - 4) & 1) * 256 + r; u16* be = wsb(p, O_BEXT) + (((size_t)h * NCQ + cidx) * 512 + e0) * 768 + c;
            st4bf(be, v00); st4bf(be + 128, v01); st4bf(be + (size_t)128 * 768, v10); st4bf(be + (size_t)128 * 768 + 128, v11); return; }
        const int h = pm; const float lgf = u.f0, lgb = u.f1, fr = ropef(r, 128);
        u16* kf = wsb(p, O_KTX) + (((size_t)h * NCQ + cidx) * 2 + 0) * 65536; u16* kb = kf + 65536;
        for (int Y = 0; Y < 2; ++Y) { const f32x4 x1 = Y ? v01 : v00, x2 = Y ? v11 : v10; f32x4 f1, f2, b1, b2;
            for (int jx = 0; jx < 4; ++jx) { const int jj = c + 128 * Y + jx; float cs = 1.f, sn = 0.f;
                if (n > 0) sincos_t((float)((n - 1) * 256 + jj) * fr, sn, cs);
                const float r1 = (x1[jx] * cs - x2[jx] * sn) * 0.0625f, r2 = (x2[jx] * cs + x1[jx] * sn) * 0.0625f;
                const float df = ex2(lgf * (float)(255 - jj)), db = ex2(lgb * (float)jj);
                f1[jx] = r1 * df; f2[jx] = r2 * df; b1[jx] = r1 * db; b2[jx] = r2 * db; }
            const int jc = c + 128 * Y;
            st4bf(kf + (size_t)r * 256 + jc, f1); st4bf(kf + (size_t)(r + 128) * 256 + jc, f2); st4bf(kb + (size_t)r * 256 + jc, b1); st4bf(kb + (size_t)(r + 128) * 256 + jc, b2); } } };
struct DRetProjAll { P p; int q; static constexpr int FENCE = 1; static constexpr int K = 1024, lda = 1024, ldb = 1024;
    HD bool unit(int L, Unit& u) const { const DRetProj a{p, q}; const DRetProjT b{p, q};
        if (L < NCQ * 16) { const bool ok = a.unit(L, u); u.d = 0; return ok; } const bool ok = b.unit(L - NCQ * 16, u); u.d = 1; return ok; }
    HD void emit(const Unit& u, int r, int c, f32x4 v00, f32x4 v01, f32x4 v10, f32x4 v11) const {
        if (u.d == 0) { const DRetProj a{p, q}; a.emit(u, r, c, v00, v01, v10, v11); } else { const DRetProjT b{p, q}; b.emit(u, r, c, v00, v01, v10, v11); } } };
struct DRetP { P p; static constexpr int FENCE = 1; static constexpr int K = 256, lda = 1024, ldb = 1024;
    HD bool unit(int L, Unit& u) const { int pm, pn; if (!rect_unit(L, NCQ, 4, pm, pn)) return false;
        u.A = wsb(p, O_QN) + (size_t)pm * 256 * 1024 + pn * 256; u.B = wsb(p, O_KN) + (size_t)pm * 256 * 1024 + pn * 256; u.a = pm; u.b = pn; u.c = 0; u.d = 0;
        u.f0 = ret_logg(p, 0, pn) * 1.4426950408889634f; u.f1 = ret_logg(p, 1, pn) * 1.4426950408889634f; return true; }
    HD void one(u16* ae, float lgf, float lgb, int i, int j0, f32x4 v) const { f32x4 o;
        for (int jx = 0; jx < 4; ++jx) { const int jj = j0 + jx; o[jx] = v[jx] * ex2(jj <= i ? lgf * (float)(i - jj) : lgb * (float)(jj - i)); }
        st4bf(ae + (size_t)i * 768 + j0, o); }
    HD void emit(const Unit& u, int r, int c, f32x4 v00, f32x4 v01, f32x4 v10, f32x4 v11) const {
        const int cidx = u.a, h = u.b; const float lgf = u.f0, lgb = u.f1;
        u16* ae = wsb(p, O_AEXT) + ((size_t)h * NCQ + cidx) * 256 * 768;
        one(ae, lgf, lgb, r, c, v00); one(ae, lgf, lgb, r, c + 128, v01); one(ae, lgf, lgb, r + 128, c, v10); one(ae, lgf, lgb, r + 128, c + 128, v11); } };
struct DRetL { P p; static constexpr int FENCE = 1; static constexpr int K = 256, lda = 768, ldb = 256;
    HD bool unit(int L, Unit& u) const { int pm, pn; if (!rect_unit(L, 4 * NCQ, 4, pm, pn)) return false;
        const int dir = pn >> 1, eh = pn & 1;
        u.A = wsb(p, O_BEXT) + ((size_t)pm * 512 + eh * 256) * 768; u.B = wsb(p, O_KTX) + ((size_t)pm * 2 + dir) * 65536; u.a = pm; u.b = dir; u.c = eh; u.d = 0; return true; }
    HD void emit(const Unit& u, int r, int c, f32x4 v00, f32x4 v01, f32x4 v10, f32x4 v11) const {
        u16* o = wsb(p, O_BEXT) + ((size_t)u.a * 512 + u.c * 256 + r) * 768 + 256 + u.b * 256 + c;
        st4bf(o, v00); st4bf(o + 128, v01); st4bf(o + (size_t)128 * 768, v10); st4bf(o + (size_t)128 * 768 + 128, v11); } };
struct DRetO { P p; static constexpr int FENCE = 1; static constexpr int K = 768, lda = 768, ldb = 768;
    HD bool unit(int L, Unit& u) const { int pm, pn; if (!rect_unit(L, 4 * NCQ, 2, pm, pn)) return false;
        u.A = wsb(p, O_AEXT) + (size_t)pm * 256 * 768; u.B = wsb(p, O_BEXT) + ((size_t)pm * 512 + pn * 256) * 768; u.a = pm; u.b = pn; u.c = 0; u.d = 0; return true; }
    HD void emit(const Unit& u, int r, int c, f32x4 v00, f32x4 v01, f32x4 v10, f32x4 v11) const {
        const int h = u.a / NCQ, cidx = u.a % NCQ;
        u16* o = wsb(p, O_OB) + ((size_t)cidx * 256 + r) * 2048 + h * 512 + u.b * 256 + c;
        st4bf(o, v00); st4bf(o + 128, v01); st4bf(o + (size_t)128 * 2048, v10); st4bf(o + (size_t)128 * 2048 + 128, v11); } };
struct DRetWoCtx { P p; int layer; static constexpr int FENCE = 4; static constexpr int K = 2048, lda = 2048, ldb = 2048;
    HD bool unit(int L, Unit& u) const { int pm, pn; if (!rect_unit(L, NC / 256, 4, pm, pn)) return false;
        u.A = wsb(p, O_YCTX) + (size_t)pm * 256 * 2048; u.B = wsb(p, O_RWO) + (size_t)pn * 256 * 2048; u.a = NL + pm * 256; u.b = pn; u.c = 0; u.d = 0; return true; }
    HD void emit(const Unit& u, int r, int c, f32x4 v00, f32x4 v01, f32x4 v10, f32x4 v11) const {
        const int R = u.a + r, col = u.b * 256 + c;
        resid4(p, layer, 5, 1.0f, R, col, v00); resid4(p, layer, 5, 1.0f, R, col + 128, v01); resid4(p, layer, 5, 1.0f, R + 128, col, v10); resid4(p, layer, 5, 1.0f, R + 128, col + 128, v11); } };
struct DRetWo { P p; int layer, q; static constexpr int FENCE = 4; static constexpr int K = 2048, lda = 2048, ldb = 2048;
    HD bool unit(int L, Unit& u) const { int pl, pn; if (!rect_unit(L, NCQ - RGB, 4, pl, pn)) return false; const int pm = pl + pl / (NCH - 1) + 1;
        u.A = wsb(p, O_OB) + (size_t)pm * 256 * 2048; u.B = wsb(p, O_RWO) + (size_t)pn * 256 * 2048; u.a = ret_tokrow(q, pm); u.b = pn; u.c = 0; u.d = 0; return true; }
    HD void emit(const Unit& u, int r, int c, f32x4 v00, f32x4 v01, f32x4 v10, f32x4 v11) const {
        const int R = u.a + r, col = u.b * 256 + c;
        resid4(p, layer, 5, 1.0f, R, col, v00); resid4(p, layer, 5, 1.0f, R, col + 128, v01); resid4(p, layer, 5, 1.0f, R + 128, col, v10); resid4(p, layer, 5, 1.0f, R + 128, col + 128, v11); } };

struct DS5L { P p; static constexpr int FENCE = 1; static constexpr int K = 512, lda = 768, ldb = 512;
    HD bool unit(int L, Unit& u) const { int pm, pn; if (!rect_unit(L, NROW5P / 256, 64, pm, pn)) return false;
        u.A = wsb(p, O_UEXT) + ((size_t)pn * NROW5P + pm * 256) * 768; u.B = wsb(p, O_FEXT) + (size_t)pn * 256 * 512; u.a = pm; u.b = pn; u.c = 0; u.d = 0; return true; }
    HD void emit(const Unit& u, int r, int c, f32x4 v00, f32x4 v01, f32x4 v10, f32x4 v11) const {
        u16* o = wsb(p, O_UEXT) + ((size_t)u.b * NROW5P + u.a * 256 + r) * 768 + 512 + c;
        st4bf(o, v00); st4bf(o + 128, v01); st4bf(o + (size_t)128 * 768, v10); st4bf(o + (size_t)128 * 768 + 128, v11); } };
struct DS5Y { P p; static constexpr int FENCE = 1; static constexpr int K = 768, lda = 768, ldb = 768;
    HD bool unit(int L, Unit& u) const { int pm, pn; if (!rect_unit(L, NROW5P / 256, 128, pm, pn)) return false;
        const int g = pn >> 1, ch = pn & 1;
        u.A = wsb(p, O_UEXT) + ((size_t)g * NROW5P + pm * 256) * 768; u.B = wsb(p, O_TEXT) + ((size_t)g * 512 + ch * 256) * 768; u.a = pm; u.b = g; u.c = ch; u.d = 0; return true; }
    HD void one(int g, int row, int col, f32x4 v) const {
        int tok; if (row < NB * S5L) tok = (row / S5L) * SEQ + (row % S5L) * 32; else if (row < NROW5) { const int rr = row - NB * S5L; tok = NL + (rr / S5C) * 256 + (rr % S5C) * 32; } else return;
        f32x4 o; for (int jx = 0; jx < 4; ++jx) o[jx] = gelu_f(v[jx]);
        st4bf(wsb(p, O_HN) + (size_t)(tok + (col >> 4)) * 1024 + g * 16 + (col & 15), o); }
    HD void emit(const Unit& u, int r, int c, f32x4 v00, f32x4 v01, f32x4 v10, f32x4 v11) const {
        const int row = u.a * 256 + r, col = u.c * 256 + c;
        one(u.b, row, col, v00); one(u.b, row, col + 128, v01); one(u.b, row + 128, col, v10); one(u.b, row + 128, col + 128, v11); } };
struct DS5Glu { P p; int layer; static constexpr int FENCE = 4; static constexpr int K = 1024, lda = 1024, ldb = 1024;
    HD bool unit(int L, Unit& u) const { int pm, pn; if (!rect_unit(L, MT / 256, 8, pm, pn)) return false;
        u.A = wsb(p, O_HN) + (size_t)pm * 256 * 1024; u.B = wsb(p, O_GLU) + (size_t)pn * 256 * 1024; u.a = pm; u.b = pn; u.c = 0; u.d = 0; return true; }
    HD void emit(const Unit& u, int r, int c, f32x4 v00, f32x4 v01, f32x4 v10, f32x4 v11) const {
        const int col = u.b * 128 + c; const float* gb = p.in[30]; f32x4 y0, y1;
        for (int jx = 0; jx < 4; ++jx) { const float ba = gb[col + jx], bg = gb[1024 + col + jx];
            y0[jx] = (v00[jx] + ba) * sigm_f(v01[jx] + bg); y1[jx] = (v10[jx] + ba) * sigm_f(v11[jx] + bg); }
        resid4(p, layer, 5, 1.0f, u.a * 256 + r, col, y0); resid4(p, layer, 5, 1.0f, u.a * 256 + r + 128, col, y1); } };

HD void cvt64(const float* src, int N, int srccol, u16* dst, int Kd, int nrow, int k0) {
    float v[64];
#pragma unroll
    for (int j = 0; j < 64; ++j) v[j] = srccol >= 0 ? src[(size_t)(k0 + j) * N + srccol] : 0.f;
#pragma unroll
    for (int j = 0; j < 64; j += 4) { f32x4 a; a[0] = v[j]; a[1] = v[j + 1]; a[2] = v[j + 2]; a[3] = v[j + 3]; st4bf(dst + (size_t)nrow * Kd + k0 + j, a); } }
constexpr long CV_FFI = (long)8 * 5632 * 16, CV_FFO = (long)8 * 1024 * 44, CV_MWIN = (long)2 * 768 * 16, CV_MWUQ = (long)2 * 1536 * 6, CV_MWUKV = (long)2 * 2048 * 4,
               CV_MWO = (long)2 * 1024 * 16, CV_RWIN = (long)6144 * 16, CV_RWO = (long)1024 * 32, CV_GLU = (long)2048 * 16;
constexpr long CV_TOTAL = CV_FFI + CV_FFO + CV_MWIN + CV_MWUQ + CV_MWUKV + CV_MWO + CV_RWIN + CV_RWO + CV_GLU;
HD void cvt_item(const P& p, long idx) {
    if (idx < CV_FFI) { const int n = (int)(idx % 5632); const long t = idx / 5632; const int kb = (int)(t % 16), m = (int)(t / 16);
        const int tile = n >> 8, rr = n & 255; const int sc = rr < 128 ? tile * 128 + rr : 2816 + tile * 128 + (rr - 128);
        cvt64(p.in[7] + (size_t)m * 1024 * 5632, 5632, sc, wsb(p, O_FFI + (size_t)m * SZ_FFI1), 1024, n, kb * 64); return; }
    idx -= CV_FFI;
    if (idx < CV_FFO) { const int n = (int)(idx % 1024); const long t = idx / 1024; const int kb = (int)(t % 44), m = (int)(t / 44);
        cvt64(p.in[8] + (size_t)m * 2816 * 1024, 1024, n, wsb(p, O_FFO + (size_t)m * SZ_FFO1), 2816, n, kb * 64); return; }
    idx -= CV_FFO;
    if (idx < CV_MWIN) { const int n = (int)(idx % 768); const long t = idx / 768; const int kb = (int)(t % 16), m = (int)(t / 16);
        cvt64(p.in[9] + (size_t)m * 1024 * 704, 704, n < 704 ? n : -1, wsb(p, O_MWIN + (size_t)m * SZ_MWIN), 1024, n, kb * 64); return; }
    idx -= CV_MWIN;
    if (idx < CV_MWUQ) { const int n = (int)(idx % 1536); const long t = idx / 1536; const int kb = (int)(t % 6), m = (int)(t / 6);
        cvt64(p.in[12] + (size_t)m * 384 * 1536, 1536, n, wsb(p, O_MWUQ + (size_t)m * SZ_MWUQ), 384, n, kb * 64); return; }
    idx -= CV_MWUQ;
    if (idx < CV_MWUKV) { const int n = (int)(idx % 2048); const long t = idx / 2048; const int kb = (int)(t % 4), m = (int)(t / 4);
        const int sc = n < 1024 ? (n >> 7) * 256 + (n & 127) : ((n - 1024) >> 7) * 256 + 128 + (n & 127);
        cvt64(p.in[13] + (size_t)m * 256 * 2048, 2048, sc, wsb(p, O_MWUKV + (size_t)m * SZ_MWUKV), 256, n, kb * 64); return; }
    idx -= CV_MWUKV;
    if (idx < CV_MWO) { const int n = (int)(idx % 1024); const long t = idx / 1024; const int kb = (int)(t % 16), m = (int)(t / 16);
        cvt64(p.in[16] + (size_t)m * 1024 * 1024, 1024, n, wsb(p, O_MWO + (size_t)m * SZ_MWO), 1024, n, kb * 64); return; }
    idx -= CV_MWO;
    if (idx < CV_RWIN) { const int n = (int)(idx % 6144), kb = (int)(idx / 6144); cvt64(p.in[17], 6144, n, wsb(p, O_RWIN), 1024, n, kb * 64); return; }
    idx -= CV_RWIN;
    if (idx < CV_RWO) { const int n = (int)(idx % 1024), kb = (int)(idx / 1024); cvt64(p.in[20], 1024, n, wsb(p, O_RWO), 2048, n, kb * 64); return; }
    idx -= CV_RWO;
    { const int n = (int)(idx % 2048), kb = (int)(idx / 2048); const int tile = n >> 8, rr = n & 255; const int sc = rr < 128 ? tile * 128 + rr : 1024 + tile * 128 + (rr - 128);
      cvt64(p.in[29], 2048, sc, wsb(p, O_GLU), 1024, n, kb * 64); }
}
HD void mod_item(const P& p, int idx) {
    const int layer = idx / 9216, col = idx % 9216; const float* w = p.in[4] + (size_t)layer * 1024 * 9216 + col; float acc[NMR];
    for (int b = 0; b < NMR; ++b) acc[b] = 0.f;
    for (int k = 0; k < 1024; ++k) { const float wv = w[(size_t)k * 9216];
#pragma unroll
        for (int b = 0; b < NMR; ++b) { const float cv = b < NB ? p.in[1][b * 1024 + k] : p.in[3][k]; acc[b] += silu_f(cv) * wv; } }
    const float bias = p.in[5][layer * 9216 + col];
#pragma unroll
    for (int b = 0; b < NMR; ++b) ((float*)(p.ws + O_MOD))[(size_t)(layer * NMR + b) * 9216 + col] = acc[b] + bias; }
HD void copy_item(const P& p, long idx) {
    const long nl4 = (long)NL * 256;
    if (idx < nl4) ((f32x4*)p.out)[idx] = ((const f32x4*)p.in[0])[idx]; else ((f32x4*)(p.ws + O_G))[idx - nl4] = ((const f32x4*)p.in[2])[idx - nl4]; }
HD void norm_item(const P& p, int layer, int k, int r, int s5) {
    const float* x = hsrc(p, r, layer == 0 && k == 0); float ss = 0.f;
    for (int d = 0; d < 1024; d += 4) { const f32x4 v = *(const f32x4*)(x + d); ss += v[0] * v[0] + v[1] * v[1] + v[2] * v[2] + v[3] * v[3]; }
    const float rinv = rsq_f(ss * (1.0f / 1024.0f) + EPS);
    const float* g = p.in[6] + (size_t)(layer * 3 + k) * 1024; const float* sh = modp(p, layer, r, 3 * k); const float* sc = modp(p, layer, r, 3 * k + 1);
    int row5 = 0, i5 = 0;
    if (s5) { if (r < NL) { const int b = r / SEQ, t = r % SEQ; row5 = b * S5L + t / 32; i5 = t % 32; } else { const int rr = r - NL; const int b = rr / 256, l = rr % 256; row5 = NB * S5L + b * S5C + l / 32; i5 = l % 32; } }
    for (int d = 0; d < 1024; d += 4) { const f32x4 v = *(const f32x4*)(x + d); f32x4 o;
        for (int j = 0; j < 4; ++j) o[j] = v[j] * rinv * g[d + j] * (1.0f + sc[d + j]) + sh[d + j];
        if (!s5) st4bf(wsb(p, O_HN) + (size_t)r * 1024 + d, o);
        else st4bf(wsb(p, O_UEXT) + ((size_t)(d >> 4) * NROW5P + row5) * 768 + i5 * 16 + (d & 15), o); } }
HD void axial_rot64(float* v, int t) {
    const int prow = t / 64, pcol = t % 64;
    for (int f = 0; f < 16; ++f) { const float fq = ropef(f, 16);
        { float cs, sn; sincos_t((float)prow * fq, sn, cs); const float x1 = v[f], x2 = v[16 + f]; v[f] = x1 * cs - x2 * sn; v[16 + f] = x2 * cs + x1 * sn; }
        { float cs, sn; sincos_t((float)pcol * fq, sn, cs); const float x1 = v[32 + f], x2 = v[48 + f]; v[32 + f] = x1 * cs - x2 * sn; v[48 + f] = x2 * cs + x1 * sn; } } }
HD void mla_row_item(const P& p, int j, int r) {
    const float* x = (const float*)(p.ws + O_CALL) + (size_t)r * 768; float ss = 0.f;
    for (int d = 0; d < 384; ++d) ss += x[d] * x[d];
    float rinv = rsq_f(ss * (1.0f / 384.0f) + EPS); const float* qn = p.in[10] + j * 384;
    for (int d = 0; d < 384; d += 4) { f32x4 o; for (int jx = 0; jx < 4; ++jx) o[jx] = x[d + jx] * rinv * qn[d + jx]; st4bf(wsb(p, O_CQN) + (size_t)r * 384 + d, o); }
    ss = 0.f; for (int d = 0; d < 256; ++d) ss += x[384 + d] * x[384 + d];
    rinv = rsq_f(ss * (1.0f / 256.0f) + EPS); const float* kvn = p.in[11] + j * 256;
    for (int d = 0; d < 256; d += 4) { f32x4 o; for (int jx = 0; jx < 4; ++jx) o[jx] = x[384 + d + jx] * rinv * kvn[d + jx]; st4bf(wsb(p, O_CKVN) + (size_t)r * 256 + d, o); }
    ss = 0.f; for (int d = 0; d < 64; ++d) ss += x[640 + d] * x[640 + d];
    rinv = rsq_f(ss * (1.0f / 64.0f) + EPS); const float* kg = p.in[15] + j * 192 + 128;
#ifdef HOST_EMU
    float kr[64];
    for (int d = 0; d < 64; ++d) kr[d] = x[640 + d] * rinv * kg[d];
    if (r < NL) axial_rot64(kr, r % SEQ);
    for (int h = 0; h < 8; ++h) for (int d = 0; d < 64; ++d) wsb(p, O_KF)[(size_t)r * 1536 + h * 192 + 128 + d] = f2bf(kr[d]);
#else
    const int t = r % SEQ, prow = t / 64, pcol = t % 64;
    for (int f = 0; f < 16; ++f) { const float fq = ropef(f, 16);
#pragma unroll
        for (int part = 0; part < 2; ++part) { float cs = 1.f, sn = 0.f; if (r < NL) sincos_t((float)(part ? pcol : prow) * fq, sn, cs);
            const int d1 = part * 32 + f, d2 = d1 + 16; const float x1 = x[640 + d1] * rinv * kg[d1], x2 = x[640 + d2] * rinv * kg[d2];
            const u16 o1 = f2bf(x1 * cs - x2 * sn), o2 = f2bf(x2 * cs + x1 * sn);
            for (int h = 0; h < 8; ++h) { wsb(p, O_KF)[(size_t)r * 1536 + h * 192 + 128 + d1] = o1; wsb(p, O_KF)[(size_t)r * 1536 + h * 192 + 128 + d2] = o2; } } }
#endif
}
HD void mla_head_item(const P& p, int j, int idx) {
    const int r = idx >> 3, h = idx & 7;
    u16* q = wsb(p, O_CALL) + (size_t)r * 1536 + h * 192; const float* qg = p.in[14] + j * 192; float ss = 0.f;
    for (int d = 0; d < 128; ++d) { const float v = bf2f(q[d]); ss += v * v; }
    float rinv = rsq_f(ss * (1.0f / 128.0f) + EPS);
    for (int d = 0; d < 128; ++d) q[d] = f2bf(bf2f(q[d]) * rinv * qg[d]);
    ss = 0.f; for (int d = 0; d < 64; ++d) { const float v = bf2f(q[128 + d]); ss += v * v; }
    rinv = rsq_f(ss * (1.0f / 64.0f) + EPS);
    { const int t = r % SEQ, prow = t / 64, pcol = t % 64;
      for (int f = 0; f < 16; ++f) { const float fq = ropef(f, 16);
#pragma unroll
        for (int part = 0; part < 2; ++part) { float cs = 1.f, sn = 0.f; if (r < NL) sincos_t((float)(part ? pcol : prow) * fq, sn, cs);
            const int d1 = 128 + part * 32 + f, d2 = d1 + 16; const float x1 = bf2f(q[d1]) * rinv * qg[d1], x2 = bf2f(q[d2]) * rinv * qg[d2];
            q[d1] = f2bf(x1 * cs - x2 * sn); q[d2] = f2bf(x2 * cs + x1 * sn); } } }
    u16* k = wsb(p, O_KF) + (size_t)r * 1536 + h * 192; const float* kg = p.in[15] + j * 192;
    ss = 0.f; for (int d = 0; d < 128; ++d) { const float v = bf2f(k[d]); ss += v * v; }
    rinv = rsq_f(ss * (1.0f / 128.0f) + EPS);
    for (int d = 0; d < 128; ++d) k[d] = f2bf(bf2f(k[d]) * rinv * kg[d]);
}
HD void ret_prefix_item(const P& p, int idx) {
    const int d4 = idx & 63, e = (idx >> 6) & 511, bq = (idx >> 15) % RGB, h = (idx >> 15) / RGB;
    const float gf = expf(256.f * ret_logg(p, 0, h)), gb = expf(256.f * ret_logg(p, 1, h));
    u16* base = wsb(p, O_BEXT) + (((size_t)h * NCQ + bq * NCH) * 512 + e) * 768 + d4 * 4; constexpr size_t CS = (size_t)512 * 768;
    u32x2 tf[NCH], tb[NCH];
#pragma unroll
    for (int n = 0; n < NCH; ++n) { tf[n] = *(const u32x2*)(base + n * CS + 256); tb[n] = *(const u32x2*)(base + n * CS + 512); }
    f32x4 cf = {0.f, 0.f, 0.f, 0.f}, cb = {0.f, 0.f, 0.f, 0.f};
#pragma unroll
    for (int n = 0; n < NCH; ++n) { f32x4 t; t[0] = bf2f((u16)(tf[n].x & 0xffff)); t[1] = bf2f((u16)(tf[n].x >> 16)); t[2] = bf2f((u16)(tf[n].y & 0xffff)); t[3] = bf2f((u16)(tf[n].y >> 16));
        st4bf(base + n * CS + 256, cf); cf = cf * gf + t; }
#pragma unroll
    for (int s_ = 0; s_ < NCH; ++s_) { const int n = s_ == 0 ? 0 : NCH - s_; f32x4 t; t[0] = bf2f((u16)(tb[n].x & 0xffff)); t[1] = bf2f((u16)(tb[n].x >> 16)); t[2] = bf2f((u16)(tb[n].y & 0xffff)); t[3] = bf2f((u16)(tb[n].y >> 16));
        st4bf(base + n * CS + 512, cb); cb = cb * gb + t; } }
HD u16* ret_ydst(const P& p, int q, int lr) { const int cidx = lr >> 8, n = cidx % NCH; return n == 0 ? wsb(p, O_YCTX) + ((size_t)((q * RGB + cidx / NCH) * 256 + (lr & 255))) * 2048 : wsb(p, O_OB) + (size_t)lr * 2048; }
HD void ret_norm_item(const P& p, int qg, int idx) {
    const int lr = idx >> 2, h = idx & 3; u16* o = wsb(p, O_OB) + (size_t)lr * 2048 + h * 512; u16* yd = ret_ydst(p, qg, lr) + h * 512; const u16* g = wsb(p, O_GATE) + (size_t)lr * 2048 + h * 512; const float* gg = p.in[19] + h * 512;
    float s = 0.f; for (int e = 0; e < 512; ++e) s += bf2f(o[e]);
    const float mu = s * (1.0f / 512.0f); float q = 0.f; for (int e = 0; e < 512; ++e) { const float d = bf2f(o[e]) - mu; q += d * d; }
    const float rstd = rsq_f(q * (1.0f / 512.0f) + EPS);
    for (int e = 0; e < 512; ++e) yd[e] = f2bf((bf2f(o[e]) - mu) * rstd * gg[e] * silu_f(bf2f(g[e]))); }
struct Cx { float re, im; };
HD Cx cmul(Cx a, Cx b) { Cx r; r.re = a.re * b.re - a.im * b.im; r.im = a.re * b.im + a.im * b.re; return r; }
HD Cx s5_alog(const P& p, int dir, int g, int pp) { const float dt = expf(p.in[23][dir * 64 + g]); Cx r; r.re = p.in[21][(dir * 64 + g) * 64 + pp] * dt; r.im = p.in[22][(dir * 64 + g) * 64 + pp] * dt; return r; }
HD Cx cpowa(Cx al, float n) { const float m = expf(al.re * n); float sn, cs; sincos_t(al.im * n * 0.15915494309189535f, sn, cs); Cx r; r.re = m * cs; r.im = m * sn; return r; }
HD Cx s5_coef(const P& p, int dir, int g, int pp) {
    const Cx al = s5_alog(p, dir, g, pp); Cx a = cpowa(al, 1.f); a.re -= 1.f; const float lr = p.in[21][(dir * 64 + g) * 64 + pp], li = p.in[22][(dir * 64 + g) * 64 + pp], den = 1.0f / (lr * lr + li * li);
    Cx r; r.re = (a.re * lr + a.im * li) * den; r.im = (a.im * lr - a.re * li) * den; return r; }
HD Cx s5_bbar(const P& p, int dir, int g, int pp, int m) { Cx b; const size_t o = (((size_t)dir * 64 + g) * 64 + pp) * 16 + m; b.re = p.in[24][o]; b.im = p.in[25][o]; return cmul(s5_coef(p, dir, g, pp), b); }
HD Cx s5_c(const P& p, int dir, int g, int m, int pp) { Cx c; const size_t o = (((size_t)dir * 64 + g) * 16 + m) * 64 + pp; c.re = p.in[26][o]; c.im = p.in[27][o]; return c; }
HD void s5_ktab_item(const P& p, int idx) {
    const int m = idx & 15, tau = (idx >> 4) & 31, dir = (idx >> 9) & 1, g = idx >> 10; float acc[16];
#pragma unroll
    for (int m2 = 0; m2 < 16; ++m2) acc[m2] = 0.f;
    for (int pp = 0; pp < 64; ++pp) { const Cx w = cmul(cmul(s5_c(p, dir, g, m, pp), cpowa(s5_alog(p, dir, g, pp), (float)tau)), s5_coef(p, dir, g, pp));
        const size_t o = (((size_t)dir * 64 + g) * 64 + pp) * 16;
#pragma unroll
        for (int m2 = 0; m2 < 16; ++m2) acc[m2] += w.re * p.in[24][o + m2] - w.im * p.in[25][o + m2]; }
#pragma unroll
    for (int m2 = 0; m2 < 16; ++m2) ((float*)(p.ws + O_KTAB))[(size_t)idx * 16 + m2] = acc[m2]; }
HD void s5_text_item(const P& p, long idx) {
    const int col = (int)(idx % 768); const long t = idx / 768; const int row = (int)(t % 512), g = (int)(t / 512), i = row >> 4, m = row & 15; float v;
    const float* kt = (const float*)(p.ws + O_KTAB);
    if (col < 512) { const int jj = col >> 4, m2 = col & 15; v = 0.f;
        if (jj <= i) v += kt[((((size_t)g * 2 + 0) * 32 + (i - jj)) * 16 + m) * 16 + m2];
        if (jj >= i) v += kt[((((size_t)g * 2 + 1) * 32 + (jj - i)) * 16 + m) * 16 + m2];
        if (jj == i && m == m2) v += p.in[28][g * 16 + m]; }
    else { const int dir = col >= 640, pp = ((col - 512) & 127) >> 1, part = col & 1;
        const Cx w = cmul(s5_c(p, dir, g, m, pp), cpowa(s5_alog(p, dir, g, pp), dir ? (float)(32 - i) : (float)(i + 1))); v = part ? -w.im : w.re; }
    wsb(p, O_TEXT)[idx] = f2bf(v); }
HD void s5_fext_item(const P& p, int idx) {
    const int col = idx & 511, row = (idx >> 9) & 255, g = idx >> 17, jj = col >> 4, m2 = col & 15, dir = row >> 7, pp = (row & 127) >> 1, part = row & 1;
    const Cx w = cmul(cpowa(s5_alog(p, dir, g, pp), dir ? (float)jj : (float)(31 - jj)), s5_bbar(p, dir, g, pp, m2));
    wsb(p, O_FEXT)[idx] = f2bf(part ? w.im : w.re); }
HD int s5_row(int b, int s) { return s < S5C ? NB * S5L + b * S5C + s : b * S5L + (s - S5C); }
HD void s5_prefix_item(const P& p, int idx) {
    const int pp = idx & 63, b = (idx >> 6) % NB, g = (idx >> 6) / NB;
    const Cx af = cpowa(s5_alog(p, 0, g, pp), 32.f), ab = cpowa(s5_alog(p, 1, g, pp), 32.f);
    u16* base = wsb(p, O_UEXT) + (size_t)g * NROW5P * 768; Cx c; c.re = 0.f; c.im = 0.f;
    for (int s0 = 0; s0 < S5C + S5L; s0 += 8) { unsigned t[8];
#pragma unroll
        for (int k = 0; k < 8; ++k) t[k] = *(const unsigned*)(base + (size_t)s5_row(b, s0 + k) * 768 + 512 + 2 * pp);
#pragma unroll
        for (int k = 0; k < 8; ++k) { u16* q = base + (size_t)s5_row(b, s0 + k) * 768 + 512 + 2 * pp; *(unsigned*)q = (unsigned)f2bf(c.re) | ((unsigned)f2bf(c.im) << 16);
            c = cmul(af, c); c.re += bf2f((u16)(t[k] & 0xffff)); c.im += bf2f((u16)(t[k] >> 16)); } }
    c.re = 0.f; c.im = 0.f;
    for (int s0 = 0; s0 < S5C + S5L; s0 += 8) { unsigned t[8]; int sv[8];
#pragma unroll
        for (int k = 0; k < 8; ++k) { const int s_ = s0 + k; sv[k] = s_ < S5C ? S5C - 1 - s_ : S5C + S5L - 1 - (s_ - S5C); t[k] = *(const unsigned*)(base + (size_t)s5_row(b, sv[k]) * 768 + 640 + 2 * pp); }
#pragma unroll
        for (int k = 0; k < 8; ++k) { u16* q = base + (size_t)s5_row(b, sv[k]) * 768 + 640 + 2 * pp; *(unsigned*)q = (unsigned)f2bf(c.re) | ((unsigned)f2bf(c.im) << 16);
            c = cmul(ab, c); c.re += bf2f((u16)(t[k] & 0xffff)); c.im += bf2f((u16)(t[k] >> 16)); } } }

struct AttItem { const u16* q; const u16* k0; const u16* k1; const u16* v0; const u16* v1; u16* o; int n0, ntot; };
HD void att_item(const P& p, int it, AttItem& a) {
    const u16* Q = wsb(p, O_CALL); const u16* KF = wsb(p, O_KF); const u16* VB = wsb(p, O_VB); u16* O = wsb(p, O_HN);
    const int nlat = NB * 8 * (SEQ / 256);
    if (it < nlat) { const int qb = it % (SEQ / 256), h = (it / (SEQ / 256)) & 7, b = it / (SEQ / 256) / 8; const size_t r0 = (size_t)b * SEQ + qb * 256, c0 = (size_t)NL + b * 256, l0 = (size_t)b * SEQ;
        a.q = Q + r0 * 1536 + h * 192; a.o = O + r0 * 1024 + h * 128; a.k0 = KF + c0 * 1536 + h * 192; a.v0 = VB + c0 * 1024 + h * 128; a.k1 = KF + l0 * 1536 + h * 192; a.v1 = VB + l0 * 1024 + h * 128; a.n0 = 256; a.ntot = 256 + SEQ; }
    else { const int x = it - nlat, h = x & 7, b = x >> 3; const size_t c0 = (size_t)NL + b * 256;
        a.q = Q + c0 * 1536 + h * 192; a.o = O + c0 * 1024 + h * 128; a.k0 = KF + c0 * 1536 + h * 192; a.v0 = VB + c0 * 1024 + h * 128; a.k1 = a.k0; a.v1 = a.v0; a.n0 = 256; a.ntot = 256; } }
constexpr float ATT_SCALE = 0.07216878364870322f;

#ifndef HOST_EMU
#define LAS __attribute__((address_space(3)))
typedef short bf16x8 __attribute__((ext_vector_type(8)));
typedef short s16x4 __attribute__((ext_vector_type(4)));
typedef float f32x16 __attribute__((ext_vector_type(16)));
typedef unsigned u32x4 __attribute__((ext_vector_type(4)));
constexpr int HTB = 128 * 64 * 2, STAGE_BYTES = 8 * HTB;
__device__ __forceinline__ int lds_byte(int r, int c) { const int st = (r >> 4) * 2 + (c >> 5), rr = r & 15, cc = c & 31, ob = rr * 64 + cc * 2; return st * 1024 + (ob ^ (((ob >> 9) & 1) << 5)); }
__device__ __forceinline__ void stage_rc(int b, int& R, int& C) { const int st = b / 1024, sb = b % 1024, swz = sb ^ (((sb >> 9) & 1) << 5); R = (st >> 1) * 16 + swz / 64; C = (st & 1) * 32 + (swz % 64) / 2; }

template <class Dsc>
__device__ __forceinline__ void gemm_run(LAS unsigned char* lds, const Dsc& D) {
    int tid_ = threadIdx.x; asm volatile("" : "+v"(tid_));
    const int tid = tid_, wid = __builtin_amdgcn_readfirstlane(tid >> 6), lane = tid & 63, wr = wid >> 2, wc = wid & 3, fr = lane & 15, fq = lane >> 4;
    constexpr int K = Dsc::K, nt = K / 64, lda = Dsc::lda, ldb = Dsc::ldb;
    static_assert(K % 128 == 0 && K >= 256, "K");
    unsigned voffA[2], voffB[2];
#pragma unroll
    for (int i = 0; i < 2; ++i) { int R, C; stage_rc(tid * 16 + i * 8192, R, C); voffA[i] = (unsigned)(R * lda + C) * 2u; voffB[i] = (unsigned)(R * ldb + C) * 2u; }
    constexpr size_t kstep = 128, hstepA = (size_t)128 * lda * 2, hstepB = (size_t)128 * ldb * 2;
    const unsigned ldsw = (unsigned)wid * 1024u;
    const int aoff = lds_byte(wr * 64 + fr, fq * 8), boff = lds_byte(wc * 32 + fr, fq * 8);
#define G_SA(b, h) (((b) * 2 + (h)) * HTB)
#define G_SB(b, h) ((4 + (b) * 2 + (h)) * HTB)
#define G_STAGE(bufoff, gbase, voff) do { _Pragma("unroll") for (int _i = 0; _i < 2; ++_i) \
        __builtin_amdgcn_global_load_lds((const unsigned*)((const char*)(gbase) + (voff)[_i]), (LAS unsigned*)(lds + (bufoff) + ldsw + _i * 8192), 16, 0, 0); } while (0)
#define G_LDA(dst, b, h) do { _Pragma("unroll") for (int m = 0; m < 4; ++m) _Pragma("unroll") for (int k = 0; k < 2; ++k) dst[m][k] = *(const LAS bf16x8*)(lds + G_SA(b, h) + aoff + m * 2048 + k * 1024); } while (0)
#define G_LDB(dst, b, h) do { _Pragma("unroll") for (int n = 0; n < 2; ++n) _Pragma("unroll") for (int k = 0; k < 2; ++k) dst[n][k] = *(const LAS bf16x8*)(lds + G_SB(b, h) + boff + n * 2048 + k * 1024); } while (0)
#define G_MMA(ai, bj, At, Bt) do { __builtin_amdgcn_s_setprio(1); _Pragma("unroll") for (int m = 0; m < 4; ++m) _Pragma("unroll") for (int n = 0; n < 2; ++n) _Pragma("unroll") for (int k = 0; k < 2; ++k) \
        acc[ai][bj][m][n] = __builtin_amdgcn_mfma_f32_16x16x32_bf16(Bt[n][k], At[m][k], acc[ai][bj][m][n], 0, 0, 0); __builtin_amdgcn_s_setprio(0); } while (0)
#define G_WAIT_V(n) asm volatile("s_waitcnt vmcnt(" #n ")" ::: "memory")
#define G_WAIT_L(n) asm volatile("s_waitcnt lgkmcnt(" #n ")" ::: "memory")
#define G_BAR __builtin_amdgcn_s_barrier()
#define G_SCHED __builtin_amdgcn_sched_barrier(0)
    Unit cur{}, nxt{}; int ui = 0; const int G = gridDim.x, cb = blockIdx.x;
    if (!D.unit(cb, cur)) return;
    f32x4 acc[2][2][4][2];
#pragma unroll
    for (int a = 0; a < 2; ++a)
#pragma unroll
        for (int b = 0; b < 2; ++b)
#pragma unroll
            for (int m = 0; m < 4; ++m)
#pragma unroll
                for (int n = 0; n < 2; ++n) acc[a][b][m][n] = (f32x4){0.f, 0.f, 0.f, 0.f};
    bf16x8 At[4][2], B0[2][2], B1[2][2];
    const char* cA = (const char*)cur.A; const char* cB = (const char*)cur.B;
    G_STAGE(G_SB(0, 0), cB, voffB); G_STAGE(G_SA(0, 0), cA, voffA); G_STAGE(G_SB(0, 1), cB + hstepB, voffB); G_STAGE(G_SA(0, 1), cA + hstepA, voffA);
    if (wr == 1) G_BAR;
    G_WAIT_V(4); G_BAR;
    G_STAGE(G_SB(1, 0), cB + kstep, voffB); G_STAGE(G_SA(1, 0), cA + kstep, voffA); G_STAGE(G_SB(1, 1), cB + hstepB + kstep, voffB);
    G_WAIT_V(6); G_BAR;
    for (;;) {
        const bool has_next = D.unit((ui + 1) * G + cb, nxt);
        const char* nA = has_next ? (const char*)nxt.A : cA; const char* nB = has_next ? (const char*)nxt.B : cB;
        _Pragma("nounroll") for (int t = 0; t < nt; t += 2) {
            const bool last = (t == nt - 2);
            const char* a1 = cA + (size_t)(t + 1) * kstep;
            const char* a2 = last ? nA : cA + (size_t)(t + 2) * kstep; const char* b2 = last ? nB : cB + (size_t)(t + 2) * kstep;
            const char* a3 = a2 + kstep; const char* b3 = b2 + kstep;
            G_LDB(B0, 0, 0); G_SCHED; G_LDA(At, 0, 0); G_STAGE(G_SA(1, 1), a1 + hstepA, voffA);
            G_WAIT_L(8); G_BAR; G_WAIT_L(0); G_MMA(0, 0, At, B0); G_BAR; G_SCHED;
            G_LDB(B1, 0, 1); G_STAGE(G_SB(0, 0), b2, voffB);
            G_BAR; G_WAIT_L(0); G_MMA(0, 1, At, B1); G_BAR;
            G_LDA(At, 0, 1); G_STAGE(G_SA(0, 0), a2, voffA);
            G_BAR; G_WAIT_L(0); G_MMA(1, 0, At, B0); G_BAR; G_SCHED;
            G_STAGE(G_SB(0, 1), b2 + hstepB, voffB);
            G_WAIT_V(6); G_BAR; G_MMA(1, 1, At, B1); G_BAR;
            G_LDB(B0, 1, 0); G_SCHED; G_LDA(At, 1, 0); G_STAGE(G_SA(0, 1), a2 + hstepA, voffA);
            G_WAIT_L(8); G_BAR; G_WAIT_L(0); G_MMA(0, 0, At, B0); G_BAR; G_SCHED;
            G_LDB(B1, 1, 1); G_STAGE(G_SB(1, 0), b3, voffB);
            G_BAR; G_WAIT_L(0); G_MMA(0, 1, At, B1); G_BAR;
            G_LDA(At, 1, 1); G_STAGE(G_SA(1, 0), a3, voffA);
            G_BAR; G_WAIT_L(0); G_MMA(1, 0, At, B0); G_BAR; G_SCHED;
            G_STAGE(G_SB(1, 1), b3 + hstepB, voffB);
            G_WAIT_V(6); G_BAR; G_MMA(1, 1, At, B1); G_BAR;
        }
        int er_ = wr * 64 + fr, ec_ = wc * 32 + fq * 4; asm volatile("" : "+v"(er_), "+v"(ec_));
#pragma unroll
        for (int m = 0; m < 4; ++m)
#pragma unroll
            for (int n = 0; n < 2; ++n) { D.emit(cur, er_ + m * 16, ec_ + n * 16, acc[0][0][m][n], acc[0][1][m][n], acc[1][0][m][n], acc[1][1][m][n]); if (((m * 2 + n + 1) % Dsc::FENCE) == 0) asm volatile("" ::: "memory"); }
        if (!has_next) break;
#pragma unroll
        for (int a = 0; a < 2; ++a)
#pragma unroll
            for (int b = 0; b < 2; ++b)
#pragma unroll
                for (int m = 0; m < 4; ++m)
#pragma unroll
                    for (int n = 0; n < 2; ++n) acc[a][b][m][n] = (f32x4){0.f, 0.f, 0.f, 0.f};
        cur = nxt; cA = nA; cB = nB; ++ui;
    }
    G_WAIT_V(0);
    if (wr == 0) G_BAR;
    G_BAR;
#undef G_SA
#undef G_SB
#undef G_STAGE
#undef G_LDA
#undef G_LDB
#undef G_MMA
#undef G_WAIT_V
#undef G_WAIT_L
#undef G_BAR
#undef G_SCHED
}

constexpr int A_SHM_V = 64 * 128 * 2, A_SHM_K = 64 * 192 * 2;
#define KSWZ(row, colB) ((row) * 384 + ((colB) ^ (((row) & 7) << 4)))
__device__ __forceinline__ int crow(int r, int hi) { return (r & 3) + 8 * (r >> 2) + 4 * hi; }
__device__ __forceinline__ unsigned cvtpk(float lo, float hi) { unsigned r; asm volatile("v_cvt_pk_bf16_f32 %0, %1, %2" : "=v"(r) : "v"(lo), "v"(hi)); return r; }
__device__ __forceinline__ int v_st(int k, int c) { const int kk = (k & ~0xC) | ((k & 4) << 1) | ((k & 8) >> 1); return ((kk >> 3) * 4 + (c >> 5)) * 512 + ((kk & 7) * 32 + (c & 31)) * 2; }
__device__ __forceinline__ int v_rd_base(int lane) { return ((lane & 3) << 3) | (((lane >> 2) & 3) << 6) | (((lane >> 4) & 1) << 5) | (((lane >> 5) & 1) << 8); }
constexpr int v_rd_off(int d0, int ks, int half) { return d0 * 512 + ks * 4096 + half * 2048; }
template <int OFF> __device__ __forceinline__ s16x4 tr_read(int vb) { s16x4 r; asm volatile("ds_read_b64_tr_b16 %0, %1 offset:%2" : "=&v"(r) : "v"(vb), "i"(OFF) : "memory"); return r; }
template <int D0> __device__ __forceinline__ void pv_one(f32x16& od, int vb, bf16x8 pa0, bf16x8 pa1, bf16x8 pa2, bf16x8 pa3) {
    const s16x4 l0 = tr_read<v_rd_off(D0, 0, 0)>(vb), h0 = tr_read<v_rd_off(D0, 0, 1)>(vb), l1 = tr_read<v_rd_off(D0, 1, 0)>(vb), h1 = tr_read<v_rd_off(D0, 1, 1)>(vb);
    const s16x4 l2 = tr_read<v_rd_off(D0, 2, 0)>(vb), h2 = tr_read<v_rd_off(D0, 2, 1)>(vb), l3 = tr_read<v_rd_off(D0, 3, 0)>(vb), h3 = tr_read<v_rd_off(D0, 3, 1)>(vb);
    asm volatile("s_waitcnt lgkmcnt(0)" ::: "memory"); __builtin_amdgcn_sched_barrier(0);
#define PK(L, H) (bf16x8){L[0], L[1], L[2], L[3], H[0], H[1], H[2], H[3]}
    od = __builtin_amdgcn_mfma_f32_32x32x16_bf16(pa0, PK(l0, h0), od, 0, 0, 0);
    od = __builtin_amdgcn_mfma_f32_32x32x16_bf16(pa1, PK(l1, h1), od, 0, 0, 0);
    od = __builtin_amdgcn_mfma_f32_32x32x16_bf16(pa2, PK(l2, h2), od, 0, 0, 0);
    od = __builtin_amdgcn_mfma_f32_32x32x16_bf16(pa3, PK(l3, h3), od, 0, 0, 0);
#undef PK
}
__device__ __forceinline__ void att_body(const AttItem& a, char* lds) {
    int tid_ = threadIdx.x; asm volatile("" : "+v"(tid_));
    const int tid = tid_, wid = tid >> 6, lane = tid & 63, r32 = lane & 31, hi = lane >> 5;
    char* V_lds = lds; char* K_lds = lds + 2 * A_SHM_V; float* li_l = (float*)(lds + 2 * A_SHM_V + 2 * A_SHM_K) + wid * 64;
    float l_reg = 0.f; f32x16 o[4] = {}; bf16x8 qr[12];
    const u16* Qw = a.q + (size_t)(wid * 32 + r32) * 1536 + hi * 8;
#pragma unroll
    for (int d0 = 0; d0 < 12; ++d0) qr[d0] = *(const bf16x8*)(Qw + d0 * 16);
    const int sr = tid >> 4, sc = (tid & 15) * 8, vst0 = v_st(sr, sc), vst1 = v_st(32 + sr, sc);
    const int voff0 = sr * 1024 + sc, voff1 = (32 + sr) * 1024 + sc;
    int koff[3], kwr[3];
#pragma unroll
    for (int i = 0; i < 3; ++i) { const int id = tid + i * 512, kr_ = id / 24, kc_ = (id % 24) * 8; koff[i] = kr_ * 1536 + kc_; kwr[i] = KSWZ(kr_, kc_ * 2); }
    const int vb0 = (int)(uintptr_t)V_lds + v_rd_base(lane);
    bf16x8 vs0, vs1, ks[3];
    const int NT = a.ntot / 64;
#define A_SLOAD(k0_) do { const int key0_ = (k0_); const u16* kb_ = key0_ < a.n0 ? a.k0 + (size_t)key0_ * 1536 : a.k1 + (size_t)(key0_ - a.n0) * 1536; \
        const u16* vbp_ = key0_ < a.n0 ? a.v0 + (size_t)key0_ * 1024 : a.v1 + (size_t)(key0_ - a.n0) * 1024; \
        vs0 = *(const bf16x8*)(vbp_ + voff0); vs1 = *(const bf16x8*)(vbp_ + voff1); \
        _Pragma("unroll") for (int i = 0; i < 3; ++i) ks[i] = *(const bf16x8*)(kb_ + koff[i]); } while (0)
#define A_SWRITE(b) do { *(bf16x8*)(V_lds + (b) * A_SHM_V + vst0) = vs0; *(bf16x8*)(V_lds + (b) * A_SHM_V + vst1) = vs1; \
        _Pragma("unroll") for (int i = 0; i < 3; ++i) *(bf16x8*)(K_lds + (b) * A_SHM_K + kwr[i]) = ks[i]; } while (0)
    A_SLOAD(0); A_SWRITE(0); __syncthreads();
    constexpr float C = ATT_SCALE * 1.4426950408889634f;
    _Pragma("nounroll") for (int j = 0; j < NT; ++j) {
        const int buf = j & 1;
        if (j + 1 < NT) A_SLOAD((j + 1) * 64);
        f32x16 p0 = {}, p1 = {};
        const char* Ks = K_lds + buf * A_SHM_K;
#pragma unroll
        for (int d0 = 0; d0 < 12; ++d0) { const int cbb = (d0 * 16 + hi * 8) * 2;
            const bf16x8 b0 = *(const bf16x8*)(Ks + KSWZ(r32, cbb)); const bf16x8 b1 = *(const bf16x8*)(Ks + KSWZ(32 + r32, cbb));
            p0 = __builtin_amdgcn_mfma_f32_32x32x16_bf16(b0, qr[d0], p0, 0, 0, 0);
            p1 = __builtin_amdgcn_mfma_f32_32x32x16_bf16(b1, qr[d0], p1, 0, 0, 0); }
        float ps = 0.f;
#pragma unroll
        for (int r = 0; r < 16; ++r) { p0[r] = __builtin_amdgcn_exp2f(p0[r] * C); p1[r] = __builtin_amdgcn_exp2f(p1[r] * C); ps += p0[r] + p1[r]; }
        { auto rr = __builtin_amdgcn_permlane32_swap(__float_as_uint(ps), __float_as_uint(ps), false, false); ps = __uint_as_float(rr[0]) + __uint_as_float(rr[1]); }
        l_reg += ps;
        bf16x8 pa0, pa1, pa2, pa3;
#define PK4(Pv, BASE, OUT) do { unsigned a0 = cvtpk(Pv[BASE + 0], Pv[BASE + 1]), a1 = cvtpk(Pv[BASE + 2], Pv[BASE + 3]); \
        unsigned b0 = cvtpk(Pv[BASE + 4], Pv[BASE + 5]), b1 = cvtpk(Pv[BASE + 6], Pv[BASE + 7]); \
        auto r0 = __builtin_amdgcn_permlane32_swap(a0, b0, false, false); auto r1 = __builtin_amdgcn_permlane32_swap(a1, b1, false, false); \
        u32x4 w = {r0[0], r1[0], r0[1], r1[1]}; OUT = *reinterpret_cast<bf16x8*>(&w); } while (0)
        PK4(p0, 0, pa0); PK4(p0, 8, pa1); PK4(p1, 0, pa2); PK4(p1, 8, pa3);
#undef PK4
        const int vb = vb0 + buf * A_SHM_V;
        pv_one<0>(o[0], vb, pa0, pa1, pa2, pa3); pv_one<1>(o[1], vb, pa0, pa1, pa2, pa3); pv_one<2>(o[2], vb, pa0, pa1, pa2, pa3); pv_one<3>(o[3], vb, pa0, pa1, pa2, pa3);
        if (j + 1 < NT) A_SWRITE(buf ^ 1);
        __syncthreads();
    }
    if (hi == 0) li_l[r32] = l_reg;
    asm volatile("s_waitcnt lgkmcnt(0)" ::: "memory");
    __builtin_amdgcn_wave_barrier();
    u16* Ow = a.o + (size_t)(wid * 32) * 1024;
#pragma unroll
    for (int r = 0; r < 16; ++r) { const int orow = crow(r, hi); const float rl = 1.0f / li_l[orow];
#pragma unroll
        for (int d0 = 0; d0 < 4; ++d0) Ow[(size_t)orow * 1024 + d0 * 32 + r32] = f2bf(o[d0][r] * rl); }
    __syncthreads();
#undef A_SLOAD
#undef A_SWRITE
}

__device__ __forceinline__ float wsum(float v) { for (int o = 32; o >= 1; o >>= 1) v += __shfl_xor(v, o); return v; }
__device__ __forceinline__ void norm_wave(const P& p, int layer, int k, int r, int s5, int lane) {
    const float* x = hsrc(p, r, layer == 0 && k == 0); f32x4 v[4]; float ss = 0.f;
#pragma unroll
    for (int i = 0; i < 4; ++i) { v[i] = *(const f32x4*)(x + i * 256 + lane * 4); ss += v[i][0] * v[i][0] + v[i][1] * v[i][1] + v[i][2] * v[i][2] + v[i][3] * v[i][3]; }
    ss = wsum(ss); const float rinv = rsq_f(ss * (1.0f / 1024.0f) + EPS);
    const float* g = p.in[6] + (size_t)(layer * 3 + k) * 1024; const float* sh = modp(p, layer, r, 3 * k); const float* sc = modp(p, layer, r, 3 * k + 1);
    int row5 = 0, i5 = 0;
    if (s5) { if (r < NL) { const int b = r / SEQ, t = r % SEQ; row5 = b * S5L + t / 32; i5 = t % 32; } else { const int rr = r - NL; const int b = rr / 256, l = rr % 256; row5 = NB * S5L + b * S5C + l / 32; i5 = l % 32; } }
#pragma unroll
    for (int i = 0; i < 4; ++i) { const int d = i * 256 + lane * 4; const f32x4 gv = *(const f32x4*)(g + d), sv = *(const f32x4*)(sc + d), hv = *(const f32x4*)(sh + d); f32x4 o;
        for (int j = 0; j < 4; ++j) o[j] = v[i][j] * rinv * gv[j] * (1.0f + sv[j]) + hv[j];
        if (!s5) st4bf(wsb(p, O_HN) + (size_t)r * 1024 + d, o);
        else st4bf(wsb(p, O_UEXT) + ((size_t)(d >> 4) * NROW5P + row5) * 768 + i5 * 16 + (d & 15), o); } }
__device__ __forceinline__ void mla_row_wave(const P& p, int j, int r, int lane) {
    const float* x = (const float*)(p.ws + O_CALL) + (size_t)r * 768; f32x4 c[3]; float q[3];
#pragma unroll
    for (int i = 0; i < 3; ++i) { c[i] = *(const f32x4*)(x + i * 256 + lane * 4); q[i] = c[i][0] * c[i][0] + c[i][1] * c[i][1] + c[i][2] * c[i][2] + c[i][3] * c[i][3]; }
    const bool lo = lane < 32;
    const float ssq = wsum(q[0] + (lo ? q[1] : 0.f)), sskv = wsum((lo ? 0.f : q[1]) + (lo ? q[2] : 0.f)), ssr = wsum((lane >= 32 && lane < 48) ? q[2] : 0.f);
    const float rq = rsq_f(ssq * (1.0f / 384.0f) + EPS), rkv = rsq_f(sskv * (1.0f / 256.0f) + EPS), rr_ = rsq_f(ssr * (1.0f / 64.0f) + EPS);
    const float* qn = p.in[10] + j * 384; const float* kvn = p.in[11] + j * 256; const float* kg = p.in[15] + j * 192 + 128;
    { const f32x4 gq = *(const f32x4*)(qn + lane * 4); f32x4 o; for (int jx = 0; jx < 4; ++jx) o[jx] = c[0][jx] * rq * gq[jx]; st4bf(wsb(p, O_CQN) + (size_t)r * 384 + lane * 4, o); }
    if (lo) { const f32x4 gq = *(const f32x4*)(qn + 256 + lane * 4); f32x4 o; for (int jx = 0; jx < 4; ++jx) o[jx] = c[1][jx] * rq * gq[jx]; st4bf(wsb(p, O_CQN) + (size_t)r * 384 + 256 + lane * 4, o);
        const f32x4 gk = *(const f32x4*)(kvn + 128 + lane * 4); f32x4 o2; for (int jx = 0; jx < 4; ++jx) o2[jx] = c[2][jx] * rkv * gk[jx]; st4bf(wsb(p, O_CKVN) + (size_t)r * 256 + 128 + lane * 4, o2); }
    else { const f32x4 gk = *(const f32x4*)(kvn + lane * 4 - 128); f32x4 o; for (int jx = 0; jx < 4; ++jx) o[jx] = c[1][jx] * rkv * gk[jx]; st4bf(wsb(p, O_CKVN) + (size_t)r * 256 + lane * 4 - 128, o); }
    const int dd = (4 * (lane - 32)) & 63; const f32x4 gr = *(const f32x4*)(kg + dd); f32x4 own, oth, o;
    for (int jx = 0; jx < 4; ++jx) own[jx] = c[2][jx] * rr_ * gr[jx];
    for (int jx = 0; jx < 4; ++jx) oth[jx] = __shfl_xor(own[jx], 4);
    const int t = r % SEQ, pos = (dd & 32) ? (t % 64) : (t / 64); const bool first = (dd & 16) == 0;
    for (int jx = 0; jx < 4; ++jx) { float cs = 1.f, sn = 0.f; if (r < NL) sincos_t((float)pos * ropef((dd & 15) + jx, 16), sn, cs);
        o[jx] = first ? own[jx] * cs - oth[jx] * sn : own[jx] * cs + oth[jx] * sn; }
    if (lane >= 32 && lane < 48) { u16* kf = wsb(p, O_KF) + (size_t)r * 1536 + 128 + dd;
#pragma unroll
        for (int h = 0; h < 8; ++h) st4bf(kf + h * 192, o); } }
__device__ __forceinline__ float bflo(unsigned w) { return __uint_as_float(w << 16); }
__device__ __forceinline__ float bfhi(unsigned w) { return __uint_as_float(w & 0xffff0000u); }
__device__ __forceinline__ unsigned pk2(float a, float b) { return (unsigned)f2bf(a) | ((unsigned)f2bf(b) << 16); }
__device__ __forceinline__ void mla_head_wave(const P& p, int j, int r, int lane) {
    const int h = lane >> 3, sub = lane & 7;
    u16* q = wsb(p, O_CALL) + (size_t)r * 1536 + h * 192; u16* k = wsb(p, O_KF) + (size_t)r * 1536 + h * 192;
    const float* qg = p.in[14] + j * 192; const float* kg = p.in[15] + j * 192;
    u32x4 qa = *(const u32x4*)(q + sub * 16), qb = *(const u32x4*)(q + sub * 16 + 8), qr = *(const u32x4*)(q + 128 + sub * 8), ka = *(const u32x4*)(k + sub * 16), kb = *(const u32x4*)(k + sub * 16 + 8);
    float sq = 0.f, sk = 0.f, sr = 0.f;
#pragma unroll
    for (int i = 0; i < 4; ++i) { sq += bflo(qa[i]) * bflo(qa[i]) + bfhi(qa[i]) * bfhi(qa[i]) + bflo(qb[i]) * bflo(qb[i]) + bfhi(qb[i]) * bfhi(qb[i]);
        sk += bflo(ka[i]) * bflo(ka[i]) + bfhi(ka[i]) * bfhi(ka[i]) + bflo(kb[i]) * bflo(kb[i]) + bfhi(kb[i]) * bfhi(kb[i]); sr += bflo(qr[i]) * bflo(qr[i]) + bfhi(qr[i]) * bfhi(qr[i]); }
    for (int o = 4; o >= 1; o >>= 1) { sq += __shfl_xor(sq, o); sk += __shfl_xor(sk, o); sr += __shfl_xor(sr, o); }
    const float rq = rsq_f(sq * (1.0f / 128.0f) + EPS), rk = rsq_f(sk * (1.0f / 128.0f) + EPS), rr_ = rsq_f(sr * (1.0f / 64.0f) + EPS);
    u32x4 oa, ob, oka, okb;
#pragma unroll
    for (int i = 0; i < 4; ++i) { const int d = sub * 16 + 2 * i;
        oa[i] = pk2(bflo(qa[i]) * rq * qg[d], bfhi(qa[i]) * rq * qg[d + 1]); ob[i] = pk2(bflo(qb[i]) * rq * qg[d + 8], bfhi(qb[i]) * rq * qg[d + 9]);
        oka[i] = pk2(bflo(ka[i]) * rk * kg[d], bfhi(ka[i]) * rk * kg[d + 1]); okb[i] = pk2(bflo(kb[i]) * rk * kg[d + 8], bfhi(kb[i]) * rk * kg[d + 9]); }
    *(u32x4*)(q + sub * 16) = oa; *(u32x4*)(q + sub * 16 + 8) = ob; *(u32x4*)(k + sub * 16) = oka; *(u32x4*)(k + sub * 16 + 8) = okb;
    const int dd = sub * 8; float own[8], oth[8];
#pragma unroll
    for (int i = 0; i < 4; ++i) { own[2 * i] = bflo(qr[i]) * rr_ * qg[128 + dd + 2 * i]; own[2 * i + 1] = bfhi(qr[i]) * rr_ * qg[128 + dd + 2 * i + 1]; }
#pragma unroll
    for (int i = 0; i < 8; ++i) oth[i] = __shfl_xor(own[i], 2);
    const int t = r % SEQ, pos = (dd & 32) ? (t % 64) : (t / 64); const bool first = (dd & 16) == 0; u32x4 orr; float res[8];
#pragma unroll
    for (int i = 0; i < 8; ++i) { float cs = 1.f, sn = 0.f; if (r < NL) sincos_t((float)pos * ropef((dd & 15) + i, 16), sn, cs); res[i] = first ? own[i] * cs - oth[i] * sn : own[i] * cs + oth[i] * sn; }
#pragma unroll
    for (int i = 0; i < 4; ++i) orr[i] = pk2(res[2 * i], res[2 * i + 1]);
    *(u32x4*)(q + 128 + dd) = orr; }
__device__ __forceinline__ void ret_norm_wave(const P& p, int q, int lr, int lane) {
    const int h = lane >> 4, sub = lane & 15; u16* o = wsb(p, O_OB) + (size_t)lr * 2048 + h * 512 + sub * 32; u16* yd = ret_ydst(p, q, lr) + h * 512 + sub * 32; const u16* g = wsb(p, O_GATE) + (size_t)lr * 2048 + h * 512 + sub * 32; const float* gg = p.in[19] + h * 512 + sub * 32;
    u32x4 ov[4]; float s = 0.f;
#pragma unroll
    for (int i = 0; i < 4; ++i) { ov[i] = *(const u32x4*)(o + i * 8); for (int jx = 0; jx < 4; ++jx) s += bflo(ov[i][jx]) + bfhi(ov[i][jx]); }
    for (int m = 8; m >= 1; m >>= 1) s += __shfl_xor(s, m);
    const float mu = s * (1.0f / 512.0f); float qv = 0.f;
#pragma unroll
    for (int i = 0; i < 4; ++i) for (int jx = 0; jx < 4; ++jx) { const float a = bflo(ov[i][jx]) - mu, b = bfhi(ov[i][jx]) - mu; qv += a * a + b * b; }
    for (int m = 8; m >= 1; m >>= 1) qv += __shfl_xor(qv, m);
    const float rstd = rsq_f(qv * (1.0f / 512.0f) + EPS);
#pragma unroll
    for (int i = 0; i < 4; ++i) { const u32x4 gv = *(const u32x4*)(g + i * 8); u32x4 w;
        for (int jx = 0; jx < 4; ++jx) { const int e = i * 8 + 2 * jx;
            w[jx] = pk2((bflo(ov[i][jx]) - mu) * rstd * gg[e] * silu_f(bflo(gv[jx])), (bfhi(ov[i][jx]) - mu) * rstd * gg[e + 1] * silu_f(bfhi(gv[jx]))); }
        *(u32x4*)(yd + i * 8) = w; } }
__device__ __forceinline__ void mod_phase(const P& p, float* tab) {
    for (int i = threadIdx.x; i < NMR * 1024; i += 512) { const int b = i >> 10, k = i & 1023; tab[i] = silu_f(b < NB ? p.in[1][b * 1024 + k] : p.in[3][k]); }
    __syncthreads();
    for (int idx = blockIdx.x * 512 + threadIdx.x; idx < DEPTH * 9216; idx += gridDim.x * 512) {
        const int layer = idx / 9216, col = idx % 9216; const float* w = p.in[4] + (size_t)layer * 1024 * 9216 + col; float acc[NMR];
#pragma unroll
        for (int b = 0; b < NMR; ++b) acc[b] = 0.f;
        for (int k = 0; k < 1024; ++k) { const float wv = w[(size_t)k * 9216];
#pragma unroll
            for (int b = 0; b < NMR; ++b) acc[b] += tab[b * 1024 + k] * wv; }
        const float bias = p.in[5][layer * 9216 + col];
#pragma unroll
        for (int b = 0; b < NMR; ++b) ((float*)(p.ws + O_MOD))[(size_t)(layer * NMR + b) * 9216 + col] = acc[b] + bias; }
    __syncthreads(); }
#define WPASS(N, HOSTCALL, DEVCALL) do { const int _n = (int)(N); int t0_ = threadIdx.x; asm volatile("" : "+v"(t0_)); const int lane = t0_ & 63; for (int it = blockIdx.x * 8 + (t0_ >> 6); it < _n; it += gridDim.x * 8) { DEVCALL; } } while (0)
#define MODPHASE() mod_phase(p, (float*)shm)

#define XB_TMO      128
#define XB_XCNT(j)  (256  + 64 * (j))
#define XB_XSUB(j)  (1280 + 64 * (j))
#define XB_XGEN(j)  (2304 + 64 * (j))
#define XB_TOP      3328
#define XB_TOPGEN   3392
#define XCD_BAR_WORDS 3456
#define XB_SPIN_CAP (1u << 18)
__device__ __forceinline__ unsigned xb_ld(unsigned* p)              { return __hip_atomic_load(p, __ATOMIC_RELAXED, __HIP_MEMORY_SCOPE_AGENT); }
__device__ __forceinline__ unsigned xb_add(unsigned* p, unsigned v) { return __hip_atomic_fetch_add(p, v, __ATOMIC_RELAXED, __HIP_MEMORY_SCOPE_AGENT); }
__device__ __forceinline__ unsigned xb_xcc_id() { return (unsigned)__builtin_amdgcn_s_getreg((3 << 11) | 20) & 0xFu; }
#define XB_SPIN(cond, bar) do { unsigned _sp = 0; while (cond) { __builtin_amdgcn_s_sleep(1); \
    if ((++_sp & 255u) == 0u) { if (xb_ld(&(bar)[XB_TMO])) break; if (_sp > XB_SPIN_CAP) { atomicAdd(&(bar)[XB_TMO], 1u); break; } } } } while (0)
struct XcdBarrier { unsigned* bar; unsigned x; volatile LAS unsigned* st; };
__device__ __forceinline__ XcdBarrier xcd_barrier_post(unsigned* bar, volatile LAS unsigned* st) {
    XcdBarrier b; b.bar = bar; b.x = xb_xcc_id(); b.st = st;
    if (threadIdx.x == 0) (void)xb_add(&bar[XB_XCNT(b.x)], 1u);
    return b; }
__device__ __forceinline__ void xcd_barrier_complete(unsigned* bar, unsigned x, unsigned& nloc, unsigned& nx) {
    const unsigned G = gridDim.x * gridDim.y * gridDim.z; unsigned sum, cnt, mine, sp = 0u;
    for (;;) { sum = 0u; cnt = 0u; mine = 0u;
#pragma unroll
        for (unsigned j = 0; j < 16; ++j) { const unsigned c = xb_ld(&bar[XB_XCNT(j)]); sum += c; cnt += (c > 0u) ? 1u : 0u; mine = (j == x) ? c : mine; }
        if (sum == G) break;
        __builtin_amdgcn_s_sleep(1);
        if ((++sp & 255u) == 0u) { if (xb_ld(&bar[XB_TMO])) break; if (sp > XB_SPIN_CAP) { atomicAdd(&bar[XB_TMO], 1u); break; } } }
    nloc = mine > 0u ? mine : 1u; nx = cnt > 0u ? cnt : 1u; }
__device__ __forceinline__ void xcd_barrier(const XcdBarrier& b) {
    asm volatile("s_waitcnt vmcnt(0)" ::: "memory");
    __syncthreads();
    if (threadIdx.x == 0) {
        unsigned* bar = b.bar;
        __builtin_amdgcn_s_waitcnt(0);
        unsigned nloc = b.st[0], nx = b.st[1];
        if (nloc == 0u) { xcd_barrier_complete(bar, b.x, nloc, nx); b.st[0] = nloc; b.st[1] = nx; }
        const unsigned old = xb_add(&bar[XB_XSUB(b.x)], 1u);
        const unsigned gen = old / nloc;
        if (old + 1u == (gen + 1u) * nloc) {
            __builtin_amdgcn_fence(__ATOMIC_RELEASE, "agent");
            asm volatile("s_waitcnt vmcnt(0)" ::: "memory");
            const unsigned og = xb_add(&bar[XB_TOP], 1u);
            const unsigned tg = og / nx;
            if (og + 1u == (tg + 1u) * nx) xb_add(&bar[XB_TOPGEN], 1u);
            else XB_SPIN(xb_ld(&bar[XB_TOPGEN]) == tg, bar);
            __builtin_amdgcn_fence(__ATOMIC_ACQUIRE, "agent");
            xb_add(&bar[XB_XGEN(b.x)], 1u);
            asm volatile("s_waitcnt vmcnt(0)" ::: "memory");
        } else {
            XB_SPIN(xb_ld(&bar[XB_XGEN(b.x)]) == gen, bar);
            __builtin_amdgcn_fence(__ATOMIC_ACQUIRE, "agent");
            asm volatile("s_waitcnt vmcnt(0)" ::: "memory");
        }
    }
    __syncthreads();
}

namespace cg = cooperative_groups;
#define PASS(N, CALL) do { const long _n = (long)(N); int t0_ = threadIdx.x; asm volatile("" : "+v"(t0_)); for (long it = (long)blockIdx.x * 512 + t0_; it < _n; it += (long)gridDim.x * 512) { CALL; } } while (0)
#define GEMM(D) gemm_run(lds, D)
#define SYNC() xcd_barrier(xb)
#define GRIDSYNC() grid.sync()
#define HOOK(L, S) do { } while (0)
#define ATTN(NITEMS) do { for (int it = blockIdx.x; it < (NITEMS); it += gridDim.x) { AttItem ai_; att_item(p, it, ai_); att_body(ai_, (char*)shm); } } while (0)
#else
template <class Dsc> static void gemm_emu(const Dsc& D) {
    std::vector<int> Ls; for (int c = 0; c < 256; ++c) for (int i = 0;; ++i) { Unit u{}; if (!D.unit(i * 256 + c, u)) break; Ls.push_back(i * 256 + c); }
    const int n = (int)Ls.size();
#pragma omp parallel for schedule(dynamic)
    for (int li = 0; li < n; ++li) { const int L = Ls[li]; Unit u{}; D.unit(L, u); const int K = Dsc::K;
        std::vector<float> A((size_t)256 * K), B((size_t)256 * K), C((size_t)256 * 256);
        for (int r = 0; r < 256; ++r) for (int k = 0; k < K; ++k) { A[(size_t)r * K + k] = bf2f(u.A[(size_t)r * Dsc::lda + k]); B[(size_t)r * K + k] = bf2f(u.B[(size_t)r * Dsc::ldb + k]); }
        for (int r = 0; r < 256; ++r) for (int c = 0; c < 256; ++c) { float s = 0.f; const float* a = &A[(size_t)r * K]; const float* b = &B[(size_t)c * K]; for (int k = 0; k < K; ++k) s += a[k] * b[k]; C[r * 256 + c] = s; }
        for (int r = 0; r < 128; ++r) for (int c = 0; c < 128; c += 4) { f32x4 v[2][2];
            for (int X = 0; X < 2; ++X) for (int Y = 0; Y < 2; ++Y) for (int j = 0; j < 4; ++j) v[X][Y][j] = C[(r + 128 * X) * 256 + c + 128 * Y + j];
            D.emit(u, r, c, v[0][0], v[0][1], v[1][0], v[1][1]); } } }
static void att_emu(const P& p, int nitems) {
#pragma omp parallel for schedule(dynamic)
    for (int it = 0; it < nitems; ++it) { AttItem a; att_item(p, it, a); std::vector<float> s(a.ntot);
        for (int i = 0; i < 256; ++i) { const u16* q = a.q + (size_t)i * 1536; float l = 0.f; float o[128]; for (int e = 0; e < 128; ++e) o[e] = 0.f;
            for (int k = 0; k < a.ntot; ++k) { const u16* kr = k < a.n0 ? a.k0 + (size_t)k * 1536 : a.k1 + (size_t)(k - a.n0) * 1536; float d = 0.f; for (int x = 0; x < 192; ++x) d += bf2f(q[x]) * bf2f(kr[x]);
                const float pv = bf2f(f2bf(expf(d * ATT_SCALE))); l += expf(d * ATT_SCALE); const u16* vr = k < a.n0 ? a.v0 + (size_t)k * 1024 : a.v1 + (size_t)(k - a.n0) * 1024; for (int e = 0; e < 128; ++e) o[e] += pv * bf2f(vr[e]); }
            for (int e = 0; e < 128; ++e) a.o[(size_t)i * 1024 + e] = f2bf(o[e] / l); } } }
#define PASS(N, CALL) do { const long _n = (long)(N); _Pragma("omp parallel for schedule(static)") for (long it = 0; it < _n; ++it) { CALL; } } while (0)
#define WPASS(N, HOSTCALL, DEVCALL) PASS(N, HOSTCALL)
#define MODPHASE() PASS(DEPTH * 9216, mod_item(p, (int)it))
#define GEMM(D) gemm_emu(D)
#define SYNC() do { } while (0)
#define GRIDSYNC() do { } while (0)
#define ATTN(NITEMS) att_emu(p, NITEMS)
static void emu_hook(const P& p, int layer, int stage);
#define HOOK(L, S) emu_hook(p, L, S)
#endif

#ifndef HOST_EMU
__global__ void __launch_bounds__(512) fwd_megakernel(P p) {
    extern __shared__ __attribute__((aligned(16))) unsigned char shm[];
    LAS unsigned char* lds = (LAS unsigned char*)shm;
    cg::grid_group grid = cg::this_grid();
    volatile LAS unsigned* xst = (volatile LAS unsigned*)(lds + STAGE_BYTES + 1024);
    if (threadIdx.x == 0) { xst[0] = 0u; xst[1] = 0u; xst[2] = 0u; xst[3] = 0u; }
    __syncthreads();
    const XcdBarrier xb = xcd_barrier_post((unsigned*)(p.ws + O_BAR), xst);
#else
static void fwd_emu(P p) {
#endif
    if (PM(0)) { MODPHASE();
    PASS((long)NC * 256, ((f32x4*)(p.ws + O_G))[it] = ((const f32x4*)p.in[2])[it]);
    PASS(CV_TOTAL, cvt_item(p, it));
    PASS(64 * 2 * 32 * 16, s5_ktab_item(p, (int)it));
    PASS(64 * 256 * 512, s5_fext_item(p, (int)it)); }
    GRIDSYNC();
    if (PM(0)) { PASS((long)64 * 512 * 768, s5_text_item(p, it)); }
    for (int rep_ = 0; rep_ < REP_SYNC; ++rep_) SYNC();
    for (int layer = 0; layer < DEPTH; ++layer) {
        const int kind = layer % 3, j = layer / 3; const bool last = layer == DEPTH - 1;
        for (int rn_ = 0; rn_ < REP_NORM; ++rn_) { if (PM(1)) { WPASS(MT, norm_item(p, layer, 0, (int)it, 0), norm_wave(p, layer, 0, it, 0, lane)); } SYNC(); }
        for (int rep_ = 0; rep_ < REP_UP; ++rep_) { if (PM(2)) { DFfnUp d{p, layer, 0, MT / 256}; GEMM(d); } SYNC(); }
        for (int rep_ = 0; rep_ < REP_DOWN; ++rep_) { if (PM(3)) { DFfnDown d{p, layer, 0, MT / 256, rep_ ? 0.f : 0.5f}; GEMM(d); } SYNC(); }
        if (kind == 0) {
            for (int rn_ = 0; rn_ < REP_NORM; ++rn_) { if (PM(1)) { WPASS(MT, norm_item(p, layer, 1, (int)it, 0), norm_wave(p, layer, 1, it, 0, lane)); } SYNC(); }
            for (int rep_ = 0; rep_ < REP_MLA; ++rep_) { if (PM(4)) { DMlaIn d{p, j}; GEMM(d); } SYNC(); }
            if (PM(5)) { WPASS(MT, mla_row_item(p, j, (int)it), mla_row_wave(p, j, it, lane)); } SYNC();
            for (int rep_ = 0; rep_ < REP_MLA; ++rep_) { if (PM(6)) { DMlaUq d{p, j}; GEMM(d); } if (PM(7)) { DMlaUkv d{p, j}; GEMM(d); } SYNC(); }
            if (PM(8)) { WPASS(MT, { for (int h_ = 0; h_ < 8; ++h_) mla_head_item(p, j, (int)it * 8 + h_); }, mla_head_wave(p, j, it, lane)); } SYNC();
            for (int rep_ = 0; rep_ < REP_ATT; ++rep_) { if (PM(9)) { ATTN(NB * 8 * (SEQ / 256) + (last ? 0 : NB * 8)); } SYNC(); }
            if (PM(10)) { DMlaO d{p, layer, j, last ? NL / 256 : MT / 256}; GEMM(d); } SYNC();
        } else if (kind == 1) {
            for (int rn_ = 0; rn_ < REP_NORM; ++rn_) { if (PM(1)) { WPASS(MT, norm_item(p, layer, 1, (int)it, 0), norm_wave(p, layer, 1, it, 0, lane)); } SYNC(); }
            for (int q = 0; q < NB / RGB; ++q) {
                for (int rep_ = 0; rep_ < REP_RET; ++rep_) { if (PM(11)) { DRetProjAll d{p, q}; GEMM(d); } SYNC(); }
                for (int rep_ = 0; rep_ < REP_RET; ++rep_) { if (PM(13)) { DRetP d{p}; GEMM(d); } if (PM(14)) { DRetL d{p}; GEMM(d); } SYNC(); }
                if (PM(15)) { PASS(4 * RGB * 512 * 64, ret_prefix_item(p, (int)it)); } SYNC();
                for (int rep_ = 0; rep_ < REP_RET; ++rep_) { if (PM(16)) { DRetO d{p}; GEMM(d); } SYNC(); }
                if (PM(17)) { WPASS(NCQ * 256, { for (int h_ = 0; h_ < 4; ++h_) ret_norm_item(p, q, (int)it * 4 + h_); }, ret_norm_wave(p, q, it, lane)); } SYNC();
                if (PM(18)) { DRetWo d{p, layer, q}; GEMM(d); if (q == NB / RGB - 1) { DRetWoCtx c{p, layer}; GEMM(c); } } SYNC();
            }
        } else {
            if (PM(19)) { WPASS(MT, norm_item(p, layer, 1, (int)it, 1), norm_wave(p, layer, 1, it, 1, lane)); } SYNC();
            for (int rep_ = 0; rep_ < REP_S5; ++rep_) { if (PM(20)) { DS5L d{p}; GEMM(d); } SYNC(); }
            if (PM(21)) { PASS(64 * NB * 64, s5_prefix_item(p, (int)it)); } SYNC();
            for (int rep_ = 0; rep_ < REP_S5; ++rep_) { if (PM(22)) { DS5Y d{p}; GEMM(d); } SYNC(); }
            if (PM(23)) { DS5Glu d{p, layer}; GEMM(d); } SYNC();
        }
        HOOK(layer, 0);
        for (int rn_ = 0; rn_ < REP_NORM; ++rn_) { if (PM(1)) { WPASS(last ? NL : MT, norm_item(p, layer, 2, (int)it, 0), norm_wave(p, layer, 2, it, 0, lane)); } SYNC(); }
        for (int rep_ = 0; rep_ < REP_UP; ++rep_) { if (PM(2)) { DFfnUp d{p, layer, 1, last ? NL / 256 : MT / 256}; GEMM(d); } SYNC(); }
        for (int rep_ = 0; rep_ < REP_DOWN; ++rep_) { if (PM(3)) { DFfnDown d{p, layer, 1, last ? NL / 256 : MT / 256, rep_ ? 0.f : 0.5f}; GEMM(d); } SYNC(); }
        HOOK(layer, 1);
    }
}

#ifndef HOST_EMU
extern "C" void kernel_launch(void* const* d_in, const int* in_sizes, int n_in, void* d_out, int out_size, void* d_ws, size_t ws_size, hipStream_t stream) {
    constexpr size_t kDynLds = STAGE_BYTES + 4096;
    static int grid_blocks = 0;
    if (!grid_blocks) {
        int dev = 0, cus = 0, per_cu = 0;
        hipGetDevice(&dev);
        hipDeviceGetAttribute(&cus, hipDeviceAttributeMultiprocessorCount, dev);
        hipFuncSetAttribute((const void*)fwd_megakernel, hipFuncAttributeMaxDynamicSharedMemorySize, (int)kDynLds);
        hipOccupancyMaxActiveBlocksPerMultiprocessor(&per_cu, fwd_megakernel, 512, kDynLds);
        if (per_cu < 1) per_cu = 1;
        if (per_cu > 1) per_cu = 1;
        grid_blocks = cus * per_cu;
        if (ws_size < WS_NEED) fprintf(stderr, "workspace too small: %zu < %zu\n", ws_size, (size_t)WS_NEED);
    }
    P p{};
    for (int i = 0; i < 31 && i < n_in; ++i) p.in[i] = (const float*)d_in[i];
    p.out = (float*)d_out; p.ws = (char*)d_ws;
    hipMemsetAsync((char*)d_ws + O_BAR, 0, XCD_BAR_WORDS * 4, stream);
    void* args[] = {&p};
    hipError_t e = hipLaunchCooperativeKernel((void*)fwd_megakernel, dim3(grid_blocks), dim3(512), args, kDynLds, stream);
    if (e != hipSuccess) fprintf(stderr, "cooperative launch failed: %s (grid %d)\n", hipGetErrorString(e), grid_blocks);
}
#endif
```

```cpp
#ifdef HOST_EMU
#include <cmath>
#include <cstdio>
#include <cstdlib>
#include <cstring>
#include <vector>
#define HD inline
#else
#include <hip/hip_runtime.h>
#include <hip/hip_cooperative_groups.h>
#include <cstdio>
#define HD __device__ __forceinline__
#endif

#ifndef CFG_BATCH
#define CFG_BATCH 16
#endif
#ifndef CFG_SEQ
#define CFG_SEQ 4096
#endif

typedef unsigned short u16;
typedef float f32x4 __attribute__((ext_vector_type(4)));
typedef unsigned u32x2 __attribute__((ext_vector_type(2)));

constexpr int DM = 1024, NB = CFG_BATCH, SEQ = CFG_SEQ, CTX = 256, DFF = 2816, DEPTH = 4;
constexpr int NL = NB * SEQ, NC = NB * CTX, MT = NL + NC;
constexpr int NMR = NB + 1;
constexpr int RGB = (NB >= 4) ? 4 : 1;
constexpr int NCH = 1 + SEQ / 256;
constexpr int NCQ = RGB * NCH;
constexpr int S5L = SEQ / 32, S5C = CTX / 32;
constexpr int NROW5 = NB * S5L + NB * S5C;
constexpr int NROW5P = (NROW5 + 255) / 256 * 256;
constexpr float EPS = 1e-6f;

constexpr size_t al(size_t x) { return (x + 255) & ~(size_t)255; }
constexpr size_t O_BAR = 0;
constexpr size_t O_MOD = 16384;
constexpr size_t O_G = O_MOD + al((size_t)DEPTH * NMR * 9216 * 4);
constexpr size_t O_FFI = O_G + al((size_t)NC * 1024 * 4);
constexpr size_t SZ_FFI1 = (size_t)5632 * 1024 * 2, SZ_FFO1 = (size_t)1024 * 2816 * 2;
constexpr size_t O_FFO = O_FFI + 8 * SZ_FFI1;
constexpr size_t O_MWIN = O_FFO + 8 * SZ_FFO1;
constexpr size_t SZ_MWIN = (size_t)768 * 1024 * 2, SZ_MWUQ = (size_t)1536 * 384 * 2, SZ_MWUKV = (size_t)2048 * 256 * 2, SZ_MWO = (size_t)1024 * 1024 * 2;
constexpr size_t O_MWUQ = O_MWIN + 2 * SZ_MWIN;
constexpr size_t O_MWUKV = O_MWUQ + 2 * SZ_MWUQ;
constexpr size_t O_MWO = O_MWUKV + 2 * SZ_MWUKV;
constexpr size_t O_RWIN = O_MWO + 2 * SZ_MWO;
constexpr size_t O_RWO = O_RWIN + (size_t)6144 * 1024 * 2;
constexpr size_t O_GLU = O_RWO + (size_t)1024 * 2048 * 2;
constexpr size_t O_HN = O_GLU + (size_t)2048 * 1024 * 2;
constexpr size_t O_KTAB = O_HN + al((size_t)MT * 1024 * 2);
constexpr size_t O_TEXT = O_KTAB + al((size_t)64 * 2 * 32 * 256 * 4);
constexpr size_t O_FEXT = O_TEXT + al((size_t)64 * 512 * 768 * 2);
constexpr size_t O_SCR = O_FEXT + al((size_t)64 * 256 * 512 * 2);
constexpr size_t O_ACT = O_SCR;
constexpr size_t O_CALL = O_SCR;
constexpr size_t O_CQN = O_CALL + al((size_t)MT * 768 * 4);
constexpr size_t O_CKVN = O_CQN + al((size_t)MT * 384 * 2);
constexpr size_t O_KF = O_CKVN + al((size_t)MT * 256 * 2);
constexpr size_t O_VB = O_KF + al((size_t)MT * 1536 * 2);
constexpr size_t END_MLA = O_VB + al((size_t)MT * 1024 * 2);
constexpr size_t O_QN = O_SCR;
constexpr size_t O_KN = O_QN + al((size_t)NCQ * 256 * 1024 * 2);
constexpr size_t O_GATE = O_KN + al((size_t)NCQ * 256 * 1024 * 2);
constexpr size_t O_OB = O_GATE + al((size_t)NCQ * 256 * 2048 * 2);
constexpr size_t O_AEXT = O_OB + al((size_t)NCQ * 256 * 2048 * 2);
constexpr size_t O_KTX = O_AEXT + al((size_t)4 * NCQ * 256 * 768 * 2);
constexpr size_t O_BEXT = O_KTX + al((size_t)4 * NCQ * 2 * 256 * 256 * 2);
constexpr size_t O_YCTX = O_BEXT + al((size_t)4 * NCQ * 512 * 768 * 2);
constexpr size_t END_RET = O_YCTX + al((size_t)NC * 2048 * 2);
constexpr size_t O_UEXT = O_SCR;
constexpr size_t END_S5 = O_UEXT + al((size_t)64 * NROW5P * 768 * 2);
constexpr size_t END_FFN = O_ACT + al((size_t)MT * 2816 * 2);
constexpr size_t cmax(size_t a, size_t b) { return a > b ? a : b; }
constexpr size_t WS_NEED = cmax(cmax(END_MLA, END_RET), cmax(END_S5, END_FFN));

struct P { const float* in[32]; float* out; char* ws; };
#ifndef PHASE_MASK
#define PHASE_MASK 0xFFFFFFFFu
#endif
#define PM(b) ((PHASE_MASK >> (b)) & 1u)
#ifndef REP_UP
#define REP_UP 1
#endif
#ifndef REP_ATT
#define REP_ATT 1
#endif
#ifndef REP_NORM
#define REP_NORM 1
#endif
#ifndef REP_RET
#define REP_RET 1
#endif
#ifndef REP_DOWN
#define REP_DOWN 1
#endif
#ifndef REP_MLA
#define REP_MLA 1
#endif
#ifndef REP_S5
#define REP_S5 1
#endif
#ifndef REP_SYNC
#define REP_SYNC 0
#endif

HD float bf2f(u16 b) { union { unsigned u; float f; } x; x.u = ((unsigned)b) << 16; return x.f; }
HD u16 f2bf(float f) { union { unsigned u; float f; } x; x.f = f; unsigned u = x.u; u += 0x7fffu + ((u >> 16) & 1u); return (u16)(u >> 16); }
#ifdef HOST_EMU
HD void st4bf(u16* p, f32x4 v) { u32x2 w; w.x = (unsigned)f2bf(v[0]) | ((unsigned)f2bf(v[1]) << 16); w.y = (unsigned)f2bf(v[2]) | ((unsigned)f2bf(v[3]) << 16); *(u32x2*)p = w; }
#else
HD unsigned cvtpk_bf(float lo, float hi) { unsigned r; asm("v_cvt_pk_bf16_f32 %0, %1, %2" : "=v"(r) : "v"(lo), "v"(hi)); return r; }
HD void st4bf(u16* p, f32x4 v) { u32x2 w; w.x = cvtpk_bf(v[0], v[1]); w.y = cvtpk_bf(v[2], v[3]); *(u32x2*)p = w; }
#endif
#ifdef HOST_EMU
HD float silu_f(float a) { return a / (1.0f + expf(-a)); }
HD float sigm_f(float a) { return 1.0f / (1.0f + expf(-a)); }
HD float gelu_f(float x) { return 0.5f * x * (1.0f + tanhf(0.7978845608028654f * (x + 0.044715f * x * x * x))); }
#else
HD float sigm_f(float a) { return __builtin_amdgcn_rcpf(1.0f + __builtin_amdgcn_exp2f(-1.4426950408889634f * a)); }
HD float silu_f(float a) { return a * sigm_f(a); }
HD float gelu_f(float x) { return x * sigm_f(1.5957691216057308f * (x + 0.044715f * x * x * x)); }
#endif
HD float rsq_f(float x) { return 1.0f / sqrtf(x); }
HD float ex2(float x) {
#ifdef HOST_EMU
    return exp2f(x);
#else
    return __builtin_amdgcn_exp2f(x);
#endif
}
HD const float* hsrc(const P& p, int r, int first) { if (first && r < NL) return p.in[0] + (size_t)r * 1024; return r < NL ? p.out + (size_t)r * 1024 : (const float*)(p.ws + O_G) + (size_t)(r - NL) * 1024; }
HD float* hrow(const P& p, int r) { return r < NL ? p.out + (size_t)r * 1024 : (float*)(p.ws + O_G) + (size_t)(r - NL) * 1024; }
HD const float* modp(const P& p, int layer, int r, int idx) { const int mr = r < NL ? r / SEQ : NB; return (const float*)(p.ws + O_MOD) + ((size_t)(layer * NMR + mr) * 9 + idx) * 1024; }
HD u16* wsb(const P& p, size_t off) { return (u16*)(p.ws + off); }
#ifdef HOST_EMU
HD float ropef(int d, int half) { return expf(-(float)d * (9.210340371976184f / (float)half)) * 0.15915494309189535f; }
#else
HD float ropef(int d, int half) { return __builtin_amdgcn_exp2f(-(float)d * (13.287712379549449f / (float)half)) * 0.15915494309189535f; }
#endif
HD void sincos_t(float turns, float& sn, float& cs) {
    const float f = turns - floorf(turns);
#ifdef HOST_EMU
    sn = sinf(6.283185307179586f * f); cs = cosf(6.283185307179586f * f);
#else
    sn = __builtin_amdgcn_sinf(f); cs = __builtin_amdgcn_cosf(f);
#endif
}

HD bool rect_unit(int L, int nM, int nN, int& pm, int& pn) {
    const int nwg = nM * nN; if (L >= nwg) return false;
    int wgid = L; { const int q = nwg / 8, r = nwg % 8, xcd = wgid % 8, off = wgid / 8; wgid = (xcd < r ? xcd * (q + 1) : r * (q + 1) + (xcd - r) * q) + off; }
    const int nig = 8 * nN, gid = wgid / nig, fm = gid * 8, gsz = (nM - fm) < 8 ? (nM - fm) : 8;
    pm = fm + ((wgid % nig) % gsz); pn = (wgid % nig) / gsz; return true;
}

struct Unit { const u16* A; const u16* B; int a, b, c, d; float f0, f1; };

struct DFfnUp { P p; int layer, f, nM; static constexpr int FENCE = 1; static constexpr int K = 1024, lda = 1024, ldb = 1024;
    HD bool unit(int L, Unit& u) const { int pm, pn; if (!rect_unit(L, nM, 22, pm, pn)) return false;
        u.A = wsb(p, O_HN) + (size_t)pm * 256 * 1024; u.B = wsb(p, O_FFI + (size_t)(layer * 2 + f) * SZ_FFI1) + (size_t)pn * 256 * 1024; u.a = pm; u.b = pn; u.c = 0; u.d = 0; return true; }
    HD void emit(const Unit& u, int r, int c, f32x4 v00, f32x4 v01, f32x4 v10, f32x4 v11) const {
        u16* act = wsb(p, O_ACT); const size_t R = (size_t)u.a * 256 + r; const int col = u.b * 128 + c; f32x4 o0, o1;
        for (int j = 0; j < 4; ++j) { o0[j] = silu_f(v00[j]) * v01[j]; o1[j] = silu_f(v10[j]) * v11[j]; }
        st4bf(act + R * 2816 + col, o0); st4bf(act + (R + 128) * 2816 + col, o1); } };

HD void resid4(const P& p, int layer, int midx, float sc, int R, int col, f32x4 v, int first = 0) {
    float* h = hrow(p, R) + col; const float* m = modp(p, layer, R, midx) + col; f32x4 x = *(const f32x4*)(hsrc(p, R, first) + col);
    for (int j = 0; j < 4; ++j) x[j] += sc * m[j] * v[j];
    *(f32x4*)h = x; }

struct DFfnDown { P p; int layer, f, nM; float sc; static constexpr int FENCE = 4; static constexpr int K = 2816, lda = 2816, ldb = 2816;
    HD bool unit(int L, Unit& u) const { int pm, pn;
        if (nM < 0) { if (L >= (NC / 256) * 4) return false; pm = NL / 256 + (L >> 2); pn = L & 3; }
        else if (((NL / 256) * 4) % 256 == 0 && nM > NL / 256) {
            if (L < (NL / 256) * 4) rect_unit(L, NL / 256, 4, pm, pn);
            else { const int c = L - (NL / 256) * 4; if (c >= 128 || (c & 1)) return false; const int k = c >> 1; pm = NL / 256 + (k >> 2); pn = k & 3; if (pm >= nM) return false; } }
        else if (!rect_unit(L, nM, 4, pm, pn)) return false;
        u.A = wsb(p, O_ACT) + (size_t)pm * 256 * 2816; u.B = wsb(p, O_FFO + (size_t)(layer * 2 + f) * SZ_FFO1) + (size_t)pn * 256 * 2816; u.a = pm; u.b = pn; u.c = 0; u.d = 0; return true; }
    HD void emit(const Unit& u, int r, int c, f32x4 v00, f32x4 v01, f32x4 v10, f32x4 v11) const {
        const int R = u.a * 256 + r, col = u.b * 256 + c, mi = f ? 8 : 2;
        const int first = (layer == 0 && f == 0 && sc != 0.f);
        resid4(p, layer, mi, sc, R, col, v00, first); resid4(p, layer, mi, sc, R, col + 128, v01, first); resid4(p, layer, mi, sc, R + 128, col, v10, first); resid4(p, layer, mi, sc, R + 128, col + 128, v11, first); } };
HD void atom4(float* g, const float* m, float sc, f32x4 v) {
#ifdef HOST_EMU
    for (int j = 0; j < 4; ++j) {
#pragma omp atomic
        g[j] += sc * m[j] * v[j]; }
#else
    for (int j = 0; j < 4; ++j) unsafeAtomicAdd(g + j, sc * m[j] * v[j]);
#endif
}
template <int KS, int SL0> struct DFfnDownCtx { P p; int layer, f; float sc; static constexpr int FENCE = 4; static constexpr int K = KS, lda = 2816, ldb = 2816;
    HD bool unit(int L, Unit& u) const { if (L >= 256) return false; const int x = SL0 ? (L + 128) % 256 : L; if (x >= 128 || x >= (NC / 256) * 8) return false;
        const int sl = x & 1, pn = (x >> 1) & 3, pm = NL / 256 + (x >> 3); const int k0 = SL0 ? 1536 + sl * 640 : sl * 768;
        u.A = wsb(p, O_ACT) + (size_t)pm * 256 * 2816 + k0; u.B = wsb(p, O_FFO + (size_t)(layer * 2 + f) * SZ_FFO1) + (size_t)pn * 256 * 2816 + k0; u.a = pm; u.b = pn; u.c = 0; u.d = 0; return true; }
    HD void one(int R, int col, f32x4 v) const { atom4(hrow(p, R) + col, modp(p, layer, R, f ? 8 : 2) + col, sc, v); }
    HD void emit(const Unit& u, int r, int c, f32x4 v00, f32x4 v01, f32x4 v10, f32x4 v11) const {
        const int R = u.a * 256 + r, col = u.b * 256 + c; one(R, col, v00); one(R, col + 128, v01); one(R + 128, col, v10); one(R + 128, col + 128, v11); } };

struct DMlaIn { P p; int j; static constexpr int FENCE = 1; static constexpr int K = 1024, lda = 1024, ldb = 1024;
    HD bool unit(int L, Unit& u) const { int pm, pn; if (!rect_unit(L, MT / 256, 3, pm, pn)) return false;
        u.A = wsb(p, O_HN) + (size_t)pm * 256 * 1024; u.B = wsb(p, O_MWIN + j * SZ_MWIN) + (size_t)pn * 256 * 1024; u.a = pm; u.b = pn; u.c = 0; u.d = 0; return true; }
    HD void emit(const Unit& u, int r, int c, f32x4 v00, f32x4 v01, f32x4 v10, f32x4 v11) const {
        float* o = (float*)(p.ws + O_CALL) + ((size_t)u.a * 256 + r) * 768 + u.b * 256 + c;
        *(f32x4*)o = v00; *(f32x4*)(o + 128) = v01; *(f32x4*)(o + (size_t)128 * 768) = v10; *(f32x4*)(o + (size_t)128 * 768 + 128) = v11; } };
struct DMlaUq { P p; int j, nM; static constexpr int FENCE = 1; static constexpr int K = 384, lda = 384, ldb = 384;
    HD bool unit(int L, Unit& u) const { int pm, pn; if (!rect_unit(L, nM, 6, pm, pn)) return false;
        u.A = wsb(p, O_CQN) + (size_t)pm * 256 * 384; u.B = wsb(p, O_MWUQ + j * SZ_MWUQ) + (size_t)pn * 256 * 384; u.a = pm; u.b = pn; u.c = 0; u.d = 0; return true; }
    HD void emit(const Unit& u, int r, int c, f32x4 v00, f32x4 v01, f32x4 v10, f32x4 v11) const {
        u16* o = wsb(p, O_CALL) + ((size_t)u.a * 256 + r) * 1536 + u.b * 256 + c;
        st4bf(o, v00); st4bf(o + 128, v01); st4bf(o + (size_t)128 * 1536, v10); st4bf(o + (size_t)128 * 1536 + 128, v11); } };
struct DMlaUkv { P p; int j; static constexpr int FENCE = 1; static constexpr int K = 256, lda = 256, ldb = 256;
    HD bool unit(int L, Unit& u) const { int pm, pn; if (!rect_unit(L, MT / 256, 8, pm, pn)) return false;
        u.A = wsb(p, O_CKVN) + (size_t)pm * 256 * 256; u.B = wsb(p, O_MWUKV + j * SZ_MWUKV) + (size_t)pn * 256 * 256; u.a = pm; u.b = pn; u.c = 0; u.d = 0; return true; }
    HD void one(size_t R, int col, f32x4 v) const {
        if (col < 1024) st4bf(wsb(p, O_KF) + R * 1536 + (col >> 7) * 192 + (col & 127), v);
        else st4bf(wsb(p, O_VB) + R * 1024 + (col - 1024), v); }
    HD void emit(const Unit& u, int r, int c, f32x4 v00, f32x4 v01, f32x4 v10, f32x4 v11) const {
        const size_t R = (size_t)u.a * 256 + r; const int col = u.b * 256 + c;
        one(R, col, v00); one(R, col + 128, v01); one(R + 128, col, v10); one(R + 128, col + 128, v11); } };
struct DMlaO { P p; int layer, j, nM; static constexpr int FENCE = 4; static constexpr int K = 1024, lda = 1024, ldb = 1024;
    HD bool unit(int L, Unit& u) const { int pm, pn;
        if (nM < 0) { if (L >= (NC / 256) * 4) return false; pm = NL / 256 + (L >> 2); pn = L & 3; }
        else if (!rect_unit(L, nM, 4, pm, pn)) return false;
        u.A = wsb(p, O_HN) + (size_t)pm * 256 * 1024; u.B = wsb(p, O_MWO + j * SZ_MWO) + (size_t)pn * 256 * 1024; u.a = pm; u.b = pn; u.c = 0; u.d = 0; return true; }
    HD void emit(const Unit& u, int r, int c, f32x4 v00, f32x4 v01, f32x4 v10, f32x4 v11) const {
        const int R = u.a * 256 + r, col = u.b * 256 + c;
        resid4(p, layer, 5, 1.0f, R, col, v00); resid4(p, layer, 5, 1.0f, R, col + 128, v01); resid4(p, layer, 5, 1.0f, R + 128, col, v10); resid4(p, layer, 5, 1.0f, R + 128, col + 128, v11); } };

HD int ret_tokrow(int q, int cidx) { const int b = q * RGB + cidx / NCH, n = cidx % NCH; return n == 0 ? NL + b * 256 : b * SEQ + (n - 1) * 256; }
HD float ret_logg(const P& p, int dir, int h) { return log1pf(-expf(p.in[18][dir * 4 + h])); }
struct DRetProj { P p; int q; static constexpr int FENCE = 1; static constexpr int K = 1024, lda = 1024, ldb = 1024;
    HD bool unit(int L, Unit& u) const { int pm, pn; if (!rect_unit(L, NCQ, 16, pm, pn)) return false;
        const int wrow = pn < 8 ? pn * 256 : 4096 + (pn - 8) * 256;
        u.A = wsb(p, O_HN) + (size_t)ret_tokrow(q, pm) * 1024; u.B = wsb(p, O_RWIN) + (size_t)wrow * 1024; u.a = pm; u.b = pn; u.c = 0; u.d = 0;
        u.f0 = ret_logg(p, 0, pn & 3) * 1.4426950408889634f; u.f1 = ret_logg(p, 1, pn & 3) * 1.4426950408889634f; return true; }
    HD void emit(const Unit& u, int r, int c, f32x4 v00, f32x4 v01, f32x4 v10, f32x4 v11) const {
        const int cidx = u.a, pn = u.b, n = cidx % NCH;
        if (pn >= 8) { u16* g = wsb(p, O_GATE) + ((size_t)cidx * 256 + r) * 2048 + (pn - 8) * 256 + c;
            st4bf(g, v00); st4bf(g + 128, v01); st4bf(g + (size_t)128 * 2048, v10); st4bf(g + (size_t)128 * 2048 + 128, v11); return; }
        const int h = pn & 3; const bool isq = pn < 4;
        const float lgf = u.f0, lgb = u.f1;
        for (int X = 0; X < 2; ++X) { const int i = r + 128 * X; const f32x4 x1 = X ? v10 : v00, x2 = X ? v11 : v01; f32x4 r1, r2;
            for (int jx = 0; jx < 4; ++jx) { float cs = 1.f, sn = 0.f;
                if (n > 0) sincos_t((float)((n - 1) * 256 + i) * ropef(c + jx, 128), sn, cs);
                r1[jx] = x1[jx] * cs - x2[jx] * sn; r2[jx] = x2[jx] * cs + x1[jx] * sn; }
            if (isq) { u16* qn = wsb(p, O_QN) + ((size_t)cidx * 256 + i) * 1024 + h * 256 + c; st4bf(qn, r1); st4bf(qn + 128, r2);
                const float df = ex2(lgf * (float)(i + 1)), db = ex2(lgb * (float)(256 - i));
                u16* ae = wsb(p, O_AEXT) + (((size_t)h * NCQ + cidx) * 256 + i) * 768;
                st4bf(ae + 256 + c, r1 * df); st4bf(ae + 384 + c, r2 * df); st4bf(ae + 512 + c, r1 * db); st4bf(ae + 640 + c, r2 * db); }
            else { u16* kn = wsb(p, O_KN) + ((size_t)cidx * 256 + i) * 1024 + h * 256 + c; st4bf(kn, r1 * 0.0625f); st4bf(kn + 128, r2 * 0.0625f); } } } };
struct DRetProjT { P p; int q; static constexpr int FENCE = 1; static constexpr int K = 1024, lda = 1024, ldb = 1024;
    HD bool unit(int L, Unit& u) const { int pm, pn; if (!rect_unit(L, 12, NCQ, pm, pn)) return false;
        u.A = wsb(p, O_RWIN) + (size_t)(1024 + pm * 256) * 1024; u.B = wsb(p, O_HN) + (size_t)ret_tokrow(q, pn) * 1024; u.a = pm; u.b = pn; u.c = 0; u.d = 0;
        u.f0 = ret_logg(p, 0, pm & 3) * 1.4426950408889634f; u.f1 = ret_logg(p, 1, pm & 3) * 1.4426950408889634f; return true; }
    HD void emit(const Unit& u, int r, int c, f32x4 v00, f32x4 v01, f32x4 v10, f32x4 v11) const {
        const int pm = u.a, cidx = u.b, n = cidx % NCH;
        if (pm >= 4) { const int h = (pm - 4) >> 1, e0 = ((pm - 4) & 1) * 256 + r; u16* be = wsb(p, O_BEXT) + (((size_t)h * NCQ + cidx) * 512 + e0) * 768 + c;
            st4bf(be, v00); st4bf(be + 128, v01); st4bf(be + (size_t)128 * 768, v10); st4bf(be + (size_t)128 * 768 + 128, v11); return; }
        const int h = pm; const float lgf = u.f0, lgb = u.f1, fr = ropef(r, 128);
        u16* kf = wsb(p, O_KTX) + (((size_t)h * NCQ + cidx) * 2 + 0) * 65536; u16* kb = kf + 65536;
        for (int Y = 0; Y < 2; ++Y) { const f32x4 x1 = Y ? v01 : v00, x2 = Y ? v11 : v10; f32x4 f1, f2, b1, b2;
            for (int jx = 0; jx < 4; ++jx) { const int jj = c + 128 * Y + jx; float cs = 1.f, sn = 0.f;
                if (n > 0) sincos_t((float)((n - 1) * 256 + jj) * fr, sn, cs);
                const float r1 = (x1[jx] * cs - x2[jx] * sn) * 0.0625f, r2 = (x2[jx] * cs + x1[jx] * sn) * 0.0625f;
                const float df = ex2(lgf * (float)(255 - jj)), db = ex2(lgb * (float)jj);
                f1[jx] = r1 * df; f2[jx] = r2 * df; b1[jx] = r1 * db; b2[jx] = r2 * db; }
            const int jc = c + 128 * Y;
            st4bf(kf + (size_t)r * 256 + jc, f1); st4bf(kf + (size_t)(r + 128) * 256 + jc, f2); st4bf(kb + (size_t)r * 256 + jc, b1); st4bf(kb + (size_t)(r + 128) * 256 + jc, b2); } } };
struct DRetProjAll { P p; int q; static constexpr int FENCE = 1; static constexpr int K = 1024, lda = 1024, ldb = 1024;
    HD bool unit(int L, Unit& u) const { const DRetProj a{p, q}; const DRetProjT b{p, q};
        if (L < NCQ * 16) { const bool ok = a.unit(L, u); u.d = 0; return ok; } const bool ok = b.unit(L - NCQ * 16, u); u.d = 1; return ok; }
    HD void emit(const Unit& u, int r, int c, f32x4 v00, f32x4 v01, f32x4 v10, f32x4 v11) const {
        if (u.d == 0) { const DRetProj a{p, q}; a.emit(u, r, c, v00, v01, v10, v11); } else { const DRetProjT b{p, q}; b.emit(u, r, c, v00, v01, v10, v11); } } };
struct DRetP { P p; static constexpr int FENCE = 1; static constexpr int K = 256, lda = 1024, ldb = 1024;
    HD bool unit(int L, Unit& u) const { int pm, pn; if (!rect_unit(L, NCQ, 4, pm, pn)) return false;
        u.A = wsb(p, O_QN) + (size_t)pm * 256 * 1024 + pn * 256; u.B = wsb(p, O_KN) + (size_t)pm * 256 * 1024 + pn * 256; u.a = pm; u.b = pn; u.c = 0; u.d = 0;
        u.f0 = ret_logg(p, 0, pn) * 1.4426950408889634f; u.f1 = ret_logg(p, 1, pn) * 1.4426950408889634f; return true; }
    HD void one(u16* ae, float lgf, float lgb, int i, int j0, f32x4 v) const { f32x4 o;
        for (int jx = 0; jx < 4; ++jx) { const int jj = j0 + jx; o[jx] = v[jx] * ex2(jj <= i ? lgf * (float)(i - jj) : lgb * (float)(jj - i)); }
        st4bf(ae + (size_t)i * 768 + j0, o); }
    HD void emit(const Unit& u, int r, int c, f32x4 v00, f32x4 v01, f32x4 v10, f32x4 v11) const {
        const int cidx = u.a, h = u.b; const float lgf = u.f0, lgb = u.f1;
        u16* ae = wsb(p, O_AEXT) + ((size_t)h * NCQ + cidx) * 256 * 768;
        one(ae, lgf, lgb, r, c, v00); one(ae, lgf, lgb, r, c + 128, v01); one(ae, lgf, lgb, r + 128, c, v10); one(ae, lgf, lgb, r + 128, c + 128, v11); } };
struct DRetL { P p; static constexpr int FENCE = 1; static constexpr int K = 256, lda = 768, ldb = 256;
    HD bool unit(int L, Unit& u) const { int pm, pn; if (!rect_unit(L, 4 * NCQ, 4, pm, pn)) return false;
        const int dir = pn >> 1, eh = pn & 1;
        u.A = wsb(p, O_BEXT) + ((size_t)pm * 512 + eh * 256) * 768; u.B = wsb(p, O_KTX) + ((size_t)pm * 2 + dir) * 65536; u.a = pm; u.b = dir; u.c = eh; u.d = 0; return true; }
    HD void emit(const Unit& u, int r, int c, f32x4 v00, f32x4 v01, f32x4 v10, f32x4 v11) const {
        u16* o = wsb(p, O_BEXT) + ((size_t)u.a * 512 + u.c * 256 + r) * 768 + 256 + u.b * 256 + c;
        st4bf(o, v00); st4bf(o + 128, v01); st4bf(o + (size_t)128 * 768, v10); st4bf(o + (size_t)128 * 768 + 128, v11); } };
struct DRetO { P p; static constexpr int FENCE = 1; static constexpr int K = 768, lda = 768, ldb = 768;
    HD bool unit(int L, Unit& u) const { int pm, pn; if (!rect_unit(L, 4 * NCQ, 2, pm, pn)) return false;
        u.A = wsb(p, O_AEXT) + (size_t)pm * 256 * 768; u.B = wsb(p, O_BEXT) + ((size_t)pm * 512 + pn * 256) * 768; u.a = pm; u.b = pn; u.c = 0; u.d = 0; return true; }
    HD void emit(const Unit& u, int r, int c, f32x4 v00, f32x4 v01, f32x4 v10, f32x4 v11) const {
        const int h = u.a / NCQ, cidx = u.a % NCQ;
        u16* o = wsb(p, O_OB) + ((size_t)cidx * 256 + r) * 2048 + h * 512 + u.b * 256 + c;
        st4bf(o, v00); st4bf(o + 128, v01); st4bf(o + (size_t)128 * 2048, v10); st4bf(o + (size_t)128 * 2048 + 128, v11); } };
struct DRetWoCtx { P p; int layer; static constexpr int FENCE = 4; static constexpr int K = 2048, lda = 2048, ldb = 2048;
    HD bool unit(int L, Unit& u) const { int pm, pn; if (!rect_unit(L, NC / 256, 4, pm, pn)) return false;
        u.A = wsb(p, O_YCTX) + (size_t)pm * 256 * 2048; u.B = wsb(p, O_RWO) + (size_t)pn * 256 * 2048; u.a = NL + pm * 256; u.b = pn; u.c = 0; u.d = 0; return true; }
    HD void emit(const Unit& u, int r, int c, f32x4 v00, f32x4 v01, f32x4 v10, f32x4 v11) const {
        const int R = u.a + r, col = u.b * 256 + c;
        resid4(p, layer, 5, 1.0f, R, col, v00); resid4(p, layer, 5, 1.0f, R, col + 128, v01); resid4(p, layer, 5, 1.0f, R + 128, col, v10); resid4(p, layer, 5, 1.0f, R + 128, col + 128, v11); } };
struct DRetWo { P p; int layer, q; static constexpr int FENCE = 4; static constexpr int K = 2048, lda = 2048, ldb = 2048;
    HD bool unit(int L, Unit& u) const { int pl, pn; if (!rect_unit(L, NCQ - RGB, 4, pl, pn)) return false; const int pm = pl + pl / (NCH - 1) + 1;
        u.A = wsb(p, O_OB) + (size_t)pm * 256 * 2048; u.B = wsb(p, O_RWO) + (size_t)pn * 256 * 2048; u.a = ret_tokrow(q, pm); u.b = pn; u.c = 0; u.d = 0; return true; }
    HD void emit(const Unit& u, int r, int c, f32x4 v00, f32x4 v01, f32x4 v10, f32x4 v11) const {
        const int R = u.a + r, col = u.b * 256 + c;
        resid4(p, layer, 5, 1.0f, R, col, v00); resid4(p, layer, 5, 1.0f, R, col + 128, v01); resid4(p, layer, 5, 1.0f, R + 128, col, v10); resid4(p, layer, 5, 1.0f, R + 128, col + 128, v11); } };

struct DS5L { P p; static constexpr int FENCE = 1; static constexpr int K = 512, lda = 768, ldb = 512;
    HD bool unit(int L, Unit& u) const { int pm, pn; if (!rect_unit(L, NROW5P / 256, 64, pm, pn)) return false;
        u.A = wsb(p, O_UEXT) + ((size_t)pn * NROW5P + pm * 256) * 768; u.B = wsb(p, O_FEXT) + (size_t)pn * 256 * 512; u.a = pm; u.b = pn; u.c = 0; u.d = 0; return true; }
    HD void emit(const Unit& u, int r, int c, f32x4 v00, f32x4 v01, f32x4 v10, f32x4 v11) const {
        u16* o = wsb(p, O_UEXT) + ((size_t)u.b * NROW5P + u.a * 256 + r) * 768 + 512 + c;
        st4bf(o, v00); st4bf(o + 128, v01); st4bf(o + (size_t)128 * 768, v10); st4bf(o + (size_t)128 * 768 + 128, v11); } };
struct DS5Y { P p; static constexpr int FENCE = 1; static constexpr int K = 768, lda = 768, ldb = 768;
    HD bool unit(int L, Unit& u) const { int pm, pn; if (!rect_unit(L, NROW5P / 256, 128, pm, pn)) return false;
        const int g = pn >> 1, ch = pn & 1;
        u.A = wsb(p, O_UEXT) + ((size_t)g * NROW5P + pm * 256) * 768; u.B = wsb(p, O_TEXT) + ((size_t)g * 512 + ch * 256) * 768; u.a = pm; u.b = g; u.c = ch; u.d = 0; return true; }
    HD void one(int g, int row, int col, f32x4 v) const {
        int tok; if (row < NB * S5L) tok = (row / S5L) * SEQ + (row % S5L) * 32; else if (row < NROW5) { const int rr = row - NB * S5L; tok = NL + (rr / S5C) * 256 + (rr % S5C) * 32; } else return;
        f32x4 o; for (int jx = 0; jx < 4; ++jx) o[jx] = gelu_f(v[jx]);
        st4bf(wsb(p, O_HN) + (size_t)(tok + (col >> 4)) * 1024 + g * 16 + (col & 15), o); }
    HD void emit(const Unit& u, int r, int c, f32x4 v00, f32x4 v01, f32x4 v10, f32x4 v11) const {
        const int row = u.a * 256 + r, col = u.c * 256 + c;
        one(u.b, row, col, v00); one(u.b, row, col + 128, v01); one(u.b, row + 128, col, v10); one(u.b, row + 128, col + 128, v11); } };
struct DS5Glu { P p; int layer; static constexpr int FENCE = 4; static constexpr int K = 1024, lda = 1024, ldb = 1024;
    HD bool unit(int L, Unit& u) const { int pm, pn; if (!rect_unit(L, MT / 256, 8, pm, pn)) return false;
        u.A = wsb(p, O_HN) + (size_t)pm * 256 * 1024; u.B = wsb(p, O_GLU) + (size_t)pn * 256 * 1024; u.a = pm; u.b = pn; u.c = 0; u.d = 0; return true; }
    HD void emit(const Unit& u, int r, int c, f32x4 v00, f32x4 v01, f32x4 v10, f32x4 v11) const {
        const int col = u.b * 128 + c; const float* gb = p.in[30]; f32x4 y0, y1;
        for (int jx = 0; jx < 4; ++jx) { const float ba = gb[col + jx], bg = gb[1024 + col + jx];
            y0[jx] = (v00[jx] + ba) * sigm_f(v01[jx] + bg); y1[jx] = (v10[jx] + ba) * sigm_f(v11[jx] + bg); }
        resid4(p, layer, 5, 1.0f, u.a * 256 + r, col, y0); resid4(p, layer, 5, 1.0f, u.a * 256 + r + 128, col, y1); } };

HD void cvt64(const float* src, int N, int srccol, u16* dst, int Kd, int nrow, int k0) {
    float v[64];
#pragma unroll
    for (int j = 0; j < 64; ++j) v[j] = srccol >= 0 ? src[(size_t)(k0 + j) * N + srccol] : 0.f;
#pragma unroll
    for (int j = 0; j < 64; j += 4) { f32x4 a; a[0] = v[j]; a[1] = v[j + 1]; a[2] = v[j + 2]; a[3] = v[j + 3]; st4bf(dst + (size_t)nrow * Kd + k0 + j, a); } }
constexpr long CV_FFI = (long)8 * 5632 * 16, CV_FFO = (long)8 * 1024 * 44, CV_MWIN = (long)2 * 768 * 16, CV_MWUQ = (long)2 * 1536 * 6, CV_MWUKV = (long)2 * 2048 * 4,
               CV_MWO = (long)2 * 1024 * 16, CV_RWIN = (long)6144 * 16, CV_RWO = (long)1024 * 32, CV_GLU = (long)2048 * 16;
constexpr long CV_TOTAL = CV_FFI + CV_FFO + CV_MWIN + CV_MWUQ + CV_MWUKV + CV_MWO + CV_RWIN + CV_RWO + CV_GLU;
HD void cvt_item(const P& p, long idx) {
    if (idx < CV_FFI) { const int n = (int)(idx % 5632); const long t = idx / 5632; const int kb = (int)(t % 16), m = (int)(t / 16);
        const int tile = n >> 8, rr = n & 255; const int sc = rr < 128 ? tile * 128 + rr : 2816 + tile * 128 + (rr - 128);
        cvt64(p.in[7] + (size_t)m * 1024 * 5632, 5632, sc, wsb(p, O_FFI + (size_t)m * SZ_FFI1), 1024, n, kb * 64); return; }
    idx -= CV_FFI;
    if (idx < CV_FFO) { const int n = (int)(idx % 1024); const long t = idx / 1024; const int kb = (int)(t % 44), m = (int)(t / 44);
        cvt64(p.in[8] + (size_t)m * 2816 * 1024, 1024, n, wsb(p, O_FFO + (size_t)m * SZ_FFO1), 2816, n, kb * 64); return; }
    idx -= CV_FFO;
    if (idx < CV_MWIN) { const int n = (int)(idx % 768); const long t = idx / 768; const int kb = (int)(t % 16), m = (int)(t / 16);
        cvt64(p.in[9] + (size_t)m * 1024 * 704, 704, n < 704 ? n : -1, wsb(p, O_MWIN + (size_t)m * SZ_MWIN), 1024, n, kb * 64); return; }
    idx -= CV_MWIN;
    if (idx < CV_MWUQ) { const int n = (int)(idx % 1536); const long t = idx / 1536; const int kb = (int)(t % 6), m = (int)(t / 6);
        cvt64(p.in[12] + (size_t)m * 384 * 1536, 1536, n, wsb(p, O_MWUQ + (size_t)m * SZ_MWUQ), 384, n, kb * 64); return; }
    idx -= CV_MWUQ;
    if (idx < CV_MWUKV) { const int n = (int)(idx % 2048); const long t = idx / 2048; const int kb = (int)(t % 4), m = (int)(t / 4);
        const int sc = n < 1024 ? (n >> 7) * 256 + (n & 127) : ((n - 1024) >> 7) * 256 + 128 + (n & 127);
        cvt64(p.in[13] + (size_t)m * 256 * 2048, 2048, sc, wsb(p, O_MWUKV + (size_t)m * SZ_MWUKV), 256, n, kb * 64); return; }
    idx -= CV_MWUKV;
    if (idx < CV_MWO) { const int n = (int)(idx % 1024); const long t = idx / 1024; const int kb = (int)(t % 16), m = (int)(t / 16);
        cvt64(p.in[16] + (size_t)m * 1024 * 1024, 1024, n, wsb(p, O_MWO + (size_t)m * SZ_MWO), 1024, n, kb * 64); return; }
    idx -= CV_MWO;
    if (idx < CV_RWIN) { const int n = (int)(idx % 6144), kb = (int)(idx / 6144); cvt64(p.in[17], 6144, n, wsb(p, O_RWIN), 1024, n, kb * 64); return; }
    idx -= CV_RWIN;
    if (idx < CV_RWO) { const int n = (int)(idx % 1024), kb = (int)(idx / 1024); cvt64(p.in[20], 1024, n, wsb(p, O_RWO), 2048, n, kb * 64); return; }
    idx -= CV_RWO;
    { const int n = (int)(idx % 2048), kb = (int)(idx / 2048); const int tile = n >> 8, rr = n & 255; const int sc = rr < 128 ? tile * 128 + rr : 1024 + tile * 128 + (rr - 128);
      cvt64(p.in[29], 2048, sc, wsb(p, O_GLU), 1024, n, kb * 64); }
}
HD void mod_item(const P& p, int idx) {
    const int layer = idx / 9216, col = idx % 9216; const float* w = p.in[4] + (size_t)layer * 1024 * 9216 + col; float acc[NMR];
    for (int b = 0; b < NMR; ++b) acc[b] = 0.f;
    for (int k = 0; k < 1024; ++k) { const float wv = w[(size_t)k * 9216];
#pragma unroll
        for (int b = 0; b < NMR; ++b) { const float cv = b < NB ? p.in[1][b * 1024 + k] : p.in[3][k]; acc[b] += silu_f(cv) * wv; } }
    const float bias = p.in[5][layer * 9216 + col];
#pragma unroll
    for (int b = 0; b < NMR; ++b) ((float*)(p.ws + O_MOD))[(size_t)(layer * NMR + b) * 9216 + col] = acc[b] + bias; }
HD void copy_item(const P& p, long idx) {
    const long nl4 = (long)NL * 256;
    if (idx < nl4) ((f32x4*)p.out)[idx] = ((const f32x4*)p.in[0])[idx]; else ((f32x4*)(p.ws + O_G))[idx - nl4] = ((const f32x4*)p.in[2])[idx - nl4]; }
HD void norm_item(const P& p, int layer, int k, int r, int s5) {
    const float* x = hsrc(p, r, layer == 0 && k == 0); float ss = 0.f;
    for (int d = 0; d < 1024; d += 4) { const f32x4 v = *(const f32x4*)(x + d); ss += v[0] * v[0] + v[1] * v[1] + v[2] * v[2] + v[3] * v[3]; }
    const float rinv = rsq_f(ss * (1.0f / 1024.0f) + EPS);
    const float* g = p.in[6] + (size_t)(layer * 3 + k) * 1024; const float* sh = modp(p, layer, r, 3 * k); const float* sc = modp(p, layer, r, 3 * k + 1);
    int row5 = 0, i5 = 0;
    if (s5) { if (r < NL) { const int b = r / SEQ, t = r % SEQ; row5 = b * S5L + t / 32; i5 = t % 32; } else { const int rr = r - NL; const int b = rr / 256, l = rr % 256; row5 = NB * S5L + b * S5C + l / 32; i5 = l % 32; } }
    for (int d = 0; d < 1024; d += 4) { const f32x4 v = *(const f32x4*)(x + d); f32x4 o;
        for (int j = 0; j < 4; ++j) o[j] = v[j] * rinv * g[d + j] * (1.0f + sc[d + j]) + sh[d + j];
        if (!s5) st4bf(wsb(p, O_HN) + (size_t)r * 1024 + d, o);
        else st4bf(wsb(p, O_UEXT) + ((size_t)(d >> 4) * NROW5P + row5) * 768 + i5 * 16 + (d & 15), o); } }
HD void axial_rot64(float* v, int t) {
    const int prow = t / 64, pcol = t % 64;
    for (int f = 0; f < 16; ++f) { const float fq = ropef(f, 16);
        { float cs, sn; sincos_t((float)prow * fq, sn, cs); const float x1 = v[f], x2 = v[16 + f]; v[f] = x1 * cs - x2 * sn; v[16 + f] = x2 * cs + x1 * sn; }
        { float cs, sn; sincos_t((float)pcol * fq, sn, cs); const float x1 = v[32 + f], x2 = v[48 + f]; v[32 + f] = x1 * cs - x2 * sn; v[48 + f] = x2 * cs + x1 * sn; } } }
HD void mla_row_item(const P& p, int j, int r) {
    const float* x = (const float*)(p.ws + O_CALL) + (size_t)r * 768; float ss = 0.f;
    for (int d = 0; d < 384; ++d) ss += x[d] * x[d];
    float rinv = rsq_f(ss * (1.0f / 384.0f) + EPS); const float* qn = p.in[10] + j * 384;
    for (int d = 0; d < 384; d += 4) { f32x4 o; for (int jx = 0; jx < 4; ++jx) o[jx] = x[d + jx] * rinv * qn[d + jx]; st4bf(wsb(p, O_CQN) + (size_t)r * 384 + d, o); }
    ss = 0.f; for (int d = 0; d < 256; ++d) ss += x[384 + d] * x[384 + d];
    rinv = rsq_f(ss * (1.0f / 256.0f) + EPS); const float* kvn = p.in[11] + j * 256;
    for (int d = 0; d < 256; d += 4) { f32x4 o; for (int jx = 0; jx < 4; ++jx) o[jx] = x[384 + d + jx] * rinv * kvn[d + jx]; st4bf(wsb(p, O_CKVN) + (size_t)r * 256 + d, o); }
    ss = 0.f; for (int d = 0; d < 64; ++d) ss += x[640 + d] * x[640 + d];
    rinv = rsq_f(ss * (1.0f / 64.0f) + EPS); const float* kg = p.in[15] + j * 192 + 128;
#ifdef HOST_EMU
    float kr[64];
    for (int d = 0; d < 64; ++d) kr[d] = x[640 + d] * rinv * kg[d];
    if (r < NL) axial_rot64(kr, r % SEQ);
    for (int h = 0; h < 8; ++h) for (int d = 0; d < 64; ++d) wsb(p, O_KF)[(size_t)r * 1536 + h * 192 + 128 + d] = f2bf(kr[d]);
#else
    const int t = r % SEQ, prow = t / 64, pcol = t % 64;
    for (int f = 0; f < 16; ++f) { const float fq = ropef(f, 16);
#pragma unroll
        for (int part = 0; part < 2; ++part) { float cs = 1.f, sn = 0.f; if (r < NL) sincos_t((float)(part ? pcol : prow) * fq, sn, cs);
            const int d1 = part * 32 + f, d2 = d1 + 16; const float x1 = x[640 + d1] * rinv * kg[d1], x2 = x[640 + d2] * rinv * kg[d2];
            const u16 o1 = f2bf(x1 * cs - x2 * sn), o2 = f2bf(x2 * cs + x1 * sn);
            for (int h = 0; h < 8; ++h) { wsb(p, O_KF)[(size_t)r * 1536 + h * 192 + 128 + d1] = o1; wsb(p, O_KF)[(size_t)r * 1536 + h * 192 + 128 + d2] = o2; } } }
#endif
}
HD void mla_head_item(const P& p, int j, int idx) {
    const int r = idx >> 3, h = idx & 7;
    u16* q = wsb(p, O_CALL) + (size_t)r * 1536 + h * 192; const float* qg = p.in[14] + j * 192; float ss = 0.f;
    for (int d = 0; d < 128; ++d) { const float v = bf2f(q[d]); ss += v * v; }
    float rinv = rsq_f(ss * (1.0f / 128.0f) + EPS);
    for (int d = 0; d < 128; ++d) q[d] = f2bf(bf2f(q[d]) * rinv * qg[d]);
    ss = 0.f; for (int d = 0; d < 64; ++d) { const float v = bf2f(q[128 + d]); ss += v * v; }
    rinv = rsq_f(ss * (1.0f / 64.0f) + EPS);
    { const int t = r % SEQ, prow = t / 64, pcol = t % 64;
      for (int f = 0; f < 16; ++f) { const float fq = ropef(f, 16);
#pragma unroll
        for (int part = 0; part < 2; ++part) { float cs = 1.f, sn = 0.f; if (r < NL) sincos_t((float)(part ? pcol : prow) * fq, sn, cs);
            const int d1 = 128 + part * 32 + f, d2 = d1 + 16; const float x1 = bf2f(q[d1]) * rinv * qg[d1], x2 = bf2f(q[d2]) * rinv * qg[d2];
            q[d1] = f2bf(x1 * cs - x2 * sn); q[d2] = f2bf(x2 * cs + x1 * sn); } } }
    u16* k = wsb(p, O_KF) + (size_t)r * 1536 + h * 192; const float* kg = p.in[15] + j * 192;
    ss = 0.f; for (int d = 0; d < 128; ++d) { const float v = bf2f(k[d]); ss += v * v; }
    rinv = rsq_f(ss * (1.0f / 128.0f) + EPS);
    for (int d = 0; d < 128; ++d) k[d] = f2bf(bf2f(k[d]) * rinv * kg[d]);
}
HD void ret_prefix_item(const P& p, int idx) {
    const int d4 = idx & 63, e = (idx >> 6) & 511, bq = (idx >> 15) % RGB, h = (idx >> 15) / RGB;
    const float gf = expf(256.f * ret_logg(p, 0, h)), gb = expf(256.f * ret_logg(p, 1, h));
    u16* base = wsb(p, O_BEXT) + (((size_t)h * NCQ + bq * NCH) * 512 + e) * 768 + d4 * 4; constexpr size_t CS = (size_t)512 * 768;
    u32x2 tf[NCH], tb[NCH];
#pragma unroll
    for (int n = 0; n < NCH; ++n) { tf[n] = *(const u32x2*)(base + n * CS + 256); tb[n] = *(const u32x2*)(base + n * CS + 512); }
    f32x4 cf = {0.f, 0.f, 0.f, 0.f}, cb = {0.f, 0.f, 0.f, 0.f};
#pragma unroll
    for (int n = 0; n < NCH; ++n) { f32x4 t; t[0] = bf2f((u16)(tf[n].x & 0xffff)); t[1] = bf2f((u16)(tf[n].x >> 16)); t[2] = bf2f((u16)(tf[n].y & 0xffff)); t[3] = bf2f((u16)(tf[n].y >> 16));
        st4bf(base + n * CS + 256, cf); cf = cf * gf + t; }
#pragma unroll
    for (int s_ = 0; s_ < NCH; ++s_) { const int n = s_ == 0 ? 0 : NCH - s_; f32x4 t; t[0] = bf2f((u16)(tb[n].x & 0xffff)); t[1] = bf2f((u16)(tb[n].x >> 16)); t[2] = bf2f((u16)(tb[n].y & 0xffff)); t[3] = bf2f((u16)(tb[n].y >> 16));
        st4bf(base + n * CS + 512, cb); cb = cb * gb + t; } }
HD u16* ret_ydst(const P& p, int q, int lr) { const int cidx = lr >> 8, n = cidx % NCH; return n == 0 ? wsb(p, O_YCTX) + ((size_t)((q * RGB + cidx / NCH) * 256 + (lr & 255))) * 2048 : wsb(p, O_OB) + (size_t)lr * 2048; }
HD void ret_norm_item(const P& p, int qg, int idx) {
    const int lr = idx >> 2, h = idx & 3; u16* o = wsb(p, O_OB) + (size_t)lr * 2048 + h * 512; u16* yd = ret_ydst(p, qg, lr) + h * 512; const u16* g = wsb(p, O_GATE) + (size_t)lr * 2048 + h * 512; const float* gg = p.in[19] + h * 512;
    float s = 0.f; for (int e = 0; e < 512; ++e) s += bf2f(o[e]);
    const float mu = s * (1.0f / 512.0f); float q = 0.f; for (int e = 0; e < 512; ++e) { const float d = bf2f(o[e]) - mu; q += d * d; }
    const float rstd = rsq_f(q * (1.0f / 512.0f) + EPS);
    for (int e = 0; e < 512; ++e) yd[e] = f2bf((bf2f(o[e]) - mu) * rstd * gg[e] * silu_f(bf2f(g[e]))); }
struct Cx { float re, im; };
HD Cx cmul(Cx a, Cx b) { Cx r; r.re = a.re * b.re - a.im * b.im; r.im = a.re * b.im + a.im * b.re; return r; }
HD Cx s5_alog(const P& p, int dir, int g, int pp) { const float dt = expf(p.in[23][dir * 64 + g]); Cx r; r.re = p.in[21][(dir * 64 + g) * 64 + pp] * dt; r.im = p.in[22][(dir * 64 + g) * 64 + pp] * dt; return r; }
HD Cx cpowa(Cx al, float n) { const float m = expf(al.re * n); float sn, cs; sincos_t(al.im * n * 0.15915494309189535f, sn, cs); Cx r; r.re = m * cs; r.im = m * sn; return r; }
HD Cx s5_coef(const P& p, int dir, int g, int pp) {
    const Cx al = s5_alog(p, dir, g, pp); Cx a = cpowa(al, 1.f); a.re -= 1.f; const float lr = p.in[21][(dir * 64 + g) * 64 + pp], li = p.in[22][(dir * 64 + g) * 64 + pp], den = 1.0f / (lr * lr + li * li);
    Cx r; r.re = (a.re * lr + a.im * li) * den; r.im = (a.im * lr - a.re * li) * den; return r; }
HD Cx s5_bbar(const P& p, int dir, int g, int pp, int m) { Cx b; const size_t o = (((size_t)dir * 64 + g) * 64 + pp) * 16 + m; b.re = p.in[24][o]; b.im = p.in[25][o]; return cmul(s5_coef(p, dir, g, pp), b); }
HD Cx s5_c(const P& p, int dir, int g, int m, int pp) { Cx c; const size_t o = (((size_t)dir * 64 + g) * 16 + m) * 64 + pp; c.re = p.in[26][o]; c.im = p.in[27][o]; return c; }
HD void s5_ktab_item(const P& p, int idx) {
    const int m = idx & 15, tau = (idx >> 4) & 31, dir = (idx >> 9) & 1, g = idx >> 10; float acc[16];
#pragma unroll
    for (int m2 = 0; m2 < 16; ++m2) acc[m2] = 0.f;
    for (int pp = 0; pp < 64; ++pp) { const Cx w = cmul(cmul(s5_c(p, dir, g, m, pp), cpowa(s5_alog(p, dir, g, pp), (float)tau)), s5_coef(p, dir, g, pp));
        const size_t o = (((size_t)dir * 64 + g) * 64 + pp) * 16;
#pragma unroll
        for (int m2 = 0; m2 < 16; ++m2) acc[m2] += w.re * p.in[24][o + m2] - w.im * p.in[25][o + m2]; }
#pragma unroll
    for (int m2 = 0; m2 < 16; ++m2) ((float*)(p.ws + O_KTAB))[(size_t)idx * 16 + m2] = acc[m2]; }
HD void s5_text_item(const P& p, long idx) {
    const int col = (int)(idx % 768); const long t = idx / 768; const int row = (int)(t % 512), g = (int)(t / 512), i = row >> 4, m = row & 15; float v;
    const float* kt = (const float*)(p.ws + O_KTAB);
    if (col < 512) { const int jj = col >> 4, m2 = col & 15; v = 0.f;
        if (jj <= i) v += kt[((((size_t)g * 2 + 0) * 32 + (i - jj)) * 16 + m) * 16 + m2];
        if (jj >= i) v += kt[((((size_t)g * 2 + 1) * 32 + (jj - i)) * 16 + m) * 16 + m2];
        if (jj == i && m == m2) v += p.in[28][g * 16 + m]; }
    else { const int dir = col >= 640, pp = ((col - 512) & 127) >> 1, part = col & 1;
        const Cx w = cmul(s5_c(p, dir, g, m, pp), cpowa(s5_alog(p, dir, g, pp), dir ? (float)(32 - i) : (float)(i + 1))); v = part ? -w.im : w.re; }
    wsb(p, O_TEXT)[idx] = f2bf(v); }
HD void s5_fext_item(const P& p, int idx) {
    const int col = idx & 511, row = (idx >> 9) & 255, g = idx >> 17, jj = col >> 4, m2 = col & 15, dir = row >> 7, pp = (row & 127) >> 1, part = row & 1;
    const Cx w = cmul(cpowa(s5_alog(p, dir, g, pp), dir ? (float)jj : (float)(31 - jj)), s5_bbar(p, dir, g, pp, m2));
    wsb(p, O_FEXT)[idx] = f2bf(part ? w.im : w.re); }
HD int s5_row(int b, int s) { return s < S5C ? NB * S5L + b * S5C + s : b * S5L + (s - S5C); }
HD void s5_prefix_item(const P& p, int idx) {
    const int pp = idx & 63, b = (idx >> 6) % NB, g = (idx >> 6) / NB;
    const Cx af = cpowa(s5_alog(p, 0, g, pp), 32.f), ab = cpowa(s5_alog(p, 1, g, pp), 32.f);
    u16* base = wsb(p, O_UEXT) + (size_t)g * NROW5P * 768; Cx c; c.re = 0.f; c.im = 0.f;
    for (int s0 = 0; s0 < S5C + S5L; s0 += 8) { unsigned t[8];
#pragma unroll
        for (int k = 0; k < 8; ++k) t[k] = *(const unsigned*)(base + (size_t)s5_row(b, s0 + k) * 768 + 512 + 2 * pp);
#pragma unroll
        for (int k = 0; k < 8; ++k) { u16* q = base + (size_t)s5_row(b, s0 + k) * 768 + 512 + 2 * pp; *(unsigned*)q = (unsigned)f2bf(c.re) | ((unsigned)f2bf(c.im) << 16);
            c = cmul(af, c); c.re += bf2f((u16)(t[k] & 0xffff)); c.im += bf2f((u16)(t[k] >> 16)); } }
    c.re = 0.f; c.im = 0.f;
    for (int s0 = 0; s0 < S5C + S5L; s0 += 8) { unsigned t[8]; int sv[8];
#pragma unroll
        for (int k = 0; k < 8; ++k) { const int s_ = s0 + k; sv[k] = s_ < S5C ? S5C - 1 - s_ : S5C + S5L - 1 - (s_ - S5C); t[k] = *(const unsigned*)(base + (size_t)s5_row(b, sv[k]) * 768 + 640 + 2 * pp); }
#pragma unroll
        for (int k = 0; k < 8; ++k) { u16* q = base + (size_t)s5_row(b, sv[k]) * 768 + 640 + 2 * pp; *(unsigned*)q = (unsigned)f2bf(c.re) | ((unsigned)f2bf(c.im) << 16);
            c = cmul(ab, c); c.re += bf2f((u16)(t[k] & 0xffff)); c.im += bf2f((u16)(t[k] >> 16)); } } }

struct AttItem { const u16* q; const u16* k0; const u16* k1; const u16* v0; const u16* v1; u16* o; int n0, ntot; };
HD void att_item(const P& p, int it, AttItem& a) {
    const u16* Q = wsb(p, O_CALL); const u16* KF = wsb(p, O_KF); const u16* VB = wsb(p, O_VB); u16* O = wsb(p, O_HN);
    const int nlat = NB * 8 * (SEQ / 256);
    if (it < nlat) { const int qb = it % (SEQ / 256), h = (it / (SEQ / 256)) & 7, b = it / (SEQ / 256) / 8; const size_t r0 = (size_t)b * SEQ + qb * 256, c0 = (size_t)NL + b * 256, l0 = (size_t)b * SEQ;
        a.q = Q + r0 * 1536 + h * 192; a.o = O + r0 * 1024 + h * 128; a.k0 = KF + c0 * 1536 + h * 192; a.v0 = VB + c0 * 1024 + h * 128; a.k1 = KF + l0 * 1536 + h * 192; a.v1 = VB + l0 * 1024 + h * 128; a.n0 = 256; a.ntot = 256 + SEQ; }
    else { const int x = it - nlat, h = x & 7, b = x >> 3; const size_t c0 = (size_t)NL + b * 256;
        a.q = Q + c0 * 1536 + h * 192; a.o = O + c0 * 1024 + h * 128; a.k0 = KF + c0 * 1536 + h * 192; a.v0 = VB + c0 * 1024 + h * 128; a.k1 = a.k0; a.v1 = a.v0; a.n0 = 256; a.ntot = 256; } }
constexpr float ATT_SCALE = 0.07216878364870322f;

#ifndef HOST_EMU
#define LAS __attribute__((address_space(3)))
typedef short bf16x8 __attribute__((ext_vector_type(8)));
typedef short s16x4 __attribute__((ext_vector_type(4)));
typedef float f32x16 __attribute__((ext_vector_type(16)));
typedef unsigned u32x4 __attribute__((ext_vector_type(4)));
constexpr int HTB = 128 * 64 * 2, STAGE_BYTES = 8 * HTB;
__device__ __forceinline__ int lds_byte(int r, int c) { const int st = (r >> 4) * 2 + (c >> 5), rr = r & 15, cc = c & 31, ob = rr * 64 + cc * 2; return st * 1024 + (ob ^ (((ob >> 9) & 1) << 5)); }
__device__ __forceinline__ void stage_rc(int b, int& R, int& C) { const int st = b / 1024, sb = b % 1024, swz = sb ^ (((sb >> 9) & 1) << 5); R = (st >> 1) * 16 + swz / 64; C = (st & 1) * 32 + (swz % 64) / 2; }

template <class Dsc>
__device__ __forceinline__ void gemm_run(LAS unsigned char* lds, const Dsc& D) {
    int tid_ = threadIdx.x; asm volatile("" : "+v"(tid_));
    const int tid = tid_, wid = __builtin_amdgcn_readfirstlane(tid >> 6), lane = tid & 63, wr = wid >> 2, wc = wid & 3, fr = lane & 15, fq = lane >> 4;
    constexpr int K = Dsc::K, nt = K / 64, lda = Dsc::lda, ldb = Dsc::ldb;
    static_assert(K % 128 == 0 && K >= 256, "K");
    unsigned voffA[2], voffB[2];
#pragma unroll
    for (int i = 0; i < 2; ++i) { int R, C; stage_rc(tid * 16 + i * 8192, R, C); voffA[i] = (unsigned)(R * lda + C) * 2u; voffB[i] = (unsigned)(R * ldb + C) * 2u; }
    constexpr size_t kstep = 128, hstepA = (size_t)128 * lda * 2, hstepB = (size_t)128 * ldb * 2;
    const unsigned ldsw = (unsigned)wid * 1024u;
    const int aoff = lds_byte(wr * 64 + fr, fq * 8), boff = lds_byte(wc * 32 + fr, fq * 8);
#define G_SA(b, h) (((b) * 2 + (h)) * HTB)
#define G_SB(b, h) ((4 + (b) * 2 + (h)) * HTB)
#define G_STAGE(bufoff, gbase, voff) do { _Pragma("unroll") for (int _i = 0; _i < 2; ++_i) \
        __builtin_amdgcn_global_load_lds((const unsigned*)((const char*)(gbase) + (voff)[_i]), (LAS unsigned*)(lds + (bufoff) + ldsw + _i * 8192), 16, 0, 0); } while (0)
#define G_LDA(dst, b, h) do { _Pragma("unroll") for (int m = 0; m < 4; ++m) _Pragma("unroll") for (int k = 0; k < 2; ++k) dst[m][k] = *(const LAS bf16x8*)(lds + G_SA(b, h) + aoff + m * 2048 + k * 1024); } while (0)
#define G_LDB(dst, b, h) do { _Pragma("unroll") for (int n = 0; n < 2; ++n) _Pragma("unroll") for (int k = 0; k < 2; ++k) dst[n][k] = *(const LAS bf16x8*)(lds + G_SB(b, h) + boff + n * 2048 + k * 1024); } while (0)
#define G_MMA(ai, bj, At, Bt) do { __builtin_amdgcn_s_setprio(1); _Pragma("unroll") for (int m = 0; m < 4; ++m) _Pragma("unroll") for (int n = 0; n < 2; ++n) _Pragma("unroll") for (int k = 0; k < 2; ++k) \
        acc[ai][bj][m][n] = __builtin_amdgcn_mfma_f32_16x16x32_bf16(Bt[n][k], At[m][k], acc[ai][bj][m][n], 0, 0, 0); __builtin_amdgcn_s_setprio(0); } while (0)
#define G_WAIT_V(n) asm volatile("s_waitcnt vmcnt(" #n ")" ::: "memory")
#define G_WAIT_L(n) asm volatile("s_waitcnt lgkmcnt(" #n ")" ::: "memory")
#define G_BAR __builtin_amdgcn_s_barrier()
#define G_SCHED __builtin_amdgcn_sched_barrier(0)
    Unit cur{}, nxt{}; int ui = 0; const int G = gridDim.x, cb = blockIdx.x;
    if (!D.unit(cb, cur)) return;
    f32x4 acc[2][2][4][2];
#pragma unroll
    for (int a = 0; a < 2; ++a)
#pragma unroll
        for (int b = 0; b < 2; ++b)
#pragma unroll
            for (int m = 0; m < 4; ++m)
#pragma unroll
                for (int n = 0; n < 2; ++n) acc[a][b][m][n] = (f32x4){0.f, 0.f, 0.f, 0.f};
    bf16x8 At[4][2], B0[2][2], B1[2][2];
    const char* cA = (const char*)cur.A; const char* cB = (const char*)cur.B;
    G_STAGE(G_SB(0, 0), cB, voffB); G_STAGE(G_SA(0, 0), cA, voffA); G_STAGE(G_SB(0, 1), cB + hstepB, voffB); G_STAGE(G_SA(0, 1), cA + hstepA, voffA);
    if (wr == 1) G_BAR;
    G_WAIT_V(4); G_BAR;
    G_STAGE(G_SB(1, 0), cB + kstep, voffB); G_STAGE(G_SA(1, 0), cA + kstep, voffA); G_STAGE(G_SB(1, 1), cB + hstepB + kstep, voffB);
    G_WAIT_V(6); G_BAR;
    for (;;) {
        const bool has_next = D.unit((ui + 1) * G + cb, nxt);
        const char* nA = has_next ? (const char*)nxt.A : cA; const char* nB = has_next ? (const char*)nxt.B : cB;
        _Pragma("nounroll") for (int t = 0; t < nt; t += 2) {
            const bool last = (t == nt - 2);
            const char* a1 = cA + (size_t)(t + 1) * kstep;
            const char* a2 = last ? nA : cA + (size_t)(t + 2) * kstep; const char* b2 = last ? nB : cB + (size_t)(t + 2) * kstep;
            const char* a3 = a2 + kstep; const char* b3 = b2 + kstep;
            G_LDB(B0, 0, 0); G_SCHED; G_LDA(At, 0, 0); G_STAGE(G_SA(1, 1), a1 + hstepA, voffA);
            G_WAIT_L(8); G_BAR; G_WAIT_L(0); G_MMA(0, 0, At, B0); G_BAR; G_SCHED;
            G_LDB(B1, 0, 1); G_STAGE(G_SB(0, 0), b2, voffB);
            G_BAR; G_WAIT_L(0); G_MMA(0, 1, At, B1); G_BAR;
            G_LDA(At, 0, 1); G_STAGE(G_SA(0, 0), a2, voffA);
            G_BAR; G_WAIT_L(0); G_MMA(1, 0, At, B0); G_BAR; G_SCHED;
            G_STAGE(G_SB(0, 1), b2 + hstepB, voffB);
            G_WAIT_V(6); G_BAR; G_MMA(1, 1, At, B1); G_BAR;
            G_LDB(B0, 1, 0); G_SCHED; G_LDA(At, 1, 0); G_STAGE(G_SA(0, 1), a2 + hstepA, voffA);
            G_WAIT_L(8); G_BAR; G_WAIT_L(0); G_MMA(0, 0, At, B0); G_BAR; G_SCHED;
            G_LDB(B1, 1, 1); G_STAGE(G_SB(1, 0), b3, voffB);
            G_BAR; G_WAIT_L(0); G_MMA(0, 1, At, B1); G_BAR;
            G_LDA(At, 1, 1); G_STAGE(G_SA(1, 0), a3, voffA);
            G_BAR; G_WAIT_L(0); G_MMA(1, 0, At, B0); G_BAR; G_SCHED;
            G_STAGE(G_SB(1, 1), b3 + hstepB, voffB);
            G_WAIT_V(6); G_BAR; G_MMA(1, 1, At, B1); G_BAR;
        }
        int er_ = wr * 64 + fr, ec_ = wc * 32 + fq * 4; asm volatile("" : "+v"(er_), "+v"(ec_));
#pragma unroll
        for (int m = 0; m < 4; ++m)
#pragma unroll
            for (int n = 0; n < 2; ++n) { D.emit(cur, er_ + m * 16, ec_ + n * 16, acc[0][0][m][n], acc[0][1][m][n], acc[1][0][m][n], acc[1][1][m][n]); if (((m * 2 + n + 1) % Dsc::FENCE) == 0) asm volatile("" ::: "memory"); }
        if (!has_next) break;
#pragma unroll
        for (int a = 0; a < 2; ++a)
#pragma unroll
            for (int b = 0; b < 2; ++b)
#pragma unroll
                for (int m = 0; m < 4; ++m)
#pragma unroll
                    for (int n = 0; n < 2; ++n) acc[a][b][m][n] = (f32x4){0.f, 0.f, 0.f, 0.f};
        cur = nxt; cA = nA; cB = nB; ++ui;
    }
    G_WAIT_V(0);
    if (wr == 0) G_BAR;
    G_BAR;
#undef G_SA
#undef G_SB
#undef G_STAGE
#undef G_LDA
#undef G_LDB
#undef G_MMA
#undef G_WAIT_V
#undef G_WAIT_L
#undef G_BAR
#undef G_SCHED
}

constexpr int A_SHM_V = 64 * 128 * 2, A_SHM_K = 64 * 400;
#define KSWZ(row, colB) ((row) * 400 + (colB))
__device__ __forceinline__ int crow(int r, int hi) { return (r & 3) + 8 * (r >> 2) + 4 * hi; }
__device__ __forceinline__ unsigned cvtpk(float lo, float hi) { unsigned r; asm volatile("v_cvt_pk_bf16_f32 %0, %1, %2" : "=v"(r) : "v"(lo), "v"(hi)); return r; }
__device__ __forceinline__ int v_st(int k, int c) { const int kk = (k & ~0xC) | ((k & 4) << 1) | ((k & 8) >> 1); return ((kk >> 3) * 4 + (c >> 5)) * 512 + ((kk & 7) * 32 + (c & 31)) * 2; }
__device__ __forceinline__ int v_rd_base(int lane) { return ((lane & 3) << 3) | (((lane >> 2) & 3) << 6) | (((lane >> 4) & 1) << 5) | (((lane >> 5) & 1) << 8); }
constexpr int v_rd_off(int d0, int ks, int half) { return d0 * 512 + ks * 4096 + half * 2048; }
template <int OFF> __device__ __forceinline__ s16x4 tr_read(int vb) { s16x4 r; asm volatile("ds_read_b64_tr_b16 %0, %1 offset:%2" : "=&v"(r) : "v"(vb), "i"(OFF) : "memory"); return r; }
template <int D0> __device__ __forceinline__ void pv_one(f32x16& od, int vb, bf16x8 pa0, bf16x8 pa1, bf16x8 pa2, bf16x8 pa3) {
    const s16x4 l0 = tr_read<v_rd_off(D0, 0, 0)>(vb), h0 = tr_read<v_rd_off(D0, 0, 1)>(vb), l1 = tr_read<v_rd_off(D0, 1, 0)>(vb), h1 = tr_read<v_rd_off(D0, 1, 1)>(vb);
    const s16x4 l2 = tr_read<v_rd_off(D0, 2, 0)>(vb), h2 = tr_read<v_rd_off(D0, 2, 1)>(vb), l3 = tr_read<v_rd_off(D0, 3, 0)>(vb), h3 = tr_read<v_rd_off(D0, 3, 1)>(vb);
    asm volatile("s_waitcnt lgkmcnt(0)" ::: "memory"); __builtin_amdgcn_sched_barrier(0);
#define PK(L, H) (bf16x8){L[0], L[1], L[2], L[3], H[0], H[1], H[2], H[3]}
    od = __builtin_amdgcn_mfma_f32_32x32x16_bf16(pa0, PK(l0, h0), od, 0, 0, 0);
    od = __builtin_amdgcn_mfma_f32_32x32x16_bf16(pa1, PK(l1, h1), od, 0, 0, 0);
    od = __builtin_amdgcn_mfma_f32_32x32x16_bf16(pa2, PK(l2, h2), od, 0, 0, 0);
    od = __builtin_amdgcn_mfma_f32_32x32x16_bf16(pa3, PK(l3, h3), od, 0, 0, 0);
#undef PK
}
__device__ __forceinline__ void att_body(const AttItem& a, char* lds) {
    int tid_ = threadIdx.x; asm volatile("" : "+v"(tid_));
    const int tid = tid_, wid = tid >> 6, lane = tid & 63, r32 = lane & 31, hi = lane >> 5;
    char* V_lds = lds; char* K_lds = lds + 2 * A_SHM_V; float* li_l = (float*)(lds + 2 * A_SHM_V + 2 * A_SHM_K) + wid * 64;
    float l_reg = 0.f; f32x16 o[4] = {}; bf16x8 qr[12];
    const u16* Qw = a.q + (size_t)(wid * 32 + r32) * 1536 + hi * 8;
#pragma unroll
    for (int d0 = 0; d0 < 12; ++d0) qr[d0] = *(const bf16x8*)(Qw + d0 * 16);
    const int sr = tid >> 4, sc = (tid & 15) * 8, vst0 = v_st(sr, sc), vst1 = v_st(32 + sr, sc);
    const int voff0 = sr * 1024 + sc, voff1 = (32 + sr) * 1024 + sc;
    int koff[3], kwr[3];
#pragma unroll
    for (int i = 0; i < 3; ++i) { const int id = tid + i * 512, kr_ = id / 24, kc_ = (id % 24) * 8; koff[i] = kr_ * 1536 + kc_; kwr[i] = KSWZ(kr_, kc_ * 2); }
    const int vb0 = (int)(uintptr_t)V_lds + v_rd_base(lane);
    bf16x8 vs0, vs1, ks[3];
    const int NT = a.ntot / 64;
#define A_SLOAD(k0_) do { const int key0_ = (k0_); const u16* kb_ = key0_ < a.n0 ? a.k0 + (size_t)key0_ * 1536 : a.k1 + (size_t)(key0_ - a.n0) * 1536; \
        const u16* vbp_ = key0_ < a.n0 ? a.v0 + (size_t)key0_ * 1024 : a.v1 + (size_t)(key0_ - a.n0) * 1024; \
        vs0 = *(const bf16x8*)(vbp_ + voff0); vs1 = *(const bf16x8*)(vbp_ + voff1); \
        _Pragma("unroll") for (int i = 0; i < 3; ++i) ks[i] = *(const bf16x8*)(kb_ + koff[i]); } while (0)
#define A_SWRITE(b) do { *(bf16x8*)(V_lds + (b) * A_SHM_V + vst0) = vs0; *(bf16x8*)(V_lds + (b) * A_SHM_V + vst1) = vs1; \
        _Pragma("unroll") for (int i = 0; i < 3; ++i) *(bf16x8*)(K_lds + (b) * A_SHM_K + kwr[i]) = ks[i]; } while (0)
    A_SLOAD(0); A_SWRITE(0); __syncthreads();
    constexpr float C = ATT_SCALE * 1.4426950408889634f;
    _Pragma("nounroll") for (int j = 0; j < NT; ++j) {
        const int buf = j & 1;
        if (j + 1 < NT) A_SLOAD((j + 1) * 64);
        f32x16 p0 = {}, p1 = {};
        const char* Ks = K_lds + buf * A_SHM_K;
#pragma unroll
        for (int d0 = 0; d0 < 12; ++d0) { const int cbb = (d0 * 16 + hi * 8) * 2;
            const bf16x8 b0 = *(const bf16x8*)(Ks + KSWZ(r32, cbb)); const bf16x8 b1 = *(const bf16x8*)(Ks + KSWZ(32 + r32, cbb));
            p0 = __builtin_amdgcn_mfma_f32_32x32x16_bf16(b0, qr[d0], p0, 0, 0, 0);
            p1 = __builtin_amdgcn_mfma_f32_32x32x16_bf16(b1, qr[d0], p1, 0, 0, 0); }
        float ps = 0.f;
#pragma unroll
        for (int r = 0; r < 16; ++r) { p0[r] = __builtin_amdgcn_exp2f(p0[r] * C); p1[r] = __builtin_amdgcn_exp2f(p1[r] * C); ps += p0[r] + p1[r]; }
        { auto rr = __builtin_amdgcn_permlane32_swap(__float_as_uint(ps), __float_as_uint(ps), false, false); ps = __uint_as_float(rr[0]) + __uint_as_float(rr[1]); }
        l_reg += ps;
        bf16x8 pa0, pa1, pa2, pa3;
#define PK4(Pv, BASE, OUT) do { unsigned a0 = cvtpk(Pv[BASE + 0], Pv[BASE + 1]), a1 = cvtpk(Pv[BASE + 2], Pv[BASE + 3]); \
        unsigned b0 = cvtpk(Pv[BASE + 4], Pv[BASE + 5]), b1 = cvtpk(Pv[BASE + 6], Pv[BASE + 7]); \
        auto r0 = __builtin_amdgcn_permlane32_swap(a0, b0, false, false); auto r1 = __builtin_amdgcn_permlane32_swap(a1, b1, false, false); \
        u32x4 w = {r0[0], r1[0], r0[1], r1[1]}; OUT = *reinterpret_cast<bf16x8*>(&w); } while (0)
        PK4(p0, 0, pa0); PK4(p0, 8, pa1); PK4(p1, 0, pa2); PK4(p1, 8, pa3);
#undef PK4
        const int vb = vb0 + buf * A_SHM_V;
        pv_one<0>(o[0], vb, pa0, pa1, pa2, pa3); pv_one<1>(o[1], vb, pa0, pa1, pa2, pa3); pv_one<2>(o[2], vb, pa0, pa1, pa2, pa3); pv_one<3>(o[3], vb, pa0, pa1, pa2, pa3);
        if (j + 1 < NT) A_SWRITE(buf ^ 1);
        __syncthreads();
    }
    if (hi == 0) li_l[r32] = l_reg;
    asm volatile("s_waitcnt lgkmcnt(0)" ::: "memory");
    __builtin_amdgcn_wave_barrier();
    u16* Ow = a.o + (size_t)(wid * 32) * 1024;
#pragma unroll
    for (int r = 0; r < 16; ++r) { const int orow = crow(r, hi); const float rl = 1.0f / li_l[orow];
#pragma unroll
        for (int d0 = 0; d0 < 4; ++d0) Ow[(size_t)orow * 1024 + d0 * 32 + r32] = f2bf(o[d0][r] * rl); }
    __syncthreads();
#undef A_SLOAD
#undef A_SWRITE
}

__device__ __forceinline__ float wsum(float v) { for (int o = 32; o >= 1; o >>= 1) v += __shfl_xor(v, o); return v; }
__device__ __forceinline__ void norm_wave(const P& p, int layer, int k, int r, int s5, int lane) {
    const float* x = hsrc(p, r, layer == 0 && k == 0); f32x4 v[4]; float ss = 0.f;
#pragma unroll
    for (int i = 0; i < 4; ++i) { v[i] = *(const f32x4*)(x + i * 256 + lane * 4); ss += v[i][0] * v[i][0] + v[i][1] * v[i][1] + v[i][2] * v[i][2] + v[i][3] * v[i][3]; }
    ss = wsum(ss); const float rinv = rsq_f(ss * (1.0f / 1024.0f) + EPS);
    const float* g = p.in[6] + (size_t)(layer * 3 + k) * 1024; const float* sh = modp(p, layer, r, 3 * k); const float* sc = modp(p, layer, r, 3 * k + 1);
    int row5 = 0, i5 = 0;
    if (s5) { if (r < NL) { const int b = r / SEQ, t = r % SEQ; row5 = b * S5L + t / 32; i5 = t % 32; } else { const int rr = r - NL; const int b = rr / 256, l = rr % 256; row5 = NB * S5L + b * S5C + l / 32; i5 = l % 32; } }
#pragma unroll
    for (int i = 0; i < 4; ++i) { const int d = i * 256 + lane * 4; const f32x4 gv = *(const f32x4*)(g + d), sv = *(const f32x4*)(sc + d), hv = *(const f32x4*)(sh + d); f32x4 o;
        for (int j = 0; j < 4; ++j) o[j] = v[i][j] * rinv * gv[j] * (1.0f + sv[j]) + hv[j];
        if (!s5) st4bf(wsb(p, O_HN) + (size_t)r * 1024 + d, o);
        else st4bf(wsb(p, O_UEXT) + ((size_t)(d >> 4) * NROW5P + row5) * 768 + i5 * 16 + (d & 15), o); } }
__device__ __forceinline__ void mla_row_wave(const P& p, int j, int r, int lane) {
    const float* x = (const float*)(p.ws + O_CALL) + (size_t)r * 768; f32x4 c[3]; float q[3];
#pragma unroll
    for (int i = 0; i < 3; ++i) { c[i] = *(const f32x4*)(x + i * 256 + lane * 4); q[i] = c[i][0] * c[i][0] + c[i][1] * c[i][1] + c[i][2] * c[i][2] + c[i][3] * c[i][3]; }
    const bool lo = lane < 32;
    const float ssq = wsum(q[0] + (lo ? q[1] : 0.f)), sskv = wsum((lo ? 0.f : q[1]) + (lo ? q[2] : 0.f)), ssr = wsum((lane >= 32 && lane < 48) ? q[2] : 0.f);
    const float rq = rsq_f(ssq * (1.0f / 384.0f) + EPS), rkv = rsq_f(sskv * (1.0f / 256.0f) + EPS), rr_ = rsq_f(ssr * (1.0f / 64.0f) + EPS);
    const float* qn = p.in[10] + j * 384; const float* kvn = p.in[11] + j * 256; const float* kg = p.in[15] + j * 192 + 128;
    { const f32x4 gq = *(const f32x4*)(qn + lane * 4); f32x4 o; for (int jx = 0; jx < 4; ++jx) o[jx] = c[0][jx] * rq * gq[jx]; st4bf(wsb(p, O_CQN) + (size_t)r * 384 + lane * 4, o); }
    if (lo) { const f32x4 gq = *(const f32x4*)(qn + 256 + lane * 4); f32x4 o; for (int jx = 0; jx < 4; ++jx) o[jx] = c[1][jx] * rq * gq[jx]; st4bf(wsb(p, O_CQN) + (size_t)r * 384 + 256 + lane * 4, o);
        const f32x4 gk = *(const f32x4*)(kvn + 128 + lane * 4); f32x4 o2; for (int jx = 0; jx < 4; ++jx) o2[jx] = c[2][jx] * rkv * gk[jx]; st4bf(wsb(p, O_CKVN) + (size_t)r * 256 + 128 + lane * 4, o2); }
    else { const f32x4 gk = *(const f32x4*)(kvn + lane * 4 - 128); f32x4 o; for (int jx = 0; jx < 4; ++jx) o[jx] = c[1][jx] * rkv * gk[jx]; st4bf(wsb(p, O_CKVN) + (size_t)r * 256 + lane * 4 - 128, o); }
    const int dd = (4 * (lane - 32)) & 63; const f32x4 gr = *(const f32x4*)(kg + dd); f32x4 own, oth, o;
    for (int jx = 0; jx < 4; ++jx) own[jx] = c[2][jx] * rr_ * gr[jx];
    for (int jx = 0; jx < 4; ++jx) oth[jx] = __shfl_xor(own[jx], 4);
    const int t = r % SEQ, pos = (dd & 32) ? (t % 64) : (t / 64); const bool first = (dd & 16) == 0;
    for (int jx = 0; jx < 4; ++jx) { float cs = 1.f, sn = 0.f; if (r < NL) sincos_t((float)pos * ropef((dd & 15) + jx, 16), sn, cs);
        o[jx] = first ? own[jx] * cs - oth[jx] * sn : own[jx] * cs + oth[jx] * sn; }
    if (lane >= 32 && lane < 48) { u16* kf = wsb(p, O_KF) + (size_t)r * 1536 + 128 + dd;
#pragma unroll
        for (int h = 0; h < 8; ++h) st4bf(kf + h * 192, o); } }
__device__ __forceinline__ float bflo(unsigned w) { return __uint_as_float(w << 16); }
__device__ __forceinline__ float bfhi(unsigned w) { return __uint_as_float(w & 0xffff0000u); }
__device__ __forceinline__ unsigned pk2(float a, float b) { return (unsigned)f2bf(a) | ((unsigned)f2bf(b) << 16); }
__device__ __forceinline__ void mla_head_wave(const P& p, int j, int r, int lane) {
    const int h = lane >> 3, sub = lane & 7;
    u16* q = wsb(p, O_CALL) + (size_t)r * 1536 + h * 192; u16* k = wsb(p, O_KF) + (size_t)r * 1536 + h * 192;
    const float* qg = p.in[14] + j * 192; const float* kg = p.in[15] + j * 192;
    u32x4 qa = *(const u32x4*)(q + sub * 16), qb = *(const u32x4*)(q + sub * 16 + 8), qr = *(const u32x4*)(q + 128 + sub * 8), ka = *(const u32x4*)(k + sub * 16), kb = *(const u32x4*)(k + sub * 16 + 8);
    float sq = 0.f, sk = 0.f, sr = 0.f;
#pragma unroll
    for (int i = 0; i < 4; ++i) { sq += bflo(qa[i]) * bflo(qa[i]) + bfhi(qa[i]) * bfhi(qa[i]) + bflo(qb[i]) * bflo(qb[i]) + bfhi(qb[i]) * bfhi(qb[i]);
        sk += bflo(ka[i]) * bflo(ka[i]) + bfhi(ka[i]) * bfhi(ka[i]) + bflo(kb[i]) * bflo(kb[i]) + bfhi(kb[i]) * bfhi(kb[i]); sr += bflo(qr[i]) * bflo(qr[i]) + bfhi(qr[i]) * bfhi(qr[i]); }
    for (int o = 4; o >= 1; o >>= 1) { sq += __shfl_xor(sq, o); sk += __shfl_xor(sk, o); sr += __shfl_xor(sr, o); }
    const float rq = rsq_f(sq * (1.0f / 128.0f) + EPS), rk = rsq_f(sk * (1.0f / 128.0f) + EPS), rr_ = rsq_f(sr * (1.0f / 64.0f) + EPS);
    u32x4 oa, ob, oka, okb;
#pragma unroll
    for (int i = 0; i < 4; ++i) { const int d = sub * 16 + 2 * i;
        oa[i] = pk2(bflo(qa[i]) * rq * qg[d], bfhi(qa[i]) * rq * qg[d + 1]); ob[i] = pk2(bflo(qb[i]) * rq * qg[d + 8], bfhi(qb[i]) * rq * qg[d + 9]);
        oka[i] = pk2(bflo(ka[i]) * rk * kg[d], bfhi(ka[i]) * rk * kg[d + 1]); okb[i] = pk2(bflo(kb[i]) * rk * kg[d + 8], bfhi(kb[i]) * rk * kg[d + 9]); }
    *(u32x4*)(q + sub * 16) = oa; *(u32x4*)(q + sub * 16 + 8) = ob; *(u32x4*)(k + sub * 16) = oka; *(u32x4*)(k + sub * 16 + 8) = okb;
    const int dd = sub * 8; float own[8], oth[8];
#pragma unroll
    for (int i = 0; i < 4; ++i) { own[2 * i] = bflo(qr[i]) * rr_ * qg[128 + dd + 2 * i]; own[2 * i + 1] = bfhi(qr[i]) * rr_ * qg[128 + dd + 2 * i + 1]; }
#pragma unroll
    for (int i = 0; i < 8; ++i) oth[i] = __shfl_xor(own[i], 2);
    const int t = r % SEQ, pos = (dd & 32) ? (t % 64) : (t / 64); const bool first = (dd & 16) == 0; u32x4 orr; float res[8];
#pragma unroll
    for (int i = 0; i < 8; ++i) { float cs = 1.f, sn = 0.f; if (r < NL) sincos_t((float)pos * ropef((dd & 15) + i, 16), sn, cs); res[i] = first ? own[i] * cs - oth[i] * sn : own[i] * cs + oth[i] * sn; }
#pragma unroll
    for (int i = 0; i < 4; ++i) orr[i] = pk2(res[2 * i], res[2 * i + 1]);
    *(u32x4*)(q + 128 + dd) = orr; }
__device__ __forceinline__ void ret_norm_wave(const P& p, int q, int lr, int lane) {
    const int h = lane >> 4, sub = lane & 15; u16* o = wsb(p, O_OB) + (size_t)lr * 2048 + h * 512 + sub * 32; u16* yd = ret_ydst(p, q, lr) + h * 512 + sub * 32; const u16* g = wsb(p, O_GATE) + (size_t)lr * 2048 + h * 512 + sub * 32; const float* gg = p.in[19] + h * 512 + sub * 32;
    u32x4 ov[4]; float s = 0.f;
#pragma unroll
    for (int i = 0; i < 4; ++i) { ov[i] = *(const u32x4*)(o + i * 8); for (int jx = 0; jx < 4; ++jx) s += bflo(ov[i][jx]) + bfhi(ov[i][jx]); }
    for (int m = 8; m >= 1; m >>= 1) s += __shfl_xor(s, m);
    const float mu = s * (1.0f / 512.0f); float qv = 0.f;
#pragma unroll
    for (int i = 0; i < 4; ++i) for (int jx = 0; jx < 4; ++jx) { const float a = bflo(ov[i][jx]) - mu, b = bfhi(ov[i][jx]) - mu; qv += a * a + b * b; }
    for (int m = 8; m >= 1; m >>= 1) qv += __shfl_xor(qv, m);
    const float rstd = rsq_f(qv * (1.0f / 512.0f) + EPS);
#pragma unroll
    for (int i = 0; i < 4; ++i) { const u32x4 gv = *(const u32x4*)(g + i * 8); u32x4 w;
        for (int jx = 0; jx < 4; ++jx) { const int e = i * 8 + 2 * jx;
            w[jx] = pk2((bflo(ov[i][jx]) - mu) * rstd * gg[e] * silu_f(bflo(gv[jx])), (bfhi(ov[i][jx]) - mu) * rstd * gg[e + 1] * silu_f(bfhi(gv[jx]))); }
        *(u32x4*)(yd + i * 8) = w; } }
__device__ __forceinline__ void mod_phase(const P& p, float* tab) {
    for (int i = threadIdx.x; i < NMR * 1024; i += 512) { const int b = i >> 10, k = i & 1023; tab[i] = silu_f(b < NB ? p.in[1][b * 1024 + k] : p.in[3][k]); }
    __syncthreads();
    for (int idx = blockIdx.x * 512 + threadIdx.x; idx < DEPTH * 9216; idx += gridDim.x * 512) {
        const int layer = idx / 9216, col = idx % 9216; const float* w = p.in[4] + (size_t)layer * 1024 * 9216 + col; float acc[NMR];
#pragma unroll
        for (int b = 0; b < NMR; ++b) acc[b] = 0.f;
        for (int k = 0; k < 1024; ++k) { const float wv = w[(size_t)k * 9216];
#pragma unroll
            for (int b = 0; b < NMR; ++b) acc[b] += tab[b * 1024 + k] * wv; }
        const float bias = p.in[5][layer * 9216 + col];
#pragma unroll
        for (int b = 0; b < NMR; ++b) ((float*)(p.ws + O_MOD))[(size_t)(layer * NMR + b) * 9216 + col] = acc[b] + bias; }
    __syncthreads(); }
#define WPASS(N, HOSTCALL, DEVCALL) do { const int _n = (int)(N); int t0_ = threadIdx.x; asm volatile("" : "+v"(t0_)); const int lane = t0_ & 63; for (int it = blockIdx.x * 8 + (t0_ >> 6); it < _n; it += gridDim.x * 8) { DEVCALL; } } while (0)
#define MODPHASE() mod_phase(p, (float*)shm)
#define NCTXWG ((NC / 256) * 4)
#define MIXED_DOWN_NORM(DESC, LAYER2, KK, S5F, ASHARE) do { int t0_ = threadIdx.x; asm volatile("" : "+v"(t0_)); const int lane = t0_ & 63; int r0_, r1_; \
    if ((int)blockIdx.x < NCTXWG) { gemm_run(lds, DESC); r0_ = (int)blockIdx.x * (ASHARE); r1_ = r0_ + (ASHARE); }     \
    else { const int no_ = (int)gridDim.x - NCTXWG, rest_ = NL - NCTXWG * (ASHARE), per_ = (rest_ + no_ - 1) / no_; r0_ = NCTXWG * (ASHARE) + ((int)blockIdx.x - NCTXWG) * per_; r1_ = r0_ + per_ < NL ? r0_ + per_ : NL; } \
    for (int it = r0_ + (t0_ >> 6); it < r1_; it += 8) norm_wave(p, LAYER2, KK, it, S5F, lane); } while (0)
#define CTXNORM(LAYER2, KK, S5F) do { int t0_ = threadIdx.x; asm volatile("" : "+v"(t0_)); const int lane = t0_ & 63; for (int it = NL + blockIdx.x * 8 + (t0_ >> 6); it < MT; it += gridDim.x * 8) norm_wave(p, LAYER2, KK, it, S5F, lane); } while (0)

#define XB_TMO      128
#define XB_XCNT(j)  (256  + 64 * (j))
#define XB_XSUB(j)  (1280 + 64 * (j))
#define XB_XGEN(j)  (2304 + 64 * (j))
#define XB_TOP      3328
#define XB_TOPGEN   3392
#define XCD_BAR_WORDS 3456
#define XB_SPIN_CAP (1u << 18)
__device__ __forceinline__ unsigned xb_ld(unsigned* p)              { return __hip_atomic_load(p, __ATOMIC_RELAXED, __HIP_MEMORY_SCOPE_AGENT); }
__device__ __forceinline__ unsigned xb_add(unsigned* p, unsigned v) { return __hip_atomic_fetch_add(p, v, __ATOMIC_RELAXED, __HIP_MEMORY_SCOPE_AGENT); }
__device__ __forceinline__ unsigned xb_xcc_id() { return (unsigned)__builtin_amdgcn_s_getreg((3 << 11) | 20) & 0xFu; }
#define XB_SPIN(cond, bar) do { unsigned _sp = 0; while (cond) { __builtin_amdgcn_s_sleep(1); \
    if ((++_sp & 255u) == 0u) { if (xb_ld(&(bar)[XB_TMO])) break; if (_sp > XB_SPIN_CAP) { atomicAdd(&(bar)[XB_TMO], 1u); break; } } } } while (0)
struct XcdBarrier { unsigned* bar; unsigned x; volatile LAS unsigned* st; };
__device__ __forceinline__ XcdBarrier xcd_barrier_post(unsigned* bar, volatile LAS unsigned* st) {
    XcdBarrier b; b.bar = bar; b.x = xb_xcc_id(); b.st = st;
    if (threadIdx.x == 0) (void)xb_add(&bar[XB_XCNT(b.x)], 1u);
    return b; }
__device__ __forceinline__ void xcd_barrier_complete(unsigned* bar, unsigned x, unsigned& nloc, unsigned& nx) {
    const unsigned G = gridDim.x * gridDim.y * gridDim.z; unsigned sum, cnt, mine, sp = 0u;
    for (;;) { sum = 0u; cnt = 0u; mine = 0u;
#pragma unroll
        for (unsigned j = 0; j < 16; ++j) { const unsigned c = xb_ld(&bar[XB_XCNT(j)]); sum += c; cnt += (c > 0u) ? 1u : 0u; mine = (j == x) ? c : mine; }
        if (sum == G) break;
        __builtin_amdgcn_s_sleep(1);
        if ((++sp & 255u) == 0u) { if (xb_ld(&bar[XB_TMO])) break; if (sp > XB_SPIN_CAP) { atomicAdd(&bar[XB_TMO], 1u); break; } } }
    nloc = mine > 0u ? mine : 1u; nx = cnt > 0u ? cnt : 1u; }
__device__ __forceinline__ void xcd_barrier(const XcdBarrier& b) {
    asm volatile("s_waitcnt vmcnt(0)" ::: "memory");
    __syncthreads();
    if (threadIdx.x == 0) {
        unsigned* bar = b.bar;
        __builtin_amdgcn_s_waitcnt(0);
        unsigned nloc = b.st[0], nx = b.st[1];
        if (nloc == 0u) { xcd_barrier_complete(bar, b.x, nloc, nx); b.st[0] = nloc; b.st[1] = nx; }
        const unsigned old = xb_add(&bar[XB_XSUB(b.x)], 1u);
        const unsigned gen = old / nloc;
        if (old + 1u == (gen + 1u) * nloc) {
            __builtin_amdgcn_fence(__ATOMIC_RELEASE, "agent");
            asm volatile("s_waitcnt vmcnt(0)" ::: "memory");
            const unsigned og = xb_add(&bar[XB_TOP], 1u);
            const unsigned tg = og / nx;
            if (og + 1u == (tg + 1u) * nx) xb_add(&bar[XB_TOPGEN], 1u);
            else XB_SPIN(xb_ld(&bar[XB_TOPGEN]) == tg, bar);
            __builtin_amdgcn_fence(__ATOMIC_ACQUIRE, "agent");
            xb_add(&bar[XB_XGEN(b.x)], 1u);
            asm volatile("s_waitcnt vmcnt(0)" ::: "memory");
        } else {
            XB_SPIN(xb_ld(&bar[XB_XGEN(b.x)]) == gen, bar);
            __builtin_amdgcn_fence(__ATOMIC_ACQUIRE, "agent");
            asm volatile("s_waitcnt vmcnt(0)" ::: "memory");
        }
    }
    __syncthreads();
}

namespace cg = cooperative_groups;
#define PASS(N, CALL) do { const long _n = (long)(N); int t0_ = threadIdx.x; asm volatile("" : "+v"(t0_)); for (long it = (long)blockIdx.x * 512 + t0_; it < _n; it += (long)gridDim.x * 512) { CALL; } } while (0)
#define GEMM(D) gemm_run(lds, D)
#define SYNC() xcd_barrier(xb)
#ifndef STAGGER_US
#define STAGGER_US 40
#endif
#define STAGGER(US) do { if ((US) > 0 && (xb.x & 1u)) { const unsigned long long t0_ = __builtin_amdgcn_s_memrealtime(); while (__builtin_amdgcn_s_memrealtime() - t0_ < (unsigned long long)(US) * 100ull) __builtin_amdgcn_s_sleep(8); } } while (0)
#define GRIDSYNC() grid.sync()
#define HOOK(L, S) do { } while (0)
#define ATTN(NITEMS) do { for (int it = blockIdx.x; it < (NITEMS); it += gridDim.x) { AttItem ai_; att_item(p, it, ai_); att_body(ai_, (char*)shm); } } while (0)
#else
template <class Dsc> static void gemm_emu(const Dsc& D) {
    std::vector<int> Ls; for (int c = 0; c < 256; ++c) for (int i = 0;; ++i) { Unit u{}; if (!D.unit(i * 256 + c, u)) break; Ls.push_back(i * 256 + c); }
    const int n = (int)Ls.size();
#pragma omp parallel for schedule(dynamic)
    for (int li = 0; li < n; ++li) { const int L = Ls[li]; Unit u{}; D.unit(L, u); const int K = Dsc::K;
        std::vector<float> A((size_t)256 * K), B((size_t)256 * K), C((size_t)256 * 256);
        for (int r = 0; r < 256; ++r) for (int k = 0; k < K; ++k) { A[(size_t)r * K + k] = bf2f(u.A[(size_t)r * Dsc::lda + k]); B[(size_t)r * K + k] = bf2f(u.B[(size_t)r * Dsc::ldb + k]); }
        for (int r = 0; r < 256; ++r) for (int c = 0; c < 256; ++c) { float s = 0.f; const float* a = &A[(size_t)r * K]; const float* b = &B[(size_t)c * K]; for (int k = 0; k < K; ++k) s += a[k] * b[k]; C[r * 256 + c] = s; }
        for (int r = 0; r < 128; ++r) for (int c = 0; c < 128; c += 4) { f32x4 v[2][2];
            for (int X = 0; X < 2; ++X) for (int Y = 0; Y < 2; ++Y) for (int j = 0; j < 4; ++j) v[X][Y][j] = C[(r + 128 * X) * 256 + c + 128 * Y + j];
            D.emit(u, r, c, v[0][0], v[0][1], v[1][0], v[1][1]); } } }
static void att_emu(const P& p, int nitems) {
#pragma omp parallel for schedule(dynamic)
    for (int it = 0; it < nitems; ++it) { AttItem a; att_item(p, it, a); std::vector<float> s(a.ntot);
        for (int i = 0; i < 256; ++i) { const u16* q = a.q + (size_t)i * 1536; float l = 0.f; float o[128]; for (int e = 0; e < 128; ++e) o[e] = 0.f;
            for (int k = 0; k < a.ntot; ++k) { const u16* kr = k < a.n0 ? a.k0 + (size_t)k * 1536 : a.k1 + (size_t)(k - a.n0) * 1536; float d = 0.f; for (int x = 0; x < 192; ++x) d += bf2f(q[x]) * bf2f(kr[x]);
                const float pv = bf2f(f2bf(expf(d * ATT_SCALE))); l += expf(d * ATT_SCALE); const u16* vr = k < a.n0 ? a.v0 + (size_t)k * 1024 : a.v1 + (size_t)(k - a.n0) * 1024; for (int e = 0; e < 128; ++e) o[e] += pv * bf2f(vr[e]); }
            for (int e = 0; e < 128; ++e) a.o[(size_t)i * 1024 + e] = f2bf(o[e] / l); } } }
#define PASS(N, CALL) do { const long _n = (long)(N); _Pragma("omp parallel for schedule(static)") for (long it = 0; it < _n; ++it) { CALL; } } while (0)
#define WPASS(N, HOSTCALL, DEVCALL) PASS(N, HOSTCALL)
#define MODPHASE() PASS(DEPTH * 9216, mod_item(p, (int)it))
#define MIXED_DOWN_NORM(DESC, LAYER2, KK, S5F, ASHARE) do { gemm_emu(DESC); PASS(NL, norm_item(p, LAYER2, KK, (int)it, S5F)); } while (0)
#define CTXNORM(LAYER2, KK, S5F) PASS(NC, norm_item(p, LAYER2, KK, NL + (int)it, S5F))
#define GEMM(D) gemm_emu(D)
#define SYNC() do { } while (0)
#define STAGGER(US) do { } while (0)
#define GRIDSYNC() do { } while (0)
#define ATTN(NITEMS) att_emu(p, NITEMS)
static void emu_hook(const P& p, int layer, int stage);
#define HOOK(L, S) emu_hook(p, L, S)
#endif

#ifndef HOST_EMU
__global__ void __launch_bounds__(512) fwd_megakernel(P p) {
    extern __shared__ __attribute__((aligned(16))) unsigned char shm[];
    LAS unsigned char* lds = (LAS unsigned char*)shm;
    cg::grid_group grid = cg::this_grid();
    volatile LAS unsigned* xst = (volatile LAS unsigned*)(lds + STAGE_BYTES + 1024);
    if (threadIdx.x == 0) { xst[0] = 0u; xst[1] = 0u; xst[2] = 0u; xst[3] = 0u; }
    __syncthreads();
    const XcdBarrier xb = xcd_barrier_post((unsigned*)(p.ws + O_BAR), xst);
#else
static void fwd_emu(P p) {
#endif
    if (PM(0)) { MODPHASE();
    PASS((long)NC * 256, ((f32x4*)(p.ws + O_G))[it] = ((const f32x4*)p.in[2])[it]);
    PASS(CV_TOTAL, cvt_item(p, it));
    PASS(64 * 2 * 32 * 16, s5_ktab_item(p, (int)it));
    PASS(64 * 256 * 512, s5_fext_item(p, (int)it)); }
    GRIDSYNC();
    if (PM(0)) { PASS((long)64 * 512 * 768, s5_text_item(p, it)); }
    for (int rep_ = 0; rep_ < REP_SYNC; ++rep_) SYNC();
    for (int layer = 0; layer < DEPTH; ++layer) {
        const int kind = layer % 3, j = layer / 3; const bool last = layer == DEPTH - 1;
        if (layer == 0) { if (PM(1)) { WPASS(MT, norm_item(p, layer, 0, (int)it, 0), norm_wave(p, layer, 0, it, 0, lane)); } SYNC(); }
        for (int rep_ = 0; rep_ < REP_UP; ++rep_) { if (PM(2)) { DFfnUp d{p, layer, 0, MT / 256}; GEMM(d); } SYNC(); }
        if (PM(3)) { DFfnDown d{p, layer, 0, NL / 256, 0.5f}; GEMM(d); } SYNC();
        if (PM(3)) { DFfnDown d{p, layer, 0, -1, 0.5f}; MIXED_DOWN_NORM(d, layer, 1, kind == 2 ? 1 : 0, 56); } SYNC();
        if (PM(1)) { CTXNORM(layer, 1, kind == 2 ? 1 : 0); } SYNC();
        if (kind == 0) {
            for (int rep_ = 0; rep_ < REP_MLA; ++rep_) { if (PM(4)) { DMlaIn d{p, j}; GEMM(d); } SYNC(); }
            if (PM(5)) { WPASS(MT, mla_row_item(p, j, (int)it), mla_row_wave(p, j, it, lane)); } SYNC();
            for (int rep_ = 0; rep_ < REP_MLA; ++rep_) { if (PM(6)) { DMlaUq d{p, j, last ? NL / 256 : MT / 256}; GEMM(d); } if (PM(7)) { DMlaUkv d{p, j}; GEMM(d); } SYNC(); }
            if (PM(8)) { WPASS(MT, { for (int h_ = 0; h_ < 8; ++h_) mla_head_item(p, j, (int)it * 8 + h_); }, mla_head_wave(p, j, it, lane)); } SYNC();
            for (int rep_ = 0; rep_ < REP_ATT; ++rep_) { if (PM(9)) { ATTN(NB * 8 * (SEQ / 256) + (last ? 0 : NB * 8)); } SYNC(); }
            if (PM(10)) { DMlaO d{p, layer, j, NL / 256}; GEMM(d); } SYNC();
            if (!last) { if (PM(10)) { DMlaO d{p, layer, j, -1}; MIXED_DOWN_NORM(d, layer, 2, 0, 184); } SYNC();
                if (PM(1)) { CTXNORM(layer, 2, 0); } SYNC(); }
        } else if (kind == 1) {
            for (int q = 0; q < NB / RGB; ++q) {
                for (int rep_ = 0; rep_ < REP_RET; ++rep_) { if (PM(11)) { DRetProjAll d{p, q}; GEMM(d); } SYNC(); }
                for (int rep_ = 0; rep_ < REP_RET; ++rep_) { if (PM(13)) { DRetP d{p}; GEMM(d); } if (PM(14)) { DRetL d{p}; GEMM(d); } SYNC(); }
                if (PM(15)) { PASS(4 * RGB * 512 * 64, ret_prefix_item(p, (int)it)); } SYNC();
                for (int rep_ = 0; rep_ < REP_RET; ++rep_) { if (PM(16)) { DRetO d{p}; GEMM(d); } SYNC(); }
                if (PM(17)) { WPASS(NCQ * 256, { for (int h_ = 0; h_ < 4; ++h_) ret_norm_item(p, q, (int)it * 4 + h_); }, ret_norm_wave(p, q, it, lane)); } SYNC();
                if (PM(18)) { DRetWo d{p, layer, q}; GEMM(d); if (q == NB / RGB - 1) { DRetWoCtx c{p, layer}; GEMM(c); } } SYNC();
            }
        } else {
            for (int rep_ = 0; rep_ < REP_S5; ++rep_) { if (PM(20)) { DS5L d{p}; GEMM(d); } SYNC(); }
            if (PM(21)) { PASS(64 * NB * 64, s5_prefix_item(p, (int)it)); } SYNC();
            for (int rep_ = 0; rep_ < REP_S5; ++rep_) { if (PM(22)) { DS5Y d{p}; GEMM(d); } SYNC(); }
            if (PM(23)) { DS5Glu d{p, layer}; GEMM(d); } SYNC();
        }
        HOOK(layer, 0);
        if (kind != 0 || last) { if (PM(1)) { WPASS(last ? NL : MT, norm_item(p, layer, 2, (int)it, 0), norm_wave(p, layer, 2, it, 0, lane)); } SYNC(); }
        for (int rep_ = 0; rep_ < REP_UP; ++rep_) { if (PM(2)) { DFfnUp d{p, layer, 1, last ? NL / 256 : MT / 256}; GEMM(d); } SYNC(); }
        if (PM(3)) { DFfnDown d{p, layer, 1, NL / 256, 0.5f}; GEMM(d); } SYNC();
        if (!last) { if (PM(3)) { DFfnDown d{p, layer, 1, -1, 0.5f}; MIXED_DOWN_NORM(d, layer + 1, 0, 0, 56); } SYNC();
            if (PM(1)) { CTXNORM(layer + 1, 0, 0); } SYNC(); }
        HOOK(layer, 1);
    }
}

#ifndef HOST_EMU
extern "C" void kernel_launch(void* const* d_in, const int* in_sizes, int n_in, void* d_out, int out_size, void* d_ws, size_t ws_size, hipStream_t stream) {
    constexpr size_t kDynLds = STAGE_BYTES + 4096;
    static int grid_blocks = 0;
    if (!grid_blocks) {
        int dev = 0, cus = 0, per_cu = 0;
        hipGetDevice(&dev);
        hipDeviceGetAttribute(&cus, hipDeviceAttributeMultiprocessorCount, dev);
        hipFuncSetAttribute((const void*)fwd_megakernel, hipFuncAttributeMaxDynamicSharedMemorySize, (int)kDynLds);
        hipOccupancyMaxActiveBlocksPerMultiprocessor(&per_cu, fwd_megakernel, 512, kDynLds);
        if (per_cu < 1) per_cu = 1;
        if (per_cu > 1) per_cu = 1;
        grid_blocks = cus * per_cu;
        if (ws_size < WS_NEED) fprintf(stderr, "workspace too small: %zu < %zu\n", ws_size, (size_t)WS_NEED);
    }
    P p{};
    for (int i = 0; i < 31 && i < n_in; ++i) p.in[i] = (const float*)d_in[i];
    p.out = (float*)d_out; p.ws = (char*)d_ws;
    hipMemsetAsync((char*)d_ws + O_BAR, 0, XCD_BAR_WORDS * 4, stream);
    void* args[] = {&p};
    hipError_t e = hipLaunchCooperativeKernel((void*)fwd_megakernel, dim3(grid_blocks), dim3(512), args, kDynLds, stream);
    if (e != hipSuccess) fprintf(stderr, "cooperative launch failed: %s (grid %d)\n", hipGetErrorString(e), grid_blocks);
}
#endif
```

```cpp
#ifdef HOST_EMU
#include <cmath>
#include <cstdio>
#include <cstdlib>
#include <cstring>
#include <vector>
#define HD inline
#else
#include <hip/hip_runtime.h>
#include <hip/hip_cooperative_groups.h>
#include <cstdio>
#define HD __device__ __forceinline__
#endif

#ifndef CFG_BATCH
#define CFG_BATCH 16
#endif
#ifndef CFG_SEQ
#define CFG_SEQ 4096
#endif

typedef unsigned short u16;
typedef float f32x4 __attribute__((ext_vector_type(4)));
typedef unsigned u32x2 __attribute__((ext_vector_type(2)));

constexpr int DM = 1024, NB = CFG_BATCH, SEQ = CFG_SEQ, CTX = 256, DFF = 2816, DEPTH = 4;
constexpr int NL = NB * SEQ, NC = NB * CTX, MT = NL + NC;
constexpr int NMR = NB + 1;
constexpr int RGB = (NB >= 4) ? 4 : 1;
constexpr int NCH = 1 + SEQ / 256;
constexpr int NCQ = RGB * NCH;
constexpr int S5L = SEQ / 32, S5C = CTX / 32;
constexpr int NROW5 = NB * S5L + NB * S5C;
constexpr int NROW5P = (NROW5 + 255) / 256 * 256;
constexpr float EPS = 1e-6f;

constexpr size_t al(size_t x) { return (x + 255) & ~(size_t)255; }
constexpr size_t O_BAR = 0;
constexpr size_t O_MOD = 16384;
constexpr size_t O_G = O_MOD + al((size_t)DEPTH * NMR * 9216 * 4);
constexpr size_t O_FFI = O_G + al((size_t)NC * 1024 * 4);
constexpr size_t SZ_FFI1 = (size_t)5632 * 1024 * 2, SZ_FFO1 = (size_t)1024 * 2816 * 2;
constexpr size_t O_FFO = O_FFI + 8 * SZ_FFI1;
constexpr size_t O_MWIN = O_FFO + 8 * SZ_FFO1;
constexpr size_t SZ_MWIN = (size_t)768 * 1024 * 2, SZ_MWUQ = (size_t)1536 * 384 * 2, SZ_MWUKV = (size_t)2048 * 256 * 2, SZ_MWO = (size_t)1024 * 1024 * 2;
constexpr size_t O_MWUQ = O_MWIN + 2 * SZ_MWIN;
constexpr size_t O_MWUKV = O_MWUQ + 2 * SZ_MWUQ;
constexpr size_t O_MWO = O_MWUKV + 2 * SZ_MWUKV;
constexpr size_t O_RWIN = O_MWO + 2 * SZ_MWO;
constexpr size_t O_RWO = O_RWIN + (size_t)6144 * 1024 * 2;
constexpr size_t O_GLU = O_RWO + (size_t)1024 * 2048 * 2;
constexpr size_t O_HN = O_GLU + (size_t)2048 * 1024 * 2;
constexpr size_t O_KTAB = O_HN + al((size_t)MT * 1024 * 2);
constexpr size_t O_TEXT = O_KTAB + al((size_t)64 * 2 * 32 * 256 * 4);
constexpr size_t O_FEXT = O_TEXT + al((size_t)64 * 512 * 768 * 2);
constexpr size_t O_SCR = O_FEXT + al((size_t)64 * 256 * 512 * 2);
constexpr size_t O_ACT = O_SCR;
constexpr size_t O_CALL = O_SCR;
constexpr size_t O_CQN = O_CALL + al((size_t)MT * 768 * 4);
constexpr size_t O_CKVN = O_CQN + al((size_t)MT * 384 * 2);
constexpr size_t O_KF = O_CKVN + al((size_t)MT * 256 * 2);
constexpr size_t O_VB = O_KF + al((size_t)MT * 1536 * 2);
constexpr size_t END_MLA = O_VB + al((size_t)MT * 1024 * 2);
constexpr size_t O_QN = O_SCR;
constexpr size_t O_KN = O_QN + al((size_t)NCQ * 256 * 1024 * 2);
constexpr size_t O_GATE = O_KN + al((size_t)NCQ * 256 * 1024 * 2);
constexpr size_t O_OB = O_GATE + al((size_t)NCQ * 256 * 2048 * 2);
constexpr size_t O_AEXT = O_OB + al((size_t)NCQ * 256 * 2048 * 2);
constexpr size_t O_KTX = O_AEXT + al((size_t)4 * NCQ * 256 * 768 * 2);
constexpr size_t O_BEXT = O_KTX + al((size_t)4 * NCQ * 2 * 256 * 256 * 2);
constexpr size_t O_YCTX = O_BEXT + al((size_t)4 * NCQ * 512 * 768 * 2);
constexpr size_t END_RET = O_YCTX + al((size_t)NC * 2048 * 2);
constexpr size_t O_UEXT = O_SCR;
constexpr size_t END_S5 = O_UEXT + al((size_t)64 * NROW5P * 768 * 2);
constexpr size_t END_FFN = O_ACT + al((size_t)MT * 2816 * 2);
constexpr size_t cmax(size_t a, size_t b) { return a > b ? a : b; }
constexpr size_t WS_NEED = cmax(cmax(END_MLA, END_RET), cmax(END_S5, END_FFN));

struct P { const float* in[32]; float* out; char* ws; };
#ifndef PHASE_MASK
#define PHASE_MASK 0xFFFFFFFFu
#endif
#define PM(b) ((PHASE_MASK >> (b)) & 1u)
#ifndef REP_UP
#define REP_UP 1
#endif
#ifndef REP_ATT
#define REP_ATT 1
#endif
#ifndef REP_NORM
#define REP_NORM 1
#endif
#ifndef REP_RET
#define REP_RET 1
#endif
#ifndef REP_DOWN
#define REP_DOWN 1
#endif
#ifndef REP_MLA
#define REP_MLA 1
#endif
#ifndef REP_S5
#define REP_S5 1
#endif
#ifndef REP_SYNC
#define REP_SYNC 0
#endif

HD float bf2f(u16 b) { union { unsigned u; float f; } x; x.u = ((unsigned)b) << 16; return x.f; }
HD u16 f2bf(float f) { union { unsigned u; float f; } x; x.f = f; unsigned u = x.u; u += 0x7fffu + ((u >> 16) & 1u); return (u16)(u >> 16); }
#ifdef HOST_EMU
HD void st4bf(u16* p, f32x4 v) { u32x2 w; w.x = (unsigned)f2bf(v[0]) | ((unsigned)f2bf(v[1]) << 16); w.y = (unsigned)f2bf(v[2]) | ((unsigned)f2bf(v[3]) << 16); *(u32x2*)p = w; }
#else
HD unsigned cvtpk_bf(float lo, float hi) { unsigned r; asm("v_cvt_pk_bf16_f32 %0, %1, %2" : "=v"(r) : "v"(lo), "v"(hi)); return r; }
HD void st4bf(u16* p, f32x4 v) { u32x2 w; w.x = cvtpk_bf(v[0], v[1]); w.y = cvtpk_bf(v[2], v[3]); *(u32x2*)p = w; }
#endif
#ifdef HOST_EMU
HD float silu_f(float a) { return a / (1.0f + expf(-a)); }
HD float sigm_f(float a) { return 1.0f / (1.0f + expf(-a)); }
HD float gelu_f(float x) { return 0.5f * x * (1.0f + tanhf(0.7978845608028654f * (x + 0.044715f * x * x * x))); }
#else
HD float sigm_f(float a) { return __builtin_amdgcn_rcpf(1.0f + __builtin_amdgcn_exp2f(-1.4426950408889634f * a)); }
HD float silu_f(float a) { return a * sigm_f(a); }
HD float gelu_f(float x) { return x * sigm_f(1.5957691216057308f * (x + 0.044715f * x * x * x)); }
#endif
HD float rsq_f(float x) { return 1.0f / sqrtf(x); }
HD float ex2(float x) {
#ifdef HOST_EMU
    return exp2f(x);
#else
    return __builtin_amdgcn_exp2f(x);
#endif
}
HD const float* hsrc(const P& p, int r, int first) { if (first && r < NL) return p.in[0] + (size_t)r * 1024; return r < NL ? p.out + (size_t)r * 1024 : (const float*)(p.ws + O_G) + (size_t)(r - NL) * 1024; }
HD float* hrow(const P& p, int r) { return r < NL ? p.out + (size_t)r * 1024 : (float*)(p.ws + O_G) + (size_t)(r - NL) * 1024; }
HD const float* modp(const P& p, int layer, int r, int idx) { const int mr = r < NL ? r / SEQ : NB; return (const float*)(p.ws + O_MOD) + ((size_t)(layer * NMR + mr) * 9 + idx) * 1024; }
HD u16* wsb(const P& p, size_t off) { return (u16*)(p.ws + off); }
#ifdef HOST_EMU
HD float ropef(int d, int half) { return expf(-(float)d * (9.210340371976184f / (float)half)) * 0.15915494309189535f; }
#else
HD float ropef(int d, int half) { return __builtin_amdgcn_exp2f(-(float)d * (13.287712379549449f / (float)half)) * 0.15915494309189535f; }
#endif
HD void sincos_t(float turns, float& sn, float& cs) {
    const float f = turns - floorf(turns);
#ifdef HOST_EMU
    sn = sinf(6.283185307179586f * f); cs = cosf(6.283185307179586f * f);
#else
    sn = __builtin_amdgcn_sinf(f); cs = __builtin_amdgcn_cosf(f);
#endif
}

HD bool rect_unit(int L, int nM, int nN, int& pm, int& pn) {
    const int nwg = nM * nN; if (L >= nwg) return false;
    int wgid = L; { const int q = nwg / 8, r = nwg % 8, xcd = wgid % 8, off = wgid / 8; wgid = (xcd < r ? xcd * (q + 1) : r * (q + 1) + (xcd - r) * q) + off; }
    const int nig = 8 * nN, gid = wgid / nig, fm = gid * 8, gsz = (nM - fm) < 8 ? (nM - fm) : 8;
    pm = fm + ((wgid % nig) % gsz); pn = (wgid % nig) / gsz; return true;
}

struct Unit { const u16* A; const u16* B; int a, b, c, d; float f0, f1; };

struct DFfnUp { P p; int layer, f, nM; static constexpr int FENCE = 1; static constexpr int K = 1024, lda = 1024, ldb = 1024;
    HD bool unit(int L, Unit& u) const { int pm, pn; if (!rect_unit(L, nM, 22, pm, pn)) return false;
        u.A = wsb(p, O_HN) + (size_t)pm * 256 * 1024; u.B = wsb(p, O_FFI + (size_t)(layer * 2 + f) * SZ_FFI1) + (size_t)pn * 256 * 1024; u.a = pm; u.b = pn; u.c = 0; u.d = 0; return true; }
    HD void emit(const Unit& u, int r, int c, f32x4 v00, f32x4 v01, f32x4 v10, f32x4 v11) const {
        u16* act = wsb(p, O_ACT); const size_t R = (size_t)u.a * 256 + r; const int col = u.b * 128 + c; f32x4 o0, o1;
        for (int j = 0; j < 4; ++j) { o0[j] = silu_f(v00[j]) * v01[j]; o1[j] = silu_f(v10[j]) * v11[j]; }
        st4bf(act + R * 2816 + col, o0); st4bf(act + (R + 128) * 2816 + col, o1); } };

HD void resid4(const P& p, int layer, int midx, float sc, int R, int col, f32x4 v, int first = 0) {
    float* h = hrow(p, R) + col; const float* m = modp(p, layer, R, midx) + col; f32x4 x = *(const f32x4*)(hsrc(p, R, first) + col);
    for (int j = 0; j < 4; ++j) x[j] += sc * m[j] * v[j];
    *(f32x4*)h = x; }

struct DFfnDown { P p; int layer, f, nM; float sc; static constexpr int FENCE = 4; static constexpr int K = 2816, lda = 2816, ldb = 2816;
    HD bool unit(int L, Unit& u) const { int pm, pn;
        if (nM < 0) { if (L >= (NC / 256) * 4) return false; pm = NL / 256 + (L >> 2); pn = L & 3; }
        else if (((NL / 256) * 4) % 256 == 0 && nM > NL / 256) {
            if (L < (NL / 256) * 4) rect_unit(L, NL / 256, 4, pm, pn);
            else { const int c = L - (NL / 256) * 4; if (c >= 128 || (c & 1)) return false; const int k = c >> 1; pm = NL / 256 + (k >> 2); pn = k & 3; if (pm >= nM) return false; } }
        else if (!rect_unit(L, nM, 4, pm, pn)) return false;
        u.A = wsb(p, O_ACT) + (size_t)pm * 256 * 2816; u.B = wsb(p, O_FFO + (size_t)(layer * 2 + f) * SZ_FFO1) + (size_t)pn * 256 * 2816; u.a = pm; u.b = pn; u.c = 0; u.d = 0; return true; }
    HD void emit(const Unit& u, int r, int c, f32x4 v00, f32x4 v01, f32x4 v10, f32x4 v11) const {
        const int R = u.a * 256 + r, col = u.b * 256 + c, mi = f ? 8 : 2;
        const int first = (layer == 0 && f == 0 && sc != 0.f);
        resid4(p, layer, mi, sc, R, col, v00, first); resid4(p, layer, mi, sc, R, col + 128, v01, first); resid4(p, layer, mi, sc, R + 128, col, v10, first); resid4(p, layer, mi, sc, R + 128, col + 128, v11, first); } };
HD void atom4(float* g, const float* m, float sc, f32x4 v) {
#ifdef HOST_EMU
    for (int j = 0; j < 4; ++j) {
#pragma omp atomic
        g[j] += sc * m[j] * v[j]; }
#else
    for (int j = 0; j < 4; ++j) unsafeAtomicAdd(g + j, sc * m[j] * v[j]);
#endif
}
template <int KS, int SL0> struct DFfnDownCtx { P p; int layer, f; float sc; static constexpr int FENCE = 4; static constexpr int K = KS, lda = 2816, ldb = 2816;
    HD bool unit(int L, Unit& u) const { if (L >= 256) return false; const int x = SL0 ? (L + 128) % 256 : L; if (x >= 128 || x >= (NC / 256) * 8) return false;
        const int sl = x & 1, pn = (x >> 1) & 3, pm = NL / 256 + (x >> 3); const int k0 = SL0 ? 1536 + sl * 640 : sl * 768;
        u.A = wsb(p, O_ACT) + (size_t)pm * 256 * 2816 + k0; u.B = wsb(p, O_FFO + (size_t)(layer * 2 + f) * SZ_FFO1) + (size_t)pn * 256 * 2816 + k0; u.a = pm; u.b = pn; u.c = 0; u.d = 0; return true; }
    HD void one(int R, int col, f32x4 v) const { atom4(hrow(p, R) + col, modp(p, layer, R, f ? 8 : 2) + col, sc, v); }
    HD void emit(const Unit& u, int r, int c, f32x4 v00, f32x4 v01, f32x4 v10, f32x4 v11) const {
        const int R = u.a * 256 + r, col = u.b * 256 + c; one(R, col, v00); one(R, col + 128, v01); one(R + 128, col, v10); one(R + 128, col + 128, v11); } };

struct DMlaIn { P p; int j; static constexpr int FENCE = 1; static constexpr int K = 1024, lda = 1024, ldb = 1024;
    HD bool unit(int L, Unit& u) const { int pm, pn; if (!rect_unit(L, MT / 256, 3, pm, pn)) return false;
        u.A = wsb(p, O_HN) + (size_t)pm * 256 * 1024; u.B = wsb(p, O_MWIN + j * SZ_MWIN) + (size_t)pn * 256 * 1024; u.a = pm; u.b = pn; u.c = 0; u.d = 0; return true; }
    HD void emit(const Unit& u, int r, int c, f32x4 v00, f32x4 v01, f32x4 v10, f32x4 v11) const {
        float* o = (float*)(p.ws + O_CALL) + ((size_t)u.a * 256 + r) * 768 + u.b * 256 + c;
        *(f32x4*)o = v00; *(f32x4*)(o + 128) = v01; *(f32x4*)(o + (size_t)128 * 768) = v10; *(f32x4*)(o + (size_t)128 * 768 + 128) = v11; } };
struct DMlaUq { P p; int j, nM; static constexpr int FENCE = 1; static constexpr int K = 384, lda = 384, ldb = 384;
    HD bool unit(int L, Unit& u) const { int pm, pn; if (!rect_unit(L, nM, 6, pm, pn)) return false;
        u.A = wsb(p, O_CQN) + (size_t)pm * 256 * 384; u.B = wsb(p, O_MWUQ + j * SZ_MWUQ) + (size_t)pn * 256 * 384; u.a = pm; u.b = pn; u.c = 0; u.d = 0; return true; }
    HD void emit(const Unit& u, int r, int c, f32x4 v00, f32x4 v01, f32x4 v10, f32x4 v11) const {
        u16* o = wsb(p, O_CALL) + ((size_t)u.a * 256 + r) * 1536 + u.b * 256 + c;
        st4bf(o, v00); st4bf(o + 128, v01); st4bf(o + (size_t)128 * 1536, v10); st4bf(o + (size_t)128 * 1536 + 128, v11); } };
struct DMlaUkv { P p; int j; static constexpr int FENCE = 1; static constexpr int K = 256, lda = 256, ldb = 256;
    HD bool unit(int L, Unit& u) const { int pm, pn; if (!rect_unit(L, MT / 256, 8, pm, pn)) return false;
        u.A = wsb(p, O_CKVN) + (size_t)pm * 256 * 256; u.B = wsb(p, O_MWUKV + j * SZ_MWUKV) + (size_t)pn * 256 * 256; u.a = pm; u.b = pn; u.c = 0; u.d = 0; return true; }
    HD void one(size_t R, int col, f32x4 v) const {
        if (col < 1024) st4bf(wsb(p, O_KF) + R * 1536 + (col >> 7) * 192 + (col & 127), v);
        else st4bf(wsb(p, O_VB) + R * 1024 + (col - 1024), v); }
    HD void emit(const Unit& u, int r, int c, f32x4 v00, f32x4 v01, f32x4 v10, f32x4 v11) const {
        const size_t R = (size_t)u.a * 256 + r; const int col = u.b * 256 + c;
        one(R, col, v00); one(R, col + 128, v01); one(R + 128, col, v10); one(R + 128, col + 128, v11); } };
struct DMlaO { P p; int layer, j, nM; static constexpr int FENCE = 4; static constexpr int K = 1024, lda = 1024, ldb = 1024;
    HD bool unit(int L, Unit& u) const { int pm, pn;
        if (nM < 0) { if (L >= (NC / 256) * 4) return false; pm = NL / 256 + (L >> 2); pn = L & 3; }
        else if (!rect_unit(L, nM, 4, pm, pn)) return false;
        u.A = wsb(p, O_HN) + (size_t)pm * 256 * 1024; u.B = wsb(p, O_MWO + j * SZ_MWO) + (size_t)pn * 256 * 1024; u.a = pm; u.b = pn; u.c = 0; u.d = 0; return true; }
    HD void emit(const Unit& u, int r, int c, f32x4 v00, f32x4 v01, f32x4 v10, f32x4 v11) const {
        const int R = u.a * 256 + r, col = u.b * 256 + c;
        resid4(p, layer, 5, 1.0f, R, col, v00); resid4(p, layer, 5, 1.0f, R, col + 128, v01); resid4(p, layer, 5, 1.0f, R + 128, col, v10); resid4(p, layer, 5, 1.0f, R + 128, col + 128, v11); } };

HD int ret_tokrow(int q, int cidx) { const int b = q * RGB + cidx / NCH, n = cidx % NCH; return n == 0 ? NL + b * 256 : b * SEQ + (n - 1) * 256; }
HD float ret_logg(const P& p, int dir, int h) { return log1pf(-expf(p.in[18][dir * 4 + h])); }
struct DRetProj { P p; int q; static constexpr int FENCE = 1; static constexpr int K = 1024, lda = 1024, ldb = 1024;
    HD bool unit(int L, Unit& u) const { int pm, pn; if (!rect_unit(L, NCQ, 16, pm, pn)) return false;
        const int wrow = pn < 8 ? pn * 256 : 4096 + (pn - 8) * 256;
        u.A = wsb(p, O_HN) + (size_t)ret_tokrow(q, pm) * 1024; u.B = wsb(p, O_RWIN) + (size_t)wrow * 1024; u.a = pm; u.b = pn; u.c = 0; u.d = 0;
        u.f0 = ret_logg(p, 0, pn & 3) * 1.4426950408889634f; u.f1 = ret_logg(p, 1, pn & 3) * 1.4426950408889634f; return true; }
    HD void emit(const Unit& u, int r, int c, f32x4 v00, f32x4 v01, f32x4 v10, f32x4 v11) const {
        const int cidx = u.a, pn = u.b, n = cidx % NCH;
        if (pn >= 8) { u16* g = wsb(p, O_GATE) + ((size_t)cidx * 256 + r) * 2048 + (pn - 8) * 256 + c;
            st4bf(g, v00); st4bf(g + 128, v01); st4bf(g + (size_t)128 * 2048, v10); st4bf(g + (size_t)128 * 2048 + 128, v11); return; }
        const int h = pn & 3; const bool isq = pn < 4;
        const float lgf = u.f0, lgb = u.f1;
        for (int X = 0; X < 2; ++X) { const int i = r + 128 * X; const f32x4 x1 = X ? v10 : v00, x2 = X ? v11 : v01; f32x4 r1, r2;
            for (int jx = 0; jx < 4; ++jx) { float cs = 1.f, sn = 0.f;
                if (n > 0) sincos_t((float)((n - 1) * 256 + i) * ropef(c + jx, 128), sn, cs);
                r1[jx] = x1[jx] * cs - x2[jx] * sn; r2[jx] = x2[jx] * cs + x1[jx] * sn; }
            if (isq) { u16* qn = wsb(p, O_QN) + ((size_t)cidx * 256 + i) * 1024 + h * 256 + c; st4bf(qn, r1); st4bf(qn + 128, r2);
                const float df = ex2(lgf * (float)(i + 1)), db = ex2(lgb * (float)(256 - i));
                u16* ae = wsb(p, O_AEXT) + (((size_t)h * NCQ + cidx) * 256 + i) * 768;
                st4bf(ae + 256 + c, r1 * df); st4bf(ae + 384 + c, r2 * df); st4bf(ae + 512 + c, r1 * db); st4bf(ae + 640 + c, r2 * db); }
            else { u16* kn = wsb(p, O_KN) + ((size_t)cidx * 256 + i) * 1024 + h * 256 + c; st4bf(kn, r1 * 0.0625f); st4bf(kn + 128, r2 * 0.0625f); } } } };
struct DRetProjT { P p; int q; static constexpr int FENCE = 1; static constexpr int K = 1024, lda = 1024, ldb = 1024;
    HD bool unit(int L, Unit& u) const { int pm, pn; if (!rect_unit(L, 12, NCQ, pm, pn)) return false;
        u.A = wsb(p, O_RWIN) + (size_t)(1024 + pm * 256) * 1024; u.B = wsb(p, O_HN) + (size_t)ret_tokrow(q, pn) * 1024; u.a = pm; u.b = pn; u.c = 0; u.d = 0;
        u.f0 = ret_logg(p, 0, pm & 3) * 1.4426950408889634f; u.f1 = ret_logg(p, 1, pm & 3) * 1.4426950408889634f; return true; }
    HD void emit(const Unit& u, int r, int c, f32x4 v00, f32x4 v01, f32x4 v10, f32x4 v11) const {
        const int pm = u.a, cidx = u.b, n = cidx % NCH;
        if (pm >= 4) { const int h = (pm - 4) >> 1, e0 = ((pm - 4) & 1) * 256 + r; u16* be = wsb(p, O_BEXT) + (((size_t)h * NCQ + cidx) * 512 + e0) * 768 + c;
            st4bf(be, v00); st4bf(be + 128, v01); st4bf(be + (size_t)128 * 768, v10); st4bf(be + (size_t)128 * 768 + 128, v11); return; }
        const int h = pm; const float lgf = u.f0, lgb = u.f1, fr = ropef(r, 128);
        u16* kf = wsb(p, O_KTX) + (((size_t)h * NCQ + cidx) * 2 + 0) * 65536; u16* kb = kf + 65536;
        for (int Y = 0; Y < 2; ++Y) { const f32x4 x1 = Y ? v01 : v00, x2 = Y ? v11 : v10; f32x4 f1, f2, b1, b2;
            for (int jx = 0; jx < 4; ++jx) { const int jj = c + 128 * Y + jx; float cs = 1.f, sn = 0.f;
                if (n > 0) sincos_t((float)((n - 1) * 256 + jj) * fr, sn, cs);
                const float r1 = (x1[jx] * cs - x2[jx] * sn) * 0.0625f, r2 = (x2[jx] * cs + x1[jx] * sn) * 0.0625f;
                const float df = ex2(lgf * (float)(255 - jj)), db = ex2(lgb * (float)jj);
                f1[jx] = r1 * df; f2[jx] = r2 * df; b1[jx] = r1 * db; b2[jx] = r2 * db; }
            const int jc = c + 128 * Y;
            st4bf(kf + (size_t)r * 256 + jc, f1); st4bf(kf + (size_t)(r + 128) * 256 + jc, f2); st4bf(kb + (size_t)r * 256 + jc, b1); st4bf(kb + (size_t)(r + 128) * 256 + jc, b2); } } };
struct DRetProjAll { P p; int q; static constexpr int FENCE = 1; static constexpr int K = 1024, lda = 1024, ldb = 1024;
    HD bool unit(int L, Unit& u) const { const DRetProj a{p, q}; const DRetProjT b{p, q};
        if (L < NCQ * 16) { const bool ok = a.unit(L, u); u.d = 0; return ok; } const bool ok = b.unit(L - NCQ * 16, u); u.d = 1; return ok; }
    HD void emit(const Unit& u, int r, int c, f32x4 v00, f32x4 v01, f32x4 v10, f32x4 v11) const {
        if (u.d == 0) { const DRetProj a{p, q}; a.emit(u, r, c, v00, v01, v10, v11); } else { const DRetProjT b{p, q}; b.emit(u, r, c, v00, v01, v10, v11); } } };
struct DRetP { P p; static constexpr int FENCE = 1; static constexpr int K = 256, lda = 1024, ldb = 1024;
    HD bool unit(int L, Unit& u) const { int pm, pn; if (!rect_unit(L, NCQ, 4, pm, pn)) return false;
        u.A = wsb(p, O_QN) + (size_t)pm * 256 * 1024 + pn * 256; u.B = wsb(p, O_KN) + (size_t)pm * 256 * 1024 + pn * 256; u.a = pm; u.b = pn; u.c = 0; u.d = 0;
        u.f0 = ret_logg(p, 0, pn) * 1.4426950408889634f; u.f1 = ret_logg(p, 1, pn) * 1.4426950408889634f; return true; }
    HD void one(u16* ae, float lgf, float lgb, int i, int j0, f32x4 v) const { f32x4 o;
        for (int jx = 0; jx < 4; ++jx) { const int jj = j0 + jx; o[jx] = v[jx] * ex2(jj <= i ? lgf * (float)(i - jj) : lgb * (float)(jj - i)); }
        st4bf(ae + (size_t)i * 768 + j0, o); }
    HD void emit(const Unit& u, int r, int c, f32x4 v00, f32x4 v01, f32x4 v10, f32x4 v11) const {
        const int cidx = u.a, h = u.b; const float lgf = u.f0, lgb = u.f1;
        u16* ae = wsb(p, O_AEXT) + ((size_t)h * NCQ + cidx) * 256 * 768;
        one(ae, lgf, lgb, r, c, v00); one(ae, lgf, lgb, r, c + 128, v01); one(ae, lgf, lgb, r + 128, c, v10); one(ae, lgf, lgb, r + 128, c + 128, v11); } };
struct DRetL { P p; static constexpr int FENCE = 1; static constexpr int K = 256, lda = 768, ldb = 256;
    HD bool unit(int L, Unit& u) const { int pm, pn; if (!rect_unit(L, 4 * NCQ, 4, pm, pn)) return false;
        const int dir = pn >> 1, eh = pn & 1;
        u.A = wsb(p, O_BEXT) + ((size_t)pm * 512 + eh * 256) * 768; u.B = wsb(p, O_KTX) + ((size_t)pm * 2 + dir) * 65536; u.a = pm; u.b = dir; u.c = eh; u.d = 0; return true; }
    HD void emit(const Unit& u, int r, int c, f32x4 v00, f32x4 v01, f32x4 v10, f32x4 v11) const {
        u16* o = wsb(p, O_BEXT) + ((size_t)u.a * 512 + u.c * 256 + r) * 768 + 256 + u.b * 256 + c;
        st4bf(o, v00); st4bf(o + 128, v01); st4bf(o + (size_t)128 * 768, v10); st4bf(o + (size_t)128 * 768 + 128, v11); } };
struct DRetO { P p; static constexpr int FENCE = 1; static constexpr int K = 768, lda = 768, ldb = 768;
    HD bool unit(int L, Unit& u) const { int pm, pn; if (!rect_unit(L, 4 * NCQ, 2, pm, pn)) return false;
        u.A = wsb(p, O_AEXT) + (size_t)pm * 256 * 768; u.B = wsb(p, O_BEXT) + ((size_t)pm * 512 + pn * 256) * 768; u.a = pm; u.b = pn; u.c = 0; u.d = 0; return true; }
    HD void emit(const Unit& u, int r, int c, f32x4 v00, f32x4 v01, f32x4 v10, f32x4 v11) const {
        const int h = u.a / NCQ, cidx = u.a % NCQ;
        u16* o = wsb(p, O_OB) + ((size_t)cidx * 256 + r) * 2048 + h * 512 + u.b * 256 + c;
        st4bf(o, v00); st4bf(o + 128, v01); st4bf(o + (size_t)128 * 2048, v10); st4bf(o + (size_t)128 * 2048 + 128, v11); } };
struct DRetWoCtx { P p; int layer; static constexpr int FENCE = 4; static constexpr int K = 2048, lda = 2048, ldb = 2048;
    HD bool unit(int L, Unit& u) const { int pm, pn; if (!rect_unit(L, NC / 256, 4, pm, pn)) return false;
        u.A = wsb(p, O_YCTX) + (size_t)pm * 256 * 2048; u.B = wsb(p, O_RWO) + (size_t)pn * 256 * 2048; u.a = NL + pm * 256; u.b = pn; u.c = 0; u.d = 0; return true; }
    HD void emit(const Unit& u, int r, int c, f32x4 v00, f32x4 v01, f32x4 v10, f32x4 v11) const {
        const int R = u.a + r, col = u.b * 256 + c;
        resid4(p, layer, 5, 1.0f, R, col, v00); resid4(p, layer, 5, 1.0f, R, col + 128, v01); resid4(p, layer, 5, 1.0f, R + 128, col, v10); resid4(p, layer, 5, 1.0f, R + 128, col + 128, v11); } };
struct DRetWo { P p; int layer, q; static constexpr int FENCE = 4; static constexpr int K = 2048, lda = 2048, ldb = 2048;
    HD bool unit(int L, Unit& u) const { int pl, pn; if (!rect_unit(L, NCQ - RGB, 4, pl, pn)) return false; const int pm = pl + pl / (NCH - 1) + 1;
        u.A = wsb(p, O_OB) + (size_t)pm * 256 * 2048; u.B = wsb(p, O_RWO) + (size_t)pn * 256 * 2048; u.a = ret_tokrow(q, pm); u.b = pn; u.c = 0; u.d = 0; return true; }
    HD void emit(const Unit& u, int r, int c, f32x4 v00, f32x4 v01, f32x4 v10, f32x4 v11) const {
        const int R = u.a + r, col = u.b * 256 + c;
        resid4(p, layer, 5, 1.0f, R, col, v00); resid4(p, layer, 5, 1.0f, R, col + 128, v01); resid4(p, layer, 5, 1.0f, R + 128, col, v10); resid4(p, layer, 5, 1.0f, R + 128, col + 128, v11); } };

struct DS5L { P p; static constexpr int FENCE = 1; static constexpr int K = 512, lda = 768, ldb = 512;
    HD bool unit(int L, Unit& u) const { int pm, pn; if (!rect_unit(L, NROW5P / 256, 64, pm, pn)) return false;
        u.A = wsb(p, O_UEXT) + ((size_t)pn * NROW5P + pm * 256) * 768; u.B = wsb(p, O_FEXT) + (size_t)pn * 256 * 512; u.a = pm; u.b = pn; u.c = 0; u.d = 0; return true; }
    HD void emit(const Unit& u, int r, int c, f32x4 v00, f32x4 v01, f32x4 v10, f32x4 v11) const {
        u16* o = wsb(p, O_UEXT) + ((size_t)u.b * NROW5P + u.a * 256 + r) * 768 + 512 + c;
        st4bf(o, v00); st4bf(o + 128, v01); st4bf(o + (size_t)128 * 768, v10); st4bf(o + (size_t)128 * 768 + 128, v11); } };
struct DS5Y { P p; static constexpr int FENCE = 1; static constexpr int K = 768, lda = 768, ldb = 768;
    HD bool unit(int L, Unit& u) const { int pm, pn; if (!rect_unit(L, NROW5P / 256, 128, pm, pn)) return false;
        const int g = pn >> 1, ch = pn & 1;
        u.A = wsb(p, O_UEXT) + ((size_t)g * NROW5P + pm * 256) * 768; u.B = wsb(p, O_TEXT) + ((size_t)g * 512 + ch * 256) * 768; u.a = pm; u.b = g; u.c = ch; u.d = 0; return true; }
    HD void one(int g, int row, int col, f32x4 v) const {
        int tok; if (row < NB * S5L) tok = (row / S5L) * SEQ + (row % S5L) * 32; else if (row < NROW5) { const int rr = row - NB * S5L; tok = NL + (rr / S5C) * 256 + (rr % S5C) * 32; } else return;
        f32x4 o; for (int jx = 0; jx < 4; ++jx) o[jx] = gelu_f(v[jx]);
        st4bf(wsb(p, O_HN) + (size_t)(tok + (col >> 4)) * 1024 + g * 16 + (col & 15), o); }
    HD void emit(const Unit& u, int r, int c, f32x4 v00, f32x4 v01, f32x4 v10, f32x4 v11) const {
        const int row = u.a * 256 + r, col = u.c * 256 + c;
        one(u.b, row, col, v00); one(u.b, row, col + 128, v01); one(u.b, row + 128, col, v10); one(u.b, row + 128, col + 128, v11); } };
struct DS5Glu { P p; int layer; static constexpr int FENCE = 4; static constexpr int K = 1024, lda = 1024, ldb = 1024;
    HD bool unit(int L, Unit& u) const { int pm, pn; if (!rect_unit(L, MT / 256, 8, pm, pn)) return false;
        u.A = wsb(p, O_HN) + (size_t)pm * 256 * 1024; u.B = wsb(p, O_GLU) + (size_t)pn * 256 * 1024; u.a = pm; u.b = pn; u.c = 0; u.d = 0; return true; }
    HD void emit(const Unit& u, int r, int c, f32x4 v00, f32x4 v01, f32x4 v10, f32x4 v11) const {
        const int col = u.b * 128 + c; const float* gb = p.in[30]; f32x4 y0, y1;
        for (int jx = 0; jx < 4; ++jx) { const float ba = gb[col + jx], bg = gb[1024 + col + jx];
            y0[jx] = (v00[jx] + ba) * sigm_f(v01[jx] + bg); y1[jx] = (v10[jx] + ba) * sigm_f(v11[jx] + bg); }
        resid4(p, layer, 5, 1.0f, u.a * 256 + r, col, y0); resid4(p, layer, 5, 1.0f, u.a * 256 + r + 128, col, y1); } };

HD void cvt64(const float* src, int N, int srccol, u16* dst, int Kd, int nrow, int k0) {
    float v[64];
#pragma unroll
    for (int j = 0; j < 64; ++j) v[j] = srccol >= 0 ? src[(size_t)(k0 + j) * N + srccol] : 0.f;
#pragma unroll
    for (int j = 0; j < 64; j += 4) { f32x4 a; a[0] = v[j]; a[1] = v[j + 1]; a[2] = v[j + 2]; a[3] = v[j + 3]; st4bf(dst + (size_t)nrow * Kd + k0 + j, a); } }
constexpr long CV_FFI = (long)8 * 5632 * 16, CV_FFO = (long)8 * 1024 * 44, CV_MWIN = (long)2 * 768 * 16, CV_MWUQ = (long)2 * 1536 * 6, CV_MWUKV = (long)2 * 2048 * 4,
               CV_MWO = (long)2 * 1024 * 16, CV_RWIN = (long)6144 * 16, CV_RWO = (long)1024 * 32, CV_GLU = (long)2048 * 16;
constexpr long CV_TOTAL = CV_FFI + CV_FFO + CV_MWIN + CV_MWUQ + CV_MWUKV + CV_MWO + CV_RWIN + CV_RWO + CV_GLU;
HD void cvt_item(const P& p, long idx) {
    if (idx < CV_FFI) { const int n = (int)(idx % 5632); const long t = idx / 5632; const int kb = (int)(t % 16), m = (int)(t / 16);
        const int tile = n >> 8, rr = n & 255; const int sc = rr < 128 ? tile * 128 + rr : 2816 + tile * 128 + (rr - 128);
        cvt64(p.in[7] + (size_t)m * 1024 * 5632, 5632, sc, wsb(p, O_FFI + (size_t)m * SZ_FFI1), 1024, n, kb * 64); return; }
    idx -= CV_FFI;
    if (idx < CV_FFO) { const int n = (int)(idx % 1024); const long t = idx / 1024; const int kb = (int)(t % 44), m = (int)(t / 44);
        cvt64(p.in[8] + (size_t)m * 2816 * 1024, 1024, n, wsb(p, O_FFO + (size_t)m * SZ_FFO1), 2816, n, kb * 64); return; }
    idx -= CV_FFO;
    if (idx < CV_MWIN) { const int n = (int)(idx % 768); const long t = idx / 768; const int kb = (int)(t % 16), m = (int)(t / 16);
        cvt64(p.in[9] + (size_t)m * 1024 * 704, 704, n < 704 ? n : -1, wsb(p, O_MWIN + (size_t)m * SZ_MWIN), 1024, n, kb * 64); return; }
    idx -= CV_MWIN;
    if (idx < CV_MWUQ) { const int n = (int)(idx % 1536); const long t = idx / 1536; const int kb = (int)(t % 6), m = (int)(t / 6);
        cvt64(p.in[12] + (size_t)m * 384 * 1536, 1536, n, wsb(p, O_MWUQ + (size_t)m * SZ_MWUQ), 384, n, kb * 64); return; }
    idx -= CV_MWUQ;
    if (idx < CV_MWUKV) { const int n = (int)(idx % 2048); const long t = idx / 2048; const int kb = (int)(t % 4), m = (int)(t / 4);
        const int sc = n < 1024 ? (n >> 7) * 256 + (n & 127) : ((n - 1024) >> 7) * 256 + 128 + (n & 127);
        cvt64(p.in[13] + (size_t)m * 256 * 2048, 2048, sc, wsb(p, O_MWUKV + (size_t)m * SZ_MWUKV), 256, n, kb * 64); return; }
    idx -= CV_MWUKV;
    if (idx < CV_MWO) { const int n = (int)(idx % 1024); const long t = idx / 1024; const int kb = (int)(t % 16), m = (int)(t / 16);
        cvt64(p.in[16] + (size_t)m * 1024 * 1024, 1024, n, wsb(p, O_MWO + (size_t)m * SZ_MWO), 1024, n, kb * 64); return; }
    idx -= CV_MWO;
    if (idx < CV_RWIN) { const int n = (int)(idx % 6144), kb = (int)(idx / 6144); cvt64(p.in[17], 6144, n, wsb(p, O_RWIN), 1024, n, kb * 64); return; }
    idx -= CV_RWIN;
    if (idx < CV_RWO) { const int n = (int)(idx % 1024), kb = (int)(idx / 1024); cvt64(p.in[20], 1024, n, wsb(p, O_RWO), 2048, n, kb * 64); return; }
    idx -= CV_RWO;
    { const int n = (int)(idx % 2048), kb = (int)(idx / 2048); const int tile = n >> 8, rr = n & 255; const int sc = rr < 128 ? tile * 128 + rr : 1024 + tile * 128 + (rr - 128);
      cvt64(p.in[29], 2048, sc, wsb(p, O_GLU), 1024, n, kb * 64); }
}
HD void mod_item(const P& p, int idx) {
    const int layer = idx / 9216, col = idx % 9216; const float* w = p.in[4] + (size_t)layer * 1024 * 9216 + col; float acc[NMR];
    for (int b = 0; b < NMR; ++b) acc[b] = 0.f;
    for (int k = 0; k < 1024; ++k) { const float wv = w[(size_t)k * 9216];
#pragma unroll
        for (int b = 0; b < NMR; ++b) { const float cv = b < NB ? p.in[1][b * 1024 + k] : p.in[3][k]; acc[b] += silu_f(cv) * wv; } }
    const float bias = p.in[5][layer * 9216 + col];
#pragma unroll
    for (int b = 0; b < NMR; ++b) ((float*)(p.ws + O_MOD))[(size_t)(layer * NMR + b) * 9216 + col] = acc[b] + bias; }
HD void copy_item(const P& p, long idx) {
    const long nl4 = (long)NL * 256;
    if (idx < nl4) ((f32x4*)p.out)[idx] = ((const f32x4*)p.in[0])[idx]; else ((f32x4*)(p.ws + O_G))[idx - nl4] = ((const f32x4*)p.in[2])[idx - nl4]; }
HD void norm_item(const P& p, int layer, int k, int r, int s5) {
    const float* x = hsrc(p, r, layer == 0 && k == 0); float ss = 0.f;
    for (int d = 0; d < 1024; d += 4) { const f32x4 v = *(const f32x4*)(x + d); ss += v[0] * v[0] + v[1] * v[1] + v[2] * v[2] + v[3] * v[3]; }
    const float rinv = rsq_f(ss * (1.0f / 1024.0f) + EPS);
    const float* g = p.in[6] + (size_t)(layer * 3 + k) * 1024; const float* sh = modp(p, layer, r, 3 * k); const float* sc = modp(p, layer, r, 3 * k + 1);
    int row5 = 0, i5 = 0;
    if (s5) { if (r < NL) { const int b = r / SEQ, t = r % SEQ; row5 = b * S5L + t / 32; i5 = t % 32; } else { const int rr = r - NL; const int b = rr / 256, l = rr % 256; row5 = NB * S5L + b * S5C + l / 32; i5 = l % 32; } }
    for (int d = 0; d < 1024; d += 4) { const f32x4 v = *(const f32x4*)(x + d); f32x4 o;
        for (int j = 0; j < 4; ++j) o[j] = v[j] * rinv * g[d + j] * (1.0f + sc[d + j]) + sh[d + j];
        if (!s5) st4bf(wsb(p, O_HN) + (size_t)r * 1024 + d, o);
        else st4bf(wsb(p, O_UEXT) + ((size_t)(d >> 4) * NROW5P + row5) * 768 + i5 * 16 + (d & 15), o); } }
HD void axial_rot64(float* v, int t) {
    const int prow = t / 64, pcol = t % 64;
    for (int f = 0; f < 16; ++f) { const float fq = ropef(f, 16);
        { float cs, sn; sincos_t((float)prow * fq, sn, cs); const float x1 = v[f], x2 = v[16 + f]; v[f] = x1 * cs - x2 * sn; v[16 + f] = x2 * cs + x1 * sn; }
        { float cs, sn; sincos_t((float)pcol * fq, sn, cs); const float x1 = v[32 + f], x2 = v[48 + f]; v[32 + f] = x1 * cs - x2 * sn; v[48 + f] = x2 * cs + x1 * sn; } } }
HD void mla_row_item(const P& p, int j, int r) {
    const float* x = (const float*)(p.ws + O_CALL) + (size_t)r * 768; float ss = 0.f;
    for (int d = 0; d < 384; ++d) ss += x[d] * x[d];
    float rinv = rsq_f(ss * (1.0f / 384.0f) + EPS); const float* qn = p.in[10] + j * 384;
    for (int d = 0; d < 384; d += 4) { f32x4 o; for (int jx = 0; jx < 4; ++jx) o[jx] = x[d + jx] * rinv * qn[d + jx]; st4bf(wsb(p, O_CQN) + (size_t)r * 384 + d, o); }
    ss = 0.f; for (int d = 0; d < 256; ++d) ss += x[384 + d] * x[384 + d];
    rinv = rsq_f(ss * (1.0f / 256.0f) + EPS); const float* kvn = p.in[11] + j * 256;
    for (int d = 0; d < 256; d += 4) { f32x4 o; for (int jx = 0; jx < 4; ++jx) o[jx] = x[384 + d + jx] * rinv * kvn[d + jx]; st4bf(wsb(p, O_CKVN) + (size_t)r * 256 + d, o); }
    ss = 0.f; for (int d = 0; d < 64; ++d) ss += x[640 + d] * x[640 + d];
    rinv = rsq_f(ss * (1.0f / 64.0f) + EPS); const float* kg = p.in[15] + j * 192 + 128;
#ifdef HOST_EMU
    float kr[64];
    for (int d = 0; d < 64; ++d) kr[d] = x[640 + d] * rinv * kg[d];
    if (r < NL) axial_rot64(kr, r % SEQ);
    for (int h = 0; h < 8; ++h) for (int d = 0; d < 64; ++d) wsb(p, O_KF)[(size_t)r * 1536 + h * 192 + 128 + d] = f2bf(kr[d]);
#else
    const int t = r % SEQ, prow = t / 64, pcol = t % 64;
    for (int f = 0; f < 16; ++f) { const float fq = ropef(f, 16);
#pragma unroll
        for (int part = 0; part < 2; ++part) { float cs = 1.f, sn = 0.f; if (r < NL) sincos_t((float)(part ? pcol : prow) * fq, sn, cs);
            const int d1 = part * 32 + f, d2 = d1 + 16; const float x1 = x[640 + d1] * rinv * kg[d1], x2 = x[640 + d2] * rinv * kg[d2];
            const u16 o1 = f2bf(x1 * cs - x2 * sn), o2 = f2bf(x2 * cs + x1 * sn);
            for (int h = 0; h < 8; ++h) { wsb(p, O_KF)[(size_t)r * 1536 + h * 192 + 128 + d1] = o1; wsb(p, O_KF)[(size_t)r * 1536 + h * 192 + 128 + d2] = o2; } } }
#endif
}
HD void mla_head_item(const P& p, int j, int idx) {
    const int r = idx >> 3, h = idx & 7;
    u16* q = wsb(p, O_CALL) + (size_t)r * 1536 + h * 192; const float* qg = p.in[14] + j * 192; float ss = 0.f;
    for (int d = 0; d < 128; ++d) { const float v = bf2f(q[d]); ss += v * v; }
    float rinv = rsq_f(ss * (1.0f / 128.0f) + EPS);
    for (int d = 0; d < 128; ++d) q[d] = f2bf(bf2f(q[d]) * rinv * qg[d]);
    ss = 0.f; for (int d = 0; d < 64; ++d) { const float v = bf2f(q[128 + d]); ss += v * v; }
    rinv = rsq_f(ss * (1.0f / 64.0f) + EPS);
    { const int t = r % SEQ, prow = t / 64, pcol = t % 64;
      for (int f = 0; f < 16; ++f) { const float fq = ropef(f, 16);
#pragma unroll
        for (int part = 0; part < 2; ++part) { float cs = 1.f, sn = 0.f; if (r < NL) sincos_t((float)(part ? pcol : prow) * fq, sn, cs);
            const int d1 = 128 + part * 32 + f, d2 = d1 + 16; const float x1 = bf2f(q[d1]) * rinv * qg[d1], x2 = bf2f(q[d2]) * rinv * qg[d2];
            q[d1] = f2bf(x1 * cs - x2 * sn); q[d2] = f2bf(x2 * cs + x1 * sn); } } }
    u16* k = wsb(p, O_KF) + (size_t)r * 1536 + h * 192; const float* kg = p.in[15] + j * 192;
    ss = 0.f; for (int d = 0; d < 128; ++d) { const float v = bf2f(k[d]); ss += v * v; }
    rinv = rsq_f(ss * (1.0f / 128.0f) + EPS);
    for (int d = 0; d < 128; ++d) k[d] = f2bf(bf2f(k[d]) * rinv * kg[d]);
}
HD void ret_prefix_item(const P& p, int idx) {
    const int d4 = idx & 63, e = (idx >> 6) & 511, bq = (idx >> 15) % RGB, h = (idx >> 15) / RGB;
    const float gf = expf(256.f * ret_logg(p, 0, h)), gb = expf(256.f * ret_logg(p, 1, h));
    u16* base = wsb(p, O_BEXT) + (((size_t)h * NCQ + bq * NCH) * 512 + e) * 768 + d4 * 4; constexpr size_t CS = (size_t)512 * 768;
    u32x2 tf[NCH], tb[NCH];
#pragma unroll
    for (int n = 0; n < NCH; ++n) { tf[n] = *(const u32x2*)(base + n * CS + 256); tb[n] = *(const u32x2*)(base + n * CS + 512); }
    f32x4 cf = {0.f, 0.f, 0.f, 0.f}, cb = {0.f, 0.f, 0.f, 0.f};
#pragma unroll
    for (int n = 0; n < NCH; ++n) { f32x4 t; t[0] = bf2f((u16)(tf[n].x & 0xffff)); t[1] = bf2f((u16)(tf[n].x >> 16)); t[2] = bf2f((u16)(tf[n].y & 0xffff)); t[3] = bf2f((u16)(tf[n].y >> 16));
        st4bf(base + n * CS + 256, cf); cf = cf * gf + t; }
#pragma unroll
    for (int s_ = 0; s_ < NCH; ++s_) { const int n = s_ == 0 ? 0 : NCH - s_; f32x4 t; t[0] = bf2f((u16)(tb[n].x & 0xffff)); t[1] = bf2f((u16)(tb[n].x >> 16)); t[2] = bf2f((u16)(tb[n].y & 0xffff)); t[3] = bf2f((u16)(tb[n].y >> 16));
        st4bf(base + n * CS + 512, cb); cb = cb * gb + t; } }
HD u16* ret_ydst(const P& p, int q, int lr) { const int cidx = lr >> 8, n = cidx % NCH; return n == 0 ? wsb(p, O_YCTX) + ((size_t)((q * RGB + cidx / NCH) * 256 + (lr & 255))) * 2048 : wsb(p, O_OB) + (size_t)lr * 2048; }
HD void ret_norm_item(const P& p, int qg, int idx) {
    const int lr = idx >> 2, h = idx & 3; u16* o = wsb(p, O_OB) + (size_t)lr * 2048 + h * 512; u16* yd = ret_ydst(p, qg, lr) + h * 512; const u16* g = wsb(p, O_GATE) + (size_t)lr * 2048 + h * 512; const float* gg = p.in[19] + h * 512;
    float s = 0.f; for (int e = 0; e < 512; ++e) s += bf2f(o[e]);
    const float mu = s * (1.0f / 512.0f); float q = 0.f; for (int e = 0; e < 512; ++e) { const float d = bf2f(o[e]) - mu; q += d * d; }
    const float rstd = rsq_f(q * (1.0f / 512.0f) + EPS);
    for (int e = 0; e < 512; ++e) yd[e] = f2bf((bf2f(o[e]) - mu) * rstd * gg[e] * silu_f(bf2f(g[e]))); }
struct Cx { float re, im; };
HD Cx cmul(Cx a, Cx b) { Cx r; r.re = a.re * b.re - a.im * b.im; r.im = a.re * b.im + a.im * b.re; return r; }
HD Cx s5_alog(const P& p, int dir, int g, int pp) { const float dt = expf(p.in[23][dir * 64 + g]); Cx r; r.re = p.in[21][(dir * 64 + g) * 64 + pp] * dt; r.im = p.in[22][(dir * 64 + g) * 64 + pp] * dt; return r; }
HD Cx cpowa(Cx al, float n) { const float m = expf(al.re * n); float sn, cs; sincos_t(al.im * n * 0.15915494309189535f, sn, cs); Cx r; r.re = m * cs; r.im = m * sn; return r; }
HD Cx s5_coef(const P& p, int dir, int g, int pp) {
    const Cx al = s5_alog(p, dir, g, pp); Cx a = cpowa(al, 1.f); a.re -= 1.f; const float lr = p.in[21][(dir * 64 + g) * 64 + pp], li = p.in[22][(dir * 64 + g) * 64 + pp], den = 1.0f / (lr * lr + li * li);
    Cx r; r.re = (a.re * lr + a.im * li) * den; r.im = (a.im * lr - a.re * li) * den; return r; }
HD Cx s5_bbar(const P& p, int dir, int g, int pp, int m) { Cx b; const size_t o = (((size_t)dir * 64 + g) * 64 + pp) * 16 + m; b.re = p.in[24][o]; b.im = p.in[25][o]; return cmul(s5_coef(p, dir, g, pp), b); }
HD Cx s5_c(const P& p, int dir, int g, int m, int pp) { Cx c; const size_t o = (((size_t)dir * 64 + g) * 16 + m) * 64 + pp; c.re = p.in[26][o]; c.im = p.in[27][o]; return c; }
HD void s5_ktab_item(const P& p, int idx) {
    const int m = idx & 15, tau = (idx >> 4) & 31, dir = (idx >> 9) & 1, g = idx >> 10; float acc[16];
#pragma unroll
    for (int m2 = 0; m2 < 16; ++m2) acc[m2] = 0.f;
    for (int pp = 0; pp < 64; ++pp) { const Cx w = cmul(cmul(s5_c(p, dir, g, m, pp), cpowa(s5_alog(p, dir, g, pp), (float)tau)), s5_coef(p, dir, g, pp));
        const size_t o = (((size_t)dir * 64 + g) * 64 + pp) * 16;
#pragma unroll
        for (int m2 = 0; m2 < 16; ++m2) acc[m2] += w.re * p.in[24][o + m2] - w.im * p.in[25][o + m2]; }
#pragma unroll
    for (int m2 = 0; m2 < 16; ++m2) ((float*)(p.ws + O_KTAB))[(size_t)idx * 16 + m2] = acc[m2]; }
HD void s5_text_item(const P& p, long idx) {
    const int col = (int)(idx % 768); const long t = idx / 768; const int row = (int)(t % 512), g = (int)(t / 512), i = row >> 4, m = row & 15; float v;
    const float* kt = (const float*)(p.ws + O_KTAB);
    if (col < 512) { const int jj = col >> 4, m2 = col & 15; v = 0.f;
        if (jj <= i) v += kt[((((size_t)g * 2 + 0) * 32 + (i - jj)) * 16 + m) * 16 + m2];
        if (jj >= i) v += kt[((((size_t)g * 2 + 1) * 32 + (jj - i)) * 16 + m) * 16 + m2];
        if (jj == i && m == m2) v += p.in[28][g * 16 + m]; }
    else { const int dir = col >= 640, pp = ((col - 512) & 127) >> 1, part = col & 1;
        const Cx w = cmul(s5_c(p, dir, g, m, pp), cpowa(s5_alog(p, dir, g, pp), dir ? (float)(32 - i) : (float)(i + 1))); v = part ? -w.im : w.re; }
    wsb(p, O_TEXT)[idx] = f2bf(v); }
HD void s5_fext_item(const P& p, int idx) {
    const int col = idx & 511, row = (idx >> 9) & 255, g = idx >> 17, jj = col >> 4, m2 = col & 15, dir = row >> 7, pp = (row & 127) >> 1, part = row & 1;
    const Cx w = cmul(cpowa(s5_alog(p, dir, g, pp), dir ? (float)jj : (float)(31 - jj)), s5_bbar(p, dir, g, pp, m2));
    wsb(p, O_FEXT)[idx] = f2bf(part ? w.im : w.re); }
HD int s5_row(int b, int s) { return s < S5C ? NB * S5L + b * S5C + s : b * S5L + (s - S5C); }
HD void s5_prefix_item(const P& p, int idx) {
    const int pp = idx & 63, b = (idx >> 6) % NB, g = (idx >> 6) / NB;
    const Cx af = cpowa(s5_alog(p, 0, g, pp), 32.f), ab = cpowa(s5_alog(p, 1, g, pp), 32.f);
    u16* base = wsb(p, O_UEXT) + (size_t)g * NROW5P * 768; Cx c; c.re = 0.f; c.im = 0.f;
    for (int s0 = 0; s0 < S5C + S5L; s0 += 8) { unsigned t[8];
#pragma unroll
        for (int k = 0; k < 8; ++k) t[k] = *(const unsigned*)(base + (size_t)s5_row(b, s0 + k) * 768 + 512 + 2 * pp);
#pragma unroll
        for (int k = 0; k < 8; ++k) { u16* q = base + (size_t)s5_row(b, s0 + k) * 768 + 512 + 2 * pp; *(unsigned*)q = (unsigned)f2bf(c.re) | ((unsigned)f2bf(c.im) << 16);
            c = cmul(af, c); c.re += bf2f((u16)(t[k] & 0xffff)); c.im += bf2f((u16)(t[k] >> 16)); } }
    c.re = 0.f; c.im = 0.f;
    for (int s0 = 0; s0 < S5C + S5L; s0 += 8) { unsigned t[8]; int sv[8];
#pragma unroll
        for (int k = 0; k < 8; ++k) { const int s_ = s0 + k; sv[k] = s_ < S5C ? S5C - 1 - s_ : S5C + S5L - 1 - (s_ - S5C); t[k] = *(const unsigned*)(base + (size_t)s5_row(b, sv[k]) * 768 + 640 + 2 * pp); }
#pragma unroll
        for (int k = 0; k < 8; ++k) { u16* q = base + (size_t)s5_row(b, sv[k]) * 768 + 640 + 2 * pp; *(unsigned*)q = (unsigned)f2bf(c.re) | ((unsigned)f2bf(c.im) << 16);
            c = cmul(ab, c); c.re += bf2f((u16)(t[k] & 0xffff)); c.im += bf2f((u16)(t[k] >> 16)); } } }

struct AttItem { const u16* q; const u16* k0; const u16* k1; const u16* v0; const u16* v1; u16* o; int n0, ntot; };
HD void att_item(const P& p, int it, AttItem& a) {
    const u16* Q = wsb(p, O_CALL); const u16* KF = wsb(p, O_KF); const u16* VB = wsb(p, O_VB); u16* O = wsb(p, O_HN);
    const int nlat = NB * 8 * (SEQ / 256);
    if (it < nlat) { const int qb = it % (SEQ / 256), h = (it / (SEQ / 256)) & 7, b = it / (SEQ / 256) / 8; const size_t r0 = (size_t)b * SEQ + qb * 256, c0 = (size_t)NL + b * 256, l0 = (size_t)b * SEQ;
        a.q = Q + r0 * 1536 + h * 192; a.o = O + r0 * 1024 + h * 128; a.k0 = KF + c0 * 1536 + h * 192; a.v0 = VB + c0 * 1024 + h * 128; a.k1 = KF + l0 * 1536 + h * 192; a.v1 = VB + l0 * 1024 + h * 128; a.n0 = 256; a.ntot = 256 + SEQ; }
    else { const int x = it - nlat, h = x & 7, b = x >> 3; const size_t c0 = (size_t)NL + b * 256;
        a.q = Q + c0 * 1536 + h * 192; a.o = O + c0 * 1024 + h * 128; a.k0 = KF + c0 * 1536 + h * 192; a.v0 = VB + c0 * 1024 + h * 128; a.k1 = a.k0; a.v1 = a.v0; a.n0 = 256; a.ntot = 256; } }
constexpr float ATT_SCALE = 0.07216878364870322f;

#ifndef HOST_EMU
#define LAS __attribute__((address_space(3)))
typedef short bf16x8 __attribute__((ext_vector_type(8)));
typedef short s16x4 __attribute__((ext_vector_type(4)));
typedef float f32x16 __attribute__((ext_vector_type(16)));
typedef unsigned u32x4 __attribute__((ext_vector_type(4)));
constexpr int HTB = 128 * 64 * 2, STAGE_BYTES = 8 * HTB;
__device__ __forceinline__ int lds_byte(int r, int c) { const int st = (r >> 4) * 2 + (c >> 5), rr = r & 15, cc = c & 31, ob = rr * 64 + cc * 2; return st * 1024 + (ob ^ (((ob >> 9) & 1) << 5)); }
__device__ __forceinline__ void stage_rc(int b, int& R, int& C) { const int st = b / 1024, sb = b % 1024, swz = sb ^ (((sb >> 9) & 1) << 5); R = (st >> 1) * 16 + swz / 64; C = (st & 1) * 32 + (swz % 64) / 2; }

template <class Dsc>
__device__ __forceinline__ void gemm_run(LAS unsigned char* lds, const Dsc& D) {
    int tid_ = threadIdx.x; asm volatile("" : "+v"(tid_));
    const int tid = tid_, wid = __builtin_amdgcn_readfirstlane(tid >> 6), lane = tid & 63, wr = wid >> 2, wc = wid & 3, fr = lane & 15, fq = lane >> 4;
    constexpr int K = Dsc::K, nt = K / 64, lda = Dsc::lda, ldb = Dsc::ldb;
    static_assert(K % 128 == 0 && K >= 256, "K");
    unsigned voffA[2], voffB[2];
#pragma unroll
    for (int i = 0; i < 2; ++i) { int R, C; stage_rc(tid * 16 + i * 8192, R, C); voffA[i] = (unsigned)(R * lda + C) * 2u; voffB[i] = (unsigned)(R * ldb + C) * 2u; }
    constexpr size_t kstep = 128, hstepA = (size_t)128 * lda * 2, hstepB = (size_t)128 * ldb * 2;
    const unsigned ldsw = (unsigned)wid * 1024u;
    const int aoff = lds_byte(wr * 64 + fr, fq * 8), boff = lds_byte(wc * 32 + fr, fq * 8);
#define G_SA(b, h) (((b) * 2 + (h)) * HTB)
#define G_SB(b, h) ((4 + (b) * 2 + (h)) * HTB)
#define G_STAGE(bufoff, gbase, voff) do { _Pragma("unroll") for (int _i = 0; _i < 2; ++_i) \
        __builtin_amdgcn_global_load_lds((const unsigned*)((const char*)(gbase) + (voff)[_i]), (LAS unsigned*)(lds + (bufoff) + ldsw + _i * 8192), 16, 0, 0); } while (0)
#define G_LDA(dst, b, h) do { _Pragma("unroll") for (int m = 0; m < 4; ++m) _Pragma("unroll") for (int k = 0; k < 2; ++k) dst[m][k] = *(const LAS bf16x8*)(lds + G_SA(b, h) + aoff + m * 2048 + k * 1024); } while (0)
#define G_LDB(dst, b, h) do { _Pragma("unroll") for (int n = 0; n < 2; ++n) _Pragma("unroll") for (int k = 0; k < 2; ++k) dst[n][k] = *(const LAS bf16x8*)(lds + G_SB(b, h) + boff + n * 2048 + k * 1024); } while (0)
#define G_MMA(ai, bj, At, Bt) do { __builtin_amdgcn_s_setprio(1); _Pragma("unroll") for (int m = 0; m < 4; ++m) _Pragma("unroll") for (int n = 0; n < 2; ++n) _Pragma("unroll") for (int k = 0; k < 2; ++k) \
        acc[ai][bj][m][n] = __builtin_amdgcn_mfma_f32_16x16x32_bf16(Bt[n][k], At[m][k], acc[ai][bj][m][n], 0, 0, 0); __builtin_amdgcn_s_setprio(0); } while (0)
#define G_WAIT_V(n) asm volatile("s_waitcnt vmcnt(" #n ")" ::: "memory")
#define G_WAIT_L(n) asm volatile("s_waitcnt lgkmcnt(" #n ")" ::: "memory")
#define G_BAR __builtin_amdgcn_s_barrier()
#define G_SCHED __builtin_amdgcn_sched_barrier(0)
    Unit cur{}, nxt{}; int ui = 0; const int G = gridDim.x, cb = blockIdx.x;
    if (!D.unit(cb, cur)) return;
    f32x4 acc[2][2][4][2];
#pragma unroll
    for (int a = 0; a < 2; ++a)
#pragma unroll
        for (int b = 0; b < 2; ++b)
#pragma unroll
            for (int m = 0; m < 4; ++m)
#pragma unroll
                for (int n = 0; n < 2; ++n) acc[a][b][m][n] = (f32x4){0.f, 0.f, 0.f, 0.f};
    bf16x8 At[4][2], B0[2][2], B1[2][2];
    const char* cA = (const char*)cur.A; const char* cB = (const char*)cur.B;
    G_STAGE(G_SB(0, 0), cB, voffB); G_STAGE(G_SA(0, 0), cA, voffA); G_STAGE(G_SB(0, 1), cB + hstepB, voffB); G_STAGE(G_SA(0, 1), cA + hstepA, voffA);
    if (wr == 1) G_BAR;
    G_WAIT_V(4); G_BAR;
    G_STAGE(G_SB(1, 0), cB + kstep, voffB); G_STAGE(G_SA(1, 0), cA + kstep, voffA); G_STAGE(G_SB(1, 1), cB + hstepB + kstep, voffB);
    G_WAIT_V(6); G_BAR;
    for (;;) {
        const bool has_next = D.unit((ui + 1) * G + cb, nxt);
        const char* nA = has_next ? (const char*)nxt.A : cA; const char* nB = has_next ? (const char*)nxt.B : cB;
        _Pragma("nounroll") for (int t = 0; t < nt; t += 2) {
            const bool last = (t == nt - 2);
            const char* a1 = cA + (size_t)(t + 1) * kstep;
            const char* a2 = last ? nA : cA + (size_t)(t + 2) * kstep; const char* b2 = last ? nB : cB + (size_t)(t + 2) * kstep;
            const char* a3 = a2 + kstep; const char* b3 = b2 + kstep;
            G_LDB(B0, 0, 0); G_SCHED; G_LDA(At, 0, 0); G_STAGE(G_SA(1, 1), a1 + hstepA, voffA);
            G_WAIT_L(8); G_BAR; G_WAIT_L(0); G_MMA(0, 0, At, B0); G_BAR; G_SCHED;
            G_LDB(B1, 0, 1); G_STAGE(G_SB(0, 0), b2, voffB);
            G_BAR; G_WAIT_L(0); G_MMA(0, 1, At, B1); G_BAR;
            G_LDA(At, 0, 1); G_STAGE(G_SA(0, 0), a2, voffA);
            G_BAR; G_WAIT_L(0); G_MMA(1, 0, At, B0); G_BAR; G_SCHED;
            G_STAGE(G_SB(0, 1), b2 + hstepB, voffB);
            G_WAIT_V(6); G_BAR; G_MMA(1, 1, At, B1); G_BAR;
            G_LDB(B0, 1, 0); G_SCHED; G_LDA(At, 1, 0); G_STAGE(G_SA(0, 1), a2 + hstepA, voffA);
            G_WAIT_L(8); G_BAR; G_WAIT_L(0); G_MMA(0, 0, At, B0); G_BAR; G_SCHED;
            G_LDB(B1, 1, 1); G_STAGE(G_SB(1, 0), b3, voffB);
            G_BAR; G_WAIT_L(0); G_MMA(0, 1, At, B1); G_BAR;
            G_LDA(At, 1, 1); G_STAGE(G_SA(1, 0), a3, voffA);
            G_BAR; G_WAIT_L(0); G_MMA(1, 0, At, B0); G_BAR; G_SCHED;
            G_STAGE(G_SB(1, 1), b3 + hstepB, voffB);
            G_WAIT_V(6); G_BAR; G_MMA(1, 1, At, B1); G_BAR;
        }
        int er_ = wr * 64 + fr, ec_ = wc * 32 + fq * 4; asm volatile("" : "+v"(er_), "+v"(ec_));
#pragma unroll
        for (int m = 0; m < 4; ++m)
#pragma unroll
            for (int n = 0; n < 2; ++n) { D.emit(cur, er_ + m * 16, ec_ + n * 16, acc[0][0][m][n], acc[0][1][m][n], acc[1][0][m][n], acc[1][1][m][n]); if (((m * 2 + n + 1) % Dsc::FENCE) == 0) asm volatile("" ::: "memory"); }
        if (!has_next) break;
#pragma unroll
        for (int a = 0; a < 2; ++a)
#pragma unroll
            for (int b = 0; b < 2; ++b)
#pragma unroll
                for (int m = 0; m < 4; ++m)
#pragma unroll
                    for (int n = 0; n < 2; ++n) acc[a][b][m][n] = (f32x4){0.f, 0.f, 0.f, 0.f};
        cur = nxt; cA = nA; cB = nB; ++ui;
    }
    G_WAIT_V(0);
    if (wr == 0) G_BAR;
    G_BAR;
#undef G_SA
#undef G_SB
#undef G_STAGE
#undef G_LDA
#undef G_LDB
#undef G_MMA
#undef G_WAIT_V
#undef G_WAIT_L
#undef G_BAR
#undef G_SCHED
}

constexpr int A_SHM_V = 64 * 128 * 2, A_SHM_K = 64 * 400;
#define KSWZ(row, colB) ((row) * 400 + (colB))
__device__ __forceinline__ int crow(int r, int hi) { return (r & 3) + 8 * (r >> 2) + 4 * hi; }
__device__ __forceinline__ unsigned cvtpk(float lo, float hi) { unsigned r; asm volatile("v_cvt_pk_bf16_f32 %0, %1, %2" : "=v"(r) : "v"(lo), "v"(hi)); return r; }
__device__ __forceinline__ int v_st(int k, int c) { const int kk = (k & ~0xC) | ((k & 4) << 1) | ((k & 8) >> 1); return ((kk >> 3) * 4 + (c >> 5)) * 512 + ((kk & 7) * 32 + (c & 31)) * 2; }
__device__ __forceinline__ int v_rd_base(int lane) { return ((lane & 3) << 3) | (((lane >> 2) & 3) << 6) | (((lane >> 4) & 1) << 5) | (((lane >> 5) & 1) << 8); }
constexpr int v_rd_off(int d0, int ks, int half) { return d0 * 512 + ks * 4096 + half * 2048; }
template <int OFF> __device__ __forceinline__ s16x4 tr_read(int vb) { s16x4 r; asm volatile("ds_read_b64_tr_b16 %0, %1 offset:%2" : "=&v"(r) : "v"(vb), "i"(OFF) : "memory"); return r; }
template <int D0> __device__ __forceinline__ void pv_one(f32x16& od, int vb, bf16x8 pa0, bf16x8 pa1, bf16x8 pa2, bf16x8 pa3) {
    const s16x4 l0 = tr_read<v_rd_off(D0, 0, 0)>(vb), h0 = tr_read<v_rd_off(D0, 0, 1)>(vb), l1 = tr_read<v_rd_off(D0, 1, 0)>(vb), h1 = tr_read<v_rd_off(D0, 1, 1)>(vb);
    const s16x4 l2 = tr_read<v_rd_off(D0, 2, 0)>(vb), h2 = tr_read<v_rd_off(D0, 2, 1)>(vb), l3 = tr_read<v_rd_off(D0, 3, 0)>(vb), h3 = tr_read<v_rd_off(D0, 3, 1)>(vb);
    asm volatile("s_waitcnt lgkmcnt(0)" ::: "memory"); __builtin_amdgcn_sched_barrier(0);
#define PK(L, H) (bf16x8){L[0], L[1], L[2], L[3], H[0], H[1], H[2], H[3]}
    od = __builtin_amdgcn_mfma_f32_32x32x16_bf16(pa0, PK(l0, h0), od, 0, 0, 0);
    od = __builtin_amdgcn_mfma_f32_32x32x16_bf16(pa1, PK(l1, h1), od, 0, 0, 0);
    od = __builtin_amdgcn_mfma_f32_32x32x16_bf16(pa2, PK(l2, h2), od, 0, 0, 0);
    od = __builtin_amdgcn_mfma_f32_32x32x16_bf16(pa3, PK(l3, h3), od, 0, 0, 0);
#undef PK
}
__device__ __forceinline__ void att_body(const AttItem& a, char* lds) {
    int tid_ = threadIdx.x; asm volatile("" : "+v"(tid_));
    const int tid = tid_, wid = tid >> 6, lane = tid & 63, r32 = lane & 31, hi = lane >> 5;
    char* V_lds = lds; char* K_lds = lds + 2 * A_SHM_V; float* li_l = (float*)(lds + 2 * A_SHM_V + 2 * A_SHM_K) + wid * 64;
    float l_reg = 0.f; f32x16 o[4] = {}; bf16x8 qr[12];
    const u16* Qw = a.q + (size_t)(wid * 32 + r32) * 1536 + hi * 8;
#pragma unroll
    for (int d0 = 0; d0 < 12; ++d0) qr[d0] = *(const bf16x8*)(Qw + d0 * 16);
    const int sr = tid >> 4, sc = (tid & 15) * 8, vst0 = v_st(sr, sc), vst1 = v_st(32 + sr, sc);
    const int voff0 = sr * 1024 + sc, voff1 = (32 + sr) * 1024 + sc;
    int koff[3], kwr[3];
#pragma unroll
    for (int i = 0; i < 3; ++i) { const int id = tid + i * 512, kr_ = id / 24, kc_ = (id % 24) * 8; koff[i] = kr_ * 1536 + kc_; kwr[i] = KSWZ(kr_, kc_ * 2); }
    const int vb0 = (int)(uintptr_t)V_lds + v_rd_base(lane);
    bf16x8 vs0, vs1, ks[3];
    const int NT = a.ntot / 64;
#define A_SLOAD(k0_) do { const int key0_ = (k0_); const u16* kb_ = key0_ < a.n0 ? a.k0 + (size_t)key0_ * 1536 : a.k1 + (size_t)(key0_ - a.n0) * 1536; \
        const u16* vbp_ = key0_ < a.n0 ? a.v0 + (size_t)key0_ * 1024 : a.v1 + (size_t)(key0_ - a.n0) * 1024; \
        vs0 = *(const bf16x8*)(vbp_ + voff0); vs1 = *(const bf16x8*)(vbp_ + voff1); \
        _Pragma("unroll") for (int i = 0; i < 3; ++i) ks[i] = *(const bf16x8*)(kb_ + koff[i]); } while (0)
#define A_SWRITE(b) do { *(bf16x8*)(V_lds + (b) * A_SHM_V + vst0) = vs0; *(bf16x8*)(V_lds + (b) * A_SHM_V + vst1) = vs1; \
        _Pragma("unroll") for (int i = 0; i < 3; ++i) *(bf16x8*)(K_lds + (b) * A_SHM_K + kwr[i]) = ks[i]; } while (0)
    A_SLOAD(0); A_SWRITE(0); __syncthreads();
    constexpr float C = ATT_SCALE * 1.4426950408889634f;
    _Pragma("nounroll") for (int j = 0; j < NT; ++j) {
        const int buf = j & 1;
        if (j + 1 < NT) A_SLOAD((j + 1) * 64);
        f32x16 p0 = {}, p1 = {};
        const char* Ks = K_lds + buf * A_SHM_K;
#pragma unroll
        for (int d0 = 0; d0 < 12; ++d0) { const int cbb = (d0 * 16 + hi * 8) * 2;
            const bf16x8 b0 = *(const bf16x8*)(Ks + KSWZ(r32, cbb)); const bf16x8 b1 = *(const bf16x8*)(Ks + KSWZ(32 + r32, cbb));
            p0 = __builtin_amdgcn_mfma_f32_32x32x16_bf16(b0, qr[d0], p0, 0, 0, 0);
            p1 = __builtin_amdgcn_mfma_f32_32x32x16_bf16(b1, qr[d0], p1, 0, 0, 0); }
        float ps = 0.f;
#pragma unroll
        for (int r = 0; r < 16; ++r) { p0[r] = __builtin_amdgcn_exp2f(p0[r] * C); p1[r] = __builtin_amdgcn_exp2f(p1[r] * C); ps += p0[r] + p1[r]; }
        { auto rr = __builtin_amdgcn_permlane32_swap(__float_as_uint(ps), __float_as_uint(ps), false, false); ps = __uint_as_float(rr[0]) + __uint_as_float(rr[1]); }
        l_reg += ps;
        bf16x8 pa0, pa1, pa2, pa3;
#define PK4(Pv, BASE, OUT) do { unsigned a0 = cvtpk(Pv[BASE + 0], Pv[BASE + 1]), a1 = cvtpk(Pv[BASE + 2], Pv[BASE + 3]); \
        unsigned b0 = cvtpk(Pv[BASE + 4], Pv[BASE + 5]), b1 = cvtpk(Pv[BASE + 6], Pv[BASE + 7]); \
        auto r0 = __builtin_amdgcn_permlane32_swap(a0, b0, false, false); auto r1 = __builtin_amdgcn_permlane32_swap(a1, b1, false, false); \
        u32x4 w = {r0[0], r1[0], r0[1], r1[1]}; OUT = *reinterpret_cast<bf16x8*>(&w); } while (0)
        PK4(p0, 0, pa0); PK4(p0, 8, pa1); PK4(p1, 0, pa2); PK4(p1, 8, pa3);
#undef PK4
        const int vb = vb0 + buf * A_SHM_V;
        pv_one<0>(o[0], vb, pa0, pa1, pa2, pa3); pv_one<1>(o[1], vb, pa0, pa1, pa2, pa3); pv_one<2>(o[2], vb, pa0, pa1, pa2, pa3); pv_one<3>(o[3], vb, pa0, pa1, pa2, pa3);
        if (j + 1 < NT) A_SWRITE(buf ^ 1);
        __syncthreads();
    }
    if (hi == 0) li_l[r32] = l_reg;
    asm volatile("s_waitcnt lgkmcnt(0)" ::: "memory");
    __builtin_amdgcn_wave_barrier();
    u16* Ow = a.o + (size_t)(wid * 32) * 1024;
#pragma unroll
    for (int r = 0; r < 16; ++r) { const int orow = crow(r, hi); const float rl = 1.0f / li_l[orow];
#pragma unroll
        for (int d0 = 0; d0 < 4; ++d0) Ow[(size_t)orow * 1024 + d0 * 32 + r32] = f2bf(o[d0][r] * rl); }
    __syncthreads();
#undef A_SLOAD
#undef A_SWRITE
}

__device__ __forceinline__ float wsum(float v) { for (int o = 32; o >= 1; o >>= 1) v += __shfl_xor(v, o); return v; }
__device__ __forceinline__ void norm_wave(const P& p, int layer, int k, int r, int s5, int lane) {
    const float* x = hsrc(p, r, layer == 0 && k == 0); f32x4 v[4]; float ss = 0.f;
#pragma unroll
    for (int i = 0; i < 4; ++i) { v[i] = *(const f32x4*)(x + i * 256 + lane * 4); ss += v[i][0] * v[i][0] + v[i][1] * v[i][1] + v[i][2] * v[i][2] + v[i][3] * v[i][3]; }
    ss = wsum(ss); const float rinv = rsq_f(ss * (1.0f / 1024.0f) + EPS);
    const float* g = p.in[6] + (size_t)(layer * 3 + k) * 1024; const float* sh = modp(p, layer, r, 3 * k); const float* sc = modp(p, layer, r, 3 * k + 1);
    int row5 = 0, i5 = 0;
    if (s5) { if (r < NL) { const int b = r / SEQ, t = r % SEQ; row5 = b * S5L + t / 32; i5 = t % 32; } else { const int rr = r - NL; const int b = rr / 256, l = rr % 256; row5 = NB * S5L + b * S5C + l / 32; i5 = l % 32; } }
#pragma unroll
    for (int i = 0; i < 4; ++i) { const int d = i * 256 + lane * 4; const f32x4 gv = *(const f32x4*)(g + d), sv = *(const f32x4*)(sc + d), hv = *(const f32x4*)(sh + d); f32x4 o;
        for (int j = 0; j < 4; ++j) o[j] = v[i][j] * rinv * gv[j] * (1.0f + sv[j]) + hv[j];
        if (!s5) st4bf(wsb(p, O_HN) + (size_t)r * 1024 + d, o);
        else st4bf(wsb(p, O_UEXT) + ((size_t)(d >> 4) * NROW5P + row5) * 768 + i5 * 16 + (d & 15), o); } }
__device__ __forceinline__ void mla_row_wave(const P& p, int j, int r, int lane) {
    const float* x = (const float*)(p.ws + O_CALL) + (size_t)r * 768; f32x4 c[3]; float q[3];
#pragma unroll
    for (int i = 0; i < 3; ++i) { c[i] = *(const f32x4*)(x + i * 256 + lane * 4); q[i] = c[i][0] * c[i][0] + c[i][1] * c[i][1] + c[i][2] * c[i][2] + c[i][3] * c[i][3]; }
    const bool lo = lane < 32;
    const float ssq = wsum(q[0] + (lo ? q[1] : 0.f)), sskv = wsum((lo ? 0.f : q[1]) + (lo ? q[2] : 0.f)), ssr = wsum((lane >= 32 && lane < 48) ? q[2] : 0.f);
    const float rq = rsq_f(ssq * (1.0f / 384.0f) + EPS), rkv = rsq_f(sskv * (1.0f / 256.0f) + EPS), rr_ = rsq_f(ssr * (1.0f / 64.0f) + EPS);
    const float* qn = p.in[10] + j * 384; const float* kvn = p.in[11] + j * 256; const float* kg = p.in[15] + j * 192 + 128;
    { const f32x4 gq = *(const f32x4*)(qn + lane * 4); f32x4 o; for (int jx = 0; jx < 4; ++jx) o[jx] = c[0][jx] * rq * gq[jx]; st4bf(wsb(p, O_CQN) + (size_t)r * 384 + lane * 4, o); }
    if (lo) { const f32x4 gq = *(const f32x4*)(qn + 256 + lane * 4); f32x4 o; for (int jx = 0; jx < 4; ++jx) o[jx] = c[1][jx] * rq * gq[jx]; st4bf(wsb(p, O_CQN) + (size_t)r * 384 + 256 + lane * 4, o);
        const f32x4 gk = *(const f32x4*)(kvn + 128 + lane * 4); f32x4 o2; for (int jx = 0; jx < 4; ++jx) o2[jx] = c[2][jx] * rkv * gk[jx]; st4bf(wsb(p, O_CKVN) + (size_t)r * 256 + 128 + lane * 4, o2); }
    else { const f32x4 gk = *(const f32x4*)(kvn + lane * 4 - 128); f32x4 o; for (int jx = 0; jx < 4; ++jx) o[jx] = c[1][jx] * rkv * gk[jx]; st4bf(wsb(p, O_CKVN) + (size_t)r * 256 + lane * 4 - 128, o); }
    const int dd = (4 * (lane - 32)) & 63; const f32x4 gr = *(const f32x4*)(kg + dd); f32x4 own, oth, o;
    for (int jx = 0; jx < 4; ++jx) own[jx] = c[2][jx] * rr_ * gr[jx];
    for (int jx = 0; jx < 4; ++jx) oth[jx] = __shfl_xor(own[jx], 4);
    const int t = r % SEQ, pos = (dd & 32) ? (t % 64) : (t / 64); const bool first = (dd & 16) == 0;
    for (int jx = 0; jx < 4; ++jx) { float cs = 1.f, sn = 0.f; if (r < NL) sincos_t((float)pos * ropef((dd & 15) + jx, 16), sn, cs);
        o[jx] = first ? own[jx] * cs - oth[jx] * sn : own[jx] * cs + oth[jx] * sn; }
    if (lane >= 32 && lane < 48) { u16* kf = wsb(p, O_KF) + (size_t)r * 1536 + 128 + dd;
#pragma unroll
        for (int h = 0; h < 8; ++h) st4bf(kf + h * 192, o); } }
__device__ __forceinline__ float bflo(unsigned w) { return __uint_as_float(w << 16); }
__device__ __forceinline__ float bfhi(unsigned w) { return __uint_as_float(w & 0xffff0000u); }
__device__ __forceinline__ unsigned pk2(float a, float b) { return (unsigned)f2bf(a) | ((unsigned)f2bf(b) << 16); }
__device__ __forceinline__ void mla_head_wave(const P& p, int j, int r, int lane) {
    const int h = lane >> 3, sub = lane & 7;
    u16* q = wsb(p, O_CALL) + (size_t)r * 1536 + h * 192; u16* k = wsb(p, O_KF) + (size_t)r * 1536 + h * 192;
    const float* qg = p.in[14] + j * 192; const float* kg = p.in[15] + j * 192;
    u32x4 qa = *(const u32x4*)(q + sub * 16), qb = *(const u32x4*)(q + sub * 16 + 8), qr = *(const u32x4*)(q + 128 + sub * 8), ka = *(const u32x4*)(k + sub * 16), kb = *(const u32x4*)(k + sub * 16 + 8);
    float sq = 0.f, sk = 0.f, sr = 0.f;
#pragma unroll
    for (int i = 0; i < 4; ++i) { sq += bflo(qa[i]) * bflo(qa[i]) + bfhi(qa[i]) * bfhi(qa[i]) + bflo(qb[i]) * bflo(qb[i]) + bfhi(qb[i]) * bfhi(qb[i]);
        sk += bflo(ka[i]) * bflo(ka[i]) + bfhi(ka[i]) * bfhi(ka[i]) + bflo(kb[i]) * bflo(kb[i]) + bfhi(kb[i]) * bfhi(kb[i]); sr += bflo(qr[i]) * bflo(qr[i]) + bfhi(qr[i]) * bfhi(qr[i]); }
    for (int o = 4; o >= 1; o >>= 1) { sq += __shfl_xor(sq, o); sk += __shfl_xor(sk, o); sr += __shfl_xor(sr, o); }
    const float rq = rsq_f(sq * (1.0f / 128.0f) + EPS), rk = rsq_f(sk * (1.0f / 128.0f) + EPS), rr_ = rsq_f(sr * (1.0f / 64.0f) + EPS);
    u32x4 oa, ob, oka, okb;
#pragma unroll
    for (int i = 0; i < 4; ++i) { const int d = sub * 16 + 2 * i;
        oa[i] = pk2(bflo(qa[i]) * rq * qg[d], bfhi(qa[i]) * rq * qg[d + 1]); ob[i] = pk2(bflo(qb[i]) * rq * qg[d + 8], bfhi(qb[i]) * rq * qg[d + 9]);
        oka[i] = pk2(bflo(ka[i]) * rk * kg[d], bfhi(ka[i]) * rk * kg[d + 1]); okb[i] = pk2(bflo(kb[i]) * rk * kg[d + 8], bfhi(kb[i]) * rk * kg[d + 9]); }
    *(u32x4*)(q + sub * 16) = oa; *(u32x4*)(q + sub * 16 + 8) = ob; *(u32x4*)(k + sub * 16) = oka; *(u32x4*)(k + sub * 16 + 8) = okb;
    const int dd = sub * 8; float own[8], oth[8];
#pragma unroll
    for (int i = 0; i < 4; ++i) { own[2 * i] = bflo(qr[i]) * rr_ * qg[128 + dd + 2 * i]; own[2 * i + 1] = bfhi(qr[i]) * rr_ * qg[128 + dd + 2 * i + 1]; }
#pragma unroll
    for (int i = 0; i < 8; ++i) oth[i] = __shfl_xor(own[i], 2);
    const int t = r % SEQ, pos = (dd & 32) ? (t % 64) : (t / 64); const bool first = (dd & 16) == 0; u32x4 orr; float res[8];
#pragma unroll
    for (int i = 0; i < 8; ++i) { float cs = 1.f, sn = 0.f; if (r < NL) sincos_t((float)pos * ropef((dd & 15) + i, 16), sn, cs); res[i] = first ? own[i] * cs - oth[i] * sn : own[i] * cs + oth[i] * sn; }
#pragma unroll
    for (int i = 0; i < 4; ++i) orr[i] = pk2(res[2 * i], res[2 * i + 1]);
    *(u32x4*)(q + 128 + dd) = orr; }
__device__ __forceinline__ void ret_norm_wave(const P& p, int q, int lr, int lane) {
    const int h = lane >> 4, sub = lane & 15; u16* o = wsb(p, O_OB) + (size_t)lr * 2048 + h * 512 + sub * 32; u16* yd = ret_ydst(p, q, lr) + h * 512 + sub * 32; const u16* g = wsb(p, O_GATE) + (size_t)lr * 2048 + h * 512 + sub * 32; const float* gg = p.in[19] + h * 512 + sub * 32;
    u32x4 ov[4]; float s = 0.f;
#pragma unroll
    for (int i = 0; i < 4; ++i) { ov[i] = *(const u32x4*)(o + i * 8); for (int jx = 0; jx < 4; ++jx) s += bflo(ov[i][jx]) + bfhi(ov[i][jx]); }
    for (int m = 8; m >= 1; m >>= 1) s += __shfl_xor(s, m);
    const float mu = s * (1.0f / 512.0f); float qv = 0.f;
#pragma unroll
    for (int i = 0; i < 4; ++i) for (int jx = 0; jx < 4; ++jx) { const float a = bflo(ov[i][jx]) - mu, b = bfhi(ov[i][jx]) - mu; qv += a * a + b * b; }
    for (int m = 8; m >= 1; m >>= 1) qv += __shfl_xor(qv, m);
    const float rstd = rsq_f(qv * (1.0f / 512.0f) + EPS);
#pragma unroll
    for (int i = 0; i < 4; ++i) { const u32x4 gv = *(const u32x4*)(g + i * 8); u32x4 w;
        for (int jx = 0; jx < 4; ++jx) { const int e = i * 8 + 2 * jx;
            w[jx] = pk2((bflo(ov[i][jx]) - mu) * rstd * gg[e] * silu_f(bflo(gv[jx])), (bfhi(ov[i][jx]) - mu) * rstd * gg[e + 1] * silu_f(bfhi(gv[jx]))); }
        *(u32x4*)(yd + i * 8) = w; } }
__device__ __forceinline__ void mod_phase(const P& p, float* tab) {
    for (int i = threadIdx.x; i < NMR * 1024; i += 512) { const int b = i >> 10, k = i & 1023; tab[i] = silu_f(b < NB ? p.in[1][b * 1024 + k] : p.in[3][k]); }
    __syncthreads();
    for (int idx = blockIdx.x * 512 + threadIdx.x; idx < DEPTH * 9216; idx += gridDim.x * 512) {
        const int layer = idx / 9216, col = idx % 9216; const float* w = p.in[4] + (size_t)layer * 1024 * 9216 + col; float acc[NMR];
#pragma unroll
        for (int b = 0; b < NMR; ++b) acc[b] = 0.f;
        for (int k = 0; k < 1024; ++k) { const float wv = w[(size_t)k * 9216];
#pragma unroll
            for (int b = 0; b < NMR; ++b) acc[b] += tab[b * 1024 + k] * wv; }
        const float bias = p.in[5][layer * 9216 + col];
#pragma unroll
        for (int b = 0; b < NMR; ++b) ((float*)(p.ws + O_MOD))[(size_t)(layer * NMR + b) * 9216 + col] = acc[b] + bias; }
    __syncthreads(); }
#define WPASS(N, HOSTCALL, DEVCALL) do { const int _n = (int)(N); int t0_ = threadIdx.x; asm volatile("" : "+v"(t0_)); const int lane = t0_ & 63; for (int it = blockIdx.x * 8 + (t0_ >> 6); it < _n; it += gridDim.x * 8) { DEVCALL; } } while (0)
#define MODPHASE() mod_phase(p, (float*)shm)
#define NCTXWG ((NC / 256) * 4)
#define MIXED_DOWN_NORM(DESC, LAYER2, KK, S5F, ASHARE) do { int t0_ = threadIdx.x; asm volatile("" : "+v"(t0_)); const int lane = t0_ & 63; int r0_, r1_; \
    if ((int)blockIdx.x < NCTXWG) { gemm_run(lds, DESC); r0_ = (int)blockIdx.x * (ASHARE); r1_ = r0_ + (ASHARE); }     \
    else { const int no_ = (int)gridDim.x - NCTXWG, rest_ = NL - NCTXWG * (ASHARE), per_ = (rest_ + no_ - 1) / no_; r0_ = NCTXWG * (ASHARE) + ((int)blockIdx.x - NCTXWG) * per_; r1_ = r0_ + per_ < NL ? r0_ + per_ : NL; } \
    for (int it = r0_ + (t0_ >> 6); it < r1_; it += 8) norm_wave(p, LAYER2, KK, it, S5F, lane); } while (0)
#define MIXED_RET_TAIL(LATDESC, CTXDESC, NCW, LAYER2, KK, RA, RB) do { gemm_run(lds, LATDESC); int t0_ = threadIdx.x; asm volatile("" : "+v"(t0_)); const int lane = t0_ & 63; \
    if ((int)blockIdx.x < (NCW)) { gemm_run(lds, CTXDESC); } else { const int nw_ = ((int)gridDim.x - (NCW)) * 8; \
        for (int it = (RA) + ((int)blockIdx.x - (NCW)) * 8 + (t0_ >> 6); it < (RB); it += nw_) norm_wave(p, LAYER2, KK, it, 0, lane); } } while (0)
#define RANGENORM(LAYER2, KK, RA, RB) do { int t0_ = threadIdx.x; asm volatile("" : "+v"(t0_)); const int lane = t0_ & 63; for (int it = (RA) + blockIdx.x * 8 + (t0_ >> 6); it < (RB); it += gridDim.x * 8) norm_wave(p, LAYER2, KK, it, 0, lane); } while (0)
#define CTXNORM(LAYER2, KK, S5F) do { int t0_ = threadIdx.x; asm volatile("" : "+v"(t0_)); const int lane = t0_ & 63; for (int it = NL + blockIdx.x * 8 + (t0_ >> 6); it < MT; it += gridDim.x * 8) norm_wave(p, LAYER2, KK, it, S5F, lane); } while (0)

#define XB_TMO      128
#define XB_XCNT(j)  (256  + 64 * (j))
#define XB_XSUB(j)  (1280 + 64 * (j))
#define XB_XGEN(j)  (2304 + 64 * (j))
#define XB_TOP      3328
#define XB_TOPGEN   3392
#define XCD_BAR_WORDS 3456
#define XB_SPIN_CAP (1u << 18)
__device__ __forceinline__ unsigned xb_ld(unsigned* p)              { return __hip_atomic_load(p, __ATOMIC_RELAXED, __HIP_MEMORY_SCOPE_AGENT); }
__device__ __forceinline__ unsigned xb_add(unsigned* p, unsigned v) { return __hip_atomic_fetch_add(p, v, __ATOMIC_RELAXED, __HIP_MEMORY_SCOPE_AGENT); }
__device__ __forceinline__ unsigned xb_xcc_id() { return (unsigned)__builtin_amdgcn_s_getreg((3 << 11) | 20) & 0xFu; }
#define XB_SPIN(cond, bar) do { unsigned _sp = 0; while (cond) { __builtin_amdgcn_s_sleep(1); \
    if ((++_sp & 255u) == 0u) { if (xb_ld(&(bar)[XB_TMO])) break; if (_sp > XB_SPIN_CAP) { atomicAdd(&(bar)[XB_TMO], 1u); break; } } } } while (0)
struct XcdBarrier { unsigned* bar; unsigned x; volatile LAS unsigned* st; };
__device__ __forceinline__ XcdBarrier xcd_barrier_post(unsigned* bar, volatile LAS unsigned* st) {
    XcdBarrier b; b.bar = bar; b.x = xb_xcc_id(); b.st = st;
    if (threadIdx.x == 0) (void)xb_add(&bar[XB_XCNT(b.x)], 1u);
    return b; }
__device__ __forceinline__ void xcd_barrier_complete(unsigned* bar, unsigned x, unsigned& nloc, unsigned& nx) {
    const unsigned G = gridDim.x * gridDim.y * gridDim.z; unsigned sum, cnt, mine, sp = 0u;
    for (;;) { sum = 0u; cnt = 0u; mine = 0u;
#pragma unroll
        for (unsigned j = 0; j < 16; ++j) { const unsigned c = xb_ld(&bar[XB_XCNT(j)]); sum += c; cnt += (c > 0u) ? 1u : 0u; mine = (j == x) ? c : mine; }
        if (sum == G) break;
        __builtin_amdgcn_s_sleep(1);
        if ((++sp & 255u) == 0u) { if (xb_ld(&bar[XB_TMO])) break; if (sp > XB_SPIN_CAP) { atomicAdd(&bar[XB_TMO], 1u); break; } } }
    nloc = mine > 0u ? mine : 1u; nx = cnt > 0u ? cnt : 1u; }
__device__ __forceinline__ void xcd_barrier(const XcdBarrier& b) {
    asm volatile("s_waitcnt vmcnt(0)" ::: "memory");
    __syncthreads();
    if (threadIdx.x == 0) {
        unsigned* bar = b.bar;
        __builtin_amdgcn_s_waitcnt(0);
        unsigned nloc = b.st[0], nx = b.st[1];
        if (nloc == 0u) { xcd_barrier_complete(bar, b.x, nloc, nx); b.st[0] = nloc; b.st[1] = nx; }
        const unsigned old = xb_add(&bar[XB_XSUB(b.x)], 1u);
        const unsigned gen = old / nloc;
        if (old + 1u == (gen + 1u) * nloc) {
            __builtin_amdgcn_fence(__ATOMIC_RELEASE, "agent");
            asm volatile("s_waitcnt vmcnt(0)" ::: "memory");
            const unsigned og = xb_add(&bar[XB_TOP], 1u);
            const unsigned tg = og / nx;
            if (og + 1u == (tg + 1u) * nx) xb_add(&bar[XB_TOPGEN], 1u);
            else XB_SPIN(xb_ld(&bar[XB_TOPGEN]) == tg, bar);
            __builtin_amdgcn_fence(__ATOMIC_ACQUIRE, "agent");
            xb_add(&bar[XB_XGEN(b.x)], 1u);
            asm volatile("s_waitcnt vmcnt(0)" ::: "memory");
        } else {
            XB_SPIN(xb_ld(&bar[XB_XGEN(b.x)]) == gen, bar);
            __builtin_amdgcn_fence(__ATOMIC_ACQUIRE, "agent");
            asm volatile("s_waitcnt vmcnt(0)" ::: "memory");
        }
    }
    __syncthreads();
}

namespace cg = cooperative_groups;
#define PASS(N, CALL) do { const long _n = (long)(N); int t0_ = threadIdx.x; asm volatile("" : "+v"(t0_)); for (long it = (long)blockIdx.x * 512 + t0_; it < _n; it += (long)gridDim.x * 512) { CALL; } } while (0)
#define GEMM(D) gemm_run(lds, D)
#define SYNC() xcd_barrier(xb)
#ifndef STAGGER_US
#define STAGGER_US 40
#endif
#define STAGGER(US) do { if ((US) > 0 && (xb.x & 1u)) { const unsigned long long t0_ = __builtin_amdgcn_s_memrealtime(); while (__builtin_amdgcn_s_memrealtime() - t0_ < (unsigned long long)(US) * 100ull) __builtin_amdgcn_s_sleep(8); } } while (0)
#define GRIDSYNC() grid.sync()
#define HOOK(L, S) do { } while (0)
#define ATTN(NITEMS) do { for (int it = blockIdx.x; it < (NITEMS); it += gridDim.x) { AttItem ai_; att_item(p, it, ai_); att_body(ai_, (char*)shm); } } while (0)
#else
template <class Dsc> static void gemm_emu(const Dsc& D) {
    std::vector<int> Ls; for (int c = 0; c < 256; ++c) for (int i = 0;; ++i) { Unit u{}; if (!D.unit(i * 256 + c, u)) break; Ls.push_back(i * 256 + c); }
    const int n = (int)Ls.size();
#pragma omp parallel for schedule(dynamic)
    for (int li = 0; li < n; ++li) { const int L = Ls[li]; Unit u{}; D.unit(L, u); const int K = Dsc::K;
        std::vector<float> A((size_t)256 * K), B((size_t)256 * K), C((size_t)256 * 256);
        for (int r = 0; r < 256; ++r) for (int k = 0; k < K; ++k) { A[(size_t)r * K + k] = bf2f(u.A[(size_t)r * Dsc::lda + k]); B[(size_t)r * K + k] = bf2f(u.B[(size_t)r * Dsc::ldb + k]); }
        for (int r = 0; r < 256; ++r) for (int c = 0; c < 256; ++c) { float s = 0.f; const float* a = &A[(size_t)r * K]; const float* b = &B[(size_t)c * K]; for (int k = 0; k < K; ++k) s += a[k] * b[k]; C[r * 256 + c] = s; }
        for (int r = 0; r < 128; ++r) for (int c = 0; c < 128; c += 4) { f32x4 v[2][2];
            for (int X = 0; X < 2; ++X) for (int Y = 0; Y < 2; ++Y) for (int j = 0; j < 4; ++j) v[X][Y][j] = C[(r + 128 * X) * 256 + c + 128 * Y + j];
            D.emit(u, r, c, v[0][0], v[0][1], v[1][0], v[1][1]); } } }
static void att_emu(const P& p, int nitems) {
#pragma omp parallel for schedule(dynamic)
    for (int it = 0; it < nitems; ++it) { AttItem a; att_item(p, it, a); std::vector<float> s(a.ntot);
        for (int i = 0; i < 256; ++i) { const u16* q = a.q + (size_t)i * 1536; float l = 0.f; float o[128]; for (int e = 0; e < 128; ++e) o[e] = 0.f;
            for (int k = 0; k < a.ntot; ++k) { const u16* kr = k < a.n0 ? a.k0 + (size_t)k * 1536 : a.k1 + (size_t)(k - a.n0) * 1536; float d = 0.f; for (int x = 0; x < 192; ++x) d += bf2f(q[x]) * bf2f(kr[x]);
                const float pv = bf2f(f2bf(expf(d * ATT_SCALE))); l += expf(d * ATT_SCALE); const u16* vr = k < a.n0 ? a.v0 + (size_t)k * 1024 : a.v1 + (size_t)(k - a.n0) * 1024; for (int e = 0; e < 128; ++e) o[e] += pv * bf2f(vr[e]); }
            for (int e = 0; e < 128; ++e) a.o[(size_t)i * 1024 + e] = f2bf(o[e] / l); } } }
#define PASS(N, CALL) do { const long _n = (long)(N); _Pragma("omp parallel for schedule(static)") for (long it = 0; it < _n; ++it) { CALL; } } while (0)
#define WPASS(N, HOSTCALL, DEVCALL) PASS(N, HOSTCALL)
#define MODPHASE() PASS(DEPTH * 9216, mod_item(p, (int)it))
#define MIXED_DOWN_NORM(DESC, LAYER2, KK, S5F, ASHARE) do { gemm_emu(DESC); PASS(NL, norm_item(p, LAYER2, KK, (int)it, S5F)); } while (0)
#define CTXNORM(LAYER2, KK, S5F) PASS(NC, norm_item(p, LAYER2, KK, NL + (int)it, S5F))
#define MIXED_RET_TAIL(LATDESC, CTXDESC, NCW, LAYER2, KK, RA, RB) do { gemm_emu(LATDESC); gemm_emu(CTXDESC); PASS((RB) - (RA), norm_item(p, LAYER2, KK, (RA) + (int)it, 0)); } while (0)
#define RANGENORM(LAYER2, KK, RA, RB) PASS((RB) - (RA), norm_item(p, LAYER2, KK, (RA) + (int)it, 0))
#define GEMM(D) gemm_emu(D)
#define SYNC() do { } while (0)
#define STAGGER(US) do { } while (0)
#define GRIDSYNC() do { } while (0)
#define ATTN(NITEMS) att_emu(p, NITEMS)
static void emu_hook(const P& p, int layer, int stage);
#define HOOK(L, S) emu_hook(p, L, S)
#endif

#ifndef HOST_EMU
__global__ void __launch_bounds__(512) fwd_megakernel(P p) {
    extern __shared__ __attribute__((aligned(16))) unsigned char shm[];
    LAS unsigned char* lds = (LAS unsigned char*)shm;
    cg::grid_group grid = cg::this_grid();
    volatile LAS unsigned* xst = (volatile LAS unsigned*)(lds + STAGE_BYTES + 1024);
    if (threadIdx.x == 0) { xst[0] = 0u; xst[1] = 0u; xst[2] = 0u; xst[3] = 0u; }
    __syncthreads();
    const XcdBarrier xb = xcd_barrier_post((unsigned*)(p.ws + O_BAR), xst);
#else
static void fwd_emu(P p) {
#endif
    if (PM(0)) { MODPHASE();
    PASS((long)NC * 256, ((f32x4*)(p.ws + O_G))[it] = ((const f32x4*)p.in[2])[it]);
    PASS(CV_TOTAL, cvt_item(p, it));
    PASS(64 * 2 * 32 * 16, s5_ktab_item(p, (int)it));
    PASS(64 * 256 * 512, s5_fext_item(p, (int)it)); }
    GRIDSYNC();
    if (PM(0)) { PASS((long)64 * 512 * 768, s5_text_item(p, it)); }
    for (int rep_ = 0; rep_ < REP_SYNC; ++rep_) SYNC();
    for (int layer = 0; layer < DEPTH; ++layer) {
        const int kind = layer % 3, j = layer / 3; const bool last = layer == DEPTH - 1;
        if (layer == 0) { if (PM(1)) { WPASS(MT, norm_item(p, layer, 0, (int)it, 0), norm_wave(p, layer, 0, it, 0, lane)); } SYNC(); }
        for (int rep_ = 0; rep_ < REP_UP; ++rep_) { if (PM(2)) { DFfnUp d{p, layer, 0, MT / 256}; GEMM(d); } SYNC(); }
        if (PM(3)) { DFfnDown d{p, layer, 0, NL / 256, 0.5f}; GEMM(d); } SYNC();
        if (PM(3)) { DFfnDown d{p, layer, 0, -1, 0.5f}; MIXED_DOWN_NORM(d, layer, 1, kind == 2 ? 1 : 0, 56); } SYNC();
        if (PM(1)) { CTXNORM(layer, 1, kind == 2 ? 1 : 0); } SYNC();
        if (kind == 0) {
            for (int rep_ = 0; rep_ < REP_MLA; ++rep_) { if (PM(4)) { DMlaIn d{p, j}; GEMM(d); } SYNC(); }
            if (PM(5)) { WPASS(MT, mla_row_item(p, j, (int)it), mla_row_wave(p, j, it, lane)); } SYNC();
            for (int rep_ = 0; rep_ < REP_MLA; ++rep_) { if (PM(6)) { DMlaUq d{p, j, last ? NL / 256 : MT / 256}; GEMM(d); } if (PM(7)) { DMlaUkv d{p, j}; GEMM(d); } SYNC(); }
            if (PM(8)) { WPASS(MT, { for (int h_ = 0; h_ < 8; ++h_) mla_head_item(p, j, (int)it * 8 + h_); }, mla_head_wave(p, j, it, lane)); } SYNC();
            for (int rep_ = 0; rep_ < REP_ATT; ++rep_) { if (PM(9)) { ATTN(NB * 8 * (SEQ / 256) + (last ? 0 : NB * 8)); } SYNC(); }
            if (PM(10)) { DMlaO d{p, layer, j, NL / 256}; GEMM(d); } SYNC();
            if (!last) { if (PM(10)) { DMlaO d{p, layer, j, -1}; MIXED_DOWN_NORM(d, layer, 2, 0, 184); } SYNC();
                if (PM(1)) { CTXNORM(layer, 2, 0); } SYNC(); }
        } else if (kind == 1) {
            for (int q = 0; q < NB / RGB; ++q) {
                for (int rep_ = 0; rep_ < REP_RET; ++rep_) { if (PM(11)) { DRetProjAll d{p, q}; GEMM(d); } SYNC(); }
                for (int rep_ = 0; rep_ < REP_RET; ++rep_) { if (PM(13)) { DRetP d{p}; GEMM(d); } if (PM(14)) { DRetL d{p}; GEMM(d); } SYNC(); }
                if (PM(15)) { PASS(4 * RGB * 512 * 64, ret_prefix_item(p, (int)it)); } SYNC();
                for (int rep_ = 0; rep_ < REP_RET; ++rep_) { if (PM(16)) { DRetO d{p}; GEMM(d); } SYNC(); }
                if (PM(17)) { WPASS(NCQ * 256, { for (int h_ = 0; h_ < 4; ++h_) ret_norm_item(p, q, (int)it * 4 + h_); }, ret_norm_wave(p, q, it, lane)); } SYNC();
                if (q < NB / RGB - 1) { if (PM(18)) { DRetWo d{p, layer, q}; GEMM(d); } SYNC(); }
                else { if (PM(18)) { DRetWo d{p, layer, q}; DRetWoCtx c{p, layer}; MIXED_RET_TAIL(d, c, (NC / 256) * 4, layer, 2, 0, q * RGB * SEQ); } SYNC();
                    if (PM(1)) { RANGENORM(layer, 2, q * RGB * SEQ, MT); } SYNC(); }
            }
        } else {
            for (int rep_ = 0; rep_ < REP_S5; ++rep_) { if (PM(20)) { DS5L d{p}; GEMM(d); } SYNC(); }
            if (PM(21)) { PASS(64 * NB * 64, s5_prefix_item(p, (int)it)); } SYNC();
            for (int rep_ = 0; rep_ < REP_S5; ++rep_) { if (PM(22)) { DS5Y d{p}; GEMM(d); } SYNC(); }
            if (PM(23)) { DS5Glu d{p, layer}; GEMM(d); } SYNC();
        }
        HOOK(layer, 0);
        if (kind == 2 || (kind == 0 && last)) { if (PM(1)) { WPASS(last ? NL : MT, norm_item(p, layer, 2, (int)it, 0), norm_wave(p, layer, 2, it, 0, lane)); } SYNC(); }
        for (int rep_ = 0; rep_ < REP_UP; ++rep_) { if (PM(2)) { DFfnUp d{p, layer, 1, last ? NL / 256 : MT / 256}; GEMM(d); } SYNC(); }
        if (PM(3)) { DFfnDown d{p, layer, 1, NL / 256, 0.5f}; GEMM(d); } SYNC();
        if (!last) { if (PM(3)) { DFfnDown d{p, layer, 1, -1, 0.5f}; MIXED_DOWN_NORM(d, layer + 1, 0, 0, 56); } SYNC();
            if (PM(1)) { CTXNORM(layer + 1, 0, 0); } SYNC(); }
        HOOK(layer, 1);
    }
}

#ifndef HOST_EMU
extern "C" void kernel_launch(void* const* d_in, const int* in_sizes, int n_in, void* d_out, int out_size, void* d_ws, size_t ws_size, hipStream_t stream) {
    constexpr size_t kDynLds = STAGE_BYTES + 4096;
    static int grid_blocks = 0;
    if (!grid_blocks) {
        int dev = 0, cus = 0, per_cu = 0;
        hipGetDevice(&dev);
        hipDeviceGetAttribute(&cus, hipDeviceAttributeMultiprocessorCount, dev);
        hipFuncSetAttribute((const void*)fwd_megakernel, hipFuncAttributeMaxDynamicSharedMemorySize, (int)kDynLds);
        hipOccupancyMaxActiveBlocksPerMultiprocessor(&per_cu, fwd_megakernel, 512, kDynLds);
        if (per_cu < 1) per_cu = 1;
        if (per_cu > 1) per_cu = 1;
        grid_blocks = cus * per_cu;
        if (ws_size < WS_NEED) fprintf(stderr, "workspace too small: %zu < %zu\n", ws_size, (size_t)WS_NEED);
    }
    P p{};
    for (int i = 0; i < 31 && i < n_in; ++i) p.in[i] = (const float*)d_in[i];
    p.out = (float*)d_out; p.ws = (char*)d_ws;
    hipMemsetAsync((char*)d_ws + O_BAR, 0, XCD_BAR_WORDS * 4, stream);
    void* args[] = {&p};
    hipError_t e = hipLaunchCooperativeKernel((void*)fwd_megakernel, dim3(grid_blocks), dim3(512), args, kDynLds, stream);
    if (e != hipSuccess) fprintf(stderr, "cooperative launch failed: %s (grid %d)\n", hipGetErrorString(e), grid_blocks);
}
#endif
```

```cpp
#ifdef HOST_EMU
#include <cmath>
#include <cstdio>
#include <cstdlib>
#include <cstring>
#include <vector>
#define HD inline
#else
#include <hip/hip_runtime.h>
#include <hip/hip_cooperative_groups.h>
#include <cstdio>
#define HD __device__ __forceinline__
#endif

#ifndef CFG_BATCH
#define CFG_BATCH 16
#endif
#ifndef CFG_SEQ
#define CFG_SEQ 4096
#endif

typedef unsigned short u16;
typedef float f32x4 __attribute__((ext_vector_type(4)));
typedef unsigned u32x2 __attribute__((ext_vector_type(2)));

constexpr int DM = 1024, NB = CFG_BATCH, SEQ = CFG_SEQ, CTX = 256, DFF = 2816, DEPTH = 4;
constexpr int NL = NB * SEQ, NC = NB * CTX, MT = NL + NC;
constexpr int NMR = NB + 1;
constexpr int RGB = (NB >= 4) ? 4 : 1;
constexpr int NCH = 1 + SEQ / 256;
constexpr int NCQ = RGB * NCH;
constexpr int S5L = SEQ / 32, S5C = CTX / 32;
constexpr int NROW5 = NB * S5L + NB * S5C;
constexpr int NROW5P = (NROW5 + 255) / 256 * 256;
constexpr float EPS = 1e-6f;
constexpr float ATT_SCALE = 0.07216878364870322f;
constexpr float QSCALE = ATT_SCALE * 1.4426950408889634f;

constexpr size_t al(size_t x) { return (x + 255) & ~(size_t)255; }
constexpr size_t O_BAR = 0;
constexpr size_t O_MOD = 16384;
constexpr size_t O_G = O_MOD + al((size_t)DEPTH * NMR * 9216 * 4);
constexpr size_t O_FFI = O_G + al((size_t)NC * 1024 * 4);
constexpr size_t SZ_FFI1 = (size_t)5632 * 1024 * 2, SZ_FFO1 = (size_t)1024 * 2816 * 2;
constexpr size_t O_FFO = O_FFI + 8 * SZ_FFI1;
constexpr size_t O_MWIN = O_FFO + 8 * SZ_FFO1;
constexpr size_t SZ_MWIN = (size_t)768 * 1024 * 2, SZ_MWUQ = (size_t)1536 * 384 * 2, SZ_MWUKV = (size_t)2048 * 256 * 2, SZ_MWO = (size_t)1024 * 1024 * 2;
constexpr size_t O_MWUQ = O_MWIN + 2 * SZ_MWIN;
constexpr size_t O_MWUKV = O_MWUQ + 2 * SZ_MWUQ;
constexpr size_t O_MWO = O_MWUKV + 2 * SZ_MWUKV;
constexpr size_t O_RWIN = O_MWO + 2 * SZ_MWO;
constexpr size_t O_RWO = O_RWIN + (size_t)6144 * 1024 * 2;
constexpr size_t O_GLU = O_RWO + (size_t)1024 * 2048 * 2;
constexpr size_t O_HN = O_GLU + (size_t)2048 * 1024 * 2;
constexpr size_t O_KTAB = O_HN + al((size_t)MT * 1024 * 2);
constexpr size_t O_TEXT = O_KTAB + al((size_t)64 * 2 * 32 * 256 * 4);
constexpr size_t O_FEXT = O_TEXT + al((size_t)64 * 512 * 768 * 2);
constexpr size_t O_SCR = O_FEXT + al((size_t)64 * 256 * 512 * 2);
constexpr size_t O_ACT = O_SCR;
constexpr size_t O_CALL = O_SCR;
constexpr size_t O_CQN = O_CALL + al((size_t)MT * 768 * 4);
constexpr size_t O_CKVN = O_CQN + al((size_t)MT * 384 * 2);
constexpr size_t O_KF = O_CKVN + al((size_t)MT * 256 * 2);
constexpr size_t O_VB = O_KF + al((size_t)MT * 1536 * 2);
constexpr size_t END_MLA = O_VB + al((size_t)MT * 1024 * 2);
constexpr size_t O_QN = O_SCR;
constexpr size_t O_KN = O_QN + al((size_t)NCQ * 256 * 1024 * 2);
constexpr size_t O_GATE = O_KN + al((size_t)NCQ * 256 * 1024 * 2);
constexpr size_t O_OB = O_GATE + al((size_t)NCQ * 256 * 2048 * 2);
constexpr size_t O_AEXT = O_OB + al((size_t)NCQ * 256 * 2048 * 2);
constexpr size_t O_KTX = O_AEXT + al((size_t)4 * NCQ * 256 * 768 * 2);
constexpr size_t O_BEXT = O_KTX + al((size_t)4 * NCQ * 2 * 256 * 256 * 2);
constexpr size_t O_YCTX = O_BEXT + al((size_t)4 * NCQ * 512 * 768 * 2);
constexpr size_t END_RET = O_YCTX + al((size_t)NC * 2048 * 2);
constexpr size_t O_UEXT = O_SCR;
constexpr size_t END_S5 = O_UEXT + al((size_t)64 * NROW5P * 768 * 2);
constexpr size_t END_FFN = O_ACT + al((size_t)MT * 2816 * 2);
constexpr size_t cmax(size_t a, size_t b) { return a > b ? a : b; }
constexpr size_t WS_NEED = cmax(cmax(END_MLA, END_RET), cmax(END_S5, END_FFN));

struct P { const float* in[32]; float* out; char* ws; };
#ifndef PHASE_MASK
#define PHASE_MASK 0xFFFFFFFFu
#endif
#define PM(b) ((PHASE_MASK >> (b)) & 1u)
#ifndef REP_UP
#define REP_UP 1
#endif
#ifndef REP_ATT
#define REP_ATT 1
#endif
#ifndef REP_NORM
#define REP_NORM 1
#endif
#ifndef REP_RET
#define REP_RET 1
#endif
#ifndef REP_DOWN
#define REP_DOWN 1
#endif
#ifndef REP_MLA
#define REP_MLA 1
#endif
#ifndef REP_S5
#define REP_S5 1
#endif
#ifndef REP_SYNC
#define REP_SYNC 0
#endif

HD float bf2f(u16 b) { union { unsigned u; float f; } x; x.u = ((unsigned)b) << 16; return x.f; }
HD u16 f2bf(float f) { union { unsigned u; float f; } x; x.f = f; unsigned u = x.u; u += 0x7fffu + ((u >> 16) & 1u); return (u16)(u >> 16); }
#ifdef HOST_EMU
HD void st4bf(u16* p, f32x4 v) { u32x2 w; w.x = (unsigned)f2bf(v[0]) | ((unsigned)f2bf(v[1]) << 16); w.y = (unsigned)f2bf(v[2]) | ((unsigned)f2bf(v[3]) << 16); *(u32x2*)p = w; }
#else
HD unsigned cvtpk_bf(float lo, float hi) { unsigned r; asm("v_cvt_pk_bf16_f32 %0, %1, %2" : "=v"(r) : "v"(lo), "v"(hi)); return r; }
HD void st4bf(u16* p, f32x4 v) { u32x2 w; w.x = cvtpk_bf(v[0], v[1]); w.y = cvtpk_bf(v[2], v[3]); *(u32x2*)p = w; }
#endif
#ifdef HOST_EMU
HD float silu_f(float a) { return a / (1.0f + expf(-a)); }
HD float sigm_f(float a) { return 1.0f / (1.0f + expf(-a)); }
HD float gelu_f(float x) { return 0.5f * x * (1.0f + tanhf(0.7978845608028654f * (x + 0.044715f * x * x * x))); }
#else
HD float sigm_f(float a) { return __builtin_amdgcn_rcpf(1.0f + __builtin_amdgcn_exp2f(-1.4426950408889634f * a)); }
HD float silu_f(float a) { return a * sigm_f(a); }
HD float gelu_f(float x) { return x * sigm_f(1.5957691216057308f * (x + 0.044715f * x * x * x)); }
#endif
HD float rsq_f(float x) { return 1.0f / sqrtf(x); }
HD float ex2(float x) {
#ifdef HOST_EMU
    return exp2f(x);
#else
    return __builtin_amdgcn_exp2f(x);
#endif
}
HD const float* hsrc(const P& p, int r, int first) { if (first && r < NL) return p.in[0] + (size_t)r * 1024; return r < NL ? p.out + (size_t)r * 1024 : (const float*)(p.ws + O_G) + (size_t)(r - NL) * 1024; }
HD float* hrow(const P& p, int r) { return r < NL ? p.out + (size_t)r * 1024 : (float*)(p.ws + O_G) + (size_t)(r - NL) * 1024; }
HD const float* modp(const P& p, int layer, int r, int idx) { const int mr = r < NL ? r / SEQ : NB; return (const float*)(p.ws + O_MOD) + ((size_t)(layer * NMR + mr) * 9 + idx) * 1024; }
HD u16* wsb(const P& p, size_t off) { return (u16*)(p.ws + off); }
#ifdef HOST_EMU
HD float ropef(int d, int half) { return expf(-(float)d * (9.210340371976184f / (float)half)) * 0.15915494309189535f; }
#else
HD float ropef(int d, int half) { return __builtin_amdgcn_exp2f(-(float)d * (13.287712379549449f / (float)half)) * 0.15915494309189535f; }
#endif
HD void sincos_t(float turns, float& sn, float& cs) {
    const float f = turns - floorf(turns);
#ifdef HOST_EMU
    sn = sinf(6.283185307179586f * f); cs = cosf(6.283185307179586f * f);
#else
    sn = __builtin_amdgcn_sinf(f); cs = __builtin_amdgcn_cosf(f);
#endif
}

HD bool rect_unit(int L, int nM, int nN, int& pm, int& pn) {
    const int nwg = nM * nN; if (L >= nwg) return false;
    int wgid = L; { const int q = nwg / 8, r = nwg % 8, xcd = wgid % 8, off = wgid / 8; wgid = (xcd < r ? xcd * (q + 1) : r * (q + 1) + (xcd - r) * q) + off; }
    const int nig = 8 * nN, gid = wgid / nig, fm = gid * 8, gsz = (nM - fm) < 8 ? (nM - fm) : 8;
    pm = fm + ((wgid % nig) % gsz); pn = (wgid % nig) / gsz; return true;
}

struct Unit { const u16* A; const u16* B; int a, b, c, d; float f0, f1; };

struct DFfnUp { P p; int layer, f, nM; static constexpr int FENCE = 1; static constexpr int K = 1024, lda = 1024, ldb = 1024;
    HD bool unit(int L, Unit& u) const { int pm, pn; if (!rect_unit(L, nM, 22, pm, pn)) return false;
        u.A = wsb(p, O_HN) + (size_t)pm * 256 * 1024; u.B = wsb(p, O_FFI + (size_t)(layer * 2 + f) * SZ_FFI1) + (size_t)pn * 256 * 1024; u.a = pm; u.b = pn; u.c = 0; u.d = 0; return true; }
    HD void emit(const Unit& u, int r, int c, f32x4 v00, f32x4 v01, f32x4 v10, f32x4 v11) const {
        u16* act = wsb(p, O_ACT); const size_t R = (size_t)u.a * 256 + r; const int col = u.b * 128 + c; f32x4 o0, o1;
        for (int j = 0; j < 4; ++j) { o0[j] = silu_f(v00[j]) * v01[j]; o1[j] = silu_f(v10[j]) * v11[j]; }
        st4bf(act + R * 2816 + col, o0); st4bf(act + (R + 128) * 2816 + col, o1); } };

HD void resid4(const P& p, int layer, int midx, float sc, int R, int col, f32x4 v, int first = 0) {
    float* h = hrow(p, R) + col; const float* m = modp(p, layer, R, midx) + col; f32x4 x = *(const f32x4*)(hsrc(p, R, first) + col);
    for (int j = 0; j < 4; ++j) x[j] += sc * m[j] * v[j];
    *(f32x4*)h = x; }

struct DFfnDown { P p; int layer, f, nM; float sc; static constexpr int FENCE = 4; static constexpr int K = 2816, lda = 2816, ldb = 2816;
    HD bool unit(int L, Unit& u) const { int pm, pn;
        if (nM < 0) { if (L >= (NC / 256) * 4) return false; pm = NL / 256 + (L >> 2); pn = L & 3; }
        else if (((NL / 256) * 4) % 256 == 0 && nM > NL / 256) {
            if (L < (NL / 256) * 4) rect_unit(L, NL / 256, 4, pm, pn);
            else { const int c = L - (NL / 256) * 4; if (c >= 128 || (c & 1)) return false; const int k = c >> 1; pm = NL / 256 + (k >> 2); pn = k & 3; if (pm >= nM) return false; } }
        else if (!rect_unit(L, nM, 4, pm, pn)) return false;
        u.A = wsb(p, O_ACT) + (size_t)pm * 256 * 2816; u.B = wsb(p, O_FFO + (size_t)(layer * 2 + f) * SZ_FFO1) + (size_t)pn * 256 * 2816; u.a = pm; u.b = pn; u.c = 0; u.d = 0; return true; }
    HD void emit(const Unit& u, int r, int c, f32x4 v00, f32x4 v01, f32x4 v10, f32x4 v11) const {
        const int R = u.a * 256 + r, col = u.b * 256 + c, mi = f ? 8 : 2;
        const int first = (layer == 0 && f == 0 && sc != 0.f);
        resid4(p, layer, mi, sc, R, col, v00, first); resid4(p, layer, mi, sc, R, col + 128, v01, first); resid4(p, layer, mi, sc, R + 128, col, v10, first); resid4(p, layer, mi, sc, R + 128, col + 128, v11, first); } };
HD void atom4(float* g, const float* m, float sc, f32x4 v) {
#ifdef HOST_EMU
    for (int j = 0; j < 4; ++j) {
#pragma omp atomic
        g[j] += sc * m[j] * v[j]; }
#else
    for (int j = 0; j < 4; ++j) unsafeAtomicAdd(g + j, sc * m[j] * v[j]);
#endif
}
template <int KS, int SL0> struct DFfnDownCtx { P p; int layer, f; float sc; static constexpr int FENCE = 4; static constexpr int K = KS, lda = 2816, ldb = 2816;
    HD bool unit(int L, Unit& u) const { if (L >= 256) return false; const int x = SL0 ? (L + 128) % 256 : L; if (x >= 128 || x >= (NC / 256) * 8) return false;
        const int sl = x & 1, pn = (x >> 1) & 3, pm = NL / 256 + (x >> 3); const int k0 = SL0 ? 1536 + sl * 640 : sl * 768;
        u.A = wsb(p, O_ACT) + (size_t)pm * 256 * 2816 + k0; u.B = wsb(p, O_FFO + (size_t)(layer * 2 + f) * SZ_FFO1) + (size_t)pn * 256 * 2816 + k0; u.a = pm; u.b = pn; u.c = 0; u.d = 0; return true; }
    HD void one(int R, int col, f32x4 v) const { atom4(hrow(p, R) + col, modp(p, layer, R, f ? 8 : 2) + col, sc, v); }
    HD void emit(const Unit& u, int r, int c, f32x4 v00, f32x4 v01, f32x4 v10, f32x4 v11) const {
        const int R = u.a * 256 + r, col = u.b * 256 + c; one(R, col, v00); one(R, col + 128, v01); one(R + 128, col, v10); one(R + 128, col + 128, v11); } };

struct DMlaIn { P p; int j; static constexpr int FENCE = 1; static constexpr int K = 1024, lda = 1024, ldb = 1024;
    HD bool unit(int L, Unit& u) const { int pm, pn; if (!rect_unit(L, MT / 256, 3, pm, pn)) return false;
        u.A = wsb(p, O_HN) + (size_t)pm * 256 * 1024; u.B = wsb(p, O_MWIN + j * SZ_MWIN) + (size_t)pn * 256 * 1024; u.a = pm; u.b = pn; u.c = 0; u.d = 0; return true; }
    HD void emit(const Unit& u, int r, int c, f32x4 v00, f32x4 v01, f32x4 v10, f32x4 v11) const {
        float* o = (float*)(p.ws + O_CALL) + ((size_t)u.a * 256 + r) * 768 + u.b * 256 + c;
        *(f32x4*)o = v00; *(f32x4*)(o + 128) = v01; *(f32x4*)(o + (size_t)128 * 768) = v10; *(f32x4*)(o + (size_t)128 * 768 + 128) = v11; } };
struct DMlaUq { P p; int j, nM; static constexpr int FENCE = 1; static constexpr int K = 384, lda = 384, ldb = 384;
    HD bool unit(int L, Unit& u) const { int pm, pn; if (!rect_unit(L, nM, 6, pm, pn)) return false;
        u.A = wsb(p, O_CQN) + (size_t)pm * 256 * 384; u.B = wsb(p, O_MWUQ + j * SZ_MWUQ) + (size_t)pn * 256 * 384; u.a = pm; u.b = pn; u.c = 0; u.d = 0; return true; }
    HD void emit(const Unit& u, int r, int c, f32x4 v00, f32x4 v01, f32x4 v10, f32x4 v11) const {
        u16* o = wsb(p, O_CALL) + ((size_t)u.a * 256 + r) * 1536 + u.b * 256 + c;
        st4bf(o, v00); st4bf(o + 128, v01); st4bf(o + (size_t)128 * 1536, v10); st4bf(o + (size_t)128 * 1536 + 128, v11); } };
struct DMlaUkv { P p; int j; static constexpr int FENCE = 1; static constexpr int K = 256, lda = 256, ldb = 256;
    HD bool unit(int L, Unit& u) const { int pm, pn; if (!rect_unit(L, MT / 256, 8, pm, pn)) return false;
        u.A = wsb(p, O_CKVN) + (size_t)pm * 256 * 256; u.B = wsb(p, O_MWUKV + j * SZ_MWUKV) + (size_t)pn * 256 * 256; u.a = pm; u.b = pn; u.c = 0; u.d = 0; return true; }
    HD void one(size_t R, int col, f32x4 v) const {
        if (col < 1024) st4bf(wsb(p, O_KF) + R * 1536 + (col >> 7) * 192 + (col & 127), v);
        else st4bf(wsb(p, O_VB) + R * 1024 + (col - 1024), v); }
    HD void emit(const Unit& u, int r, int c, f32x4 v00, f32x4 v01, f32x4 v10, f32x4 v11) const {
        const size_t R = (size_t)u.a * 256 + r; const int col = u.b * 256 + c;
        one(R, col, v00); one(R, col + 128, v01); one(R + 128, col, v10); one(R + 128, col + 128, v11); } };
struct DMlaO { P p; int layer, j, nM; static constexpr int FENCE = 4; static constexpr int K = 1024, lda = 1024, ldb = 1024;
    HD bool unit(int L, Unit& u) const { int pm, pn;
        if (nM < 0) { if (L >= (NC / 256) * 4) return false; pm = NL / 256 + (L >> 2); pn = L & 3; }
        else if (!rect_unit(L, nM, 4, pm, pn)) return false;
        u.A = wsb(p, O_HN) + (size_t)pm * 256 * 1024; u.B = wsb(p, O_MWO + j * SZ_MWO) + (size_t)pn * 256 * 1024; u.a = pm; u.b = pn; u.c = 0; u.d = 0; return true; }
    HD void emit(const Unit& u, int r, int c, f32x4 v00, f32x4 v01, f32x4 v10, f32x4 v11) const {
        const int R = u.a * 256 + r, col = u.b * 256 + c;
        resid4(p, layer, 5, 1.0f, R, col, v00); resid4(p, layer, 5, 1.0f, R, col + 128, v01); resid4(p, layer, 5, 1.0f, R + 128, col, v10); resid4(p, layer, 5, 1.0f, R + 128, col + 128, v11); } };

HD int ret_tokrow(int q, int cidx) { const int b = q * RGB + cidx / NCH, n = cidx % NCH; return n == 0 ? NL + b * 256 : b * SEQ + (n - 1) * 256; }
HD float ret_logg(const P& p, int dir, int h) { return log1pf(-expf(p.in[18][dir * 4 + h])); }
struct DRetProj { P p; int q; static constexpr int FENCE = 1; static constexpr int K = 1024, lda = 1024, ldb = 1024;
    HD bool unit(int L, Unit& u) const { int pm, pn; if (!rect_unit(L, NCQ, 16, pm, pn)) return false;
        const int wrow = pn < 8 ? pn * 256 : 4096 + (pn - 8) * 256;
        u.A = wsb(p, O_HN) + (size_t)ret_tokrow(q, pm) * 1024; u.B = wsb(p, O_RWIN) + (size_t)wrow * 1024; u.a = pm; u.b = pn; u.c = 0; u.d = 0;
        u.f0 = ret_logg(p, 0, pn & 3) * 1.4426950408889634f; u.f1 = ret_logg(p, 1, pn & 3) * 1.4426950408889634f; return true; }
    HD void emit(const Unit& u, int r, int c, f32x4 v00, f32x4 v01, f32x4 v10, f32x4 v11) const {
        const int cidx = u.a, pn = u.b, n = cidx % NCH;
        if (pn >= 8) { u16* g = wsb(p, O_GATE) + ((size_t)cidx * 256 + r) * 2048 + (pn - 8) * 256 + c;
            st4bf(g, v00); st4bf(g + 128, v01); st4bf(g + (size_t)128 * 2048, v10); st4bf(g + (size_t)128 * 2048 + 128, v11); return; }
        const int h = pn & 3; const bool isq = pn < 4;
        const float lgf = u.f0, lgb = u.f1;
        for (int X = 0; X < 2; ++X) { const int i = r + 128 * X; const f32x4 x1 = X ? v10 : v00, x2 = X ? v11 : v01; f32x4 r1, r2;
            for (int jx = 0; jx < 4; ++jx) { float cs = 1.f, sn = 0.f;
                if (n > 0) sincos_t((float)((n - 1) * 256 + i) * ropef(c + jx, 128), sn, cs);
                r1[jx] = x1[jx] * cs - x2[jx] * sn; r2[jx] = x2[jx] * cs + x1[jx] * sn; }
            if (isq) { u16* qn = wsb(p, O_QN) + ((size_t)cidx * 256 + i) * 1024 + h * 256 + c; st4bf(qn, r1); st4bf(qn + 128, r2);
                const float df = ex2(lgf * (float)(i + 1)), db = ex2(lgb * (float)(256 - i));
                u16* ae = wsb(p, O_AEXT) + (((size_t)h * NCQ + cidx) * 256 + i) * 768;
                st4bf(ae + 256 + c, r1 * df); st4bf(ae + 384 + c, r2 * df); st4bf(ae + 512 + c, r1 * db); st4bf(ae + 640 + c, r2 * db); }
            else { u16* kn = wsb(p, O_KN) + ((size_t)cidx * 256 + i) * 1024 + h * 256 + c; st4bf(kn, r1 * 0.0625f); st4bf(kn + 128, r2 * 0.0625f); } } } };
struct DRetProjT { P p; int q; static constexpr int FENCE = 1; static constexpr int K = 1024, lda = 1024, ldb = 1024;
    HD bool unit(int L, Unit& u) const { int pm, pn; if (!rect_unit(L, 12, NCQ, pm, pn)) return false;
        u.A = wsb(p, O_RWIN) + (size_t)(1024 + pm * 256) * 1024; u.B = wsb(p, O_HN) + (size_t)ret_tokrow(q, pn) * 1024; u.a = pm; u.b = pn; u.c = 0; u.d = 0;
        u.f0 = ret_logg(p, 0, pm & 3) * 1.4426950408889634f; u.f1 = ret_logg(p, 1, pm & 3) * 1.4426950408889634f; return true; }
    HD void emit(const Unit& u, int r, int c, f32x4 v00, f32x4 v01, f32x4 v10, f32x4 v11) const {
        const int pm = u.a, cidx = u.b, n = cidx % NCH;
        if (pm >= 4) { const int h = (pm - 4) >> 1, e0 = ((pm - 4) & 1) * 256 + r; u16* be = wsb(p, O_BEXT) + (((size_t)h * NCQ + cidx) * 512 + e0) * 768 + c;
            st4bf(be, v00); st4bf(be + 128, v01); st4bf(be + (size_t)128 * 768, v10); st4bf(be + (size_t)128 * 768 + 128, v11); return; }
        const int h = pm; const float lgf = u.f0, lgb = u.f1, fr = ropef(r, 128);
        u16* kf = wsb(p, O_KTX) + (((size_t)h * NCQ + cidx) * 2 + 0) * 65536; u16* kb = kf + 65536;
        for (int Y = 0; Y < 2; ++Y) { const f32x4 x1 = Y ? v01 : v00, x2 = Y ? v11 : v10; f32x4 f1, f2, b1, b2;
            for (int jx = 0; jx < 4; ++jx) { const int jj = c + 128 * Y + jx; float cs = 1.f, sn = 0.f;
                if (n > 0) sincos_t((float)((n - 1) * 256 + jj) * fr, sn, cs);
                const float r1 = (x1[jx] * cs - x2[jx] * sn) * 0.0625f, r2 = (x2[jx] * cs + x1[jx] * sn) * 0.0625f;
                const float df = ex2(lgf * (float)(255 - jj)), db = ex2(lgb * (float)jj);
                f1[jx] = r1 * df; f2[jx] = r2 * df; b1[jx] = r1 * db; b2[jx] = r2 * db; }
            const int jc = c + 128 * Y;
            st4bf(kf + (size_t)r * 256 + jc, f1); st4bf(kf + (size_t)(r + 128) * 256 + jc, f2); st4bf(kb + (size_t)r * 256 + jc, b1); st4bf(kb + (size_t)(r + 128) * 256 + jc, b2); } } };
struct DRetProjAll { P p; int q; static constexpr int FENCE = 1; static constexpr int K = 1024, lda = 1024, ldb = 1024;
    HD bool unit(int L, Unit& u) const { const DRetProj a{p, q}; const DRetProjT b{p, q};
        if (L < NCQ * 16) { const bool ok = a.unit(L, u); u.d = 0; return ok; } const bool ok = b.unit(L - NCQ * 16, u); u.d = 1; return ok; }
    HD void emit(const Unit& u, int r, int c, f32x4 v00, f32x4 v01, f32x4 v10, f32x4 v11) const {
        if (u.d == 0) { const DRetProj a{p, q}; a.emit(u, r, c, v00, v01, v10, v11); } else { const DRetProjT b{p, q}; b.emit(u, r, c, v00, v01, v10, v11); } } };
struct DRetP { P p; static constexpr int FENCE = 1; static constexpr int K = 256, lda = 1024, ldb = 1024;
    HD bool unit(int L, Unit& u) const { int pm, pn; if (!rect_unit(L, NCQ, 4, pm, pn)) return false;
        u.A = wsb(p, O_QN) + (size_t)pm * 256 * 1024 + pn * 256; u.B = wsb(p, O_KN) + (size_t)pm * 256 * 1024 + pn * 256; u.a = pm; u.b = pn; u.c = 0; u.d = 0;
        u.f0 = ret_logg(p, 0, pn) * 1.4426950408889634f; u.f1 = ret_logg(p, 1, pn) * 1.4426950408889634f; return true; }
    HD void one(u16* ae, float lgf, float lgb, int i, int j0, f32x4 v) const { f32x4 o;
        for (int jx = 0; jx < 4; ++jx) { const int jj = j0 + jx; o[jx] = v[jx] * ex2(jj <= i ? lgf * (float)(i - jj) : lgb * (float)(jj - i)); }
        st4bf(ae + (size_t)i * 768 + j0, o); }
    HD void emit(const Unit& u, int r, int c, f32x4 v00, f32x4 v01, f32x4 v10, f32x4 v11) const {
        const int cidx = u.a, h = u.b; const float lgf = u.f0, lgb = u.f1;
        u16* ae = wsb(p, O_AEXT) + ((size_t)h * NCQ + cidx) * 256 * 768;
        one(ae, lgf, lgb, r, c, v00); one(ae, lgf, lgb, r, c + 128, v01); one(ae, lgf, lgb, r + 128, c, v10); one(ae, lgf, lgb, r + 128, c + 128, v11); } };
struct DRetL { P p; static constexpr int FENCE = 1; static constexpr int K = 256, lda = 768, ldb = 256;
    HD bool unit(int L, Unit& u) const { int pm, pn; if (!rect_unit(L, 4 * NCQ, 4, pm, pn)) return false;
        const int dir = pn >> 1, eh = pn & 1;
        u.A = wsb(p, O_BEXT) + ((size_t)pm * 512 + eh * 256) * 768; u.B = wsb(p, O_KTX) + ((size_t)pm * 2 + dir) * 65536; u.a = pm; u.b = dir; u.c = eh; u.d = 0; return true; }
    HD void emit(const Unit& u, int r, int c, f32x4 v00, f32x4 v01, f32x4 v10, f32x4 v11) const {
        u16* o = wsb(p, O_BEXT) + ((size_t)u.a * 512 + u.c * 256 + r) * 768 + 256 + u.b * 256 + c;
        st4bf(o, v00); st4bf(o + 128, v01); st4bf(o + (size_t)128 * 768, v10); st4bf(o + (size_t)128 * 768 + 128, v11); } };
struct DRetO { P p; static constexpr int FENCE = 1; static constexpr int K = 768, lda = 768, ldb = 768;
    HD bool unit(int L, Unit& u) const { int pm, pn; if (!rect_unit(L, 4 * NCQ, 2, pm, pn)) return false;
        u.A = wsb(p, O_AEXT) + (size_t)pm * 256 * 768; u.B = wsb(p, O_BEXT) + ((size_t)pm * 512 + pn * 256) * 768; u.a = pm; u.b = pn; u.c = 0; u.d = 0; return true; }
    HD void emit(const Unit& u, int r, int c, f32x4 v00, f32x4 v01, f32x4 v10, f32x4 v11) const {
        const int h = u.a / NCQ, cidx = u.a % NCQ;
        u16* o = wsb(p, O_OB) + ((size_t)cidx * 256 + r) * 2048 + h * 512 + u.b * 256 + c;
        st4bf(o, v00); st4bf(o + 128, v01); st4bf(o + (size_t)128 * 2048, v10); st4bf(o + (size_t)128 * 2048 + 128, v11); } };
struct DRetWoCtx { P p; int layer; static constexpr int FENCE = 4; static constexpr int K = 2048, lda = 2048, ldb = 2048;
    HD bool unit(int L, Unit& u) const { int pm, pn; if (!rect_unit(L, NC / 256, 4, pm, pn)) return false;
        u.A = wsb(p, O_YCTX) + (size_t)pm * 256 * 2048; u.B = wsb(p, O_RWO) + (size_t)pn * 256 * 2048; u.a = NL + pm * 256; u.b = pn; u.c = 0; u.d = 0; return true; }
    HD void emit(const Unit& u, int r, int c, f32x4 v00, f32x4 v01, f32x4 v10, f32x4 v11) const {
        const int R = u.a + r, col = u.b * 256 + c;
        resid4(p, layer, 5, 1.0f, R, col, v00); resid4(p, layer, 5, 1.0f, R, col + 128, v01); resid4(p, layer, 5, 1.0f, R + 128, col, v10); resid4(p, layer, 5, 1.0f, R + 128, col + 128, v11); } };
struct DRetWo { P p; int layer, q; static constexpr int FENCE = 4; static constexpr int K = 2048, lda = 2048, ldb = 2048;
    HD bool unit(int L, Unit& u) const { int pl, pn; if (!rect_unit(L, NCQ - RGB, 4, pl, pn)) return false; const int pm = pl + pl / (NCH - 1) + 1;
        u.A = wsb(p, O_OB) + (size_t)pm * 256 * 2048; u.B = wsb(p, O_RWO) + (size_t)pn * 256 * 2048; u.a = ret_tokrow(q, pm); u.b = pn; u.c = 0; u.d = 0; return true; }
    HD void emit(const Unit& u, int r, int c, f32x4 v00, f32x4 v01, f32x4 v10, f32x4 v11) const {
        const int R = u.a + r, col = u.b * 256 + c;
        resid4(p, layer, 5, 1.0f, R, col, v00); resid4(p, layer, 5, 1.0f, R, col + 128, v01); resid4(p, layer, 5, 1.0f, R + 128, col, v10); resid4(p, layer, 5, 1.0f, R + 128, col + 128, v11); } };

struct DS5L { P p; static constexpr int FENCE = 1; static constexpr int K = 512, lda = 768, ldb = 512;
    HD bool unit(int L, Unit& u) const { int pm, pn; if (!rect_unit(L, NROW5P / 256, 64, pm, pn)) return false;
        u.A = wsb(p, O_UEXT) + ((size_t)pn * NROW5P + pm * 256) * 768; u.B = wsb(p, O_FEXT) + (size_t)pn * 256 * 512; u.a = pm; u.b = pn; u.c = 0; u.d = 0; return true; }
    HD void emit(const Unit& u, int r, int c, f32x4 v00, f32x4 v01, f32x4 v10, f32x4 v11) const {
        u16* o = wsb(p, O_UEXT) + ((size_t)u.b * NROW5P + u.a * 256 + r) * 768 + 512 + c;
        st4bf(o, v00); st4bf(o + 128, v01); st4bf(o + (size_t)128 * 768, v10); st4bf(o + (size_t)128 * 768 + 128, v11); } };
struct DS5Y { P p; static constexpr int FENCE = 1; static constexpr int K = 768, lda = 768, ldb = 768;
    HD bool unit(int L, Unit& u) const { int pm, pn; if (!rect_unit(L, NROW5P / 256, 128, pm, pn)) return false;
        const int g = pn >> 1, ch = pn & 1;
        u.A = wsb(p, O_UEXT) + ((size_t)g * NROW5P + pm * 256) * 768; u.B = wsb(p, O_TEXT) + ((size_t)g * 512 + ch * 256) * 768; u.a = pm; u.b = g; u.c = ch; u.d = 0; return true; }
    HD void one(int g, int row, int col, f32x4 v) const {
        int tok; if (row < NB * S5L) tok = (row / S5L) * SEQ + (row % S5L) * 32; else if (row < NROW5) { const int rr = row - NB * S5L; tok = NL + (rr / S5C) * 256 + (rr % S5C) * 32; } else return;
        f32x4 o; for (int jx = 0; jx < 4; ++jx) o[jx] = gelu_f(v[jx]);
        st4bf(wsb(p, O_HN) + (size_t)(tok + (col >> 4)) * 1024 + g * 16 + (col & 15), o); }
    HD void emit(const Unit& u, int r, int c, f32x4 v00, f32x4 v01, f32x4 v10, f32x4 v11) const {
        const int row = u.a * 256 + r, col = u.c * 256 + c;
        one(u.b, row, col, v00); one(u.b, row, col + 128, v01); one(u.b, row + 128, col, v10); one(u.b, row + 128, col + 128, v11); } };
struct DS5Glu { P p; int layer; static constexpr int FENCE = 4; static constexpr int K = 1024, lda = 1024, ldb = 1024;
    HD bool unit(int L, Unit& u) const { int pm, pn; if (!rect_unit(L, MT / 256, 8, pm, pn)) return false;
        u.A = wsb(p, O_HN) + (size_t)pm * 256 * 1024; u.B = wsb(p, O_GLU) + (size_t)pn * 256 * 1024; u.a = pm; u.b = pn; u.c = 0; u.d = 0; return true; }
    HD void emit(const Unit& u, int r, int c, f32x4 v00, f32x4 v01, f32x4 v10, f32x4 v11) const {
        const int col = u.b * 128 + c; const float* gb = p.in[30]; f32x4 y0, y1;
        for (int jx = 0; jx < 4; ++jx) { const float ba = gb[col + jx], bg = gb[1024 + col + jx];
            y0[jx] = (v00[jx] + ba) * sigm_f(v01[jx] + bg); y1[jx] = (v10[jx] + ba) * sigm_f(v11[jx] + bg); }
        resid4(p, layer, 5, 1.0f, u.a * 256 + r, col, y0); resid4(p, layer, 5, 1.0f, u.a * 256 + r + 128, col, y1); } };

HD void cvt64(const float* src, int N, int srccol, u16* dst, int Kd, int nrow, int k0) {
    float v[64];
#pragma unroll
    for (int j = 0; j < 64; ++j) v[j] = srccol >= 0 ? src[(size_t)(k0 + j) * N + srccol] : 0.f;
#pragma unroll
    for (int j = 0; j < 64; j += 4) { f32x4 a; a[0] = v[j]; a[1] = v[j + 1]; a[2] = v[j + 2]; a[3] = v[j + 3]; st4bf(dst + (size_t)nrow * Kd + k0 + j, a); } }
constexpr long CV_FFI = (long)8 * 5632 * 16, CV_FFO = (long)8 * 1024 * 44, CV_MWIN = (long)2 * 768 * 16, CV_MWUQ = (long)2 * 1536 * 6, CV_MWUKV = (long)2 * 2048 * 4,
               CV_MWO = (long)2 * 1024 * 16, CV_RWIN = (long)6144 * 16, CV_RWO = (long)1024 * 32, CV_GLU = (long)2048 * 16;
constexpr long CV_TOTAL = CV_FFI + CV_FFO + CV_MWIN + CV_MWUQ + CV_MWUKV + CV_MWO + CV_RWIN + CV_RWO + CV_GLU;
HD void cvt_item(const P& p, long idx) {
    if (idx < CV_FFI) { const int n = (int)(idx % 5632); const long t = idx / 5632; const int kb = (int)(t % 16), m = (int)(t / 16);
        const int tile = n >> 8, rr = n & 255; const int sc = rr < 128 ? tile * 128 + rr : 2816 + tile * 128 + (rr - 128);
        cvt64(p.in[7] + (size_t)m * 1024 * 5632, 5632, sc, wsb(p, O_FFI + (size_t)m * SZ_FFI1), 1024, n, kb * 64); return; }
    idx -= CV_FFI;
    if (idx < CV_FFO) { const int n = (int)(idx % 1024); const long t = idx / 1024; const int kb = (int)(t % 44), m = (int)(t / 44);
        cvt64(p.in[8] + (size_t)m * 2816 * 1024, 1024, n, wsb(p, O_FFO + (size_t)m * SZ_FFO1), 2816, n, kb * 64); return; }
    idx -= CV_FFO;
    if (idx < CV_MWIN) { const int n = (int)(idx % 768); const long t = idx / 768; const int kb = (int)(t % 16), m = (int)(t / 16);
        cvt64(p.in[9] + (size_t)m * 1024 * 704, 704, n < 704 ? n : -1, wsb(p, O_MWIN + (size_t)m * SZ_MWIN), 1024, n, kb * 64); return; }
    idx -= CV_MWIN;
    if (idx < CV_MWUQ) { const int n = (int)(idx % 1536); const long t = idx / 1536; const int kb = (int)(t % 6), m = (int)(t / 6);
        cvt64(p.in[12] + (size_t)m * 384 * 1536, 1536, n, wsb(p, O_MWUQ + (size_t)m * SZ_MWUQ), 384, n, kb * 64); return; }
    idx -= CV_MWUQ;
    if (idx < CV_MWUKV) { const int n = (int)(idx % 2048); const long t = idx / 2048; const int kb = (int)(t % 4), m = (int)(t / 4);
        const int sc = n < 1024 ? (n >> 7) * 256 + (n & 127) : ((n - 1024) >> 7) * 256 + 128 + (n & 127);
        cvt64(p.in[13] + (size_t)m * 256 * 2048, 2048, sc, wsb(p, O_MWUKV + (size_t)m * SZ_MWUKV), 256, n, kb * 64); return; }
    idx -= CV_MWUKV;
    if (idx < CV_MWO) { const int n = (int)(idx % 1024); const long t = idx / 1024; const int kb = (int)(t % 16), m = (int)(t / 16);
        cvt64(p.in[16] + (size_t)m * 1024 * 1024, 1024, n, wsb(p, O_MWO + (size_t)m * SZ_MWO), 1024, n, kb * 64); return; }
    idx -= CV_MWO;
    if (idx < CV_RWIN) { const int n = (int)(idx % 6144), kb = (int)(idx / 6144); cvt64(p.in[17], 6144, n, wsb(p, O_RWIN), 1024, n, kb * 64); return; }
    idx -= CV_RWIN;
    if (idx < CV_RWO) { const int n = (int)(idx % 1024), kb = (int)(idx / 1024); cvt64(p.in[20], 1024, n, wsb(p, O_RWO), 2048, n, kb * 64); return; }
    idx -= CV_RWO;
    { const int n = (int)(idx % 2048), kb = (int)(idx / 2048); const int tile = n >> 8, rr = n & 255; const int sc = rr < 128 ? tile * 128 + rr : 1024 + tile * 128 + (rr - 128);
      cvt64(p.in[29], 2048, sc, wsb(p, O_GLU), 1024, n, kb * 64); }
}
HD void mod_item(const P& p, int idx) {
    const int layer = idx / 9216, col = idx % 9216; const float* w = p.in[4] + (size_t)layer * 1024 * 9216 + col; float acc[NMR];
    for (int b = 0; b < NMR; ++b) acc[b] = 0.f;
    for (int k = 0; k < 1024; ++k) { const float wv = w[(size_t)k * 9216];
#pragma unroll
        for (int b = 0; b < NMR; ++b) { const float cv = b < NB ? p.in[1][b * 1024 + k] : p.in[3][k]; acc[b] += silu_f(cv) * wv; } }
    const float bias = p.in[5][layer * 9216 + col];
#pragma unroll
    for (int b = 0; b < NMR; ++b) ((float*)(p.ws + O_MOD))[(size_t)(layer * NMR + b) * 9216 + col] = acc[b] + bias; }
HD void copy_item(const P& p, long idx) {
    const long nl4 = (long)NL * 256;
    if (idx < nl4) ((f32x4*)p.out)[idx] = ((const f32x4*)p.in[0])[idx]; else ((f32x4*)(p.ws + O_G))[idx - nl4] = ((const f32x4*)p.in[2])[idx - nl4]; }
HD void norm_item(const P& p, int layer, int k, int r, int s5) {
    const float* x = hsrc(p, r, layer == 0 && k == 0); float ss = 0.f;
    for (int d = 0; d < 1024; d += 4) { const f32x4 v = *(const f32x4*)(x + d); ss += v[0] * v[0] + v[1] * v[1] + v[2] * v[2] + v[3] * v[3]; }
    const float rinv = rsq_f(ss * (1.0f / 1024.0f) + EPS);
    const float* g = p.in[6] + (size_t)(layer * 3 + k) * 1024; const float* sh = modp(p, layer, r, 3 * k); const float* sc = modp(p, layer, r, 3 * k + 1);
    int row5 = 0, i5 = 0;
    if (s5) { if (r < NL) { const int b = r / SEQ, t = r % SEQ; row5 = b * S5L + t / 32; i5 = t % 32; } else { const int rr = r - NL; const int b = rr / 256, l = rr % 256; row5 = NB * S5L + b * S5C + l / 32; i5 = l % 32; } }
    for (int d = 0; d < 1024; d += 4) { const f32x4 v = *(const f32x4*)(x + d); f32x4 o;
        for (int j = 0; j < 4; ++j) o[j] = v[j] * rinv * g[d + j] * (1.0f + sc[d + j]) + sh[d + j];
        if (!s5) st4bf(wsb(p, O_HN) + (size_t)r * 1024 + d, o);
        else st4bf(wsb(p, O_UEXT) + ((size_t)(d >> 4) * NROW5P + row5) * 768 + i5 * 16 + (d & 15), o); } }
HD void axial_rot64(float* v, int t) {
    const int prow = t / 64, pcol = t % 64;
    for (int f = 0; f < 16; ++f) { const float fq = ropef(f, 16);
        { float cs, sn; sincos_t((float)prow * fq, sn, cs); const float x1 = v[f], x2 = v[16 + f]; v[f] = x1 * cs - x2 * sn; v[16 + f] = x2 * cs + x1 * sn; }
        { float cs, sn; sincos_t((float)pcol * fq, sn, cs); const float x1 = v[32 + f], x2 = v[48 + f]; v[32 + f] = x1 * cs - x2 * sn; v[48 + f] = x2 * cs + x1 * sn; } } }
HD void mla_row_item(const P& p, int j, int r) {
    const float* x = (const float*)(p.ws + O_CALL) + (size_t)r * 768; float ss = 0.f;
    for (int d = 0; d < 384; ++d) ss += x[d] * x[d];
    float rinv = rsq_f(ss * (1.0f / 384.0f) + EPS); const float* qn = p.in[10] + j * 384;
    for (int d = 0; d < 384; d += 4) { f32x4 o; for (int jx = 0; jx < 4; ++jx) o[jx] = x[d + jx] * rinv * qn[d + jx]; st4bf(wsb(p, O_CQN) + (size_t)r * 384 + d, o); }
    ss = 0.f; for (int d = 0; d < 256; ++d) ss += x[384 + d] * x[384 + d];
    rinv = rsq_f(ss * (1.0f / 256.0f) + EPS); const float* kvn = p.in[11] + j * 256;
    for (int d = 0; d < 256; d += 4) { f32x4 o; for (int jx = 0; jx < 4; ++jx) o[jx] = x[384 + d + jx] * rinv * kvn[d + jx]; st4bf(wsb(p, O_CKVN) + (size_t)r * 256 + d, o); }
    ss = 0.f; for (int d = 0; d < 64; ++d) ss += x[640 + d] * x[640 + d];
    rinv = rsq_f(ss * (1.0f / 64.0f) + EPS); const float* kg = p.in[15] + j * 192 + 128;
#ifdef HOST_EMU
    float kr[64];
    for (int d = 0; d < 64; ++d) kr[d] = x[640 + d] * rinv * kg[d];
    if (r < NL) axial_rot64(kr, r % SEQ);
    for (int h = 0; h < 8; ++h) for (int d = 0; d < 64; ++d) wsb(p, O_KF)[(size_t)r * 1536 + h * 192 + 128 + d] = f2bf(kr[d]);
#else
    const int t = r % SEQ, prow = t / 64, pcol = t % 64;
    for (int f = 0; f < 16; ++f) { const float fq = ropef(f, 16);
#pragma unroll
        for (int part = 0; part < 2; ++part) { float cs = 1.f, sn = 0.f; if (r < NL) sincos_t((float)(part ? pcol : prow) * fq, sn, cs);
            const int d1 = part * 32 + f, d2 = d1 + 16; const float x1 = x[640 + d1] * rinv * kg[d1], x2 = x[640 + d2] * rinv * kg[d2];
            const u16 o1 = f2bf(x1 * cs - x2 * sn), o2 = f2bf(x2 * cs + x1 * sn);
            for (int h = 0; h < 8; ++h) { wsb(p, O_KF)[(size_t)r * 1536 + h * 192 + 128 + d1] = o1; wsb(p, O_KF)[(size_t)r * 1536 + h * 192 + 128 + d2] = o2; } } }
#endif
}
HD void mla_head_item(const P& p, int j, int idx) {
    const int r = idx >> 3, h = idx & 7;
    u16* q = wsb(p, O_CALL) + (size_t)r * 1536 + h * 192; const float* qg = p.in[14] + j * 192; float ss = 0.f;
    for (int d = 0; d < 128; ++d) { const float v = bf2f(q[d]); ss += v * v; }
    float rinv = rsq_f(ss * (1.0f / 128.0f) + EPS);
    for (int d = 0; d < 128; ++d) q[d] = f2bf(bf2f(q[d]) * rinv * qg[d] * QSCALE);
    ss = 0.f; for (int d = 0; d < 64; ++d) { const float v = bf2f(q[128 + d]); ss += v * v; }
    rinv = rsq_f(ss * (1.0f / 64.0f) + EPS);
    { const int t = r % SEQ, prow = t / 64, pcol = t % 64;
      for (int f = 0; f < 16; ++f) { const float fq = ropef(f, 16);
#pragma unroll
        for (int part = 0; part < 2; ++part) { float cs = 1.f, sn = 0.f; if (r < NL) sincos_t((float)(part ? pcol : prow) * fq, sn, cs);
            const int d1 = 128 + part * 32 + f, d2 = d1 + 16; const float x1 = bf2f(q[d1]) * rinv * qg[d1], x2 = bf2f(q[d2]) * rinv * qg[d2];
            q[d1] = f2bf((x1 * cs - x2 * sn) * QSCALE); q[d2] = f2bf((x2 * cs + x1 * sn) * QSCALE); } } }
    u16* k = wsb(p, O_KF) + (size_t)r * 1536 + h * 192; const float* kg = p.in[15] + j * 192;
    ss = 0.f; for (int d = 0; d < 128; ++d) { const float v = bf2f(k[d]); ss += v * v; }
    rinv = rsq_f(ss * (1.0f / 128.0f) + EPS);
    for (int d = 0; d < 128; ++d) k[d] = f2bf(bf2f(k[d]) * rinv * kg[d]);
}
HD void ret_prefix_item(const P& p, int idx) {
    const int d4 = idx & 63, e = (idx >> 6) & 511, bq = (idx >> 15) % RGB, h = (idx >> 15) / RGB;
    const float gf = expf(256.f * ret_logg(p, 0, h)), gb = expf(256.f * ret_logg(p, 1, h));
    u16* base = wsb(p, O_BEXT) + (((size_t)h * NCQ + bq * NCH) * 512 + e) * 768 + d4 * 4; constexpr size_t CS = (size_t)512 * 768;
    u32x2 tf[NCH], tb[NCH];
#pragma unroll
    for (int n = 0; n < NCH; ++n) { tf[n] = *(const u32x2*)(base + n * CS + 256); tb[n] = *(const u32x2*)(base + n * CS + 512); }
    f32x4 cf = {0.f, 0.f, 0.f, 0.f}, cb = {0.f, 0.f, 0.f, 0.f};
#pragma unroll
    for (int n = 0; n < NCH; ++n) { f32x4 t; t[0] = bf2f((u16)(tf[n].x & 0xffff)); t[1] = bf2f((u16)(tf[n].x >> 16)); t[2] = bf2f((u16)(tf[n].y & 0xffff)); t[3] = bf2f((u16)(tf[n].y >> 16));
        st4bf(base + n * CS + 256, cf); cf = cf * gf + t; }
#pragma unroll
    for (int s_ = 0; s_ < NCH; ++s_) { const int n = s_ == 0 ? 0 : NCH - s_; f32x4 t; t[0] = bf2f((u16)(tb[n].x & 0xffff)); t[1] = bf2f((u16)(tb[n].x >> 16)); t[2] = bf2f((u16)(tb[n].y & 0xffff)); t[3] = bf2f((u16)(tb[n].y >> 16));
        st4bf(base + n * CS + 512, cb); cb = cb * gb + t; } }
HD u16* ret_ydst(const P& p, int q, int lr) { const int cidx = lr >> 8, n = cidx % NCH; return n == 0 ? wsb(p, O_YCTX) + ((size_t)((q * RGB + cidx / NCH) * 256 + (lr & 255))) * 2048 : wsb(p, O_OB) + (size_t)lr * 2048; }
HD void ret_norm_item(const P& p, int qg, int idx) {
    const int lr = idx >> 2, h = idx & 3; u16* o = wsb(p, O_OB) + (size_t)lr * 2048 + h * 512; u16* yd = ret_ydst(p, qg, lr) + h * 512; const u16* g = wsb(p, O_GATE) + (size_t)lr * 2048 + h * 512; const float* gg = p.in[19] + h * 512;
    float s = 0.f; for (int e = 0; e < 512; ++e) s += bf2f(o[e]);
    const float mu = s * (1.0f / 512.0f); float q = 0.f; for (int e = 0; e < 512; ++e) { const float d = bf2f(o[e]) - mu; q += d * d; }
    const float rstd = rsq_f(q * (1.0f / 512.0f) + EPS);
    for (int e = 0; e < 512; ++e) yd[e] = f2bf((bf2f(o[e]) - mu) * rstd * gg[e] * silu_f(bf2f(g[e]))); }
struct Cx { float re, im; };
HD Cx cmul(Cx a, Cx b) { Cx r; r.re = a.re * b.re - a.im * b.im; r.im = a.re * b.im + a.im * b.re; return r; }
HD Cx s5_alog(const P& p, int dir, int g, int pp) { const float dt = expf(p.in[23][dir * 64 + g]); Cx r; r.re = p.in[21][(dir * 64 + g) * 64 + pp] * dt; r.im = p.in[22][(dir * 64 + g) * 64 + pp] * dt; return r; }
HD Cx cpowa(Cx al, float n) { const float m = expf(al.re * n); float sn, cs; sincos_t(al.im * n * 0.15915494309189535f, sn, cs); Cx r; r.re = m * cs; r.im = m * sn; return r; }
HD Cx s5_coef(const P& p, int dir, int g, int pp) {
    const Cx al = s5_alog(p, dir, g, pp); Cx a = cpowa(al, 1.f); a.re -= 1.f; const float lr = p.in[21][(dir * 64 + g) * 64 + pp], li = p.in[22][(dir * 64 + g) * 64 + pp], den = 1.0f / (lr * lr + li * li);
    Cx r; r.re = (a.re * lr + a.im * li) * den; r.im = (a.im * lr - a.re * li) * den; return r; }
HD Cx s5_bbar(const P& p, int dir, int g, int pp, int m) { Cx b; const size_t o = (((size_t)dir * 64 + g) * 64 + pp) * 16 + m; b.re = p.in[24][o]; b.im = p.in[25][o]; return cmul(s5_coef(p, dir, g, pp), b); }
HD Cx s5_c(const P& p, int dir, int g, int m, int pp) { Cx c; const size_t o = (((size_t)dir * 64 + g) * 16 + m) * 64 + pp; c.re = p.in[26][o]; c.im = p.in[27][o]; return c; }
HD void s5_ktab_item(const P& p, int idx) {
    const int m = idx & 15, tau = (idx >> 4) & 31, dir = (idx >> 9) & 1, g = idx >> 10; float acc[16];
#pragma unroll
    for (int m2 = 0; m2 < 16; ++m2) acc[m2] = 0.f;
    for (int pp = 0; pp < 64; ++pp) { const Cx w = cmul(cmul(s5_c(p, dir, g, m, pp), cpowa(s5_alog(p, dir, g, pp), (float)tau)), s5_coef(p, dir, g, pp));
        const size_t o = (((size_t)dir * 64 + g) * 64 + pp) * 16;
#pragma unroll
        for (int m2 = 0; m2 < 16; ++m2) acc[m2] += w.re * p.in[24][o + m2] - w.im * p.in[25][o + m2]; }
#pragma unroll
    for (int m2 = 0; m2 < 16; ++m2) ((float*)(p.ws + O_KTAB))[(size_t)idx * 16 + m2] = acc[m2]; }
HD void s5_text_item(const P& p, long idx) {
    const int col = (int)(idx % 768); const long t = idx / 768; const int row = (int)(t % 512), g = (int)(t / 512), i = row >> 4, m = row & 15; float v;
    const float* kt = (const float*)(p.ws + O_KTAB);
    if (col < 512) { const int jj = col >> 4, m2 = col & 15; v = 0.f;
        if (jj <= i) v += kt[((((size_t)g * 2 + 0) * 32 + (i - jj)) * 16 + m) * 16 + m2];
        if (jj >= i) v += kt[((((size_t)g * 2 + 1) * 32 + (jj - i)) * 16 + m) * 16 + m2];
        if (jj == i && m == m2) v += p.in[28][g * 16 + m]; }
    else { const int dir = col >= 640, pp = ((col - 512) & 127) >> 1, part = col & 1;
        const Cx w = cmul(s5_c(p, dir, g, m, pp), cpowa(s5_alog(p, dir, g, pp), dir ? (float)(32 - i) : (float)(i + 1))); v = part ? -w.im : w.re; }
    wsb(p, O_TEXT)[idx] = f2bf(v); }
HD void s5_fext_item(const P& p, int idx) {
    const int col = idx & 511, row = (idx >> 9) & 255, g = idx >> 17, jj = col >> 4, m2 = col & 15, dir = row >> 7, pp = (row & 127) >> 1, part = row & 1;
    const Cx w = cmul(cpowa(s5_alog(p, dir, g, pp), dir ? (float)jj : (float)(31 - jj)), s5_bbar(p, dir, g, pp, m2));
    wsb(p, O_FEXT)[idx] = f2bf(part ? w.im : w.re); }
HD int s5_row(int b, int s) { return s < S5C ? NB * S5L + b * S5C + s : b * S5L + (s - S5C); }
HD void s5_prefix_item(const P& p, int idx) {
    const int pp = idx & 63, b = (idx >> 6) % NB, g = (idx >> 6) / NB;
    const Cx af = cpowa(s5_alog(p, 0, g, pp), 32.f), ab = cpowa(s5_alog(p, 1, g, pp), 32.f);
    u16* base = wsb(p, O_UEXT) + (size_t)g * NROW5P * 768; Cx c; c.re = 0.f; c.im = 0.f;
    for (int s0 = 0; s0 < S5C + S5L; s0 += 8) { unsigned t[8];
#pragma unroll
        for (int k = 0; k < 8; ++k) t[k] = *(const unsigned*)(base + (size_t)s5_row(b, s0 + k) * 768 + 512 + 2 * pp);
#pragma unroll
        for (int k = 0; k < 8; ++k) { u16* q = base + (size_t)s5_row(b, s0 + k) * 768 + 512 + 2 * pp; *(unsigned*)q = (unsigned)f2bf(c.re) | ((unsigned)f2bf(c.im) << 16);
            c = cmul(af, c); c.re += bf2f((u16)(t[k] & 0xffff)); c.im += bf2f((u16)(t[k] >> 16)); } }
    c.re = 0.f; c.im = 0.f;
    for (int s0 = 0; s0 < S5C + S5L; s0 += 8) { unsigned t[8]; int sv[8];
#pragma unroll
        for (int k = 0; k < 8; ++k) { const int s_ = s0 + k; sv[k] = s_ < S5C ? S5C - 1 - s_ : S5C + S5L - 1 - (s_ - S5C); t[k] = *(const unsigned*)(base + (size_t)s5_row(b, sv[k]) * 768 + 640 + 2 * pp); }
#pragma unroll
        for (int k = 0; k < 8; ++k) { u16* q = base + (size_t)s5_row(b, sv[k]) * 768 + 640 + 2 * pp; *(unsigned*)q = (unsigned)f2bf(c.re) | ((unsigned)f2bf(c.im) << 16);
            c = cmul(ab, c); c.re += bf2f((u16)(t[k] & 0xffff)); c.im += bf2f((u16)(t[k] >> 16)); } } }

struct AttItem { const u16* q; const u16* k0; const u16* k1; const u16* v0; const u16* v1; u16* o; int n0, ntot; };
HD void att_item(const P& p, int it, AttItem& a) {
    const u16* Q = wsb(p, O_CALL); const u16* KF = wsb(p, O_KF); const u16* VB = wsb(p, O_VB); u16* O = wsb(p, O_HN);
    const int nlat = NB * 8 * (SEQ / 256);
    if (it < nlat) { const int qb = it % (SEQ / 256), h = (it / (SEQ / 256)) & 7, b = it / (SEQ / 256) / 8; const size_t r0 = (size_t)b * SEQ + qb * 256, c0 = (size_t)NL + b * 256, l0 = (size_t)b * SEQ;
        a.q = Q + r0 * 1536 + h * 192; a.o = O + r0 * 1024 + h * 128; a.k0 = KF + c0 * 1536 + h * 192; a.v0 = VB + c0 * 1024 + h * 128; a.k1 = KF + l0 * 1536 + h * 192; a.v1 = VB + l0 * 1024 + h * 128; a.n0 = 256; a.ntot = 256 + SEQ; }
    else { const int x = it - nlat, h = x & 7, b = x >> 3; const size_t c0 = (size_t)NL + b * 256;
        a.q = Q + c0 * 1536 + h * 192; a.o = O + c0 * 1024 + h * 128; a.k0 = KF + c0 * 1536 + h * 192; a.v0 = VB + c0 * 1024 + h * 128; a.k1 = a.k0; a.v1 = a.v0; a.n0 = 256; a.ntot = 256; } }

#ifndef HOST_EMU
#define LAS __attribute__((address_space(3)))
typedef short bf16x8 __attribute__((ext_vector_type(8)));
typedef short s16x4 __attribute__((ext_vector_type(4)));
typedef float f32x16 __attribute__((ext_vector_type(16)));
typedef unsigned u32x4 __attribute__((ext_vector_type(4)));
constexpr int HTB = 128 * 64 * 2, STAGE_BYTES = 8 * HTB;
__device__ __forceinline__ int lds_byte(int r, int c) { const int st = (r >> 4) * 2 + (c >> 5), rr = r & 15, cc = c & 31, ob = rr * 64 + cc * 2; return st * 1024 + (ob ^ (((ob >> 9) & 1) << 5)); }
__device__ __forceinline__ void stage_rc(int b, int& R, int& C) { const int st = b / 1024, sb = b % 1024, swz = sb ^ (((sb >> 9) & 1) << 5); R = (st >> 1) * 16 + swz / 64; C = (st & 1) * 32 + (swz % 64) / 2; }

template <class Dsc>
__device__ __forceinline__ void gemm_run(LAS unsigned char* lds, const Dsc& D) {
    int tid_ = threadIdx.x; asm volatile("" : "+v"(tid_));
    const int tid = tid_, wid = __builtin_amdgcn_readfirstlane(tid >> 6), lane = tid & 63, wr = wid >> 2, wc = wid & 3, fr = lane & 15, fq = lane >> 4;
    constexpr int K = Dsc::K, nt = K / 64, lda = Dsc::lda, ldb = Dsc::ldb;
    static_assert(K % 128 == 0 && K >= 256, "K");
    unsigned voffA[2], voffB[2];
#pragma unroll
    for (int i = 0; i < 2; ++i) { int R, C; stage_rc(tid * 16 + i * 8192, R, C); voffA[i] = (unsigned)(R * lda + C) * 2u; voffB[i] = (unsigned)(R * ldb + C) * 2u; }
    constexpr size_t kstep = 128, hstepA = (size_t)128 * lda * 2, hstepB = (size_t)128 * ldb * 2;
    const unsigned ldsw = (unsigned)wid * 1024u;
    const int aoff = lds_byte(wr * 64 + fr, fq * 8), boff = lds_byte(wc * 32 + fr, fq * 8);
#define G_SA(b, h) (((b) * 2 + (h)) * HTB)
#define G_SB(b, h) ((4 + (b) * 2 + (h)) * HTB)
#define G_STAGE(bufoff, gbase, voff) do { _Pragma("unroll") for (int _i = 0; _i < 2; ++_i) \
        __builtin_amdgcn_global_load_lds((const unsigned*)((const char*)(gbase) + (voff)[_i]), (LAS unsigned*)(lds + (bufoff) + ldsw + _i * 8192), 16, 0, 0); } while (0)
#define G_LDA(dst, b, h) do { _Pragma("unroll") for (int m = 0; m < 4; ++m) _Pragma("unroll") for (int k = 0; k < 2; ++k) dst[m][k] = *(const LAS bf16x8*)(lds + G_SA(b, h) + aoff + m * 2048 + k * 1024); } while (0)
#define G_LDB(dst, b, h) do { _Pragma("unroll") for (int n = 0; n < 2; ++n) _Pragma("unroll") for (int k = 0; k < 2; ++k) dst[n][k] = *(const LAS bf16x8*)(lds + G_SB(b, h) + boff + n * 2048 + k * 1024); } while (0)
#define G_MMA(ai, bj, At, Bt) do { __builtin_amdgcn_s_setprio(1); _Pragma("unroll") for (int m = 0; m < 4; ++m) _Pragma("unroll") for (int n = 0; n < 2; ++n) _Pragma("unroll") for (int k = 0; k < 2; ++k) \
        acc[ai][bj][m][n] = __builtin_amdgcn_mfma_f32_16x16x32_bf16(Bt[n][k], At[m][k], acc[ai][bj][m][n], 0, 0, 0); __builtin_amdgcn_s_setprio(0); } while (0)
#define G_WAIT_V(n) asm volatile("s_waitcnt vmcnt(" #n ")" ::: "memory")
#define G_WAIT_L(n) asm volatile("s_waitcnt lgkmcnt(" #n ")" ::: "memory")
#define G_BAR __builtin_amdgcn_s_barrier()
#define G_SCHED __builtin_amdgcn_sched_barrier(0)
    Unit cur{}, nxt{}; int ui = 0; const int G = gridDim.x, cb = blockIdx.x;
    if (!D.unit(cb, cur)) return;
    f32x4 acc[2][2][4][2];
#pragma unroll
    for (int a = 0; a < 2; ++a)
#pragma unroll
        for (int b = 0; b < 2; ++b)
#pragma unroll
            for (int m = 0; m < 4; ++m)
#pragma unroll
                for (int n = 0; n < 2; ++n) acc[a][b][m][n] = (f32x4){0.f, 0.f, 0.f, 0.f};
    bf16x8 At[4][2], B0[2][2], B1[2][2];
    const char* cA = (const char*)cur.A; const char* cB = (const char*)cur.B;
    G_STAGE(G_SB(0, 0), cB, voffB); G_STAGE(G_SA(0, 0), cA, voffA); G_STAGE(G_SB(0, 1), cB + hstepB, voffB); G_STAGE(G_SA(0, 1), cA + hstepA, voffA);
    if (wr == 1) G_BAR;
    G_WAIT_V(4); G_BAR;
    G_STAGE(G_SB(1, 0), cB + kstep, voffB); G_STAGE(G_SA(1, 0), cA + kstep, voffA); G_STAGE(G_SB(1, 1), cB + hstepB + kstep, voffB);
    G_WAIT_V(6); G_BAR;
    for (;;) {
        const bool has_next = D.unit((ui + 1) * G + cb, nxt);
        const char* nA = has_next ? (const char*)nxt.A : cA; const char* nB = has_next ? (const char*)nxt.B : cB;
        _Pragma("nounroll") for (int t = 0; t < nt; t += 2) {
            const bool last = (t == nt - 2);
            const char* a1 = cA + (size_t)(t + 1) * kstep;
            const char* a2 = last ? nA : cA + (size_t)(t + 2) * kstep; const char* b2 = last ? nB : cB + (size_t)(t + 2) * kstep;
            const char* a3 = a2 + kstep; const char* b3 = b2 + kstep;
            G_LDB(B0, 0, 0); G_SCHED; G_LDA(At, 0, 0); G_STAGE(G_SA(1, 1), a1 + hstepA, voffA);
            G_WAIT_L(8); G_BAR; G_WAIT_L(0); G_MMA(0, 0, At, B0); G_BAR; G_SCHED;
            G_LDB(B1, 0, 1); G_STAGE(G_SB(0, 0), b2, voffB);
            G_BAR; G_WAIT_L(0); G_MMA(0, 1, At, B1); G_BAR;
            G_LDA(At, 0, 1); G_STAGE(G_SA(0, 0), a2, voffA);
            G_BAR; G_WAIT_L(0); G_MMA(1, 0, At, B0); G_BAR; G_SCHED;
            G_STAGE(G_SB(0, 1), b2 + hstepB, voffB);
            G_WAIT_V(6); G_BAR; G_MMA(1, 1, At, B1); G_BAR;
            G_LDB(B0, 1, 0); G_SCHED; G_LDA(At, 1, 0); G_STAGE(G_SA(0, 1), a2 + hstepA, voffA);
            G_WAIT_L(8); G_BAR; G_WAIT_L(0); G_MMA(0, 0, At, B0); G_BAR; G_SCHED;
            G_LDB(B1, 1, 1); G_STAGE(G_SB(1, 0), b3, voffB);
            G_BAR; G_WAIT_L(0); G_MMA(0, 1, At, B1); G_BAR;
            G_LDA(At, 1, 1); G_STAGE(G_SA(1, 0), a3, voffA);
            G_BAR; G_WAIT_L(0); G_MMA(1, 0, At, B0); G_BAR; G_SCHED;
            G_STAGE(G_SB(1, 1), b3 + hstepB, voffB);
            G_WAIT_V(6); G_BAR; G_MMA(1, 1, At, B1); G_BAR;
        }
        int er_ = wr * 64 + fr, ec_ = wc * 32 + fq * 4; asm volatile("" : "+v"(er_), "+v"(ec_));
#pragma unroll
        for (int m = 0; m < 4; ++m)
#pragma unroll
            for (int n = 0; n < 2; ++n) { D.emit(cur, er_ + m * 16, ec_ + n * 16, acc[0][0][m][n], acc[0][1][m][n], acc[1][0][m][n], acc[1][1][m][n]); if (((m * 2 + n + 1) % Dsc::FENCE) == 0) asm volatile("" ::: "memory"); }
        if (!has_next) break;
#pragma unroll
        for (int a = 0; a < 2; ++a)
#pragma unroll
            for (int b = 0; b < 2; ++b)
#pragma unroll
                for (int m = 0; m < 4; ++m)
#pragma unroll
                    for (int n = 0; n < 2; ++n) acc[a][b][m][n] = (f32x4){0.f, 0.f, 0.f, 0.f};
        cur = nxt; cA = nA; cB = nB; ++ui;
    }
    G_WAIT_V(0);
    if (wr == 0) G_BAR;
    G_BAR;
#undef G_SA
#undef G_SB
#undef G_STAGE
#undef G_LDA
#undef G_LDB
#undef G_MMA
#undef G_WAIT_V
#undef G_WAIT_L
#undef G_BAR
#undef G_SCHED
}

constexpr int A_SHM_V = 64 * 128 * 2, A_SHM_K = 64 * 400;
#define KSWZ(row, colB) ((row) * 400 + (colB))
__device__ __forceinline__ int crow(int r, int hi) { return (r & 3) + 8 * (r >> 2) + 4 * hi; }
__device__ __forceinline__ unsigned cvtpk(float lo, float hi) { unsigned r; asm volatile("v_cvt_pk_bf16_f32 %0, %1, %2" : "=v"(r) : "v"(lo), "v"(hi)); return r; }
__device__ __forceinline__ int v_st(int k, int c) { const int kk = (k & ~0xC) | ((k & 4) << 1) | ((k & 8) >> 1); return ((kk >> 3) * 4 + (c >> 5)) * 512 + ((kk & 7) * 32 + (c & 31)) * 2; }
__device__ __forceinline__ int v_rd_base(int lane) { return ((lane & 3) << 3) | (((lane >> 2) & 3) << 6) | (((lane >> 4) & 1) << 5) | (((lane >> 5) & 1) << 8); }
constexpr int v_rd_off(int d0, int ks, int half) { return d0 * 512 + ks * 4096 + half * 2048; }
template <int OFF> __device__ __forceinline__ s16x4 tr_read(int vb) { s16x4 r; asm volatile("ds_read_b64_tr_b16 %0, %1 offset:%2" : "=&v"(r) : "v"(vb), "i"(OFF) : "memory"); return r; }
template <int D0> __device__ __forceinline__ void pv_one(f32x16& od, int vb, bf16x8 pa0, bf16x8 pa1, bf16x8 pa2, bf16x8 pa3) {
    const s16x4 l0 = tr_read<v_rd_off(D0, 0, 0)>(vb), h0 = tr_read<v_rd_off(D0, 0, 1)>(vb), l1 = tr_read<v_rd_off(D0, 1, 0)>(vb), h1 = tr_read<v_rd_off(D0, 1, 1)>(vb);
    const s16x4 l2 = tr_read<v_rd_off(D0, 2, 0)>(vb), h2 = tr_read<v_rd_off(D0, 2, 1)>(vb), l3 = tr_read<v_rd_off(D0, 3, 0)>(vb), h3 = tr_read<v_rd_off(D0, 3, 1)>(vb);
    asm volatile("s_waitcnt lgkmcnt(0)" ::: "memory"); __builtin_amdgcn_sched_barrier(0);
#define PK(L, H) (bf16x8){L[0], L[1], L[2], L[3], H[0], H[1], H[2], H[3]}
    od = __builtin_amdgcn_mfma_f32_32x32x16_bf16(pa0, PK(l0, h0), od, 0, 0, 0);
    od = __builtin_amdgcn_mfma_f32_32x32x16_bf16(pa1, PK(l1, h1), od, 0, 0, 0);
    od = __builtin_amdgcn_mfma_f32_32x32x16_bf16(pa2, PK(l2, h2), od, 0, 0, 0);
    od = __builtin_amdgcn_mfma_f32_32x32x16_bf16(pa3, PK(l3, h3), od, 0, 0, 0);
#undef PK
}
__device__ __forceinline__ void att_body(const AttItem& a, char* lds) {
    int tid_ = threadIdx.x; asm volatile("" : "+v"(tid_));
    const int tid = tid_, wid = tid >> 6, lane = tid & 63, r32 = lane & 31, hi = lane >> 5;
    char* V_lds = lds; char* K_lds = lds + 2 * A_SHM_V; float* li_l = (float*)(lds + 2 * A_SHM_V + 2 * A_SHM_K) + wid * 64;
    float l_reg = 0.f; f32x16 o[4] = {}; bf16x8 qr[12];
    const u16* Qw = a.q + (size_t)(wid * 32 + r32) * 1536 + hi * 8;
#pragma unroll
    for (int d0 = 0; d0 < 12; ++d0) qr[d0] = *(const bf16x8*)(Qw + d0 * 16);
    const int sr = tid >> 4, sc = (tid & 15) * 8, vst0 = v_st(sr, sc), vst1 = v_st(32 + sr, sc);
    const int voff0 = sr * 1024 + sc, voff1 = (32 + sr) * 1024 + sc;
    int koff[3], kwr[3];
#pragma unroll
    for (int i = 0; i < 3; ++i) { const int id = tid + i * 512, kr_ = id / 24, kc_ = (id % 24) * 8; koff[i] = kr_ * 1536 + kc_; kwr[i] = KSWZ(kr_, kc_ * 2); }
    const int vb0 = (int)(uintptr_t)V_lds + v_rd_base(lane);
    bf16x8 vs0, vs1, ks[3];
    const int NT = a.ntot / 64;
#define A_SLOAD(k0_) do { const int key0_ = (k0_); const u16* kb_ = key0_ < a.n0 ? a.k0 + (size_t)key0_ * 1536 : a.k1 + (size_t)(key0_ - a.n0) * 1536; \
        const u16* vbp_ = key0_ < a.n0 ? a.v0 + (size_t)key0_ * 1024 : a.v1 + (size_t)(key0_ - a.n0) * 1024; \
        vs0 = *(const bf16x8*)(vbp_ + voff0); vs1 = *(const bf16x8*)(vbp_ + voff1); \
        _Pragma("unroll") for (int i = 0; i < 3; ++i) ks[i] = *(const bf16x8*)(kb_ + koff[i]); } while (0)
#define A_SWRITE(b) do { *(bf16x8*)(V_lds + (b) * A_SHM_V + vst0) = vs0; *(bf16x8*)(V_lds + (b) * A_SHM_V + vst1) = vs1; \
        _Pragma("unroll") for (int i = 0; i < 3; ++i) *(bf16x8*)(K_lds + (b) * A_SHM_K + kwr[i]) = ks[i]; } while (0)
    A_SLOAD(0); A_SWRITE(0); __syncthreads();
    _Pragma("nounroll") for (int j = 0; j < NT; ++j) {
        const int buf = j & 1;
        if (j + 1 < NT) A_SLOAD((j + 1) * 64);
        f32x16 p0 = {}, p1 = {};
        const char* Ks = K_lds + buf * A_SHM_K;
#pragma unroll
        for (int d0 = 0; d0 < 12; ++d0) { const int cbb = (d0 * 16 + hi * 8) * 2;
            const bf16x8 b0 = *(const bf16x8*)(Ks + KSWZ(r32, cbb)); const bf16x8 b1 = *(const bf16x8*)(Ks + KSWZ(32 + r32, cbb));
            p0 = __builtin_amdgcn_mfma_f32_32x32x16_bf16(b0, qr[d0], p0, 0, 0, 0);
            p1 = __builtin_amdgcn_mfma_f32_32x32x16_bf16(b1, qr[d0], p1, 0, 0, 0); }
        float ps = 0.f;
#pragma unroll
        for (int r = 0; r < 16; ++r) { p0[r] = __builtin_amdgcn_exp2f(p0[r]); p1[r] = __builtin_amdgcn_exp2f(p1[r]); ps += p0[r] + p1[r]; }
        { auto rr = __builtin_amdgcn_permlane32_swap(__float_as_uint(ps), __float_as_uint(ps), false, false); ps = __uint_as_float(rr[0]) + __uint_as_float(rr[1]); }
        l_reg += ps;
        bf16x8 pa0, pa1, pa2, pa3;
#define PK4(Pv, BASE, OUT) do { unsigned a0 = cvtpk(Pv[BASE + 0], Pv[BASE + 1]), a1 = cvtpk(Pv[BASE + 2], Pv[BASE + 3]); \
        unsigned b0 = cvtpk(Pv[BASE + 4], Pv[BASE + 5]), b1 = cvtpk(Pv[BASE + 6], Pv[BASE + 7]); \
        auto r0 = __builtin_amdgcn_permlane32_swap(a0, b0, false, false); auto r1 = __builtin_amdgcn_permlane32_swap(a1, b1, false, false); \
        u32x4 w = {r0[0], r1[0], r0[1], r1[1]}; OUT = *reinterpret_cast<bf16x8*>(&w); } while (0)
        PK4(p0, 0, pa0); PK4(p0, 8, pa1); PK4(p1, 0, pa2); PK4(p1, 8, pa3);
#undef PK4
        const int vb = vb0 + buf * A_SHM_V;
        pv_one<0>(o[0], vb, pa0, pa1, pa2, pa3); pv_one<1>(o[1], vb, pa0, pa1, pa2, pa3); pv_one<2>(o[2], vb, pa0, pa1, pa2, pa3); pv_one<3>(o[3], vb, pa0, pa1, pa2, pa3);
        if (j + 1 < NT) A_SWRITE(buf ^ 1);
        __syncthreads();
    }
    if (hi == 0) li_l[r32] = l_reg;
    asm volatile("s_waitcnt lgkmcnt(0)" ::: "memory");
    __builtin_amdgcn_wave_barrier();
    u16* Ow = a.o + (size_t)(wid * 32) * 1024;
#pragma unroll
    for (int r = 0; r < 16; ++r) { const int orow = crow(r, hi); const float rl = 1.0f / li_l[orow];
#pragma unroll
        for (int d0 = 0; d0 < 4; ++d0) Ow[(size_t)orow * 1024 + d0 * 32 + r32] = f2bf(o[d0][r] * rl); }
    __syncthreads();
#undef A_SLOAD
#undef A_SWRITE
}

__device__ __forceinline__ float wsum(float v) { for (int o = 32; o >= 1; o >>= 1) v += __shfl_xor(v, o); return v; }
__device__ __forceinline__ void norm_wave(const P& p, int layer, int k, int r, int s5, int lane) {
    const float* x = hsrc(p, r, layer == 0 && k == 0); f32x4 v[4]; float ss = 0.f;
#pragma unroll
    for (int i = 0; i < 4; ++i) { v[i] = *(const f32x4*)(x + i * 256 + lane * 4); ss += v[i][0] * v[i][0] + v[i][1] * v[i][1] + v[i][2] * v[i][2] + v[i][3] * v[i][3]; }
    ss = wsum(ss); const float rinv = rsq_f(ss * (1.0f / 1024.0f) + EPS);
    const float* g = p.in[6] + (size_t)(layer * 3 + k) * 1024; const float* sh = modp(p, layer, r, 3 * k); const float* sc = modp(p, layer, r, 3 * k + 1);
    int row5 = 0, i5 = 0;
    if (s5) { if (r < NL) { const int b = r / SEQ, t = r % SEQ; row5 = b * S5L + t / 32; i5 = t % 32; } else { const int rr = r - NL; const int b = rr / 256, l = rr % 256; row5 = NB * S5L + b * S5C + l / 32; i5 = l % 32; } }
#pragma unroll
    for (int i = 0; i < 4; ++i) { const int d = i * 256 + lane * 4; const f32x4 gv = *(const f32x4*)(g + d), sv = *(const f32x4*)(sc + d), hv = *(const f32x4*)(sh + d); f32x4 o;
        for (int j = 0; j < 4; ++j) o[j] = v[i][j] * rinv * gv[j] * (1.0f + sv[j]) + hv[j];
        if (!s5) st4bf(wsb(p, O_HN) + (size_t)r * 1024 + d, o);
        else st4bf(wsb(p, O_UEXT) + ((size_t)(d >> 4) * NROW5P + row5) * 768 + i5 * 16 + (d & 15), o); } }
__device__ __forceinline__ void mla_row_wave(const P& p, int j, int r, int lane) {
    const float* x = (const float*)(p.ws + O_CALL) + (size_t)r * 768; f32x4 c[3]; float q[3];
#pragma unroll
    for (int i = 0; i < 3; ++i) { c[i] = *(const f32x4*)(x + i * 256 + lane * 4); q[i] = c[i][0] * c[i][0] + c[i][1] * c[i][1] + c[i][2] * c[i][2] + c[i][3] * c[i][3]; }
    const bool lo = lane < 32;
    const float ssq = wsum(q[0] + (lo ? q[1] : 0.f)), sskv = wsum((lo ? 0.f : q[1]) + (lo ? q[2] : 0.f)), ssr = wsum((lane >= 32 && lane < 48) ? q[2] : 0.f);
    const float rq = rsq_f(ssq * (1.0f / 384.0f) + EPS), rkv = rsq_f(sskv * (1.0f / 256.0f) + EPS), rr_ = rsq_f(ssr * (1.0f / 64.0f) + EPS);
    const float* qn = p.in[10] + j * 384; const float* kvn = p.in[11] + j * 256; const float* kg = p.in[15] + j * 192 + 128;
    { const f32x4 gq = *(const f32x4*)(qn + lane * 4); f32x4 o; for (int jx = 0; jx < 4; ++jx) o[jx] = c[0][jx] * rq * gq[jx]; st4bf(wsb(p, O_CQN) + (size_t)r * 384 + lane * 4, o); }
    if (lo) { const f32x4 gq = *(const f32x4*)(qn + 256 + lane * 4); f32x4 o; for (int jx = 0; jx < 4; ++jx) o[jx] = c[1][jx] * rq * gq[jx]; st4bf(wsb(p, O_CQN) + (size_t)r * 384 + 256 + lane * 4, o);
        const f32x4 gk = *(const f32x4*)(kvn + 128 + lane * 4); f32x4 o2; for (int jx = 0; jx < 4; ++jx) o2[jx] = c[2][jx] * rkv * gk[jx]; st4bf(wsb(p, O_CKVN) + (size_t)r * 256 + 128 + lane * 4, o2); }
    else { const f32x4 gk = *(const f32x4*)(kvn + lane * 4 - 128); f32x4 o; for (int jx = 0; jx < 4; ++jx) o[jx] = c[1][jx] * rkv * gk[jx]; st4bf(wsb(p, O_CKVN) + (size_t)r * 256 + lane * 4 - 128, o); }
    const int dd = (4 * (lane - 32)) & 63; const f32x4 gr = *(const f32x4*)(kg + dd); f32x4 own, oth, o;
    for (int jx = 0; jx < 4; ++jx) own[jx] = c[2][jx] * rr_ * gr[jx];
    for (int jx = 0; jx < 4; ++jx) oth[jx] = __shfl_xor(own[jx], 4);
    const int t = r % SEQ, pos = (dd & 32) ? (t % 64) : (t / 64); const bool first = (dd & 16) == 0;
    for (int jx = 0; jx < 4; ++jx) { float cs = 1.f, sn = 0.f; if (r < NL) sincos_t((float)pos * ropef((dd & 15) + jx, 16), sn, cs);
        o[jx] = first ? own[jx] * cs - oth[jx] * sn : own[jx] * cs + oth[jx] * sn; }
    if (lane >= 32 && lane < 48) { u16* kf = wsb(p, O_KF) + (size_t)r * 1536 + 128 + dd;
#pragma unroll
        for (int h = 0; h < 8; ++h) st4bf(kf + h * 192, o); } }
__device__ __forceinline__ float bflo(unsigned w) { return __uint_as_float(w << 16); }
__device__ __forceinline__ float bfhi(unsigned w) { return __uint_as_float(w & 0xffff0000u); }
__device__ __forceinline__ unsigned pk2(float a, float b) { return (unsigned)f2bf(a) | ((unsigned)f2bf(b) << 16); }
__device__ __forceinline__ void mla_head_wave(const P& p, int j, int r, int lane) {
    const int h = lane >> 3, sub = lane & 7;
    u16* q = wsb(p, O_CALL) + (size_t)r * 1536 + h * 192; u16* k = wsb(p, O_KF) + (size_t)r * 1536 + h * 192;
    const float* qg = p.in[14] + j * 192; const float* kg = p.in[15] + j * 192;
    u32x4 qa = *(const u32x4*)(q + sub * 16), qb = *(const u32x4*)(q + sub * 16 + 8), qr = *(const u32x4*)(q + 128 + sub * 8), ka = *(const u32x4*)(k + sub * 16), kb = *(const u32x4*)(k + sub * 16 + 8);
    float sq = 0.f, sk = 0.f, sr = 0.f;
#pragma unroll
    for (int i = 0; i < 4; ++i) { sq += bflo(qa[i]) * bflo(qa[i]) + bfhi(qa[i]) * bfhi(qa[i]) + bflo(qb[i]) * bflo(qb[i]) + bfhi(qb[i]) * bfhi(qb[i]);
        sk += bflo(ka[i]) * bflo(ka[i]) + bfhi(ka[i]) * bfhi(ka[i]) + bflo(kb[i]) * bflo(kb[i]) + bfhi(kb[i]) * bfhi(kb[i]); sr += bflo(qr[i]) * bflo(qr[i]) + bfhi(qr[i]) * bfhi(qr[i]); }
    for (int o = 4; o >= 1; o >>= 1) { sq += __shfl_xor(sq, o); sk += __shfl_xor(sk, o); sr += __shfl_xor(sr, o); }
    const float rq = rsq_f(sq * (1.0f / 128.0f) + EPS), rk = rsq_f(sk * (1.0f / 128.0f) + EPS), rr_ = rsq_f(sr * (1.0f / 64.0f) + EPS);
    u32x4 oa, ob, oka, okb;
#pragma unroll
    for (int i = 0; i < 4; ++i) { const int d = sub * 16 + 2 * i;
        oa[i] = pk2(bflo(qa[i]) * rq * qg[d] * QSCALE, bfhi(qa[i]) * rq * qg[d + 1] * QSCALE); ob[i] = pk2(bflo(qb[i]) * rq * qg[d + 8] * QSCALE, bfhi(qb[i]) * rq * qg[d + 9] * QSCALE);
        oka[i] = pk2(bflo(ka[i]) * rk * kg[d], bfhi(ka[i]) * rk * kg[d + 1]); okb[i] = pk2(bflo(kb[i]) * rk * kg[d + 8], bfhi(kb[i]) * rk * kg[d + 9]); }
    *(u32x4*)(q + sub * 16) = oa; *(u32x4*)(q + sub * 16 + 8) = ob; *(u32x4*)(k + sub * 16) = oka; *(u32x4*)(k + sub * 16 + 8) = okb;
    const int dd = sub * 8; float own[8], oth[8];
#pragma unroll
    for (int i = 0; i < 4; ++i) { own[2 * i] = bflo(qr[i]) * rr_ * qg[128 + dd + 2 * i]; own[2 * i + 1] = bfhi(qr[i]) * rr_ * qg[128 + dd + 2 * i + 1]; }
#pragma unroll
    for (int i = 0; i < 8; ++i) oth[i] = __shfl_xor(own[i], 2);
    const int t = r % SEQ, pos = (dd & 32) ? (t % 64) : (t / 64); const bool first = (dd & 16) == 0; u32x4 orr; float res[8];
#pragma unroll
    for (int i = 0; i < 8; ++i) { float cs = 1.f, sn = 0.f; if (r < NL) sincos_t((float)pos * ropef((dd & 15) + i, 16), sn, cs); res[i] = first ? own[i] * cs - oth[i] * sn : own[i] * cs + oth[i] * sn; }
#pragma unroll
    for (int i = 0; i < 4; ++i) orr[i] = pk2(res[2 * i] * QSCALE, res[2 * i + 1] * QSCALE);
    *(u32x4*)(q + 128 + dd) = orr; }
__device__ __forceinline__ void ret_norm_wave(const P& p, int q, int lr, int lane) {
    const int h = lane >> 4, sub = lane & 15; u16* o = wsb(p, O_OB) + (size_t)lr * 2048 + h * 512 + sub * 32; u16* yd = ret_ydst(p, q, lr) + h * 512 + sub * 32; const u16* g = wsb(p, O_GATE) + (size_t)lr * 2048 + h * 512 + sub * 32; const float* gg = p.in[19] + h * 512 + sub * 32;
    u32x4 ov[4]; float s = 0.f;
#pragma unroll
    for (int i = 0; i < 4; ++i) { ov[i] = *(const u32x4*)(o + i * 8); for (int jx = 0; jx < 4; ++jx) s += bflo(ov[i][jx]) + bfhi(ov[i][jx]); }
    for (int m = 8; m >= 1; m >>= 1) s += __shfl_xor(s, m);
    const float mu = s * (1.0f / 512.0f); float qv = 0.f;
#pragma unroll
    for (int i = 0; i < 4; ++i) for (int jx = 0; jx < 4; ++jx) { const float a = bflo(ov[i][jx]) - mu, b = bfhi(ov[i][jx]) - mu; qv += a * a + b * b; }
    for (int m = 8; m >= 1; m >>= 1) qv += __shfl_xor(qv, m);
    const float rstd = rsq_f(qv * (1.0f / 512.0f) + EPS);
#pragma unroll
    for (int i = 0; i < 4; ++i) { const u32x4 gv = *(const u32x4*)(g + i * 8); u32x4 w;
        for (int jx = 0; jx < 4; ++jx) { const int e = i * 8 + 2 * jx;
            w[jx] = pk2((bflo(ov[i][jx]) - mu) * rstd * gg[e] * silu_f(bflo(gv[jx])), (bfhi(ov[i][jx]) - mu) * rstd * gg[e + 1] * silu_f(bfhi(gv[jx]))); }
        *(u32x4*)(yd + i * 8) = w; } }
__device__ __forceinline__ void mod_phase(const P& p, float* tab) {
    for (int i = threadIdx.x; i < NMR * 1024; i += 512) { const int b = i >> 10, k = i & 1023; tab[i] = silu_f(b < NB ? p.in[1][b * 1024 + k] : p.in[3][k]); }
    __syncthreads();
    for (int idx = blockIdx.x * 512 + threadIdx.x; idx < DEPTH * 9216; idx += gridDim.x * 512) {
        const int layer = idx / 9216, col = idx % 9216; const float* w = p.in[4] + (size_t)layer * 1024 * 9216 + col; float acc[NMR];
#pragma unroll
        for (int b = 0; b < NMR; ++b) acc[b] = 0.f;
        for (int k = 0; k < 1024; ++k) { const float wv = w[(size_t)k * 9216];
#pragma unroll
            for (int b = 0; b < NMR; ++b) acc[b] += tab[b * 1024 + k] * wv; }
        const float bias = p.in[5][layer * 9216 + col];
#pragma unroll
        for (int b = 0; b < NMR; ++b) ((float*)(p.ws + O_MOD))[(size_t)(layer * NMR + b) * 9216 + col] = acc[b] + bias; }
    __syncthreads(); }
#define WPASS(N, HOSTCALL, DEVCALL) do { const int _n = (int)(N); int t0_ = threadIdx.x; asm volatile("" : "+v"(t0_)); const int lane = t0_ & 63; for (int it = blockIdx.x * 8 + (t0_ >> 6); it < _n; it += gridDim.x * 8) { DEVCALL; } } while (0)
#define MODPHASE() mod_phase(p, (float*)shm)
#define NCTXWG ((NC / 256) * 4)
#define MIXED_DOWN_NORM(DESC, LAYER2, KK, S5F, ASHARE) do { int t0_ = threadIdx.x; asm volatile("" : "+v"(t0_)); const int lane = t0_ & 63; int r0_, r1_; \
    if ((int)blockIdx.x < NCTXWG) { gemm_run(lds, DESC); r0_ = (int)blockIdx.x * (ASHARE); r1_ = r0_ + (ASHARE); }     \
    else { const int no_ = (int)gridDim.x - NCTXWG, rest_ = NL - NCTXWG * (ASHARE), per_ = (rest_ + no_ - 1) / no_; r0_ = NCTXWG * (ASHARE) + ((int)blockIdx.x - NCTXWG) * per_; r1_ = r0_ + per_ < NL ? r0_ + per_ : NL; } \
    for (int it = r0_ + (t0_ >> 6); it < r1_; it += 8) norm_wave(p, LAYER2, KK, it, S5F, lane); } while (0)
#define MIXED_RET_TAIL(LATDESC, CTXDESC, NCW, LAYER2, KK, RA, RB) do { gemm_run(lds, LATDESC); int t0_ = threadIdx.x; asm volatile("" : "+v"(t0_)); const int lane = t0_ & 63; \
    if ((int)blockIdx.x < (NCW)) { gemm_run(lds, CTXDESC); } else { const int nw_ = ((int)gridDim.x - (NCW)) * 8; \
        for (int it = (RA) + ((int)blockIdx.x - (NCW)) * 8 + (t0_ >> 6); it < (RB); it += nw_) norm_wave(p, LAYER2, KK, it, 0, lane); } } while (0)
#define RANGENORM(LAYER2, KK, RA, RB) do { int t0_ = threadIdx.x; asm volatile("" : "+v"(t0_)); const int lane = t0_ & 63; for (int it = (RA) + blockIdx.x * 8 + (t0_ >> 6); it < (RB); it += gridDim.x * 8) norm_wave(p, LAYER2, KK, it, 0, lane); } while (0)
#define CTXNORM(LAYER2, KK, S5F) do { int t0_ = threadIdx.x; asm volatile("" : "+v"(t0_)); const int lane = t0_ & 63; for (int it = NL + blockIdx.x * 8 + (t0_ >> 6); it < MT; it += gridDim.x * 8) norm_wave(p, LAYER2, KK, it, S5F, lane); } while (0)

#define XB_TMO      128
#define XB_XCNT(j)  (256  + 64 * (j))
#define XB_XSUB(j)  (1280 + 64 * (j))
#define XB_XGEN(j)  (2304 + 64 * (j))
#define XB_TOP      3328
#define XB_TOPGEN   3392
#define XCD_BAR_WORDS 3456
#define XB_SPIN_CAP (1u << 18)
__device__ __forceinline__ unsigned xb_ld(unsigned* p)              { return __hip_atomic_load(p, __ATOMIC_RELAXED, __HIP_MEMORY_SCOPE_AGENT); }
__device__ __forceinline__ unsigned xb_add(unsigned* p, unsigned v) { return __hip_atomic_fetch_add(p, v, __ATOMIC_RELAXED, __HIP_MEMORY_SCOPE_AGENT); }
__device__ __forceinline__ unsigned xb_xcc_id() { return (unsigned)__builtin_amdgcn_s_getreg((3 << 11) | 20) & 0xFu; }
#define XB_SPIN(cond, bar) do { unsigned _sp = 0; while (cond) { __builtin_amdgcn_s_sleep(1); \
    if ((++_sp & 255u) == 0u) { if (xb_ld(&(bar)[XB_TMO])) break; if (_sp > XB_SPIN_CAP) { atomicAdd(&(bar)[XB_TMO], 1u); break; } } } } while (0)
struct XcdBarrier { unsigned* bar; unsigned x; volatile LAS unsigned* st; };
__device__ __forceinline__ XcdBarrier xcd_barrier_post(unsigned* bar, volatile LAS unsigned* st) {
    XcdBarrier b; b.bar = bar; b.x = xb_xcc_id(); b.st = st;
    if (threadIdx.x == 0) (void)xb_add(&bar[XB_XCNT(b.x)], 1u);
    return b; }
__device__ __forceinline__ void xcd_barrier_complete(unsigned* bar, unsigned x, unsigned& nloc, unsigned& nx) {
    const unsigned G = gridDim.x * gridDim.y * gridDim.z; unsigned sum, cnt, mine, sp = 0u;
    for (;;) { sum = 0u; cnt = 0u; mine = 0u;
#pragma unroll
        for (unsigned j = 0; j < 16; ++j) { const unsigned c = xb_ld(&bar[XB_XCNT(j)]); sum += c; cnt += (c > 0u) ? 1u : 0u; mine = (j == x) ? c : mine; }
        if (sum == G) break;
        __builtin_amdgcn_s_sleep(1);
        if ((++sp & 255u) == 0u) { if (xb_ld(&bar[XB_TMO])) break; if (sp > XB_SPIN_CAP) { atomicAdd(&bar[XB_TMO], 1u); break; } } }
    nloc = mine > 0u ? mine : 1u; nx = cnt > 0u ? cnt : 1u; }
__device__ __forceinline__ void xcd_barrier(const XcdBarrier& b) {
    asm volatile("s_waitcnt vmcnt(0)" ::: "memory");
    __syncthreads();
    if (threadIdx.x == 0) {
        unsigned* bar = b.bar;
        __builtin_amdgcn_s_waitcnt(0);
        unsigned nloc = b.st[0], nx = b.st[1];
        if (nloc == 0u) { xcd_barrier_complete(bar, b.x, nloc, nx); b.st[0] = nloc; b.st[1] = nx; }
        const unsigned old = xb_add(&bar[XB_XSUB(b.x)], 1u);
        const unsigned gen = old / nloc;
        if (old + 1u == (gen + 1u) * nloc) {
            __builtin_amdgcn_fence(__ATOMIC_RELEASE, "agent");
            asm volatile("s_waitcnt vmcnt(0)" ::: "memory");
            const unsigned og = xb_add(&bar[XB_TOP], 1u);
            const unsigned tg = og / nx;
            if (og + 1u == (tg + 1u) * nx) xb_add(&bar[XB_TOPGEN], 1u);
            else XB_SPIN(xb_ld(&bar[XB_TOPGEN]) == tg, bar);
            __builtin_amdgcn_fence(__ATOMIC_ACQUIRE, "agent");
            xb_add(&bar[XB_XGEN(b.x)], 1u);
            asm volatile("s_waitcnt vmcnt(0)" ::: "memory");
        } else {
            XB_SPIN(xb_ld(&bar[XB_XGEN(b.x)]) == gen, bar);
            __builtin_amdgcn_fence(__ATOMIC_ACQUIRE, "agent");
            asm volatile("s_waitcnt vmcnt(0)" ::: "memory");
        }
    }
    __syncthreads();
}

namespace cg = cooperative_groups;
#define PASS(N, CALL) do { const long _n = (long)(N); int t0_ = threadIdx.x; asm volatile("" : "+v"(t0_)); for (long it = (long)blockIdx.x * 512 + t0_; it < _n; it += (long)gridDim.x * 512) { CALL; } } while (0)
#define GEMM(D) gemm_run(lds, D)
#define SYNC() xcd_barrier(xb)
#ifndef STAGGER_US
#define STAGGER_US 40
#endif
#define STAGGER(US) do { if ((US) > 0 && (xb.x & 1u)) { const unsigned long long t0_ = __builtin_amdgcn_s_memrealtime(); while (__builtin_amdgcn_s_memrealtime() - t0_ < (unsigned long long)(US) * 100ull) __builtin_amdgcn_s_sleep(8); } } while (0)
#define GRIDSYNC() grid.sync()
#define HOOK(L, S) do { } while (0)
#define ATTN(NITEMS) do { for (int it = blockIdx.x; it < (NITEMS); it += gridDim.x) { AttItem ai_; att_item(p, it, ai_); att_body(ai_, (char*)shm); } } while (0)
#else
template <class Dsc> static void gemm_emu(const Dsc& D) {
    std::vector<int> Ls; for (int c = 0; c < 256; ++c) for (int i = 0;; ++i) { Unit u{}; if (!D.unit(i * 256 + c, u)) break; Ls.push_back(i * 256 + c); }
    const int n = (int)Ls.size();
#pragma omp parallel for schedule(dynamic)
    for (int li = 0; li < n; ++li) { const int L = Ls[li]; Unit u{}; D.unit(L, u); const int K = Dsc::K;
        std::vector<float> A((size_t)256 * K), B((size_t)256 * K), C((size_t)256 * 256);
        for (int r = 0; r < 256; ++r) for (int k = 0; k < K; ++k) { A[(size_t)r * K + k] = bf2f(u.A[(size_t)r * Dsc::lda + k]); B[(size_t)r * K + k] = bf2f(u.B[(size_t)r * Dsc::ldb + k]); }
        for (int r = 0; r < 256; ++r) for (int c = 0; c < 256; ++c) { float s = 0.f; const float* a = &A[(size_t)r * K]; const float* b = &B[(size_t)c * K]; for (int k = 0; k < K; ++k) s += a[k] * b[k]; C[r * 256 + c] = s; }
        for (int r = 0; r < 128; ++r) for (int c = 0; c < 128; c += 4) { f32x4 v[2][2];
            for (int X = 0; X < 2; ++X) for (int Y = 0; Y < 2; ++Y) for (int j = 0; j < 4; ++j) v[X][Y][j] = C[(r + 128 * X) * 256 + c + 128 * Y + j];
            D.emit(u, r, c, v[0][0], v[0][1], v[1][0], v[1][1]); } } }
static void att_emu(const P& p, int nitems) {
#pragma omp parallel for schedule(dynamic)
    for (int it = 0; it < nitems; ++it) { AttItem a; att_item(p, it, a); std::vector<float> s(a.ntot);
        for (int i = 0; i < 256; ++i) { const u16* q = a.q + (size_t)i * 1536; float l = 0.f; float o[128]; for (int e = 0; e < 128; ++e) o[e] = 0.f;
            for (int k = 0; k < a.ntot; ++k) { const u16* kr = k < a.n0 ? a.k0 + (size_t)k * 1536 : a.k1 + (size_t)(k - a.n0) * 1536; float d = 0.f; for (int x = 0; x < 192; ++x) d += bf2f(q[x]) * bf2f(kr[x]);
                const float pv = bf2f(f2bf(exp2f(d))); l += exp2f(d); const u16* vr = k < a.n0 ? a.v0 + (size_t)k * 1024 : a.v1 + (size_t)(k - a.n0) * 1024; for (int e = 0; e < 128; ++e) o[e] += pv * bf2f(vr[e]); }
            for (int e = 0; e < 128; ++e) a.o[(size_t)i * 1024 + e] = f2bf(o[e] / l); } } }
#define PASS(N, CALL) do { const long _n = (long)(N); _Pragma("omp parallel for schedule(static)") for (long it = 0; it < _n; ++it) { CALL; } } while (0)
#define WPASS(N, HOSTCALL, DEVCALL) PASS(N, HOSTCALL)
#define MODPHASE() PASS(DEPTH * 9216, mod_item(p, (int)it))
#define MIXED_DOWN_NORM(DESC, LAYER2, KK, S5F, ASHARE) do { gemm_emu(DESC); PASS(NL, norm_item(p, LAYER2, KK, (int)it, S5F)); } while (0)
#define CTXNORM(LAYER2, KK, S5F) PASS(NC, norm_item(p, LAYER2, KK, NL + (int)it, S5F))
#define MIXED_RET_TAIL(LATDESC, CTXDESC, NCW, LAYER2, KK, RA, RB) do { gemm_emu(LATDESC); gemm_emu(CTXDESC); PASS((RB) - (RA), norm_item(p, LAYER2, KK, (RA) + (int)it, 0)); } while (0)
#define RANGENORM(LAYER2, KK, RA, RB) PASS((RB) - (RA), norm_item(p, LAYER2, KK, (RA) + (int)it, 0))
#define GEMM(D) gemm_emu(D)
#define SYNC() do { } while (0)
#define STAGGER(US) do { } while (0)
#define GRIDSYNC() do { } while (0)
#define ATTN(NITEMS) att_emu(p, NITEMS)
static void emu_hook(const P& p, int layer, int stage);
#define HOOK(L, S) emu_hook(p, L, S)
#endif

#ifndef HOST_EMU
__global__ void __launch_bounds__(512) fwd_megakernel(P p) {
    extern __shared__ __attribute__((aligned(16))) unsigned char shm[];
    LAS unsigned char* lds = (LAS unsigned char*)shm;
    cg::grid_group grid = cg::this_grid();
    volatile LAS unsigned* xst = (volatile LAS unsigned*)(lds + STAGE_BYTES + 1024);
    if (threadIdx.x == 0) { xst[0] = 0u; xst[1] = 0u; xst[2] = 0u; xst[3] = 0u; }
    __syncthreads();
    const XcdBarrier xb = xcd_barrier_post((unsigned*)(p.ws + O_BAR), xst);
#else
static void fwd_emu(P p) {
#endif
    if (PM(0)) { MODPHASE();
    PASS((long)NC * 256, ((f32x4*)(p.ws + O_G))[it] = ((const f32x4*)p.in[2])[it]);
    PASS(CV_TOTAL, cvt_item(p, it));
    PASS(64 * 2 * 32 * 16, s5_ktab_item(p, (int)it));
    PASS(64 * 256 * 512, s5_fext_item(p, (int)it)); }
    GRIDSYNC();
    if (PM(0)) { PASS((long)64 * 512 * 768, s5_text_item(p, it)); }
    for (int rep_ = 0; rep_ < REP_SYNC; ++rep_) SYNC();
    for (int layer = 0; layer < DEPTH; ++layer) {
        const int kind = layer % 3, j = layer / 3; const bool last = layer == DEPTH - 1;
        if (layer == 0) { if (PM(1)) { WPASS(MT, norm_item(p, layer, 0, (int)it, 0), norm_wave(p, layer, 0, it, 0, lane)); } SYNC(); }
        for (int rep_ = 0; rep_ < REP_UP; ++rep_) { if (PM(2)) { DFfnUp d{p, layer, 0, MT / 256}; GEMM(d); } SYNC(); }
        if (PM(3)) { DFfnDown d{p, layer, 0, NL / 256, 0.5f}; GEMM(d); } SYNC();
        if (PM(3)) { DFfnDown d{p, layer, 0, -1, 0.5f}; MIXED_DOWN_NORM(d, layer, 1, kind == 2 ? 1 : 0, 56); } SYNC();
        if (PM(1)) { CTXNORM(layer, 1, kind == 2 ? 1 : 0); } SYNC();
        if (kind == 0) {
            for (int rep_ = 0; rep_ < REP_MLA; ++rep_) { if (PM(4)) { DMlaIn d{p, j}; GEMM(d); } SYNC(); }
            if (PM(5)) { WPASS(MT, mla_row_item(p, j, (int)it), mla_row_wave(p, j, it, lane)); } SYNC();
            for (int rep_ = 0; rep_ < REP_MLA; ++rep_) { if (PM(6)) { DMlaUq d{p, j, last ? NL / 256 : MT / 256}; GEMM(d); } if (PM(7)) { DMlaUkv d{p, j}; GEMM(d); } SYNC(); }
            if (PM(8)) { WPASS(MT, { for (int h_ = 0; h_ < 8; ++h_) mla_head_item(p, j, (int)it * 8 + h_); }, mla_head_wave(p, j, it, lane)); } SYNC();
            for (int rep_ = 0; rep_ < REP_ATT; ++rep_) { if (PM(9)) { ATTN(NB * 8 * (SEQ / 256) + (last ? 0 : NB * 8)); } SYNC(); }
            if (PM(10)) { DMlaO d{p, layer, j, NL / 256}; GEMM(d); } SYNC();
            if (!last) { if (PM(10)) { DMlaO d{p, layer, j, -1}; MIXED_DOWN_NORM(d, layer, 2, 0, 184); } SYNC();
                if (PM(1)) { CTXNORM(layer, 2, 0); } SYNC(); }
        } else if (kind == 1) {
            for (int q = 0; q < NB / RGB; ++q) {
                for (int rep_ = 0; rep_ < REP_RET; ++rep_) { if (PM(11)) { DRetProjAll d{p, q}; GEMM(d); } SYNC(); }
                for (int rep_ = 0; rep_ < REP_RET; ++rep_) { if (PM(13)) { DRetP d{p}; GEMM(d); } if (PM(14)) { DRetL d{p}; GEMM(d); } SYNC(); }
                if (PM(15)) { PASS(4 * RGB * 512 * 64, ret_prefix_item(p, (int)it)); } SYNC();
                for (int rep_ = 0; rep_ < REP_RET; ++rep_) { if (PM(16)) { DRetO d{p}; GEMM(d); } SYNC(); }
                if (PM(17)) { WPASS(NCQ * 256, { for (int h_ = 0; h_ < 4; ++h_) ret_norm_item(p, q, (int)it * 4 + h_); }, ret_norm_wave(p, q, it, lane)); } SYNC();
                if (q < NB / RGB - 1) { if (PM(18)) { DRetWo d{p, layer, q}; GEMM(d); } SYNC(); }
                else { if (PM(18)) { DRetWo d{p, layer, q}; DRetWoCtx c{p, layer}; MIXED_RET_TAIL(d, c, (NC / 256) * 4, layer, 2, 0, q * RGB * SEQ); } SYNC();
                    if (PM(1)) { RANGENORM(layer, 2, q * RGB * SEQ, MT); } SYNC(); }
            }
        } else {
            for (int rep_ = 0; rep_ < REP_S5; ++rep_) { if (PM(20)) { DS5L d{p}; GEMM(d); } SYNC(); }
            if (PM(21)) { PASS(64 * NB * 64, s5_prefix_item(p, (int)it)); } SYNC();
            for (int rep_ = 0; rep_ < REP_S5; ++rep_) { if (PM(22)) { DS5Y d{p}; GEMM(d); } SYNC(); }
            if (PM(23)) { DS5Glu d{p, layer}; GEMM(d); } SYNC();
        }
        HOOK(layer, 0);
        if (kind == 2 || (kind == 0 && last)) { if (PM(1)) { WPASS(last ? NL : MT, norm_item(p, layer, 2, (int)it, 0), norm_wave(p, layer, 2, it, 0, lane)); } SYNC(); }
        for (int rep_ = 0; rep_ < REP_UP; ++rep_) { if (PM(2)) { DFfnUp d{p, layer, 1, last ? NL / 256 : MT / 256}; GEMM(d); } SYNC(); }
        if (PM(3)) { DFfnDown d{p, layer, 1, NL / 256, 0.5f}; GEMM(d); } SYNC();
        if (!last) { if (PM(3)) { DFfnDown d{p, layer, 1, -1, 0.5f}; MIXED_DOWN_NORM(d, layer + 1, 0, 0, 56); } SYNC();
            if (PM(1)) { CTXNORM(layer + 1, 0, 0); } SYNC(); }
        HOOK(layer, 1);
    }
}

#ifndef HOST_EMU
extern "C" void kernel_launch(void* const* d_in, const int* in_sizes, int n_in, void* d_out, int out_size, void* d_ws, size_t ws_size, hipStream_t stream) {
    constexpr size_t kDynLds = STAGE_BYTES + 4096;
    static int grid_blocks = 0;
    if (!grid_blocks) {
        int dev = 0, cus = 0, per_cu = 0;
        hipGetDevice(&dev);
        hipDeviceGetAttribute(&cus, hipDeviceAttributeMultiprocessorCount, dev);
        hipFuncSetAttribute((const void*)fwd_megakernel, hipFuncAttributeMaxDynamicSharedMemorySize, (int)kDynLds);
        hipOccupancyMaxActiveBlocksPerMultiprocessor(&per_cu, fwd_megakernel, 512, kDynLds);
        if (per_cu < 1) per_cu = 1;
        if (per_cu > 1) per_cu = 1;
        grid_blocks = cus * per_cu;
        if (ws_size < WS_NEED) fprintf(stderr, "workspace too small: %zu < %zu\n", ws_size, (size_t)WS_NEED);
    }
    P p{};
    for (int i = 0; i < 31 && i < n_in; ++i) p.in[i] = (const float*)d_in[i];
    p.out = (float*)d_out; p.ws = (char*)d_ws;
    hipMemsetAsync((char*)d_ws + O_BAR, 0, XCD_BAR_WORDS * 4, stream);
    void* args[] = {&p};
    hipError_t e = hipLaunchCooperativeKernel((void*)fwd_megakernel, dim3(grid_blocks), dim3(512), args, kDynLds, stream);
    if (e != hipSuccess) fprintf(stderr, "cooperative launch failed: %s (grid %d)\n", hipGetErrorString(e), grid_blocks);
}
#endif
```

```cpp
#ifdef HOST_EMU
#include <cmath>
#include <cstdio>
#include <cstdlib>
#include <cstring>
#include <vector>
#define HD inline
#else
#include <hip/hip_runtime.h>
#include <hip/hip_cooperative_groups.h>
#include <cstdio>
#define HD __device__ __forceinline__
#endif

#ifndef CFG_BATCH
#define CFG_BATCH 16
#endif
#ifndef CFG_SEQ
#define CFG_SEQ 4096
#endif

typedef unsigned short u16;
typedef float f32x4 __attribute__((ext_vector_type(4)));
typedef unsigned u32x2 __attribute__((ext_vector_type(2)));

constexpr int DM = 1024, NB = CFG_BATCH, SEQ = CFG_SEQ, CTX = 256, DFF = 2816, DEPTH = 4;
constexpr int NL = NB * SEQ, NC = NB * CTX, MT = NL + NC;
constexpr int NMR = NB + 1;
constexpr int RGB = (NB >= 4) ? 4 : 1;
constexpr int NCH = 1 + SEQ / 256;
constexpr int NCQ = RGB * NCH;
constexpr int S5L = SEQ / 32, S5C = CTX / 32;
constexpr int NROW5 = NB * S5L + NB * S5C;
constexpr int NROW5P = (NROW5 + 255) / 256 * 256;
constexpr float EPS = 1e-6f;
constexpr float ATT_SCALE = 0.07216878364870322f;
constexpr float QSCALE = ATT_SCALE * 1.4426950408889634f;

constexpr size_t al(size_t x) { return (x + 255) & ~(size_t)255; }
constexpr size_t O_BAR = 0;
constexpr size_t O_MOD = 16384;
constexpr size_t O_G = O_MOD + al((size_t)DEPTH * NMR * 9216 * 4);
constexpr size_t O_FFI = O_G + al((size_t)NC * 1024 * 4);
constexpr size_t SZ_FFI1 = (size_t)5632 * 1024 * 2, SZ_FFO1 = (size_t)1024 * 2816 * 2;
constexpr size_t O_FFO = O_FFI + 8 * SZ_FFI1;
constexpr size_t O_MWIN = O_FFO + 8 * SZ_FFO1;
constexpr size_t SZ_MWIN = (size_t)768 * 1024 * 2, SZ_MWUQ = (size_t)1536 * 384 * 2, SZ_MWUKV = (size_t)2048 * 256 * 2, SZ_MWO = (size_t)1024 * 1024 * 2;
constexpr size_t O_MWUQ = O_MWIN + 2 * SZ_MWIN;
constexpr size_t O_MWUKV = O_MWUQ + 2 * SZ_MWUQ;
constexpr size_t O_MWO = O_MWUKV + 2 * SZ_MWUKV;
constexpr size_t O_RWIN = O_MWO + 2 * SZ_MWO;
constexpr size_t O_RWO = O_RWIN + (size_t)6144 * 1024 * 2;
constexpr size_t O_GLU = O_RWO + (size_t)1024 * 2048 * 2;
constexpr size_t O_HN = O_GLU + (size_t)2048 * 1024 * 2;
constexpr size_t O_KTAB = O_HN + al((size_t)MT * 1024 * 2);
constexpr size_t O_TEXT = O_KTAB + al((size_t)64 * 2 * 32 * 256 * 4);
constexpr size_t O_FEXT = O_TEXT + al((size_t)64 * 512 * 768 * 2);
constexpr size_t O_SCR = O_FEXT + al((size_t)64 * 256 * 512 * 2);
constexpr size_t O_ACT = O_SCR;
constexpr size_t O_CALL = O_SCR;
constexpr size_t O_CQN = O_CALL + al((size_t)MT * 768 * 4);
constexpr size_t O_CKVN = O_CQN + al((size_t)MT * 384 * 2);
constexpr size_t O_KF = O_CKVN + al((size_t)MT * 256 * 2);
constexpr size_t O_VB = O_KF + al((size_t)MT * 1536 * 2);
constexpr size_t END_MLA = O_VB + al((size_t)MT * 1024 * 2);
constexpr size_t O_QN = O_SCR;
constexpr size_t O_KN = O_QN + al((size_t)NCQ * 256 * 1024 * 2);
constexpr size_t O_GATE = O_KN + al((size_t)NCQ * 256 * 1024 * 2);
constexpr size_t O_OB = O_GATE + al((size_t)NCQ * 256 * 2048 * 2);
constexpr size_t O_AEXT = O_OB + al((size_t)NCQ * 256 * 2048 * 2);
constexpr size_t O_KTX = O_AEXT + al((size_t)4 * NCQ * 256 * 768 * 2);
constexpr size_t O_BEXT = O_KTX + al((size_t)4 * NCQ * 2 * 256 * 256 * 2);
constexpr size_t O_YCTX = O_BEXT + al((size_t)4 * NCQ * 512 * 768 * 2);
constexpr size_t END_RET = O_YCTX + al((size_t)NC * 2048 * 2);
constexpr size_t O_UEXT = O_SCR;
constexpr size_t END_S5 = O_UEXT + al((size_t)64 * NROW5P * 768 * 2);
constexpr size_t END_FFN = O_ACT + al((size_t)MT * 2816 * 2);
constexpr size_t cmax(size_t a, size_t b) { return a > b ? a : b; }
constexpr size_t WS_NEED = cmax(cmax(END_MLA, END_RET), cmax(END_S5, END_FFN));

struct P { const float* in[32]; float* out; char* ws; };
#ifndef PHASE_MASK
#define PHASE_MASK 0xFFFFFFFFu
#endif
#define PM(b) ((PHASE_MASK >> (b)) & 1u)
#ifndef REP_UP
#define REP_UP 1
#endif
#ifndef REP_ATT
#define REP_ATT 1
#endif
#ifndef REP_NORM
#define REP_NORM 1
#endif
#ifndef REP_RET
#define REP_RET 1
#endif
#ifndef REP_DOWN
#define REP_DOWN 1
#endif
#ifndef REP_MLA
#define REP_MLA 1
#endif
#ifndef REP_S5
#define REP_S5 1
#endif
#ifndef REP_SYNC
#define REP_SYNC 0
#endif

HD float bf2f(u16 b) { union { unsigned u; float f; } x; x.u = ((unsigned)b) << 16; return x.f; }
HD u16 f2bf(float f) { union { unsigned u; float f; } x; x.f = f; unsigned u = x.u; u += 0x7fffu + ((u >> 16) & 1u); return (u16)(u >> 16); }
#ifdef HOST_EMU
HD void st4bf(u16* p, f32x4 v) { u32x2 w; w.x = (unsigned)f2bf(v[0]) | ((unsigned)f2bf(v[1]) << 16); w.y = (unsigned)f2bf(v[2]) | ((unsigned)f2bf(v[3]) << 16); *(u32x2*)p = w; }
#else
HD unsigned cvtpk_bf(float lo, float hi) { unsigned r; asm("v_cvt_pk_bf16_f32 %0, %1, %2" : "=v"(r) : "v"(lo), "v"(hi)); return r; }
HD void st4bf(u16* p, f32x4 v) { u32x2 w; w.x = cvtpk_bf(v[0], v[1]); w.y = cvtpk_bf(v[2], v[3]); *(u32x2*)p = w; }
#endif
#ifdef HOST_EMU
HD float silu_f(float a) { return a / (1.0f + expf(-a)); }
HD float sigm_f(float a) { return 1.0f / (1.0f + expf(-a)); }
HD float gelu_f(float x) { return 0.5f * x * (1.0f + tanhf(0.7978845608028654f * (x + 0.044715f * x * x * x))); }
#else
HD float sigm_f(float a) { return __builtin_amdgcn_rcpf(1.0f + __builtin_amdgcn_exp2f(-1.4426950408889634f * a)); }
HD float silu_f(float a) { return a * sigm_f(a); }
HD float gelu_f(float x) { return x * sigm_f(1.5957691216057308f * (x + 0.044715f * x * x * x)); }
#endif
HD float rsq_f(float x) { return 1.0f / sqrtf(x); }
HD float ex2(float x) {
#ifdef HOST_EMU
    return exp2f(x);
#else
    return __builtin_amdgcn_exp2f(x);
#endif
}
HD const float* hsrc(const P& p, int r, int first) { if (first && r < NL) return p.in[0] + (size_t)r * 1024; return r < NL ? p.out + (size_t)r * 1024 : (const float*)(p.ws + O_G) + (size_t)(r - NL) * 1024; }
HD float* hrow(const P& p, int r) { return r < NL ? p.out + (size_t)r * 1024 : (float*)(p.ws + O_G) + (size_t)(r - NL) * 1024; }
HD const float* modp(const P& p, int layer, int r, int idx) { const int mr = r < NL ? r / SEQ : NB; return (const float*)(p.ws + O_MOD) + ((size_t)(layer * NMR + mr) * 9 + idx) * 1024; }
HD u16* wsb(const P& p, size_t off) { return (u16*)(p.ws + off); }
#ifdef HOST_EMU
HD float ropef(int d, int half) { return expf(-(float)d * (9.210340371976184f / (float)half)) * 0.15915494309189535f; }
#else
HD float ropef(int d, int half) { return __builtin_amdgcn_exp2f(-(float)d * (13.287712379549449f / (float)half)) * 0.15915494309189535f; }
#endif
HD void sincos_t(float turns, float& sn, float& cs) {
    const float f = turns - floorf(turns);
#ifdef HOST_EMU
    sn = sinf(6.283185307179586f * f); cs = cosf(6.283185307179586f * f);
#else
    sn = __builtin_amdgcn_sinf(f); cs = __builtin_amdgcn_cosf(f);
#endif
}

HD bool rect_unit(int L, int nM, int nN, int& pm, int& pn) {
    const int nwg = nM * nN; if (L >= nwg) return false;
    int wgid = L; { const int q = nwg / 8, r = nwg % 8, xcd = wgid % 8, off = wgid / 8; wgid = (xcd < r ? xcd * (q + 1) : r * (q + 1) + (xcd - r) * q) + off; }
    const int nig = 8 * nN, gid = wgid / nig, fm = gid * 8, gsz = (nM - fm) < 8 ? (nM - fm) : 8;
    pm = fm + ((wgid % nig) % gsz); pn = (wgid % nig) / gsz; return true;
}

struct Unit { const u16* A; const u16* B; int a, b, c, d; float f0, f1; };

struct DFfnUp { P p; int layer, f, nM; static constexpr int FENCE = 1; static constexpr int K = 1024, lda = 1024, ldb = 1024;
    HD bool unit(int L, Unit& u) const { int pm, pn; if (!rect_unit(L, nM, 22, pm, pn)) return false;
        u.A = wsb(p, O_HN) + (size_t)pm * 256 * 1024; u.B = wsb(p, O_FFI + (size_t)(layer * 2 + f) * SZ_FFI1) + (size_t)pn * 256 * 1024; u.a = pm; u.b = pn; u.c = 0; u.d = 0; return true; }
    HD void emit(const Unit& u, int r, int c, f32x4 v00, f32x4 v01, f32x4 v10, f32x4 v11) const {
        u16* act = wsb(p, O_ACT); const size_t R = (size_t)u.a * 256 + r; const int col = u.b * 128 + c; f32x4 o0, o1;
        for (int j = 0; j < 4; ++j) { o0[j] = silu_f(v00[j]) * v01[j]; o1[j] = silu_f(v10[j]) * v11[j]; }
        st4bf(act + R * 2816 + col, o0); st4bf(act + (R + 128) * 2816 + col, o1); } };

HD void resid4(const P& p, int layer, int midx, float sc, int R, int col, f32x4 v, int first = 0) {
    float* h = hrow(p, R) + col; const float* m = modp(p, layer, R, midx) + col; f32x4 x = *(const f32x4*)(hsrc(p, R, first) + col);
    for (int j = 0; j < 4; ++j) x[j] += sc * m[j] * v[j];
    *(f32x4*)h = x; }

struct DFfnDown { P p; int layer, f, nM; float sc; static constexpr int FENCE = 4; static constexpr int K = 2816, lda = 2816, ldb = 2816;
    HD bool unit(int L, Unit& u) const { int pm, pn;
        if (nM < 0) { if (L >= (NC / 256) * 4) return false; pm = NL / 256 + (L >> 2); pn = L & 3; }
        else if (((NL / 256) * 4) % 256 == 0 && nM > NL / 256) {
            if (L < (NL / 256) * 4) rect_unit(L, NL / 256, 4, pm, pn);
            else { const int c = L - (NL / 256) * 4; if (c >= 128 || (c & 1)) return false; const int k = c >> 1; pm = NL / 256 + (k >> 2); pn = k & 3; if (pm >= nM) return false; } }
        else if (!rect_unit(L, nM, 4, pm, pn)) return false;
        u.A = wsb(p, O_ACT) + (size_t)pm * 256 * 2816; u.B = wsb(p, O_FFO + (size_t)(layer * 2 + f) * SZ_FFO1) + (size_t)pn * 256 * 2816; u.a = pm; u.b = pn; u.c = 0; u.d = 0; return true; }
    HD void emit(const Unit& u, int r, int c, f32x4 v00, f32x4 v01, f32x4 v10, f32x4 v11) const {
        const int R = u.a * 256 + r, col = u.b * 256 + c, mi = f ? 8 : 2;
        const int first = (layer == 0 && f == 0 && sc != 0.f);
        resid4(p, layer, mi, sc, R, col, v00, first); resid4(p, layer, mi, sc, R, col + 128, v01, first); resid4(p, layer, mi, sc, R + 128, col, v10, first); resid4(p, layer, mi, sc, R + 128, col + 128, v11, first); } };
HD void atom4(float* g, const float* m, float sc, f32x4 v) {
#ifdef HOST_EMU
    for (int j = 0; j < 4; ++j) {
#pragma omp atomic
        g[j] += sc * m[j] * v[j]; }
#else
    for (int j = 0; j < 4; ++j) unsafeAtomicAdd(g + j, sc * m[j] * v[j]);
#endif
}
template <int KS, int SL0> struct DFfnDownCtx { P p; int layer, f; float sc; static constexpr int FENCE = 4; static constexpr int K = KS, lda = 2816, ldb = 2816;
    HD bool unit(int L, Unit& u) const { if (L >= 256) return false; const int x = SL0 ? (L + 128) % 256 : L; if (x >= 128 || x >= (NC / 256) * 8) return false;
        const int sl = x & 1, pn = (x >> 1) & 3, pm = NL / 256 + (x >> 3); const int k0 = SL0 ? 1536 + sl * 640 : sl * 768;
        u.A = wsb(p, O_ACT) + (size_t)pm * 256 * 2816 + k0; u.B = wsb(p, O_FFO + (size_t)(layer * 2 + f) * SZ_FFO1) + (size_t)pn * 256 * 2816 + k0; u.a = pm; u.b = pn; u.c = 0; u.d = 0; return true; }
    HD void one(int R, int col, f32x4 v) const { atom4(hrow(p, R) + col, modp(p, layer, R, f ? 8 : 2) + col, sc, v); }
    HD void emit(const Unit& u, int r, int c, f32x4 v00, f32x4 v01, f32x4 v10, f32x4 v11) const {
        const int R = u.a * 256 + r, col = u.b * 256 + c; one(R, col, v00); one(R, col + 128, v01); one(R + 128, col, v10); one(R + 128, col + 128, v11); } };

struct DMlaIn { P p; int j; static constexpr int FENCE = 1; static constexpr int K = 1024, lda = 1024, ldb = 1024;
    HD bool unit(int L, Unit& u) const { int pm, pn; if (!rect_unit(L, MT / 256, 3, pm, pn)) return false;
        u.A = wsb(p, O_HN) + (size_t)pm * 256 * 1024; u.B = wsb(p, O_MWIN + j * SZ_MWIN) + (size_t)pn * 256 * 1024; u.a = pm; u.b = pn; u.c = 0; u.d = 0; return true; }
    HD void emit(const Unit& u, int r, int c, f32x4 v00, f32x4 v01, f32x4 v10, f32x4 v11) const {
        float* o = (float*)(p.ws + O_CALL) + ((size_t)u.a * 256 + r) * 768 + u.b * 256 + c;
        *(f32x4*)o = v00; *(f32x4*)(o + 128) = v01; *(f32x4*)(o + (size_t)128 * 768) = v10; *(f32x4*)(o + (size_t)128 * 768 + 128) = v11; } };
struct DMlaUq { P p; int j, nM; static constexpr int FENCE = 1; static constexpr int K = 384, lda = 384, ldb = 384;
    HD bool unit(int L, Unit& u) const { int pm, pn; if (!rect_unit(L, nM, 6, pm, pn)) return false;
        u.A = wsb(p, O_CQN) + (size_t)pm * 256 * 384; u.B = wsb(p, O_MWUQ + j * SZ_MWUQ) + (size_t)pn * 256 * 384; u.a = pm; u.b = pn; u.c = 0; u.d = 0; return true; }
    HD void emit(const Unit& u, int r, int c, f32x4 v00, f32x4 v01, f32x4 v10, f32x4 v11) const {
        u16* o = wsb(p, O_CALL) + ((size_t)u.a * 256 + r) * 1536 + u.b * 256 + c;
        st4bf(o, v00); st4bf(o + 128, v01); st4bf(o + (size_t)128 * 1536, v10); st4bf(o + (size_t)128 * 1536 + 128, v11); } };
struct DMlaUkv { P p; int j; static constexpr int FENCE = 1; static constexpr int K = 256, lda = 256, ldb = 256;
    HD bool unit(int L, Unit& u) const { int pm, pn; if (!rect_unit(L, MT / 256, 8, pm, pn)) return false;
        u.A = wsb(p, O_CKVN) + (size_t)pm * 256 * 256; u.B = wsb(p, O_MWUKV + j * SZ_MWUKV) + (size_t)pn * 256 * 256; u.a = pm; u.b = pn; u.c = 0; u.d = 0; return true; }
    HD void one(size_t R, int col, f32x4 v) const {
        if (col < 1024) st4bf(wsb(p, O_KF) + R * 1536 + (col >> 7) * 192 + (col & 127), v);
        else st4bf(wsb(p, O_VB) + R * 1024 + (col - 1024), v); }
    HD void emit(const Unit& u, int r, int c, f32x4 v00, f32x4 v01, f32x4 v10, f32x4 v11) const {
        const size_t R = (size_t)u.a * 256 + r; const int col = u.b * 256 + c;
        one(R, col, v00); one(R, col + 128, v01); one(R + 128, col, v10); one(R + 128, col + 128, v11); } };
struct DMlaO { P p; int layer, j, nM; static constexpr int FENCE = 4; static constexpr int K = 1024, lda = 1024, ldb = 1024;
    HD bool unit(int L, Unit& u) const { int pm, pn;
        if (nM < 0) { if (L >= (NC / 256) * 4) return false; pm = NL / 256 + (L >> 2); pn = L & 3; }
        else if (!rect_unit(L, nM, 4, pm, pn)) return false;
        u.A = wsb(p, O_HN) + (size_t)pm * 256 * 1024; u.B = wsb(p, O_MWO + j * SZ_MWO) + (size_t)pn * 256 * 1024; u.a = pm; u.b = pn; u.c = 0; u.d = 0; return true; }
    HD void emit(const Unit& u, int r, int c, f32x4 v00, f32x4 v01, f32x4 v10, f32x4 v11) const {
        const int R = u.a * 256 + r, col = u.b * 256 + c;
        resid4(p, layer, 5, 1.0f, R, col, v00); resid4(p, layer, 5, 1.0f, R, col + 128, v01); resid4(p, layer, 5, 1.0f, R + 128, col, v10); resid4(p, layer, 5, 1.0f, R + 128, col + 128, v11); } };

HD int ret_tokrow(int q, int cidx) { const int b = q * RGB + cidx / NCH, n = cidx % NCH; return n == 0 ? NL + b * 256 : b * SEQ + (n - 1) * 256; }
HD float ret_logg(const P& p, int dir, int h) { return log1pf(-expf(p.in[18][dir * 4 + h])); }
struct DRetProj { P p; int q; static constexpr int FENCE = 1; static constexpr int K = 1024, lda = 1024, ldb = 1024;
    HD bool unit(int L, Unit& u) const { int pm, pn; if (!rect_unit(L, NCQ, 16, pm, pn)) return false;
        const int wrow = pn < 8 ? pn * 256 : 4096 + (pn - 8) * 256;
        u.A = wsb(p, O_HN) + (size_t)ret_tokrow(q, pm) * 1024; u.B = wsb(p, O_RWIN) + (size_t)wrow * 1024; u.a = pm; u.b = pn; u.c = 0; u.d = 0;
        u.f0 = ret_logg(p, 0, pn & 3) * 1.4426950408889634f; u.f1 = ret_logg(p, 1, pn & 3) * 1.4426950408889634f; return true; }
    HD void emit(const Unit& u, int r, int c, f32x4 v00, f32x4 v01, f32x4 v10, f32x4 v11) const {
        const int cidx = u.a, pn = u.b, n = cidx % NCH;
        if (pn >= 8) { u16* g = wsb(p, O_GATE) + ((size_t)cidx * 256 + r) * 2048 + (pn - 8) * 256 + c;
            st4bf(g, v00); st4bf(g + 128, v01); st4bf(g + (size_t)128 * 2048, v10); st4bf(g + (size_t)128 * 2048 + 128, v11); return; }
        const int h = pn & 3; const bool isq = pn < 4;
        const float lgf = u.f0, lgb = u.f1;
        for (int X = 0; X < 2; ++X) { const int i = r + 128 * X; const f32x4 x1 = X ? v10 : v00, x2 = X ? v11 : v01; f32x4 r1, r2;
            for (int jx = 0; jx < 4; ++jx) { float cs = 1.f, sn = 0.f;
                if (n > 0) sincos_t((float)((n - 1) * 256 + i) * ropef(c + jx, 128), sn, cs);
                r1[jx] = x1[jx] * cs - x2[jx] * sn; r2[jx] = x2[jx] * cs + x1[jx] * sn; }
            if (isq) { u16* qn = wsb(p, O_QN) + ((size_t)cidx * 256 + i) * 1024 + h * 256 + c; st4bf(qn, r1); st4bf(qn + 128, r2);
                const float df = ex2(lgf * (float)(i + 1)), db = ex2(lgb * (float)(256 - i));
                u16* ae = wsb(p, O_AEXT) + (((size_t)h * NCQ + cidx) * 256 + i) * 768;
                st4bf(ae + 256 + c, r1 * df); st4bf(ae + 384 + c, r2 * df); st4bf(ae + 512 + c, r1 * db); st4bf(ae + 640 + c, r2 * db); }
            else { u16* kn = wsb(p, O_KN) + ((size_t)cidx * 256 + i) * 1024 + h * 256 + c; st4bf(kn, r1 * 0.0625f); st4bf(kn + 128, r2 * 0.0625f); } } } };
struct DRetProjT { P p; int q; static constexpr int FENCE = 1; static constexpr int K = 1024, lda = 1024, ldb = 1024;
    HD bool unit(int L, Unit& u) const { int pm, pn; if (!rect_unit(L, 12, NCQ, pm, pn)) return false;
        u.A = wsb(p, O_RWIN) + (size_t)(1024 + pm * 256) * 1024; u.B = wsb(p, O_HN) + (size_t)ret_tokrow(q, pn) * 1024; u.a = pm; u.b = pn; u.c = 0; u.d = 0;
        u.f0 = ret_logg(p, 0, pm & 3) * 1.4426950408889634f; u.f1 = ret_logg(p, 1, pm & 3) * 1.4426950408889634f; return true; }
    HD void emit(const Unit& u, int r, int c, f32x4 v00, f32x4 v01, f32x4 v10, f32x4 v11) const {
        const int pm = u.a, cidx = u.b, n = cidx % NCH;
        if (pm >= 4) { const int h = (pm - 4) >> 1, e0 = ((pm - 4) & 1) * 256 + r; u16* be = wsb(p, O_BEXT) + (((size_t)h * NCQ + cidx) * 512 + e0) * 768 + c;
            st4bf(be, v00); st4bf(be + 128, v01); st4bf(be + (size_t)128 * 768, v10); st4bf(be + (size_t)128 * 768 + 128, v11); return; }
        const int h = pm; const float lgf = u.f0, lgb = u.f1, fr = ropef(r, 128);
        u16* kf = wsb(p, O_KTX) + (((size_t)h * NCQ + cidx) * 2 + 0) * 65536; u16* kb = kf + 65536;
        for (int Y = 0; Y < 2; ++Y) { const f32x4 x1 = Y ? v01 : v00, x2 = Y ? v11 : v10; f32x4 f1, f2, b1, b2;
            for (int jx = 0; jx < 4; ++jx) { const int jj = c + 128 * Y + jx; float cs = 1.f, sn = 0.f;
                if (n > 0) sincos_t((float)((n - 1) * 256 + jj) * fr, sn, cs);
                const float r1 = (x1[jx] * cs - x2[jx] * sn) * 0.0625f, r2 = (x2[jx] * cs + x1[jx] * sn) * 0.0625f;
                const float df = ex2(lgf * (float)(255 - jj)), db = ex2(lgb * (float)jj);
                f1[jx] = r1 * df; f2[jx] = r2 * df; b1[jx] = r1 * db; b2[jx] = r2 * db; }
            const int jc = c + 128 * Y;
            st4bf(kf + (size_t)r * 256 + jc, f1); st4bf(kf + (size_t)(r + 128) * 256 + jc, f2); st4bf(kb + (size_t)r * 256 + jc, b1); st4bf(kb + (size_t)(r + 128) * 256 + jc, b2); } } };
struct DRetProjAll { P p; int q; static constexpr int FENCE = 1; static constexpr int K = 1024, lda = 1024, ldb = 1024;
    HD bool unit(int L, Unit& u) const { const DRetProj a{p, q}; const DRetProjT b{p, q};
        if (L < NCQ * 16) { const bool ok = a.unit(L, u); u.d = 0; return ok; } const bool ok = b.unit(L - NCQ * 16, u); u.d = 1; return ok; }
    HD void emit(const Unit& u, int r, int c, f32x4 v00, f32x4 v01, f32x4 v10, f32x4 v11) const {
        if (u.d == 0) { const DRetProj a{p, q}; a.emit(u, r, c, v00, v01, v10, v11); } else { const DRetProjT b{p, q}; b.emit(u, r, c, v00, v01, v10, v11); } } };
struct DRetP { P p; static constexpr int FENCE = 1; static constexpr int K = 256, lda = 1024, ldb = 1024;
    HD bool unit(int L, Unit& u) const { int pm, pn; if (!rect_unit(L, NCQ, 4, pm, pn)) return false;
        u.A = wsb(p, O_QN) + (size_t)pm * 256 * 1024 + pn * 256; u.B = wsb(p, O_KN) + (size_t)pm * 256 * 1024 + pn * 256; u.a = pm; u.b = pn; u.c = 0; u.d = 0;
        u.f0 = ret_logg(p, 0, pn) * 1.4426950408889634f; u.f1 = ret_logg(p, 1, pn) * 1.4426950408889634f; return true; }
    HD void one(u16* ae, float lgf, float lgb, int i, int j0, f32x4 v) const { f32x4 o;
        for (int jx = 0; jx < 4; ++jx) { const int jj = j0 + jx; o[jx] = v[jx] * ex2(jj <= i ? lgf * (float)(i - jj) : lgb * (float)(jj - i)); }
        st4bf(ae + (size_t)i * 768 + j0, o); }
    HD void emit(const Unit& u, int r, int c, f32x4 v00, f32x4 v01, f32x4 v10, f32x4 v11) const {
        const int cidx = u.a, h = u.b; const float lgf = u.f0, lgb = u.f1;
        u16* ae = wsb(p, O_AEXT) + ((size_t)h * NCQ + cidx) * 256 * 768;
        one(ae, lgf, lgb, r, c, v00); one(ae, lgf, lgb, r, c + 128, v01); one(ae, lgf, lgb, r + 128, c, v10); one(ae, lgf, lgb, r + 128, c + 128, v11); } };
struct DRetL { P p; static constexpr int FENCE = 1; static constexpr int K = 256, lda = 768, ldb = 256;
    HD bool unit(int L, Unit& u) const { int pm, pn; if (!rect_unit(L, 4 * NCQ, 4, pm, pn)) return false;
        const int dir = pn >> 1, eh = pn & 1;
        u.A = wsb(p, O_BEXT) + ((size_t)pm * 512 + eh * 256) * 768; u.B = wsb(p, O_KTX) + ((size_t)pm * 2 + dir) * 65536; u.a = pm; u.b = dir; u.c = eh; u.d = 0; return true; }
    HD void emit(const Unit& u, int r, int c, f32x4 v00, f32x4 v01, f32x4 v10, f32x4 v11) const {
        u16* o = wsb(p, O_BEXT) + ((size_t)u.a * 512 + u.c * 256 + r) * 768 + 256 + u.b * 256 + c;
        st4bf(o, v00); st4bf(o + 128, v01); st4bf(o + (size_t)128 * 768, v10); st4bf(o + (size_t)128 * 768 + 128, v11); } };
struct DRetO { P p; static constexpr int FENCE = 1; static constexpr int K = 768, lda = 768, ldb = 768;
    HD bool unit(int L, Unit& u) const { int pm, pn; if (!rect_unit(L, 4 * NCQ, 2, pm, pn)) return false;
        u.A = wsb(p, O_AEXT) + (size_t)pm * 256 * 768; u.B = wsb(p, O_BEXT) + ((size_t)pm * 512 + pn * 256) * 768; u.a = pm; u.b = pn; u.c = 0; u.d = 0; return true; }
    HD void emit(const Unit& u, int r, int c, f32x4 v00, f32x4 v01, f32x4 v10, f32x4 v11) const {
        const int h = u.a / NCQ, cidx = u.a % NCQ;
        u16* o = wsb(p, O_OB) + ((size_t)cidx * 256 + r) * 2048 + h * 512 + u.b * 256 + c;
        st4bf(o, v00); st4bf(o + 128, v01); st4bf(o + (size_t)128 * 2048, v10); st4bf(o + (size_t)128 * 2048 + 128, v11); } };
struct DRetWoCtx { P p; int layer; static constexpr int FENCE = 4; static constexpr int K = 2048, lda = 2048, ldb = 2048;
    HD bool unit(int L, Unit& u) const { int pm, pn; if (!rect_unit(L, NC / 256, 4, pm, pn)) return false;
        u.A = wsb(p, O_YCTX) + (size_t)pm * 256 * 2048; u.B = wsb(p, O_RWO) + (size_t)pn * 256 * 2048; u.a = NL + pm * 256; u.b = pn; u.c = 0; u.d = 0; return true; }
    HD void emit(const Unit& u, int r, int c, f32x4 v00, f32x4 v01, f32x4 v10, f32x4 v11) const {
        const int R = u.a + r, col = u.b * 256 + c;
        resid4(p, layer, 5, 1.0f, R, col, v00); resid4(p, layer, 5, 1.0f, R, col + 128, v01); resid4(p, layer, 5, 1.0f, R + 128, col, v10); resid4(p, layer, 5, 1.0f, R + 128, col + 128, v11); } };
struct DRetWo { P p; int layer, q; static constexpr int FENCE = 4; static constexpr int K = 2048, lda = 2048, ldb = 2048;
    HD bool unit(int L, Unit& u) const { int pl, pn; if (!rect_unit(L, NCQ - RGB, 4, pl, pn)) return false; const int pm = pl + pl / (NCH - 1) + 1;
        u.A = wsb(p, O_OB) + (size_t)pm * 256 * 2048; u.B = wsb(p, O_RWO) + (size_t)pn * 256 * 2048; u.a = ret_tokrow(q, pm); u.b = pn; u.c = 0; u.d = 0; return true; }
    HD void emit(const Unit& u, int r, int c, f32x4 v00, f32x4 v01, f32x4 v10, f32x4 v11) const {
        const int R = u.a + r, col = u.b * 256 + c;
        resid4(p, layer, 5, 1.0f, R, col, v00); resid4(p, layer, 5, 1.0f, R, col + 128, v01); resid4(p, layer, 5, 1.0f, R + 128, col, v10); resid4(p, layer, 5, 1.0f, R + 128, col + 128, v11); } };

struct DS5L { P p; static constexpr int FENCE = 1; static constexpr int K = 512, lda = 768, ldb = 512;
    HD bool unit(int L, Unit& u) const { int pm, pn; if (!rect_unit(L, NROW5P / 256, 64, pm, pn)) return false;
        u.A = wsb(p, O_UEXT) + ((size_t)pn * NROW5P + pm * 256) * 768; u.B = wsb(p, O_FEXT) + (size_t)pn * 256 * 512; u.a = pm; u.b = pn; u.c = 0; u.d = 0; return true; }
    HD void emit(const Unit& u, int r, int c, f32x4 v00, f32x4 v01, f32x4 v10, f32x4 v11) const {
        u16* o = wsb(p, O_UEXT) + ((size_t)u.b * NROW5P + u.a * 256 + r) * 768 + 512 + c;
        st4bf(o, v00); st4bf(o + 128, v01); st4bf(o + (size_t)128 * 768, v10); st4bf(o + (size_t)128 * 768 + 128, v11); } };
struct DS5Y { P p; static constexpr int FENCE = 1; static constexpr int K = 768, lda = 768, ldb = 768;
    HD bool unit(int L, Unit& u) const { int pm, pn; if (!rect_unit(L, NROW5P / 256, 128, pm, pn)) return false;
        const int g = pn >> 1, ch = pn & 1;
        u.A = wsb(p, O_UEXT) + ((size_t)g * NROW5P + pm * 256) * 768; u.B = wsb(p, O_TEXT) + ((size_t)g * 512 + ch * 256) * 768; u.a = pm; u.b = g; u.c = ch; u.d = 0; return true; }
    HD void one(int g, int row, int col, f32x4 v) const {
        int tok; if (row < NB * S5L) tok = (row / S5L) * SEQ + (row % S5L) * 32; else if (row < NROW5) { const int rr = row - NB * S5L; tok = NL + (rr / S5C) * 256 + (rr % S5C) * 32; } else return;
        f32x4 o; for (int jx = 0; jx < 4; ++jx) o[jx] = gelu_f(v[jx]);
        st4bf(wsb(p, O_HN) + (size_t)(tok + (col >> 4)) * 1024 + g * 16 + (col & 15), o); }
    HD void emit(const Unit& u, int r, int c, f32x4 v00, f32x4 v01, f32x4 v10, f32x4 v11) const {
        const int row = u.a * 256 + r, col = u.c * 256 + c;
        one(u.b, row, col, v00); one(u.b, row, col + 128, v01); one(u.b, row + 128, col, v10); one(u.b, row + 128, col + 128, v11); } };
struct DS5Glu { P p; int layer; static constexpr int FENCE = 4; static constexpr int K = 1024, lda = 1024, ldb = 1024;
    HD bool unit(int L, Unit& u) const { int pm, pn; if (!rect_unit(L, MT / 256, 8, pm, pn)) return false;
        u.A = wsb(p, O_HN) + (size_t)pm * 256 * 1024; u.B = wsb(p, O_GLU) + (size_t)pn * 256 * 1024; u.a = pm; u.b = pn; u.c = 0; u.d = 0; return true; }
    HD void emit(const Unit& u, int r, int c, f32x4 v00, f32x4 v01, f32x4 v10, f32x4 v11) const {
        const int col = u.b * 128 + c; const float* gb = p.in[30]; f32x4 y0, y1;
        for (int jx = 0; jx < 4; ++jx) { const float ba = gb[col + jx], bg = gb[1024 + col + jx];
            y0[jx] = (v00[jx] + ba) * sigm_f(v01[jx] + bg); y1[jx] = (v10[jx] + ba) * sigm_f(v11[jx] + bg); }
        resid4(p, layer, 5, 1.0f, u.a * 256 + r, col, y0); resid4(p, layer, 5, 1.0f, u.a * 256 + r + 128, col, y1); } };

HD void cvt64(const float* src, int N, int srccol, u16* dst, int Kd, int nrow, int k0) {
    float v[64];
#pragma unroll
    for (int j = 0; j < 64; ++j) v[j] = srccol >= 0 ? src[(size_t)(k0 + j) * N + srccol] : 0.f;
#pragma unroll
    for (int j = 0; j < 64; j += 4) { f32x4 a; a[0] = v[j]; a[1] = v[j + 1]; a[2] = v[j + 2]; a[3] = v[j + 3]; st4bf(dst + (size_t)nrow * Kd + k0 + j, a); } }
constexpr long CV_FFI = (long)8 * 5632 * 16, CV_FFO = (long)8 * 1024 * 44, CV_MWIN = (long)2 * 768 * 16, CV_MWUQ = (long)2 * 1536 * 6, CV_MWUKV = (long)2 * 2048 * 4,
               CV_MWO = (long)2 * 1024 * 16, CV_RWIN = (long)6144 * 16, CV_RWO = (long)1024 * 32, CV_GLU = (long)2048 * 16;
constexpr long CV_TOTAL = CV_FFI + CV_FFO + CV_MWIN + CV_MWUQ + CV_MWUKV + CV_MWO + CV_RWIN + CV_RWO + CV_GLU;
HD void cvt_item(const P& p, long idx) {
    if (idx < CV_FFI) { const int n = (int)(idx % 5632); const long t = idx / 5632; const int kb = (int)(t % 16), m = (int)(t / 16);
        const int tile = n >> 8, rr = n & 255; const int sc = rr < 128 ? tile * 128 + rr : 2816 + tile * 128 + (rr - 128);
        cvt64(p.in[7] + (size_t)m * 1024 * 5632, 5632, sc, wsb(p, O_FFI + (size_t)m * SZ_FFI1), 1024, n, kb * 64); return; }
    idx -= CV_FFI;
    if (idx < CV_FFO) { const int n = (int)(idx % 1024); const long t = idx / 1024; const int kb = (int)(t % 44), m = (int)(t / 44);
        cvt64(p.in[8] + (size_t)m * 2816 * 1024, 1024, n, wsb(p, O_FFO + (size_t)m * SZ_FFO1), 2816, n, kb * 64); return; }
    idx -= CV_FFO;
    if (idx < CV_MWIN) { const int n = (int)(idx % 768); const long t = idx / 768; const int kb = (int)(t % 16), m = (int)(t / 16);
        cvt64(p.in[9] + (size_t)m * 1024 * 704, 704, n < 704 ? n : -1, wsb(p, O_MWIN + (size_t)m * SZ_MWIN), 1024, n, kb * 64); return; }
    idx -= CV_MWIN;
    if (idx < CV_MWUQ) { const int n = (int)(idx % 1536); const long t = idx / 1536; const int kb = (int)(t % 6), m = (int)(t / 6);
        cvt64(p.in[12] + (size_t)m * 384 * 1536, 1536, n, wsb(p, O_MWUQ + (size_t)m * SZ_MWUQ), 384, n, kb * 64); return; }
    idx -= CV_MWUQ;
    if (idx < CV_MWUKV) { const int n = (int)(idx % 2048); const long t = idx / 2048; const int kb = (int)(t % 4), m = (int)(t / 4);
        const int sc = n < 1024 ? (n >> 7) * 256 + (n & 127) : ((n - 1024) >> 7) * 256 + 128 + (n & 127);
        cvt64(p.in[13] + (size_t)m * 256 * 2048, 2048, sc, wsb(p, O_MWUKV + (size_t)m * SZ_MWUKV), 256, n, kb * 64); return; }
    idx -= CV_MWUKV;
    if (idx < CV_MWO) { const int n = (int)(idx % 1024); const long t = idx / 1024; const int kb = (int)(t % 16), m = (int)(t / 16);
        cvt64(p.in[16] + (size_t)m * 1024 * 1024, 1024, n, wsb(p, O_MWO + (size_t)m * SZ_MWO), 1024, n, kb * 64); return; }
    idx -= CV_MWO;
    if (idx < CV_RWIN) { const int n = (int)(idx % 6144), kb = (int)(idx / 6144); cvt64(p.in[17], 6144, n, wsb(p, O_RWIN), 1024, n, kb * 64); return; }
    idx -= CV_RWIN;
    if (idx < CV_RWO) { const int n = (int)(idx % 1024), kb = (int)(idx / 1024); cvt64(p.in[20], 1024, n, wsb(p, O_RWO), 2048, n, kb * 64); return; }
    idx -= CV_RWO;
    { const int n = (int)(idx % 2048), kb = (int)(idx / 2048); const int tile = n >> 8, rr = n & 255; const int sc = rr < 128 ? tile * 128 + rr : 1024 + tile * 128 + (rr - 128);
      cvt64(p.in[29], 2048, sc, wsb(p, O_GLU), 1024, n, kb * 64); }
}
HD void mod_item(const P& p, int idx) {
    const int layer = idx / 9216, col = idx % 9216; const float* w = p.in[4] + (size_t)layer * 1024 * 9216 + col; float acc[NMR];
    for (int b = 0; b < NMR; ++b) acc[b] = 0.f;
    for (int k = 0; k < 1024; ++k) { const float wv = w[(size_t)k * 9216];
#pragma unroll
        for (int b = 0; b < NMR; ++b) { const float cv = b < NB ? p.in[1][b * 1024 + k] : p.in[3][k]; acc[b] += silu_f(cv) * wv; } }
    const float bias = p.in[5][layer * 9216 + col];
#pragma unroll
    for (int b = 0; b < NMR; ++b) ((float*)(p.ws + O_MOD))[(size_t)(layer * NMR + b) * 9216 + col] = acc[b] + bias; }
HD void copy_item(const P& p, long idx) {
    const long nl4 = (long)NL * 256;
    if (idx < nl4) ((f32x4*)p.out)[idx] = ((const f32x4*)p.in[0])[idx]; else ((f32x4*)(p.ws + O_G))[idx - nl4] = ((const f32x4*)p.in[2])[idx - nl4]; }
HD void norm_item(const P& p, int layer, int k, int r, int s5) {
    const float* x = hsrc(p, r, layer == 0 && k == 0); float ss = 0.f;
    for (int d = 0; d < 1024; d += 4) { const f32x4 v = *(const f32x4*)(x + d); ss += v[0] * v[0] + v[1] * v[1] + v[2] * v[2] + v[3] * v[3]; }
    const float rinv = rsq_f(ss * (1.0f / 1024.0f) + EPS);
    const float* g = p.in[6] + (size_t)(layer * 3 + k) * 1024; const float* sh = modp(p, layer, r, 3 * k); const float* sc = modp(p, layer, r, 3 * k + 1);
    int row5 = 0, i5 = 0;
    if (s5) { if (r < NL) { const int b = r / SEQ, t = r % SEQ; row5 = b * S5L + t / 32; i5 = t % 32; } else { const int rr = r - NL; const int b = rr / 256, l = rr % 256; row5 = NB * S5L + b * S5C + l / 32; i5 = l % 32; } }
    for (int d = 0; d < 1024; d += 4) { const f32x4 v = *(const f32x4*)(x + d); f32x4 o;
        for (int j = 0; j < 4; ++j) o[j] = v[j] * rinv * g[d + j] * (1.0f + sc[d + j]) + sh[d + j];
        if (!s5) st4bf(wsb(p, O_HN) + (size_t)r * 1024 + d, o);
        else st4bf(wsb(p, O_UEXT) + ((size_t)(d >> 4) * NROW5P + row5) * 768 + i5 * 16 + (d & 15), o); } }
HD void axial_rot64(float* v, int t) {
    const int prow = t / 64, pcol = t % 64;
    for (int f = 0; f < 16; ++f) { const float fq = ropef(f, 16);
        { float cs, sn; sincos_t((float)prow * fq, sn, cs); const float x1 = v[f], x2 = v[16 + f]; v[f] = x1 * cs - x2 * sn; v[16 + f] = x2 * cs + x1 * sn; }
        { float cs, sn; sincos_t((float)pcol * fq, sn, cs); const float x1 = v[32 + f], x2 = v[48 + f]; v[32 + f] = x1 * cs - x2 * sn; v[48 + f] = x2 * cs + x1 * sn; } } }
HD void mla_row_item(const P& p, int j, int r) {
    const float* x = (const float*)(p.ws + O_CALL) + (size_t)r * 768; float ss = 0.f;
    for (int d = 0; d < 384; ++d) ss += x[d] * x[d];
    float rinv = rsq_f(ss * (1.0f / 384.0f) + EPS); const float* qn = p.in[10] + j * 384;
    for (int d = 0; d < 384; d += 4) { f32x4 o; for (int jx = 0; jx < 4; ++jx) o[jx] = x[d + jx] * rinv * qn[d + jx]; st4bf(wsb(p, O_CQN) + (size_t)r * 384 + d, o); }
    ss = 0.f; for (int d = 0; d < 256; ++d) ss += x[384 + d] * x[384 + d];
    rinv = rsq_f(ss * (1.0f / 256.0f) + EPS); const float* kvn = p.in[11] + j * 256;
    for (int d = 0; d < 256; d += 4) { f32x4 o; for (int jx = 0; jx < 4; ++jx) o[jx] = x[384 + d + jx] * rinv * kvn[d + jx]; st4bf(wsb(p, O_CKVN) + (size_t)r * 256 + d, o); }
    ss = 0.f; for (int d = 0; d < 64; ++d) ss += x[640 + d] * x[640 + d];
    rinv = rsq_f(ss * (1.0f / 64.0f) + EPS); const float* kg = p.in[15] + j * 192 + 128;
#ifdef HOST_EMU
    float kr[64];
    for (int d = 0; d < 64; ++d) kr[d] = x[640 + d] * rinv * kg[d];
    if (r < NL) axial_rot64(kr, r % SEQ);
    for (int h = 0; h < 8; ++h) for (int d = 0; d < 64; ++d) wsb(p, O_KF)[(size_t)r * 1536 + h * 192 + 128 + d] = f2bf(kr[d]);
#else
    const int t = r % SEQ, prow = t / 64, pcol = t % 64;
    for (int f = 0; f < 16; ++f) { const float fq = ropef(f, 16);
#pragma unroll
        for (int part = 0; part < 2; ++part) { float cs = 1.f, sn = 0.f; if (r < NL) sincos_t((float)(part ? pcol : prow) * fq, sn, cs);
            const int d1 = part * 32 + f, d2 = d1 + 16; const float x1 = x[640 + d1] * rinv * kg[d1], x2 = x[640 + d2] * rinv * kg[d2];
            const u16 o1 = f2bf(x1 * cs - x2 * sn), o2 = f2bf(x2 * cs + x1 * sn);
            for (int h = 0; h < 8; ++h) { wsb(p, O_KF)[(size_t)r * 1536 + h * 192 + 128 + d1] = o1; wsb(p, O_KF)[(size_t)r * 1536 + h * 192 + 128 + d2] = o2; } } }
#endif
}
HD void mla_head_item(const P& p, int j, int idx) {
    const int r = idx >> 3, h = idx & 7;
    u16* q = wsb(p, O_CALL) + (size_t)r * 1536 + h * 192; const float* qg = p.in[14] + j * 192; float ss = 0.f;
    for (int d = 0; d < 128; ++d) { const float v = bf2f(q[d]); ss += v * v; }
    float rinv = rsq_f(ss * (1.0f / 128.0f) + EPS);
    for (int d = 0; d < 128; ++d) q[d] = f2bf(bf2f(q[d]) * rinv * qg[d] * QSCALE);
    ss = 0.f; for (int d = 0; d < 64; ++d) { const float v = bf2f(q[128 + d]); ss += v * v; }
    rinv = rsq_f(ss * (1.0f / 64.0f) + EPS);
    { const int t = r % SEQ, prow = t / 64, pcol = t % 64;
      for (int f = 0; f < 16; ++f) { const float fq = ropef(f, 16);
#pragma unroll
        for (int part = 0; part < 2; ++part) { float cs = 1.f, sn = 0.f; if (r < NL) sincos_t((float)(part ? pcol : prow) * fq, sn, cs);
            const int d1 = 128 + part * 32 + f, d2 = d1 + 16; const float x1 = bf2f(q[d1]) * rinv * qg[d1], x2 = bf2f(q[d2]) * rinv * qg[d2];
            q[d1] = f2bf((x1 * cs - x2 * sn) * QSCALE); q[d2] = f2bf((x2 * cs + x1 * sn) * QSCALE); } } }
    u16* k = wsb(p, O_KF) + (size_t)r * 1536 + h * 192; const float* kg = p.in[15] + j * 192;
    ss = 0.f; for (int d = 0; d < 128; ++d) { const float v = bf2f(k[d]); ss += v * v; }
    rinv = rsq_f(ss * (1.0f / 128.0f) + EPS);
    for (int d = 0; d < 128; ++d) k[d] = f2bf(bf2f(k[d]) * rinv * kg[d]);
}
HD void ret_prefix_item(const P& p, int idx) {
    const int d4 = idx & 63, e = (idx >> 6) & 511, bq = (idx >> 15) % RGB, h = (idx >> 15) / RGB;
    const float gf = expf(256.f * ret_logg(p, 0, h)), gb = expf(256.f * ret_logg(p, 1, h));
    u16* base = wsb(p, O_BEXT) + (((size_t)h * NCQ + bq * NCH) * 512 + e) * 768 + d4 * 4; constexpr size_t CS = (size_t)512 * 768;
    u32x2 tf[NCH], tb[NCH];
#pragma unroll
    for (int n = 0; n < NCH; ++n) { tf[n] = *(const u32x2*)(base + n * CS + 256); tb[n] = *(const u32x2*)(base + n * CS + 512); }
    f32x4 cf = {0.f, 0.f, 0.f, 0.f}, cb = {0.f, 0.f, 0.f, 0.f};
#pragma unroll
    for (int n = 0; n < NCH; ++n) { f32x4 t; t[0] = bf2f((u16)(tf[n].x & 0xffff)); t[1] = bf2f((u16)(tf[n].x >> 16)); t[2] = bf2f((u16)(tf[n].y & 0xffff)); t[3] = bf2f((u16)(tf[n].y >> 16));
        st4bf(base + n * CS + 256, cf); cf = cf * gf + t; }
#pragma unroll
    for (int s_ = 0; s_ < NCH; ++s_) { const int n = s_ == 0 ? 0 : NCH - s_; f32x4 t; t[0] = bf2f((u16)(tb[n].x & 0xffff)); t[1] = bf2f((u16)(tb[n].x >> 16)); t[2] = bf2f((u16)(tb[n].y & 0xffff)); t[3] = bf2f((u16)(tb[n].y >> 16));
        st4bf(base + n * CS + 512, cb); cb = cb * gb + t; } }
HD u16* ret_ydst(const P& p, int q, int lr) { const int cidx = lr >> 8, n = cidx % NCH; return n == 0 ? wsb(p, O_YCTX) + ((size_t)((q * RGB + cidx / NCH) * 256 + (lr & 255))) * 2048 : wsb(p, O_OB) + (size_t)lr * 2048; }
HD void ret_norm_item(const P& p, int qg, int idx) {
    const int lr = idx >> 2, h = idx & 3; u16* o = wsb(p, O_OB) + (size_t)lr * 2048 + h * 512; u16* yd = ret_ydst(p, qg, lr) + h * 512; const u16* g = wsb(p, O_GATE) + (size_t)lr * 2048 + h * 512; const float* gg = p.in[19] + h * 512;
    float s = 0.f; for (int e = 0; e < 512; ++e) s += bf2f(o[e]);
    const float mu = s * (1.0f / 512.0f); float q = 0.f; for (int e = 0; e < 512; ++e) { const float d = bf2f(o[e]) - mu; q += d * d; }
    const float rstd = rsq_f(q * (1.0f / 512.0f) + EPS);
    for (int e = 0; e < 512; ++e) yd[e] = f2bf((bf2f(o[e]) - mu) * rstd * gg[e] * silu_f(bf2f(g[e]))); }
struct Cx { float re, im; };
HD Cx cmul(Cx a, Cx b) { Cx r; r.re = a.re * b.re - a.im * b.im; r.im = a.re * b.im + a.im * b.re; return r; }
HD Cx s5_alog(const P& p, int dir, int g, int pp) { const float dt = expf(p.in[23][dir * 64 + g]); Cx r; r.re = p.in[21][(dir * 64 + g) * 64 + pp] * dt; r.im = p.in[22][(dir * 64 + g) * 64 + pp] * dt; return r; }
HD Cx cpowa(Cx al, float n) { const float m = expf(al.re * n); float sn, cs; sincos_t(al.im * n * 0.15915494309189535f, sn, cs); Cx r; r.re = m * cs; r.im = m * sn; return r; }
HD Cx s5_coef(const P& p, int dir, int g, int pp) {
    const Cx al = s5_alog(p, dir, g, pp); Cx a = cpowa(al, 1.f); a.re -= 1.f; const float lr = p.in[21][(dir * 64 + g) * 64 + pp], li = p.in[22][(dir * 64 + g) * 64 + pp], den = 1.0f / (lr * lr + li * li);
    Cx r; r.re = (a.re * lr + a.im * li) * den; r.im = (a.im * lr - a.re * li) * den; return r; }
HD Cx s5_bbar(const P& p, int dir, int g, int pp, int m) { Cx b; const size_t o = (((size_t)dir * 64 + g) * 64 + pp) * 16 + m; b.re = p.in[24][o]; b.im = p.in[25][o]; return cmul(s5_coef(p, dir, g, pp), b); }
HD Cx s5_c(const P& p, int dir, int g, int m, int pp) { Cx c; const size_t o = (((size_t)dir * 64 + g) * 16 + m) * 64 + pp; c.re = p.in[26][o]; c.im = p.in[27][o]; return c; }
HD void s5_ktab_item(const P& p, int idx) {
    const int m = idx & 15, tau = (idx >> 4) & 31, dir = (idx >> 9) & 1, g = idx >> 10; float acc[16];
#pragma unroll
    for (int m2 = 0; m2 < 16; ++m2) acc[m2] = 0.f;
    for (int pp = 0; pp < 64; ++pp) { const Cx w = cmul(cmul(s5_c(p, dir, g, m, pp), cpowa(s5_alog(p, dir, g, pp), (float)tau)), s5_coef(p, dir, g, pp));
        const size_t o = (((size_t)dir * 64 + g) * 64 + pp) * 16;
#pragma unroll
        for (int m2 = 0; m2 < 16; ++m2) acc[m2] += w.re * p.in[24][o + m2] - w.im * p.in[25][o + m2]; }
#pragma unroll
    for (int m2 = 0; m2 < 16; ++m2) ((float*)(p.ws + O_KTAB))[(size_t)idx * 16 + m2] = acc[m2]; }
HD void s5_text_item(const P& p, long idx) {
    const int col = (int)(idx % 768); const long t = idx / 768; const int row = (int)(t % 512), g = (int)(t / 512), i = row >> 4, m = row & 15; float v;
    const float* kt = (const float*)(p.ws + O_KTAB);
    if (col < 512) { const int jj = col >> 4, m2 = col & 15; v = 0.f;
        if (jj <= i) v += kt[((((size_t)g * 2 + 0) * 32 + (i - jj)) * 16 + m) * 16 + m2];
        if (jj >= i) v += kt[((((size_t)g * 2 + 1) * 32 + (jj - i)) * 16 + m) * 16 + m2];
        if (jj == i && m == m2) v += p.in[28][g * 16 + m]; }
    else { const int dir = col >= 640, pp = ((col - 512) & 127) >> 1, part = col & 1;
        const Cx w = cmul(s5_c(p, dir, g, m, pp), cpowa(s5_alog(p, dir, g, pp), dir ? (float)(32 - i) : (float)(i + 1))); v = part ? -w.im : w.re; }
    wsb(p, O_TEXT)[idx] = f2bf(v); }
HD void s5_fext_item(const P& p, int idx) {
    const int col = idx & 511, row = (idx >> 9) & 255, g = idx >> 17, jj = col >> 4, m2 = col & 15, dir = row >> 7, pp = (row & 127) >> 1, part = row & 1;
    const Cx w = cmul(cpowa(s5_alog(p, dir, g, pp), dir ? (float)jj : (float)(31 - jj)), s5_bbar(p, dir, g, pp, m2));
    wsb(p, O_FEXT)[idx] = f2bf(part ? w.im : w.re); }
HD int s5_row(int b, int s) { return s < S5C ? NB * S5L + b * S5C + s : b * S5L + (s - S5C); }
HD void s5_prefix_item(const P& p, int idx) {
    const int pp = idx & 63, b = (idx >> 6) % NB, g = (idx >> 6) / NB;
    const Cx af = cpowa(s5_alog(p, 0, g, pp), 32.f), ab = cpowa(s5_alog(p, 1, g, pp), 32.f);
    u16* base = wsb(p, O_UEXT) + (size_t)g * NROW5P * 768; Cx c; c.re = 0.f; c.im = 0.f;
    for (int s0 = 0; s0 < S5C + S5L; s0 += 8) { unsigned t[8];
#pragma unroll
        for (int k = 0; k < 8; ++k) t[k] = *(const unsigned*)(base + (size_t)s5_row(b, s0 + k) * 768 + 512 + 2 * pp);
#pragma unroll
        for (int k = 0; k < 8; ++k) { u16* q = base + (size_t)s5_row(b, s0 + k) * 768 + 512 + 2 * pp; *(unsigned*)q = (unsigned)f2bf(c.re) | ((unsigned)f2bf(c.im) << 16);
            c = cmul(af, c); c.re += bf2f((u16)(t[k] & 0xffff)); c.im += bf2f((u16)(t[k] >> 16)); } }
    c.re = 0.f; c.im = 0.f;
    for (int s0 = 0; s0 < S5C + S5L; s0 += 8) { unsigned t[8]; int sv[8];
#pragma unroll
        for (int k = 0; k < 8; ++k) { const int s_ = s0 + k; sv[k] = s_ < S5C ? S5C - 1 - s_ : S5C + S5L - 1 - (s_ - S5C); t[k] = *(const unsigned*)(base + (size_t)s5_row(b, sv[k]) * 768 + 640 + 2 * pp); }
#pragma unroll
        for (int k = 0; k < 8; ++k) { u16* q = base + (size_t)s5_row(b, sv[k]) * 768 + 640 + 2 * pp; *(unsigned*)q = (unsigned)f2bf(c.re) | ((unsigned)f2bf(c.im) << 16);
            c = cmul(ab, c); c.re += bf2f((u16)(t[k] & 0xffff)); c.im += bf2f((u16)(t[k] >> 16)); } } }

struct AttItem { const u16* q; const u16* k0; const u16* k1; const u16* v0; const u16* v1; u16* o; int n0, ntot; };
HD void att_item(const P& p, int it, AttItem& a) {
    const u16* Q = wsb(p, O_CALL); const u16* KF = wsb(p, O_KF); const u16* VB = wsb(p, O_VB); u16* O = wsb(p, O_HN);
    const int nlat = NB * 8 * (SEQ / 256);
    if (it < nlat) { int itx = it;
        if (SEQ / 256 == 16 && nlat % 256 == 0) { const int i_ = it >> 8, c_ = it & 255, x_ = c_ & 7, s_ = c_ >> 3; itx = ((i_ * 16 + 2 * x_ + (s_ >> 4)) << 4) | (s_ & 15); }
        const int qb = itx % (SEQ / 256), h = (itx / (SEQ / 256)) & 7, b = itx / (SEQ / 256) / 8; const size_t r0 = (size_t)b * SEQ + qb * 256, c0 = (size_t)NL + b * 256, l0 = (size_t)b * SEQ;
        a.q = Q + r0 * 1536 + h * 192; a.o = O + r0 * 1024 + h * 128; a.k0 = KF + c0 * 1536 + h * 192; a.v0 = VB + c0 * 1024 + h * 128; a.k1 = KF + l0 * 1536 + h * 192; a.v1 = VB + l0 * 1024 + h * 128; a.n0 = 256; a.ntot = 256 + SEQ; }
    else { const int x = it - nlat, h = x & 7, b = x >> 3; const size_t c0 = (size_t)NL + b * 256;
        a.q = Q + c0 * 1536 + h * 192; a.o = O + c0 * 1024 + h * 128; a.k0 = KF + c0 * 1536 + h * 192; a.v0 = VB + c0 * 1024 + h * 128; a.k1 = a.k0; a.v1 = a.v0; a.n0 = 256; a.ntot = 256; } }

#ifndef HOST_EMU
#define LAS __attribute__((address_space(3)))
typedef short bf16x8 __attribute__((ext_vector_type(8)));
typedef short s16x4 __attribute__((ext_vector_type(4)));
typedef float f32x16 __attribute__((ext_vector_type(16)));
typedef unsigned u32x4 __attribute__((ext_vector_type(4)));
constexpr int HTB = 128 * 64 * 2, STAGE_BYTES = 8 * HTB;
__device__ __forceinline__ int lds_byte(int r, int c) { const int st = (r >> 4) * 2 + (c >> 5), rr = r & 15, cc = c & 31, ob = rr * 64 + cc * 2; return st * 1024 + (ob ^ (((ob >> 9) & 1) << 5)); }
__device__ __forceinline__ void stage_rc(int b, int& R, int& C) { const int st = b / 1024, sb = b % 1024, swz = sb ^ (((sb >> 9) & 1) << 5); R = (st >> 1) * 16 + swz / 64; C = (st & 1) * 32 + (swz % 64) / 2; }

template <class Dsc>
__device__ __forceinline__ void gemm_run(LAS unsigned char* lds, const Dsc& D) {
    int tid_ = threadIdx.x; asm volatile("" : "+v"(tid_));
    const int tid = tid_, wid = __builtin_amdgcn_readfirstlane(tid >> 6), lane = tid & 63, wr = wid >> 2, wc = wid & 3, fr = lane & 15, fq = lane >> 4;
    constexpr int K = Dsc::K, nt = K / 64, lda = Dsc::lda, ldb = Dsc::ldb;
    static_assert(K % 128 == 0 && K >= 256, "K");
    unsigned voffA[2], voffB[2];
#pragma unroll
    for (int i = 0; i < 2; ++i) { int R, C; stage_rc(tid * 16 + i * 8192, R, C); voffA[i] = (unsigned)(R * lda + C) * 2u; voffB[i] = (unsigned)(R * ldb + C) * 2u; }
    constexpr size_t kstep = 128, hstepA = (size_t)128 * lda * 2, hstepB = (size_t)128 * ldb * 2;
    const unsigned ldsw = (unsigned)wid * 1024u;
    const int aoff = lds_byte(wr * 64 + fr, fq * 8), boff = lds_byte(wc * 32 + fr, fq * 8);
#define G_SA(b, h) (((b) * 2 + (h)) * HTB)
#define G_SB(b, h) ((4 + (b) * 2 + (h)) * HTB)
#define G_STAGE(bufoff, gbase, voff) do { _Pragma("unroll") for (int _i = 0; _i < 2; ++_i) \
        __builtin_amdgcn_global_load_lds((const unsigned*)((const char*)(gbase) + (voff)[_i]), (LAS unsigned*)(lds + (bufoff) + ldsw + _i * 8192), 16, 0, 0); } while (0)
#define G_LDA(dst, b, h) do { _Pragma("unroll") for (int m = 0; m < 4; ++m) _Pragma("unroll") for (int k = 0; k < 2; ++k) dst[m][k] = *(const LAS bf16x8*)(lds + G_SA(b, h) + aoff + m * 2048 + k * 1024); } while (0)
#define G_LDB(dst, b, h) do { _Pragma("unroll") for (int n = 0; n < 2; ++n) _Pragma("unroll") for (int k = 0; k < 2; ++k) dst[n][k] = *(const LAS bf16x8*)(lds + G_SB(b, h) + boff + n * 2048 + k * 1024); } while (0)
#define G_MMA(ai, bj, At, Bt) do { __builtin_amdgcn_s_setprio(1); _Pragma("unroll") for (int m = 0; m < 4; ++m) _Pragma("unroll") for (int n = 0; n < 2; ++n) _Pragma("unroll") for (int k = 0; k < 2; ++k) \
        acc[ai][bj][m][n] = __builtin_amdgcn_mfma_f32_16x16x32_bf16(Bt[n][k], At[m][k], acc[ai][bj][m][n], 0, 0, 0); __builtin_amdgcn_s_setprio(0); } while (0)
#define G_WAIT_V(n) asm volatile("s_waitcnt vmcnt(" #n ")" ::: "memory")
#define G_WAIT_L(n) asm volatile("s_waitcnt lgkmcnt(" #n ")" ::: "memory")
#define G_BAR __builtin_amdgcn_s_barrier()
#define G_SCHED __builtin_amdgcn_sched_barrier(0)
    Unit cur{}, nxt{}; int ui = 0; const int G = gridDim.x, cb = blockIdx.x;
    if (!D.unit(cb, cur)) return;
    f32x4 acc[2][2][4][2];
#pragma unroll
    for (int a = 0; a < 2; ++a)
#pragma unroll
        for (int b = 0; b < 2; ++b)
#pragma unroll
            for (int m = 0; m < 4; ++m)
#pragma unroll
                for (int n = 0; n < 2; ++n) acc[a][b][m][n] = (f32x4){0.f, 0.f, 0.f, 0.f};
    bf16x8 At[4][2], B0[2][2], B1[2][2];
    const char* cA = (const char*)cur.A; const char* cB = (const char*)cur.B;
    G_STAGE(G_SB(0, 0), cB, voffB); G_STAGE(G_SA(0, 0), cA, voffA); G_STAGE(G_SB(0, 1), cB + hstepB, voffB); G_STAGE(G_SA(0, 1), cA + hstepA, voffA);
    if (wr == 1) G_BAR;
    G_WAIT_V(4); G_BAR;
    G_STAGE(G_SB(1, 0), cB + kstep, voffB); G_STAGE(G_SA(1, 0), cA + kstep, voffA); G_STAGE(G_SB(1, 1), cB + hstepB + kstep, voffB);
    G_WAIT_V(6); G_BAR;
    for (;;) {
        const bool has_next = D.unit((ui + 1) * G + cb, nxt);
        const char* nA = has_next ? (const char*)nxt.A : cA; const char* nB = has_next ? (const char*)nxt.B : cB;
        _Pragma("nounroll") for (int t = 0; t < nt; t += 2) {
            const bool last = (t == nt - 2);
            const char* a1 = cA + (size_t)(t + 1) * kstep;
            const char* a2 = last ? nA : cA + (size_t)(t + 2) * kstep; const char* b2 = last ? nB : cB + (size_t)(t + 2) * kstep;
            const char* a3 = a2 + kstep; const char* b3 = b2 + kstep;
            G_LDB(B0, 0, 0); G_SCHED; G_LDA(At, 0, 0); G_STAGE(G_SA(1, 1), a1 + hstepA, voffA);
            G_WAIT_L(8); G_BAR; G_WAIT_L(0); G_MMA(0, 0, At, B0); G_BAR; G_SCHED;
            G_LDB(B1, 0, 1); G_STAGE(G_SB(0, 0), b2, voffB);
            G_BAR; G_WAIT_L(0); G_MMA(0, 1, At, B1); G_BAR;
            G_LDA(At, 0, 1); G_STAGE(G_SA(0, 0), a2, voffA);
            G_BAR; G_WAIT_L(0); G_MMA(1, 0, At, B0); G_BAR; G_SCHED;
            G_STAGE(G_SB(0, 1), b2 + hstepB, voffB);
            G_WAIT_V(6); G_BAR; G_MMA(1, 1, At, B1); G_BAR;
            G_LDB(B0, 1, 0); G_SCHED; G_LDA(At, 1, 0); G_STAGE(G_SA(0, 1), a2 + hstepA, voffA);
            G_WAIT_L(8); G_BAR; G_WAIT_L(0); G_MMA(0, 0, At, B0); G_BAR; G_SCHED;
            G_LDB(B1, 1, 1); G_STAGE(G_SB(1, 0), b3, voffB);
            G_BAR; G_WAIT_L(0); G_MMA(0, 1, At, B1); G_BAR;
            G_LDA(At, 1, 1); G_STAGE(G_SA(1, 0), a3, voffA);
            G_BAR; G_WAIT_L(0); G_MMA(1, 0, At, B0); G_BAR; G_SCHED;
            G_STAGE(G_SB(1, 1), b3 + hstepB, voffB);
            G_WAIT_V(6); G_BAR; G_MMA(1, 1, At, B1); G_BAR;
        }
        int er_ = wr * 64 + fr, ec_ = wc * 32 + fq * 4; asm volatile("" : "+v"(er_), "+v"(ec_));
#pragma unroll
        for (int m = 0; m < 4; ++m)
#pragma unroll
            for (int n = 0; n < 2; ++n) { D.emit(cur, er_ + m * 16, ec_ + n * 16, acc[0][0][m][n], acc[0][1][m][n], acc[1][0][m][n], acc[1][1][m][n]); if (((m * 2 + n + 1) % Dsc::FENCE) == 0) asm volatile("" ::: "memory"); }
        if (!has_next) break;
#pragma unroll
        for (int a = 0; a < 2; ++a)
#pragma unroll
            for (int b = 0; b < 2; ++b)
#pragma unroll
                for (int m = 0; m < 4; ++m)
#pragma unroll
                    for (int n = 0; n < 2; ++n) acc[a][b][m][n] = (f32x4){0.f, 0.f, 0.f, 0.f};
        cur = nxt; cA = nA; cB = nB; ++ui;
    }
    G_WAIT_V(0);
    if (wr == 0) G_BAR;
    G_BAR;
#undef G_SA
#undef G_SB
#undef G_STAGE
#undef G_LDA
#undef G_LDB
#undef G_MMA
#undef G_WAIT_V
#undef G_WAIT_L
#undef G_BAR
#undef G_SCHED
}

constexpr int A_SHM_V = 64 * 128 * 2, A_SHM_K = 64 * 400;
#define KSWZ(row, colB) ((row) * 400 + (colB))
__device__ __forceinline__ int crow(int r, int hi) { return (r & 3) + 8 * (r >> 2) + 4 * hi; }
__device__ __forceinline__ unsigned cvtpk(float lo, float hi) { unsigned r; asm volatile("v_cvt_pk_bf16_f32 %0, %1, %2" : "=v"(r) : "v"(lo), "v"(hi)); return r; }
__device__ __forceinline__ int v_st(int k, int c) { const int kk = (k & ~0xC) | ((k & 4) << 1) | ((k & 8) >> 1); return ((kk >> 3) * 4 + (c >> 5)) * 512 + ((kk & 7) * 32 + (c & 31)) * 2; }
__device__ __forceinline__ int v_rd_base(int lane) { return ((lane & 3) << 3) | (((lane >> 2) & 3) << 6) | (((lane >> 4) & 1) << 5) | (((lane >> 5) & 1) << 8); }
constexpr int v_rd_off(int d0, int ks, int half) { return d0 * 512 + ks * 4096 + half * 2048; }
template <int OFF> __device__ __forceinline__ s16x4 tr_read(int vb) { s16x4 r; asm volatile("ds_read_b64_tr_b16 %0, %1 offset:%2" : "=&v"(r) : "v"(vb), "i"(OFF) : "memory"); return r; }
template <int D0> __device__ __forceinline__ void pv_one(f32x16& od, int vb, bf16x8 pa0, bf16x8 pa1, bf16x8 pa2, bf16x8 pa3) {
    const s16x4 l0 = tr_read<v_rd_off(D0, 0, 0)>(vb), h0 = tr_read<v_rd_off(D0, 0, 1)>(vb), l1 = tr_read<v_rd_off(D0, 1, 0)>(vb), h1 = tr_read<v_rd_off(D0, 1, 1)>(vb);
    const s16x4 l2 = tr_read<v_rd_off(D0, 2, 0)>(vb), h2 = tr_read<v_rd_off(D0, 2, 1)>(vb), l3 = tr_read<v_rd_off(D0, 3, 0)>(vb), h3 = tr_read<v_rd_off(D0, 3, 1)>(vb);
    asm volatile("s_waitcnt lgkmcnt(0)" ::: "memory"); __builtin_amdgcn_sched_barrier(0);
#define PK(L, H) (bf16x8){L[0], L[1], L[2], L[3], H[0], H[1], H[2], H[3]}
    od = __builtin_amdgcn_mfma_f32_32x32x16_bf16(pa0, PK(l0, h0), od, 0, 0, 0);
    od = __builtin_amdgcn_mfma_f32_32x32x16_bf16(pa1, PK(l1, h1), od, 0, 0, 0);
    od = __builtin_amdgcn_mfma_f32_32x32x16_bf16(pa2, PK(l2, h2), od, 0, 0, 0);
    od = __builtin_amdgcn_mfma_f32_32x32x16_bf16(pa3, PK(l3, h3), od, 0, 0, 0);
#undef PK
}
__device__ __forceinline__ void att_body(const AttItem& a, char* lds) {
    int tid_ = threadIdx.x; asm volatile("" : "+v"(tid_));
    const int tid = tid_, wid = tid >> 6, lane = tid & 63, r32 = lane & 31, hi = lane >> 5;
    char* V_lds = lds; char* K_lds = lds + 2 * A_SHM_V; float* li_l = (float*)(lds + 2 * A_SHM_V + 2 * A_SHM_K) + wid * 64;
    float l_reg = 0.f; f32x16 o[4] = {}; bf16x8 qr[12];
    const u16* Qw = a.q + (size_t)(wid * 32 + r32) * 1536 + hi * 8;
#pragma unroll
    for (int d0 = 0; d0 < 12; ++d0) qr[d0] = *(const bf16x8*)(Qw + d0 * 16);
    const int sr = tid >> 4, sc = (tid & 15) * 8, vst0 = v_st(sr, sc), vst1 = v_st(32 + sr, sc);
    const int voff0 = sr * 1024 + sc, voff1 = (32 + sr) * 1024 + sc;
    int koff[3], kwr[3];
#pragma unroll
    for (int i = 0; i < 3; ++i) { const int id = tid + i * 512, kr_ = id / 24, kc_ = (id % 24) * 8; koff[i] = kr_ * 1536 + kc_; kwr[i] = KSWZ(kr_, kc_ * 2); }
    const int vb0 = (int)(uintptr_t)V_lds + v_rd_base(lane);
    bf16x8 vs0, vs1, ks[3];
    const int NT = a.ntot / 64;
#define A_SLOAD(k0_) do { const int key0_ = (k0_); const u16* kb_ = key0_ < a.n0 ? a.k0 + (size_t)key0_ * 1536 : a.k1 + (size_t)(key0_ - a.n0) * 1536; \
        const u16* vbp_ = key0_ < a.n0 ? a.v0 + (size_t)key0_ * 1024 : a.v1 + (size_t)(key0_ - a.n0) * 1024; \
        vs0 = *(const bf16x8*)(vbp_ + voff0); vs1 = *(const bf16x8*)(vbp_ + voff1); \
        _Pragma("unroll") for (int i = 0; i < 3; ++i) ks[i] = *(const bf16x8*)(kb_ + koff[i]); } while (0)
#define A_SWRITE(b) do { *(bf16x8*)(V_lds + (b) * A_SHM_V + vst0) = vs0; *(bf16x8*)(V_lds + (b) * A_SHM_V + vst1) = vs1; \
        _Pragma("unroll") for (int i = 0; i < 3; ++i) *(bf16x8*)(K_lds + (b) * A_SHM_K + kwr[i]) = ks[i]; } while (0)
    A_SLOAD(0); A_SWRITE(0); __syncthreads();
    _Pragma("nounroll") for (int j = 0; j < NT; ++j) {
        const int buf = j & 1;
        if (j + 1 < NT) A_SLOAD((j + 1) * 64);
        f32x16 p0 = {}, p1 = {};
        const char* Ks = K_lds + buf * A_SHM_K;
#pragma unroll
        for (int d0 = 0; d0 < 12; ++d0) { const int cbb = (d0 * 16 + hi * 8) * 2;
            const bf16x8 b0 = *(const bf16x8*)(Ks + KSWZ(r32, cbb)); const bf16x8 b1 = *(const bf16x8*)(Ks + KSWZ(32 + r32, cbb));
            p0 = __builtin_amdgcn_mfma_f32_32x32x16_bf16(b0, qr[d0], p0, 0, 0, 0);
            p1 = __builtin_amdgcn_mfma_f32_32x32x16_bf16(b1, qr[d0], p1, 0, 0, 0); }
        float ps = 0.f;
#pragma unroll
        for (int r = 0; r < 16; ++r) { p0[r] = __builtin_amdgcn_exp2f(p0[r]); p1[r] = __builtin_amdgcn_exp2f(p1[r]); ps += p0[r] + p1[r]; }
        { auto rr = __builtin_amdgcn_permlane32_swap(__float_as_uint(ps), __float_as_uint(ps), false, false); ps = __uint_as_float(rr[0]) + __uint_as_float(rr[1]); }
        l_reg += ps;
        bf16x8 pa0, pa1, pa2, pa3;
#define PK4(Pv, BASE, OUT) do { unsigned a0 = cvtpk(Pv[BASE + 0], Pv[BASE + 1]), a1 = cvtpk(Pv[BASE + 2], Pv[BASE + 3]); \
        unsigned b0 = cvtpk(Pv[BASE + 4], Pv[BASE + 5]), b1 = cvtpk(Pv[BASE + 6], Pv[BASE + 7]); \
        auto r0 = __builtin_amdgcn_permlane32_swap(a0, b0, false, false); auto r1 = __builtin_amdgcn_permlane32_swap(a1, b1, false, false); \
        u32x4 w = {r0[0], r1[0], r0[1], r1[1]}; OUT = *reinterpret_cast<bf16x8*>(&w); } while (0)
        PK4(p0, 0, pa0); PK4(p0, 8, pa1); PK4(p1, 0, pa2); PK4(p1, 8, pa3);
#undef PK4
        const int vb = vb0 + buf * A_SHM_V;
        pv_one<0>(o[0], vb, pa0, pa1, pa2, pa3); pv_one<1>(o[1], vb, pa0, pa1, pa2, pa3); pv_one<2>(o[2], vb, pa0, pa1, pa2, pa3); pv_one<3>(o[3], vb, pa0, pa1, pa2, pa3);
        if (j + 1 < NT) A_SWRITE(buf ^ 1);
        __syncthreads();
    }
    if (hi == 0) li_l[r32] = l_reg;
    asm volatile("s_waitcnt lgkmcnt(0)" ::: "memory");
    __builtin_amdgcn_wave_barrier();
    u16* Ow = a.o + (size_t)(wid * 32) * 1024;
#pragma unroll
    for (int r = 0; r < 16; ++r) { const int orow = crow(r, hi); const float rl = 1.0f / li_l[orow];
#pragma unroll
        for (int d0 = 0; d0 < 4; ++d0) Ow[(size_t)orow * 1024 + d0 * 32 + r32] = f2bf(o[d0][r] * rl); }
    __syncthreads();
#undef A_SLOAD
#undef A_SWRITE
}

__device__ __forceinline__ float wsum(float v) { for (int o = 32; o >= 1; o >>= 1) v += __shfl_xor(v, o); return v; }
__device__ __forceinline__ void norm_wave(const P& p, int layer, int k, int r, int s5, int lane) {
    const float* x = hsrc(p, r, layer == 0 && k == 0); f32x4 v[4]; float ss = 0.f;
#pragma unroll
    for (int i = 0; i < 4; ++i) { v[i] = *(const f32x4*)(x + i * 256 + lane * 4); ss += v[i][0] * v[i][0] + v[i][1] * v[i][1] + v[i][2] * v[i][2] + v[i][3] * v[i][3]; }
    ss = wsum(ss); const float rinv = rsq_f(ss * (1.0f / 1024.0f) + EPS);
    const float* g = p.in[6] + (size_t)(layer * 3 + k) * 1024; const float* sh = modp(p, layer, r, 3 * k); const float* sc = modp(p, layer, r, 3 * k + 1);
    int row5 = 0, i5 = 0;
    if (s5) { if (r < NL) { const int b = r / SEQ, t = r % SEQ; row5 = b * S5L + t / 32; i5 = t % 32; } else { const int rr = r - NL; const int b = rr / 256, l = rr % 256; row5 = NB * S5L + b * S5C + l / 32; i5 = l % 32; } }
#pragma unroll
    for (int i = 0; i < 4; ++i) { const int d = i * 256 + lane * 4; const f32x4 gv = *(const f32x4*)(g + d), sv = *(const f32x4*)(sc + d), hv = *(const f32x4*)(sh + d); f32x4 o;
        for (int j = 0; j < 4; ++j) o[j] = v[i][j] * rinv * gv[j] * (1.0f + sv[j]) + hv[j];
        if (!s5) st4bf(wsb(p, O_HN) + (size_t)r * 1024 + d, o);
        else st4bf(wsb(p, O_UEXT) + ((size_t)(d >> 4) * NROW5P + row5) * 768 + i5 * 16 + (d & 15), o); } }
__device__ __forceinline__ void mla_row_wave(const P& p, int j, int r, int lane) {
    const float* x = (const float*)(p.ws + O_CALL) + (size_t)r * 768; f32x4 c[3]; float q[3];
#pragma unroll
    for (int i = 0; i < 3; ++i) { c[i] = *(const f32x4*)(x + i * 256 + lane * 4); q[i] = c[i][0] * c[i][0] + c[i][1] * c[i][1] + c[i][2] * c[i][2] + c[i][3] * c[i][3]; }
    const bool lo = lane < 32;
    const float ssq = wsum(q[0] + (lo ? q[1] : 0.f)), sskv = wsum((lo ? 0.f : q[1]) + (lo ? q[2] : 0.f)), ssr = wsum((lane >= 32 && lane < 48) ? q[2] : 0.f);
    const float rq = rsq_f(ssq * (1.0f / 384.0f) + EPS), rkv = rsq_f(sskv * (1.0f / 256.0f) + EPS), rr_ = rsq_f(ssr * (1.0f / 64.0f) + EPS);
    const float* qn = p.in[10] + j * 384; const float* kvn = p.in[11] + j * 256; const float* kg = p.in[15] + j * 192 + 128;
    { const f32x4 gq = *(const f32x4*)(qn + lane * 4); f32x4 o; for (int jx = 0; jx < 4; ++jx) o[jx] = c[0][jx] * rq * gq[jx]; st4bf(wsb(p, O_CQN) + (size_t)r * 384 + lane * 4, o); }
    if (lo) { const f32x4 gq = *(const f32x4*)(qn + 256 + lane * 4); f32x4 o; for (int jx = 0; jx < 4; ++jx) o[jx] = c[1][jx] * rq * gq[jx]; st4bf(wsb(p, O_CQN) + (size_t)r * 384 + 256 + lane * 4, o);
        const f32x4 gk = *(const f32x4*)(kvn + 128 + lane * 4); f32x4 o2; for (int jx = 0; jx < 4; ++jx) o2[jx] = c[2][jx] * rkv * gk[jx]; st4bf(wsb(p, O_CKVN) + (size_t)r * 256 + 128 + lane * 4, o2); }
    else { const f32x4 gk = *(const f32x4*)(kvn + lane * 4 - 128); f32x4 o; for (int jx = 0; jx < 4; ++jx) o[jx] = c[1][jx] * rkv * gk[jx]; st4bf(wsb(p, O_CKVN) + (size_t)r * 256 + lane * 4 - 128, o); }
    const int dd = (4 * (lane - 32)) & 63; const f32x4 gr = *(const f32x4*)(kg + dd); f32x4 own, oth, o;
    for (int jx = 0; jx < 4; ++jx) own[jx] = c[2][jx] * rr_ * gr[jx];
    for (int jx = 0; jx < 4; ++jx) oth[jx] = __shfl_xor(own[jx], 4);
    const int t = r % SEQ, pos = (dd & 32) ? (t % 64) : (t / 64); const bool first = (dd & 16) == 0;
    for (int jx = 0; jx < 4; ++jx) { float cs = 1.f, sn = 0.f; if (r < NL) sincos_t((float)pos * ropef((dd & 15) + jx, 16), sn, cs);
        o[jx] = first ? own[jx] * cs - oth[jx] * sn : own[jx] * cs + oth[jx] * sn; }
    if (lane >= 32 && lane < 48) { u16* kf = wsb(p, O_KF) + (size_t)r * 1536 + 128 + dd;
#pragma unroll
        for (int h = 0; h < 8; ++h) st4bf(kf + h * 192, o); } }
__device__ __forceinline__ float bflo(unsigned w) { return __uint_as_float(w << 16); }
__device__ __forceinline__ float bfhi(unsigned w) { return __uint_as_float(w & 0xffff0000u); }
__device__ __forceinline__ unsigned pk2(float a, float b) { return (unsigned)f2bf(a) | ((unsigned)f2bf(b) << 16); }
__device__ __forceinline__ void mla_head_wave(const P& p, int j, int r, int lane) {
    const int h = lane >> 3, sub = lane & 7;
    u16* q = wsb(p, O_CALL) + (size_t)r * 1536 + h * 192; u16* k = wsb(p, O_KF) + (size_t)r * 1536 + h * 192;
    const float* qg = p.in[14] + j * 192; const float* kg = p.in[15] + j * 192;
    u32x4 qa = *(const u32x4*)(q + sub * 16), qb = *(const u32x4*)(q + sub * 16 + 8), qr = *(const u32x4*)(q + 128 + sub * 8), ka = *(const u32x4*)(k + sub * 16), kb = *(const u32x4*)(k + sub * 16 + 8);
    float sq = 0.f, sk = 0.f, sr = 0.f;
#pragma unroll
    for (int i = 0; i < 4; ++i) { sq += bflo(qa[i]) * bflo(qa[i]) + bfhi(qa[i]) * bfhi(qa[i]) + bflo(qb[i]) * bflo(qb[i]) + bfhi(qb[i]) * bfhi(qb[i]);
        sk += bflo(ka[i]) * bflo(ka[i]) + bfhi(ka[i]) * bfhi(ka[i]) + bflo(kb[i]) * bflo(kb[i]) + bfhi(kb[i]) * bfhi(kb[i]); sr += bflo(qr[i]) * bflo(qr[i]) + bfhi(qr[i]) * bfhi(qr[i]); }
    for (int o = 4; o >= 1; o >>= 1) { sq += __shfl_xor(sq, o); sk += __shfl_xor(sk, o); sr += __shfl_xor(sr, o); }
    const float rq = rsq_f(sq * (1.0f / 128.0f) + EPS), rk = rsq_f(sk * (1.0f / 128.0f) + EPS), rr_ = rsq_f(sr * (1.0f / 64.0f) + EPS);
    u32x4 oa, ob, oka, okb;
#pragma unroll
    for (int i = 0; i < 4; ++i) { const int d = sub * 16 + 2 * i;
        oa[i] = pk2(bflo(qa[i]) * rq * qg[d] * QSCALE, bfhi(qa[i]) * rq * qg[d + 1] * QSCALE); ob[i] = pk2(bflo(qb[i]) * rq * qg[d + 8] * QSCALE, bfhi(qb[i]) * rq * qg[d + 9] * QSCALE);
        oka[i] = pk2(bflo(ka[i]) * rk * kg[d], bfhi(ka[i]) * rk * kg[d + 1]); okb[i] = pk2(bflo(kb[i]) * rk * kg[d + 8], bfhi(kb[i]) * rk * kg[d + 9]); }
    *(u32x4*)(q + sub * 16) = oa; *(u32x4*)(q + sub * 16 + 8) = ob; *(u32x4*)(k + sub * 16) = oka; *(u32x4*)(k + sub * 16 + 8) = okb;
    const int dd = sub * 8; float own[8], oth[8];
#pragma unroll
    for (int i = 0; i < 4; ++i) { own[2 * i] = bflo(qr[i]) * rr_ * qg[128 + dd + 2 * i]; own[2 * i + 1] = bfhi(qr[i]) * rr_ * qg[128 + dd + 2 * i + 1]; }
#pragma unroll
    for (int i = 0; i < 8; ++i) oth[i] = __shfl_xor(own[i], 2);
    const int t = r % SEQ, pos = (dd & 32) ? (t % 64) : (t / 64); const bool first = (dd & 16) == 0; u32x4 orr; float res[8];
#pragma unroll
    for (int i = 0; i < 8; ++i) { float cs = 1.f, sn = 0.f; if (r < NL) sincos_t((float)pos * ropef((dd & 15) + i, 16), sn, cs); res[i] = first ? own[i] * cs - oth[i] * sn : own[i] * cs + oth[i] * sn; }
#pragma unroll
    for (int i = 0; i < 4; ++i) orr[i] = pk2(res[2 * i] * QSCALE, res[2 * i + 1] * QSCALE);
    *(u32x4*)(q + 128 + dd) = orr; }
__device__ __forceinline__ void ret_norm_wave(const P& p, int q, int lr, int lane) {
    const int h = lane >> 4, sub = lane & 15; u16* o = wsb(p, O_OB) + (size_t)lr * 2048 + h * 512 + sub * 32; u16* yd = ret_ydst(p, q, lr) + h * 512 + sub * 32; const u16* g = wsb(p, O_GATE) + (size_t)lr * 2048 + h * 512 + sub * 32; const float* gg = p.in[19] + h * 512 + sub * 32;
    u32x4 ov[4]; float s = 0.f;
#pragma unroll
    for (int i = 0; i < 4; ++i) { ov[i] = *(const u32x4*)(o + i * 8); for (int jx = 0; jx < 4; ++jx) s += bflo(ov[i][jx]) + bfhi(ov[i][jx]); }
    for (int m = 8; m >= 1; m >>= 1) s += __shfl_xor(s, m);
    const float mu = s * (1.0f / 512.0f); float qv = 0.f;
#pragma unroll
    for (int i = 0; i < 4; ++i) for (int jx = 0; jx < 4; ++jx) { const float a = bflo(ov[i][jx]) - mu, b = bfhi(ov[i][jx]) - mu; qv += a * a + b * b; }
    for (int m = 8; m >= 1; m >>= 1) qv += __shfl_xor(qv, m);
    const float rstd = rsq_f(qv * (1.0f / 512.0f) + EPS);
#pragma unroll
    for (int i = 0; i < 4; ++i) { const u32x4 gv = *(const u32x4*)(g + i * 8); u32x4 w;
        for (int jx = 0; jx < 4; ++jx) { const int e = i * 8 + 2 * jx;
            w[jx] = pk2((bflo(ov[i][jx]) - mu) * rstd * gg[e] * silu_f(bflo(gv[jx])), (bfhi(ov[i][jx]) - mu) * rstd * gg[e + 1] * silu_f(bfhi(gv[jx]))); }
        *(u32x4*)(yd + i * 8) = w; } }
__device__ __forceinline__ void mod_phase(const P& p, float* tab) {
    for (int i = threadIdx.x; i < NMR * 1024; i += 512) { const int b = i >> 10, k = i & 1023; tab[i] = silu_f(b < NB ? p.in[1][b * 1024 + k] : p.in[3][k]); }
    __syncthreads();
    for (int idx = blockIdx.x * 512 + threadIdx.x; idx < DEPTH * 9216; idx += gridDim.x * 512) {
        const int layer = idx / 9216, col = idx % 9216; const float* w = p.in[4] + (size_t)layer * 1024 * 9216 + col; float acc[NMR];
#pragma unroll
        for (int b = 0; b < NMR; ++b) acc[b] = 0.f;
        for (int k = 0; k < 1024; ++k) { const float wv = w[(size_t)k * 9216];
#pragma unroll
            for (int b = 0; b < NMR; ++b) acc[b] += tab[b * 1024 + k] * wv; }
        const float bias = p.in[5][layer * 9216 + col];
#pragma unroll
        for (int b = 0; b < NMR; ++b) ((float*)(p.ws + O_MOD))[(size_t)(layer * NMR + b) * 9216 + col] = acc[b] + bias; }
    __syncthreads(); }
#define WPASS(N, HOSTCALL, DEVCALL) do { const int _n = (int)(N); int t0_ = threadIdx.x; asm volatile("" : "+v"(t0_)); const int lane = t0_ & 63; for (int it = blockIdx.x * 8 + (t0_ >> 6); it < _n; it += gridDim.x * 8) { DEVCALL; } } while (0)
#define MODPHASE() mod_phase(p, (float*)shm)
#define NCTXWG ((NC / 256) * 4)
#define MIXED_DOWN_NORM(DESC, LAYER2, KK, S5F, ASHARE) do { int t0_ = threadIdx.x; asm volatile("" : "+v"(t0_)); const int lane = t0_ & 63; int r0_, r1_; \
    if ((int)blockIdx.x < NCTXWG) { gemm_run(lds, DESC); r0_ = (int)blockIdx.x * (ASHARE); r1_ = r0_ + (ASHARE); }     \
    else { const int no_ = (int)gridDim.x - NCTXWG, rest_ = NL - NCTXWG * (ASHARE), per_ = (rest_ + no_ - 1) / no_; r0_ = NCTXWG * (ASHARE) + ((int)blockIdx.x - NCTXWG) * per_; r1_ = r0_ + per_ < NL ? r0_ + per_ : NL; } \
    for (int it = r0_ + (t0_ >> 6); it < r1_; it += 8) norm_wave(p, LAYER2, KK, it, S5F, lane); } while (0)
#define MIXED_RET_TAIL(LATDESC, CTXDESC, NCW, LAYER2, KK, RA, RB) do { gemm_run(lds, LATDESC); int t0_ = threadIdx.x; asm volatile("" : "+v"(t0_)); const int lane = t0_ & 63; \
    if ((int)blockIdx.x < (NCW)) { gemm_run(lds, CTXDESC); } else { const int nw_ = ((int)gridDim.x - (NCW)) * 8; \
        for (int it = (RA) + ((int)blockIdx.x - (NCW)) * 8 + (t0_ >> 6); it < (RB); it += nw_) norm_wave(p, LAYER2, KK, it, 0, lane); } } while (0)
#define RANGENORM(LAYER2, KK, RA, RB) do { int t0_ = threadIdx.x; asm volatile("" : "+v"(t0_)); const int lane = t0_ & 63; for (int it = (RA) + blockIdx.x * 8 + (t0_ >> 6); it < (RB); it += gridDim.x * 8) norm_wave(p, LAYER2, KK, it, 0, lane); } while (0)
#define CTXNORM(LAYER2, KK, S5F) do { int t0_ = threadIdx.x; asm volatile("" : "+v"(t0_)); const int lane = t0_ & 63; for (int it = NL + blockIdx.x * 8 + (t0_ >> 6); it < MT; it += gridDim.x * 8) norm_wave(p, LAYER2, KK, it, S5F, lane); } while (0)

#define XB_TMO      128
#define XB_XCNT(j)  (256  + 64 * (j))
#define XB_XSUB(j)  (1280 + 64 * (j))
#define XB_XGEN(j)  (2304 + 64 * (j))
#define XB_TOP      3328
#define XB_TOPGEN   3392
#define XCD_BAR_WORDS 3456
#define XB_SPIN_CAP (1u << 18)
__device__ __forceinline__ unsigned xb_ld(unsigned* p)              { return __hip_atomic_load(p, __ATOMIC_RELAXED, __HIP_MEMORY_SCOPE_AGENT); }
__device__ __forceinline__ unsigned xb_add(unsigned* p, unsigned v) { return __hip_atomic_fetch_add(p, v, __ATOMIC_RELAXED, __HIP_MEMORY_SCOPE_AGENT); }
__device__ __forceinline__ unsigned xb_xcc_id() { return (unsigned)__builtin_amdgcn_s_getreg((3 << 11) | 20) & 0xFu; }
#define XB_SPIN(cond, bar) do { unsigned _sp = 0; while (cond) { __builtin_amdgcn_s_sleep(1); \
    if ((++_sp & 255u) == 0u) { if (xb_ld(&(bar)[XB_TMO])) break; if (_sp > XB_SPIN_CAP) { atomicAdd(&(bar)[XB_TMO], 1u); break; } } } } while (0)
struct XcdBarrier { unsigned* bar; unsigned x; volatile LAS unsigned* st; };
__device__ __forceinline__ XcdBarrier xcd_barrier_post(unsigned* bar, volatile LAS unsigned* st) {
    XcdBarrier b; b.bar = bar; b.x = xb_xcc_id(); b.st = st;
    if (threadIdx.x == 0) (void)xb_add(&bar[XB_XCNT(b.x)], 1u);
    return b; }
__device__ __forceinline__ void xcd_barrier_complete(unsigned* bar, unsigned x, unsigned& nloc, unsigned& nx) {
    const unsigned G = gridDim.x * gridDim.y * gridDim.z; unsigned sum, cnt, mine, sp = 0u;
    for (;;) { sum = 0u; cnt = 0u; mine = 0u;
#pragma unroll
        for (unsigned j = 0; j < 16; ++j) { const unsigned c = xb_ld(&bar[XB_XCNT(j)]); sum += c; cnt += (c > 0u) ? 1u : 0u; mine = (j == x) ? c : mine; }
        if (sum == G) break;
        __builtin_amdgcn_s_sleep(1);
        if ((++sp & 255u) == 0u) { if (xb_ld(&bar[XB_TMO])) break; if (sp > XB_SPIN_CAP) { atomicAdd(&bar[XB_TMO], 1u); break; } } }
    nloc = mine > 0u ? mine : 1u; nx = cnt > 0u ? cnt : 1u; }
__device__ __forceinline__ void xcd_barrier(const XcdBarrier& b) {
    asm volatile("s_waitcnt vmcnt(0)" ::: "memory");
    __syncthreads();
    if (threadIdx.x == 0) {
        unsigned* bar = b.bar;
        __builtin_amdgcn_s_waitcnt(0);
        unsigned nloc = b.st[0], nx = b.st[1];
        if (nloc == 0u) { xcd_barrier_complete(bar, b.x, nloc, nx); b.st[0] = nloc; b.st[1] = nx; }
        const unsigned old = xb_add(&bar[XB_XSUB(b.x)], 1u);
        const unsigned gen = old / nloc;
        if (old + 1u == (gen + 1u) * nloc) {
            __builtin_amdgcn_fence(__ATOMIC_RELEASE, "agent");
            asm volatile("s_waitcnt vmcnt(0)" ::: "memory");
            const unsigned og = xb_add(&bar[XB_TOP], 1u);
            const unsigned tg = og / nx;
            if (og + 1u == (tg + 1u) * nx) xb_add(&bar[XB_TOPGEN], 1u);
            else XB_SPIN(xb_ld(&bar[XB_TOPGEN]) == tg, bar);
            __builtin_amdgcn_fence(__ATOMIC_ACQUIRE, "agent");
            xb_add(&bar[XB_XGEN(b.x)], 1u);
            asm volatile("s_waitcnt vmcnt(0)" ::: "memory");
        } else {
            XB_SPIN(xb_ld(&bar[XB_XGEN(b.x)]) == gen, bar);
            __builtin_amdgcn_fence(__ATOMIC_ACQUIRE, "agent");
            asm volatile("s_waitcnt vmcnt(0)" ::: "memory");
        }
    }
    __syncthreads();
}

namespace cg = cooperative_groups;
#define PASS(N, CALL) do { const long _n = (long)(N); int t0_ = threadIdx.x; asm volatile("" : "+v"(t0_)); for (long it = (long)blockIdx.x * 512 + t0_; it < _n; it += (long)gridDim.x * 512) { CALL; } } while (0)
#define GEMM(D) gemm_run(lds, D)
#define SYNC() xcd_barrier(xb)
#ifndef STAGGER_US
#define STAGGER_US 40
#endif
#define STAGGER(US) do { if ((US) > 0 && (xb.x & 1u)) { const unsigned long long t0_ = __builtin_amdgcn_s_memrealtime(); while (__builtin_amdgcn_s_memrealtime() - t0_ < (unsigned long long)(US) * 100ull) __builtin_amdgcn_s_sleep(8); } } while (0)
#define GRIDSYNC() grid.sync()
#define HOOK(L, S) do { } while (0)
#define ATTN(NITEMS) do { for (int it = blockIdx.x; it < (NITEMS); it += gridDim.x) { AttItem ai_; att_item(p, it, ai_); att_body(ai_, (char*)shm); } } while (0)
#else
template <class Dsc> static void gemm_emu(const Dsc& D) {
    std::vector<int> Ls; for (int c = 0; c < 256; ++c) for (int i = 0;; ++i) { Unit u{}; if (!D.unit(i * 256 + c, u)) break; Ls.push_back(i * 256 + c); }
    const int n = (int)Ls.size();
#pragma omp parallel for schedule(dynamic)
    for (int li = 0; li < n; ++li) { const int L = Ls[li]; Unit u{}; D.unit(L, u); const int K = Dsc::K;
        std::vector<float> A((size_t)256 * K), B((size_t)256 * K), C((size_t)256 * 256);
        for (int r = 0; r < 256; ++r) for (int k = 0; k < K; ++k) { A[(size_t)r * K + k] = bf2f(u.A[(size_t)r * Dsc::lda + k]); B[(size_t)r * K + k] = bf2f(u.B[(size_t)r * Dsc::ldb + k]); }
        for (int r = 0; r < 256; ++r) for (int c = 0; c < 256; ++c) { float s = 0.f; const float* a = &A[(size_t)r * K]; const float* b = &B[(size_t)c * K]; for (int k = 0; k < K; ++k) s += a[k] * b[k]; C[r * 256 + c] = s; }
        for (int r = 0; r < 128; ++r) for (int c = 0; c < 128; c += 4) { f32x4 v[2][2];
            for (int X = 0; X < 2; ++X) for (int Y = 0; Y < 2; ++Y) for (int j = 0; j < 4; ++j) v[X][Y][j] = C[(r + 128 * X) * 256 + c + 128 * Y + j];
            D.emit(u, r, c, v[0][0], v[0][1], v[1][0], v[1][1]); } } }
static void att_emu(const P& p, int nitems) {
#pragma omp parallel for schedule(dynamic)
    for (int it = 0; it < nitems; ++it) { AttItem a; att_item(p, it, a); std::vector<float> s(a.ntot);
        for (int i = 0; i < 256; ++i) { const u16* q = a.q + (size_t)i * 1536; float l = 0.f; float o[128]; for (int e = 0; e < 128; ++e) o[e] = 0.f;
            for (int k = 0; k < a.ntot; ++k) { const u16* kr = k < a.n0 ? a.k0 + (size_t)k * 1536 : a.k1 + (size_t)(k - a.n0) * 1536; float d = 0.f; for (int x = 0; x < 192; ++x) d += bf2f(q[x]) * bf2f(kr[x]);
                const float pv = bf2f(f2bf(exp2f(d))); l += exp2f(d); const u16* vr = k < a.n0 ? a.v0 + (size_t)k * 1024 : a.v1 + (size_t)(k - a.n0) * 1024; for (int e = 0; e < 128; ++e) o[e] += pv * bf2f(vr[e]); }
            for (int e = 0; e < 128; ++e) a.o[(size_t)i * 1024 + e] = f2bf(o[e] / l); } } }
#define PASS(N, CALL) do { const long _n = (long)(N); _Pragma("omp parallel for schedule(static)") for (long it = 0; it < _n; ++it) { CALL; } } while (0)
#define WPASS(N, HOSTCALL, DEVCALL) PASS(N, HOSTCALL)
#define MODPHASE() PASS(DEPTH * 9216, mod_item(p, (int)it))
#define MIXED_DOWN_NORM(DESC, LAYER2, KK, S5F, ASHARE) do { gemm_emu(DESC); PASS(NL, norm_item(p, LAYER2, KK, (int)it, S5F)); } while (0)
#define CTXNORM(LAYER2, KK, S5F) PASS(NC, norm_item(p, LAYER2, KK, NL + (int)it, S5F))
#define MIXED_RET_TAIL(LATDESC, CTXDESC, NCW, LAYER2, KK, RA, RB) do { gemm_emu(LATDESC); gemm_emu(CTXDESC); PASS((RB) - (RA), norm_item(p, LAYER2, KK, (RA) + (int)it, 0)); } while (0)
#define RANGENORM(LAYER2, KK, RA, RB) PASS((RB) - (RA), norm_item(p, LAYER2, KK, (RA) + (int)it, 0))
#define GEMM(D) gemm_emu(D)
#define SYNC() do { } while (0)
#define STAGGER(US) do { } while (0)
#define GRIDSYNC() do { } while (0)
#define ATTN(NITEMS) att_emu(p, NITEMS)
static void emu_hook(const P& p, int layer, int stage);
#define HOOK(L, S) emu_hook(p, L, S)
#endif

#ifndef HOST_EMU
__global__ void __launch_bounds__(512) fwd_megakernel(P p) {
    extern __shared__ __attribute__((aligned(16))) unsigned char shm[];
    LAS unsigned char* lds = (LAS unsigned char*)shm;
    cg::grid_group grid = cg::this_grid();
    volatile LAS unsigned* xst = (volatile LAS unsigned*)(lds + STAGE_BYTES + 1024);
    if (threadIdx.x == 0) { xst[0] = 0u; xst[1] = 0u; xst[2] = 0u; xst[3] = 0u; }
    __syncthreads();
    const XcdBarrier xb = xcd_barrier_post((unsigned*)(p.ws + O_BAR), xst);
#else
static void fwd_emu(P p) {
#endif
    if (PM(0)) { MODPHASE();
    PASS((long)NC * 256, ((f32x4*)(p.ws + O_G))[it] = ((const f32x4*)p.in[2])[it]);
    PASS(CV_TOTAL, cvt_item(p, it));
    PASS(64 * 2 * 32 * 16, s5_ktab_item(p, (int)it));
    PASS(64 * 256 * 512, s5_fext_item(p, (int)it)); }
    GRIDSYNC();
    if (PM(0)) { PASS((long)64 * 512 * 768, s5_text_item(p, it)); }
    for (int rep_ = 0; rep_ < REP_SYNC; ++rep_) SYNC();
    for (int layer = 0; layer < DEPTH; ++layer) {
        const int kind = layer % 3, j = layer / 3; const bool last = layer == DEPTH - 1;
        if (layer == 0) { if (PM(1)) { WPASS(MT, norm_item(p, layer, 0, (int)it, 0), norm_wave(p, layer, 0, it, 0, lane)); } SYNC(); }
        for (int rep_ = 0; rep_ < REP_UP; ++rep_) { if (PM(2)) { DFfnUp d{p, layer, 0, MT / 256}; GEMM(d); } SYNC(); }
        if (PM(3)) { DFfnDown d{p, layer, 0, NL / 256, 0.5f}; GEMM(d); } SYNC();
        if (PM(3)) { DFfnDown d{p, layer, 0, -1, 0.5f}; MIXED_DOWN_NORM(d, layer, 1, kind == 2 ? 1 : 0, 56); } SYNC();
        if (PM(1)) { CTXNORM(layer, 1, kind == 2 ? 1 : 0); } SYNC();
        if (kind == 0) {
            for (int rep_ = 0; rep_ < REP_MLA; ++rep_) { if (PM(4)) { DMlaIn d{p, j}; GEMM(d); } SYNC(); }
            if (PM(5)) { WPASS(MT, mla_row_item(p, j, (int)it), mla_row_wave(p, j, it, lane)); } SYNC();
            for (int rep_ = 0; rep_ < REP_MLA; ++rep_) { if (PM(6)) { DMlaUq d{p, j, last ? NL / 256 : MT / 256}; GEMM(d); } if (PM(7)) { DMlaUkv d{p, j}; GEMM(d); } SYNC(); }
            if (PM(8)) { WPASS(MT, { for (int h_ = 0; h_ < 8; ++h_) mla_head_item(p, j, (int)it * 8 + h_); }, mla_head_wave(p, j, it, lane)); } SYNC();
            for (int rep_ = 0; rep_ < REP_ATT; ++rep_) { if (PM(9)) { ATTN(NB * 8 * (SEQ / 256) + (last ? 0 : NB * 8)); } SYNC(); }
            if (PM(10)) { DMlaO d{p, layer, j, NL / 256}; GEMM(d); } SYNC();
            if (!last) { if (PM(10)) { DMlaO d{p, layer, j, -1}; MIXED_DOWN_NORM(d, layer, 2, 0, 184); } SYNC();
                if (PM(1)) { CTXNORM(layer, 2, 0); } SYNC(); }
        } else if (kind == 1) {
            for (int q = 0; q < NB / RGB; ++q) {
                for (int rep_ = 0; rep_ < REP_RET; ++rep_) { if (PM(11)) { DRetProjAll d{p, q}; GEMM(d); } SYNC(); }
                for (int rep_ = 0; rep_ < REP_RET; ++rep_) { if (PM(13)) { DRetP d{p}; GEMM(d); } if (PM(14)) { DRetL d{p}; GEMM(d); } SYNC(); }
                if (PM(15)) { PASS(4 * RGB * 512 * 64, ret_prefix_item(p, (int)it)); } SYNC();
                for (int rep_ = 0; rep_ < REP_RET; ++rep_) { if (PM(16)) { DRetO d{p}; GEMM(d); } SYNC(); }
                if (PM(17)) { WPASS(NCQ * 256, { for (int h_ = 0; h_ < 4; ++h_) ret_norm_item(p, q, (int)it * 4 + h_); }, ret_norm_wave(p, q, it, lane)); } SYNC();
                if (q < NB / RGB - 1) { if (PM(18)) { DRetWo d{p, layer, q}; GEMM(d); } SYNC(); }
                else { if (PM(18)) { DRetWo d{p, layer, q}; DRetWoCtx c{p, layer}; MIXED_RET_TAIL(d, c, (NC / 256) * 4, layer, 2, 0, q * RGB * SEQ); } SYNC();
                    if (PM(1)) { RANGENORM(layer, 2, q * RGB * SEQ, MT); } SYNC(); }
            }
        } else {
            for (int rep_ = 0; rep_ < REP_S5; ++rep_) { if (PM(20)) { DS5L d{p}; GEMM(d); } SYNC(); }
            if (PM(21)) { PASS(64 * NB * 64, s5_prefix_item(p, (int)it)); } SYNC();
            for (int rep_ = 0; rep_ < REP_S5; ++rep_) { if (PM(22)) { DS5Y d{p}; GEMM(d); } SYNC(); }
            if (PM(23)) { DS5Glu d{p, layer}; GEMM(d); } SYNC();
        }
        HOOK(layer, 0);
        if (kind == 2 || (kind == 0 && last)) { if (PM(1)) { WPASS(last ? NL : MT, norm_item(p, layer, 2, (int)it, 0), norm_wave(p, layer, 2, it, 0, lane)); } SYNC(); }
        for (int rep_ = 0; rep_ < REP_UP; ++rep_) { if (PM(2)) { DFfnUp d{p, layer, 1, last ? NL / 256 : MT / 256}; GEMM(d); } SYNC(); }
        if (PM(3)) { DFfnDown d{p, layer, 1, NL / 256, 0.5f}; GEMM(d); } SYNC();
        if (!last) { if (PM(3)) { DFfnDown d{p, layer, 1, -1, 0.5f}; MIXED_DOWN_NORM(d, layer + 1, 0, 0, 56); } SYNC();
            if (PM(1)) { CTXNORM(layer + 1, 0, 0); } SYNC(); }
        HOOK(layer, 1);
    }
}

#ifndef HOST_EMU
extern "C" void kernel_launch(void* const* d_in, const int* in_sizes, int n_in, void* d_out, int out_size, void* d_ws, size_t ws_size, hipStream_t stream) {
    constexpr size_t kDynLds = STAGE_BYTES + 4096;
    static int grid_blocks = 0;
    if (!grid_blocks) {
        int dev = 0, cus = 0, per_cu = 0;
        hipGetDevice(&dev);
        hipDeviceGetAttribute(&cus, hipDeviceAttributeMultiprocessorCount, dev);
        hipFuncSetAttribute((const void*)fwd_megakernel, hipFuncAttributeMaxDynamicSharedMemorySize, (int)kDynLds);
        hipOccupancyMaxActiveBlocksPerMultiprocessor(&per_cu, fwd_megakernel, 512, kDynLds);
        if (per_cu < 1) per_cu = 1;
        if (per_cu > 1) per_cu = 1;
        grid_blocks = cus * per_cu;
        if (ws_size < WS_NEED) fprintf(stderr, "workspace too small: %zu < %zu\n", ws_size, (size_t)WS_NEED);
    }
    P p{};
    for (int i = 0; i < 31 && i < n_in; ++i) p.in[i] = (const float*)d_in[i];
    p.out = (float*)d_out; p.ws = (char*)d_ws;
    hipMemsetAsync((char*)d_ws + O_BAR, 0, XCD_BAR_WORDS * 4, stream);
    void* args[] = {&p};
    hipError_t e = hipLaunchCooperativeKernel((void*)fwd_megakernel, dim3(grid_blocks), dim3(512), args, kDynLds, stream);
    if (e != hipSuccess) fprintf(stderr, "cooperative launch failed: %s (grid %d)\n", hipGetErrorString(e), grid_blocks);
}
#endif
```

```cpp
#ifdef HOST_EMU
#include <cmath>
#include <cstdio>
#include <cstdlib>
#include <cstring>
#include <vector>
#define HD inline
#else
#include <hip/hip_runtime.h>
#include <hip/hip_cooperative_groups.h>
#include <type_traits>
#include <cstdio>
#define HD __device__ __forceinline__
#endif

#ifndef CFG_BATCH
#define CFG_BATCH 16
#endif
#ifndef CFG_SEQ
#define CFG_SEQ 4096
#endif

typedef unsigned short u16;
typedef float f32x4 __attribute__((ext_vector_type(4)));
typedef unsigned u32x2 __attribute__((ext_vector_type(2)));

constexpr int DM = 1024, NB = CFG_BATCH, SEQ = CFG_SEQ, CTX = 256, DFF = 2816, DEPTH = 4;
constexpr int NL = NB * SEQ, NC = NB * CTX, MT = NL + NC;
constexpr int NMR = NB + 1;
constexpr int RGB = (NB >= 4) ? 4 : 1;
constexpr int NCH = 1 + SEQ / 256;
constexpr int NCQ = RGB * NCH;
constexpr int S5L = SEQ / 32, S5C = CTX / 32;
constexpr int NROW5 = NB * S5L + NB * S5C;
constexpr int NROW5P = (NROW5 + 255) / 256 * 256;
constexpr float EPS = 1e-6f;
constexpr float ATT_SCALE = 0.07216878364870322f;
constexpr float QSCALE = ATT_SCALE * 1.4426950408889634f;

constexpr size_t al(size_t x) { return (x + 255) & ~(size_t)255; }
constexpr size_t O_BAR = 0;
constexpr size_t O_MOD = 16384;
constexpr size_t O_G = O_MOD + al((size_t)DEPTH * NMR * 9216 * 4);
constexpr size_t O_FFI = O_G + al((size_t)NC * 1024 * 4);
constexpr size_t SZ_FFI1 = (size_t)5632 * 1024 * 2, SZ_FFO1 = (size_t)1024 * 2816 * 2;
constexpr size_t O_FFO = O_FFI + 8 * SZ_FFI1;
constexpr size_t O_MWIN = O_FFO + 8 * SZ_FFO1;
constexpr size_t SZ_MWIN = (size_t)768 * 1024 * 2, SZ_MWUQ = (size_t)1536 * 384 * 2, SZ_MWUKV = (size_t)2048 * 256 * 2, SZ_MWO = (size_t)1024 * 1024 * 2;
constexpr size_t O_MWUQ = O_MWIN + 2 * SZ_MWIN;
constexpr size_t O_MWUKV = O_MWUQ + 2 * SZ_MWUQ;
constexpr size_t O_MWO = O_MWUKV + 2 * SZ_MWUKV;
constexpr size_t O_RWIN = O_MWO + 2 * SZ_MWO;
constexpr size_t O_RWO = O_RWIN + (size_t)6144 * 1024 * 2;
constexpr size_t O_GLU = O_RWO + (size_t)1024 * 2048 * 2;
constexpr size_t O_HN = O_GLU + (size_t)2048 * 1024 * 2;
constexpr size_t O_KTAB = O_HN + al((size_t)MT * 1024 * 2);
constexpr size_t O_TEXT = O_KTAB + al((size_t)64 * 2 * 32 * 256 * 4);
constexpr size_t O_FEXT = O_TEXT + al((size_t)64 * 512 * 768 * 2);
constexpr size_t O_SCR = O_FEXT + al((size_t)64 * 256 * 512 * 2);
constexpr size_t O_ACT = O_SCR;
constexpr size_t O_CALL = O_SCR;
constexpr size_t O_CQN = O_CALL + al((size_t)MT * 768 * 4);
constexpr size_t O_CKVN = O_CQN + al((size_t)MT * 384 * 2);
constexpr size_t O_KF = O_CKVN + al((size_t)MT * 256 * 2);
constexpr size_t O_VB = O_KF + al((size_t)MT * 1536 * 2);
constexpr size_t END_MLA = O_VB + al((size_t)MT * 1024 * 2);
constexpr size_t O_QN = O_SCR;
constexpr size_t O_KN = O_QN + al((size_t)NCQ * 256 * 1024 * 2);
constexpr size_t O_GATE = O_KN + al((size_t)NCQ * 256 * 1024 * 2);
constexpr size_t O_OB = O_GATE + al((size_t)NCQ * 256 * 2048 * 2);
constexpr size_t O_AEXT = O_OB + al((size_t)NCQ * 256 * 2048 * 2);
constexpr size_t O_KTX = O_AEXT + al((size_t)4 * NCQ * 256 * 768 * 2);
constexpr size_t O_BEXT = O_KTX + al((size_t)4 * NCQ * 2 * 256 * 256 * 2);
constexpr size_t O_YCTX = O_BEXT + al((size_t)4 * NCQ * 512 * 768 * 2);
constexpr size_t END_RET = O_YCTX + al((size_t)NC * 2048 * 2);
constexpr size_t O_UEXT = O_SCR;
constexpr size_t END_S5 = O_UEXT + al((size_t)64 * NROW5P * 768 * 2);
constexpr size_t END_FFN = O_ACT + al((size_t)MT * 2816 * 2);
constexpr size_t cmax(size_t a, size_t b) { return a > b ? a : b; }
constexpr size_t WS_NEED = cmax(cmax(END_MLA, END_RET), cmax(END_S5, END_FFN));

struct P { const float* in[32]; float* out; char* ws; };
#ifndef PHASE_MASK
#define PHASE_MASK 0xFFFFFFFFu
#endif
#define PM(b) ((PHASE_MASK >> (b)) & 1u)
#ifndef REP_UP
#define REP_UP 1
#endif
#ifndef REP_ATT
#define REP_ATT 1
#endif
#ifndef REP_NORM
#define REP_NORM 1
#endif
#ifndef REP_RET
#define REP_RET 1
#endif
#ifndef REP_DOWN
#define REP_DOWN 1
#endif
#ifndef REP_MLA
#define REP_MLA 1
#endif
#ifndef REP_S5
#define REP_S5 1
#endif
#ifndef REP_SYNC
#define REP_SYNC 0
#endif

HD float bf2f(u16 b) { union { unsigned u; float f; } x; x.u = ((unsigned)b) << 16; return x.f; }
HD u16 f2bf(float f) { union { unsigned u; float f; } x; x.f = f; unsigned u = x.u; u += 0x7fffu + ((u >> 16) & 1u); return (u16)(u >> 16); }
#ifdef HOST_EMU
HD void st4bf(u16* p, f32x4 v) { u32x2 w; w.x = (unsigned)f2bf(v[0]) | ((unsigned)f2bf(v[1]) << 16); w.y = (unsigned)f2bf(v[2]) | ((unsigned)f2bf(v[3]) << 16); *(u32x2*)p = w; }
#else
HD unsigned cvtpk_bf(float lo, float hi) { unsigned r; asm("v_cvt_pk_bf16_f32 %0, %1, %2" : "=v"(r) : "v"(lo), "v"(hi)); return r; }
HD void st4bf(u16* p, f32x4 v) { u32x2 w; w.x = cvtpk_bf(v[0], v[1]); w.y = cvtpk_bf(v[2], v[3]); *(u32x2*)p = w; }
#endif
#ifdef HOST_EMU
HD float silu_f(float a) { return a / (1.0f + expf(-a)); }
HD float sigm_f(float a) { return 1.0f / (1.0f + expf(-a)); }
HD float gelu_f(float x) { return 0.5f * x * (1.0f + tanhf(0.7978845608028654f * (x + 0.044715f * x * x * x))); }
#else
HD float sigm_f(float a) { return __builtin_amdgcn_rcpf(1.0f + __builtin_amdgcn_exp2f(-1.4426950408889634f * a)); }
HD float silu_f(float a) { return a * sigm_f(a); }
HD float gelu_f(float x) { return x * sigm_f(1.5957691216057308f * (x + 0.044715f * x * x * x)); }
#endif
HD float rsq_f(float x) { return 1.0f / sqrtf(x); }
HD float ex2(float x) {
#ifdef HOST_EMU
    return exp2f(x);
#else
    return __builtin_amdgcn_exp2f(x);
#endif
}
HD const float* hsrc(const P& p, int r, int first) { if (first && r < NL) return p.in[0] + (size_t)r * 1024; return r < NL ? p.out + (size_t)r * 1024 : (const float*)(p.ws + O_G) + (size_t)(r - NL) * 1024; }
HD float* hrow(const P& p, int r) { return r < NL ? p.out + (size_t)r * 1024 : (float*)(p.ws + O_G) + (size_t)(r - NL) * 1024; }
HD const float* modp(const P& p, int layer, int r, int idx) { const int mr = r < NL ? r / SEQ : NB; return (const float*)(p.ws + O_MOD) + ((size_t)(layer * NMR + mr) * 9 + idx) * 1024; }
HD u16* wsb(const P& p, size_t off) { return (u16*)(p.ws + off); }
#ifdef HOST_EMU
HD float ropef(int d, int half) { return expf(-(float)d * (9.210340371976184f / (float)half)) * 0.15915494309189535f; }
#else
HD float ropef(int d, int half) { return __builtin_amdgcn_exp2f(-(float)d * (13.287712379549449f / (float)half)) * 0.15915494309189535f; }
#endif
HD void sincos_t(float turns, float& sn, float& cs) {
    const float f = turns - floorf(turns);
#ifdef HOST_EMU
    sn = sinf(6.283185307179586f * f); cs = cosf(6.283185307179586f * f);
#else
    sn = __builtin_amdgcn_sinf(f); cs = __builtin_amdgcn_cosf(f);
#endif
}

HD bool rect_unit(int L, int nM, int nN, int& pm, int& pn) {
    const int nwg = nM * nN; if (L >= nwg) return false;
    int wgid = L; { const int q = nwg / 8, r = nwg % 8, xcd = wgid % 8, off = wgid / 8; wgid = (xcd < r ? xcd * (q + 1) : r * (q + 1) + (xcd - r) * q) + off; }
    const int nig = 8 * nN, gid = wgid / nig, fm = gid * 8, gsz = (nM - fm) < 8 ? (nM - fm) : 8;
    pm = fm + ((wgid % nig) % gsz); pn = (wgid % nig) / gsz; return true;
}

struct Unit { const u16* A; const u16* B; int a, b, c, d; float f0, f1; };

struct DFfnUp { P p; int layer, f, nM; static constexpr int FENCE = 1; static constexpr int K = 1024, lda = 1024, ldb = 1024;
    HD bool unit(int L, Unit& u) const { int pm, pn; if (!rect_unit(L, nM, 22, pm, pn)) return false;
        u.A = wsb(p, O_HN) + (size_t)pm * 256 * 1024; u.B = wsb(p, O_FFI + (size_t)(layer * 2 + f) * SZ_FFI1) + (size_t)pn * 256 * 1024; u.a = pm; u.b = pn; u.c = 0; u.d = 0; return true; }
    HD void emit(const Unit& u, int r, int c, f32x4 v00, f32x4 v01, f32x4 v10, f32x4 v11) const {
        u16* act = wsb(p, O_ACT); const size_t R = (size_t)u.a * 256 + r; const int col = u.b * 128 + c; f32x4 o0, o1;
        for (int j = 0; j < 4; ++j) { o0[j] = silu_f(v00[j]) * v01[j]; o1[j] = silu_f(v10[j]) * v11[j]; }
        st4bf(act + R * 2816 + col, o0); st4bf(act + (R + 128) * 2816 + col, o1); } };

HD void resid4(const P& p, int layer, int midx, float sc, int R, int col, f32x4 v, int first = 0) {
    float* h = hrow(p, R) + col; const float* m = modp(p, layer, R, midx) + col; f32x4 x = *(const f32x4*)(hsrc(p, R, first) + col);
    for (int j = 0; j < 4; ++j) x[j] += sc * m[j] * v[j];
    *(f32x4*)h = x; }

struct DFfnDown { P p; int layer, f, nM; float sc; static constexpr int FENCE = 4; static constexpr int K = 2816, lda = 2816, ldb = 2816;
    HD bool unit(int L, Unit& u) const { int pm, pn;
        if (nM < 0) { if (L >= (NC / 256) * 4) return false; pm = NL / 256 + (L >> 2); pn = L & 3; }
        else if (((NL / 256) * 4) % 256 == 0 && nM > NL / 256) {
            if (L < (NL / 256) * 4) rect_unit(L, NL / 256, 4, pm, pn);
            else { const int c = L - (NL / 256) * 4; if (c >= 128 || (c & 1)) return false; const int k = c >> 1; pm = NL / 256 + (k >> 2); pn = k & 3; if (pm >= nM) return false; } }
        else if (!rect_unit(L, nM, 4, pm, pn)) return false;
        u.A = wsb(p, O_ACT) + (size_t)pm * 256 * 2816; u.B = wsb(p, O_FFO + (size_t)(layer * 2 + f) * SZ_FFO1) + (size_t)pn * 256 * 2816; u.a = pm; u.b = pn; u.c = 0; u.d = 0; return true; }
    HD void emit(const Unit& u, int r, int c, f32x4 v00, f32x4 v01, f32x4 v10, f32x4 v11) const {
        const int R = u.a * 256 + r, col = u.b * 256 + c, mi = f ? 8 : 2;
        const int first = (layer == 0 && f == 0 && sc != 0.f);
        resid4(p, layer, mi, sc, R, col, v00, first); resid4(p, layer, mi, sc, R, col + 128, v01, first); resid4(p, layer, mi, sc, R + 128, col, v10, first); resid4(p, layer, mi, sc, R + 128, col + 128, v11, first); } };
HD void atom4(float* g, const float* m, float sc, f32x4 v) {
#ifdef HOST_EMU
    for (int j = 0; j < 4; ++j) {
#pragma omp atomic
        g[j] += sc * m[j] * v[j]; }
#else
    for (int j = 0; j < 4; ++j) unsafeAtomicAdd(g + j, sc * m[j] * v[j]);
#endif
}
template <int KS, int SL0> struct DFfnDownCtx { P p; int layer, f; float sc; static constexpr int FENCE = 4; static constexpr int K = KS, lda = 2816, ldb = 2816;
    HD bool unit(int L, Unit& u) const { if (L >= 256) return false; const int x = SL0 ? (L + 128) % 256 : L; if (x >= 128 || x >= (NC / 256) * 8) return false;
        const int sl = x & 1, pn = (x >> 1) & 3, pm = NL / 256 + (x >> 3); const int k0 = SL0 ? 1536 + sl * 640 : sl * 768;
        u.A = wsb(p, O_ACT) + (size_t)pm * 256 * 2816 + k0; u.B = wsb(p, O_FFO + (size_t)(layer * 2 + f) * SZ_FFO1) + (size_t)pn * 256 * 2816 + k0; u.a = pm; u.b = pn; u.c = 0; u.d = 0; return true; }
    HD void one(int R, int col, f32x4 v) const { atom4(hrow(p, R) + col, modp(p, layer, R, f ? 8 : 2) + col, sc, v); }
    HD void emit(const Unit& u, int r, int c, f32x4 v00, f32x4 v01, f32x4 v10, f32x4 v11) const {
        const int R = u.a * 256 + r, col = u.b * 256 + c; one(R, col, v00); one(R, col + 128, v01); one(R + 128, col, v10); one(R + 128, col + 128, v11); } };

struct DMlaIn { P p; int j; static constexpr int FENCE = 1; static constexpr int K = 1024, lda = 1024, ldb = 1024;
    HD bool unit(int L, Unit& u) const { int pm, pn; if (!rect_unit(L, MT / 256, 3, pm, pn)) return false;
        u.A = wsb(p, O_HN) + (size_t)pm * 256 * 1024; u.B = wsb(p, O_MWIN + j * SZ_MWIN) + (size_t)pn * 256 * 1024; u.a = pm; u.b = pn; u.c = 0; u.d = 0; return true; }
    HD void emit(const Unit& u, int r, int c, f32x4 v00, f32x4 v01, f32x4 v10, f32x4 v11) const {
        float* o = (float*)(p.ws + O_CALL) + ((size_t)u.a * 256 + r) * 768 + u.b * 256 + c;
        *(f32x4*)o = v00; *(f32x4*)(o + 128) = v01; *(f32x4*)(o + (size_t)128 * 768) = v10; *(f32x4*)(o + (size_t)128 * 768 + 128) = v11; } };
struct DMlaUq { P p; int j, nM; static constexpr int FENCE = 1; static constexpr int K = 384, lda = 384, ldb = 384;
    HD bool unit(int L, Unit& u) const { int pm, pn; if (!rect_unit(L, nM, 6, pm, pn)) return false;
        u.A = wsb(p, O_CQN) + (size_t)pm * 256 * 384; u.B = wsb(p, O_MWUQ + j * SZ_MWUQ) + (size_t)pn * 256 * 384; u.a = pm; u.b = pn; u.c = 0; u.d = 0; return true; }
    HD void emit(const Unit& u, int r, int c, f32x4 v00, f32x4 v01, f32x4 v10, f32x4 v11) const {
        u16* o = wsb(p, O_CALL) + ((size_t)u.a * 256 + r) * 1536 + u.b * 256 + c;
        st4bf(o, v00); st4bf(o + 128, v01); st4bf(o + (size_t)128 * 1536, v10); st4bf(o + (size_t)128 * 1536 + 128, v11); } };
struct DMlaUkv { P p; int j; static constexpr int FENCE = 1; static constexpr int K = 256, lda = 256, ldb = 256;
    HD bool unit(int L, Unit& u) const { int pm, pn; if (!rect_unit(L, MT / 256, 8, pm, pn)) return false;
        u.A = wsb(p, O_CKVN) + (size_t)pm * 256 * 256; u.B = wsb(p, O_MWUKV + j * SZ_MWUKV) + (size_t)pn * 256 * 256; u.a = pm; u.b = pn; u.c = 0; u.d = 0; return true; }
    HD void one(size_t R, int col, f32x4 v) const {
        if (col < 1024) st4bf(wsb(p, O_KF) + R * 1536 + (col >> 7) * 192 + (col & 127), v);
        else st4bf(wsb(p, O_VB) + R * 1024 + (col - 1024), v); }
    HD void emit(const Unit& u, int r, int c, f32x4 v00, f32x4 v01, f32x4 v10, f32x4 v11) const {
        const size_t R = (size_t)u.a * 256 + r; const int col = u.b * 256 + c;
        one(R, col, v00); one(R, col + 128, v01); one(R + 128, col, v10); one(R + 128, col + 128, v11); } };
struct DMlaO { P p; int layer, j, nM; static constexpr int FENCE = 4; static constexpr int K = 1024, lda = 1024, ldb = 1024;
    HD bool unit(int L, Unit& u) const { int pm, pn;
        if (nM < 0) { if (L >= (NC / 256) * 4) return false; pm = NL / 256 + (L >> 2); pn = L & 3; }
        else if (!rect_unit(L, nM, 4, pm, pn)) return false;
        u.A = wsb(p, O_HN) + (size_t)pm * 256 * 1024; u.B = wsb(p, O_MWO + j * SZ_MWO) + (size_t)pn * 256 * 1024; u.a = pm; u.b = pn; u.c = 0; u.d = 0; return true; }
    HD void emit(const Unit& u, int r, int c, f32x4 v00, f32x4 v01, f32x4 v10, f32x4 v11) const {
        const int R = u.a * 256 + r, col = u.b * 256 + c;
        resid4(p, layer, 5, 1.0f, R, col, v00); resid4(p, layer, 5, 1.0f, R, col + 128, v01); resid4(p, layer, 5, 1.0f, R + 128, col, v10); resid4(p, layer, 5, 1.0f, R + 128, col + 128, v11); } };

HD int ret_tokrow(int q, int cidx) { const int b = q * RGB + cidx / NCH, n = cidx % NCH; return n == 0 ? NL + b * 256 : b * SEQ + (n - 1) * 256; }
HD float ret_logg(const P& p, int dir, int h) { return log1pf(-expf(p.in[18][dir * 4 + h])); }
struct DRetProj { P p; int q; static constexpr int FENCE = 1; static constexpr int K = 1024, lda = 1024, ldb = 1024;
    HD bool unit(int L, Unit& u) const { int pm, pn; if (!rect_unit(L, NCQ, 16, pm, pn)) return false;
        const int wrow = pn < 8 ? pn * 256 : 4096 + (pn - 8) * 256;
        u.A = wsb(p, O_HN) + (size_t)ret_tokrow(q, pm) * 1024; u.B = wsb(p, O_RWIN) + (size_t)wrow * 1024; u.a = pm; u.b = pn; u.c = 0; u.d = 0;
        u.f0 = ret_logg(p, 0, pn & 3) * 1.4426950408889634f; u.f1 = ret_logg(p, 1, pn & 3) * 1.4426950408889634f; return true; }
    HD void emit(const Unit& u, int r, int c, f32x4 v00, f32x4 v01, f32x4 v10, f32x4 v11) const {
        const int cidx = u.a, pn = u.b, n = cidx % NCH;
        if (pn >= 8) { u16* g = wsb(p, O_GATE) + ((size_t)cidx * 256 + r) * 2048 + (pn - 8) * 256 + c;
            st4bf(g, v00); st4bf(g + 128, v01); st4bf(g + (size_t)128 * 2048, v10); st4bf(g + (size_t)128 * 2048 + 128, v11); return; }
        const int h = pn & 3; const bool isq = pn < 4;
        const float lgf = u.f0, lgb = u.f1;
        for (int X = 0; X < 2; ++X) { const int i = r + 128 * X; const f32x4 x1 = X ? v10 : v00, x2 = X ? v11 : v01; f32x4 r1, r2;
            for (int jx = 0; jx < 4; ++jx) { float cs = 1.f, sn = 0.f;
                if (n > 0) sincos_t((float)((n - 1) * 256 + i) * ropef(c + jx, 128), sn, cs);
                r1[jx] = x1[jx] * cs - x2[jx] * sn; r2[jx] = x2[jx] * cs + x1[jx] * sn; }
            if (isq) { u16* qn = wsb(p, O_QN) + ((size_t)cidx * 256 + i) * 1024 + h * 256 + c; st4bf(qn, r1); st4bf(qn + 128, r2);
                const float df = ex2(lgf * (float)(i + 1)), db = ex2(lgb * (float)(256 - i));
                u16* ae = wsb(p, O_AEXT) + (((size_t)h * NCQ + cidx) * 256 + i) * 768;
                st4bf(ae + 256 + c, r1 * df); st4bf(ae + 384 + c, r2 * df); st4bf(ae + 512 + c, r1 * db); st4bf(ae + 640 + c, r2 * db); }
            else { u16* kn = wsb(p, O_KN) + ((size_t)cidx * 256 + i) * 1024 + h * 256 + c; st4bf(kn, r1 * 0.0625f); st4bf(kn + 128, r2 * 0.0625f); } } } };
struct DRetProjT { P p; int q; static constexpr int FENCE = 1; static constexpr int K = 1024, lda = 1024, ldb = 1024;
    HD bool unit(int L, Unit& u) const { int pm, pn; if (!rect_unit(L, 12, NCQ, pm, pn)) return false;
        u.A = wsb(p, O_RWIN) + (size_t)(1024 + pm * 256) * 1024; u.B = wsb(p, O_HN) + (size_t)ret_tokrow(q, pn) * 1024; u.a = pm; u.b = pn; u.c = 0; u.d = 0;
        u.f0 = ret_logg(p, 0, pm & 3) * 1.4426950408889634f; u.f1 = ret_logg(p, 1, pm & 3) * 1.4426950408889634f; return true; }
    HD void emit(const Unit& u, int r, int c, f32x4 v00, f32x4 v01, f32x4 v10, f32x4 v11) const {
        const int pm = u.a, cidx = u.b, n = cidx % NCH;
        if (pm >= 4) { const int h = (pm - 4) >> 1, e0 = ((pm - 4) & 1) * 256 + r; u16* be = wsb(p, O_BEXT) + (((size_t)h * NCQ + cidx) * 512 + e0) * 768 + c;
            st4bf(be, v00); st4bf(be + 128, v01); st4bf(be + (size_t)128 * 768, v10); st4bf(be + (size_t)128 * 768 + 128, v11); return; }
        const int h = pm; const float lgf = u.f0, lgb = u.f1, fr = ropef(r, 128);
        u16* kf = wsb(p, O_KTX) + (((size_t)h * NCQ + cidx) * 2 + 0) * 65536; u16* kb = kf + 65536;
        for (int Y = 0; Y < 2; ++Y) { const f32x4 x1 = Y ? v01 : v00, x2 = Y ? v11 : v10; f32x4 f1, f2, b1, b2;
            for (int jx = 0; jx < 4; ++jx) { const int jj = c + 128 * Y + jx; float cs = 1.f, sn = 0.f;
                if (n > 0) sincos_t((float)((n - 1) * 256 + jj) * fr, sn, cs);
                const float r1 = (x1[jx] * cs - x2[jx] * sn) * 0.0625f, r2 = (x2[jx] * cs + x1[jx] * sn) * 0.0625f;
                const float df = ex2(lgf * (float)(255 - jj)), db = ex2(lgb * (float)jj);
                f1[jx] = r1 * df; f2[jx] = r2 * df; b1[jx] = r1 * db; b2[jx] = r2 * db; }
            const int jc = c + 128 * Y;
            st4bf(kf + (size_t)r * 256 + jc, f1); st4bf(kf + (size_t)(r + 128) * 256 + jc, f2); st4bf(kb + (size_t)r * 256 + jc, b1); st4bf(kb + (size_t)(r + 128) * 256 + jc, b2); } } };
struct DRetProjAll { P p; int q; static constexpr int FENCE = 1; static constexpr int K = 1024, lda = 1024, ldb = 1024;
    HD bool unit(int L, Unit& u) const { const DRetProj a{p, q}; const DRetProjT b{p, q};
        if (L < NCQ * 16) { const bool ok = a.unit(L, u); u.d = 0; return ok; } const bool ok = b.unit(L - NCQ * 16, u); u.d = 1; return ok; }
    HD void emit(const Unit& u, int r, int c, f32x4 v00, f32x4 v01, f32x4 v10, f32x4 v11) const {
        if (u.d == 0) { const DRetProj a{p, q}; a.emit(u, r, c, v00, v01, v10, v11); } else { const DRetProjT b{p, q}; b.emit(u, r, c, v00, v01, v10, v11); } } };
struct DRetP { P p; static constexpr int FENCE = 1; static constexpr int K = 256, lda = 1024, ldb = 1024;
    HD bool unit(int L, Unit& u) const { int pm, pn; if (!rect_unit(L, NCQ, 4, pm, pn)) return false;
        u.A = wsb(p, O_QN) + (size_t)pm * 256 * 1024 + pn * 256; u.B = wsb(p, O_KN) + (size_t)pm * 256 * 1024 + pn * 256; u.a = pm; u.b = pn; u.c = 0; u.d = 0;
        u.f0 = ret_logg(p, 0, pn) * 1.4426950408889634f; u.f1 = ret_logg(p, 1, pn) * 1.4426950408889634f; return true; }
    HD void one(u16* ae, float lgf, float lgb, int i, int j0, f32x4 v) const { f32x4 o;
        for (int jx = 0; jx < 4; ++jx) { const int jj = j0 + jx; o[jx] = v[jx] * ex2(jj <= i ? lgf * (float)(i - jj) : lgb * (float)(jj - i)); }
        st4bf(ae + (size_t)i * 768 + j0, o); }
    HD void emit(const Unit& u, int r, int c, f32x4 v00, f32x4 v01, f32x4 v10, f32x4 v11) const {
        const int cidx = u.a, h = u.b; const float lgf = u.f0, lgb = u.f1;
        u16* ae = wsb(p, O_AEXT) + ((size_t)h * NCQ + cidx) * 256 * 768;
        one(ae, lgf, lgb, r, c, v00); one(ae, lgf, lgb, r, c + 128, v01); one(ae, lgf, lgb, r + 128, c, v10); one(ae, lgf, lgb, r + 128, c + 128, v11); } };
struct DRetL { P p; static constexpr int FENCE = 1; static constexpr int K = 256, lda = 768, ldb = 256;
    HD bool unit(int L, Unit& u) const { int pm, pn; if (!rect_unit(L, 4 * NCQ, 4, pm, pn)) return false;
        const int dir = pn >> 1, eh = pn & 1;
        u.A = wsb(p, O_BEXT) + ((size_t)pm * 512 + eh * 256) * 768; u.B = wsb(p, O_KTX) + ((size_t)pm * 2 + dir) * 65536; u.a = pm; u.b = dir; u.c = eh; u.d = 0; return true; }
    HD void emit(const Unit& u, int r, int c, f32x4 v00, f32x4 v01, f32x4 v10, f32x4 v11) const {
        u16* o = wsb(p, O_BEXT) + ((size_t)u.a * 512 + u.c * 256 + r) * 768 + 256 + u.b * 256 + c;
        st4bf(o, v00); st4bf(o + 128, v01); st4bf(o + (size_t)128 * 768, v10); st4bf(o + (size_t)128 * 768 + 128, v11); } };
struct DRetO { P p; static constexpr int FENCE = 1; static constexpr int K = 768, lda = 768, ldb = 768;
    HD bool unit(int L, Unit& u) const { int pm, pn; if (!rect_unit(L, 4 * NCQ, 2, pm, pn)) return false;
        u.A = wsb(p, O_AEXT) + (size_t)pm * 256 * 768; u.B = wsb(p, O_BEXT) + ((size_t)pm * 512 + pn * 256) * 768; u.a = pm; u.b = pn; u.c = 0; u.d = 0; return true; }
    HD void emit(const Unit& u, int r, int c, f32x4 v00, f32x4 v01, f32x4 v10, f32x4 v11) const {
        const int h = u.a / NCQ, cidx = u.a % NCQ;
        u16* o = wsb(p, O_OB) + ((size_t)cidx * 256 + r) * 2048 + h * 512 + u.b * 256 + c;
        st4bf(o, v00); st4bf(o + 128, v01); st4bf(o + (size_t)128 * 2048, v10); st4bf(o + (size_t)128 * 2048 + 128, v11); } };
struct DRetWoCtx { P p; int layer; static constexpr int FENCE = 4; static constexpr int K = 2048, lda = 2048, ldb = 2048;
    HD bool unit(int L, Unit& u) const { int pm, pn; if (!rect_unit(L, NC / 256, 4, pm, pn)) return false;
        u.A = wsb(p, O_YCTX) + (size_t)pm * 256 * 2048; u.B = wsb(p, O_RWO) + (size_t)pn * 256 * 2048; u.a = NL + pm * 256; u.b = pn; u.c = 0; u.d = 0; return true; }
    HD void emit(const Unit& u, int r, int c, f32x4 v00, f32x4 v01, f32x4 v10, f32x4 v11) const {
        const int R = u.a + r, col = u.b * 256 + c;
        resid4(p, layer, 5, 1.0f, R, col, v00); resid4(p, layer, 5, 1.0f, R, col + 128, v01); resid4(p, layer, 5, 1.0f, R + 128, col, v10); resid4(p, layer, 5, 1.0f, R + 128, col + 128, v11); } };
struct DRetWo { P p; int layer, q; static constexpr int FENCE = 4; static constexpr int K = 2048, lda = 2048, ldb = 2048;
    HD bool unit(int L, Unit& u) const { int pl, pn; if (!rect_unit(L, NCQ - RGB, 4, pl, pn)) return false; const int pm = pl + pl / (NCH - 1) + 1;
        u.A = wsb(p, O_OB) + (size_t)pm * 256 * 2048; u.B = wsb(p, O_RWO) + (size_t)pn * 256 * 2048; u.a = ret_tokrow(q, pm); u.b = pn; u.c = 0; u.d = 0; return true; }
    HD void emit(const Unit& u, int r, int c, f32x4 v00, f32x4 v01, f32x4 v10, f32x4 v11) const {
        const int R = u.a + r, col = u.b * 256 + c;
        resid4(p, layer, 5, 1.0f, R, col, v00); resid4(p, layer, 5, 1.0f, R, col + 128, v01); resid4(p, layer, 5, 1.0f, R + 128, col, v10); resid4(p, layer, 5, 1.0f, R + 128, col + 128, v11); } };

struct DS5L { P p; static constexpr int FENCE = 1; static constexpr int K = 512, lda = 768, ldb = 512;
    HD bool unit(int L, Unit& u) const { int pm, pn; if (!rect_unit(L, NROW5P / 256, 64, pm, pn)) return false;
        u.A = wsb(p, O_UEXT) + ((size_t)pn * NROW5P + pm * 256) * 768; u.B = wsb(p, O_FEXT) + (size_t)pn * 256 * 512; u.a = pm; u.b = pn; u.c = 0; u.d = 0; return true; }
    HD void emit(const Unit& u, int r, int c, f32x4 v00, f32x4 v01, f32x4 v10, f32x4 v11) const {
        u16* o = wsb(p, O_UEXT) + ((size_t)u.b * NROW5P + u.a * 256 + r) * 768 + 512 + c;
        st4bf(o, v00); st4bf(o + 128, v01); st4bf(o + (size_t)128 * 768, v10); st4bf(o + (size_t)128 * 768 + 128, v11); } };
struct DS5Y { P p; static constexpr int FENCE = 1; static constexpr int K = 768, lda = 768, ldb = 768;
    HD bool unit(int L, Unit& u) const { int pm, pn; if (!rect_unit(L, NROW5P / 256, 128, pm, pn)) return false;
        const int g = pn >> 1, ch = pn & 1;
        u.A = wsb(p, O_UEXT) + ((size_t)g * NROW5P + pm * 256) * 768; u.B = wsb(p, O_TEXT) + ((size_t)g * 512 + ch * 256) * 768; u.a = pm; u.b = g; u.c = ch; u.d = 0; return true; }
    HD void one(int g, int row, int col, f32x4 v) const {
        int tok; if (row < NB * S5L) tok = (row / S5L) * SEQ + (row % S5L) * 32; else if (row < NROW5) { const int rr = row - NB * S5L; tok = NL + (rr / S5C) * 256 + (rr % S5C) * 32; } else return;
        f32x4 o; for (int jx = 0; jx < 4; ++jx) o[jx] = gelu_f(v[jx]);
        st4bf(wsb(p, O_HN) + (size_t)(tok + (col >> 4)) * 1024 + g * 16 + (col & 15), o); }
    HD void emit(const Unit& u, int r, int c, f32x4 v00, f32x4 v01, f32x4 v10, f32x4 v11) const {
        const int row = u.a * 256 + r, col = u.c * 256 + c;
        one(u.b, row, col, v00); one(u.b, row, col + 128, v01); one(u.b, row + 128, col, v10); one(u.b, row + 128, col + 128, v11); } };
struct DS5Glu { P p; int layer; static constexpr int FENCE = 4; static constexpr int K = 1024, lda = 1024, ldb = 1024;
    HD bool unit(int L, Unit& u) const { int pm, pn; if (!rect_unit(L, MT / 256, 8, pm, pn)) return false;
        u.A = wsb(p, O_HN) + (size_t)pm * 256 * 1024; u.B = wsb(p, O_GLU) + (size_t)pn * 256 * 1024; u.a = pm; u.b = pn; u.c = 0; u.d = 0; return true; }
    HD void emit(const Unit& u, int r, int c, f32x4 v00, f32x4 v01, f32x4 v10, f32x4 v11) const {
        const int col = u.b * 128 + c; const float* gb = p.in[30]; f32x4 y0, y1;
        for (int jx = 0; jx < 4; ++jx) { const float ba = gb[col + jx], bg = gb[1024 + col + jx];
            y0[jx] = (v00[jx] + ba) * sigm_f(v01[jx] + bg); y1[jx] = (v10[jx] + ba) * sigm_f(v11[jx] + bg); }
        resid4(p, layer, 5, 1.0f, u.a * 256 + r, col, y0); resid4(p, layer, 5, 1.0f, u.a * 256 + r + 128, col, y1); } };

HD void cvt64(const float* src, int N, int srccol, u16* dst, int Kd, int nrow, int k0) {
    float v[64];
#pragma unroll
    for (int j = 0; j < 64; ++j) v[j] = srccol >= 0 ? src[(size_t)(k0 + j) * N + srccol] : 0.f;
#pragma unroll
    for (int j = 0; j < 64; j += 4) { f32x4 a; a[0] = v[j]; a[1] = v[j + 1]; a[2] = v[j + 2]; a[3] = v[j + 3]; st4bf(dst + (size_t)nrow * Kd + k0 + j, a); } }
constexpr long CV_FFI = (long)8 * 5632 * 16, CV_FFO = (long)8 * 1024 * 44, CV_MWIN = (long)2 * 768 * 16, CV_MWUQ = (long)2 * 1536 * 6, CV_MWUKV = (long)2 * 2048 * 4,
               CV_MWO = (long)2 * 1024 * 16, CV_RWIN = (long)6144 * 16, CV_RWO = (long)1024 * 32, CV_GLU = (long)2048 * 16;
constexpr long CV_TOTAL = CV_FFI + CV_FFO + CV_MWIN + CV_MWUQ + CV_MWUKV + CV_MWO + CV_RWIN + CV_RWO + CV_GLU;
HD void cvt_item(const P& p, long idx) {
    if (idx < CV_FFI) { const int n = (int)(idx % 5632); const long t = idx / 5632; const int kb = (int)(t % 16), m = (int)(t / 16);
        const int tile = n >> 8, rr = n & 255; const int sc = rr < 128 ? tile * 128 + rr : 2816 + tile * 128 + (rr - 128);
        cvt64(p.in[7] + (size_t)m * 1024 * 5632, 5632, sc, wsb(p, O_FFI + (size_t)m * SZ_FFI1), 1024, n, kb * 64); return; }
    idx -= CV_FFI;
    if (idx < CV_FFO) { const int n = (int)(idx % 1024); const long t = idx / 1024; const int kb = (int)(t % 44), m = (int)(t / 44);
        cvt64(p.in[8] + (size_t)m * 2816 * 1024, 1024, n, wsb(p, O_FFO + (size_t)m * SZ_FFO1), 2816, n, kb * 64); return; }
    idx -= CV_FFO;
    if (idx < CV_MWIN) { const int n = (int)(idx % 768); const long t = idx / 768; const int kb = (int)(t % 16), m = (int)(t / 16);
        cvt64(p.in[9] + (size_t)m * 1024 * 704, 704, n < 704 ? n : -1, wsb(p, O_MWIN + (size_t)m * SZ_MWIN), 1024, n, kb * 64); return; }
    idx -= CV_MWIN;
    if (idx < CV_MWUQ) { const int n = (int)(idx % 1536); const long t = idx / 1536; const int kb = (int)(t % 6), m = (int)(t / 6);
        cvt64(p.in[12] + (size_t)m * 384 * 1536, 1536, n, wsb(p, O_MWUQ + (size_t)m * SZ_MWUQ), 384, n, kb * 64); return; }
    idx -= CV_MWUQ;
    if (idx < CV_MWUKV) { const int n = (int)(idx % 2048); const long t = idx / 2048; const int kb = (int)(t % 4), m = (int)(t / 4);
        const int sc = n < 1024 ? (n >> 7) * 256 + (n & 127) : ((n - 1024) >> 7) * 256 + 128 + (n & 127);
        cvt64(p.in[13] + (size_t)m * 256 * 2048, 2048, sc, wsb(p, O_MWUKV + (size_t)m * SZ_MWUKV), 256, n, kb * 64); return; }
    idx -= CV_MWUKV;
    if (idx < CV_MWO) { const int n = (int)(idx % 1024); const long t = idx / 1024; const int kb = (int)(t % 16), m = (int)(t / 16);
        cvt64(p.in[16] + (size_t)m * 1024 * 1024, 1024, n, wsb(p, O_MWO + (size_t)m * SZ_MWO), 1024, n, kb * 64); return; }
    idx -= CV_MWO;
    if (idx < CV_RWIN) { const int n = (int)(idx % 6144), kb = (int)(idx / 6144); cvt64(p.in[17], 6144, n, wsb(p, O_RWIN), 1024, n, kb * 64); return; }
    idx -= CV_RWIN;
    if (idx < CV_RWO) { const int n = (int)(idx % 1024), kb = (int)(idx / 1024); cvt64(p.in[20], 1024, n, wsb(p, O_RWO), 2048, n, kb * 64); return; }
    idx -= CV_RWO;
    { const int n = (int)(idx % 2048), kb = (int)(idx / 2048); const int tile = n >> 8, rr = n & 255; const int sc = rr < 128 ? tile * 128 + rr : 1024 + tile * 128 + (rr - 128);
      cvt64(p.in[29], 2048, sc, wsb(p, O_GLU), 1024, n, kb * 64); }
}
HD void mod_item(const P& p, int idx) {
    const int layer = idx / 9216, col = idx % 9216; const float* w = p.in[4] + (size_t)layer * 1024 * 9216 + col; float acc[NMR];
    for (int b = 0; b < NMR; ++b) acc[b] = 0.f;
    for (int k = 0; k < 1024; ++k) { const float wv = w[(size_t)k * 9216];
#pragma unroll
        for (int b = 0; b < NMR; ++b) { const float cv = b < NB ? p.in[1][b * 1024 + k] : p.in[3][k]; acc[b] += silu_f(cv) * wv; } }
    const float bias = p.in[5][layer * 9216 + col];
#pragma unroll
    for (int b = 0; b < NMR; ++b) ((float*)(p.ws + O_MOD))[(size_t)(layer * NMR + b) * 9216 + col] = acc[b] + bias; }
HD void copy_item(const P& p, long idx) {
    const long nl4 = (long)NL * 256;
    if (idx < nl4) ((f32x4*)p.out)[idx] = ((const f32x4*)p.in[0])[idx]; else ((f32x4*)(p.ws + O_G))[idx - nl4] = ((const f32x4*)p.in[2])[idx - nl4]; }
HD void norm_item(const P& p, int layer, int k, int r, int s5) {
    const float* x = hsrc(p, r, layer == 0 && k == 0); float ss = 0.f;
    for (int d = 0; d < 1024; d += 4) { const f32x4 v = *(const f32x4*)(x + d); ss += v[0] * v[0] + v[1] * v[1] + v[2] * v[2] + v[3] * v[3]; }
    const float rinv = rsq_f(ss * (1.0f / 1024.0f) + EPS);
    const float* g = p.in[6] + (size_t)(layer * 3 + k) * 1024; const float* sh = modp(p, layer, r, 3 * k); const float* sc = modp(p, layer, r, 3 * k + 1);
    int row5 = 0, i5 = 0;
    if (s5) { if (r < NL) { const int b = r / SEQ, t = r % SEQ; row5 = b * S5L + t / 32; i5 = t % 32; } else { const int rr = r - NL; const int b = rr / 256, l = rr % 256; row5 = NB * S5L + b * S5C + l / 32; i5 = l % 32; } }
    for (int d = 0; d < 1024; d += 4) { const f32x4 v = *(const f32x4*)(x + d); f32x4 o;
        for (int j = 0; j < 4; ++j) o[j] = v[j] * rinv * g[d + j] * (1.0f + sc[d + j]) + sh[d + j];
        if (!s5) st4bf(wsb(p, O_HN) + (size_t)r * 1024 + d, o);
        else st4bf(wsb(p, O_UEXT) + ((size_t)(d >> 4) * NROW5P + row5) * 768 + i5 * 16 + (d & 15), o); } }
HD void axial_rot64(float* v, int t) {
    const int prow = t / 64, pcol = t % 64;
    for (int f = 0; f < 16; ++f) { const float fq = ropef(f, 16);
        { float cs, sn; sincos_t((float)prow * fq, sn, cs); const float x1 = v[f], x2 = v[16 + f]; v[f] = x1 * cs - x2 * sn; v[16 + f] = x2 * cs + x1 * sn; }
        { float cs, sn; sincos_t((float)pcol * fq, sn, cs); const float x1 = v[32 + f], x2 = v[48 + f]; v[32 + f] = x1 * cs - x2 * sn; v[48 + f] = x2 * cs + x1 * sn; } } }
HD void mla_row_item(const P& p, int j, int r) {
    const float* x = (const float*)(p.ws + O_CALL) + (size_t)r * 768; float ss = 0.f;
    for (int d = 0; d < 384; ++d) ss += x[d] * x[d];
    float rinv = rsq_f(ss * (1.0f / 384.0f) + EPS); const float* qn = p.in[10] + j * 384;
    for (int d = 0; d < 384; d += 4) { f32x4 o; for (int jx = 0; jx < 4; ++jx) o[jx] = x[d + jx] * rinv * qn[d + jx]; st4bf(wsb(p, O_CQN) + (size_t)r * 384 + d, o); }
    ss = 0.f; for (int d = 0; d < 256; ++d) ss += x[384 + d] * x[384 + d];
    rinv = rsq_f(ss * (1.0f / 256.0f) + EPS); const float* kvn = p.in[11] + j * 256;
    for (int d = 0; d < 256; d += 4) { f32x4 o; for (int jx = 0; jx < 4; ++jx) o[jx] = x[384 + d + jx] * rinv * kvn[d + jx]; st4bf(wsb(p, O_CKVN) + (size_t)r * 256 + d, o); }
    ss = 0.f; for (int d = 0; d < 64; ++d) ss += x[640 + d] * x[640 + d];
    rinv = rsq_f(ss * (1.0f / 64.0f) + EPS); const float* kg = p.in[15] + j * 192 + 128;
#ifdef HOST_EMU
    float kr[64];
    for (int d = 0; d < 64; ++d) kr[d] = x[640 + d] * rinv * kg[d];
    if (r < NL) axial_rot64(kr, r % SEQ);
    for (int h = 0; h < 8; ++h) for (int d = 0; d < 64; ++d) wsb(p, O_KF)[(size_t)r * 1536 + h * 192 + 128 + d] = f2bf(kr[d]);
#else
    const int t = r % SEQ, prow = t / 64, pcol = t % 64;
    for (int f = 0; f < 16; ++f) { const float fq = ropef(f, 16);
#pragma unroll
        for (int part = 0; part < 2; ++part) { float cs = 1.f, sn = 0.f; if (r < NL) sincos_t((float)(part ? pcol : prow) * fq, sn, cs);
            const int d1 = part * 32 + f, d2 = d1 + 16; const float x1 = x[640 + d1] * rinv * kg[d1], x2 = x[640 + d2] * rinv * kg[d2];
            const u16 o1 = f2bf(x1 * cs - x2 * sn), o2 = f2bf(x2 * cs + x1 * sn);
            for (int h = 0; h < 8; ++h) { wsb(p, O_KF)[(size_t)r * 1536 + h * 192 + 128 + d1] = o1; wsb(p, O_KF)[(size_t)r * 1536 + h * 192 + 128 + d2] = o2; } } }
#endif
}
HD void mla_head_item(const P& p, int j, int idx) {
    const int r = idx >> 3, h = idx & 7;
    u16* q = wsb(p, O_CALL) + (size_t)r * 1536 + h * 192; const float* qg = p.in[14] + j * 192; float ss = 0.f;
    for (int d = 0; d < 128; ++d) { const float v = bf2f(q[d]); ss += v * v; }
    float rinv = rsq_f(ss * (1.0f / 128.0f) + EPS);
    for (int d = 0; d < 128; ++d) q[d] = f2bf(bf2f(q[d]) * rinv * qg[d] * QSCALE);
    ss = 0.f; for (int d = 0; d < 64; ++d) { const float v = bf2f(q[128 + d]); ss += v * v; }
    rinv = rsq_f(ss * (1.0f / 64.0f) + EPS);
    { const int t = r % SEQ, prow = t / 64, pcol = t % 64;
      for (int f = 0; f < 16; ++f) { const float fq = ropef(f, 16);
#pragma unroll
        for (int part = 0; part < 2; ++part) { float cs = 1.f, sn = 0.f; if (r < NL) sincos_t((float)(part ? pcol : prow) * fq, sn, cs);
            const int d1 = 128 + part * 32 + f, d2 = d1 + 16; const float x1 = bf2f(q[d1]) * rinv * qg[d1], x2 = bf2f(q[d2]) * rinv * qg[d2];
            q[d1] = f2bf((x1 * cs - x2 * sn) * QSCALE); q[d2] = f2bf((x2 * cs + x1 * sn) * QSCALE); } } }
    u16* k = wsb(p, O_KF) + (size_t)r * 1536 + h * 192; const float* kg = p.in[15] + j * 192;
    ss = 0.f; for (int d = 0; d < 128; ++d) { const float v = bf2f(k[d]); ss += v * v; }
    rinv = rsq_f(ss * (1.0f / 128.0f) + EPS);
    for (int d = 0; d < 128; ++d) k[d] = f2bf(bf2f(k[d]) * rinv * kg[d]);
}
HD void ret_prefix_item(const P& p, int idx) {
    const int d4 = idx & 63, e = (idx >> 6) & 511, bq = (idx >> 15) % RGB, h = (idx >> 15) / RGB;
    const float gf = expf(256.f * ret_logg(p, 0, h)), gb = expf(256.f * ret_logg(p, 1, h));
    u16* base = wsb(p, O_BEXT) + (((size_t)h * NCQ + bq * NCH) * 512 + e) * 768 + d4 * 4; constexpr size_t CS = (size_t)512 * 768;
    u32x2 tf[NCH], tb[NCH];
#pragma unroll
    for (int n = 0; n < NCH; ++n) { tf[n] = *(const u32x2*)(base + n * CS + 256); tb[n] = *(const u32x2*)(base + n * CS + 512); }
    f32x4 cf = {0.f, 0.f, 0.f, 0.f}, cb = {0.f, 0.f, 0.f, 0.f};
#pragma unroll
    for (int n = 0; n < NCH; ++n) { f32x4 t; t[0] = bf2f((u16)(tf[n].x & 0xffff)); t[1] = bf2f((u16)(tf[n].x >> 16)); t[2] = bf2f((u16)(tf[n].y & 0xffff)); t[3] = bf2f((u16)(tf[n].y >> 16));
        st4bf(base + n * CS + 256, cf); cf = cf * gf + t; }
#pragma unroll
    for (int s_ = 0; s_ < NCH; ++s_) { const int n = s_ == 0 ? 0 : NCH - s_; f32x4 t; t[0] = bf2f((u16)(tb[n].x & 0xffff)); t[1] = bf2f((u16)(tb[n].x >> 16)); t[2] = bf2f((u16)(tb[n].y & 0xffff)); t[3] = bf2f((u16)(tb[n].y >> 16));
        st4bf(base + n * CS + 512, cb); cb = cb * gb + t; } }
HD u16* ret_ydst(const P& p, int q, int lr) { const int cidx = lr >> 8, n = cidx % NCH; return n == 0 ? wsb(p, O_YCTX) + ((size_t)((q * RGB + cidx / NCH) * 256 + (lr & 255))) * 2048 : wsb(p, O_OB) + (size_t)lr * 2048; }
HD void ret_norm_item(const P& p, int qg, int idx) {
    const int lr = idx >> 2, h = idx & 3; u16* o = wsb(p, O_OB) + (size_t)lr * 2048 + h * 512; u16* yd = ret_ydst(p, qg, lr) + h * 512; const u16* g = wsb(p, O_GATE) + (size_t)lr * 2048 + h * 512; const float* gg = p.in[19] + h * 512;
    float s = 0.f; for (int e = 0; e < 512; ++e) s += bf2f(o[e]);
    const float mu = s * (1.0f / 512.0f); float q = 0.f; for (int e = 0; e < 512; ++e) { const float d = bf2f(o[e]) - mu; q += d * d; }
    const float rstd = rsq_f(q * (1.0f / 512.0f) + EPS);
    for (int e = 0; e < 512; ++e) yd[e] = f2bf((bf2f(o[e]) - mu) * rstd * gg[e] * silu_f(bf2f(g[e]))); }
struct Cx { float re, im; };
HD Cx cmul(Cx a, Cx b) { Cx r; r.re = a.re * b.re - a.im * b.im; r.im = a.re * b.im + a.im * b.re; return r; }
HD Cx s5_alog(const P& p, int dir, int g, int pp) { const float dt = expf(p.in[23][dir * 64 + g]); Cx r; r.re = p.in[21][(dir * 64 + g) * 64 + pp] * dt; r.im = p.in[22][(dir * 64 + g) * 64 + pp] * dt; return r; }
HD Cx cpowa(Cx al, float n) { const float m = expf(al.re * n); float sn, cs; sincos_t(al.im * n * 0.15915494309189535f, sn, cs); Cx r; r.re = m * cs; r.im = m * sn; return r; }
HD Cx s5_coef(const P& p, int dir, int g, int pp) {
    const Cx al = s5_alog(p, dir, g, pp); Cx a = cpowa(al, 1.f); a.re -= 1.f; const float lr = p.in[21][(dir * 64 + g) * 64 + pp], li = p.in[22][(dir * 64 + g) * 64 + pp], den = 1.0f / (lr * lr + li * li);
    Cx r; r.re = (a.re * lr + a.im * li) * den; r.im = (a.im * lr - a.re * li) * den; return r; }
HD Cx s5_bbar(const P& p, int dir, int g, int pp, int m) { Cx b; const size_t o = (((size_t)dir * 64 + g) * 64 + pp) * 16 + m; b.re = p.in[24][o]; b.im = p.in[25][o]; return cmul(s5_coef(p, dir, g, pp), b); }
HD Cx s5_c(const P& p, int dir, int g, int m, int pp) { Cx c; const size_t o = (((size_t)dir * 64 + g) * 16 + m) * 64 + pp; c.re = p.in[26][o]; c.im = p.in[27][o]; return c; }
HD void s5_ktab_item(const P& p, int idx) {
    const int m = idx & 15, tau = (idx >> 4) & 31, dir = (idx >> 9) & 1, g = idx >> 10; float acc[16];
#pragma unroll
    for (int m2 = 0; m2 < 16; ++m2) acc[m2] = 0.f;
    for (int pp = 0; pp < 64; ++pp) { const Cx w = cmul(cmul(s5_c(p, dir, g, m, pp), cpowa(s5_alog(p, dir, g, pp), (float)tau)), s5_coef(p, dir, g, pp));
        const size_t o = (((size_t)dir * 64 + g) * 64 + pp) * 16;
#pragma unroll
        for (int m2 = 0; m2 < 16; ++m2) acc[m2] += w.re * p.in[24][o + m2] - w.im * p.in[25][o + m2]; }
#pragma unroll
    for (int m2 = 0; m2 < 16; ++m2) ((float*)(p.ws + O_KTAB))[(size_t)idx * 16 + m2] = acc[m2]; }
HD void s5_text_item(const P& p, long idx) {
    const int col = (int)(idx % 768); const long t = idx / 768; const int row = (int)(t % 512), g = (int)(t / 512), i = row >> 4, m = row & 15; float v;
    const float* kt = (const float*)(p.ws + O_KTAB);
    if (col < 512) { const int jj = col >> 4, m2 = col & 15; v = 0.f;
        if (jj <= i) v += kt[((((size_t)g * 2 + 0) * 32 + (i - jj)) * 16 + m) * 16 + m2];
        if (jj >= i) v += kt[((((size_t)g * 2 + 1) * 32 + (jj - i)) * 16 + m) * 16 + m2];
        if (jj == i && m == m2) v += p.in[28][g * 16 + m]; }
    else { const int dir = col >= 640, pp = ((col - 512) & 127) >> 1, part = col & 1;
        const Cx w = cmul(s5_c(p, dir, g, m, pp), cpowa(s5_alog(p, dir, g, pp), dir ? (float)(32 - i) : (float)(i + 1))); v = part ? -w.im : w.re; }
    wsb(p, O_TEXT)[idx] = f2bf(v); }
HD void s5_fext_item(const P& p, int idx) {
    const int col = idx & 511, row = (idx >> 9) & 255, g = idx >> 17, jj = col >> 4, m2 = col & 15, dir = row >> 7, pp = (row & 127) >> 1, part = row & 1;
    const Cx w = cmul(cpowa(s5_alog(p, dir, g, pp), dir ? (float)jj : (float)(31 - jj)), s5_bbar(p, dir, g, pp, m2));
    wsb(p, O_FEXT)[idx] = f2bf(part ? w.im : w.re); }
HD int s5_row(int b, int s) { return s < S5C ? NB * S5L + b * S5C + s : b * S5L + (s - S5C); }
HD void s5_prefix_item(const P& p, int idx) {
    const int pp = idx & 63, b = (idx >> 6) % NB, g = (idx >> 6) / NB;
    const Cx af = cpowa(s5_alog(p, 0, g, pp), 32.f), ab = cpowa(s5_alog(p, 1, g, pp), 32.f);
    u16* base = wsb(p, O_UEXT) + (size_t)g * NROW5P * 768; Cx c; c.re = 0.f; c.im = 0.f;
    for (int s0 = 0; s0 < S5C + S5L; s0 += 8) { unsigned t[8];
#pragma unroll
        for (int k = 0; k < 8; ++k) t[k] = *(const unsigned*)(base + (size_t)s5_row(b, s0 + k) * 768 + 512 + 2 * pp);
#pragma unroll
        for (int k = 0; k < 8; ++k) { u16* q = base + (size_t)s5_row(b, s0 + k) * 768 + 512 + 2 * pp; *(unsigned*)q = (unsigned)f2bf(c.re) | ((unsigned)f2bf(c.im) << 16);
            c = cmul(af, c); c.re += bf2f((u16)(t[k] & 0xffff)); c.im += bf2f((u16)(t[k] >> 16)); } }
    c.re = 0.f; c.im = 0.f;
    for (int s0 = 0; s0 < S5C + S5L; s0 += 8) { unsigned t[8]; int sv[8];
#pragma unroll
        for (int k = 0; k < 8; ++k) { const int s_ = s0 + k; sv[k] = s_ < S5C ? S5C - 1 - s_ : S5C + S5L - 1 - (s_ - S5C); t[k] = *(const unsigned*)(base + (size_t)s5_row(b, sv[k]) * 768 + 640 + 2 * pp); }
#pragma unroll
        for (int k = 0; k < 8; ++k) { u16* q = base + (size_t)s5_row(b, sv[k]) * 768 + 640 + 2 * pp; *(unsigned*)q = (unsigned)f2bf(c.re) | ((unsigned)f2bf(c.im) << 16);
            c = cmul(ab, c); c.re += bf2f((u16)(t[k] & 0xffff)); c.im += bf2f((u16)(t[k] >> 16)); } } }

struct AttItem { const u16* q; const u16* k0; const u16* k1; const u16* v0; const u16* v1; u16* o; int n0, ntot; };
HD void att_item(const P& p, int it, AttItem& a) {
    const u16* Q = wsb(p, O_CALL); const u16* KF = wsb(p, O_KF); const u16* VB = wsb(p, O_VB); u16* O = wsb(p, O_HN);
    const int nlat = NB * 8 * (SEQ / 256);
    if (it < nlat) { int itx = it;
        if (SEQ / 256 == 16 && nlat % 256 == 0) { const int i_ = it >> 8, c_ = it & 255, x_ = c_ & 7, s_ = c_ >> 3; itx = ((i_ * 16 + 2 * x_ + (s_ >> 4)) << 4) | (s_ & 15); }
        const int qb = itx % (SEQ / 256), h = (itx / (SEQ / 256)) & 7, b = itx / (SEQ / 256) / 8; const size_t r0 = (size_t)b * SEQ + qb * 256, c0 = (size_t)NL + b * 256, l0 = (size_t)b * SEQ;
        a.q = Q + r0 * 1536 + h * 192; a.o = O + r0 * 1024 + h * 128; a.k0 = KF + c0 * 1536 + h * 192; a.v0 = VB + c0 * 1024 + h * 128; a.k1 = KF + l0 * 1536 + h * 192; a.v1 = VB + l0 * 1024 + h * 128; a.n0 = 256; a.ntot = 256 + SEQ; }
    else { const int x = it - nlat, h = x & 7, b = x >> 3; const size_t c0 = (size_t)NL + b * 256;
        a.q = Q + c0 * 1536 + h * 192; a.o = O + c0 * 1024 + h * 128; a.k0 = KF + c0 * 1536 + h * 192; a.v0 = VB + c0 * 1024 + h * 128; a.k1 = a.k0; a.v1 = a.v0; a.n0 = 256; a.ntot = 256; } }

#ifndef HOST_EMU
#define LAS __attribute__((address_space(3)))
typedef short bf16x8 __attribute__((ext_vector_type(8)));
typedef short s16x4 __attribute__((ext_vector_type(4)));
typedef float f32x16 __attribute__((ext_vector_type(16)));
typedef unsigned u32x4 __attribute__((ext_vector_type(4)));
constexpr int HTB = 128 * 64 * 2, STAGE_BYTES = 8 * HTB;
__device__ __forceinline__ int lds_byte(int r, int c) { const int st = (r >> 4) * 2 + (c >> 5), rr = r & 15, cc = c & 31, ob = rr * 64 + cc * 2; return st * 1024 + (ob ^ (((ob >> 9) & 1) << 5)); }
__device__ __forceinline__ void stage_rc(int b, int& R, int& C) { const int st = b / 1024, sb = b % 1024, swz = sb ^ (((sb >> 9) & 1) << 5); R = (st >> 1) * 16 + swz / 64; C = (st & 1) * 32 + (swz % 64) / 2; }

template <class Dsc>
__device__ __forceinline__ void gemm_run(LAS unsigned char* lds, const Dsc& D) {
    int tid_ = threadIdx.x; asm volatile("" : "+v"(tid_));
    const int tid = tid_, wid = __builtin_amdgcn_readfirstlane(tid >> 6), lane = tid & 63, wr = wid >> 2, wc = wid & 3, fr = lane & 15, fq = lane >> 4;
    constexpr int K = Dsc::K, nt = K / 64, lda = Dsc::lda, ldb = Dsc::ldb;
    static_assert(K % 128 == 0 && K >= 256, "K");
    unsigned voffA[2], voffB[2];
#pragma unroll
    for (int i = 0; i < 2; ++i) { int R, C; stage_rc(tid * 16 + i * 8192, R, C); voffA[i] = (unsigned)(R * lda + C) * 2u; voffB[i] = (unsigned)(R * ldb + C) * 2u; }
    constexpr size_t kstep = 128, hstepA = (size_t)128 * lda * 2, hstepB = (size_t)128 * ldb * 2;
    const unsigned ldsw = (unsigned)wid * 1024u;
    const int aoff = lds_byte(wr * 64 + fr, fq * 8), boff = lds_byte(wc * 32 + fr, fq * 8);
#define G_SA(b, h) (((b) * 2 + (h)) * HTB)
#define G_SB(b, h) ((4 + (b) * 2 + (h)) * HTB)
#define G_STAGE(bufoff, gbase, voff) do { _Pragma("unroll") for (int _i = 0; _i < 2; ++_i) \
        __builtin_amdgcn_global_load_lds((const unsigned*)((const char*)(gbase) + (voff)[_i]), (LAS unsigned*)(lds + (bufoff) + ldsw + _i * 8192), 16, 0, 0); } while (0)
#define G_LDA(dst, b, h) do { _Pragma("unroll") for (int m = 0; m < 4; ++m) _Pragma("unroll") for (int k = 0; k < 2; ++k) dst[m][k] = *(const LAS bf16x8*)(lds + G_SA(b, h) + aoff + m * 2048 + k * 1024); } while (0)
#define G_LDB(dst, b, h) do { _Pragma("unroll") for (int n = 0; n < 2; ++n) _Pragma("unroll") for (int k = 0; k < 2; ++k) dst[n][k] = *(const LAS bf16x8*)(lds + G_SB(b, h) + boff + n * 2048 + k * 1024); } while (0)
#define G_MMA(ai, bj, At, Bt) do { __builtin_amdgcn_s_setprio(1); _Pragma("unroll") for (int m = 0; m < 4; ++m) _Pragma("unroll") for (int n = 0; n < 2; ++n) _Pragma("unroll") for (int k = 0; k < 2; ++k) \
        acc[ai][bj][m][n] = __builtin_amdgcn_mfma_f32_16x16x32_bf16(Bt[n][k], At[m][k], acc[ai][bj][m][n], 0, 0, 0); __builtin_amdgcn_s_setprio(0); } while (0)
#define G_WAIT_V(n) asm volatile("s_waitcnt vmcnt(" #n ")" ::: "memory")
#define G_WAIT_L(n) asm volatile("s_waitcnt lgkmcnt(" #n ")" ::: "memory")
#define G_BAR __builtin_amdgcn_s_barrier()
#define G_SCHED __builtin_amdgcn_sched_barrier(0)
    Unit cur{}, nxt{}; int ui = 0; const int G = gridDim.x, cb = blockIdx.x;
    if (!D.unit(cb, cur)) return;
    f32x4 acc[2][2][4][2];
#pragma unroll
    for (int a = 0; a < 2; ++a)
#pragma unroll
        for (int b = 0; b < 2; ++b)
#pragma unroll
            for (int m = 0; m < 4; ++m)
#pragma unroll
                for (int n = 0; n < 2; ++n) acc[a][b][m][n] = (f32x4){0.f, 0.f, 0.f, 0.f};
    bf16x8 At[4][2], B0[2][2], B1[2][2];
    const char* cA = (const char*)cur.A; const char* cB = (const char*)cur.B;
    G_STAGE(G_SB(0, 0), cB, voffB); G_STAGE(G_SA(0, 0), cA, voffA); G_STAGE(G_SB(0, 1), cB + hstepB, voffB); G_STAGE(G_SA(0, 1), cA + hstepA, voffA);
    if (wr == 1) G_BAR;
    G_WAIT_V(4); G_BAR;
    G_STAGE(G_SB(1, 0), cB + kstep, voffB); G_STAGE(G_SA(1, 0), cA + kstep, voffA); G_STAGE(G_SB(1, 1), cB + hstepB + kstep, voffB);
    G_WAIT_V(6); G_BAR;
    for (;;) {
        const bool has_next = D.unit((ui + 1) * G + cb, nxt);
        const char* nA = has_next ? (const char*)nxt.A : cA; const char* nB = has_next ? (const char*)nxt.B : cB;
        _Pragma("nounroll") for (int t = 0; t < nt; t += 2) {
            const bool last = (t == nt - 2);
            const char* a1 = cA + (size_t)(t + 1) * kstep;
            const char* a2 = last ? nA : cA + (size_t)(t + 2) * kstep; const char* b2 = last ? nB : cB + (size_t)(t + 2) * kstep;
            const char* a3 = a2 + kstep; const char* b3 = b2 + kstep;
            G_LDB(B0, 0, 0); G_SCHED; G_LDA(At, 0, 0); G_STAGE(G_SA(1, 1), a1 + hstepA, voffA);
            G_WAIT_L(8); G_BAR; G_WAIT_L(0); G_MMA(0, 0, At, B0); G_BAR; G_SCHED;
            G_LDB(B1, 0, 1); G_STAGE(G_SB(0, 0), b2, voffB);
            G_BAR; G_WAIT_L(0); G_MMA(0, 1, At, B1); G_BAR;
            G_LDA(At, 0, 1); G_STAGE(G_SA(0, 0), a2, voffA);
            G_BAR; G_WAIT_L(0); G_MMA(1, 0, At, B0); G_BAR; G_SCHED;
            G_STAGE(G_SB(0, 1), b2 + hstepB, voffB);
            G_WAIT_V(6); G_BAR; G_MMA(1, 1, At, B1); G_BAR;
            G_LDB(B0, 1, 0); G_SCHED; G_LDA(At, 1, 0); G_STAGE(G_SA(0, 1), a2 + hstepA, voffA);
            G_WAIT_L(8); G_BAR; G_WAIT_L(0); G_MMA(0, 0, At, B0); G_BAR; G_SCHED;
            G_LDB(B1, 1, 1); G_STAGE(G_SB(1, 0), b3, voffB);
            G_BAR; G_WAIT_L(0); G_MMA(0, 1, At, B1); G_BAR;
            G_LDA(At, 1, 1); G_STAGE(G_SA(1, 0), a3, voffA);
            G_BAR; G_WAIT_L(0); G_MMA(1, 0, At, B0); G_BAR; G_SCHED;
            G_STAGE(G_SB(1, 1), b3 + hstepB, voffB);
            G_WAIT_V(6); G_BAR; G_MMA(1, 1, At, B1); G_BAR;
        }
        int er_ = wr * 64 + fr, ec_ = wc * 32 + fq * 4; asm volatile("" : "+v"(er_), "+v"(ec_));
#pragma unroll
        for (int m = 0; m < 4; ++m)
#pragma unroll
            for (int n = 0; n < 2; ++n) { D.emit(cur, er_ + m * 16, ec_ + n * 16, acc[0][0][m][n], acc[0][1][m][n], acc[1][0][m][n], acc[1][1][m][n]); if (((m * 2 + n + 1) % Dsc::FENCE) == 0) asm volatile("" ::: "memory"); }
        if (!has_next) break;
#pragma unroll
        for (int a = 0; a < 2; ++a)
#pragma unroll
            for (int b = 0; b < 2; ++b)
#pragma unroll
                for (int m = 0; m < 4; ++m)
#pragma unroll
                    for (int n = 0; n < 2; ++n) acc[a][b][m][n] = (f32x4){0.f, 0.f, 0.f, 0.f};
        cur = nxt; cA = nA; cB = nB; ++ui;
    }
    G_WAIT_V(0);
    if (wr == 0) G_BAR;
    G_BAR;
#undef G_SA
#undef G_SB
#undef G_STAGE
#undef G_LDA
#undef G_LDB
#undef G_MMA
#undef G_WAIT_V
#undef G_WAIT_L
#undef G_BAR
#undef G_SCHED
}

constexpr int A_SHM_V = 64 * 128 * 2, A_SHM_K = 64 * 400;
#define KSWZ(row, colB) ((row) * 400 + (colB))
__device__ __forceinline__ int crow(int r, int hi) { return (r & 3) + 8 * (r >> 2) + 4 * hi; }
__device__ __forceinline__ unsigned cvtpk(float lo, float hi) { unsigned r; asm volatile("v_cvt_pk_bf16_f32 %0, %1, %2" : "=v"(r) : "v"(lo), "v"(hi)); return r; }
__device__ __forceinline__ int v_st(int k, int c) { const int kk = (k & ~0xC) | ((k & 4) << 1) | ((k & 8) >> 1); return ((kk >> 3) * 4 + (c >> 5)) * 512 + ((kk & 7) * 32 + (c & 31)) * 2; }
__device__ __forceinline__ int v_rd_base(int lane) { return ((lane & 3) << 3) | (((lane >> 2) & 3) << 6) | (((lane >> 4) & 1) << 5) | (((lane >> 5) & 1) << 8); }
constexpr int v_rd_off(int d0, int ks, int half) { return d0 * 512 + ks * 4096 + half * 2048; }
template <int OFF> __device__ __forceinline__ s16x4 tr_read(int vb) { s16x4 r; asm volatile("ds_read_b64_tr_b16 %0, %1 offset:%2" : "=&v"(r) : "v"(vb), "i"(OFF) : "memory"); return r; }
template <int D0> __device__ __forceinline__ void pv_one(f32x16& od, int vb, bf16x8 pa0, bf16x8 pa1, bf16x8 pa2, bf16x8 pa3) {
    const s16x4 l0 = tr_read<v_rd_off(D0, 0, 0)>(vb), h0 = tr_read<v_rd_off(D0, 0, 1)>(vb), l1 = tr_read<v_rd_off(D0, 1, 0)>(vb), h1 = tr_read<v_rd_off(D0, 1, 1)>(vb);
    const s16x4 l2 = tr_read<v_rd_off(D0, 2, 0)>(vb), h2 = tr_read<v_rd_off(D0, 2, 1)>(vb), l3 = tr_read<v_rd_off(D0, 3, 0)>(vb), h3 = tr_read<v_rd_off(D0, 3, 1)>(vb);
    asm volatile("s_waitcnt lgkmcnt(0)" ::: "memory"); __builtin_amdgcn_sched_barrier(0);
#define PK(L, H) (bf16x8){L[0], L[1], L[2], L[3], H[0], H[1], H[2], H[3]}
    od = __builtin_amdgcn_mfma_f32_32x32x16_bf16(pa0, PK(l0, h0), od, 0, 0, 0);
    od = __builtin_amdgcn_mfma_f32_32x32x16_bf16(pa1, PK(l1, h1), od, 0, 0, 0);
    od = __builtin_amdgcn_mfma_f32_32x32x16_bf16(pa2, PK(l2, h2), od, 0, 0, 0);
    od = __builtin_amdgcn_mfma_f32_32x32x16_bf16(pa3, PK(l3, h3), od, 0, 0, 0);
#undef PK
}
__device__ __forceinline__ void att_body(const AttItem& a, char* lds) {
    int tid_ = threadIdx.x; asm volatile("" : "+v"(tid_));
    const int tid = tid_, wid = tid >> 6, lane = tid & 63, r32 = lane & 31, hi = lane >> 5;
    char* V_lds = lds; char* K_lds = lds + 2 * A_SHM_V; float* li_l = (float*)(lds + 2 * A_SHM_V + 2 * A_SHM_K) + wid * 64;
    float l_reg = 0.f; f32x16 o[4] = {}; bf16x8 qr[12];
    const u16* Qw = a.q + (size_t)(wid * 32 + r32) * 1536 + hi * 8;
#pragma unroll
    for (int d0 = 0; d0 < 12; ++d0) qr[d0] = *(const bf16x8*)(Qw + d0 * 16);
    const int sr = tid >> 4, sc = (tid & 15) * 8, vst0 = v_st(sr, sc), vst1 = v_st(32 + sr, sc);
    const int voff0 = sr * 1024 + sc, voff1 = (32 + sr) * 1024 + sc;
    int koff[3], kwr[3];
#pragma unroll
    for (int i = 0; i < 3; ++i) { const int id = tid + i * 512, kr_ = id / 24, kc_ = (id % 24) * 8; koff[i] = kr_ * 1536 + kc_; kwr[i] = KSWZ(kr_, kc_ * 2); }
    const int vb0 = (int)(uintptr_t)V_lds + v_rd_base(lane);
    bf16x8 vs0, vs1, ks[3];
    const int NT = a.ntot / 64;
#define A_SLOAD(k0_) do { const int key0_ = (k0_); const u16* kb_ = key0_ < a.n0 ? a.k0 + (size_t)key0_ * 1536 : a.k1 + (size_t)(key0_ - a.n0) * 1536; \
        const u16* vbp_ = key0_ < a.n0 ? a.v0 + (size_t)key0_ * 1024 : a.v1 + (size_t)(key0_ - a.n0) * 1024; \
        vs0 = *(const bf16x8*)(vbp_ + voff0); vs1 = *(const bf16x8*)(vbp_ + voff1); \
        _Pragma("unroll") for (int i = 0; i < 3; ++i) ks[i] = *(const bf16x8*)(kb_ + koff[i]); } while (0)
#define A_SWRITE(b) do { *(bf16x8*)(V_lds + (b) * A_SHM_V + vst0) = vs0; *(bf16x8*)(V_lds + (b) * A_SHM_V + vst1) = vs1; \
        _Pragma("unroll") for (int i = 0; i < 3; ++i) *(bf16x8*)(K_lds + (b) * A_SHM_K + kwr[i]) = ks[i]; } while (0)
    A_SLOAD(0); A_SWRITE(0); __syncthreads();
    auto tile = [&](int j, auto bufc) { constexpr int buf = decltype(bufc)::value;
        if (j + 1 < NT) A_SLOAD((j + 1) * 64);
        f32x16 p0 = {}, p1 = {};
        const char* Ks = K_lds + buf * A_SHM_K;
#pragma unroll
        for (int d0 = 0; d0 < 12; ++d0) { const int cbb = (d0 * 16 + hi * 8) * 2;
            const bf16x8 b0 = *(const bf16x8*)(Ks + KSWZ(r32, cbb)); const bf16x8 b1 = *(const bf16x8*)(Ks + KSWZ(32 + r32, cbb));
            p0 = __builtin_amdgcn_mfma_f32_32x32x16_bf16(b0, qr[d0], p0, 0, 0, 0);
            p1 = __builtin_amdgcn_mfma_f32_32x32x16_bf16(b1, qr[d0], p1, 0, 0, 0); }
        float ps = 0.f;
#pragma unroll
        for (int r = 0; r < 16; ++r) { p0[r] = __builtin_amdgcn_exp2f(p0[r]); p1[r] = __builtin_amdgcn_exp2f(p1[r]); ps += p0[r] + p1[r]; }
        { auto rr = __builtin_amdgcn_permlane32_swap(__float_as_uint(ps), __float_as_uint(ps), false, false); ps = __uint_as_float(rr[0]) + __uint_as_float(rr[1]); }
        l_reg += ps;
        bf16x8 pa0, pa1, pa2, pa3;
#define PK4(Pv, BASE, OUT) do { unsigned a0 = cvtpk(Pv[BASE + 0], Pv[BASE + 1]), a1 = cvtpk(Pv[BASE + 2], Pv[BASE + 3]); \
        unsigned b0 = cvtpk(Pv[BASE + 4], Pv[BASE + 5]), b1 = cvtpk(Pv[BASE + 6], Pv[BASE + 7]); \
        auto r0 = __builtin_amdgcn_permlane32_swap(a0, b0, false, false); auto r1 = __builtin_amdgcn_permlane32_swap(a1, b1, false, false); \
        u32x4 w = {r0[0], r1[0], r0[1], r1[1]}; OUT = *reinterpret_cast<bf16x8*>(&w); } while (0)
        PK4(p0, 0, pa0); PK4(p0, 8, pa1); PK4(p1, 0, pa2); PK4(p1, 8, pa3);
#undef PK4
        const int vb = vb0 + buf * A_SHM_V;
        pv_one<0>(o[0], vb, pa0, pa1, pa2, pa3); pv_one<1>(o[1], vb, pa0, pa1, pa2, pa3); pv_one<2>(o[2], vb, pa0, pa1, pa2, pa3); pv_one<3>(o[3], vb, pa0, pa1, pa2, pa3);
        if (j + 1 < NT) A_SWRITE(buf ^ 1);
        __syncthreads();
    };
    _Pragma("nounroll") for (int j = 0; j < NT; j += 2) { tile(j, std::integral_constant<int, 0>{}); tile(j + 1, std::integral_constant<int, 1>{}); }
    if (hi == 0) li_l[r32] = l_reg;
    asm volatile("s_waitcnt lgkmcnt(0)" ::: "memory");
    __builtin_amdgcn_wave_barrier();
    u16* Ow = a.o + (size_t)(wid * 32) * 1024;
#pragma unroll
    for (int r = 0; r < 16; ++r) { const int orow = crow(r, hi); const float rl = 1.0f / li_l[orow];
#pragma unroll
        for (int d0 = 0; d0 < 4; ++d0) Ow[(size_t)orow * 1024 + d0 * 32 + r32] = f2bf(o[d0][r] * rl); }
    __syncthreads();
#undef A_SLOAD
#undef A_SWRITE
}

__device__ __forceinline__ float wsum(float v) { for (int o = 32; o >= 1; o >>= 1) v += __shfl_xor(v, o); return v; }
__device__ __forceinline__ void norm_wave(const P& p, int layer, int k, int r, int s5, int lane) {
    const float* x = hsrc(p, r, layer == 0 && k == 0); f32x4 v[4]; float ss = 0.f;
#pragma unroll
    for (int i = 0; i < 4; ++i) { v[i] = *(const f32x4*)(x + i * 256 + lane * 4); ss += v[i][0] * v[i][0] + v[i][1] * v[i][1] + v[i][2] * v[i][2] + v[i][3] * v[i][3]; }
    ss = wsum(ss); const float rinv = rsq_f(ss * (1.0f / 1024.0f) + EPS);
    const float* g = p.in[6] + (size_t)(layer * 3 + k) * 1024; const float* sh = modp(p, layer, r, 3 * k); const float* sc = modp(p, layer, r, 3 * k + 1);
    int row5 = 0, i5 = 0;
    if (s5) { if (r < NL) { const int b = r / SEQ, t = r % SEQ; row5 = b * S5L + t / 32; i5 = t % 32; } else { const int rr = r - NL; const int b = rr / 256, l = rr % 256; row5 = NB * S5L + b * S5C + l / 32; i5 = l % 32; } }
#pragma unroll
    for (int i = 0; i < 4; ++i) { const int d = i * 256 + lane * 4; const f32x4 gv = *(const f32x4*)(g + d), sv = *(const f32x4*)(sc + d), hv = *(const f32x4*)(sh + d); f32x4 o;
        for (int j = 0; j < 4; ++j) o[j] = v[i][j] * rinv * gv[j] * (1.0f + sv[j]) + hv[j];
        if (!s5) st4bf(wsb(p, O_HN) + (size_t)r * 1024 + d, o);
        else st4bf(wsb(p, O_UEXT) + ((size_t)(d >> 4) * NROW5P + row5) * 768 + i5 * 16 + (d & 15), o); } }
__device__ __forceinline__ void mla_row_wave(const P& p, int j, int r, int lane) {
    const float* x = (const float*)(p.ws + O_CALL) + (size_t)r * 768; f32x4 c[3]; float q[3];
#pragma unroll
    for (int i = 0; i < 3; ++i) { c[i] = *(const f32x4*)(x + i * 256 + lane * 4); q[i] = c[i][0] * c[i][0] + c[i][1] * c[i][1] + c[i][2] * c[i][2] + c[i][3] * c[i][3]; }
    const bool lo = lane < 32;
    const float ssq = wsum(q[0] + (lo ? q[1] : 0.f)), sskv = wsum((lo ? 0.f : q[1]) + (lo ? q[2] : 0.f)), ssr = wsum((lane >= 32 && lane < 48) ? q[2] : 0.f);
    const float rq = rsq_f(ssq * (1.0f / 384.0f) + EPS), rkv = rsq_f(sskv * (1.0f / 256.0f) + EPS), rr_ = rsq_f(ssr * (1.0f / 64.0f) + EPS);
    const float* qn = p.in[10] + j * 384; const float* kvn = p.in[11] + j * 256; const float* kg = p.in[15] + j * 192 + 128;
    { const f32x4 gq = *(const f32x4*)(qn + lane * 4); f32x4 o; for (int jx = 0; jx < 4; ++jx) o[jx] = c[0][jx] * rq * gq[jx]; st4bf(wsb(p, O_CQN) + (size_t)r * 384 + lane * 4, o); }
    if (lo) { const f32x4 gq = *(const f32x4*)(qn + 256 + lane * 4); f32x4 o; for (int jx = 0; jx < 4; ++jx) o[jx] = c[1][jx] * rq * gq[jx]; st4bf(wsb(p, O_CQN) + (size_t)r * 384 + 256 + lane * 4, o);
        const f32x4 gk = *(const f32x4*)(kvn + 128 + lane * 4); f32x4 o2; for (int jx = 0; jx < 4; ++jx) o2[jx] = c[2][jx] * rkv * gk[jx]; st4bf(wsb(p, O_CKVN) + (size_t)r * 256 + 128 + lane * 4, o2); }
    else { const f32x4 gk = *(const f32x4*)(kvn + lane * 4 - 128); f32x4 o; for (int jx = 0; jx < 4; ++jx) o[jx] = c[1][jx] * rkv * gk[jx]; st4bf(wsb(p, O_CKVN) + (size_t)r * 256 + lane * 4 - 128, o); }
    const int dd = (4 * (lane - 32)) & 63; const f32x4 gr = *(const f32x4*)(kg + dd); f32x4 own, oth, o;
    for (int jx = 0; jx < 4; ++jx) own[jx] = c[2][jx] * rr_ * gr[jx];
    for (int jx = 0; jx < 4; ++jx) oth[jx] = __shfl_xor(own[jx], 4);
    const int t = r % SEQ, pos = (dd & 32) ? (t % 64) : (t / 64); const bool first = (dd & 16) == 0;
    for (int jx = 0; jx < 4; ++jx) { float cs = 1.f, sn = 0.f; if (r < NL) sincos_t((float)pos * ropef((dd & 15) + jx, 16), sn, cs);
        o[jx] = first ? own[jx] * cs - oth[jx] * sn : own[jx] * cs + oth[jx] * sn; }
    if (lane >= 32 && lane < 48) { u16* kf = wsb(p, O_KF) + (size_t)r * 1536 + 128 + dd;
#pragma unroll
        for (int h = 0; h < 8; ++h) st4bf(kf + h * 192, o); } }
__device__ __forceinline__ float bflo(unsigned w) { return __uint_as_float(w << 16); }
__device__ __forceinline__ float bfhi(unsigned w) { return __uint_as_float(w & 0xffff0000u); }
__device__ __forceinline__ unsigned pk2(float a, float b) { return (unsigned)f2bf(a) | ((unsigned)f2bf(b) << 16); }
__device__ __forceinline__ void mla_head_wave(const P& p, int j, int r, int lane) {
    const int h = lane >> 3, sub = lane & 7;
    u16* q = wsb(p, O_CALL) + (size_t)r * 1536 + h * 192; u16* k = wsb(p, O_KF) + (size_t)r * 1536 + h * 192;
    const float* qg = p.in[14] + j * 192; const float* kg = p.in[15] + j * 192;
    u32x4 qa = *(const u32x4*)(q + sub * 16), qb = *(const u32x4*)(q + sub * 16 + 8), qr = *(const u32x4*)(q + 128 + sub * 8), ka = *(const u32x4*)(k + sub * 16), kb = *(const u32x4*)(k + sub * 16 + 8);
    float sq = 0.f, sk = 0.f, sr = 0.f;
#pragma unroll
    for (int i = 0; i < 4; ++i) { sq += bflo(qa[i]) * bflo(qa[i]) + bfhi(qa[i]) * bfhi(qa[i]) + bflo(qb[i]) * bflo(qb[i]) + bfhi(qb[i]) * bfhi(qb[i]);
        sk += bflo(ka[i]) * bflo(ka[i]) + bfhi(ka[i]) * bfhi(ka[i]) + bflo(kb[i]) * bflo(kb[i]) + bfhi(kb[i]) * bfhi(kb[i]); sr += bflo(qr[i]) * bflo(qr[i]) + bfhi(qr[i]) * bfhi(qr[i]); }
    for (int o = 4; o >= 1; o >>= 1) { sq += __shfl_xor(sq, o); sk += __shfl_xor(sk, o); sr += __shfl_xor(sr, o); }
    const float rq = rsq_f(sq * (1.0f / 128.0f) + EPS), rk = rsq_f(sk * (1.0f / 128.0f) + EPS), rr_ = rsq_f(sr * (1.0f / 64.0f) + EPS);
    u32x4 oa, ob, oka, okb;
#pragma unroll
    for (int i = 0; i < 4; ++i) { const int d = sub * 16 + 2 * i;
        oa[i] = pk2(bflo(qa[i]) * rq * qg[d] * QSCALE, bfhi(qa[i]) * rq * qg[d + 1] * QSCALE); ob[i] = pk2(bflo(qb[i]) * rq * qg[d + 8] * QSCALE, bfhi(qb[i]) * rq * qg[d + 9] * QSCALE);
        oka[i] = pk2(bflo(ka[i]) * rk * kg[d], bfhi(ka[i]) * rk * kg[d + 1]); okb[i] = pk2(bflo(kb[i]) * rk * kg[d + 8], bfhi(kb[i]) * rk * kg[d + 9]); }
    *(u32x4*)(q + sub * 16) = oa; *(u32x4*)(q + sub * 16 + 8) = ob; *(u32x4*)(k + sub * 16) = oka; *(u32x4*)(k + sub * 16 + 8) = okb;
    const int dd = sub * 8; float own[8], oth[8];
#pragma unroll
    for (int i = 0; i < 4; ++i) { own[2 * i] = bflo(qr[i]) * rr_ * qg[128 + dd + 2 * i]; own[2 * i + 1] = bfhi(qr[i]) * rr_ * qg[128 + dd + 2 * i + 1]; }
#pragma unroll
    for (int i = 0; i < 8; ++i) oth[i] = __shfl_xor(own[i], 2);
    const int t = r % SEQ, pos = (dd & 32) ? (t % 64) : (t / 64); const bool first = (dd & 16) == 0; u32x4 orr; float res[8];
#pragma unroll
    for (int i = 0; i < 8; ++i) { float cs = 1.f, sn = 0.f; if (r < NL) sincos_t((float)pos * ropef((dd & 15) + i, 16), sn, cs); res[i] = first ? own[i] * cs - oth[i] * sn : own[i] * cs + oth[i] * sn; }
#pragma unroll
    for (int i = 0; i < 4; ++i) orr[i] = pk2(res[2 * i] * QSCALE, res[2 * i + 1] * QSCALE);
    *(u32x4*)(q + 128 + dd) = orr; }
__device__ __forceinline__ void ret_norm_wave(const P& p, int q, int lr, int lane) {
    const int h = lane >> 4, sub = lane & 15; u16* o = wsb(p, O_OB) + (size_t)lr * 2048 + h * 512 + sub * 32; u16* yd = ret_ydst(p, q, lr) + h * 512 + sub * 32; const u16* g = wsb(p, O_GATE) + (size_t)lr * 2048 + h * 512 + sub * 32; const float* gg = p.in[19] + h * 512 + sub * 32;
    u32x4 ov[4]; float s = 0.f;
#pragma unroll
    for (int i = 0; i < 4; ++i) { ov[i] = *(const u32x4*)(o + i * 8); for (int jx = 0; jx < 4; ++jx) s += bflo(ov[i][jx]) + bfhi(ov[i][jx]); }
    for (int m = 8; m >= 1; m >>= 1) s += __shfl_xor(s, m);
    const float mu = s * (1.0f / 512.0f); float qv = 0.f;
#pragma unroll
    for (int i = 0; i < 4; ++i) for (int jx = 0; jx < 4; ++jx) { const float a = bflo(ov[i][jx]) - mu, b = bfhi(ov[i][jx]) - mu; qv += a * a + b * b; }
    for (int m = 8; m >= 1; m >>= 1) qv += __shfl_xor(qv, m);
    const float rstd = rsq_f(qv * (1.0f / 512.0f) + EPS);
#pragma unroll
    for (int i = 0; i < 4; ++i) { const u32x4 gv = *(const u32x4*)(g + i * 8); u32x4 w;
        for (int jx = 0; jx < 4; ++jx) { const int e = i * 8 + 2 * jx;
            w[jx] = pk2((bflo(ov[i][jx]) - mu) * rstd * gg[e] * silu_f(bflo(gv[jx])), (bfhi(ov[i][jx]) - mu) * rstd * gg[e + 1] * silu_f(bfhi(gv[jx]))); }
        *(u32x4*)(yd + i * 8) = w; } }
__device__ __forceinline__ void mod_phase(const P& p, float* tab) {
    for (int i = threadIdx.x; i < NMR * 1024; i += 512) { const int b = i >> 10, k = i & 1023; tab[i] = silu_f(b < NB ? p.in[1][b * 1024 + k] : p.in[3][k]); }
    __syncthreads();
    for (int idx = blockIdx.x * 512 + threadIdx.x; idx < DEPTH * 9216; idx += gridDim.x * 512) {
        const int layer = idx / 9216, col = idx % 9216; const float* w = p.in[4] + (size_t)layer * 1024 * 9216 + col; float acc[NMR];
#pragma unroll
        for (int b = 0; b < NMR; ++b) acc[b] = 0.f;
        for (int k = 0; k < 1024; ++k) { const float wv = w[(size_t)k * 9216];
#pragma unroll
            for (int b = 0; b < NMR; ++b) acc[b] += tab[b * 1024 + k] * wv; }
        const float bias = p.in[5][layer * 9216 + col];
#pragma unroll
        for (int b = 0; b < NMR; ++b) ((float*)(p.ws + O_MOD))[(size_t)(layer * NMR + b) * 9216 + col] = acc[b] + bias; }
    __syncthreads(); }
#define WPASS(N, HOSTCALL, DEVCALL) do { const int _n = (int)(N); int t0_ = threadIdx.x; asm volatile("" : "+v"(t0_)); const int lane = t0_ & 63; for (int it = blockIdx.x * 8 + (t0_ >> 6); it < _n; it += gridDim.x * 8) { DEVCALL; } } while (0)
#define MODPHASE() mod_phase(p, (float*)shm)
#define NCTXWG ((NC / 256) * 4)
#define MIXED_DOWN_NORM(DESC, LAYER2, KK, S5F, ASHARE) do { int t0_ = threadIdx.x; asm volatile("" : "+v"(t0_)); const int lane = t0_ & 63; int r0_, r1_; \
    if ((int)blockIdx.x < NCTXWG) { gemm_run(lds, DESC); r0_ = (int)blockIdx.x * (ASHARE); r1_ = r0_ + (ASHARE); }     \
    else { const int no_ = (int)gridDim.x - NCTXWG, rest_ = NL - NCTXWG * (ASHARE), per_ = (rest_ + no_ - 1) / no_; r0_ = NCTXWG * (ASHARE) + ((int)blockIdx.x - NCTXWG) * per_; r1_ = r0_ + per_ < NL ? r0_ + per_ : NL; } \
    for (int it = r0_ + (t0_ >> 6); it < r1_; it += 8) norm_wave(p, LAYER2, KK, it, S5F, lane); } while (0)
#define MIXED_RET_TAIL(LATDESC, CTXDESC, NCW, LAYER2, KK, RA, RB) do { gemm_run(lds, LATDESC); int t0_ = threadIdx.x; asm volatile("" : "+v"(t0_)); const int lane = t0_ & 63; \
    if ((int)blockIdx.x < (NCW)) { gemm_run(lds, CTXDESC); } else { const int nw_ = ((int)gridDim.x - (NCW)) * 8; \
        for (int it = (RA) + ((int)blockIdx.x - (NCW)) * 8 + (t0_ >> 6); it < (RB); it += nw_) norm_wave(p, LAYER2, KK, it, 0, lane); } } while (0)
#define RANGENORM(LAYER2, KK, RA, RB) do { int t0_ = threadIdx.x; asm volatile("" : "+v"(t0_)); const int lane = t0_ & 63; for (int it = (RA) + blockIdx.x * 8 + (t0_ >> 6); it < (RB); it += gridDim.x * 8) norm_wave(p, LAYER2, KK, it, 0, lane); } while (0)
#define CTXNORM(LAYER2, KK, S5F) do { int t0_ = threadIdx.x; asm volatile("" : "+v"(t0_)); const int lane = t0_ & 63; for (int it = NL + blockIdx.x * 8 + (t0_ >> 6); it < MT; it += gridDim.x * 8) norm_wave(p, LAYER2, KK, it, S5F, lane); } while (0)

#define XB_TMO      128
#define XB_XCNT(j)  (256  + 64 * (j))
#define XB_XSUB(j)  (1280 + 64 * (j))
#define XB_XGEN(j)  (2304 + 64 * (j))
#define XB_TOP      3328
#define XB_TOPGEN   3392
#define XCD_BAR_WORDS 3456
#define XB_SPIN_CAP (1u << 18)
__device__ __forceinline__ unsigned xb_ld(unsigned* p)              { return __hip_atomic_load(p, __ATOMIC_RELAXED, __HIP_MEMORY_SCOPE_AGENT); }
__device__ __forceinline__ unsigned xb_add(unsigned* p, unsigned v) { return __hip_atomic_fetch_add(p, v, __ATOMIC_RELAXED, __HIP_MEMORY_SCOPE_AGENT); }
__device__ __forceinline__ unsigned xb_xcc_id() { return (unsigned)__builtin_amdgcn_s_getreg((3 << 11) | 20) & 0xFu; }
#define XB_SPIN(cond, bar) do { unsigned _sp = 0; while (cond) { __builtin_amdgcn_s_sleep(1); \
    if ((++_sp & 255u) == 0u) { if (xb_ld(&(bar)[XB_TMO])) break; if (_sp > XB_SPIN_CAP) { atomicAdd(&(bar)[XB_TMO], 1u); break; } } } } while (0)
struct XcdBarrier { unsigned* bar; unsigned x; volatile LAS unsigned* st; };
__device__ __forceinline__ XcdBarrier xcd_barrier_post(unsigned* bar, volatile LAS unsigned* st) {
    XcdBarrier b; b.bar = bar; b.x = xb_xcc_id(); b.st = st;
    if (threadIdx.x == 0) (void)xb_add(&bar[XB_XCNT(b.x)], 1u);
    return b; }
__device__ __forceinline__ void xcd_barrier_complete(unsigned* bar, unsigned x, unsigned& nloc, unsigned& nx) {
    const unsigned G = gridDim.x * gridDim.y * gridDim.z; unsigned sum, cnt, mine, sp = 0u;
    for (;;) { sum = 0u; cnt = 0u; mine = 0u;
#pragma unroll
        for (unsigned j = 0; j < 16; ++j) { const unsigned c = xb_ld(&bar[XB_XCNT(j)]); sum += c; cnt += (c > 0u) ? 1u : 0u; mine = (j == x) ? c : mine; }
        if (sum == G) break;
        __builtin_amdgcn_s_sleep(1);
        if ((++sp & 255u) == 0u) { if (xb_ld(&bar[XB_TMO])) break; if (sp > XB_SPIN_CAP) { atomicAdd(&bar[XB_TMO], 1u); break; } } }
    nloc = mine > 0u ? mine : 1u; nx = cnt > 0u ? cnt : 1u; }
__device__ __forceinline__ void xcd_barrier(const XcdBarrier& b) {
    asm volatile("s_waitcnt vmcnt(0)" ::: "memory");
    __syncthreads();
    if (threadIdx.x == 0) {
        unsigned* bar = b.bar;
        __builtin_amdgcn_s_waitcnt(0);
        unsigned nloc = b.st[0], nx = b.st[1];
        if (nloc == 0u) { xcd_barrier_complete(bar, b.x, nloc, nx); b.st[0] = nloc; b.st[1] = nx; }
        const unsigned old = xb_add(&bar[XB_XSUB(b.x)], 1u);
        const unsigned gen = old / nloc;
        if (old + 1u == (gen + 1u) * nloc) {
            __builtin_amdgcn_fence(__ATOMIC_RELEASE, "agent");
            asm volatile("s_waitcnt vmcnt(0)" ::: "memory");
            const unsigned og = xb_add(&bar[XB_TOP], 1u);
            const unsigned tg = og / nx;
            if (og + 1u == (tg + 1u) * nx) xb_add(&bar[XB_TOPGEN], 1u);
            else XB_SPIN(xb_ld(&bar[XB_TOPGEN]) == tg, bar);
            __builtin_amdgcn_fence(__ATOMIC_ACQUIRE, "agent");
            xb_add(&bar[XB_XGEN(b.x)], 1u);
            asm volatile("s_waitcnt vmcnt(0)" ::: "memory");
        } else {
            XB_SPIN(xb_ld(&bar[XB_XGEN(b.x)]) == gen, bar);
            __builtin_amdgcn_fence(__ATOMIC_ACQUIRE, "agent");
            asm volatile("s_waitcnt vmcnt(0)" ::: "memory");
        }
    }
    __syncthreads();
}

namespace cg = cooperative_groups;
#define PASS(N, CALL) do { const long _n = (long)(N); int t0_ = threadIdx.x; asm volatile("" : "+v"(t0_)); for (long it = (long)blockIdx.x * 512 + t0_; it < _n; it += (long)gridDim.x * 512) { CALL; } } while (0)
#define GEMM(D) gemm_run(lds, D)
#define SYNC() xcd_barrier(xb)
#ifndef STAGGER_US
#define STAGGER_US 40
#endif
#define STAGGER(US) do { if ((US) > 0 && (xb.x & 1u)) { const unsigned long long t0_ = __builtin_amdgcn_s_memrealtime(); while (__builtin_amdgcn_s_memrealtime() - t0_ < (unsigned long long)(US) * 100ull) __builtin_amdgcn_s_sleep(8); } } while (0)
#define GRIDSYNC() grid.sync()
#define HOOK(L, S) do { } while (0)
#define ATTN(NITEMS) do { for (int it = blockIdx.x; it < (NITEMS); it += gridDim.x) { AttItem ai_; att_item(p, it, ai_); att_body(ai_, (char*)shm); } } while (0)
#else
template <class Dsc> static void gemm_emu(const Dsc& D) {
    std::vector<int> Ls; for (int c = 0; c < 256; ++c) for (int i = 0;; ++i) { Unit u{}; if (!D.unit(i * 256 + c, u)) break; Ls.push_back(i * 256 + c); }
    const int n = (int)Ls.size();
#pragma omp parallel for schedule(dynamic)
    for (int li = 0; li < n; ++li) { const int L = Ls[li]; Unit u{}; D.unit(L, u); const int K = Dsc::K;
        std::vector<float> A((size_t)256 * K), B((size_t)256 * K), C((size_t)256 * 256);
        for (int r = 0; r < 256; ++r) for (int k = 0; k < K; ++k) { A[(size_t)r * K + k] = bf2f(u.A[(size_t)r * Dsc::lda + k]); B[(size_t)r * K + k] = bf2f(u.B[(size_t)r * Dsc::ldb + k]); }
        for (int r = 0; r < 256; ++r) for (int c = 0; c < 256; ++c) { float s = 0.f; const float* a = &A[(size_t)r * K]; const float* b = &B[(size_t)c * K]; for (int k = 0; k < K; ++k) s += a[k] * b[k]; C[r * 256 + c] = s; }
        for (int r = 0; r < 128; ++r) for (int c = 0; c < 128; c += 4) { f32x4 v[2][2];
            for (int X = 0; X < 2; ++X) for (int Y = 0; Y < 2; ++Y) for (int j = 0; j < 4; ++j) v[X][Y][j] = C[(r + 128 * X) * 256 + c + 128 * Y + j];
            D.emit(u, r, c, v[0][0], v[0][1], v[1][0], v[1][1]); } } }
static void att_emu(const P& p, int nitems) {
#pragma omp parallel for schedule(dynamic)
    for (int it = 0; it < nitems; ++it) { AttItem a; att_item(p, it, a); std::vector<float> s(a.ntot);
        for (int i = 0; i < 256; ++i) { const u16* q = a.q + (size_t)i * 1536; float l = 0.f; float o[128]; for (int e = 0; e < 128; ++e) o[e] = 0.f;
            for (int k = 0; k < a.ntot; ++k) { const u16* kr = k < a.n0 ? a.k0 + (size_t)k * 1536 : a.k1 + (size_t)(k - a.n0) * 1536; float d = 0.f; for (int x = 0; x < 192; ++x) d += bf2f(q[x]) * bf2f(kr[x]);
                const float pv = bf2f(f2bf(exp2f(d))); l += exp2f(d); const u16* vr = k < a.n0 ? a.v0 + (size_t)k * 1024 : a.v1 + (size_t)(k - a.n0) * 1024; for (int e = 0; e < 128; ++e) o[e] += pv * bf2f(vr[e]); }
            for (int e = 0; e < 128; ++e) a.o[(size_t)i * 1024 + e] = f2bf(o[e] / l); } } }
#define PASS(N, CALL) do { const long _n = (long)(N); _Pragma("omp parallel for schedule(static)") for (long it = 0; it < _n; ++it) { CALL; } } while (0)
#define WPASS(N, HOSTCALL, DEVCALL) PASS(N, HOSTCALL)
#define MODPHASE() PASS(DEPTH * 9216, mod_item(p, (int)it))
#define MIXED_DOWN_NORM(DESC, LAYER2, KK, S5F, ASHARE) do { gemm_emu(DESC); PASS(NL, norm_item(p, LAYER2, KK, (int)it, S5F)); } while (0)
#define CTXNORM(LAYER2, KK, S5F) PASS(NC, norm_item(p, LAYER2, KK, NL + (int)it, S5F))
#define MIXED_RET_TAIL(LATDESC, CTXDESC, NCW, LAYER2, KK, RA, RB) do { gemm_emu(LATDESC); gemm_emu(CTXDESC); PASS((RB) - (RA), norm_item(p, LAYER2, KK, (RA) + (int)it, 0)); } while (0)
#define RANGENORM(LAYER2, KK, RA, RB) PASS((RB) - (RA), norm_item(p, LAYER2, KK, (RA) + (int)it, 0))
#define GEMM(D) gemm_emu(D)
#define SYNC() do { } while (0)
#define STAGGER(US) do { } while (0)
#define GRIDSYNC() do { } while (0)
#define ATTN(NITEMS) att_emu(p, NITEMS)
static void emu_hook(const P& p, int layer, int stage);
#define HOOK(L, S) emu_hook(p, L, S)
#endif

#ifndef HOST_EMU
__global__ void __launch_bounds__(512) fwd_megakernel(P p) {
    extern __shared__ __attribute__((aligned(16))) unsigned char shm[];
    LAS unsigned char* lds = (LAS unsigned char*)shm;
    cg::grid_group grid = cg::this_grid();
    volatile LAS unsigned* xst = (volatile LAS unsigned*)(lds + STAGE_BYTES + 1024);
    if (threadIdx.x == 0) { xst[0] = 0u; xst[1] = 0u; xst[2] = 0u; xst[3] = 0u; }
    __syncthreads();
    const XcdBarrier xb = xcd_barrier_post((unsigned*)(p.ws + O_BAR), xst);
#else
static void fwd_emu(P p) {
#endif
    if (PM(0)) { MODPHASE();
    PASS((long)NC * 256, ((f32x4*)(p.ws + O_G))[it] = ((const f32x4*)p.in[2])[it]);
    PASS(CV_TOTAL, cvt_item(p, it));
    PASS(64 * 2 * 32 * 16, s5_ktab_item(p, (int)it));
    PASS(64 * 256 * 512, s5_fext_item(p, (int)it)); }
    GRIDSYNC();
    if (PM(0)) { PASS((long)64 * 512 * 768, s5_text_item(p, it)); }
    for (int rep_ = 0; rep_ < REP_SYNC; ++rep_) SYNC();
    for (int layer = 0; layer < DEPTH; ++layer) {
        const int kind = layer % 3, j = layer / 3; const bool last = layer == DEPTH - 1;
        if (layer == 0) { if (PM(1)) { WPASS(MT, norm_item(p, layer, 0, (int)it, 0), norm_wave(p, layer, 0, it, 0, lane)); } SYNC(); }
        for (int rep_ = 0; rep_ < REP_UP; ++rep_) { if (PM(2)) { DFfnUp d{p, layer, 0, MT / 256}; GEMM(d); } SYNC(); }
        if (PM(3)) { DFfnDown d{p, layer, 0, NL / 256, 0.5f}; GEMM(d); } SYNC();
        if (PM(3)) { DFfnDown d{p, layer, 0, -1, 0.5f}; MIXED_DOWN_NORM(d, layer, 1, kind == 2 ? 1 : 0, 56); } SYNC();
        if (PM(1)) { CTXNORM(layer, 1, kind == 2 ? 1 : 0); } SYNC();
        if (kind == 0) {
            for (int rep_ = 0; rep_ < REP_MLA; ++rep_) { if (PM(4)) { DMlaIn d{p, j}; GEMM(d); } SYNC(); }
            if (PM(5)) { WPASS(MT, mla_row_item(p, j, (int)it), mla_row_wave(p, j, it, lane)); } SYNC();
            for (int rep_ = 0; rep_ < REP_MLA; ++rep_) { if (PM(6)) { DMlaUq d{p, j, last ? NL / 256 : MT / 256}; GEMM(d); } if (PM(7)) { DMlaUkv d{p, j}; GEMM(d); } SYNC(); }
            if (PM(8)) { WPASS(MT, { for (int h_ = 0; h_ < 8; ++h_) mla_head_item(p, j, (int)it * 8 + h_); }, mla_head_wave(p, j, it, lane)); } SYNC();
            for (int rep_ = 0; rep_ < REP_ATT; ++rep_) { if (PM(9)) { ATTN(NB * 8 * (SEQ / 256) + (last ? 0 : NB * 8)); } SYNC(); }
            if (PM(10)) { DMlaO d{p, layer, j, NL / 256}; GEMM(d); } SYNC();
            if (!last) { if (PM(10)) { DMlaO d{p, layer, j, -1}; MIXED_DOWN_NORM(d, layer, 2, 0, 184); } SYNC();
                if (PM(1)) { CTXNORM(layer, 2, 0); } SYNC(); }
        } else if (kind == 1) {
            for (int q = 0; q < NB / RGB; ++q) {
                for (int rep_ = 0; rep_ < REP_RET; ++rep_) { if (PM(11)) { DRetProjAll d{p, q}; GEMM(d); } SYNC(); }
                for (int rep_ = 0; rep_ < REP_RET; ++rep_) { if (PM(13)) { DRetP d{p}; GEMM(d); } if (PM(14)) { DRetL d{p}; GEMM(d); } SYNC(); }
                if (PM(15)) { PASS(4 * RGB * 512 * 64, ret_prefix_item(p, (int)it)); } SYNC();
                for (int rep_ = 0; rep_ < REP_RET; ++rep_) { if (PM(16)) { DRetO d{p}; GEMM(d); } SYNC(); }
                if (PM(17)) { WPASS(NCQ * 256, { for (int h_ = 0; h_ < 4; ++h_) ret_norm_item(p, q, (int)it * 4 + h_); }, ret_norm_wave(p, q, it, lane)); } SYNC();
                if (q < NB / RGB - 1) { if (PM(18)) { DRetWo d{p, layer, q}; GEMM(d); } SYNC(); }
                else { if (PM(18)) { DRetWo d{p, layer, q}; DRetWoCtx c{p, layer}; MIXED_RET_TAIL(d, c, (NC / 256) * 4, layer, 2, 0, q * RGB * SEQ); } SYNC();
                    if (PM(1)) { RANGENORM(layer, 2, q * RGB * SEQ, MT); } SYNC(); }
            }
        } else {
            for (int rep_ = 0; rep_ < REP_S5; ++rep_) { if (PM(20)) { DS5L d{p}; GEMM(d); } SYNC(); }
            if (PM(21)) { PASS(64 * NB * 64, s5_prefix_item(p, (int)it)); } SYNC();
            for (int rep_ = 0; rep_ < REP_S5; ++rep_) { if (PM(22)) { DS5Y d{p}; GEMM(d); } SYNC(); }
            if (PM(23)) { DS5Glu d{p, layer}; GEMM(d); } SYNC();
        }
        HOOK(layer, 0);
        if (kind == 2 || (kind == 0 && last)) { if (PM(1)) { WPASS(last ? NL : MT, norm_item(p, layer, 2, (int)it, 0), norm_wave(p, layer, 2, it, 0, lane)); } SYNC(); }
        for (int rep_ = 0; rep_ < REP_UP; ++rep_) { if (PM(2)) { DFfnUp d{p, layer, 1, last ? NL / 256 : MT / 256}; GEMM(d); } SYNC(); }
        if (PM(3)) { DFfnDown d{p, layer, 1, NL / 256, 0.5f}; GEMM(d); } SYNC();
        if (!last) { if (PM(3)) { DFfnDown d{p, layer, 1, -1, 0.5f}; MIXED_DOWN_NORM(d, layer + 1, 0, 0, 56); } SYNC();
            if (PM(1)) { CTXNORM(layer + 1, 0, 0); } SYNC(); }
        HOOK(layer, 1);
    }
}

#ifndef HOST_EMU
extern "C" void kernel_launch(void* const* d_in, const int* in_sizes, int n_in, void* d_out, int out_size, void* d_ws, size_t ws_size, hipStream_t stream) {
    constexpr size_t kDynLds = STAGE_BYTES + 4096;
    static int grid_blocks = 0;
    if (!grid_blocks) {
        int dev = 0, cus = 0, per_cu = 0;
        hipGetDevice(&dev);
        hipDeviceGetAttribute(&cus, hipDeviceAttributeMultiprocessorCount, dev);
        hipFuncSetAttribute((const void*)fwd_megakernel, hipFuncAttributeMaxDynamicSharedMemorySize, (int)kDynLds);
        hipOccupancyMaxActiveBlocksPerMultiprocessor(&per_cu, fwd_megakernel, 512, kDynLds);
        if (per_cu < 1) per_cu = 1;
        if (per_cu > 1) per_cu = 1;
        grid_blocks = cus * per_cu;
        if (ws_size < WS_NEED) fprintf(stderr, "workspace too small: %zu < %zu\n", ws_size, (size_t)WS_NEED);
    }
    P p{};
    for (int i = 0; i < 31 && i < n_in; ++i) p.in[i] = (const float*)d_in[i];
    p.out = (float*)d_out; p.ws = (char*)d_ws;
    hipMemsetAsync((char*)d_ws + O_BAR, 0, XCD_BAR_WORDS * 4, stream);
    void* args[] = {&p};
    hipError_t e = hipLaunchCooperativeKernel((void*)fwd_megakernel, dim3(grid_blocks), dim3(512), args, kDynLds, stream);
    if (e != hipSuccess) fprintf(stderr, "cooperative launch failed: %s (grid %d)\n", hipGetErrorString(e), grid_blocks);
}
#endif
```

```cpp
#ifdef HOST_EMU
#include <cmath>
#include <cstdio>
#include <cstdlib>
#include <cstring>
#include <vector>
#define HD inline
#else
#include <hip/hip_runtime.h>
#include <hip/hip_cooperative_groups.h>
#include <type_traits>
#include <cstdio>
#define HD __device__ __forceinline__
#endif

#ifndef CFG_BATCH
#define CFG_BATCH 16
#endif
#ifndef CFG_SEQ
#define CFG_SEQ 4096
#endif

typedef unsigned short u16;
typedef float f32x4 __attribute__((ext_vector_type(4)));
typedef unsigned u32x2 __attribute__((ext_vector_type(2)));

constexpr int DM = 1024, NB = CFG_BATCH, SEQ = CFG_SEQ, CTX = 256, DFF = 2816, DEPTH = 4;
constexpr int NL = NB * SEQ, NC = NB * CTX, MT = NL + NC;
constexpr int NMR = NB + 1;
constexpr int RGB = (NB >= 4) ? 4 : 1;
constexpr int NCH = 1 + SEQ / 256;
constexpr int NCQ = RGB * NCH;
constexpr int S5L = SEQ / 32, S5C = CTX / 32;
constexpr int NROW5 = NB * S5L + NB * S5C;
constexpr int NROW5P = (NROW5 + 255) / 256 * 256;
constexpr float EPS = 1e-6f;
constexpr float ATT_SCALE = 0.07216878364870322f;
constexpr float QSCALE = ATT_SCALE * 1.4426950408889634f;

constexpr size_t al(size_t x) { return (x + 255) & ~(size_t)255; }
constexpr size_t O_BAR = 0;
constexpr size_t O_MOD = 16384;
constexpr size_t O_G = O_MOD + al((size_t)DEPTH * NMR * 9216 * 4);
constexpr size_t O_FFI = O_G + al((size_t)NC * 1024 * 4);
constexpr size_t SZ_FFI1 = (size_t)5632 * 1024 * 2, SZ_FFO1 = (size_t)1024 * 2816 * 2;
constexpr size_t O_FFO = O_FFI + 8 * SZ_FFI1;
constexpr size_t O_MWIN = O_FFO + 8 * SZ_FFO1;
constexpr size_t SZ_MWIN = (size_t)768 * 1024 * 2, SZ_MWUQ = (size_t)1536 * 384 * 2, SZ_MWUKV = (size_t)2048 * 256 * 2, SZ_MWO = (size_t)1024 * 1024 * 2;
constexpr size_t O_MWUQ = O_MWIN + 2 * SZ_MWIN;
constexpr size_t O_MWUKV = O_MWUQ + 2 * SZ_MWUQ;
constexpr size_t O_MWO = O_MWUKV + 2 * SZ_MWUKV;
constexpr size_t O_RWIN = O_MWO + 2 * SZ_MWO;
constexpr size_t O_RWO = O_RWIN + (size_t)6144 * 1024 * 2;
constexpr size_t O_GLU = O_RWO + (size_t)1024 * 2048 * 2;
constexpr size_t O_HN = O_GLU + (size_t)2048 * 1024 * 2;
constexpr size_t O_KTAB = O_HN + al((size_t)MT * 1024 * 2);
constexpr size_t O_TEXT = O_KTAB + al((size_t)64 * 2 * 32 * 256 * 4);
constexpr size_t O_FEXT = O_TEXT + al((size_t)64 * 512 * 768 * 2);
constexpr size_t O_SCR = O_FEXT + al((size_t)64 * 256 * 512 * 2);
constexpr size_t O_ACT = O_SCR;
constexpr size_t O_CALL = O_SCR;
constexpr size_t O_CQN = O_CALL + al((size_t)MT * 768 * 4);
constexpr size_t O_CKVN = O_CQN + al((size_t)MT * 384 * 2);
constexpr size_t O_KF = O_CKVN + al((size_t)MT * 256 * 2);
constexpr size_t O_VB = O_KF + al((size_t)MT * 1536 * 2);
constexpr size_t END_MLA = O_VB + al((size_t)MT * 1024 * 2);
constexpr size_t O_QN = O_SCR;
constexpr size_t O_KN = O_QN + al((size_t)NCQ * 256 * 1024 * 2);
constexpr size_t O_GATE = O_KN + al((size_t)NCQ * 256 * 1024 * 2);
constexpr size_t O_OB = O_GATE + al((size_t)NCQ * 256 * 2048 * 2);
constexpr size_t O_AEXT = O_OB + al((size_t)NCQ * 256 * 2048 * 2);
constexpr size_t O_KTX = O_AEXT + al((size_t)4 * NCQ * 256 * 768 * 2);
constexpr size_t O_BEXT = O_KTX + al((size_t)4 * NCQ * 2 * 256 * 256 * 2);
constexpr size_t O_YCTX = O_BEXT + al((size_t)4 * NCQ * 512 * 768 * 2);
constexpr size_t END_RET = O_YCTX + al((size_t)NC * 2048 * 2);
constexpr size_t O_UEXT = O_SCR;
constexpr size_t END_S5 = O_UEXT + al((size_t)64 * NROW5P * 768 * 2);
constexpr size_t END_FFN = O_ACT + al((size_t)MT * 2816 * 2);
constexpr size_t cmax(size_t a, size_t b) { return a > b ? a : b; }
constexpr size_t WS_NEED = cmax(cmax(END_MLA, END_RET), cmax(END_S5, END_FFN));

struct P { const float* in[32]; float* out; char* ws; };
#ifndef PHASE_MASK
#define PHASE_MASK 0xFFFFFFFFu
#endif
#define PM(b) ((PHASE_MASK >> (b)) & 1u)
#ifndef REP_UP
#define REP_UP 1
#endif
#ifndef REP_ATT
#define REP_ATT 1
#endif
#ifndef REP_NORM
#define REP_NORM 1
#endif
#ifndef REP_RET
#define REP_RET 1
#endif
#ifndef REP_DOWN
#define REP_DOWN 1
#endif
#ifndef REP_MLA
#define REP_MLA 1
#endif
#ifndef REP_S5
#define REP_S5 1
#endif
#ifndef REP_SYNC
#define REP_SYNC 0
#endif

HD float bf2f(u16 b) { union { unsigned u; float f; } x; x.u = ((unsigned)b) << 16; return x.f; }
HD u16 f2bf(float f) { union { unsigned u; float f; } x; x.f = f; unsigned u = x.u; u += 0x7fffu + ((u >> 16) & 1u); return (u16)(u >> 16); }
#ifdef HOST_EMU
HD void st4bf(u16* p, f32x4 v) { u32x2 w; w.x = (unsigned)f2bf(v[0]) | ((unsigned)f2bf(v[1]) << 16); w.y = (unsigned)f2bf(v[2]) | ((unsigned)f2bf(v[3]) << 16); *(u32x2*)p = w; }
#else
HD unsigned cvtpk_bf(float lo, float hi) { unsigned r; asm("v_cvt_pk_bf16_f32 %0, %1, %2" : "=v"(r) : "v"(lo), "v"(hi)); return r; }
HD void st4bf(u16* p, f32x4 v) { u32x2 w; w.x = cvtpk_bf(v[0], v[1]); w.y = cvtpk_bf(v[2], v[3]); *(u32x2*)p = w; }
#endif
#ifdef HOST_EMU
HD float silu_f(float a) { return a / (1.0f + expf(-a)); }
HD float sigm_f(float a) { return 1.0f / (1.0f + expf(-a)); }
HD float gelu_f(float x) { return 0.5f * x * (1.0f + tanhf(0.7978845608028654f * (x + 0.044715f * x * x * x))); }
#else
HD float sigm_f(float a) { return __builtin_amdgcn_rcpf(1.0f + __builtin_amdgcn_exp2f(-1.4426950408889634f * a)); }
HD float silu_f(float a) { return a * sigm_f(a); }
HD float gelu_f(float x) { return x * sigm_f(1.5957691216057308f * (x + 0.044715f * x * x * x)); }
#endif
HD float rsq_f(float x) { return 1.0f / sqrtf(x); }
HD float ex2(float x) {
#ifdef HOST_EMU
    return exp2f(x);
#else
    return __builtin_amdgcn_exp2f(x);
#endif
}
HD const float* hsrc(const P& p, int r, int first) { if (first && r < NL) return p.in[0] + (size_t)r * 1024; return r < NL ? p.out + (size_t)r * 1024 : (const float*)(p.ws + O_G) + (size_t)(r - NL) * 1024; }
HD float* hrow(const P& p, int r) { return r < NL ? p.out + (size_t)r * 1024 : (float*)(p.ws + O_G) + (size_t)(r - NL) * 1024; }
HD const float* modp(const P& p, int layer, int r, int idx) { const int mr = r < NL ? r / SEQ : NB; return (const float*)(p.ws + O_MOD) + ((size_t)(layer * NMR + mr) * 9 + idx) * 1024; }
HD u16* wsb(const P& p, size_t off) { return (u16*)(p.ws + off); }
#ifdef HOST_EMU
HD float ropef(int d, int half) { return expf(-(float)d * (9.210340371976184f / (float)half)) * 0.15915494309189535f; }
#else
HD float ropef(int d, int half) { return __builtin_amdgcn_exp2f(-(float)d * (13.287712379549449f / (float)half)) * 0.15915494309189535f; }
#endif
HD void sincos_t(float turns, float& sn, float& cs) {
    const float f = turns - floorf(turns);
#ifdef HOST_EMU
    sn = sinf(6.283185307179586f * f); cs = cosf(6.283185307179586f * f);
#else
    sn = __builtin_amdgcn_sinf(f); cs = __builtin_amdgcn_cosf(f);
#endif
}

HD bool rect_unit(int L, int nM, int nN, int& pm, int& pn) {
    const int nwg = nM * nN; if (L >= nwg) return false;
    int wgid = L; { const int q = nwg / 8, r = nwg % 8, xcd = wgid % 8, off = wgid / 8; wgid = (xcd < r ? xcd * (q + 1) : r * (q + 1) + (xcd - r) * q) + off; }
    const int nig = 8 * nN, gid = wgid / nig, fm = gid * 8, gsz = (nM - fm) < 8 ? (nM - fm) : 8;
    pm = fm + ((wgid % nig) % gsz); pn = (wgid % nig) / gsz; return true;
}

struct Unit { const u16* A; const u16* B; int a, b, c, d; float f0, f1; };

struct DFfnUp { P p; int layer, f, nM; static constexpr int FENCE = 1; static constexpr int K = 1024, lda = 1024, ldb = 1024;
    HD bool unit(int L, Unit& u) const { int pm, pn; if (!rect_unit(L, nM, 22, pm, pn)) return false;
        u.A = wsb(p, O_HN) + (size_t)pm * 256 * 1024; u.B = wsb(p, O_FFI + (size_t)(layer * 2 + f) * SZ_FFI1) + (size_t)pn * 256 * 1024; u.a = pm; u.b = pn; u.c = 0; u.d = 0; return true; }
    HD void emit(const Unit& u, int r, int c, f32x4 v00, f32x4 v01, f32x4 v10, f32x4 v11) const {
        u16* act = wsb(p, O_ACT); const size_t R = (size_t)u.a * 256 + r; const int col = u.b * 128 + c; f32x4 o0, o1;
        for (int j = 0; j < 4; ++j) { o0[j] = silu_f(v00[j]) * v01[j]; o1[j] = silu_f(v10[j]) * v11[j]; }
        st4bf(act + R * 2816 + col, o0); st4bf(act + (R + 128) * 2816 + col, o1); } };

HD void resid4(const P& p, int layer, int midx, float sc, int R, int col, f32x4 v, int first = 0) {
    float* h = hrow(p, R) + col; const float* m = modp(p, layer, R, midx) + col; f32x4 x = *(const f32x4*)(hsrc(p, R, first) + col);
    for (int j = 0; j < 4; ++j) x[j] += sc * m[j] * v[j];
    *(f32x4*)h = x; }

struct DFfnDown { P p; int layer, f, nM; float sc; static constexpr int FENCE = 4; static constexpr int K = 2816, lda = 2816, ldb = 2816;
    HD bool unit(int L, Unit& u) const { int pm, pn;
        if (nM < 0) { if (L >= (NC / 256) * 4) return false; pm = NL / 256 + (L >> 2); pn = L & 3; }
        else if (((NL / 256) * 4) % 256 == 0 && nM > NL / 256) {
            if (L < (NL / 256) * 4) rect_unit(L, NL / 256, 4, pm, pn);
            else { const int c = L - (NL / 256) * 4; if (c >= 128 || (c & 1)) return false; const int k = c >> 1; pm = NL / 256 + (k >> 2); pn = k & 3; if (pm >= nM) return false; } }
        else if (!rect_unit(L, nM, 4, pm, pn)) return false;
        u.A = wsb(p, O_ACT) + (size_t)pm * 256 * 2816; u.B = wsb(p, O_FFO + (size_t)(layer * 2 + f) * SZ_FFO1) + (size_t)pn * 256 * 2816; u.a = pm; u.b = pn; u.c = 0; u.d = 0; return true; }
    HD void emit(const Unit& u, int r, int c, f32x4 v00, f32x4 v01, f32x4 v10, f32x4 v11) const {
        const int R = u.a * 256 + r, col = u.b * 256 + c, mi = f ? 8 : 2;
        const int first = (layer == 0 && f == 0 && sc != 0.f);
        resid4(p, layer, mi, sc, R, col, v00, first); resid4(p, layer, mi, sc, R, col + 128, v01, first); resid4(p, layer, mi, sc, R + 128, col, v10, first); resid4(p, layer, mi, sc, R + 128, col + 128, v11, first); } };
HD void atom4(float* g, const float* m, float sc, f32x4 v) {
#ifdef HOST_EMU
    for (int j = 0; j < 4; ++j) {
#pragma omp atomic
        g[j] += sc * m[j] * v[j]; }
#else
    for (int j = 0; j < 4; ++j) unsafeAtomicAdd(g + j, sc * m[j] * v[j]);
#endif
}
template <int KS, int SL0> struct DFfnDownCtx { P p; int layer, f; float sc; static constexpr int FENCE = 4; static constexpr int K = KS, lda = 2816, ldb = 2816;
    HD bool unit(int L, Unit& u) const { if (L >= 256) return false; const int x = SL0 ? (L + 128) % 256 : L; if (x >= 128 || x >= (NC / 256) * 8) return false;
        const int sl = x & 1, pn = (x >> 1) & 3, pm = NL / 256 + (x >> 3); const int k0 = SL0 ? 1536 + sl * 640 : sl * 768;
        u.A = wsb(p, O_ACT) + (size_t)pm * 256 * 2816 + k0; u.B = wsb(p, O_FFO + (size_t)(layer * 2 + f) * SZ_FFO1) + (size_t)pn * 256 * 2816 + k0; u.a = pm; u.b = pn; u.c = 0; u.d = 0; return true; }
    HD void one(int R, int col, f32x4 v) const { atom4(hrow(p, R) + col, modp(p, layer, R, f ? 8 : 2) + col, sc, v); }
    HD void emit(const Unit& u, int r, int c, f32x4 v00, f32x4 v01, f32x4 v10, f32x4 v11) const {
        const int R = u.a * 256 + r, col = u.b * 256 + c; one(R, col, v00); one(R, col + 128, v01); one(R + 128, col, v10); one(R + 128, col + 128, v11); } };

struct DMlaIn { P p; int j; static constexpr int FENCE = 1; static constexpr int K = 1024, lda = 1024, ldb = 1024;
    HD bool unit(int L, Unit& u) const { int pm, pn; if (!rect_unit(L, MT / 256, 3, pm, pn)) return false;
        u.A = wsb(p, O_HN) + (size_t)pm * 256 * 1024; u.B = wsb(p, O_MWIN + j * SZ_MWIN) + (size_t)pn * 256 * 1024; u.a = pm; u.b = pn; u.c = 0; u.d = 0; return true; }
    HD void emit(const Unit& u, int r, int c, f32x4 v00, f32x4 v01, f32x4 v10, f32x4 v11) const {
        float* o = (float*)(p.ws + O_CALL) + ((size_t)u.a * 256 + r) * 768 + u.b * 256 + c;
        *(f32x4*)o = v00; *(f32x4*)(o + 128) = v01; *(f32x4*)(o + (size_t)128 * 768) = v10; *(f32x4*)(o + (size_t)128 * 768 + 128) = v11; } };
struct DMlaUq { P p; int j, nM; static constexpr int FENCE = 1; static constexpr int K = 384, lda = 384, ldb = 384;
    HD bool unit(int L, Unit& u) const { int pm, pn; if (!rect_unit(L, nM, 6, pm, pn)) return false;
        u.A = wsb(p, O_CQN) + (size_t)pm * 256 * 384; u.B = wsb(p, O_MWUQ + j * SZ_MWUQ) + (size_t)pn * 256 * 384; u.a = pm; u.b = pn; u.c = 0; u.d = 0; return true; }
    HD void emit(const Unit& u, int r, int c, f32x4 v00, f32x4 v01, f32x4 v10, f32x4 v11) const {
        u16* o = wsb(p, O_CALL) + ((size_t)u.a * 256 + r) * 1536 + u.b * 256 + c;
        st4bf(o, v00); st4bf(o + 128, v01); st4bf(o + (size_t)128 * 1536, v10); st4bf(o + (size_t)128 * 1536 + 128, v11); } };
struct DMlaUkv { P p; int j; static constexpr int FENCE = 1; static constexpr int K = 256, lda = 256, ldb = 256;
    HD bool unit(int L, Unit& u) const { int pm, pn; if (!rect_unit(L, MT / 256, 8, pm, pn)) return false;
        u.A = wsb(p, O_CKVN) + (size_t)pm * 256 * 256; u.B = wsb(p, O_MWUKV + j * SZ_MWUKV) + (size_t)pn * 256 * 256; u.a = pm; u.b = pn; u.c = 0; u.d = 0; return true; }
    HD void one(size_t R, int col, f32x4 v) const {
        if (col < 1024) st4bf(wsb(p, O_KF) + R * 1536 + (col >> 7) * 192 + (col & 127), v);
        else st4bf(wsb(p, O_VB) + R * 1024 + (col - 1024), v); }
    HD void emit(const Unit& u, int r, int c, f32x4 v00, f32x4 v01, f32x4 v10, f32x4 v11) const {
        const size_t R = (size_t)u.a * 256 + r; const int col = u.b * 256 + c;
        one(R, col, v00); one(R, col + 128, v01); one(R + 128, col, v10); one(R + 128, col + 128, v11); } };
struct DMlaO { P p; int layer, j, nM; static constexpr int FENCE = 4; static constexpr int K = 1024, lda = 1024, ldb = 1024;
    HD bool unit(int L, Unit& u) const { int pm, pn;
        if (nM < 0) { if (L >= (NC / 256) * 4) return false; pm = NL / 256 + (L >> 2); pn = L & 3; }
        else if (!rect_unit(L, nM, 4, pm, pn)) return false;
        u.A = wsb(p, O_HN) + (size_t)pm * 256 * 1024; u.B = wsb(p, O_MWO + j * SZ_MWO) + (size_t)pn * 256 * 1024; u.a = pm; u.b = pn; u.c = 0; u.d = 0; return true; }
    HD void emit(const Unit& u, int r, int c, f32x4 v00, f32x4 v01, f32x4 v10, f32x4 v11) const {
        const int R = u.a * 256 + r, col = u.b * 256 + c;
        resid4(p, layer, 5, 1.0f, R, col, v00); resid4(p, layer, 5, 1.0f, R, col + 128, v01); resid4(p, layer, 5, 1.0f, R + 128, col, v10); resid4(p, layer, 5, 1.0f, R + 128, col + 128, v11); } };

HD int ret_tokrow(int q, int cidx) { const int b = q * RGB + cidx / NCH, n = cidx % NCH; return n == 0 ? NL + b * 256 : b * SEQ + (n - 1) * 256; }
HD float ret_logg(const P& p, int dir, int h) { return log1pf(-expf(p.in[18][dir * 4 + h])); }
struct DRetProj { P p; int q; static constexpr int FENCE = 1; static constexpr int K = 1024, lda = 1024, ldb = 1024;
    HD bool unit(int L, Unit& u) const { int pm, pn; if (!rect_unit(L, NCQ, 16, pm, pn)) return false;
        const int wrow = pn < 8 ? pn * 256 : 4096 + (pn - 8) * 256;
        u.A = wsb(p, O_HN) + (size_t)ret_tokrow(q, pm) * 1024; u.B = wsb(p, O_RWIN) + (size_t)wrow * 1024; u.a = pm; u.b = pn; u.c = 0; u.d = 0;
        u.f0 = ret_logg(p, 0, pn & 3) * 1.4426950408889634f; u.f1 = ret_logg(p, 1, pn & 3) * 1.4426950408889634f; return true; }
    HD void emit(const Unit& u, int r, int c, f32x4 v00, f32x4 v01, f32x4 v10, f32x4 v11) const {
        const int cidx = u.a, pn = u.b, n = cidx % NCH;
        if (pn >= 8) { u16* g = wsb(p, O_GATE) + ((size_t)cidx * 256 + r) * 2048 + (pn - 8) * 256 + c;
            st4bf(g, v00); st4bf(g + 128, v01); st4bf(g + (size_t)128 * 2048, v10); st4bf(g + (size_t)128 * 2048 + 128, v11); return; }
        const int h = pn & 3; const bool isq = pn < 4;
        const float lgf = u.f0, lgb = u.f1;
        for (int X = 0; X < 2; ++X) { const int i = r + 128 * X; const f32x4 x1 = X ? v10 : v00, x2 = X ? v11 : v01; f32x4 r1, r2;
            for (int jx = 0; jx < 4; ++jx) { float cs = 1.f, sn = 0.f;
                if (n > 0) sincos_t((float)((n - 1) * 256 + i) * ropef(c + jx, 128), sn, cs);
                r1[jx] = x1[jx] * cs - x2[jx] * sn; r2[jx] = x2[jx] * cs + x1[jx] * sn; }
            if (isq) { u16* qn = wsb(p, O_QN) + ((size_t)cidx * 256 + i) * 1024 + h * 256 + c; st4bf(qn, r1); st4bf(qn + 128, r2);
                const float df = ex2(lgf * (float)(i + 1)), db = ex2(lgb * (float)(256 - i));
                u16* ae = wsb(p, O_AEXT) + (((size_t)h * NCQ + cidx) * 256 + i) * 768;
                st4bf(ae + 256 + c, r1 * df); st4bf(ae + 384 + c, r2 * df); st4bf(ae + 512 + c, r1 * db); st4bf(ae + 640 + c, r2 * db); }
            else { u16* kn = wsb(p, O_KN) + ((size_t)cidx * 256 + i) * 1024 + h * 256 + c; st4bf(kn, r1 * 0.0625f); st4bf(kn + 128, r2 * 0.0625f); } } } };
struct DRetProjT { P p; int q; static constexpr int FENCE = 1; static constexpr int K = 1024, lda = 1024, ldb = 1024;
    HD bool unit(int L, Unit& u) const { int pm, pn; if (!rect_unit(L, 12, NCQ, pm, pn)) return false;
        u.A = wsb(p, O_RWIN) + (size_t)(1024 + pm * 256) * 1024; u.B = wsb(p, O_HN) + (size_t)ret_tokrow(q, pn) * 1024; u.a = pm; u.b = pn; u.c = 0; u.d = 0;
        u.f0 = ret_logg(p, 0, pm & 3) * 1.4426950408889634f; u.f1 = ret_logg(p, 1, pm & 3) * 1.4426950408889634f; return true; }
    HD void emit(const Unit& u, int r, int c, f32x4 v00, f32x4 v01, f32x4 v10, f32x4 v11) const {
        const int pm = u.a, cidx = u.b, n = cidx % NCH;
        if (pm >= 4) { const int h = (pm - 4) >> 1, e0 = ((pm - 4) & 1) * 256 + r; u16* be = wsb(p, O_BEXT) + (((size_t)h * NCQ + cidx) * 512 + e0) * 768 + c;
            st4bf(be, v00); st4bf(be + 128, v01); st4bf(be + (size_t)128 * 768, v10); st4bf(be + (size_t)128 * 768 + 128, v11); return; }
        const int h = pm; const float lgf = u.f0, lgb = u.f1, fr = ropef(r, 128);
        u16* kf = wsb(p, O_KTX) + (((size_t)h * NCQ + cidx) * 2 + 0) * 65536; u16* kb = kf + 65536;
        for (int Y = 0; Y < 2; ++Y) { const f32x4 x1 = Y ? v01 : v00, x2 = Y ? v11 : v10; f32x4 f1, f2, b1, b2;
            for (int jx = 0; jx < 4; ++jx) { const int jj = c + 128 * Y + jx; float cs = 1.f, sn = 0.f;
                if (n > 0) sincos_t((float)((n - 1) * 256 + jj) * fr, sn, cs);
                const float r1 = (x1[jx] * cs - x2[jx] * sn) * 0.0625f, r2 = (x2[jx] * cs + x1[jx] * sn) * 0.0625f;
                const float df = ex2(lgf * (float)(255 - jj)), db = ex2(lgb * (float)jj);
                f1[jx] = r1 * df; f2[jx] = r2 * df; b1[jx] = r1 * db; b2[jx] = r2 * db; }
            const int jc = c + 128 * Y;
            st4bf(kf + (size_t)r * 256 + jc, f1); st4bf(kf + (size_t)(r + 128) * 256 + jc, f2); st4bf(kb + (size_t)r * 256 + jc, b1); st4bf(kb + (size_t)(r + 128) * 256 + jc, b2); } } };
struct DRetProjAll { P p; int q; static constexpr int FENCE = 1; static constexpr int K = 1024, lda = 1024, ldb = 1024;
    HD bool unit(int L, Unit& u) const { const DRetProj a{p, q}; const DRetProjT b{p, q};
        if (L < NCQ * 16) { const bool ok = a.unit(L, u); u.d = 0; return ok; } const bool ok = b.unit(L - NCQ * 16, u); u.d = 1; return ok; }
    HD void emit(const Unit& u, int r, int c, f32x4 v00, f32x4 v01, f32x4 v10, f32x4 v11) const {
        if (u.d == 0) { const DRetProj a{p, q}; a.emit(u, r, c, v00, v01, v10, v11); } else { const DRetProjT b{p, q}; b.emit(u, r, c, v00, v01, v10, v11); } } };
struct DRetP { P p; static constexpr int FENCE = 1; static constexpr int K = 256, lda = 1024, ldb = 1024;
    HD bool unit(int L, Unit& u) const { int pm, pn; if (!rect_unit(L, NCQ, 4, pm, pn)) return false;
        u.A = wsb(p, O_QN) + (size_t)pm * 256 * 1024 + pn * 256; u.B = wsb(p, O_KN) + (size_t)pm * 256 * 1024 + pn * 256; u.a = pm; u.b = pn; u.c = 0; u.d = 0;
        u.f0 = ret_logg(p, 0, pn) * 1.4426950408889634f; u.f1 = ret_logg(p, 1, pn) * 1.4426950408889634f; return true; }
    HD void one(u16* ae, float lgf, float lgb, int i, int j0, f32x4 v) const { f32x4 o;
        for (int jx = 0; jx < 4; ++jx) { const int jj = j0 + jx; o[jx] = v[jx] * ex2(jj <= i ? lgf * (float)(i - jj) : lgb * (float)(jj - i)); }
        st4bf(ae + (size_t)i * 768 + j0, o); }
    HD void emit(const Unit& u, int r, int c, f32x4 v00, f32x4 v01, f32x4 v10, f32x4 v11) const {
        const int cidx = u.a, h = u.b; const float lgf = u.f0, lgb = u.f1;
        u16* ae = wsb(p, O_AEXT) + ((size_t)h * NCQ + cidx) * 256 * 768;
        one(ae, lgf, lgb, r, c, v00); one(ae, lgf, lgb, r, c + 128, v01); one(ae, lgf, lgb, r + 128, c, v10); one(ae, lgf, lgb, r + 128, c + 128, v11); } };
struct DRetL { P p; static constexpr int FENCE = 1; static constexpr int K = 256, lda = 768, ldb = 256;
    HD bool unit(int L, Unit& u) const { int pm, pn; if (!rect_unit(L, 4 * NCQ, 4, pm, pn)) return false;
        const int dir = pn >> 1, eh = pn & 1;
        u.A = wsb(p, O_BEXT) + ((size_t)pm * 512 + eh * 256) * 768; u.B = wsb(p, O_KTX) + ((size_t)pm * 2 + dir) * 65536; u.a = pm; u.b = dir; u.c = eh; u.d = 0; return true; }
    HD void emit(const Unit& u, int r, int c, f32x4 v00, f32x4 v01, f32x4 v10, f32x4 v11) const {
        u16* o = wsb(p, O_BEXT) + ((size_t)u.a * 512 + u.c * 256 + r) * 768 + 256 + u.b * 256 + c;
        st4bf(o, v00); st4bf(o + 128, v01); st4bf(o + (size_t)128 * 768, v10); st4bf(o + (size_t)128 * 768 + 128, v11); } };
struct DRetO { P p; static constexpr int FENCE = 1; static constexpr int K = 768, lda = 768, ldb = 768;
    HD bool unit(int L, Unit& u) const { int pm, pn; if (!rect_unit(L, 4 * NCQ, 2, pm, pn)) return false;
        u.A = wsb(p, O_AEXT) + (size_t)pm * 256 * 768; u.B = wsb(p, O_BEXT) + ((size_t)pm * 512 + pn * 256) * 768; u.a = pm; u.b = pn; u.c = 0; u.d = 0; return true; }
    HD void emit(const Unit& u, int r, int c, f32x4 v00, f32x4 v01, f32x4 v10, f32x4 v11) const {
        const int h = u.a / NCQ, cidx = u.a % NCQ;
        u16* o = wsb(p, O_OB) + ((size_t)cidx * 256 + r) * 2048 + h * 512 + u.b * 256 + c;
        st4bf(o, v00); st4bf(o + 128, v01); st4bf(o + (size_t)128 * 2048, v10); st4bf(o + (size_t)128 * 2048 + 128, v11); } };
struct DRetWoCtx { P p; int layer; static constexpr int FENCE = 4; static constexpr int K = 2048, lda = 2048, ldb = 2048;
    HD bool unit(int L, Unit& u) const { int pm, pn; if (!rect_unit(L, NC / 256, 4, pm, pn)) return false;
        u.A = wsb(p, O_YCTX) + (size_t)pm * 256 * 2048; u.B = wsb(p, O_RWO) + (size_t)pn * 256 * 2048; u.a = NL + pm * 256; u.b = pn; u.c = 0; u.d = 0; return true; }
    HD void emit(const Unit& u, int r, int c, f32x4 v00, f32x4 v01, f32x4 v10, f32x4 v11) const {
        const int R = u.a + r, col = u.b * 256 + c;
        resid4(p, layer, 5, 1.0f, R, col, v00); resid4(p, layer, 5, 1.0f, R, col + 128, v01); resid4(p, layer, 5, 1.0f, R + 128, col, v10); resid4(p, layer, 5, 1.0f, R + 128, col + 128, v11); } };
struct DRetWo { P p; int layer, q; static constexpr int FENCE = 4; static constexpr int K = 2048, lda = 2048, ldb = 2048;
    HD bool unit(int L, Unit& u) const { int pl, pn; if (!rect_unit(L, NCQ - RGB, 4, pl, pn)) return false; const int pm = pl + pl / (NCH - 1) + 1;
        u.A = wsb(p, O_OB) + (size_t)pm * 256 * 2048; u.B = wsb(p, O_RWO) + (size_t)pn * 256 * 2048; u.a = ret_tokrow(q, pm); u.b = pn; u.c = 0; u.d = 0; return true; }
    HD void emit(const Unit& u, int r, int c, f32x4 v00, f32x4 v01, f32x4 v10, f32x4 v11) const {
        const int R = u.a + r, col = u.b * 256 + c;
        resid4(p, layer, 5, 1.0f, R, col, v00); resid4(p, layer, 5, 1.0f, R, col + 128, v01); resid4(p, layer, 5, 1.0f, R + 128, col, v10); resid4(p, layer, 5, 1.0f, R + 128, col + 128, v11); } };

struct DS5L { P p; static constexpr int FENCE = 1; static constexpr int K = 512, lda = 768, ldb = 512;
    HD bool unit(int L, Unit& u) const { int pm, pn; if (!rect_unit(L, NROW5P / 256, 64, pm, pn)) return false;
        u.A = wsb(p, O_UEXT) + ((size_t)pn * NROW5P + pm * 256) * 768; u.B = wsb(p, O_FEXT) + (size_t)pn * 256 * 512; u.a = pm; u.b = pn; u.c = 0; u.d = 0; return true; }
    HD void emit(const Unit& u, int r, int c, f32x4 v00, f32x4 v01, f32x4 v10, f32x4 v11) const {
        u16* o = wsb(p, O_UEXT) + ((size_t)u.b * NROW5P + u.a * 256 + r) * 768 + 512 + c;
        st4bf(o, v00); st4bf(o + 128, v01); st4bf(o + (size_t)128 * 768, v10); st4bf(o + (size_t)128 * 768 + 128, v11); } };
struct DS5Y { P p; static constexpr int FENCE = 1; static constexpr int K = 768, lda = 768, ldb = 768;
    HD bool unit(int L, Unit& u) const { int pm, pn; if (!rect_unit(L, NROW5P / 256, 128, pm, pn)) return false;
        const int g = pn >> 1, ch = pn & 1;
        u.A = wsb(p, O_UEXT) + ((size_t)g * NROW5P + pm * 256) * 768; u.B = wsb(p, O_TEXT) + ((size_t)g * 512 + ch * 256) * 768; u.a = pm; u.b = g; u.c = ch; u.d = 0; return true; }
    HD void one(int g, int row, int col, f32x4 v) const {
        int tok; if (row < NB * S5L) tok = (row / S5L) * SEQ + (row % S5L) * 32; else if (row < NROW5) { const int rr = row - NB * S5L; tok = NL + (rr / S5C) * 256 + (rr % S5C) * 32; } else return;
        f32x4 o; for (int jx = 0; jx < 4; ++jx) o[jx] = gelu_f(v[jx]);
        st4bf(wsb(p, O_HN) + (size_t)(tok + (col >> 4)) * 1024 + g * 16 + (col & 15), o); }
    HD void emit(const Unit& u, int r, int c, f32x4 v00, f32x4 v01, f32x4 v10, f32x4 v11) const {
        const int row = u.a * 256 + r, col = u.c * 256 + c;
        one(u.b, row, col, v00); one(u.b, row, col + 128, v01); one(u.b, row + 128, col, v10); one(u.b, row + 128, col + 128, v11); } };
struct DS5Glu { P p; int layer; static constexpr int FENCE = 4; static constexpr int K = 1024, lda = 1024, ldb = 1024;
    HD bool unit(int L, Unit& u) const { int pm, pn; if (!rect_unit(L, MT / 256, 8, pm, pn)) return false;
        u.A = wsb(p, O_HN) + (size_t)pm * 256 * 1024; u.B = wsb(p, O_GLU) + (size_t)pn * 256 * 1024; u.a = pm; u.b = pn; u.c = 0; u.d = 0; return true; }
    HD void emit(const Unit& u, int r, int c, f32x4 v00, f32x4 v01, f32x4 v10, f32x4 v11) const {
        const int col = u.b * 128 + c; const float* gb = p.in[30]; f32x4 y0, y1;
        for (int jx = 0; jx < 4; ++jx) { const float ba = gb[col + jx], bg = gb[1024 + col + jx];
            y0[jx] = (v00[jx] + ba) * sigm_f(v01[jx] + bg); y1[jx] = (v10[jx] + ba) * sigm_f(v11[jx] + bg); }
        resid4(p, layer, 5, 1.0f, u.a * 256 + r, col, y0); resid4(p, layer, 5, 1.0f, u.a * 256 + r + 128, col, y1); } };

HD void cvt64(const float* src, int N, int srccol, u16* dst, int Kd, int nrow, int k0) {
    float v[64];
#pragma unroll
    for (int j = 0; j < 64; ++j) v[j] = srccol >= 0 ? src[(size_t)(k0 + j) * N + srccol] : 0.f;
#pragma unroll
    for (int j = 0; j < 64; j += 4) { f32x4 a; a[0] = v[j]; a[1] = v[j + 1]; a[2] = v[j + 2]; a[3] = v[j + 3]; st4bf(dst + (size_t)nrow * Kd + k0 + j, a); } }
constexpr long CV_FFI = (long)8 * 5632 * 16, CV_FFO = (long)8 * 1024 * 44, CV_MWIN = (long)2 * 768 * 16, CV_MWUQ = (long)2 * 1536 * 6, CV_MWUKV = (long)2 * 2048 * 4,
               CV_MWO = (long)2 * 1024 * 16, CV_RWIN = (long)6144 * 16, CV_RWO = (long)1024 * 32, CV_GLU = (long)2048 * 16;
constexpr long CV_TOTAL = CV_FFI + CV_FFO + CV_MWIN + CV_MWUQ + CV_MWUKV + CV_MWO + CV_RWIN + CV_RWO + CV_GLU;
HD void cvt_item(const P& p, long idx) {
    if (idx < CV_FFI) { const int n = (int)(idx % 5632); const long t = idx / 5632; const int kb = (int)(t % 16), m = (int)(t / 16);
        const int tile = n >> 8, rr = n & 255; const int sc = rr < 128 ? tile * 128 + rr : 2816 + tile * 128 + (rr - 128);
        cvt64(p.in[7] + (size_t)m * 1024 * 5632, 5632, sc, wsb(p, O_FFI + (size_t)m * SZ_FFI1), 1024, n, kb * 64); return; }
    idx -= CV_FFI;
    if (idx < CV_FFO) { const int n = (int)(idx % 1024); const long t = idx / 1024; const int kb = (int)(t % 44), m = (int)(t / 44);
        cvt64(p.in[8] + (size_t)m * 2816 * 1024, 1024, n, wsb(p, O_FFO + (size_t)m * SZ_FFO1), 2816, n, kb * 64); return; }
    idx -= CV_FFO;
    if (idx < CV_MWIN) { const int n = (int)(idx % 768); const long t = idx / 768; const int kb = (int)(t % 16), m = (int)(t / 16);
        cvt64(p.in[9] + (size_t)m * 1024 * 704, 704, n < 704 ? n : -1, wsb(p, O_MWIN + (size_t)m * SZ_MWIN), 1024, n, kb * 64); return; }
    idx -= CV_MWIN;
    if (idx < CV_MWUQ) { const int n = (int)(idx % 1536); const long t = idx / 1536; const int kb = (int)(t % 6), m = (int)(t / 6);
        cvt64(p.in[12] + (size_t)m * 384 * 1536, 1536, n, wsb(p, O_MWUQ + (size_t)m * SZ_MWUQ), 384, n, kb * 64); return; }
    idx -= CV_MWUQ;
    if (idx < CV_MWUKV) { const int n = (int)(idx % 2048); const long t = idx / 2048; const int kb = (int)(t % 4), m = (int)(t / 4);
        const int sc = n < 1024 ? (n >> 7) * 256 + (n & 127) : ((n - 1024) >> 7) * 256 + 128 + (n & 127);
        cvt64(p.in[13] + (size_t)m * 256 * 2048, 2048, sc, wsb(p, O_MWUKV + (size_t)m * SZ_MWUKV), 256, n, kb * 64); return; }
    idx -= CV_MWUKV;
    if (idx < CV_MWO) { const int n = (int)(idx % 1024); const long t = idx / 1024; const int kb = (int)(t % 16), m = (int)(t / 16);
        cvt64(p.in[16] + (size_t)m * 1024 * 1024, 1024, n, wsb(p, O_MWO + (size_t)m * SZ_MWO), 1024, n, kb * 64); return; }
    idx -= CV_MWO;
    if (idx < CV_RWIN) { const int n = (int)(idx % 6144), kb = (int)(idx / 6144); cvt64(p.in[17], 6144, n, wsb(p, O_RWIN), 1024, n, kb * 64); return; }
    idx -= CV_RWIN;
    if (idx < CV_RWO) { const int n = (int)(idx % 1024), kb = (int)(idx / 1024); cvt64(p.in[20], 1024, n, wsb(p, O_RWO), 2048, n, kb * 64); return; }
    idx -= CV_RWO;
    { const int n = (int)(idx % 2048), kb = (int)(idx / 2048); const int tile = n >> 8, rr = n & 255; const int sc = rr < 128 ? tile * 128 + rr : 1024 + tile * 128 + (rr - 128);
      cvt64(p.in[29], 2048, sc, wsb(p, O_GLU), 1024, n, kb * 64); }
}
HD void mod_item(const P& p, int idx) {
    const int layer = idx / 9216, col = idx % 9216; const float* w = p.in[4] + (size_t)layer * 1024 * 9216 + col; float acc[NMR];
    for (int b = 0; b < NMR; ++b) acc[b] = 0.f;
    for (int k = 0; k < 1024; ++k) { const float wv = w[(size_t)k * 9216];
#pragma unroll
        for (int b = 0; b < NMR; ++b) { const float cv = b < NB ? p.in[1][b * 1024 + k] : p.in[3][k]; acc[b] += silu_f(cv) * wv; } }
    const float bias = p.in[5][layer * 9216 + col];
#pragma unroll
    for (int b = 0; b < NMR; ++b) ((float*)(p.ws + O_MOD))[(size_t)(layer * NMR + b) * 9216 + col] = acc[b] + bias; }
HD void copy_item(const P& p, long idx) {
    const long nl4 = (long)NL * 256;
    if (idx < nl4) ((f32x4*)p.out)[idx] = ((const f32x4*)p.in[0])[idx]; else ((f32x4*)(p.ws + O_G))[idx - nl4] = ((const f32x4*)p.in[2])[idx - nl4]; }
HD void norm_item(const P& p, int layer, int k, int r, int s5) {
    const float* x = hsrc(p, r, layer == 0 && k == 0); float ss = 0.f;
    for (int d = 0; d < 1024; d += 4) { const f32x4 v = *(const f32x4*)(x + d); ss += v[0] * v[0] + v[1] * v[1] + v[2] * v[2] + v[3] * v[3]; }
    const float rinv = rsq_f(ss * (1.0f / 1024.0f) + EPS);
    const float* g = p.in[6] + (size_t)(layer * 3 + k) * 1024; const float* sh = modp(p, layer, r, 3 * k); const float* sc = modp(p, layer, r, 3 * k + 1);
    int row5 = 0, i5 = 0;
    if (s5) { if (r < NL) { const int b = r / SEQ, t = r % SEQ; row5 = b * S5L + t / 32; i5 = t % 32; } else { const int rr = r - NL; const int b = rr / 256, l = rr % 256; row5 = NB * S5L + b * S5C + l / 32; i5 = l % 32; } }
    for (int d = 0; d < 1024; d += 4) { const f32x4 v = *(const f32x4*)(x + d); f32x4 o;
        for (int j = 0; j < 4; ++j) o[j] = v[j] * rinv * g[d + j] * (1.0f + sc[d + j]) + sh[d + j];
        if (!s5) st4bf(wsb(p, O_HN) + (size_t)r * 1024 + d, o);
        else st4bf(wsb(p, O_UEXT) + ((size_t)(d >> 4) * NROW5P + row5) * 768 + i5 * 16 + (d & 15), o); } }
HD void axial_rot64(float* v, int t) {
    const int prow = t / 64, pcol = t % 64;
    for (int f = 0; f < 16; ++f) { const float fq = ropef(f, 16);
        { float cs, sn; sincos_t((float)prow * fq, sn, cs); const float x1 = v[f], x2 = v[16 + f]; v[f] = x1 * cs - x2 * sn; v[16 + f] = x2 * cs + x1 * sn; }
        { float cs, sn; sincos_t((float)pcol * fq, sn, cs); const float x1 = v[32 + f], x2 = v[48 + f]; v[32 + f] = x1 * cs - x2 * sn; v[48 + f] = x2 * cs + x1 * sn; } } }
HD void mla_row_item(const P& p, int j, int r) {
    const float* x = (const float*)(p.ws + O_CALL) + (size_t)r * 768; float ss = 0.f;
    for (int d = 0; d < 384; ++d) ss += x[d] * x[d];
    float rinv = rsq_f(ss * (1.0f / 384.0f) + EPS); const float* qn = p.in[10] + j * 384;
    for (int d = 0; d < 384; d += 4) { f32x4 o; for (int jx = 0; jx < 4; ++jx) o[jx] = x[d + jx] * rinv * qn[d + jx]; st4bf(wsb(p, O_CQN) + (size_t)r * 384 + d, o); }
    ss = 0.f; for (int d = 0; d < 256; ++d) ss += x[384 + d] * x[384 + d];
    rinv = rsq_f(ss * (1.0f / 256.0f) + EPS); const float* kvn = p.in[11] + j * 256;
    for (int d = 0; d < 256; d += 4) { f32x4 o; for (int jx = 0; jx < 4; ++jx) o[jx] = x[384 + d + jx] * rinv * kvn[d + jx]; st4bf(wsb(p, O_CKVN) + (size_t)r * 256 + d, o); }
    ss = 0.f; for (int d = 0; d < 64; ++d) ss += x[640 + d] * x[640 + d];
    rinv = rsq_f(ss * (1.0f / 64.0f) + EPS); const float* kg = p.in[15] + j * 192 + 128;
#ifdef HOST_EMU
    float kr[64];
    for (int d = 0; d < 64; ++d) kr[d] = x[640 + d] * rinv * kg[d];
    if (r < NL) axial_rot64(kr, r % SEQ);
    for (int h = 0; h < 8; ++h) for (int d = 0; d < 64; ++d) wsb(p, O_KF)[(size_t)r * 1536 + h * 192 + 128 + d] = f2bf(kr[d]);
#else
    const int t = r % SEQ, prow = t / 64, pcol = t % 64;
    for (int f = 0; f < 16; ++f) { const float fq = ropef(f, 16);
#pragma unroll
        for (int part = 0; part < 2; ++part) { float cs = 1.f, sn = 0.f; if (r < NL) sincos_t((float)(part ? pcol : prow) * fq, sn, cs);
            const int d1 = part * 32 + f, d2 = d1 + 16; const float x1 = x[640 + d1] * rinv * kg[d1], x2 = x[640 + d2] * rinv * kg[d2];
            const u16 o1 = f2bf(x1 * cs - x2 * sn), o2 = f2bf(x2 * cs + x1 * sn);
            for (int h = 0; h < 8; ++h) { wsb(p, O_KF)[(size_t)r * 1536 + h * 192 + 128 + d1] = o1; wsb(p, O_KF)[(size_t)r * 1536 + h * 192 + 128 + d2] = o2; } } }
#endif
}
HD void mla_head_item(const P& p, int j, int idx) {
    const int r = idx >> 3, h = idx & 7;
    u16* q = wsb(p, O_CALL) + (size_t)r * 1536 + h * 192; const float* qg = p.in[14] + j * 192; float ss = 0.f;
    for (int d = 0; d < 128; ++d) { const float v = bf2f(q[d]); ss += v * v; }
    float rinv = rsq_f(ss * (1.0f / 128.0f) + EPS);
    for (int d = 0; d < 128; ++d) q[d] = f2bf(bf2f(q[d]) * rinv * qg[d] * QSCALE);
    ss = 0.f; for (int d = 0; d < 64; ++d) { const float v = bf2f(q[128 + d]); ss += v * v; }
    rinv = rsq_f(ss * (1.0f / 64.0f) + EPS);
    { const int t = r % SEQ, prow = t / 64, pcol = t % 64;
      for (int f = 0; f < 16; ++f) { const float fq = ropef(f, 16);
#pragma unroll
        for (int part = 0; part < 2; ++part) { float cs = 1.f, sn = 0.f; if (r < NL) sincos_t((float)(part ? pcol : prow) * fq, sn, cs);
            const int d1 = 128 + part * 32 + f, d2 = d1 + 16; const float x1 = bf2f(q[d1]) * rinv * qg[d1], x2 = bf2f(q[d2]) * rinv * qg[d2];
            q[d1] = f2bf((x1 * cs - x2 * sn) * QSCALE); q[d2] = f2bf((x2 * cs + x1 * sn) * QSCALE); } } }
    u16* k = wsb(p, O_KF) + (size_t)r * 1536 + h * 192; const float* kg = p.in[15] + j * 192;
    ss = 0.f; for (int d = 0; d < 128; ++d) { const float v = bf2f(k[d]); ss += v * v; }
    rinv = rsq_f(ss * (1.0f / 128.0f) + EPS);
    for (int d = 0; d < 128; ++d) k[d] = f2bf(bf2f(k[d]) * rinv * kg[d]);
}
HD void ret_prefix_item(const P& p, int idx) {
    const int d4 = idx & 63, e = (idx >> 6) & 511, bq = (idx >> 15) % RGB, h = (idx >> 15) / RGB;
    const float gf = expf(256.f * ret_logg(p, 0, h)), gb = expf(256.f * ret_logg(p, 1, h));
    u16* base = wsb(p, O_BEXT) + (((size_t)h * NCQ + bq * NCH) * 512 + e) * 768 + d4 * 4; constexpr size_t CS = (size_t)512 * 768;
    u32x2 tf[NCH], tb[NCH];
#pragma unroll
    for (int n = 0; n < NCH; ++n) { tf[n] = *(const u32x2*)(base + n * CS + 256); tb[n] = *(const u32x2*)(base + n * CS + 512); }
    f32x4 cf = {0.f, 0.f, 0.f, 0.f}, cb = {0.f, 0.f, 0.f, 0.f};
#pragma unroll
    for (int n = 0; n < NCH; ++n) { f32x4 t; t[0] = bf2f((u16)(tf[n].x & 0xffff)); t[1] = bf2f((u16)(tf[n].x >> 16)); t[2] = bf2f((u16)(tf[n].y & 0xffff)); t[3] = bf2f((u16)(tf[n].y >> 16));
        st4bf(base + n * CS + 256, cf); cf = cf * gf + t; }
#pragma unroll
    for (int s_ = 0; s_ < NCH; ++s_) { const int n = s_ == 0 ? 0 : NCH - s_; f32x4 t; t[0] = bf2f((u16)(tb[n].x & 0xffff)); t[1] = bf2f((u16)(tb[n].x >> 16)); t[2] = bf2f((u16)(tb[n].y & 0xffff)); t[3] = bf2f((u16)(tb[n].y >> 16));
        st4bf(base + n * CS + 512, cb); cb = cb * gb + t; } }
HD u16* ret_ydst(const P& p, int q, int lr) { const int cidx = lr >> 8, n = cidx % NCH; return n == 0 ? wsb(p, O_YCTX) + ((size_t)((q * RGB + cidx / NCH) * 256 + (lr & 255))) * 2048 : wsb(p, O_OB) + (size_t)lr * 2048; }
HD void ret_norm_item(const P& p, int qg, int idx) {
    const int lr = idx >> 2, h = idx & 3; u16* o = wsb(p, O_OB) + (size_t)lr * 2048 + h * 512; u16* yd = ret_ydst(p, qg, lr) + h * 512; const u16* g = wsb(p, O_GATE) + (size_t)lr * 2048 + h * 512; const float* gg = p.in[19] + h * 512;
    float s = 0.f; for (int e = 0; e < 512; ++e) s += bf2f(o[e]);
    const float mu = s * (1.0f / 512.0f); float q = 0.f; for (int e = 0; e < 512; ++e) { const float d = bf2f(o[e]) - mu; q += d * d; }
    const float rstd = rsq_f(q * (1.0f / 512.0f) + EPS);
    for (int e = 0; e < 512; ++e) yd[e] = f2bf((bf2f(o[e]) - mu) * rstd * gg[e] * silu_f(bf2f(g[e]))); }
struct Cx { float re, im; };
HD Cx cmul(Cx a, Cx b) { Cx r; r.re = a.re * b.re - a.im * b.im; r.im = a.re * b.im + a.im * b.re; return r; }
HD Cx s5_alog(const P& p, int dir, int g, int pp) { const float dt = expf(p.in[23][dir * 64 + g]); Cx r; r.re = p.in[21][(dir * 64 + g) * 64 + pp] * dt; r.im = p.in[22][(dir * 64 + g) * 64 + pp] * dt; return r; }
HD Cx cpowa(Cx al, float n) { const float m = expf(al.re * n); float sn, cs; sincos_t(al.im * n * 0.15915494309189535f, sn, cs); Cx r; r.re = m * cs; r.im = m * sn; return r; }
HD Cx s5_coef(const P& p, int dir, int g, int pp) {
    const Cx al = s5_alog(p, dir, g, pp); Cx a = cpowa(al, 1.f); a.re -= 1.f; const float lr = p.in[21][(dir * 64 + g) * 64 + pp], li = p.in[22][(dir * 64 + g) * 64 + pp], den = 1.0f / (lr * lr + li * li);
    Cx r; r.re = (a.re * lr + a.im * li) * den; r.im = (a.im * lr - a.re * li) * den; return r; }
HD Cx s5_bbar(const P& p, int dir, int g, int pp, int m) { Cx b; const size_t o = (((size_t)dir * 64 + g) * 64 + pp) * 16 + m; b.re = p.in[24][o]; b.im = p.in[25][o]; return cmul(s5_coef(p, dir, g, pp), b); }
HD Cx s5_c(const P& p, int dir, int g, int m, int pp) { Cx c; const size_t o = (((size_t)dir * 64 + g) * 16 + m) * 64 + pp; c.re = p.in[26][o]; c.im = p.in[27][o]; return c; }
HD void s5_ktab_item(const P& p, int idx) {
    const int m = idx & 15, tau = (idx >> 4) & 31, dir = (idx >> 9) & 1, g = idx >> 10; float acc[16];
#pragma unroll
    for (int m2 = 0; m2 < 16; ++m2) acc[m2] = 0.f;
    for (int pp = 0; pp < 64; ++pp) { const Cx w = cmul(cmul(s5_c(p, dir, g, m, pp), cpowa(s5_alog(p, dir, g, pp), (float)tau)), s5_coef(p, dir, g, pp));
        const size_t o = (((size_t)dir * 64 + g) * 64 + pp) * 16;
#pragma unroll
        for (int m2 = 0; m2 < 16; ++m2) acc[m2] += w.re * p.in[24][o + m2] - w.im * p.in[25][o + m2]; }
#pragma unroll
    for (int m2 = 0; m2 < 16; ++m2) ((float*)(p.ws + O_KTAB))[(size_t)idx * 16 + m2] = acc[m2]; }
HD void s5_text_item(const P& p, long idx) {
    const int col = (int)(idx % 768); const long t = idx / 768; const int row = (int)(t % 512), g = (int)(t / 512), i = row >> 4, m = row & 15; float v;
    const float* kt = (const float*)(p.ws + O_KTAB);
    if (col < 512) { const int jj = col >> 4, m2 = col & 15; v = 0.f;
        if (jj <= i) v += kt[((((size_t)g * 2 + 0) * 32 + (i - jj)) * 16 + m) * 16 + m2];
        if (jj >= i) v += kt[((((size_t)g * 2 + 1) * 32 + (jj - i)) * 16 + m) * 16 + m2];
        if (jj == i && m == m2) v += p.in[28][g * 16 + m]; }
    else { const int dir = col >= 640, pp = ((col - 512) & 127) >> 1, part = col & 1;
        const Cx w = cmul(s5_c(p, dir, g, m, pp), cpowa(s5_alog(p, dir, g, pp), dir ? (float)(32 - i) : (float)(i + 1))); v = part ? -w.im : w.re; }
    wsb(p, O_TEXT)[idx] = f2bf(v); }
HD void s5_fext_item(const P& p, int idx) {
    const int col = idx & 511, row = (idx >> 9) & 255, g = idx >> 17, jj = col >> 4, m2 = col & 15, dir = row >> 7, pp = (row & 127) >> 1, part = row & 1;
    const Cx w = cmul(cpowa(s5_alog(p, dir, g, pp), dir ? (float)jj : (float)(31 - jj)), s5_bbar(p, dir, g, pp, m2));
    wsb(p, O_FEXT)[idx] = f2bf(part ? w.im : w.re); }
HD int s5_row(int b, int s) { return s < S5C ? NB * S5L + b * S5C + s : b * S5L + (s - S5C); }
HD void s5_prefix_item(const P& p, int idx) {
    const int pp = idx & 63, b = (idx >> 6) % NB, g = (idx >> 6) / NB;
    const Cx af = cpowa(s5_alog(p, 0, g, pp), 32.f), ab = cpowa(s5_alog(p, 1, g, pp), 32.f);
    u16* base = wsb(p, O_UEXT) + (size_t)g * NROW5P * 768; Cx c; c.re = 0.f; c.im = 0.f;
    for (int s0 = 0; s0 < S5C + S5L; s0 += 8) { unsigned t[8];
#pragma unroll
        for (int k = 0; k < 8; ++k) t[k] = *(const unsigned*)(base + (size_t)s5_row(b, s0 + k) * 768 + 512 + 2 * pp);
#pragma unroll
        for (int k = 0; k < 8; ++k) { u16* q = base + (size_t)s5_row(b, s0 + k) * 768 + 512 + 2 * pp; *(unsigned*)q = (unsigned)f2bf(c.re) | ((unsigned)f2bf(c.im) << 16);
            c = cmul(af, c); c.re += bf2f((u16)(t[k] & 0xffff)); c.im += bf2f((u16)(t[k] >> 16)); } }
    c.re = 0.f; c.im = 0.f;
    for (int s0 = 0; s0 < S5C + S5L; s0 += 8) { unsigned t[8]; int sv[8];
#pragma unroll
        for (int k = 0; k < 8; ++k) { const int s_ = s0 + k; sv[k] = s_ < S5C ? S5C - 1 - s_ : S5C + S5L - 1 - (s_ - S5C); t[k] = *(const unsigned*)(base + (size_t)s5_row(b, sv[k]) * 768 + 640 + 2 * pp); }
#pragma unroll
        for (int k = 0; k < 8; ++k) { u16* q = base + (size_t)s5_row(b, sv[k]) * 768 + 640 + 2 * pp; *(unsigned*)q = (unsigned)f2bf(c.re) | ((unsigned)f2bf(c.im) << 16);
            c = cmul(ab, c); c.re += bf2f((u16)(t[k] & 0xffff)); c.im += bf2f((u16)(t[k] >> 16)); } } }

struct AttItem { const u16* q; const u16* k0; const u16* k1; const u16* v0; const u16* v1; u16* o; int n0, ntot; };
HD void att_item(const P& p, int it, AttItem& a) {
    const u16* Q = wsb(p, O_CALL); const u16* KF = wsb(p, O_KF); const u16* VB = wsb(p, O_VB); u16* O = wsb(p, O_HN);
    const int nlat = NB * 8 * (SEQ / 256);
    if (it < nlat) { int itx = it;
        if (SEQ / 256 == 16 && nlat % 256 == 0) { const int i_ = it >> 8, c_ = it & 255, x_ = c_ & 7, s_ = c_ >> 3; itx = ((i_ * 16 + 2 * x_ + (s_ >> 4)) << 4) | (s_ & 15); }
        const int qb = itx % (SEQ / 256), h = (itx / (SEQ / 256)) & 7, b = itx / (SEQ / 256) / 8; const size_t r0 = (size_t)b * SEQ + qb * 256, c0 = (size_t)NL + b * 256, l0 = (size_t)b * SEQ;
        a.q = Q + r0 * 1536 + h * 192; a.o = O + r0 * 1024 + h * 128; a.k0 = KF + c0 * 1536 + h * 192; a.v0 = VB + c0 * 1024 + h * 128; a.k1 = KF + l0 * 1536 + h * 192; a.v1 = VB + l0 * 1024 + h * 128; a.n0 = 256; a.ntot = 256 + SEQ; }
    else { const int x = it - nlat, h = x & 7, b = x >> 3; const size_t c0 = (size_t)NL + b * 256;
        a.q = Q + c0 * 1536 + h * 192; a.o = O + c0 * 1024 + h * 128; a.k0 = KF + c0 * 1536 + h * 192; a.v0 = VB + c0 * 1024 + h * 128; a.k1 = a.k0; a.v1 = a.v0; a.n0 = 256; a.ntot = 256; } }

#ifndef HOST_EMU
#define LAS __attribute__((address_space(3)))
typedef short bf16x8 __attribute__((ext_vector_type(8)));
typedef short s16x4 __attribute__((ext_vector_type(4)));
typedef float f32x16 __attribute__((ext_vector_type(16)));
typedef unsigned u32x4 __attribute__((ext_vector_type(4)));
constexpr int HTB = 128 * 64 * 2, STAGE_BYTES = 8 * HTB;
__device__ __forceinline__ int lds_byte(int r, int c) { const int st = (r >> 4) * 2 + (c >> 5), rr = r & 15, cc = c & 31, ob = rr * 64 + cc * 2; return st * 1024 + (ob ^ (((ob >> 9) & 1) << 5)); }
__device__ __forceinline__ void stage_rc(int b, int& R, int& C) { const int st = b / 1024, sb = b % 1024, swz = sb ^ (((sb >> 9) & 1) << 5); R = (st >> 1) * 16 + swz / 64; C = (st & 1) * 32 + (swz % 64) / 2; }

template <class Dsc>
__device__ __forceinline__ void gemm_run(LAS unsigned char* lds, const Dsc& D) {
    int tid_ = threadIdx.x; asm volatile("" : "+v"(tid_));
    const int tid = tid_, wid = __builtin_amdgcn_readfirstlane(tid >> 6), lane = tid & 63, wr = wid >> 2, wc = wid & 3, fr = lane & 15, fq = lane >> 4;
    constexpr int K = Dsc::K, nt = K / 64, lda = Dsc::lda, ldb = Dsc::ldb;
    static_assert(K % 128 == 0 && K >= 256, "K");
    unsigned voffA[2], voffB[2];
#pragma unroll
    for (int i = 0; i < 2; ++i) { int R, C; stage_rc(tid * 16 + i * 8192, R, C); voffA[i] = (unsigned)(R * lda + C) * 2u; voffB[i] = (unsigned)(R * ldb + C) * 2u; }
    constexpr size_t kstep = 128, hstepA = (size_t)128 * lda * 2, hstepB = (size_t)128 * ldb * 2;
    const unsigned ldsw = (unsigned)wid * 1024u;
    const int aoff = lds_byte(wr * 64 + fr, fq * 8), boff = lds_byte(wc * 32 + fr, fq * 8);
#define G_SA(b, h) (((b) * 2 + (h)) * HTB)
#define G_SB(b, h) ((4 + (b) * 2 + (h)) * HTB)
#define G_STAGE(bufoff, gbase, voff) do { _Pragma("unroll") for (int _i = 0; _i < 2; ++_i) \
        __builtin_amdgcn_global_load_lds((const unsigned*)((const char*)(gbase) + (voff)[_i]), (LAS unsigned*)(lds + (bufoff) + ldsw + _i * 8192), 16, 0, 0); } while (0)
#define G_LDA(dst, b, h) do { _Pragma("unroll") for (int m = 0; m < 4; ++m) _Pragma("unroll") for (int k = 0; k < 2; ++k) dst[m][k] = *(const LAS bf16x8*)(lds + G_SA(b, h) + aoff + m * 2048 + k * 1024); } while (0)
#define G_LDB(dst, b, h) do { _Pragma("unroll") for (int n = 0; n < 2; ++n) _Pragma("unroll") for (int k = 0; k < 2; ++k) dst[n][k] = *(const LAS bf16x8*)(lds + G_SB(b, h) + boff + n * 2048 + k * 1024); } while (0)
#define G_MMA(ai, bj, At, Bt) do { __builtin_amdgcn_s_setprio(1); _Pragma("unroll") for (int m = 0; m < 4; ++m) _Pragma("unroll") for (int n = 0; n < 2; ++n) _Pragma("unroll") for (int k = 0; k < 2; ++k) \
        acc[ai][bj][m][n] = __builtin_amdgcn_mfma_f32_16x16x32_bf16(Bt[n][k], At[m][k], acc[ai][bj][m][n], 0, 0, 0); __builtin_amdgcn_s_setprio(0); } while (0)
#define G_WAIT_V(n) asm volatile("s_waitcnt vmcnt(" #n ")" ::: "memory")
#define G_WAIT_L(n) asm volatile("s_waitcnt lgkmcnt(" #n ")" ::: "memory")
#define G_BAR __builtin_amdgcn_s_barrier()
#define G_SCHED __builtin_amdgcn_sched_barrier(0)
    Unit cur{}, nxt{}; int ui = 0; const int G = gridDim.x, cb = blockIdx.x;
    if (!D.unit(cb, cur)) return;
    f32x4 acc[2][2][4][2];
#pragma unroll
    for (int a = 0; a < 2; ++a)
#pragma unroll
        for (int b = 0; b < 2; ++b)
#pragma unroll
            for (int m = 0; m < 4; ++m)
#pragma unroll
                for (int n = 0; n < 2; ++n) acc[a][b][m][n] = (f32x4){0.f, 0.f, 0.f, 0.f};
    bf16x8 At[4][2], B0[2][2], B1[2][2];
    const char* cA = (const char*)cur.A; const char* cB = (const char*)cur.B;
    G_STAGE(G_SB(0, 0), cB, voffB); G_STAGE(G_SA(0, 0), cA, voffA); G_STAGE(G_SB(0, 1), cB + hstepB, voffB); G_STAGE(G_SA(0, 1), cA + hstepA, voffA);
    if (wr == 1) G_BAR;
    G_WAIT_V(4); G_BAR;
    G_STAGE(G_SB(1, 0), cB + kstep, voffB); G_STAGE(G_SA(1, 0), cA + kstep, voffA); G_STAGE(G_SB(1, 1), cB + hstepB + kstep, voffB);
    G_WAIT_V(6); G_BAR;
    for (;;) {
        const bool has_next = D.unit((ui + 1) * G + cb, nxt);
        const char* nA = has_next ? (const char*)nxt.A : cA; const char* nB = has_next ? (const char*)nxt.B : cB;
        _Pragma("nounroll") for (int t = 0; t < nt; t += 2) {
            const bool last = (t == nt - 2);
            const char* a1 = cA + (size_t)(t + 1) * kstep;
            const char* a2 = last ? nA : cA + (size_t)(t + 2) * kstep; const char* b2 = last ? nB : cB + (size_t)(t + 2) * kstep;
            const char* a3 = a2 + kstep; const char* b3 = b2 + kstep;
            G_LDB(B0, 0, 0); G_SCHED; G_LDA(At, 0, 0); G_STAGE(G_SA(1, 1), a1 + hstepA, voffA);
            G_WAIT_L(8); G_BAR; G_WAIT_L(0); G_MMA(0, 0, At, B0); G_BAR; G_SCHED;
            G_LDB(B1, 0, 1); G_STAGE(G_SB(0, 0), b2, voffB);
            G_BAR; G_WAIT_L(0); G_MMA(0, 1, At, B1); G_BAR;
            G_LDA(At, 0, 1); G_STAGE(G_SA(0, 0), a2, voffA);
            G_BAR; G_WAIT_L(0); G_MMA(1, 0, At, B0); G_BAR; G_SCHED;
            G_STAGE(G_SB(0, 1), b2 + hstepB, voffB);
            G_WAIT_V(6); G_BAR; G_MMA(1, 1, At, B1); G_BAR;
            G_LDB(B0, 1, 0); G_SCHED; G_LDA(At, 1, 0); G_STAGE(G_SA(0, 1), a2 + hstepA, voffA);
            G_WAIT_L(8); G_BAR; G_WAIT_L(0); G_MMA(0, 0, At, B0); G_BAR; G_SCHED;
            G_LDB(B1, 1, 1); G_STAGE(G_SB(1, 0), b3, voffB);
            G_BAR; G_WAIT_L(0); G_MMA(0, 1, At, B1); G_BAR;
            G_LDA(At, 1, 1); G_STAGE(G_SA(1, 0), a3, voffA);
            G_BAR; G_WAIT_L(0); G_MMA(1, 0, At, B0); G_BAR; G_SCHED;
            G_STAGE(G_SB(1, 1), b3 + hstepB, voffB);
            G_WAIT_V(6); G_BAR; G_MMA(1, 1, At, B1); G_BAR;
        }
        int er_ = wr * 64 + fr, ec_ = wc * 32 + fq * 4; asm volatile("" : "+v"(er_), "+v"(ec_));
#pragma unroll
        for (int m = 0; m < 4; ++m)
#pragma unroll
            for (int n = 0; n < 2; ++n) { D.emit(cur, er_ + m * 16, ec_ + n * 16, acc[0][0][m][n], acc[0][1][m][n], acc[1][0][m][n], acc[1][1][m][n]); if (((m * 2 + n + 1) % Dsc::FENCE) == 0) asm volatile("" ::: "memory"); }
        if (!has_next) break;
#pragma unroll
        for (int a = 0; a < 2; ++a)
#pragma unroll
            for (int b = 0; b < 2; ++b)
#pragma unroll
                for (int m = 0; m < 4; ++m)
#pragma unroll
                    for (int n = 0; n < 2; ++n) acc[a][b][m][n] = (f32x4){0.f, 0.f, 0.f, 0.f};
        cur = nxt; cA = nA; cB = nB; ++ui;
    }
    G_WAIT_V(0);
    if (wr == 0) G_BAR;
    G_BAR;
#undef G_SA
#undef G_SB
#undef G_STAGE
#undef G_LDA
#undef G_LDB
#undef G_MMA
#undef G_WAIT_V
#undef G_WAIT_L
#undef G_BAR
#undef G_SCHED
}

constexpr int A_SHM_V = 64 * 128 * 2, A_SHM_K = 64 * 400;
#define KSWZ(row, colB) ((row) * 400 + (colB))
__device__ __forceinline__ int crow(int r, int hi) { return (r & 3) + 8 * (r >> 2) + 4 * hi; }
__device__ __forceinline__ unsigned cvtpk(float lo, float hi) { unsigned r; asm volatile("v_cvt_pk_bf16_f32 %0, %1, %2" : "=v"(r) : "v"(lo), "v"(hi)); return r; }
__device__ __forceinline__ int v_st(int k, int c) { const int kk = (k & ~0xC) | ((k & 4) << 1) | ((k & 8) >> 1); return ((kk >> 3) * 4 + (c >> 5)) * 512 + ((kk & 7) * 32 + (c & 31)) * 2; }
__device__ __forceinline__ int v_rd_base(int lane) { return ((lane & 3) << 3) | (((lane >> 2) & 3) << 6) | (((lane >> 4) & 1) << 5) | (((lane >> 5) & 1) << 8); }
constexpr int v_rd_off(int d0, int ks, int half) { return d0 * 512 + ks * 4096 + half * 2048; }
template <int OFF> __device__ __forceinline__ s16x4 tr_read(int vb) { s16x4 r; asm volatile("ds_read_b64_tr_b16 %0, %1 offset:%2" : "=&v"(r) : "v"(vb), "i"(OFF) : "memory"); return r; }
template <int D0> __device__ __forceinline__ void pv_one(f32x16& od, int vb, bf16x8 pa0, bf16x8 pa1, bf16x8 pa2, bf16x8 pa3) {
    const s16x4 l0 = tr_read<v_rd_off(D0, 0, 0)>(vb), h0 = tr_read<v_rd_off(D0, 0, 1)>(vb), l1 = tr_read<v_rd_off(D0, 1, 0)>(vb), h1 = tr_read<v_rd_off(D0, 1, 1)>(vb);
    const s16x4 l2 = tr_read<v_rd_off(D0, 2, 0)>(vb), h2 = tr_read<v_rd_off(D0, 2, 1)>(vb), l3 = tr_read<v_rd_off(D0, 3, 0)>(vb), h3 = tr_read<v_rd_off(D0, 3, 1)>(vb);
    asm volatile("s_waitcnt lgkmcnt(0)" ::: "memory"); __builtin_amdgcn_sched_barrier(0);
#define PK(L, H) (bf16x8){L[0], L[1], L[2], L[3], H[0], H[1], H[2], H[3]}
    od = __builtin_amdgcn_mfma_f32_32x32x16_bf16(pa0, PK(l0, h0), od, 0, 0, 0);
    od = __builtin_amdgcn_mfma_f32_32x32x16_bf16(pa1, PK(l1, h1), od, 0, 0, 0);
    od = __builtin_amdgcn_mfma_f32_32x32x16_bf16(pa2, PK(l2, h2), od, 0, 0, 0);
    od = __builtin_amdgcn_mfma_f32_32x32x16_bf16(pa3, PK(l3, h3), od, 0, 0, 0);
#undef PK
}
__device__ __forceinline__ void att_body(const AttItem& a, char* lds) {
    int tid_ = threadIdx.x; asm volatile("" : "+v"(tid_));
    const int tid = tid_, wid = tid >> 6, lane = tid & 63, r32 = lane & 31, hi = lane >> 5;
    char* V_lds = lds; char* K_lds = lds + 2 * A_SHM_V; float* li_l = (float*)(lds + 2 * A_SHM_V + 2 * A_SHM_K) + wid * 64;
    float l_reg = 0.f; f32x16 o[4] = {}; bf16x8 qr[12];
    const u16* Qw = a.q + (size_t)(wid * 32 + r32) * 1536 + hi * 8;
#pragma unroll
    for (int d0 = 0; d0 < 12; ++d0) qr[d0] = *(const bf16x8*)(Qw + d0 * 16);
    const int sr = tid >> 4, sc = (tid & 15) * 8, vst0 = v_st(sr, sc), vst1 = v_st(32 + sr, sc);
    const int voff0 = sr * 1024 + sc, voff1 = (32 + sr) * 1024 + sc;
    int koff[3], kwr[3];
#pragma unroll
    for (int i = 0; i < 3; ++i) { const int id = tid + i * 512, kr_ = id / 24, kc_ = (id % 24) * 8; koff[i] = kr_ * 1536 + kc_; kwr[i] = KSWZ(kr_, kc_ * 2); }
    const int vb0 = (int)(uintptr_t)V_lds + v_rd_base(lane);
    bf16x8 vs0, vs1, ks[3];
    const int NT = a.ntot / 64;
#define A_SLOAD(k0_) do { const int key0_ = (k0_); const u16* kb_ = key0_ < a.n0 ? a.k0 + (size_t)key0_ * 1536 : a.k1 + (size_t)(key0_ - a.n0) * 1536; \
        const u16* vbp_ = key0_ < a.n0 ? a.v0 + (size_t)key0_ * 1024 : a.v1 + (size_t)(key0_ - a.n0) * 1024; \
        vs0 = *(const bf16x8*)(vbp_ + voff0); vs1 = *(const bf16x8*)(vbp_ + voff1); \
        _Pragma("unroll") for (int i = 0; i < 3; ++i) ks[i] = *(const bf16x8*)(kb_ + koff[i]); } while (0)
#define A_SWRITE(b) do { *(bf16x8*)(V_lds + (b) * A_SHM_V + vst0) = vs0; *(bf16x8*)(V_lds + (b) * A_SHM_V + vst1) = vs1; \
        _Pragma("unroll") for (int i = 0; i < 3; ++i) *(bf16x8*)(K_lds + (b) * A_SHM_K + kwr[i]) = ks[i]; } while (0)
    A_SLOAD(0); A_SWRITE(0); __syncthreads();
    auto tile = [&](int j, auto bufc) { constexpr int buf = decltype(bufc)::value;
        if (buf == 0 || j + 1 < NT) A_SLOAD((j + 1) * 64);
        f32x16 p0 = {}, p1 = {};
        const char* Ks = K_lds + buf * A_SHM_K;
#pragma unroll
        for (int d0 = 0; d0 < 12; ++d0) { const int cbb = (d0 * 16 + hi * 8) * 2;
            const bf16x8 b0 = *(const bf16x8*)(Ks + KSWZ(r32, cbb)); const bf16x8 b1 = *(const bf16x8*)(Ks + KSWZ(32 + r32, cbb));
            p0 = __builtin_amdgcn_mfma_f32_32x32x16_bf16(b0, qr[d0], p0, 0, 0, 0);
            p1 = __builtin_amdgcn_mfma_f32_32x32x16_bf16(b1, qr[d0], p1, 0, 0, 0); }
        float ps = 0.f;
#pragma unroll
        for (int r = 0; r < 16; ++r) { p0[r] = __builtin_amdgcn_exp2f(p0[r]); p1[r] = __builtin_amdgcn_exp2f(p1[r]); ps += p0[r] + p1[r]; }
        { auto rr = __builtin_amdgcn_permlane32_swap(__float_as_uint(ps), __float_as_uint(ps), false, false); ps = __uint_as_float(rr[0]) + __uint_as_float(rr[1]); }
        l_reg += ps;
        bf16x8 pa0, pa1, pa2, pa3;
#define PK4(Pv, BASE, OUT) do { unsigned a0 = cvtpk(Pv[BASE + 0], Pv[BASE + 1]), a1 = cvtpk(Pv[BASE + 2], Pv[BASE + 3]); \
        unsigned b0 = cvtpk(Pv[BASE + 4], Pv[BASE + 5]), b1 = cvtpk(Pv[BASE + 6], Pv[BASE + 7]); \
        auto r0 = __builtin_amdgcn_permlane32_swap(a0, b0, false, false); auto r1 = __builtin_amdgcn_permlane32_swap(a1, b1, false, false); \
        u32x4 w = {r0[0], r1[0], r0[1], r1[1]}; OUT = *reinterpret_cast<bf16x8*>(&w); } while (0)
        PK4(p0, 0, pa0); PK4(p0, 8, pa1); PK4(p1, 0, pa2); PK4(p1, 8, pa3);
#undef PK4
        const int vb = vb0 + buf * A_SHM_V;
        pv_one<0>(o[0], vb, pa0, pa1, pa2, pa3); pv_one<1>(o[1], vb, pa0, pa1, pa2, pa3); pv_one<2>(o[2], vb, pa0, pa1, pa2, pa3); pv_one<3>(o[3], vb, pa0, pa1, pa2, pa3);
        if (buf == 0 || j + 1 < NT) A_SWRITE(buf ^ 1);
        __syncthreads();
    };
    _Pragma("nounroll") for (int j = 0; j < NT; j += 2) { tile(j, std::integral_constant<int, 0>{}); tile(j + 1, std::integral_constant<int, 1>{}); }
    if (hi == 0) li_l[r32] = l_reg;
    asm volatile("s_waitcnt lgkmcnt(0)" ::: "memory");
    __builtin_amdgcn_wave_barrier();
    u16* Ow = a.o + (size_t)(wid * 32) * 1024;
#pragma unroll
    for (int r = 0; r < 16; ++r) { const int orow = crow(r, hi); const float rl = 1.0f / li_l[orow];
#pragma unroll
        for (int d0 = 0; d0 < 4; ++d0) Ow[(size_t)orow * 1024 + d0 * 32 + r32] = f2bf(o[d0][r] * rl); }
    __syncthreads();
#undef A_SLOAD
#undef A_SWRITE
}

__device__ __forceinline__ float wsum(float v) { for (int o = 32; o >= 1; o >>= 1) v += __shfl_xor(v, o); return v; }
__device__ __forceinline__ void norm_wave(const P& p, int layer, int k, int r, int s5, int lane) {
    const float* x = hsrc(p, r, layer == 0 && k == 0); f32x4 v[4]; float ss = 0.f;
#pragma unroll
    for (int i = 0; i < 4; ++i) { v[i] = *(const f32x4*)(x + i * 256 + lane * 4); ss += v[i][0] * v[i][0] + v[i][1] * v[i][1] + v[i][2] * v[i][2] + v[i][3] * v[i][3]; }
    ss = wsum(ss); const float rinv = rsq_f(ss * (1.0f / 1024.0f) + EPS);
    const float* g = p.in[6] + (size_t)(layer * 3 + k) * 1024; const float* sh = modp(p, layer, r, 3 * k); const float* sc = modp(p, layer, r, 3 * k + 1);
    int row5 = 0, i5 = 0;
    if (s5) { if (r < NL) { const int b = r / SEQ, t = r % SEQ; row5 = b * S5L + t / 32; i5 = t % 32; } else { const int rr = r - NL; const int b = rr / 256, l = rr % 256; row5 = NB * S5L + b * S5C + l / 32; i5 = l % 32; } }
#pragma unroll
    for (int i = 0; i < 4; ++i) { const int d = i * 256 + lane * 4; const f32x4 gv = *(const f32x4*)(g + d), sv = *(const f32x4*)(sc + d), hv = *(const f32x4*)(sh + d); f32x4 o;
        for (int j = 0; j < 4; ++j) o[j] = v[i][j] * rinv * gv[j] * (1.0f + sv[j]) + hv[j];
        if (!s5) st4bf(wsb(p, O_HN) + (size_t)r * 1024 + d, o);
        else st4bf(wsb(p, O_UEXT) + ((size_t)(d >> 4) * NROW5P + row5) * 768 + i5 * 16 + (d & 15), o); } }
__device__ __forceinline__ void mla_row_wave(const P& p, int j, int r, int lane) {
    const float* x = (const float*)(p.ws + O_CALL) + (size_t)r * 768; f32x4 c[3]; float q[3];
#pragma unroll
    for (int i = 0; i < 3; ++i) { c[i] = *(const f32x4*)(x + i * 256 + lane * 4); q[i] = c[i][0] * c[i][0] + c[i][1] * c[i][1] + c[i][2] * c[i][2] + c[i][3] * c[i][3]; }
    const bool lo = lane < 32;
    const float ssq = wsum(q[0] + (lo ? q[1] : 0.f)), sskv = wsum((lo ? 0.f : q[1]) + (lo ? q[2] : 0.f)), ssr = wsum((lane >= 32 && lane < 48) ? q[2] : 0.f);
    const float rq = rsq_f(ssq * (1.0f / 384.0f) + EPS), rkv = rsq_f(sskv * (1.0f / 256.0f) + EPS), rr_ = rsq_f(ssr * (1.0f / 64.0f) + EPS);
    const float* qn = p.in[10] + j * 384; const float* kvn = p.in[11] + j * 256; const float* kg = p.in[15] + j * 192 + 128;
    { const f32x4 gq = *(const f32x4*)(qn + lane * 4); f32x4 o; for (int jx = 0; jx < 4; ++jx) o[jx] = c[0][jx] * rq * gq[jx]; st4bf(wsb(p, O_CQN) + (size_t)r * 384 + lane * 4, o); }
    if (lo) { const f32x4 gq = *(const f32x4*)(qn + 256 + lane * 4); f32x4 o; for (int jx = 0; jx < 4; ++jx) o[jx] = c[1][jx] * rq * gq[jx]; st4bf(wsb(p, O_CQN) + (size_t)r * 384 + 256 + lane * 4, o);
        const f32x4 gk = *(const f32x4*)(kvn + 128 + lane * 4); f32x4 o2; for (int jx = 0; jx < 4; ++jx) o2[jx] = c[2][jx] * rkv * gk[jx]; st4bf(wsb(p, O_CKVN) + (size_t)r * 256 + 128 + lane * 4, o2); }
    else { const f32x4 gk = *(const f32x4*)(kvn + lane * 4 - 128); f32x4 o; for (int jx = 0; jx < 4; ++jx) o[jx] = c[1][jx] * rkv * gk[jx]; st4bf(wsb(p, O_CKVN) + (size_t)r * 256 + lane * 4 - 128, o); }
    const int dd = (4 * (lane - 32)) & 63; const f32x4 gr = *(const f32x4*)(kg + dd); f32x4 own, oth, o;
    for (int jx = 0; jx < 4; ++jx) own[jx] = c[2][jx] * rr_ * gr[jx];
    for (int jx = 0; jx < 4; ++jx) oth[jx] = __shfl_xor(own[jx], 4);
    const int t = r % SEQ, pos = (dd & 32) ? (t % 64) : (t / 64); const bool first = (dd & 16) == 0;
    for (int jx = 0; jx < 4; ++jx) { float cs = 1.f, sn = 0.f; if (r < NL) sincos_t((float)pos * ropef((dd & 15) + jx, 16), sn, cs);
        o[jx] = first ? own[jx] * cs - oth[jx] * sn : own[jx] * cs + oth[jx] * sn; }
    if (lane >= 32 && lane < 48) { u16* kf = wsb(p, O_KF) + (size_t)r * 1536 + 128 + dd;
#pragma unroll
        for (int h = 0; h < 8; ++h) st4bf(kf + h * 192, o); } }
__device__ __forceinline__ float bflo(unsigned w) { return __uint_as_float(w << 16); }
__device__ __forceinline__ float bfhi(unsigned w) { return __uint_as_float(w & 0xffff0000u); }
__device__ __forceinline__ unsigned pk2(float a, float b) { return (unsigned)f2bf(a) | ((unsigned)f2bf(b) << 16); }
__device__ __forceinline__ void mla_head_wave(const P& p, int j, int r, int lane) {
    const int h = lane >> 3, sub = lane & 7;
    u16* q = wsb(p, O_CALL) + (size_t)r * 1536 + h * 192; u16* k = wsb(p, O_KF) + (size_t)r * 1536 + h * 192;
    const float* qg = p.in[14] + j * 192; const float* kg = p.in[15] + j * 192;
    u32x4 qa = *(const u32x4*)(q + sub * 16), qb = *(const u32x4*)(q + sub * 16 + 8), qr = *(const u32x4*)(q + 128 + sub * 8), ka = *(const u32x4*)(k + sub * 16), kb = *(const u32x4*)(k + sub * 16 + 8);
    float sq = 0.f, sk = 0.f, sr = 0.f;
#pragma unroll
    for (int i = 0; i < 4; ++i) { sq += bflo(qa[i]) * bflo(qa[i]) + bfhi(qa[i]) * bfhi(qa[i]) + bflo(qb[i]) * bflo(qb[i]) + bfhi(qb[i]) * bfhi(qb[i]);
        sk += bflo(ka[i]) * bflo(ka[i]) + bfhi(ka[i]) * bfhi(ka[i]) + bflo(kb[i]) * bflo(kb[i]) + bfhi(kb[i]) * bfhi(kb[i]); sr += bflo(qr[i]) * bflo(qr[i]) + bfhi(qr[i]) * bfhi(qr[i]); }
    for (int o = 4; o >= 1; o >>= 1) { sq += __shfl_xor(sq, o); sk += __shfl_xor(sk, o); sr += __shfl_xor(sr, o); }
    const float rq = rsq_f(sq * (1.0f / 128.0f) + EPS), rk = rsq_f(sk * (1.0f / 128.0f) + EPS), rr_ = rsq_f(sr * (1.0f / 64.0f) + EPS);
    u32x4 oa, ob, oka, okb;
#pragma unroll
    for (int i = 0; i < 4; ++i) { const int d = sub * 16 + 2 * i;
        oa[i] = pk2(bflo(qa[i]) * rq * qg[d] * QSCALE, bfhi(qa[i]) * rq * qg[d + 1] * QSCALE); ob[i] = pk2(bflo(qb[i]) * rq * qg[d + 8] * QSCALE, bfhi(qb[i]) * rq * qg[d + 9] * QSCALE);
        oka[i] = pk2(bflo(ka[i]) * rk * kg[d], bfhi(ka[i]) * rk * kg[d + 1]); okb[i] = pk2(bflo(kb[i]) * rk * kg[d + 8], bfhi(kb[i]) * rk * kg[d + 9]); }
    *(u32x4*)(q + sub * 16) = oa; *(u32x4*)(q + sub * 16 + 8) = ob; *(u32x4*)(k + sub * 16) = oka; *(u32x4*)(k + sub * 16 + 8) = okb;
    const int dd = sub * 8; float own[8], oth[8];
#pragma unroll
    for (int i = 0; i < 4; ++i) { own[2 * i] = bflo(qr[i]) * rr_ * qg[128 + dd + 2 * i]; own[2 * i + 1] = bfhi(qr[i]) * rr_ * qg[128 + dd + 2 * i + 1]; }
#pragma unroll
    for (int i = 0; i < 8; ++i) oth[i] = __shfl_xor(own[i], 2);
    const int t = r % SEQ, pos = (dd & 32) ? (t % 64) : (t / 64); const bool first = (dd & 16) == 0; u32x4 orr; float res[8];
#pragma unroll
    for (int i = 0; i < 8; ++i) { float cs = 1.f, sn = 0.f; if (r < NL) sincos_t((float)pos * ropef((dd & 15) + i, 16), sn, cs); res[i] = first ? own[i] * cs - oth[i] * sn : own[i] * cs + oth[i] * sn; }
#pragma unroll
    for (int i = 0; i < 4; ++i) orr[i] = pk2(res[2 * i] * QSCALE, res[2 * i + 1] * QSCALE);
    *(u32x4*)(q + 128 + dd) = orr; }
__device__ __forceinline__ void ret_norm_wave(const P& p, int q, int lr, int lane) {
    const int h = lane >> 4, sub = lane & 15; u16* o = wsb(p, O_OB) + (size_t)lr * 2048 + h * 512 + sub * 32; u16* yd = ret_ydst(p, q, lr) + h * 512 + sub * 32; const u16* g = wsb(p, O_GATE) + (size_t)lr * 2048 + h * 512 + sub * 32; const float* gg = p.in[19] + h * 512 + sub * 32;
    u32x4 ov[4]; float s = 0.f;
#pragma unroll
    for (int i = 0; i < 4; ++i) { ov[i] = *(const u32x4*)(o + i * 8); for (int jx = 0; jx < 4; ++jx) s += bflo(ov[i][jx]) + bfhi(ov[i][jx]); }
    for (int m = 8; m >= 1; m >>= 1) s += __shfl_xor(s, m);
    const float mu = s * (1.0f / 512.0f); float qv = 0.f;
#pragma unroll
    for (int i = 0; i < 4; ++i) for (int jx = 0; jx < 4; ++jx) { const float a = bflo(ov[i][jx]) - mu, b = bfhi(ov[i][jx]) - mu; qv += a * a + b * b; }
    for (int m = 8; m >= 1; m >>= 1) qv += __shfl_xor(qv, m);
    const float rstd = rsq_f(qv * (1.0f / 512.0f) + EPS);
#pragma unroll
    for (int i = 0; i < 4; ++i) { const u32x4 gv = *(const u32x4*)(g + i * 8); u32x4 w;
        for (int jx = 0; jx < 4; ++jx) { const int e = i * 8 + 2 * jx;
            w[jx] = pk2((bflo(ov[i][jx]) - mu) * rstd * gg[e] * silu_f(bflo(gv[jx])), (bfhi(ov[i][jx]) - mu) * rstd * gg[e + 1] * silu_f(bfhi(gv[jx]))); }
        *(u32x4*)(yd + i * 8) = w; } }
__device__ __forceinline__ void mod_phase(const P& p, float* tab) {
    for (int i = threadIdx.x; i < NMR * 1024; i += 512) { const int b = i >> 10, k = i & 1023; tab[i] = silu_f(b < NB ? p.in[1][b * 1024 + k] : p.in[3][k]); }
    __syncthreads();
    for (int idx = blockIdx.x * 512 + threadIdx.x; idx < DEPTH * 9216; idx += gridDim.x * 512) {
        const int layer = idx / 9216, col = idx % 9216; const float* w = p.in[4] + (size_t)layer * 1024 * 9216 + col; float acc[NMR];
#pragma unroll
        for (int b = 0; b < NMR; ++b) acc[b] = 0.f;
        for (int k = 0; k < 1024; ++k) { const float wv = w[(size_t)k * 9216];
#pragma unroll
            for (int b = 0; b < NMR; ++b) acc[b] += tab[b * 1024 + k] * wv; }
        const float bias = p.in[5][layer * 9216 + col];
#pragma unroll
        for (int b = 0; b < NMR; ++b) ((float*)(p.ws + O_MOD))[(size_t)(layer * NMR + b) * 9216 + col] = acc[b] + bias; }
    __syncthreads(); }
#define WPASS(N, HOSTCALL, DEVCALL) do { const int _n = (int)(N); int t0_ = threadIdx.x; asm volatile("" : "+v"(t0_)); const int lane = t0_ & 63; for (int it = blockIdx.x * 8 + (t0_ >> 6); it < _n; it += gridDim.x * 8) { DEVCALL; } } while (0)
#define MODPHASE() mod_phase(p, (float*)shm)
#define NCTXWG ((NC / 256) * 4)
#define MIXED_DOWN_NORM(DESC, LAYER2, KK, S5F, ASHARE) do { int t0_ = threadIdx.x; asm volatile("" : "+v"(t0_)); const int lane = t0_ & 63; int r0_, r1_; \
    if ((int)blockIdx.x < NCTXWG) { gemm_run(lds, DESC); r0_ = (int)blockIdx.x * (ASHARE); r1_ = r0_ + (ASHARE); }     \
    else { const int no_ = (int)gridDim.x - NCTXWG, rest_ = NL - NCTXWG * (ASHARE), per_ = (rest_ + no_ - 1) / no_; r0_ = NCTXWG * (ASHARE) + ((int)blockIdx.x - NCTXWG) * per_; r1_ = r0_ + per_ < NL ? r0_ + per_ : NL; } \
    for (int it = r0_ + (t0_ >> 6); it < r1_; it += 8) norm_wave(p, LAYER2, KK, it, S5F, lane); } while (0)
#define MIXED_RET_TAIL(LATDESC, CTXDESC, NCW, LAYER2, KK, RA, RB) do { gemm_run(lds, LATDESC); int t0_ = threadIdx.x; asm volatile("" : "+v"(t0_)); const int lane = t0_ & 63; \
    if ((int)blockIdx.x < (NCW)) { gemm_run(lds, CTXDESC); } else { const int nw_ = ((int)gridDim.x - (NCW)) * 8; \
        for (int it = (RA) + ((int)blockIdx.x - (NCW)) * 8 + (t0_ >> 6); it < (RB); it += nw_) norm_wave(p, LAYER2, KK, it, 0, lane); } } while (0)
#define RANGENORM(LAYER2, KK, RA, RB) do { int t0_ = threadIdx.x; asm volatile("" : "+v"(t0_)); const int lane = t0_ & 63; for (int it = (RA) + blockIdx.x * 8 + (t0_ >> 6); it < (RB); it += gridDim.x * 8) norm_wave(p, LAYER2, KK, it, 0, lane); } while (0)
#define CTXNORM(LAYER2, KK, S5F) do { int t0_ = threadIdx.x; asm volatile("" : "+v"(t0_)); const int lane = t0_ & 63; for (int it = NL + blockIdx.x * 8 + (t0_ >> 6); it < MT; it += gridDim.x * 8) norm_wave(p, LAYER2, KK, it, S5F, lane); } while (0)

#define XB_TMO      128
#define XB_XCNT(j)  (256  + 64 * (j))
#define XB_XSUB(j)  (1280 + 64 * (j))
#define XB_XGEN(j)  (2304 + 64 * (j))
#define XB_TOP      3328
#define XB_TOPGEN   3392
#define XCD_BAR_WORDS 3456
#define XB_SPIN_CAP (1u << 18)
__device__ __forceinline__ unsigned xb_ld(unsigned* p)              { return __hip_atomic_load(p, __ATOMIC_RELAXED, __HIP_MEMORY_SCOPE_AGENT); }
__device__ __forceinline__ unsigned xb_add(unsigned* p, unsigned v) { return __hip_atomic_fetch_add(p, v, __ATOMIC_RELAXED, __HIP_MEMORY_SCOPE_AGENT); }
__device__ __forceinline__ unsigned xb_xcc_id() { return (unsigned)__builtin_amdgcn_s_getreg((3 << 11) | 20) & 0xFu; }
#define XB_SPIN(cond, bar) do { unsigned _sp = 0; while (cond) { __builtin_amdgcn_s_sleep(1); \
    if ((++_sp & 255u) == 0u) { if (xb_ld(&(bar)[XB_TMO])) break; if (_sp > XB_SPIN_CAP) { atomicAdd(&(bar)[XB_TMO], 1u); break; } } } } while (0)
struct XcdBarrier { unsigned* bar; unsigned x; volatile LAS unsigned* st; };
__device__ __forceinline__ XcdBarrier xcd_barrier_post(unsigned* bar, volatile LAS unsigned* st) {
    XcdBarrier b; b.bar = bar; b.x = xb_xcc_id(); b.st = st;
    if (threadIdx.x == 0) (void)xb_add(&bar[XB_XCNT(b.x)], 1u);
    return b; }
__device__ __forceinline__ void xcd_barrier_complete(unsigned* bar, unsigned x, unsigned& nloc, unsigned& nx) {
    const unsigned G = gridDim.x * gridDim.y * gridDim.z; unsigned sum, cnt, mine, sp = 0u;
    for (;;) { sum = 0u; cnt = 0u; mine = 0u;
#pragma unroll
        for (unsigned j = 0; j < 16; ++j) { const unsigned c = xb_ld(&bar[XB_XCNT(j)]); sum += c; cnt += (c > 0u) ? 1u : 0u; mine = (j == x) ? c : mine; }
        if (sum == G) break;
        __builtin_amdgcn_s_sleep(1);
        if ((++sp & 255u) == 0u) { if (xb_ld(&bar[XB_TMO])) break; if (sp > XB_SPIN_CAP) { atomicAdd(&bar[XB_TMO], 1u); break; } } }
    nloc = mine > 0u ? mine : 1u; nx = cnt > 0u ? cnt : 1u; }
__device__ __forceinline__ void xcd_barrier(const XcdBarrier& b) {
    asm volatile("s_waitcnt vmcnt(0)" ::: "memory");
    __syncthreads();
    if (threadIdx.x == 0) {
        unsigned* bar = b.bar;
        __builtin_amdgcn_s_waitcnt(0);
        unsigned nloc = b.st[0], nx = b.st[1];
        if (nloc == 0u) { xcd_barrier_complete(bar, b.x, nloc, nx); b.st[0] = nloc; b.st[1] = nx; }
        const unsigned old = xb_add(&bar[XB_XSUB(b.x)], 1u);
        const unsigned gen = old / nloc;
        if (old + 1u == (gen + 1u) * nloc) {
            __builtin_amdgcn_fence(__ATOMIC_RELEASE, "agent");
            asm volatile("s_waitcnt vmcnt(0)" ::: "memory");
            const unsigned og = xb_add(&bar[XB_TOP], 1u);
            const unsigned tg = og / nx;
            if (og + 1u == (tg + 1u) * nx) xb_add(&bar[XB_TOPGEN], 1u);
            else XB_SPIN(xb_ld(&bar[XB_TOPGEN]) == tg, bar);
            __builtin_amdgcn_fence(__ATOMIC_ACQUIRE, "agent");
            xb_add(&bar[XB_XGEN(b.x)], 1u);
            asm volatile("s_waitcnt vmcnt(0)" ::: "memory");
        } else {
            XB_SPIN(xb_ld(&bar[XB_XGEN(b.x)]) == gen, bar);
            __builtin_amdgcn_fence(__ATOMIC_ACQUIRE, "agent");
            asm volatile("s_waitcnt vmcnt(0)" ::: "memory");
        }
    }
    __syncthreads();
}

namespace cg = cooperative_groups;
#define PASS(N, CALL) do { const long _n = (long)(N); int t0_ = threadIdx.x; asm volatile("" : "+v"(t0_)); for (long it = (long)blockIdx.x * 512 + t0_; it < _n; it += (long)gridDim.x * 512) { CALL; } } while (0)
#define GEMM(D) gemm_run(lds, D)
#define SYNC() xcd_barrier(xb)
#ifndef STAGGER_US
#define STAGGER_US 40
#endif
#define STAGGER(US) do { if ((US) > 0 && (xb.x & 1u)) { const unsigned long long t0_ = __builtin_amdgcn_s_memrealtime(); while (__builtin_amdgcn_s_memrealtime() - t0_ < (unsigned long long)(US) * 100ull) __builtin_amdgcn_s_sleep(8); } } while (0)
#define GRIDSYNC() grid.sync()
#define HOOK(L, S) do { } while (0)
#define ATTN(NITEMS) do { for (int it = blockIdx.x; it < (NITEMS); it += gridDim.x) { AttItem ai_; att_item(p, it, ai_); att_body(ai_, (char*)shm); } } while (0)
#else
template <class Dsc> static void gemm_emu(const Dsc& D) {
    std::vector<int> Ls; for (int c = 0; c < 256; ++c) for (int i = 0;; ++i) { Unit u{}; if (!D.unit(i * 256 + c, u)) break; Ls.push_back(i * 256 + c); }
    const int n = (int)Ls.size();
#pragma omp parallel for schedule(dynamic)
    for (int li = 0; li < n; ++li) { const int L = Ls[li]; Unit u{}; D.unit(L, u); const int K = Dsc::K;
        std::vector<float> A((size_t)256 * K), B((size_t)256 * K), C((size_t)256 * 256);
        for (int r = 0; r < 256; ++r) for (int k = 0; k < K; ++k) { A[(size_t)r * K + k] = bf2f(u.A[(size_t)r * Dsc::lda + k]); B[(size_t)r * K + k] = bf2f(u.B[(size_t)r * Dsc::ldb + k]); }
        for (int r = 0; r < 256; ++r) for (int c = 0; c < 256; ++c) { float s = 0.f; const float* a = &A[(size_t)r * K]; const float* b = &B[(size_t)c * K]; for (int k = 0; k < K; ++k) s += a[k] * b[k]; C[r * 256 + c] = s; }
        for (int r = 0; r < 128; ++r) for (int c = 0; c < 128; c += 4) { f32x4 v[2][2];
            for (int X = 0; X < 2; ++X) for (int Y = 0; Y < 2; ++Y) for (int j = 0; j < 4; ++j) v[X][Y][j] = C[(r + 128 * X) * 256 + c + 128 * Y + j];
            D.emit(u, r, c, v[0][0], v[0][1], v[1][0], v[1][1]); } } }
static void att_emu(const P& p, int nitems) {
#pragma omp parallel for schedule(dynamic)
    for (int it = 0; it < nitems; ++it) { AttItem a; att_item(p, it, a); std::vector<float> s(a.ntot);
        for (int i = 0; i < 256; ++i) { const u16* q = a.q + (size_t)i * 1536; float l = 0.f; float o[128]; for (int e = 0; e < 128; ++e) o[e] = 0.f;
            for (int k = 0; k < a.ntot; ++k) { const u16* kr = k < a.n0 ? a.k0 + (size_t)k * 1536 : a.k1 + (size_t)(k - a.n0) * 1536; float d = 0.f; for (int x = 0; x < 192; ++x) d += bf2f(q[x]) * bf2f(kr[x]);
                const float pv = bf2f(f2bf(exp2f(d))); l += exp2f(d); const u16* vr = k < a.n0 ? a.v0 + (size_t)k * 1024 : a.v1 + (size_t)(k - a.n0) * 1024; for (int e = 0; e < 128; ++e) o[e] += pv * bf2f(vr[e]); }
            for (int e = 0; e < 128; ++e) a.o[(size_t)i * 1024 + e] = f2bf(o[e] / l); } } }
#define PASS(N, CALL) do { const long _n = (long)(N); _Pragma("omp parallel for schedule(static)") for (long it = 0; it < _n; ++it) { CALL; } } while (0)
#define WPASS(N, HOSTCALL, DEVCALL) PASS(N, HOSTCALL)
#define MODPHASE() PASS(DEPTH * 9216, mod_item(p, (int)it))
#define MIXED_DOWN_NORM(DESC, LAYER2, KK, S5F, ASHARE) do { gemm_emu(DESC); PASS(NL, norm_item(p, LAYER2, KK, (int)it, S5F)); } while (0)
#define CTXNORM(LAYER2, KK, S5F) PASS(NC, norm_item(p, LAYER2, KK, NL + (int)it, S5F))
#define MIXED_RET_TAIL(LATDESC, CTXDESC, NCW, LAYER2, KK, RA, RB) do { gemm_emu(LATDESC); gemm_emu(CTXDESC); PASS((RB) - (RA), norm_item(p, LAYER2, KK, (RA) + (int)it, 0)); } while (0)
#define RANGENORM(LAYER2, KK, RA, RB) PASS((RB) - (RA), norm_item(p, LAYER2, KK, (RA) + (int)it, 0))
#define GEMM(D) gemm_emu(D)
#define SYNC() do { } while (0)
#define STAGGER(US) do { } while (0)
#define GRIDSYNC() do { } while (0)
#define ATTN(NITEMS) att_emu(p, NITEMS)
static void emu_hook(const P& p, int layer, int stage);
#define HOOK(L, S) emu_hook(p, L, S)
#endif

#ifndef HOST_EMU
__global__ void __launch_bounds__(512) fwd_megakernel(P p) {
    extern __shared__ __attribute__((aligned(16))) unsigned char shm[];
    LAS unsigned char* lds = (LAS unsigned char*)shm;
    cg::grid_group grid = cg::this_grid();
    volatile LAS unsigned* xst = (volatile LAS unsigned*)(lds + STAGE_BYTES + 1024);
    if (threadIdx.x == 0) { xst[0] = 0u; xst[1] = 0u; xst[2] = 0u; xst[3] = 0u; }
    __syncthreads();
    const XcdBarrier xb = xcd_barrier_post((unsigned*)(p.ws + O_BAR), xst);
#else
static void fwd_emu(P p) {
#endif
    if (PM(0)) { MODPHASE();
    PASS((long)NC * 256, ((f32x4*)(p.ws + O_G))[it] = ((const f32x4*)p.in[2])[it]);
    PASS(CV_TOTAL, cvt_item(p, it));
    PASS(64 * 2 * 32 * 16, s5_ktab_item(p, (int)it));
    PASS(64 * 256 * 512, s5_fext_item(p, (int)it)); }
    GRIDSYNC();
    if (PM(0)) { PASS((long)64 * 512 * 768, s5_text_item(p, it)); }
    for (int rep_ = 0; rep_ < REP_SYNC; ++rep_) SYNC();
    for (int layer = 0; layer < DEPTH; ++layer) {
        const int kind = layer % 3, j = layer / 3; const bool last = layer == DEPTH - 1;
        if (layer == 0) { if (PM(1)) { WPASS(MT, norm_item(p, layer, 0, (int)it, 0), norm_wave(p, layer, 0, it, 0, lane)); } SYNC(); }
        for (int rep_ = 0; rep_ < REP_UP; ++rep_) { if (PM(2)) { DFfnUp d{p, layer, 0, MT / 256}; GEMM(d); } SYNC(); }
        if (PM(3)) { DFfnDown d{p, layer, 0, NL / 256, 0.5f}; GEMM(d); } SYNC();
        if (PM(3)) { DFfnDown d{p, layer, 0, -1, 0.5f}; MIXED_DOWN_NORM(d, layer, 1, kind == 2 ? 1 : 0, 56); } SYNC();
        if (PM(1)) { CTXNORM(layer, 1, kind == 2 ? 1 : 0); } SYNC();
        if (kind == 0) {
            for (int rep_ = 0; rep_ < REP_MLA; ++rep_) { if (PM(4)) { DMlaIn d{p, j}; GEMM(d); } SYNC(); }
            if (PM(5)) { WPASS(MT, mla_row_item(p, j, (int)it), mla_row_wave(p, j, it, lane)); } SYNC();
            for (int rep_ = 0; rep_ < REP_MLA; ++rep_) { if (PM(6)) { DMlaUq d{p, j, last ? NL / 256 : MT / 256}; GEMM(d); } if (PM(7)) { DMlaUkv d{p, j}; GEMM(d); } SYNC(); }
            if (PM(8)) { WPASS(MT, { for (int h_ = 0; h_ < 8; ++h_) mla_head_item(p, j, (int)it * 8 + h_); }, mla_head_wave(p, j, it, lane)); } SYNC();
            for (int rep_ = 0; rep_ < REP_ATT; ++rep_) { if (PM(9)) { ATTN(NB * 8 * (SEQ / 256) + (last ? 0 : NB * 8)); } SYNC(); }
            if (PM(10)) { DMlaO d{p, layer, j, NL / 256}; GEMM(d); } SYNC();
            if (!last) { if (PM(10)) { DMlaO d{p, layer, j, -1}; MIXED_DOWN_NORM(d, layer, 2, 0, 184); } SYNC();
                if (PM(1)) { CTXNORM(layer, 2, 0); } SYNC(); }
        } else if (kind == 1) {
            for (int q = 0; q < NB / RGB; ++q) {
                for (int rep_ = 0; rep_ < REP_RET; ++rep_) { if (PM(11)) { DRetProjAll d{p, q}; GEMM(d); } SYNC(); }
                for (int rep_ = 0; rep_ < REP_RET; ++rep_) { if (PM(13)) { DRetP d{p}; GEMM(d); } if (PM(14)) { DRetL d{p}; GEMM(d); } SYNC(); }
                if (PM(15)) { PASS(4 * RGB * 512 * 64, ret_prefix_item(p, (int)it)); } SYNC();
                for (int rep_ = 0; rep_ < REP_RET; ++rep_) { if (PM(16)) { DRetO d{p}; GEMM(d); } SYNC(); }
                if (PM(17)) { WPASS(NCQ * 256, { for (int h_ = 0; h_ < 4; ++h_) ret_norm_item(p, q, (int)it * 4 + h_); }, ret_norm_wave(p, q, it, lane)); } SYNC();
                if (q < NB / RGB - 1) { if (PM(18)) { DRetWo d{p, layer, q}; GEMM(d); } SYNC(); }
                else { if (PM(18)) { DRetWo d{p, layer, q}; DRetWoCtx c{p, layer}; MIXED_RET_TAIL(d, c, (NC / 256) * 4, layer, 2, 0, q * RGB * SEQ); } SYNC();
                    if (PM(1)) { RANGENORM(layer, 2, q * RGB * SEQ, MT); } SYNC(); }
            }
        } else {
            for (int rep_ = 0; rep_ < REP_S5; ++rep_) { if (PM(20)) { DS5L d{p}; GEMM(d); } SYNC(); }
            if (PM(21)) { PASS(64 * NB * 64, s5_prefix_item(p, (int)it)); } SYNC();
            for (int rep_ = 0; rep_ < REP_S5; ++rep_) { if (PM(22)) { DS5Y d{p}; GEMM(d); } SYNC(); }
            if (PM(23)) { DS5Glu d{p, layer}; GEMM(d); } SYNC();
        }
        HOOK(layer, 0);
        if (kind == 2 || (kind == 0 && last)) { if (PM(1)) { WPASS(last ? NL : MT, norm_item(p, layer, 2, (int)it, 0), norm_wave(p, layer, 2, it, 0, lane)); } SYNC(); }
        for (int rep_ = 0; rep_ < REP_UP; ++rep_) { if (PM(2)) { DFfnUp d{p, layer, 1, last ? NL / 256 : MT / 256}; GEMM(d); } SYNC(); }
        if (PM(3)) { DFfnDown d{p, layer, 1, NL / 256, 0.5f}; GEMM(d); } SYNC();
        if (!last) { if (PM(3)) { DFfnDown d{p, layer, 1, -1, 0.5f}; MIXED_DOWN_NORM(d, layer + 1, 0, 0, 56); } SYNC();
            if (PM(1)) { CTXNORM(layer + 1, 0, 0); } SYNC(); }
        HOOK(layer, 1);
    }
}

#ifndef HOST_EMU
extern "C" void kernel_launch(void* const* d_in, const int* in_sizes, int n_in, void* d_out, int out_size, void* d_ws, size_t ws_size, hipStream_t stream) {
    constexpr size_t kDynLds = STAGE_BYTES + 4096;
    static int grid_blocks = 0;
    if (!grid_blocks) {
        int dev = 0, cus = 0, per_cu = 0;
        hipGetDevice(&dev);
        hipDeviceGetAttribute(&cus, hipDeviceAttributeMultiprocessorCount, dev);
        hipFuncSetAttribute((const void*)fwd_megakernel, hipFuncAttributeMaxDynamicSharedMemorySize, (int)kDynLds);
        hipOccupancyMaxActiveBlocksPerMultiprocessor(&per_cu, fwd_megakernel, 512, kDynLds);
        if (per_cu < 1) per_cu = 1;
        if (per_cu > 1) per_cu = 1;
        grid_blocks = cus * per_cu;
        if (ws_size < WS_NEED) fprintf(stderr, "workspace too small: %zu < %zu\n", ws_size, (size_t)WS_NEED);
    }
    P p{};
    for (int i = 0; i < 31 && i < n_in; ++i) p.in[i] = (const float*)d_in[i];
    p.out = (float*)d_out; p.ws = (char*)d_ws;
    hipMemsetAsync((char*)d_ws + O_BAR, 0, XCD_BAR_WORDS * 4, stream);
    void* args[] = {&p};
    hipError_t e = hipLaunchCooperativeKernel((void*)fwd_megakernel, dim3(grid_blocks), dim3(512), args, kDynLds, stream);
    if (e != hipSuccess) fprintf(stderr, "cooperative launch failed: %s (grid %d)\n", hipGetErrorString(e), grid_blocks);
}
#endif
```
